# Optimizing an MI355X kernel written in HIP

```python
import jax
import jax.numpy as jnp
from jax import lax
import numpy as np

D_MODEL = 1024
BATCH = 2
SEQ = 8192
DEPTH = 4

GRID_W = 64
CTX_LEN = 256
EPS = 1e-6

POOL_WIDTH = 512
POOL_WINDOWS = (2, 4, 8, 16)
POOL_GROUP = POOL_WIDTH // len(POOL_WINDOWS)

HY_WIDTH = 512
HY_EMB = 33
HY_BANDS = (HY_EMB - 1) // 2
HY_FILTER_HIDDEN = 64

MLA_HEADS = 8
QK_NOPE = 64
QK_ROPE = 32
QK_DIM = QK_NOPE + QK_ROPE
V_HEAD = 64
Q_LORA = 384
KV_LORA = 256
MLA_SCALE = QK_DIM ** -0.5
ROPE_BASE = 10000.0
Q_BLOCK = 128

D_FF = 4 * D_MODEL
N_BRANCH = 3
N_MOD = 6

OFF_POOL = 0
OFF_HY = OFF_POOL + POOL_WIDTH
OFF_Q = OFF_HY + 3 * HY_WIDTH
OFF_KV = OFF_Q + Q_LORA
OFF_GATE = OFF_KV + KV_LORA + QK_ROPE
D_IN = OFF_GATE + N_BRANCH * D_MODEL

kernel_name = 'hybrid_pool_hyena_mla_prefix_dit'


def rmsnorm(x, g):
    xf = x.astype(jnp.float32)
    y = xf * lax.rsqrt(jnp.mean(xf * xf, axis=-1, keepdims=True) + EPS)
    return (y * g.astype(jnp.float32)).astype(x.dtype)


def axial_rope_tables(n_rows):
    f32 = jnp.float32
    rows = jnp.repeat(jnp.arange(n_rows, dtype=f32), GRID_W)
    cols = jnp.tile(jnp.arange(GRID_W, dtype=f32), n_rows)
    half = QK_ROPE // 2
    inv = ROPE_BASE ** (-jnp.arange(0, half, 2, dtype=f32) / half)
    ar = rows[:, None] * inv
    ac = cols[:, None] * inv
    ang = jnp.concatenate([ar, ar, ac, ac], axis=-1)
    return jnp.cos(ang), jnp.sin(ang)


def apply_axial_rope(x, cos, sin):
    q = QK_ROPE // 4
    rot = jnp.concatenate([-x[..., q:2 * q], x[..., :q], -x[..., 3 * q:], x[..., 2 * q:3 * q]], axis=-1)
    return x * cos.astype(x.dtype) + rot * sin.astype(x.dtype)


def pool_mixer(p, w_group, scale):
    f32 = jnp.float32
    b_, L, _ = p.shape
    pf = p.astype(f32)
    cs = jnp.concatenate([jnp.zeros((b_, 1, POOL_WIDTH), f32), jnp.cumsum(pf, axis=1)], axis=1)
    t = jnp.arange(L)
    outs = []
    for gi, w in enumerate(POOL_WINDOWS):
        lo = jnp.clip(t - w // 2, 0, L)
        hi = jnp.clip(t + w // 2, 0, L)
        sl = slice(gi * POOL_GROUP, (gi + 1) * POOL_GROUP)
        csg = cs[:, :, sl]
        mean = (jnp.take(csg, hi, axis=1) - jnp.take(csg, lo, axis=1)) / (hi - lo).astype(f32)[None, :, None]
        outs.append(mean - pf[:, :, sl])
    u = jnp.stack(outs, axis=2).astype(p.dtype)
    u = jnp.einsum('blgc,gcd->blgd', u, w_group).reshape(b_, L, POOL_WIDTH)
    return u * scale


def short_conv(u, w, b):
    up = jnp.pad(u, ((0, 0), (1, 1), (0, 0)))
    return up[:, :-2] * w[0] + up[:, 1:-1] * w[1] + up[:, 2:] * w[2] + b


def hyena_filter(L, w1, b1, freq1, w2, b2, freq2, w3, decay):
    f32 = jnp.float32
    t = jnp.linspace(0.0, 1.0, L, dtype=f32)[:, None]
    omega = 2.0 * np.pi * jnp.arange(L, dtype=f32)[:, None] / L
    bands = jnp.linspace(1e-4, HY_BANDS - 1, HY_BANDS, dtype=f32)[None, :]
    z = jnp.concatenate([t, jnp.cos(omega * bands), -jnp.sin(omega * bands)], axis=-1)
    hid = jnp.sin(freq1.astype(f32) * (z @ w1.astype(f32) + b1.astype(f32)))
    hid = jnp.sin(freq2.astype(f32) * (hid @ w2.astype(f32) + b2.astype(f32)))
    h = (hid @ w3.astype(f32)).reshape(L, 2, HY_WIDTH)
    h = h * jnp.exp(-t[:, :, None] * jnp.abs(decay.astype(f32)))
    h_fwd, h_bwd = h[:, 0], h[1:, 1]
    l1 = jnp.sum(jnp.abs(h_fwd), axis=0) + jnp.sum(jnp.abs(h_bwd), axis=0)
    filt = jnp.concatenate([h_fwd, jnp.zeros((1, HY_WIDTH), f32), h_bwd[::-1]], axis=0)
    return filt / l1


def long_conv(u, filt):
    L = u.shape[1]
    u_f = jnp.fft.rfft(u.astype(jnp.float32), n=2 * L, axis=1)
    f_f = jnp.fft.rfft(filt, n=2 * L, axis=0)
    y = jnp.fft.irfft(u_f * f_f[None], n=2 * L, axis=1)[:, :L]
    return y.astype(u.dtype)


def hyena_mixer(u, lp):
    L = u.shape[1]
    x0, x1, v = jnp.split(short_conv(u, lp['hy_conv_w'], lp['hy_conv_b']), 3, axis=-1)
    filt = hyena_filter(L, lp['hy_f_w1'], lp['hy_f_b1'], lp['hy_f_freq1'], lp['hy_f_w2'],
                        lp['hy_f_b2'], lp['hy_f_freq2'], lp['hy_f_w3'], lp['hy_decay'])
    zv = v * x1
    return x0 * (long_conv(zv, filt) + zv * lp['hy_bias'])


def mla_query(c_q, q_norm_g, w_uq, cos, sin):
    b_, L, _ = c_q.shape
    q = (rmsnorm(c_q, q_norm_g) @ w_uq).reshape(b_, L, MLA_HEADS, QK_DIM)
    if cos is None:
        return q
    q_pe = apply_axial_rope(q[..., QK_NOPE:], cos[None, :, None, :], sin[None, :, None, :])
    return jnp.concatenate([q[..., :QK_NOPE], q_pe], axis=-1)


def mla_kv(c_kv, kv_norm_g, w_ukv, cos, sin):
    b_, L, _ = c_kv.shape
    kv = (rmsnorm(c_kv[..., :KV_LORA], kv_norm_g) @ w_ukv).reshape(b_, L, MLA_HEADS, QK_NOPE + V_HEAD)
    k_nope, v = kv[..., :QK_NOPE], kv[..., QK_NOPE:]
    k_pe = c_kv[..., KV_LORA:]
    if cos is not None:
        k_pe = apply_axial_rope(k_pe, cos[None], sin[None])
    k_pe = jnp.broadcast_to(k_pe[:, :, None, :], (b_, L, MLA_HEADS, QK_ROPE))
    return jnp.concatenate([k_nope, k_pe], axis=-1), v


def attend(q, k, v):
    s = jnp.einsum('bqhd,bkhd->bhqk', q, k).astype(jnp.float32) * MLA_SCALE
    p = jax.nn.softmax(s, axis=-1).astype(v.dtype)
    return jnp.einsum('bhqk,bkhd->bqhd', p, v)


def blocked_attend(q, k, v):
    b_, L, H, dk = q.shape
    qb = q.reshape(b_, L // Q_BLOCK, Q_BLOCK, H, dk).transpose(1, 0, 2, 3, 4)
    ob = lax.map(lambda qi: attend(qi, k, v), qb)
    return ob.transpose(1, 0, 2, 3, 4).reshape(b_, L, H, V_HEAD)


def token_mix(proj, k_ctx, v_ctx, lp, cos, sin):
    b_, L, _ = proj.shape
    ga, gb, gc = jnp.split(jax.nn.sigmoid(proj[..., OFF_GATE:]), N_BRANCH, axis=-1)
    a = pool_mixer(proj[..., OFF_POOL:OFF_HY], lp['pool_w'], lp['pool_scale']) @ lp['pool_out']
    b = hyena_mixer(proj[..., OFF_HY:OFF_Q], lp) @ lp['hy_out']
    q = mla_query(proj[..., OFF_Q:OFF_KV], lp['q_norm_g'], lp['w_uq'], cos, sin)
    if cos is None:
        o = attend(q, k_ctx, v_ctx)
    else:
        k_lat, v_lat = mla_kv(proj[..., OFF_KV:OFF_GATE], lp['kv_norm_g'], lp['w_ukv'], cos, sin)
        o = blocked_attend(q, jnp.concatenate([k_ctx, k_lat], axis=1), jnp.concatenate([v_ctx, v_lat], axis=1))
    cm = o.reshape(b_, L, MLA_HEADS * V_HEAD) @ lp['w_o']
    return (ga * a + gb * b + gc * cm) @ lp['w_out']


def sq_relu_mlp(x, w1, w2):
    return jnp.square(jax.nn.relu(x @ w1)) @ w2


def setup_inputs(seed: int = 0) -> dict:
    key = jax.random.key(seed)
    ks = iter(jax.random.split(key, 40))
    f32 = jnp.float32

    def nrm(shape, s):
        return jax.random.normal(next(ks), shape, f32) * s

    def gain(shape):
        return 1.0 + nrm(shape, 0.02)

    L_ = DEPTH
    return {
        'x': nrm((BATCH, SEQ, D_MODEL), 1.0),
        'c': nrm((BATCH, D_MODEL), 1.0),
        'ctx': nrm((BATCH, CTX_LEN, D_MODEL), 1.0),
        'c_ctx': nrm((D_MODEL,), 1.0),
        'w_mod': nrm((L_, D_MODEL, N_MOD * D_MODEL), 0.5 * D_MODEL ** -0.5),
        'b_mod': nrm((L_, N_MOD * D_MODEL), 0.02),
        'norm1_g': gain((L_, D_MODEL)),
        'norm2_g': gain((L_, D_MODEL)),
        'w_in': nrm((L_, D_MODEL, D_IN), D_MODEL ** -0.5),
        'pool_w': nrm((L_, len(POOL_WINDOWS), POOL_GROUP, POOL_GROUP), POOL_GROUP ** -0.5),
        'pool_scale': 1.0 + nrm((L_, POOL_WIDTH), 0.1),
        'pool_out': nrm((L_, POOL_WIDTH, D_MODEL), POOL_WIDTH ** -0.5),
        'hy_conv_w': nrm((L_, 3, 3 * HY_WIDTH), 3 ** -0.5),
        'hy_conv_b': nrm((L_, 3 * HY_WIDTH), 0.02),
        'hy_f_w1': nrm((L_, HY_EMB, HY_FILTER_HIDDEN), HY_EMB ** -0.5),
        'hy_f_b1': nrm((L_, HY_FILTER_HIDDEN), 0.1),
        'hy_f_freq1': 1.0 + nrm((L_, HY_FILTER_HIDDEN), 0.1),
        'hy_f_w2': nrm((L_, HY_FILTER_HIDDEN, HY_FILTER_HIDDEN), HY_FILTER_HIDDEN ** -0.5),
        'hy_f_b2': nrm((L_, HY_FILTER_HIDDEN), 0.1),
        'hy_f_freq2': 1.0 + nrm((L_, HY_FILTER_HIDDEN), 0.1),
        'hy_f_w3': nrm((L_, HY_FILTER_HIDDEN, 2 * HY_WIDTH), HY_FILTER_HIDDEN ** -0.5),
        'hy_decay': jax.random.uniform(next(ks), (L_, 2, HY_WIDTH), f32, 3.0, 15.0),
        'hy_bias': nrm((L_, HY_WIDTH), 0.5),
        'hy_out': nrm((L_, HY_WIDTH, D_MODEL), HY_WIDTH ** -0.5),
        'q_norm_g': gain((L_, Q_LORA)),
        'w_uq': nrm((L_, Q_LORA, MLA_HEADS * QK_DIM), Q_LORA ** -0.5),
        'kv_norm_g': gain((L_, KV_LORA)),
        'w_ukv': nrm((L_, KV_LORA, MLA_HEADS * (QK_NOPE + V_HEAD)), KV_LORA ** -0.5),
        'w_o': nrm((L_, MLA_HEADS * V_HEAD, D_MODEL), (MLA_HEADS * V_HEAD) ** -0.5),
        'w_out': nrm((L_, D_MODEL, D_MODEL), D_MODEL ** -0.5),
        'w_ff1': nrm((L_, D_MODEL, D_FF), D_MODEL ** -0.5),
        'w_ff2': nrm((L_, D_FF, D_MODEL), D_FF ** -0.5),
        'final_g': gain((D_MODEL,)),
    }


def reference(x, c, ctx, c_ctx, w_mod, b_mod, norm1_g, norm2_g, w_in, pool_w, pool_scale, pool_out,
              hy_conv_w, hy_conv_b, hy_f_w1, hy_f_b1, hy_f_freq1, hy_f_w2, hy_f_b2, hy_f_freq2, hy_f_w3,
              hy_decay, hy_bias, hy_out, q_norm_g, w_uq, kv_norm_g, w_ukv, w_o, w_out, w_ff1, w_ff2,
              final_g):
    ROWS = x.shape[1] // GRID_W
    cos, sin = axial_rope_tables(ROWS)
    s_lat = jax.nn.silu(c)
    s_ctx = jax.nn.silu(c_ctx)
    h, hc = x, ctx
    for l in range(DEPTH):
        lp = {
            'pool_w': pool_w[l], 'pool_scale': pool_scale[l], 'pool_out': pool_out[l],
            'hy_conv_w': hy_conv_w[l], 'hy_conv_b': hy_conv_b[l],
            'hy_f_w1': hy_f_w1[l], 'hy_f_b1': hy_f_b1[l], 'hy_f_freq1': hy_f_freq1[l],
            'hy_f_w2': hy_f_w2[l], 'hy_f_b2': hy_f_b2[l], 'hy_f_freq2': hy_f_freq2[l],
            'hy_f_w3': hy_f_w3[l], 'hy_decay': hy_decay[l], 'hy_bias': hy_bias[l], 'hy_out': hy_out[l],
            'q_norm_g': q_norm_g[l], 'w_uq': w_uq[l], 'kv_norm_g': kv_norm_g[l], 'w_ukv': w_ukv[l],
            'w_o': w_o[l], 'w_out': w_out[l],
        }
        last = l == DEPTH - 1
        sh1, sc1, g1, sh2, sc2, g2 = jnp.split((s_lat @ w_mod[l] + b_mod[l])[:, None, :], N_MOD, axis=-1)
        mod_c = s_ctx @ w_mod[l] + b_mod[l]
        sh1c, sc1c = mod_c[:D_MODEL], mod_c[D_MODEL:2 * D_MODEL]
        xn = rmsnorm(h, norm1_g[l]) * (1 + sc1) + sh1
        xnc = rmsnorm(hc, norm1_g[l]) * (1 + sc1c) + sh1c
        if last:
            proj_c = None
            ckv_c = xnc @ w_in[l][:, OFF_KV:OFF_GATE]
        else:
            proj_c = xnc @ w_in[l]
            ckv_c = proj_c[..., OFF_KV:OFF_GATE]
        k_c, v_c = mla_kv(ckv_c, kv_norm_g[l], w_ukv[l], None, None)
        h = h + g1 * token_mix(xn @ w_in[l], k_c, v_c, lp, cos, sin)
        h = h + g2 * sq_relu_mlp(rmsnorm(h, norm2_g[l]) * (1 + sc2) + sh2, w_ff1[l], w_ff2[l])
        if not last:
            g1c, sh2c, sc2c, g2c = jnp.split(mod_c[2 * D_MODEL:], 4)
            hc = hc + g1c * token_mix(proj_c, k_c, v_c, lp, None, None)
            hc = hc + g2c * sq_relu_mlp(rmsnorm(hc, norm2_g[l]) * (1 + sc2c) + sh2c, w_ff1[l], w_ff2[l])
    return rmsnorm(h, final_g)
```

```cpp
#include <hip/hip_runtime.h>
#include <hip/hip_cooperative_groups.h>
#include <cstdio>
namespace cg = cooperative_groups;

typedef unsigned short u16;
using bf16x8 = __attribute__((ext_vector_type(8))) short;
using f32x4 = __attribute__((ext_vector_type(4))) float;
using f32x16 = __attribute__((ext_vector_type(16))) float;

constexpr int D = 1024, SEQ = 8192, CTX = 256, SP = 8448, MROWS = 16896, NMT = 66;
constexpr int DIN = 5792, DINP = 5888, DFF = 4096;
constexpr int OFF_HY = 512, OFF_Q = 2048, OFF_KV = 2432, OFF_GATE = 2720;
constexpr int NT = 512;
constexpr float EPS = 1e-6f;

constexpr size_t WS_H = 0;
constexpr size_t WS_PROJ = WS_H + (size_t)MROWS * D * 4;
constexpr size_t WS_U = WS_PROJ + (size_t)MROWS * DINP * 2;
constexpr size_t WS_Y = WS_U + (size_t)MROWS * 512 * 2;
constexpr size_t WS_O = WS_Y + (size_t)MROWS * 512 * 2;
constexpr size_t WS_Q = WS_O + (size_t)MROWS * 512 * 2;
constexpr size_t WS_K = WS_Q + (size_t)16 * SP * 96 * 2;
constexpr size_t WS_VT = WS_K + (size_t)16 * SP * 96 * 2;
constexpr size_t WS_ZV = WS_VT + (size_t)16 * 64 * SP * 2;
constexpr size_t WS_HID2 = WS_ZV + (size_t)512 * SP * 8;
constexpr size_t WS_HID2C = WS_HID2 + (size_t)4 * 8192 * 64 * 4;
constexpr size_t WS_MOD = WS_HID2C + (size_t)4 * 256 * 64 * 4;
constexpr size_t WS_ROPE = WS_MOD + (size_t)4 * 3 * 6144 * 4;
constexpr size_t WS_TW = WS_ROPE + (size_t)128 * 8 * 8;
constexpr size_t WS_END = WS_TW + (size_t)16384 * 8;
constexpr size_t WO_IN = 0;
constexpr size_t WO_FF1 = WO_IN + (size_t)DINP * 1024 * 2;
constexpr size_t WO_FF2 = WO_FF1 + (size_t)4096 * 1024 * 2;
constexpr size_t WO_OUT = WO_FF2 + (size_t)4096 * 1024 * 2;
constexpr size_t WO_HY = WO_OUT + (size_t)1024 * 1024 * 2;
constexpr size_t WO_WO = WO_HY + (size_t)1024 * 512 * 2;
constexpr size_t WO_PE = WO_WO + (size_t)1024 * 512 * 2;
constexpr size_t WO_UQ = WO_PE + (size_t)1024 * 512 * 2;
constexpr size_t WO_UKV = WO_UQ + (size_t)768 * 384 * 2;
constexpr size_t WO_END = WO_UKV + (size_t)1024 * 256 * 2;

constexpr int LDS_BYTES = 131072 + 8192;

struct Params {
  const float* in[33];
  float* out;
  char* ws;
  int ph_lo, ph_hi;
};

struct Ctx { const unsigned long long* intab; char* ws; float* out; };
__device__ __forceinline__ const float* pin(const Ctx& c, int i) {
  unsigned long long v = c.intab[i];
  unsigned lo = __builtin_amdgcn_readfirstlane((unsigned)v), hi = __builtin_amdgcn_readfirstlane((unsigned)(v >> 32));
  return (const float*)(((unsigned long long)hi << 32) | lo);
}

__device__ __forceinline__ u16 f2bf(float f) {
  unsigned u = __float_as_uint(f);
  u += 0x7fffu + ((u >> 16) & 1u);
  return (u16)(u >> 16);
}
__device__ __forceinline__ float bf2f(u16 b) { return __uint_as_float(((unsigned)b) << 16); }
__device__ __forceinline__ unsigned pk2(float a, float b) { return (unsigned)f2bf(a) | ((unsigned)f2bf(b) << 16); }
__device__ __forceinline__ float wave_sum(float v) {
#pragma unroll
  for (int o = 1; o < 64; o <<= 1) v += __shfl_xor(v, o);
  return v;
}
__device__ __forceinline__ int grp_of_row(int m) {
  int tile = m >> 8, b = tile / 33, t33 = tile - b * 33;
  return t33 == 0 ? 2 : b;
}
__device__ __forceinline__ float2 cmul(float2 a, float2 b) { return make_float2(a.x * b.x - a.y * b.y, a.x * b.y + a.y * b.x); }

__device__ __forceinline__ int tid_l() { int t = threadIdx.x; asm volatile("" : "+v"(t)); return t; }
#define WAIT_V(n) asm volatile("s_waitcnt vmcnt(%0)" ::"n"(n) : "memory")
#define SCHED() __builtin_amdgcn_sched_barrier(0)

constexpr float QSCALE = 0.10206207261596575f * 1.4426950408889634f;
enum { EM_PROJ = 0, EM_SQRELU = 1, EM_RESID = 2, EM_MIX0 = 3, EM_MIX1 = 4, EM_MIX2 = 5, EM_Q = 6, EM_KV = 7 };
struct Epi {
  int mode;
  char* ws;
  const float* gate;
  __device__ __forceinline__ void proj(int row, int col, f32x4 v) const {
    {
      u16* out = (u16*)(ws + WS_PROJ);
#pragma unroll
      for (int j = 0; j < 4; ++j) out[(size_t)(row + j) * DINP + col] = f2bf(v[j]);
    }
  }
  __device__ __forceinline__ void sqrelu(int row, int col, f32x4 v) const {
    {
      u16* out = (u16*)(ws + WS_PROJ);
#pragma unroll
      for (int j = 0; j < 4; ++j) { float r = fmaxf(v[j], 0.f); out[(size_t)(row + j) * DFF + col] = f2bf(r * r); }
    }
  }
  __device__ __forceinline__ void resid(int row, int col, f32x4 v) const {
    {
      float* h = (float*)(ws + WS_H);
      float g = gate[grp_of_row(row) * 6144 + col];
#pragma unroll
      for (int j = 0; j < 4; ++j) { size_t i = (size_t)(row + j) * D + col; h[i] = h[i] + g * v[j]; }
    }
  }
  __device__ __forceinline__ void mix(int row, int col, f32x4 v) const {
    {
      const int br = mode - EM_MIX0;
      const u16* projb = (const u16*)(ws + WS_PROJ);
      float* mixf = (float*)(ws + WS_Q);
      u16* mixb = (u16*)(ws + WS_ZV);
#pragma unroll
      for (int j = 0; j < 4; ++j) {
        int m = row + j;
        float gv = bf2f(projb[(size_t)m * DINP + OFF_GATE + br * 1024 + col]);
        float sg = 1.f / (1.f + __expf(-gv));
        size_t i = (size_t)m * D + col;
        float val = sg * v[j];
        if (br > 0) val += mixf[i];
        if (br < 2) mixf[i] = val; else mixb[i] = f2bf(val);
      }
    }
  }
  __device__ __forceinline__ void q(int row, int col, f32x4 v) const {
    {
      u16* Q = (u16*)(ws + WS_Q);
      const float2* rope = (const float2*)(ws + WS_ROPE);
      int head = col / 96, d = col - head * 96;
      int b = row / SP, pos0 = row - b * SP;
      bool isrope = (d >= 64) && (pos0 >= CTX);
      int rd = d - 64;
#pragma unroll
      for (int j = 0; j < 4; ++j) {
        float val = v[j];
        float partner = __shfl_xor(val, 8);
        int pos = pos0 + j;
        if (isrope) {
          int t = pos - CTX, idx = (rd < 16) ? (t >> 6) : (t & 63);
          float2 cs = rope[idx * 8 + (rd & 7)];
          float sgn = (rd & 8) ? 1.f : -1.f;
          val = val * cs.x + sgn * partner * cs.y;
        }
        Q[((size_t)(b * 8 + head) * SP + pos) * 96 + d] = f2bf(val * QSCALE);
      }
    }
  }
  __device__ __forceinline__ void kv(int row, int col, f32x4 v) const {
    {
      u16* Kb = (u16*)(ws + WS_K);
      u16* Vt = (u16*)(ws + WS_VT);
      int head = col >> 7, j2 = col & 127;
      int b = row / SP, pos0 = row - b * SP;
      if (j2 < 64) {
#pragma unroll
        for (int j = 0; j < 4; ++j) Kb[((size_t)(b * 8 + head) * SP + pos0 + j) * 96 + j2] = f2bf(v[j]);
      } else {
        uint2 o;
        o.x = pk2(v[0], v[1]);
        o.y = pk2(v[2], v[3]);
        *(uint2*)(Vt + ((size_t)(b * 8 + head) * 64 + (j2 - 64)) * SP + pos0) = o;
      }
    }
  }
};
struct GD { const u16* A; int lda; const u16* Bt; int ldb; int K; int nN; int mode; };

constexpr int G_TILE_B = 256 * 64 * 2, G_STAGE_B = 2 * G_TILE_B;
__device__ __forceinline__ int lds_byte(int r, int c) {
  int st = (r >> 4) * 2 + (c >> 5), ob = (r & 15) * 64 + (c & 31) * 2;
  return st * 1024 + (ob ^ (((ob >> 9) & 1) << 5));
}
__device__ __forceinline__ void stage_rc(int b, int& R, int& C) {
  int st = b >> 10, sb = b & 1023, swz = sb ^ (((sb >> 9) & 1) << 5);
  R = (st / 2) * 16 + swz / 64;
  C = (st % 2) * 32 + (swz % 64) / 2;
}

template <class EpiT>
__device__ __forceinline__ void gemm_tile(const u16* __restrict__ A, int lda, const u16* __restrict__ Bt, int ldb, int K,
                                          int brow, int bcol, char* shm, const EpiT& epi) {
  const int tid = tid_l(), wid = tid >> 6, lane = tid & 63, wr = wid >> 2, wc = wid & 3, fr = lane & 15, fq = lane >> 4;
  const u16* Ab = A + (size_t)brow * lda;
  const u16* Bb = Bt + (size_t)bcol * ldb;
  int sR[4], sC[4];
#pragma unroll
  for (int i = 0; i < 4; ++i) stage_rc(wid * 1024 + i * 8192 + lane * 16, sR[i], sC[i]);
#define SA(b) (shm + (b) * G_STAGE_B)
#define SB(b) (shm + (b) * G_STAGE_B + G_TILE_B)
#define GLDS_STAGE(buf, kt)                                                                                              \
  do {                                                                                                                   \
    _Pragma("unroll") for (int i = 0; i < 4; ++i) {                                                                      \
      __builtin_amdgcn_global_load_lds((const unsigned*)(Ab + (size_t)sR[i] * lda + (kt) * 64 + sC[i]),                  \
                                       (unsigned*)(SA(buf) + wid * 1024 + i * 8192), 16, 0, 0);                          \
      __builtin_amdgcn_global_load_lds((const unsigned*)(Bb + (size_t)sR[i] * ldb + (kt) * 64 + sC[i]),                  \
                                       (unsigned*)(SB(buf) + wid * 1024 + i * 8192), 16, 0, 0);                          \
    }                                                                                                                    \
  } while (0)
  f32x4 acc[8][4];
#pragma unroll
  for (int m = 0; m < 8; ++m)
#pragma unroll
    for (int n = 0; n < 4; ++n) acc[m][n] = (f32x4){0.f, 0.f, 0.f, 0.f};
  const int nt = K / 64;
  GLDS_STAGE(0, 0);
  WAIT_V(0);
  __syncthreads();
  for (int t = 0; t < nt; ++t) {
    const int cur = t & 1;
    if (t + 1 < nt) GLDS_STAGE(cur ^ 1, t + 1);
#pragma unroll
    for (int ks = 0; ks < 2; ++ks) {
      bf16x8 At[8], Bf[4];
#pragma unroll
      for (int m = 0; m < 8; ++m) At[m] = *(const bf16x8*)(SA(cur) + lds_byte(wr * 128 + m * 16 + fr, ks * 32 + fq * 8));
#pragma unroll
      for (int n = 0; n < 4; ++n) Bf[n] = *(const bf16x8*)(SB(cur) + lds_byte(wc * 64 + n * 16 + fr, ks * 32 + fq * 8));
#pragma unroll
      for (int m = 0; m < 8; ++m)
#pragma unroll
        for (int n = 0; n < 4; ++n) acc[m][n] = __builtin_amdgcn_mfma_f32_16x16x32_bf16(At[m], Bf[n], acc[m][n], 0, 0, 0);
      SCHED();
    }
    WAIT_V(0);
    __syncthreads();
  }
#define EPI_LOOP(CALL)                                                                              \
  _Pragma("unroll") for (int m = 0; m < 8; ++m) _Pragma("unroll") for (int n = 0; n < 4; ++n) {      \
    const int row = brow + wr * 128 + m * 16 + fq * 4, col = bcol + wc * 64 + n * 16 + fr;           \
    const f32x4 v = acc[m][n];                                                                        \
    CALL;                                                                                             \
  }
  if (epi.mode == EM_PROJ) { EPI_LOOP(epi.proj(row, col, v)) }
  else if (epi.mode == EM_SQRELU) { EPI_LOOP(epi.sqrelu(row, col, v)) }
  else if (epi.mode == EM_RESID) { EPI_LOOP(epi.resid(row, col, v)) }
  else if (epi.mode <= EM_MIX2) { EPI_LOOP(epi.mix(row, col, v)) }
  else if (epi.mode == EM_Q) { EPI_LOOP(epi.q(row, col, v)) }
  else { EPI_LOOP(epi.kv(row, col, v)) }
#undef EPI_LOOP
#undef SA
#undef SB
#undef GLDS_STAGE
}

__device__ __forceinline__ void tile_map(int t, int nM, int nN, int& pm, int& pn) {
  int nwg = nM * nN, wgid = t;
  {
    int q = nwg / 8, r = nwg % 8, xcd = wgid % 8, off = wgid / 8;
    wgid = (xcd < r ? xcd * (q + 1) : r * (q + 1) + (xcd - r) * q) + off;
  }
  int nig = 8 * nN, gid = wgid / nig, fm = gid * 8, gsz = min(nM - fm, 8);
  pm = fm + ((wgid % nig) % gsz);
  pn = (wgid % nig) / gsz;
}

__device__ __forceinline__ void p0_misc(const Ctx& p) {
  const int gtid = blockIdx.x * NT + tid_l(), gn = gridDim.x * NT;
  float4* h4 = (float4*)(p.ws + WS_H);
  const float4* x4 = (const float4*)pin(p, 0);
  const float4* c4 = (const float4*)pin(p, 2);
  for (int i = gtid; i < MROWS * 256; i += gn) {
    int m = i >> 8, q = i & 255, b = m / SP, pos = m - b * SP;
    float4 v = (pos < CTX) ? c4[(size_t)(b * CTX + pos) * 256 + q] : x4[(size_t)(b * SEQ + pos - CTX) * 256 + q];
    h4[i] = v;
  }
  float2* rope = (float2*)(p.ws + WS_ROPE);
  for (int i = gtid; i < 1024; i += gn) {
    int idx = i >> 3, f = i & 7;
    float inv = powf(10000.f, -(float)f / 8.f);
    float a = (float)idx * inv;
    rope[i] = make_float2(cosf(a), sinf(a));
  }
  float2* tw = (float2*)(p.ws + WS_TW);
  for (int i = gtid; i < 16384; i += gn) {
    float s, c;
    sincospif(-(float)i / 8192.f, &s, &c);
    tw[i] = make_float2(c, s);
  }
}

__device__ __forceinline__ void p0_mod_task(const Ctx& p, int task, char* smem) {
  float* s = (float*)smem;
  float* red = s + 3072;
  const int tid = tid_l();
  const int l = task / 48, chunk = task - l * 48;
  for (int i = tid; i < 3072; i += NT) {
    int g = i >> 10, k = i & 1023;
    float cv = (g < 2) ? pin(p, 1)[g * 1024 + k] : pin(p, 3)[k];
    s[i] = cv / (1.f + __expf(-cv));
  }
  __syncthreads();
  const int kq = tid >> 7, col = tid & 127, n = chunk * 128 + col;
  const float* W = pin(p, 4) + (size_t)l * 1024 * 6144 + n;
  float a0 = 0.f, a1 = 0.f, a2 = 0.f;
#pragma unroll 8
  for (int k = kq * 256; k < kq * 256 + 256; ++k) {
    float w = W[(size_t)k * 6144];
    a0 += s[k] * w; a1 += s[1024 + k] * w; a2 += s[2048 + k] * w;
  }
  red[(kq * 3 + 0) * 128 + col] = a0;
  red[(kq * 3 + 1) * 128 + col] = a1;
  red[(kq * 3 + 2) * 128 + col] = a2;
  __syncthreads();
  if (tid < 384) {
    int g = tid >> 7, c2 = tid & 127, n2 = chunk * 128 + c2;
    float v = red[(0 * 3 + g) * 128 + c2] + red[(1 * 3 + g) * 128 + c2] + red[(2 * 3 + g) * 128 + c2] + red[(3 * 3 + g) * 128 + c2];
    ((float*)(p.ws + WS_MOD))[(size_t)(l * 3 + g) * 6144 + n2] = v + pin(p, 5)[l * 6144 + n2];
  }
  __syncthreads();
}

__device__ __forceinline__ void p0_hid_task(const Ctx& p, int task, char* smem) {
  float* zs = (float*)smem;
  float* h1 = zs + 8 * 36;
  const int tid = tid_l(), tl = tid >> 6, j = tid & 63;
  const int l = task / 1056, r = task - l * 1056;
  const bool isctx = r >= 1024;
  const int L = isctx ? 256 : 8192;
  const int t = (isctx ? (r - 1024) : r) * 8 + tl;
  if (j < 33) {
    float z;
    if (j == 0) z = (float)t / (float)(L - 1);
    else {
      int i = (j - 1) & 15;
      float band = 1e-4f + (float)i * ((15.f - 1e-4f) / 15.f);
      float omega = 6.2831855f * (float)t / (float)L;
      float a = omega * band;
      z = (j <= 16) ? cosf(a) : -sinf(a);
    }
    zs[tl * 36 + j] = z;
  }
  __syncthreads();
  {
    const float* w1 = pin(p, 14) + l * 33 * 64;
    float a = pin(p, 15)[l * 64 + j];
#pragma unroll
    for (int k = 0; k < 33; ++k) a += zs[tl * 36 + k] * w1[k * 64 + j];
    h1[tl * 64 + j] = sinf(pin(p, 16)[l * 64 + j] * a);
  }
  __syncthreads();
  {
    const float* w2 = pin(p, 17) + l * 64 * 64;
    float a = pin(p, 18)[l * 64 + j];
#pragma unroll 8
    for (int k = 0; k < 64; ++k) a += h1[tl * 64 + k] * w2[k * 64 + j];
    float v = sinf(pin(p, 19)[l * 64 + j] * a);
    float* dst = isctx ? (float*)(p.ws + WS_HID2C) + ((size_t)l * 64 + j) * 256 + t : (float*)(p.ws + WS_HID2) + ((size_t)l * 64 + j) * 8192 + t;
    dst[0] = v;
  }
  __syncthreads();
}

__device__ __forceinline__ void wt_task(const float* __restrict__ W, int K, int N, u16* __restrict__ WT, int item, int nblkN, char* smem) {
  float* tile = (float*)smem;
  const int tid = tid_l();
  const int kb = item / nblkN, nb = item - kb * nblkN, k0 = kb * 64, n0 = nb * 64;
#pragma unroll
  for (int r = 0; r < 8; ++r) {
    int kk = r * 8 + (tid >> 6), nn = tid & 63;
    float v = (n0 + nn < N) ? W[(size_t)(k0 + kk) * N + n0 + nn] : 0.f;
    tile[kk * 65 + nn] = v;
  }
  __syncthreads();
  {
    int n = tid >> 3, kc = (tid & 7) * 8;
    uint4 o;
    o.x = pk2(tile[(kc + 0) * 65 + n], tile[(kc + 1) * 65 + n]);
    o.y = pk2(tile[(kc + 2) * 65 + n], tile[(kc + 3) * 65 + n]);
    o.z = pk2(tile[(kc + 4) * 65 + n], tile[(kc + 5) * 65 + n]);
    o.w = pk2(tile[(kc + 6) * 65 + n], tile[(kc + 7) * 65 + n]);
    *(uint4*)(WT + (size_t)(n0 + n) * K + k0 + kc) = o;
  }
  __syncthreads();
}

__device__ __forceinline__ void wpe_task(const Ctx& p, int l, int task) {
  const int g = task >> 3, c0 = (task & 7) * 16, tid = threadIdx.x;
  const float* pw = pin(p, 9) + ((size_t)(l * 4 + g) * 128) * 128;
  const float* sc = pin(p, 10) + l * 512 + g * 128;
  const float* po = pin(p, 11) + ((size_t)l * 512 + g * 128) * 1024;
  u16* WpeT = (u16*)((char*)p.out + WO_PE);
  float acc0[16], acc1[16];
#pragma unroll
  for (int i = 0; i < 16; ++i) { acc0[i] = 0.f; acc1[i] = 0.f; }
  for (int d = 0; d < 128; ++d) {
    float s = sc[d];
    float p0 = po[(size_t)d * 1024 + tid] * s, p1 = po[(size_t)d * 1024 + 512 + tid] * s;
#pragma unroll
    for (int i = 0; i < 16; ++i) { float w = pw[(c0 + i) * 128 + d]; acc0[i] += w * p0; acc1[i] += w * p1; }
  }
  uint4 o0, o1;
  o0.x = pk2(acc0[0], acc0[1]); o0.y = pk2(acc0[2], acc0[3]); o0.z = pk2(acc0[4], acc0[5]); o0.w = pk2(acc0[6], acc0[7]);
  o1.x = pk2(acc0[8], acc0[9]); o1.y = pk2(acc0[10], acc0[11]); o1.z = pk2(acc0[12], acc0[13]); o1.w = pk2(acc0[14], acc0[15]);
  uint4* dst = (uint4*)(WpeT + (size_t)tid * 512 + g * 128 + c0);
  dst[0] = o0; dst[1] = o1;
  o0.x = pk2(acc1[0], acc1[1]); o0.y = pk2(acc1[2], acc1[3]); o0.z = pk2(acc1[4], acc1[5]); o0.w = pk2(acc1[6], acc1[7]);
  o1.x = pk2(acc1[8], acc1[9]); o1.y = pk2(acc1[10], acc1[11]); o1.z = pk2(acc1[12], acc1[13]); o1.w = pk2(acc1[14], acc1[15]);
  dst = (uint4*)(WpeT + (size_t)(512 + tid) * 512 + g * 128 + c0);
  dst[0] = o0; dst[1] = o1;
}

__device__ __forceinline__ void norm_rows(const Ctx& p, const float* gain, const float* modl, int sh_idx, int sc_idx, u16* outp) {
  const int tidx = tid_l(), lane = tidx & 63, gw = blockIdx.x * 8 + (tidx >> 6), ngw = gridDim.x * 8;
  const float* h = (const float*)(p.ws + WS_H);
  for (int m = gw; m < MROWS; m += ngw) {
    const float4* hr = (const float4*)(h + (size_t)m * D) + lane;
    float4 v[4];
    float ss = 0.f;
#pragma unroll
    for (int j = 0; j < 4; ++j) { v[j] = hr[64 * j]; ss += v[j].x * v[j].x + v[j].y * v[j].y + v[j].z * v[j].z + v[j].w * v[j].w; }
    ss = wave_sum(ss);
    float r = rsqrtf(ss * (1.f / D) + EPS);
    const float* mg = modl + grp_of_row(m) * 6144;
    uint2* o8 = (uint2*)(outp + (size_t)m * D) + lane;
#pragma unroll
    for (int j = 0; j < 4; ++j) {
      int n = lane * 4 + 256 * j;
      float4 g = *(const float4*)(gain + n), sc = *(const float4*)(mg + sc_idx * 1024 + n), sh = *(const float4*)(mg + sh_idx * 1024 + n);
      uint2 o;
      o.x = pk2(v[j].x * r * g.x * (1.f + sc.x) + sh.x, v[j].y * r * g.y * (1.f + sc.y) + sh.y);
      o.y = pk2(v[j].z * r * g.z * (1.f + sc.z) + sh.z, v[j].w * r * g.w * (1.f + sc.w) + sh.w);
      o8[64 * j] = o;
    }
  }
}

__device__ __forceinline__ void final_norm(const Ctx& p) {
  const int tidx = tid_l(), lane = tidx & 63, gw = blockIdx.x * 8 + (tidx >> 6), ngw = gridDim.x * 8;
  const float* h = (const float*)(p.ws + WS_H);
  const float* gain = pin(p, 32);
  for (int r0 = gw; r0 < 2 * SEQ; r0 += ngw) {
    int b = r0 >> 13, t = r0 & 8191, m = b * SP + CTX + t;
    const float4* hr = (const float4*)(h + (size_t)m * D) + lane;
    float4 v[4];
    float ss = 0.f;
#pragma unroll
    for (int j = 0; j < 4; ++j) { v[j] = hr[64 * j]; ss += v[j].x * v[j].x + v[j].y * v[j].y + v[j].z * v[j].z + v[j].w * v[j].w; }
    ss = wave_sum(ss);
    float r = rsqrtf(ss * (1.f / D) + EPS);
    float4* o = (float4*)(p.out + (size_t)r0 * D) + lane;
#pragma unroll
    for (int j = 0; j < 4; ++j) {
      float4 g = *(const float4*)(gain + lane * 4 + 256 * j);
      o[64 * j] = make_float4(v[j].x * r * g.x, v[j].y * r * g.y, v[j].z * r * g.z, v[j].w * r * g.w);
    }
  }
}

__device__ __forceinline__ void premix_task(const Ctx& p, int l, int task, char* smem) {
  const int tid = tid_l(), lane = tid & 63, wid = tid >> 6;
  const int tile64 = task >> 2, part = task & 3;
  const int m0 = tile64 * 64, b = m0 / SP, pos0 = m0 - b * SP;
  const bool isctx = pos0 < CTX;
  const int s0 = isctx ? 0 : CTX, L = isctx ? CTX : SEQ, t0 = pos0 - s0;
  const size_t mb = (size_t)b * SP + s0;
  const u16* proj = (const u16*)(p.ws + WS_PROJ);
  if (part == 0) {
    u16* P = (u16*)smem;
    for (int i = tid; i < 80 * 64; i += NT) {
      int r = i >> 6, ch = i & 63, t = t0 - 8 + r;
      uint4 v = make_uint4(0, 0, 0, 0);
      if (t >= 0 && t < L) v = *(const uint4*)(proj + (mb + t) * DINP + ch * 8);
      *(uint4*)(P + r * 512 + ch * 8) = v;
    }
    __syncthreads();
    const int c = tid, g = c >> 7, hw = 1 << g;
    u16* U = (u16*)(p.ws + WS_U);
    for (int tt = 0; tt < 64; ++tt) {
      int t = t0 + tt, lo = max(t - hw, 0), hi = min(t + hw, L);
      float s = 0.f;
      for (int q = lo; q < hi; ++q) s += bf2f(P[(q - t0 + 8) * 512 + c]);
      float u = s / (float)(hi - lo) - bf2f(P[(tt + 8) * 512 + c]);
      U[(mb + t) * 512 + c] = f2bf(u);
    }
    __syncthreads();
  } else if (part <= 2) {
    const int ch0 = (part - 1) * 256;
    constexpr int PITCH = 260;
    u16* X = (u16*)smem;
    for (int i = tid; i < 3 * 66 * 32; i += NT) {
      int pr = i / (66 * 32), rem = i - pr * 66 * 32, r = rem >> 5, ch = rem & 31, t = t0 - 1 + r;
      uint4 v = make_uint4(0, 0, 0, 0);
      if (t >= 0 && t < L) v = *(const uint4*)(proj + (mb + t) * DINP + OFF_HY + pr * 512 + ch0 + ch * 8);
      uint2* d = (uint2*)(X + (pr * 66 + r) * PITCH + ch * 8);
      d[0] = make_uint2(v.x, v.y);
      d[1] = make_uint2(v.z, v.w);
    }
    __syncthreads();
    const float* cw = pin(p, 12) + l * 3 * 1536;
    const float* cb = pin(p, 13) + l * 1536;
    {
      const int c = tid & 255, th = tid >> 8, col = ch0 + c;
      float w0 = cw[col], w1 = cw[1536 + col], w2 = cw[3072 + col], bb = cb[col];
      u16* Y = (u16*)(p.ws + WS_Y);
      for (int tt = th * 32; tt < th * 32 + 32; ++tt) {
        float v = w0 * bf2f(X[(tt)*PITCH + c]) + w1 * bf2f(X[(tt + 1) * PITCH + c]) + w2 * bf2f(X[(tt + 2) * PITCH + c]) + bb;
        Y[(mb + t0 + tt) * 512 + col] = f2bf(v);
      }
    }
    {
      const int tt = lane;
      float* ZV = (float*)(p.ws + WS_ZV);
      for (int cc = 0; cc < 32; ++cc) {
        int c = wid * 32 + cc, col = ch0 + c;
        float a0 = cw[512 + col], a1 = cw[1536 + 512 + col], a2 = cw[3072 + 512 + col], ab = cb[512 + col];
        float v0 = cw[1024 + col], v1 = cw[1536 + 1024 + col], v2 = cw[3072 + 1024 + col], vb = cb[1024 + col];
        const u16* X1 = X + 66 * PITCH, *XV = X + 2 * 66 * PITCH;
        float x1 = a0 * bf2f(X1[tt * PITCH + c]) + a1 * bf2f(X1[(tt + 1) * PITCH + c]) + a2 * bf2f(X1[(tt + 2) * PITCH + c]) + ab;
        float vv = v0 * bf2f(XV[tt * PITCH + c]) + v1 * bf2f(XV[(tt + 1) * PITCH + c]) + v2 * bf2f(XV[(tt + 2) * PITCH + c]) + vb;
        ZV[((size_t)col * SP + pos0 + tt) * 2 + b] = x1 * vv;
      }
    }
    __syncthreads();
  } else {
    u16* projw = (u16*)(p.ws + WS_PROJ);
    const float* qg = pin(p, 24) + l * 384;
    const float* kg = pin(p, 26) + l * 256;
    const float2* rope = (const float2*)(p.ws + WS_ROPE);
    u16* Kb = (u16*)(p.ws + WS_K);
    for (int rr = 0; rr < 8; ++rr) {
      int tt = wid * 8 + rr, pos = pos0 + tt;
      u16* row = projw + ((size_t)b * SP + pos) * DINP;
      {
        unsigned* q32 = (unsigned*)(row + OFF_Q);
        unsigned v[3];
        float ss = 0.f;
#pragma unroll
        for (int j = 0; j < 3; ++j) { v[j] = q32[lane + 64 * j]; float a = bf2f(v[j] & 0xffff), c2 = bf2f(v[j] >> 16); ss += a * a + c2 * c2; }
        ss = wave_sum(ss);
        float r = rsqrtf(ss * (1.f / 384.f) + EPS);
#pragma unroll
        for (int j = 0; j < 3; ++j) {
          int n = (lane + 64 * j) * 2;
          q32[lane + 64 * j] = pk2(bf2f(v[j] & 0xffff) * r * qg[n], bf2f(v[j] >> 16) * r * qg[n + 1]);
        }
      }
      {
        unsigned* k32 = (unsigned*)(row + OFF_KV);
        unsigned v[2];
        float ss = 0.f;
#pragma unroll
        for (int j = 0; j < 2; ++j) { v[j] = k32[lane + 64 * j]; float a = bf2f(v[j] & 0xffff), c2 = bf2f(v[j] >> 16); ss += a * a + c2 * c2; }
        ss = wave_sum(ss);
        float r = rsqrtf(ss * (1.f / 256.f) + EPS);
#pragma unroll
        for (int j = 0; j < 2; ++j) {
          int n = (lane + 64 * j) * 2;
          k32[lane + 64 * j] = pk2(bf2f(v[j] & 0xffff) * r * kg[n], bf2f(v[j] >> 16) * r * kg[n + 1]);
        }
      }
      {
        int rd = lane & 31;
        float val = bf2f(row[OFF_KV + 256 + rd]);
        float partner = __shfl_xor(val, 8);
        if (!isctx) {
          int t = pos - CTX, idx = (rd < 16) ? (t >> 6) : (t & 63);
          float2 cs = rope[idx * 8 + (rd & 7)];
          float sgn = (rd & 8) ? 1.f : -1.f;
          val = val * cs.x + sgn * partner * cs.y;
        }
        if (lane < 32) {
          u16 o = f2bf(val);
#pragma unroll
          for (int hd = 0; hd < 8; ++hd) Kb[((size_t)(b * 8 + hd) * SP + pos) * 96 + 64 + rd] = o;
        }
      }
    }
  }
}

__device__ __forceinline__ void fft_dif(float2* X, const float2* __restrict__ tw) {
  const int tid = tid_l();
  for (int lq = 12; lq >= 0; lq -= 2) {
    const int q = 1 << lq, sh = 12 - lq;
#pragma unroll 1
    for (int b8 = 0; b8 < 8; ++b8) {
      int u = b8 * NT + tid, j = u & (q - 1), base = ((u >> lq) << (lq + 2)) + j;
      float2 w1 = tw[j << sh], w2 = cmul(w1, w1), w3 = cmul(w2, w1);
      float2 a0 = X[base], a1 = X[base + q], a2 = X[base + 2 * q], a3 = X[base + 3 * q];
      float2 s02 = make_float2(a0.x + a2.x, a0.y + a2.y), d02 = make_float2(a0.x - a2.x, a0.y - a2.y);
      float2 s13 = make_float2(a1.x + a3.x, a1.y + a3.y), d13 = make_float2(a1.x - a3.x, a1.y - a3.y);
      X[base] = make_float2(s02.x + s13.x, s02.y + s13.y);
      X[base + q] = cmul(make_float2(d02.x + d13.y, d02.y - d13.x), w1);
      X[base + 2 * q] = cmul(make_float2(s02.x - s13.x, s02.y - s13.y), w2);
      X[base + 3 * q] = cmul(make_float2(d02.x - d13.y, d02.y + d13.x), w3);
    }
    __syncthreads();
  }
}
__device__ __forceinline__ void fft_dit_inv(float2* X, const float2* __restrict__ tw) {
  const int tid = tid_l();
  for (int lq = 0; lq <= 12; lq += 2) {
    const int q = 1 << lq, sh = 12 - lq;
#pragma unroll 1
    for (int b8 = 0; b8 < 8; ++b8) {
      int u = b8 * NT + tid, j = u & (q - 1), base = ((u >> lq) << (lq + 2)) + j;
      float2 w1 = tw[j << sh];
      w1.y = -w1.y;
      float2 w2 = cmul(w1, w1), w3 = cmul(w2, w1);
      float2 b0 = X[base], c1 = cmul(X[base + q], w1), c2 = cmul(X[base + 2 * q], w2), c3 = cmul(X[base + 3 * q], w3);
      float2 s02 = make_float2(b0.x + c2.x, b0.y + c2.y), d02 = make_float2(b0.x - c2.x, b0.y - c2.y);
      float2 s13 = make_float2(c1.x + c3.x, c1.y + c3.y), d13 = make_float2(c1.x - c3.x, c1.y - c3.y);
      X[base] = make_float2(s02.x + s13.x, s02.y + s13.y);
      X[base + q] = make_float2(d02.x - d13.y, d02.y + d13.x);
      X[base + 2 * q] = make_float2(s02.x - s13.x, s02.y - s13.y);
      X[base + 3 * q] = make_float2(d02.x + d13.y, d02.y - d13.x);
    }
    __syncthreads();
  }
}
__device__ __forceinline__ float block_sum(float v, float* red) {
  v = wave_sum(v);
  __syncthreads();
  if ((threadIdx.x & 63) == 0) red[threadIdx.x >> 6] = v;
  __syncthreads();
  float s = red[0] + red[1] + red[2] + red[3] + red[4] + red[5] + red[6] + red[7];
  __syncthreads();
  return s;
}

__device__ __forceinline__ void fft_task(const Ctx& p, int l, int c, char* smem) {
  float2* X = (float2*)smem;
  float* aux = (float*)(smem + 131072);
  float* red = aux + 128;
  const int tid = tid_l();
  const float2* tw = (const float2*)(p.ws + WS_TW);
  const float* w3 = pin(p, 20) + (size_t)l * 64 * 1024;
  if (tid < 64) { aux[tid] = w3[tid * 1024 + c]; aux[64 + tid] = w3[tid * 1024 + 512 + c]; }
  __syncthreads();
  const float dF = fabsf(pin(p, 21)[(l * 2 + 0) * 512 + c]), dB = fabsf(pin(p, 21)[(l * 2 + 1) * 512 + c]);
  const float bias = pin(p, 22)[l * 512 + c];
  float2* zp = (float2*)(p.ws + WS_ZV) + (size_t)c * SP;
  float l1 = 0.f;
  {
    const float* hid = (const float*)(p.ws + WS_HID2) + (size_t)l * 64 * 8192 + tid;
    float af[16], ab[16];
#pragma unroll
    for (int i = 0; i < 16; ++i) { af[i] = 0.f; ab[i] = 0.f; }
#pragma unroll 2
    for (int k = 0; k < 64; ++k) {
      const float wf = aux[k], wb = aux[64 + k];
#pragma unroll
      for (int i = 0; i < 16; ++i) { float v = hid[(size_t)k * 8192 + i * NT]; af[i] += v * wf; ab[i] += v * wb; }
    }
#pragma unroll
    for (int i = 0; i < 16; ++i) {
      int t = i * NT + tid;
      float tl = (float)t * (1.f / 8191.f);
      float hf = af[i] * expf(-tl * dF);
      float hb = ab[i] * expf(-tl * dB);
      X[t] = make_float2(hf, 0.f);
      if (t >= 1) { X[16384 - t] = make_float2(hb, 0.f); l1 += fabsf(hf) + fabsf(hb); }
      else { X[8192] = make_float2(0.f, 0.f); l1 += fabsf(hf); }
    }
  }
  float l1tot = block_sum(l1, red);
  fft_dif(X, tw);
  float2 F[32];
  {
    float s = 1.f / (l1tot * 16384.f);
#pragma unroll
    for (int i = 0; i < 32; ++i) { float2 v = X[i * NT + tid]; F[i] = make_float2(v.x * s, v.y * s); }
  }
  __syncthreads();
#pragma unroll 2
  for (int i = 0; i < 16; ++i) {
    int t = i * NT + tid;
    X[t] = zp[CTX + t];
    X[8192 + t] = make_float2(0.f, 0.f);
  }
  __syncthreads();
  fft_dif(X, tw);
#pragma unroll
  for (int i = 0; i < 32; ++i) { int idx = i * NT + tid; X[idx] = cmul(X[idx], F[i]); }
  __syncthreads();
  fft_dit_inv(X, tw);
#pragma unroll 2
  for (int i = 0; i < 16; ++i) {
    int t = i * NT + tid;
    float2 z = zp[CTX + t], y = X[t];
    zp[CTX + t] = make_float2(y.x + bias * z.x, y.y + bias * z.y);
  }
  __syncthreads();
  {
    float* hFc = (float*)smem;
    float* hBc = hFc + 256;
    float2* zc = (float2*)(hBc + 256);
    float l1c = 0.f;
    if (tid < 256) {
      int t = tid;
      const float* hc = (const float*)(p.ws + WS_HID2C) + (size_t)l * 64 * 256 + t;
      float hf = 0.f, hb = 0.f;
#pragma unroll 8
      for (int k = 0; k < 64; ++k) { float v = hc[k * 256]; hf += v * aux[k]; hb += v * aux[64 + k]; }
      float tl = (float)t * (1.f / 255.f);
      hf *= expf(-tl * dF);
      hb *= expf(-tl * dB);
      hFc[t] = hf;
      hBc[t] = hb;
      l1c = fabsf(hf) + (t >= 1 ? fabsf(hb) : 0.f);
      zc[t] = zp[t];
    }
    float l1ct = block_sum(l1c, red);
    const int bb = tid >> 8, t = tid & 255;
    float acc = 0.f;
    for (int s = 0; s < 256; ++s) {
      float kf = (s <= t) ? hFc[t - s] : hBc[s - t];
      float2 z = zc[s];
      acc += kf * (bb ? z.y : z.x);
    }
    float2 z = zc[t];
    ((float*)zp)[t * 2 + bb] = acc / l1ct + bias * (bb ? z.y : z.x);
    __syncthreads();
  }
}

constexpr int AT_KP = 208, AT_VP = 136, AT_STAGE = 64 * AT_KP + 64 * AT_VP;
__device__ __forceinline__ void attn_task(const Ctx& p, int bh, int qb, char* smem) {
  const int tid = tid_l(), wid = tid >> 6, lane = tid & 63, r = lane & 31, hh = lane >> 5;
  const u16* Qp = (const u16*)(p.ws + WS_Q) + ((size_t)bh * SP + qb * 256) * 96;
  const u16* Kp = (const u16*)(p.ws + WS_K) + (size_t)bh * SP * 96;
  const u16* Vp = (const u16*)(p.ws + WS_VT) + (size_t)bh * 64 * SP;
  const int nkt = (qb == 0) ? 4 : 132;
  bf16x8 qf[6];
#pragma unroll
  for (int ks = 0; ks < 6; ++ks) qf[ks] = *(const bf16x8*)(Qp + (size_t)(wid * 32 + r) * 96 + ks * 16 + hh * 8);
  f32x16 o0, o1;
#pragma unroll
  for (int i = 0; i < 16; ++i) { o0[i] = 0.f; o1[i] = 0.f; }
  float mrun = -1e30f, lrun = 0.f;
  const u16* src[3];
  int dst[3], kstep[3];
#pragma unroll
  for (int i = 0; i < 3; ++i) {
    int ch = tid + i * NT;
    if (ch < 768) { int row = ch / 12, cc = ch - row * 12; src[i] = Kp + (size_t)row * 96 + cc * 8; dst[i] = row * AT_KP + cc * 16; kstep[i] = 64 * 96; }
    else { int v = ch - 768, row = (v >> 3) & 63, cc = v & 7; src[i] = Vp + (size_t)row * SP + cc * 8; dst[i] = 64 * AT_KP + row * AT_VP + cc * 16; kstep[i] = 64; }
  }
  const bool has3 = tid < 256;
  uint4 st[3];
#define AT_LOAD(t)                                                                                   \
  do {                                                                                               \
    st[0] = *(const uint4*)(src[0] + (size_t)(t) * kstep[0]);                                        \
    st[1] = *(const uint4*)(src[1] + (size_t)(t) * kstep[1]);                                        \
    if (has3) st[2] = *(const uint4*)(src[2] + (size_t)(t) * kstep[2]);                              \
  } while (0)
#define AT_WRITE1(i, base)                                                                           \
  do {                                                                                               \
    uint2* d_ = (uint2*)((base) + dst[i]);                                                           \
    d_[0] = make_uint2(st[i].x, st[i].y);                                                            \
    d_[1] = make_uint2(st[i].z, st[i].w);                                                            \
  } while (0)
#define AT_WRITE(buf)                                                                                \
  do {                                                                                               \
    char* base_ = smem + (buf) * AT_STAGE;                                                           \
    AT_WRITE1(0, base_); AT_WRITE1(1, base_);                                                        \
    if (has3) AT_WRITE1(2, base_);                                                                   \
  } while (0)
  AT_LOAD(0);
  AT_WRITE(0);
  __syncthreads();
  for (int t = 0; t < nkt; ++t) {
    const int cur = t & 1;
    if (t + 1 < nkt) AT_LOAD(t + 1);
    const char* Ks = smem + cur * AT_STAGE;
    const char* Vs = Ks + 64 * AT_KP;
    f32x16 s0, s1;
#pragma unroll
    for (int i = 0; i < 16; ++i) { s0[i] = 0.f; s1[i] = 0.f; }
#pragma unroll
    for (int ks = 0; ks < 6; ++ks) {
      bf16x8 a0 = *(const bf16x8*)(Ks + r * AT_KP + ks * 32 + hh * 16);
      bf16x8 a1 = *(const bf16x8*)(Ks + (32 + r) * AT_KP + ks * 32 + hh * 16);
      s0 = __builtin_amdgcn_mfma_f32_32x32x16_bf16(a0, qf[ks], s0, 0, 0, 0);
      s1 = __builtin_amdgcn_mfma_f32_32x32x16_bf16(a1, qf[ks], s1, 0, 0, 0);
    }
    float mx = s0[0];
#pragma unroll
    for (int i = 1; i < 16; ++i) mx = fmaxf(mx, s0[i]);
#pragma unroll
    for (int i = 0; i < 16; ++i) mx = fmaxf(mx, s1[i]);
    mx = fmaxf(mx, __shfl_xor(mx, 32));
    const float mnew = fmaxf(mrun, mx);
    const float alpha = __builtin_amdgcn_exp2f(mrun - mnew);
    mrun = mnew;
    float ps = 0.f;
#pragma unroll
    for (int i = 0; i < 16; ++i) { s0[i] = __builtin_amdgcn_exp2f(s0[i] - mnew); ps += s0[i]; }
#pragma unroll
    for (int i = 0; i < 16; ++i) { s1[i] = __builtin_amdgcn_exp2f(s1[i] - mnew); ps += s1[i]; }
    lrun = lrun * alpha + ps;
#pragma unroll
    for (int i = 0; i < 16; ++i) { o0[i] *= alpha; o1[i] *= alpha; }
#pragma unroll
    for (int kb = 0; kb < 2; ++kb) {
#pragma unroll
      for (int sI = 0; sI < 2; ++sI) {
        bf16x8 pf;
#pragma unroll
        for (int j = 0; j < 8; ++j) pf[j] = (short)f2bf(kb == 0 ? s0[8 * sI + j] : s1[8 * sI + j]);
        const int koff = (kb * 32 + 16 * sI + 4 * hh) * 2;
        union { bf16x8 v; uint2 h2[2]; } va, vb;
        va.h2[0] = *(const uint2*)(Vs + r * AT_VP + koff);
        va.h2[1] = *(const uint2*)(Vs + r * AT_VP + koff + 16);
        vb.h2[0] = *(const uint2*)(Vs + (32 + r) * AT_VP + koff);
        vb.h2[1] = *(const uint2*)(Vs + (32 + r) * AT_VP + koff + 16);
        o0 = __builtin_amdgcn_mfma_f32_32x32x16_bf16(va.v, pf, o0, 0, 0, 0);
        o1 = __builtin_amdgcn_mfma_f32_32x32x16_bf16(vb.v, pf, o1, 0, 0, 0);
      }
    }
    if (t + 1 < nkt) AT_WRITE(cur ^ 1);
    __syncthreads();
  }
  const float ltot = lrun + __shfl_xor(lrun, 32);
  const float inv = 1.f / ltot;
  const int b = bh >> 3, head = bh & 7;
  u16* Op = (u16*)(p.ws + WS_O) + ((size_t)b * SP + qb * 256 + wid * 32 + r) * 512 + head * 64;
#pragma unroll
  for (int g = 0; g < 4; ++g) {
    uint2 w0, w1;
    w0.x = pk2(o0[4 * g] * inv, o0[4 * g + 1] * inv);
    w0.y = pk2(o0[4 * g + 2] * inv, o0[4 * g + 3] * inv);
    w1.x = pk2(o1[4 * g] * inv, o1[4 * g + 1] * inv);
    w1.y = pk2(o1[4 * g + 2] * inv, o1[4 * g + 3] * inv);
    *(uint2*)(Op + 8 * g + 4 * hh) = w0;
    *(uint2*)(Op + 32 + 8 * g + 4 * hh) = w1;
  }
#undef AT_LOAD
#undef AT_WRITE
#undef AT_WRITE1
}

__device__ __forceinline__ void hypost_task(const Ctx& p, int task, char* smem) {
  const int tid = tid_l(), lane = tid & 63, wid = tid >> 6;
  const int tile64 = task >> 1, ch0 = (task & 1) * 256;
  const int m0 = tile64 * 64, b = m0 / SP, pos0 = m0 - b * SP;
  float* T = (float*)smem;
  const float* ZV = (const float*)(p.ws + WS_ZV);
  for (int cc = 0; cc < 32; ++cc) {
    int c = wid * 32 + cc;
    T[c * 65 + lane] = ZV[((size_t)(ch0 + c) * SP + pos0 + lane) * 2 + b];
  }
  __syncthreads();
  u16* Y = (u16*)(p.ws + WS_Y);
  const int c = tid & 255, th = tid >> 8;
  for (int tt = th * 32; tt < th * 32 + 32; ++tt) {
    size_t i = (size_t)(m0 + tt) * 512 + ch0 + c;
    Y[i] = f2bf(bf2f(Y[i]) * T[c * 65 + tt]);
  }
  __syncthreads();
}

#ifndef PHMASK
#define PHMASK 0xFFFF
#endif
#define PHON(k) (((PHMASK) >> (k)) & 1)
constexpr int NPH = 1 + 4 * 10 + 1;
__global__ void __launch_bounds__(NT, 2) mega(Params prm) {
  __shared__ __attribute__((aligned(1024))) char smem[LDS_BYTES];
  cg::grid_group grid = cg::this_grid();
  const int bid = blockIdx.x, nb = gridDim.x;
  {
    unsigned long long* it = (unsigned long long*)(smem + 131072 + 6144);
    if (threadIdx.x < 33) it[threadIdx.x] = (unsigned long long)prm.in[threadIdx.x];
    __syncthreads();
  }
  for (int ph = prm.ph_lo; ph < prm.ph_hi; ++ph) {
    Ctx p;
    p.intab = (const unsigned long long*)(smem + 131072 + 6144);
    p.ws = prm.ws;
    p.out = prm.out;
    asm volatile("" : "+s"(p.ws), "+s"(p.out));
    float* modall = (float*)(p.ws + WS_MOD);
    u16* proj = (u16*)(p.ws + WS_PROJ);
    u16* xn = (u16*)(p.ws + WS_U);
    char* wo = (char*)p.out;
    if (ph == 0) {
      if (PHON(10)) {
      p0_misc(p);
      for (int t = bid; t < 192; t += nb) p0_mod_task(p, t, smem);
      for (int t = bid; t < 4224; t += nb) p0_hid_task(p, t, smem);
      }
    } else if (ph == NPH - 1) {
      if (PHON(11)) final_norm(p);
    } else {
      const int l = (ph - 1) / 10, sp = (ph - 1) % 10;
      const float* modl = modall + (size_t)l * 3 * 6144;
      GD* tab = (GD*)(smem + 131072 + 4096);
      int ng = 0, nN0 = 0, nN1 = 0;
      bool seq = false;
      const float* gate = modl;
      if (sp == 0 && PHON(0)) {
        for (int t = bid; t < 4168; t += nb) {
          int r = t;
          if (r < 1472) { wt_task(pin(p, 8) + (size_t)l * 1024 * DIN, 1024, DIN, (u16*)(wo + WO_IN), r, 92, smem); continue; } r -= 1472;
          if (r < 1024) { wt_task(pin(p, 30) + (size_t)l * 1024 * 4096, 1024, 4096, (u16*)(wo + WO_FF1), r, 64, smem); continue; } r -= 1024;
          if (r < 1024) { wt_task(pin(p, 31) + (size_t)l * 4096 * 1024, 4096, 1024, (u16*)(wo + WO_FF2), r, 16, smem); continue; } r -= 1024;
          if (r < 256) { wt_task(pin(p, 29) + (size_t)l * 1024 * 1024, 1024, 1024, (u16*)(wo + WO_OUT), r, 16, smem); continue; } r -= 256;
          if (r < 128) { wt_task(pin(p, 23) + (size_t)l * 512 * 1024, 512, 1024, (u16*)(wo + WO_HY), r, 16, smem); continue; } r -= 128;
          if (r < 128) { wt_task(pin(p, 28) + (size_t)l * 512 * 1024, 512, 1024, (u16*)(wo + WO_WO), r, 16, smem); continue; } r -= 128;
          if (r < 72) { wt_task(pin(p, 25) + (size_t)l * 384 * 768, 384, 768, (u16*)(wo + WO_UQ), r, 12, smem); continue; } r -= 72;
          wt_task(pin(p, 27) + (size_t)l * 256 * 1024, 256, 1024, (u16*)(wo + WO_UKV), r, 16, smem);
        }
        for (int t = bid; t < 32; t += nb) wpe_task(p, l, t);
        norm_rows(p, pin(p, 6) + l * 1024, modl, 0, 1, xn);
      } else if (sp == 1 && PHON(1)) {
        if (threadIdx.x == 0) tab[0] = GD{xn, 1024, (const u16*)(wo + WO_IN), 1024, 1024, 23, EM_PROJ};
        ng = 1; nN0 = 23;
      } else if (sp == 2 && PHON(2)) {
        for (int t = bid; t < 264 * 4; t += nb) premix_task(p, l, t, smem);
      } else if (sp == 3 && PHON(3)) {
        for (int t = bid; t < 512; t += nb) fft_task(p, l, t, smem);
        if (threadIdx.x == 0) {
          tab[0] = GD{proj + OFF_Q, DINP, (const u16*)(wo + WO_UQ), 384, 384, 3, EM_Q};
          tab[1] = GD{proj + OFF_KV, DINP, (const u16*)(wo + WO_UKV), 256, 256, 4, EM_KV};
        }
        ng = 2; nN0 = 3; nN1 = 4;
      } else if (sp == 4 && PHON(4)) {
        for (int t = bid; t < 528; t += nb) {
          int bh, qb;
          if (t < 512) { int rnd = t >> 8, w = t & 255; bh = (w & 7) + 8 * rnd; qb = 1 + (w >> 3); }
          else { bh = t - 512; qb = 0; }
          attn_task(p, bh, qb, smem);
        }
        for (int t = bid; t < 528; t += nb) hypost_task(p, t, smem);
      } else if (sp == 5 && PHON(5)) {
        if (threadIdx.x == 0) {
          tab[0] = GD{(const u16*)(p.ws + WS_U), 512, (const u16*)(wo + WO_PE), 512, 512, 4, EM_MIX0};
          tab[1] = GD{(const u16*)(p.ws + WS_Y), 512, (const u16*)(wo + WO_HY), 512, 512, 4, EM_MIX1};
          tab[2] = GD{(const u16*)(p.ws + WS_O), 512, (const u16*)(wo + WO_WO), 512, 512, 4, EM_MIX2};
        }
        ng = 3; seq = true; nN0 = 4;
      } else if (sp == 6 && PHON(6)) {
        if (threadIdx.x == 0) tab[0] = GD{(const u16*)(p.ws + WS_ZV), 1024, (const u16*)(wo + WO_OUT), 1024, 1024, 4, EM_RESID};
        ng = 1; nN0 = 4;
        gate = modl + 2 * 1024;
      } else if (sp == 7 && PHON(7)) {
        norm_rows(p, pin(p, 7) + l * 1024, modl, 3, 4, xn);
      } else if (sp == 8 && PHON(8)) {
        if (threadIdx.x == 0) tab[0] = GD{xn, 1024, (const u16*)(wo + WO_FF1), 1024, 1024, 16, EM_SQRELU};
        ng = 1; nN0 = 16;
      } else if (sp == 9 && PHON(9)) {
        if (threadIdx.x == 0) tab[0] = GD{proj, DFF, (const u16*)(wo + WO_FF2), 4096, 4096, 4, EM_RESID};
        ng = 1; nN0 = 4;
        gate = modl + 5 * 1024;
      }
      if (ng > 0) {
        __syncthreads();
        const int nt0 = NMT * nN0, ntot = seq ? nt0 : nt0 + NMT * nN1;
        const int nseq = seq ? ng : 1;
        const int nitems = ((ntot - bid + nb - 1) / nb) * nseq;
#pragma unroll 1
        for (int it = 0; it < nitems; ++it) {
          int t = bid + (it / nseq) * nb, gi = it % nseq, tt = t;
          if (!seq && t >= nt0) { gi = 1; tt = t - nt0; }
          const volatile GD* gp = tab + gi;
          unsigned long long a64 = (unsigned long long)gp->A, b64 = (unsigned long long)gp->Bt;
          a64 = ((unsigned long long)(unsigned)__builtin_amdgcn_readfirstlane((unsigned)(a64 >> 32)) << 32) | (unsigned long long)(unsigned)__builtin_amdgcn_readfirstlane((unsigned)a64);
          b64 = ((unsigned long long)(unsigned)__builtin_amdgcn_readfirstlane((unsigned)(b64 >> 32)) << 32) | (unsigned long long)(unsigned)__builtin_amdgcn_readfirstlane((unsigned)b64);
          const int lda = __builtin_amdgcn_readfirstlane(gp->lda), ldb = __builtin_amdgcn_readfirstlane(gp->ldb);
          const int K = __builtin_amdgcn_readfirstlane(gp->K), nN = __builtin_amdgcn_readfirstlane(gp->nN);
          const int mode = __builtin_amdgcn_readfirstlane(gp->mode);
          int pm, pn;
          tile_map(tt, NMT, nN, pm, pn);
          Epi e{mode, p.ws, gate};
          gemm_tile((const u16*)a64, lda, (const u16*)b64, ldb, K, pm * 256, pn * 256, smem, e);
        }
      }
    }
    if (ph + 1 < prm.ph_hi) grid.sync();
  }
}

extern "C" void kernel_launch(void* const* d_in, const int* in_sizes, int n_in, void* d_out, int out_size, void* d_ws,
                              size_t ws_size, hipStream_t stream) {
  static int grid_blocks = 0;
  if (grid_blocks == 0) {
    if (n_in != 33 || ws_size < WS_END || (size_t)out_size * 4 < WO_END) {
      fprintf(stderr, "kernel_launch: unexpected sizes n_in=%d ws=%zu (need %zu) out=%d\n", n_in, ws_size, (size_t)WS_END, out_size);
      grid_blocks = -1;
      return;
    }
    int dev = 0, cus = 0, per_cu = 0;
    hipGetDevice(&dev);
    hipDeviceGetAttribute(&cus, hipDeviceAttributeMultiprocessorCount, dev);
    hipOccupancyMaxActiveBlocksPerMultiprocessor(&per_cu, mega, NT, 0);
    if (per_cu < 1) per_cu = 1;
    if (per_cu > 1) per_cu = 1;
    grid_blocks = cus * per_cu;
  }
  if (grid_blocks < 0) return;
  Params p{};
  for (int i = 0; i < 33; ++i) p.in[i] = (const float*)d_in[i];
  p.out = (float*)d_out;
  p.ws = (char*)d_ws;
  p.ph_lo = 0;
  p.ph_hi = NPH;
  void* args[] = {&p};
  hipError_t e = hipLaunchCooperativeKernel((void*)mega, dim3(grid_blocks), dim3(NT), args, 0, stream);
  if (e != hipSuccess) fprintf(stderr, "cooperative launch failed: %s (grid %d)\n", hipGetErrorString(e), grid_blocks);
}
```

```cpp
#include <hip/hip_runtime.h>
#include <hip/hip_cooperative_groups.h>
#include <cstdio>
namespace cg = cooperative_groups;

typedef unsigned short u16;
using bf16x8 = __attribute__((ext_vector_type(8))) short;
using f32x4 = __attribute__((ext_vector_type(4))) float;
using f32x16 = __attribute__((ext_vector_type(16))) float;

constexpr int D = 1024, SEQ = 8192, CTX = 256, SP = 8448, MROWS = 16896, NMT = 66;
constexpr int DIN = 5792, DINP = 5888, DFF = 4096;
constexpr int OFF_HY = 512, OFF_Q = 2048, OFF_KV = 2432, OFF_GATE = 2720;
constexpr int NT = 512;
constexpr float EPS = 1e-6f;

constexpr size_t WS_H = 0;
constexpr size_t WS_PROJ = WS_H + (size_t)MROWS * D * 4;
constexpr size_t WS_U = WS_PROJ + (size_t)MROWS * DINP * 2;
constexpr size_t WS_Y = WS_U + (size_t)MROWS * 512 * 2;
constexpr size_t WS_O = WS_Y + (size_t)MROWS * 512 * 2;
constexpr size_t WS_Q = WS_O + (size_t)MROWS * 512 * 2;
constexpr size_t WS_K = WS_Q + (size_t)16 * SP * 96 * 2;
constexpr size_t WS_VT = WS_K + (size_t)16 * SP * 96 * 2;
constexpr size_t WS_ZV = WS_VT + (size_t)16 * 64 * SP * 2;
constexpr size_t WS_HID2 = WS_ZV + (size_t)512 * SP * 8;
constexpr size_t WS_HID2C = WS_HID2 + (size_t)4 * 8192 * 64 * 4;
constexpr size_t WS_MOD = WS_HID2C + (size_t)4 * 256 * 64 * 4;
constexpr size_t WS_ROPE = WS_MOD + (size_t)4 * 3 * 6144 * 4;
constexpr size_t WS_TW = WS_ROPE + (size_t)128 * 8 * 8;
constexpr size_t WS_BAR = WS_TW + (size_t)16384 * 8;
constexpr size_t WS_END = WS_BAR + 1024;
constexpr size_t WO_IN = 0;
constexpr size_t WO_FF1 = WO_IN + (size_t)DINP * 1024 * 2;
constexpr size_t WO_FF2 = WO_FF1 + (size_t)4096 * 1024 * 2;
constexpr size_t WO_OUT = WO_FF2 + (size_t)4096 * 1024 * 2;
constexpr size_t WO_HY = WO_OUT + (size_t)1024 * 1024 * 2;
constexpr size_t WO_WO = WO_HY + (size_t)1024 * 512 * 2;
constexpr size_t WO_PE = WO_WO + (size_t)1024 * 512 * 2;
constexpr size_t WO_UQ = WO_PE + (size_t)1024 * 512 * 2;
constexpr size_t WO_UKV = WO_UQ + (size_t)768 * 384 * 2;
constexpr size_t WO_END = WO_UKV + (size_t)1024 * 256 * 2;

constexpr int LDS_BYTES = 131072 + 8192;

struct Params {
  const float* in[33];
  float* out;
  char* ws;
  int ph_lo, ph_hi;
};

struct Ctx { const unsigned long long* intab; char* ws; float* out; };
__device__ __forceinline__ const float* pin(const Ctx& c, int i) {
  unsigned long long v = c.intab[i];
  unsigned lo = __builtin_amdgcn_readfirstlane((unsigned)v), hi = __builtin_amdgcn_readfirstlane((unsigned)(v >> 32));
  return (const float*)(((unsigned long long)hi << 32) | lo);
}

typedef __bf16 hwbf2 __attribute__((ext_vector_type(2)));
typedef float hwf2 __attribute__((ext_vector_type(2)));
__device__ __forceinline__ unsigned pk2(float a, float b) {
  hwf2 v = {a, b};
  hwbf2 r = __builtin_convertvector(v, hwbf2);
  return __builtin_bit_cast(unsigned, r);
}
__device__ __forceinline__ u16 f2bf(float f) { return (u16)(pk2(f, 0.f) & 0xffffu); }
__device__ __forceinline__ float bf2f(u16 b) { return __uint_as_float(((unsigned)b) << 16); }
__device__ __forceinline__ float wave_sum(float v) {
#pragma unroll
  for (int o = 1; o < 64; o <<= 1) v += __shfl_xor(v, o);
  return v;
}
__device__ __forceinline__ int grp_of_row(int m) {
  int tile = m >> 8, b = tile / 33, t33 = tile - b * 33;
  return t33 == 0 ? 2 : b;
}
__device__ __forceinline__ float2 cmul(float2 a, float2 b) { return make_float2(a.x * b.x - a.y * b.y, a.x * b.y + a.y * b.x); }

__device__ __forceinline__ int tid_l() { int t = threadIdx.x; asm volatile("" : "+v"(t)); return t; }
__device__ __forceinline__ void grid_barrier(unsigned* bar, unsigned target) {
  asm volatile("s_waitcnt vmcnt(0)" ::: "memory");
  __syncthreads();
  if (threadIdx.x == 0) {
    __builtin_amdgcn_fence(__ATOMIC_RELEASE, "agent");
    asm volatile("s_waitcnt vmcnt(0)" ::: "memory");
    __hip_atomic_fetch_add(bar, 1u, __ATOMIC_RELAXED, __HIP_MEMORY_SCOPE_AGENT);
    while (__hip_atomic_load(bar, __ATOMIC_RELAXED, __HIP_MEMORY_SCOPE_AGENT) < target) __builtin_amdgcn_s_sleep(2);
    __builtin_amdgcn_fence(__ATOMIC_ACQUIRE, "agent");
    asm volatile("s_waitcnt vmcnt(0)" ::: "memory");
  }
  __syncthreads();
}
#define WAIT_V(n) asm volatile("s_waitcnt vmcnt(%0)" ::"n"(n) : "memory")
#define SCHED() __builtin_amdgcn_sched_barrier(0)

constexpr float QSCALE = 0.10206207261596575f * 1.4426950408889634f;
enum { EM_PROJ = 0, EM_SQRELU = 1, EM_RESID = 2, EM_MIX0 = 3, EM_MIX1 = 4, EM_MIX2 = 5, EM_Q = 6, EM_KV = 7 };
struct Epi {
  int mode;
  char* ws;
  const float* gate;
  __device__ __forceinline__ void proj(int row, int col, f32x4 v) const {
    {
      u16* out = (u16*)(ws + WS_PROJ);
#pragma unroll
      for (int j = 0; j < 4; ++j) out[(size_t)(row + j) * DINP + col] = f2bf(v[j]);
    }
  }
  __device__ __forceinline__ void sqrelu(int row, int col, f32x4 v) const {
    {
      u16* out = (u16*)(ws + WS_PROJ);
#pragma unroll
      for (int j = 0; j < 4; ++j) { float r = fmaxf(v[j], 0.f); out[(size_t)(row + j) * DFF + col] = f2bf(r * r); }
    }
  }
  __device__ __forceinline__ void resid(int row, int col, f32x4 v) const {
    {
      float* h = (float*)(ws + WS_H);
      float g = gate[grp_of_row(row) * 6144 + col];
#pragma unroll
      for (int j = 0; j < 4; ++j) unsafeAtomicAdd(h + (size_t)(row + j) * D + col, g * v[j]);
    }
  }
  __device__ __forceinline__ void mix(int row, int col, f32x4 v) const {
    {
      const int br = mode - EM_MIX0;
      const u16* projb = (const u16*)(ws + WS_PROJ);
      float* mixf = (float*)(ws + WS_Q);
      u16* mixb = (u16*)(ws + WS_ZV);
#pragma unroll
      for (int j = 0; j < 4; ++j) {
        int m = row + j;
        float gv = bf2f(projb[(size_t)m * DINP + OFF_GATE + br * 1024 + col]);
        float sg = 1.f / (1.f + __expf(-gv));
        size_t i = (size_t)m * D + col;
        float val = sg * v[j];
        if (br > 0) val += mixf[i];
        if (br < 2) mixf[i] = val; else mixb[i] = f2bf(val);
      }
    }
  }
  __device__ __forceinline__ void q(int row, int col, f32x4 v) const {
    {
      u16* Q = (u16*)(ws + WS_Q);
      const float2* rope = (const float2*)(ws + WS_ROPE);
      int head = col / 96, d = col - head * 96;
      int b = row / SP, pos0 = row - b * SP;
      bool isrope = (d >= 64) && (pos0 >= CTX);
      int rd = d - 64;
#pragma unroll
      for (int j = 0; j < 4; ++j) {
        float val = v[j];
        float partner = __shfl_xor(val, 8);
        int pos = pos0 + j;
        if (isrope) {
          int t = pos - CTX, idx = (rd < 16) ? (t >> 6) : (t & 63);
          float2 cs = rope[idx * 8 + (rd & 7)];
          float sgn = (rd & 8) ? 1.f : -1.f;
          val = val * cs.x + sgn * partner * cs.y;
        }
        Q[((size_t)(b * 8 + head) * SP + pos) * 96 + d] = f2bf(val * QSCALE);
      }
    }
  }
  __device__ __forceinline__ void kv(int row, int col, f32x4 v) const {
    {
      u16* Kb = (u16*)(ws + WS_K);
      u16* Vt = (u16*)(ws + WS_VT);
      int head = col >> 7, j2 = col & 127;
      int b = row / SP, pos0 = row - b * SP;
      if (j2 < 64) {
#pragma unroll
        for (int j = 0; j < 4; ++j) Kb[((size_t)(b * 8 + head) * SP + pos0 + j) * 96 + j2] = f2bf(v[j]);
      } else {
        uint2 o;
        o.x = pk2(v[0], v[1]);
        o.y = pk2(v[2], v[3]);
        *(uint2*)(Vt + ((size_t)(b * 8 + head) * 64 + (j2 - 64)) * SP + pos0) = o;
      }
    }
  }
};
struct GD { const u16* A; int lda; const u16* Bt; int ldb; int K; int nN; int mode; int ks; };

constexpr int G_TILE_B = 256 * 64 * 2, G_STAGE_B = 2 * G_TILE_B;
__device__ __forceinline__ int lds_byte(int r, int c) {
  int st = (r >> 4) * 2 + (c >> 5), ob = (r & 15) * 64 + (c & 31) * 2;
  return st * 1024 + (ob ^ (((ob >> 9) & 1) << 5));
}
__device__ __forceinline__ void stage_rc(int b, int& R, int& C) {
  int st = b >> 10, sb = b & 1023, swz = sb ^ (((sb >> 9) & 1) << 5);
  R = (st / 2) * 16 + swz / 64;
  C = (st % 2) * 32 + (swz % 64) / 2;
}

template <int MI>
__device__ __forceinline__ void gemm_core(const u16* __restrict__ A, int lda, const u16* __restrict__ Bt, int ldb, int K,
                                          int brow, int bcol, char* shm, f32x4 (&acc)[MI][4]) {
  constexpr int TILE_A = MI * 32 * 64 * 2, TILE_BB = 256 * 64 * 2, STAGE = TILE_A + TILE_BB;
  const int tid = tid_l(), wid = tid >> 6, lane = tid & 63, wr = wid >> 2, wc = wid & 3, fr = lane & 15, fq = lane >> 4;
  const u16* Ab = A + (size_t)brow * lda;
  const u16* Bb = Bt + (size_t)bcol * ldb;
  int sR[4], sC[4];
#pragma unroll
  for (int i = 0; i < 4; ++i) stage_rc(wid * 1024 + i * 8192 + lane * 16, sR[i], sC[i]);
#define SA(b) (shm + (b) * STAGE)
#define SB(b) (shm + (b) * STAGE + TILE_A)
#define GLDS_STAGE(buf, kt)                                                                                              \
  do {                                                                                                                   \
    _Pragma("unroll") for (int i = 0; i < 4; ++i) {                                                                      \
      if (i < MI / 2)                                                                                                    \
        __builtin_amdgcn_global_load_lds((const unsigned*)(Ab + (size_t)sR[i] * lda + (kt) * 64 + sC[i]),                \
                                         (unsigned*)(SA(buf) + wid * 1024 + i * 8192), 16, 0, 0);                        \
      __builtin_amdgcn_global_load_lds((const unsigned*)(Bb + (size_t)sR[i] * ldb + (kt) * 64 + sC[i]),                  \
                                       (unsigned*)(SB(buf) + wid * 1024 + i * 8192), 16, 0, 0);                          \
    }                                                                                                                    \
  } while (0)
  const int nt = K / 64;
  GLDS_STAGE(0, 0);
  WAIT_V(0);
  __syncthreads();
  for (int t = 0; t < nt; ++t) {
    const int cur = t & 1;
    if (t + 1 < nt) GLDS_STAGE(cur ^ 1, t + 1);
#pragma unroll
    for (int ks = 0; ks < 2; ++ks) {
      bf16x8 At[MI], Bf[4];
#pragma unroll
      for (int m = 0; m < MI; ++m) At[m] = *(const bf16x8*)(SA(cur) + lds_byte(wr * (MI * 16) + m * 16 + fr, ks * 32 + fq * 8));
#pragma unroll
      for (int n = 0; n < 4; ++n) Bf[n] = *(const bf16x8*)(SB(cur) + lds_byte(wc * 64 + n * 16 + fr, ks * 32 + fq * 8));
#pragma unroll
      for (int m = 0; m < MI; ++m)
#pragma unroll
        for (int n = 0; n < 4; ++n) acc[m][n] = __builtin_amdgcn_mfma_f32_16x16x32_bf16(At[m], Bf[n], acc[m][n], 0, 0, 0);
      SCHED();
    }
    WAIT_V(0);
    __syncthreads();
  }
#undef SA
#undef SB
#undef GLDS_STAGE
}

template <class EpiT>
__device__ __forceinline__ void gemm_tile(const u16* __restrict__ A, int lda, const u16* __restrict__ Bt, int ldb, int K,
                                          int brow, int bcol, char* shm, const EpiT& epi) {
  const int tid = tid_l(), wid = tid >> 6, lane = tid & 63, wr = wid >> 2, wc = wid & 3, fr = lane & 15, fq = lane >> 4;
  f32x4 acc[8][4];
#pragma unroll
  for (int m = 0; m < 8; ++m)
#pragma unroll
    for (int n = 0; n < 4; ++n) acc[m][n] = (f32x4){0.f, 0.f, 0.f, 0.f};
  gemm_core<8>(A, lda, Bt, ldb, K, brow, bcol, shm, acc);
#define EPI_LOOP(CALL)                                                                              \
  _Pragma("unroll") for (int m = 0; m < 8; ++m) _Pragma("unroll") for (int n = 0; n < 4; ++n) {      \
    const int row = brow + wr * 128 + m * 16 + fq * 4, col = bcol + wc * 64 + n * 16 + fr;           \
    const f32x4 v = acc[m][n];                                                                        \
    CALL;                                                                                             \
  }
  if (epi.mode == EM_PROJ) { EPI_LOOP(epi.proj(row, col, v)) }
  else if (epi.mode == EM_SQRELU) { EPI_LOOP(epi.sqrelu(row, col, v)) }
  else if (epi.mode == EM_RESID) { EPI_LOOP(epi.resid(row, col, v)) }
  else if (epi.mode == EM_Q) { EPI_LOOP(epi.q(row, col, v)) }
  else { EPI_LOOP(epi.kv(row, col, v)) }
#undef EPI_LOOP
}

__device__ __forceinline__ void mix_tile(const Ctx& p, int pm, int pn, char* shm) {
  const int tid = tid_l(), wid = tid >> 6, lane = tid & 63, wr = wid >> 2, wc = wid & 3, fr = lane & 15, fq = lane >> 4;
  const int brow = pm * 128, bcol = pn * 256;
  const u16* projb = (const u16*)(p.ws + WS_PROJ);
  char* wo = (char*)p.out;
  f32x4 tot[4][4];
#pragma unroll
  for (int m = 0; m < 4; ++m)
#pragma unroll
    for (int n = 0; n < 4; ++n) tot[m][n] = (f32x4){0.f, 0.f, 0.f, 0.f};
#pragma unroll 1
  for (int br = 0; br < 3; ++br) {
    const u16* A = (const u16*)(p.ws + (br == 0 ? WS_U : br == 1 ? WS_Y : WS_O));
    const u16* Bt = (const u16*)(wo + (br == 0 ? WO_PE : br == 1 ? WO_HY : WO_WO));
    f32x4 acc[4][4];
#pragma unroll
    for (int m = 0; m < 4; ++m)
#pragma unroll
      for (int n = 0; n < 4; ++n) acc[m][n] = (f32x4){0.f, 0.f, 0.f, 0.f};
    gemm_core<4>(A, 512, Bt, 512, 512, brow, bcol, shm, acc);
    u16 gt[4][4][4];
#pragma unroll
    for (int m = 0; m < 4; ++m)
#pragma unroll
      for (int n = 0; n < 4; ++n)
#pragma unroll
        for (int j = 0; j < 4; ++j)
          gt[m][n][j] = projb[(size_t)(brow + wr * 64 + m * 16 + fq * 4 + j) * DINP + OFF_GATE + br * 1024 + bcol + wc * 64 + n * 16 + fr];
#pragma unroll
    for (int m = 0; m < 4; ++m)
#pragma unroll
      for (int n = 0; n < 4; ++n)
#pragma unroll
        for (int j = 0; j < 4; ++j) tot[m][n][j] += acc[m][n][j] / (1.f + __expf(-bf2f(gt[m][n][j])));
  }
  u16* mixb = (u16*)(p.ws + WS_ZV);
#pragma unroll
  for (int m = 0; m < 4; ++m)
#pragma unroll
    for (int n = 0; n < 4; ++n)
#pragma unroll
      for (int j = 0; j < 4; ++j)
        mixb[(size_t)(brow + wr * 64 + m * 16 + fq * 4 + j) * D + bcol + wc * 64 + n * 16 + fr] = f2bf(tot[m][n][j]);
}

__device__ __forceinline__ void tile_map(int t, int nM, int nN, int& pm, int& pn) {
  int nwg = nM * nN, wgid = t;
  {
    int q = nwg / 8, r = nwg % 8, xcd = wgid % 8, off = wgid / 8;
    wgid = (xcd < r ? xcd * (q + 1) : r * (q + 1) + (xcd - r) * q) + off;
  }
  int nig = 8 * nN, gid = wgid / nig, fm = gid * 8, gsz = min(nM - fm, 8);
  pm = fm + ((wgid % nig) % gsz);
  pn = (wgid % nig) / gsz;
}

__device__ __forceinline__ void p0_misc(const Ctx& p) {
  const int gtid = blockIdx.x * NT + tid_l(), gn = gridDim.x * NT;
  float4* h4 = (float4*)(p.ws + WS_H);
  const float4* x4 = (const float4*)pin(p, 0);
  const float4* c4 = (const float4*)pin(p, 2);
  for (int i = gtid; i < MROWS * 256; i += gn) {
    int m = i >> 8, q = i & 255, b = m / SP, pos = m - b * SP;
    float4 v = (pos < CTX) ? c4[(size_t)(b * CTX + pos) * 256 + q] : x4[(size_t)(b * SEQ + pos - CTX) * 256 + q];
    h4[i] = v;
  }
  float2* rope = (float2*)(p.ws + WS_ROPE);
  for (int i = gtid; i < 1024; i += gn) {
    int idx = i >> 3, f = i & 7;
    float inv = powf(10000.f, -(float)f / 8.f);
    float a = (float)idx * inv;
    rope[i] = make_float2(cosf(a), sinf(a));
  }
  float2* tw = (float2*)(p.ws + WS_TW);
  for (int i = gtid; i < 16384; i += gn) {
    float s, c;
    sincospif(-(float)i / 8192.f, &s, &c);
    tw[i] = make_float2(c, s);
  }
}

__device__ __forceinline__ void p0_mod_task(const Ctx& p, int task, char* smem) {
  float* s = (float*)smem;
  float* red = s + 3072;
  const int tid = tid_l();
  const int l = task / 48, chunk = task - l * 48;
  for (int i = tid; i < 3072; i += NT) {
    int g = i >> 10, k = i & 1023;
    float cv = (g < 2) ? pin(p, 1)[g * 1024 + k] : pin(p, 3)[k];
    s[i] = cv / (1.f + __expf(-cv));
  }
  __syncthreads();
  const int kq = tid >> 7, col = tid & 127, n = chunk * 128 + col;
  const float* W = pin(p, 4) + (size_t)l * 1024 * 6144 + n;
  float a0 = 0.f, a1 = 0.f, a2 = 0.f;
#pragma unroll 8
  for (int k = kq * 256; k < kq * 256 + 256; ++k) {
    float w = W[(size_t)k * 6144];
    a0 += s[k] * w; a1 += s[1024 + k] * w; a2 += s[2048 + k] * w;
  }
  red[(kq * 3 + 0) * 128 + col] = a0;
  red[(kq * 3 + 1) * 128 + col] = a1;
  red[(kq * 3 + 2) * 128 + col] = a2;
  __syncthreads();
  if (tid < 384) {
    int g = tid >> 7, c2 = tid & 127, n2 = chunk * 128 + c2;
    float v = red[(0 * 3 + g) * 128 + c2] + red[(1 * 3 + g) * 128 + c2] + red[(2 * 3 + g) * 128 + c2] + red[(3 * 3 + g) * 128 + c2];
    ((float*)(p.ws + WS_MOD))[(size_t)(l * 3 + g) * 6144 + n2] = v + pin(p, 5)[l * 6144 + n2];
  }
  __syncthreads();
}

__device__ __forceinline__ void p0_hid_task(const Ctx& p, int task, char* smem) {
  float* zs = (float*)smem;
  float* h1 = zs + 8 * 36;
  float* w1s = h1 + 8 * 64;
  float* w2s = w1s + 33 * 64;
  const int tid = tid_l(), tl = tid >> 6, j = tid & 63;
  const int l = task / 132, r = task - l * 132;
  const bool isctx = r >= 128;
  const int L = isctx ? 256 : 8192;
  const int tbase = (isctx ? (r - 128) : r) * 64;
  for (int i = tid; i < 33 * 64; i += NT) w1s[i] = pin(p, 14)[l * 33 * 64 + i];
  for (int i = tid; i < 64 * 64; i += NT) w2s[i] = pin(p, 17)[l * 64 * 64 + i];
  const float b1 = pin(p, 15)[l * 64 + j], f1 = pin(p, 16)[l * 64 + j], b2 = pin(p, 18)[l * 64 + j], f2 = pin(p, 19)[l * 64 + j];
  __syncthreads();
  for (int sub = 0; sub < 8; ++sub) {
    const int t = tbase + sub * 8 + tl;
    if (j < 33) {
      float z;
      if (j == 0) z = (float)t / (float)(L - 1);
      else {
        int i = (j - 1) & 15;
        float band = 1e-4f + (float)i * ((15.f - 1e-4f) / 15.f);
        float omega = 6.2831855f * (float)t / (float)L;
        float a = omega * band;
        z = (j <= 16) ? cosf(a) : -sinf(a);
      }
      zs[tl * 36 + j] = z;
    }
    __syncthreads();
    {
      float a = b1;
#pragma unroll
      for (int k = 0; k < 33; ++k) a += zs[tl * 36 + k] * w1s[k * 64 + j];
      h1[tl * 64 + j] = sinf(f1 * a);
    }
    __syncthreads();
    {
      float a = b2;
#pragma unroll 16
      for (int k = 0; k < 64; ++k) a += h1[tl * 64 + k] * w2s[k * 64 + j];
      float v = sinf(f2 * a);
      float* dst = isctx ? (float*)(p.ws + WS_HID2C) + ((size_t)l * 64 + j) * 256 + t : (float*)(p.ws + WS_HID2) + ((size_t)l * 64 + j) * 8192 + t;
      dst[0] = v;
    }
  }
  __syncthreads();
}

__device__ __forceinline__ void wt_task(const float* __restrict__ W, int K, int N, u16* __restrict__ WT, int item, int nblkN, char* smem) {
  float* tile = (float*)smem;
  const int tid = tid_l();
  const int kb = item / nblkN, nb = item - kb * nblkN, k0 = kb * 64, n0 = nb * 64;
#pragma unroll
  for (int r = 0; r < 8; ++r) {
    int kk = r * 8 + (tid >> 6), nn = tid & 63;
    float v = (n0 + nn < N) ? W[(size_t)(k0 + kk) * N + n0 + nn] : 0.f;
    tile[kk * 65 + nn] = v;
  }
  __syncthreads();
  {
    int n = tid >> 3, kc = (tid & 7) * 8;
    uint4 o;
    o.x = pk2(tile[(kc + 0) * 65 + n], tile[(kc + 1) * 65 + n]);
    o.y = pk2(tile[(kc + 2) * 65 + n], tile[(kc + 3) * 65 + n]);
    o.z = pk2(tile[(kc + 4) * 65 + n], tile[(kc + 5) * 65 + n]);
    o.w = pk2(tile[(kc + 6) * 65 + n], tile[(kc + 7) * 65 + n]);
    *(uint4*)(WT + (size_t)(n0 + n) * K + k0 + kc) = o;
  }
  __syncthreads();
}

__device__ __forceinline__ void wpe_task(const Ctx& p, int l, int task, char* smem) {
  const int g = task >> 3, c0 = (task & 7) * 16, tid = tid_l();
  const float* pw = pin(p, 9) + ((size_t)(l * 4 + g) * 128) * 128;
  const float* sc = pin(p, 10) + l * 512 + g * 128;
  const float* po = pin(p, 11) + ((size_t)l * 512 + g * 128) * 1024;
  u16* WpeT = (u16*)((char*)p.out + WO_PE);
  float* wl = (float*)smem;
  for (int i = tid; i < 16 * 128; i += NT) { int d = i & 127; wl[i] = pw[(c0 + (i >> 7)) * 128 + d] * sc[d]; }
  __syncthreads();
  float acc0[16], acc1[16];
#pragma unroll
  for (int i = 0; i < 16; ++i) { acc0[i] = 0.f; acc1[i] = 0.f; }
#pragma unroll 4
  for (int d = 0; d < 128; ++d) {
    float p0 = po[(size_t)d * 1024 + tid], p1 = po[(size_t)d * 1024 + 512 + tid];
#pragma unroll
    for (int i = 0; i < 16; ++i) { float w = wl[i * 128 + d]; acc0[i] += w * p0; acc1[i] += w * p1; }
  }
  uint4 o0, o1;
  o0.x = pk2(acc0[0], acc0[1]); o0.y = pk2(acc0[2], acc0[3]); o0.z = pk2(acc0[4], acc0[5]); o0.w = pk2(acc0[6], acc0[7]);
  o1.x = pk2(acc0[8], acc0[9]); o1.y = pk2(acc0[10], acc0[11]); o1.z = pk2(acc0[12], acc0[13]); o1.w = pk2(acc0[14], acc0[15]);
  uint4* dst = (uint4*)(WpeT + (size_t)tid * 512 + g * 128 + c0);
  dst[0] = o0; dst[1] = o1;
  o0.x = pk2(acc1[0], acc1[1]); o0.y = pk2(acc1[2], acc1[3]); o0.z = pk2(acc1[4], acc1[5]); o0.w = pk2(acc1[6], acc1[7]);
  o1.x = pk2(acc1[8], acc1[9]); o1.y = pk2(acc1[10], acc1[11]); o1.z = pk2(acc1[12], acc1[13]); o1.w = pk2(acc1[14], acc1[15]);
  dst = (uint4*)(WpeT + (size_t)(512 + tid) * 512 + g * 128 + c0);
  dst[0] = o0; dst[1] = o1;
  __syncthreads();
}

__device__ __forceinline__ void norm_rows(const Ctx& p, const float* gain, const float* modl, int sh_idx, int sc_idx, u16* outp) {
  const int tidx = tid_l(), lane = tidx & 63, gw = blockIdx.x * 8 + (tidx >> 6), ngw = gridDim.x * 8;
  const float* h = (const float*)(p.ws + WS_H);
  for (int m = gw; m < MROWS; m += ngw) {
    const float4* hr = (const float4*)(h + (size_t)m * D) + lane;
    float4 v[4];
    float ss = 0.f;
#pragma unroll
    for (int j = 0; j < 4; ++j) { v[j] = hr[64 * j]; ss += v[j].x * v[j].x + v[j].y * v[j].y + v[j].z * v[j].z + v[j].w * v[j].w; }
    ss = wave_sum(ss);
    float r = rsqrtf(ss * (1.f / D) + EPS);
    const float* mg = modl + grp_of_row(m) * 6144;
    uint2* o8 = (uint2*)(outp + (size_t)m * D) + lane;
#pragma unroll
    for (int j = 0; j < 4; ++j) {
      int n = lane * 4 + 256 * j;
      float4 g = *(const float4*)(gain + n), sc = *(const float4*)(mg + sc_idx * 1024 + n), sh = *(const float4*)(mg + sh_idx * 1024 + n);
      uint2 o;
      o.x = pk2(v[j].x * r * g.x * (1.f + sc.x) + sh.x, v[j].y * r * g.y * (1.f + sc.y) + sh.y);
      o.y = pk2(v[j].z * r * g.z * (1.f + sc.z) + sh.z, v[j].w * r * g.w * (1.f + sc.w) + sh.w);
      o8[64 * j] = o;
    }
  }
}

__device__ __forceinline__ void final_norm(const Ctx& p) {
  const int tidx = tid_l(), lane = tidx & 63, gw = blockIdx.x * 8 + (tidx >> 6), ngw = gridDim.x * 8;
  const float* h = (const float*)(p.ws + WS_H);
  const float* gain = pin(p, 32);
  for (int r0 = gw; r0 < 2 * SEQ; r0 += ngw) {
    int b = r0 >> 13, t = r0 & 8191, m = b * SP + CTX + t;
    const float4* hr = (const float4*)(h + (size_t)m * D) + lane;
    float4 v[4];
    float ss = 0.f;
#pragma unroll
    for (int j = 0; j < 4; ++j) { v[j] = hr[64 * j]; ss += v[j].x * v[j].x + v[j].y * v[j].y + v[j].z * v[j].z + v[j].w * v[j].w; }
    ss = wave_sum(ss);
    float r = rsqrtf(ss * (1.f / D) + EPS);
    float4* o = (float4*)(p.out + (size_t)r0 * D) + lane;
#pragma unroll
    for (int j = 0; j < 4; ++j) {
      float4 g = *(const float4*)(gain + lane * 4 + 256 * j);
      o[64 * j] = make_float4(v[j].x * r * g.x, v[j].y * r * g.y, v[j].z * r * g.z, v[j].w * r * g.w);
    }
  }
}

__device__ __forceinline__ void premix_task(const Ctx& p, int l, int task, char* smem) {
  const int tid = tid_l(), lane = tid & 63, wid = tid >> 6;
  const int tile64 = task >> 2, part = task & 3;
  const int m0 = tile64 * 64, b = m0 / SP, pos0 = m0 - b * SP;
  const bool isctx = pos0 < CTX;
  const int s0 = isctx ? 0 : CTX, L = isctx ? CTX : SEQ, t0 = pos0 - s0;
  const size_t mb = (size_t)b * SP + s0;
  const u16* proj = (const u16*)(p.ws + WS_PROJ);
  if (part == 0) {
    u16* P = (u16*)smem;
    for (int i = tid; i < 80 * 64; i += NT) {
      int r = i >> 6, ch = i & 63, t = t0 - 8 + r;
      uint4 v = make_uint4(0, 0, 0, 0);
      if (t >= 0 && t < L) v = *(const uint4*)(proj + (mb + t) * DINP + ch * 8);
      *(uint4*)(P + r * 512 + ch * 8) = v;
    }
    __syncthreads();
    const int c = tid, g = c >> 7, hw = 1 << g;
    u16* U = (u16*)(p.ws + WS_U);
    for (int tt = 0; tt < 64; ++tt) {
      int t = t0 + tt, lo = max(t - hw, 0), hi = min(t + hw, L);
      float s = 0.f;
      for (int q = lo; q < hi; ++q) s += bf2f(P[(q - t0 + 8) * 512 + c]);
      float u = s / (float)(hi - lo) - bf2f(P[(tt + 8) * 512 + c]);
      U[(mb + t) * 512 + c] = f2bf(u);
    }
    __syncthreads();
  } else if (part <= 2) {
    const int ch0 = (part - 1) * 256;
    constexpr int PITCH = 260;
    u16* X = (u16*)smem;
    for (int i = tid; i < 3 * 66 * 32; i += NT) {
      int pr = i / (66 * 32), rem = i - pr * 66 * 32, r = rem >> 5, ch = rem & 31, t = t0 - 1 + r;
      uint4 v = make_uint4(0, 0, 0, 0);
      if (t >= 0 && t < L) v = *(const uint4*)(proj + (mb + t) * DINP + OFF_HY + pr * 512 + ch0 + ch * 8);
      uint2* d = (uint2*)(X + (pr * 66 + r) * PITCH + ch * 8);
      d[0] = make_uint2(v.x, v.y);
      d[1] = make_uint2(v.z, v.w);
    }
    __syncthreads();
    const float* cw = pin(p, 12) + l * 3 * 1536;
    const float* cb = pin(p, 13) + l * 1536;
    {
      const int c = tid & 255, th = tid >> 8, col = ch0 + c;
      float w0 = cw[col], w1 = cw[1536 + col], w2 = cw[3072 + col], bb = cb[col];
      u16* Y = (u16*)(p.ws + WS_Y);
      for (int tt = th * 32; tt < th * 32 + 32; ++tt) {
        float v = w0 * bf2f(X[(tt)*PITCH + c]) + w1 * bf2f(X[(tt + 1) * PITCH + c]) + w2 * bf2f(X[(tt + 2) * PITCH + c]) + bb;
        Y[(mb + t0 + tt) * 512 + col] = f2bf(v);
      }
    }
    {
      const int tt = lane;
      float* ZV = (float*)(p.ws + WS_ZV);
      for (int cc = 0; cc < 32; ++cc) {
        int c = wid * 32 + cc, col = ch0 + c;
        float a0 = cw[512 + col], a1 = cw[1536 + 512 + col], a2 = cw[3072 + 512 + col], ab = cb[512 + col];
        float v0 = cw[1024 + col], v1 = cw[1536 + 1024 + col], v2 = cw[3072 + 1024 + col], vb = cb[1024 + col];
        const u16* X1 = X + 66 * PITCH, *XV = X + 2 * 66 * PITCH;
        float x1 = a0 * bf2f(X1[tt * PITCH + c]) + a1 * bf2f(X1[(tt + 1) * PITCH + c]) + a2 * bf2f(X1[(tt + 2) * PITCH + c]) + ab;
        float vv = v0 * bf2f(XV[tt * PITCH + c]) + v1 * bf2f(XV[(tt + 1) * PITCH + c]) + v2 * bf2f(XV[(tt + 2) * PITCH + c]) + vb;
        ZV[((size_t)col * SP + pos0 + tt) * 2 + b] = x1 * vv;
      }
    }
    __syncthreads();
  } else {
    u16* projw = (u16*)(p.ws + WS_PROJ);
    const float* qg = pin(p, 24) + l * 384;
    const float* kg = pin(p, 26) + l * 256;
    const float2* rope = (const float2*)(p.ws + WS_ROPE);
    u16* Kb = (u16*)(p.ws + WS_K);
    for (int rr = 0; rr < 8; ++rr) {
      int tt = wid * 8 + rr, pos = pos0 + tt;
      u16* row = projw + ((size_t)b * SP + pos) * DINP;
      {
        unsigned* q32 = (unsigned*)(row + OFF_Q);
        unsigned v[3];
        float ss = 0.f;
#pragma unroll
        for (int j = 0; j < 3; ++j) { v[j] = q32[lane + 64 * j]; float a = bf2f(v[j] & 0xffff), c2 = bf2f(v[j] >> 16); ss += a * a + c2 * c2; }
        ss = wave_sum(ss);
        float r = rsqrtf(ss * (1.f / 384.f) + EPS);
#pragma unroll
        for (int j = 0; j < 3; ++j) {
          int n = (lane + 64 * j) * 2;
          q32[lane + 64 * j] = pk2(bf2f(v[j] & 0xffff) * r * qg[n], bf2f(v[j] >> 16) * r * qg[n + 1]);
        }
      }
      {
        unsigned* k32 = (unsigned*)(row + OFF_KV);
        unsigned v[2];
        float ss = 0.f;
#pragma unroll
        for (int j = 0; j < 2; ++j) { v[j] = k32[lane + 64 * j]; float a = bf2f(v[j] & 0xffff), c2 = bf2f(v[j] >> 16); ss += a * a + c2 * c2; }
        ss = wave_sum(ss);
        float r = rsqrtf(ss * (1.f / 256.f) + EPS);
#pragma unroll
        for (int j = 0; j < 2; ++j) {
          int n = (lane + 64 * j) * 2;
          k32[lane + 64 * j] = pk2(bf2f(v[j] & 0xffff) * r * kg[n], bf2f(v[j] >> 16) * r * kg[n + 1]);
        }
      }
      {
        int rd = lane & 31;
        float val = bf2f(row[OFF_KV + 256 + rd]);
        float partner = __shfl_xor(val, 8);
        if (!isctx) {
          int t = pos - CTX, idx = (rd < 16) ? (t >> 6) : (t & 63);
          float2 cs = rope[idx * 8 + (rd & 7)];
          float sgn = (rd & 8) ? 1.f : -1.f;
          val = val * cs.x + sgn * partner * cs.y;
        }
        if (lane < 32) {
          u16 o = f2bf(val);
#pragma unroll
          for (int hd = 0; hd < 8; ++hd) Kb[((size_t)(b * 8 + hd) * SP + pos) * 96 + 64 + rd] = o;
        }
      }
    }
  }
}

__device__ __forceinline__ void bf_fwd(float2* X, int base, int q, float2 w1) {
  float2 w2 = cmul(w1, w1), w3 = cmul(w2, w1);
  float2 a0 = X[base], a1 = X[base + q], a2 = X[base + 2 * q], a3 = X[base + 3 * q];
  float2 s02 = make_float2(a0.x + a2.x, a0.y + a2.y), d02 = make_float2(a0.x - a2.x, a0.y - a2.y);
  float2 s13 = make_float2(a1.x + a3.x, a1.y + a3.y), d13 = make_float2(a1.x - a3.x, a1.y - a3.y);
  X[base] = make_float2(s02.x + s13.x, s02.y + s13.y);
  X[base + q] = cmul(make_float2(d02.x + d13.y, d02.y - d13.x), w1);
  X[base + 2 * q] = cmul(make_float2(s02.x - s13.x, s02.y - s13.y), w2);
  X[base + 3 * q] = cmul(make_float2(d02.x - d13.y, d02.y + d13.x), w3);
}
__device__ __forceinline__ void bf_inv(float2* X, int base, int q, float2 w1) {
  w1.y = -w1.y;
  float2 w2 = cmul(w1, w1), w3 = cmul(w2, w1);
  float2 b0 = X[base], c1 = cmul(X[base + q], w1), c2 = cmul(X[base + 2 * q], w2), c3 = cmul(X[base + 3 * q], w3);
  float2 s02 = make_float2(b0.x + c2.x, b0.y + c2.y), d02 = make_float2(b0.x - c2.x, b0.y - c2.y);
  float2 s13 = make_float2(c1.x + c3.x, c1.y + c3.y), d13 = make_float2(c1.x - c3.x, c1.y - c3.y);
  X[base] = make_float2(s02.x + s13.x, s02.y + s13.y);
  X[base + q] = make_float2(d02.x - d13.y, d02.y + d13.x);
  X[base + 2 * q] = make_float2(s02.x - s13.x, s02.y - s13.y);
  X[base + 3 * q] = make_float2(d02.x + d13.y, d02.y - d13.x);
}
template <bool INV>
__device__ __forceinline__ void fft_pass(float2* X, const float2* __restrict__ tw, int lq, int tid) {
  const int q = 1 << lq, sh = 12 - lq;
  if (lq == 12) {
    float2 w[8];
#pragma unroll
    for (int b8 = 0; b8 < 8; ++b8) w[b8] = tw[b8 * NT + tid];
#pragma unroll
    for (int b8 = 0; b8 < 8; ++b8) { int u = b8 * NT + tid; if (INV) bf_inv(X, u, q, w[b8]); else bf_fwd(X, u, q, w[b8]); }
  } else if (lq == 10) {
    float2 wA = tw[tid << 2], wB = tw[(512 + tid) << 2];
#pragma unroll 2
    for (int b8 = 0; b8 < 8; ++b8) {
      int u = b8 * NT + tid, j = u & 1023, base = ((u >> 10) << 12) + j;
      float2 w = (b8 & 1) ? wB : wA;
      if (INV) bf_inv(X, base, q, w); else bf_fwd(X, base, q, w);
    }
  } else {
    const int j = tid & (q - 1);
    float2 w = tw[j << sh];
#pragma unroll 2
    for (int b8 = 0; b8 < 8; ++b8) {
      int u = b8 * NT + tid, base = ((u >> lq) << (lq + 2)) + j;
      if (INV) bf_inv(X, base, q, w); else bf_fwd(X, base, q, w);
    }
  }
  __syncthreads();
}
__device__ __forceinline__ void fft_dif(float2* X, const float2* __restrict__ tw) {
  const int tid = tid_l();
  for (int lq = 12; lq >= 0; lq -= 2) fft_pass<false>(X, tw, lq, tid);
}
__device__ __forceinline__ void fft_dit_inv(float2* X, const float2* __restrict__ tw) {
  const int tid = tid_l();
  for (int lq = 0; lq <= 12; lq += 2) fft_pass<true>(X, tw, lq, tid);
}
__device__ __forceinline__ float block_sum(float v, float* red) {
  v = wave_sum(v);
  __syncthreads();
  if ((threadIdx.x & 63) == 0) red[threadIdx.x >> 6] = v;
  __syncthreads();
  float s = red[0] + red[1] + red[2] + red[3] + red[4] + red[5] + red[6] + red[7];
  __syncthreads();
  return s;
}

__device__ __forceinline__ void fft_task(const Ctx& p, int l, int c, char* smem) {
  float2* X = (float2*)smem;
  float* aux = (float*)(smem + 131072);
  float* red = aux + 128;
  const int tid = tid_l();
  const float2* tw = (const float2*)(p.ws + WS_TW);
  const float* w3 = pin(p, 20) + (size_t)l * 64 * 1024;
  if (tid < 64) { aux[tid] = w3[tid * 1024 + c]; aux[64 + tid] = w3[tid * 1024 + 512 + c]; }
  __syncthreads();
  const float dF = fabsf(pin(p, 21)[(l * 2 + 0) * 512 + c]), dB = fabsf(pin(p, 21)[(l * 2 + 1) * 512 + c]);
  const float bias = pin(p, 22)[l * 512 + c];
  float2* zp = (float2*)(p.ws + WS_ZV) + (size_t)c * SP;
  float l1 = 0.f;
  {
    const float* hid = (const float*)(p.ws + WS_HID2) + (size_t)l * 64 * 8192 + tid;
    float af[16], ab[16];
#pragma unroll
    for (int i = 0; i < 16; ++i) { af[i] = 0.f; ab[i] = 0.f; }
#pragma unroll 2
    for (int k = 0; k < 64; ++k) {
      const float wf = aux[k], wb = aux[64 + k];
#pragma unroll
      for (int i = 0; i < 16; ++i) { float v = hid[(size_t)k * 8192 + i * NT]; af[i] += v * wf; ab[i] += v * wb; }
    }
#pragma unroll
    for (int i = 0; i < 16; ++i) {
      int t = i * NT + tid;
      float tl = (float)t * (1.f / 8191.f);
      float hf = af[i] * expf(-tl * dF);
      float hb = ab[i] * expf(-tl * dB);
      X[t] = make_float2(hf, 0.f);
      if (t >= 1) { X[16384 - t] = make_float2(hb, 0.f); l1 += fabsf(hf) + fabsf(hb); }
      else { X[8192] = make_float2(0.f, 0.f); l1 += fabsf(hf); }
    }
  }
  float l1tot = block_sum(l1, red);
  fft_dif(X, tw);
  float2 F[32];
  {
    float s = 1.f / (l1tot * 16384.f);
#pragma unroll
    for (int i = 0; i < 32; ++i) { float2 v = X[i * NT + tid]; F[i] = make_float2(v.x * s, v.y * s); }
  }
  __syncthreads();
#pragma unroll 2
  for (int i = 0; i < 16; ++i) {
    int t = i * NT + tid;
    X[t] = zp[CTX + t];
    X[8192 + t] = make_float2(0.f, 0.f);
  }
  __syncthreads();
  fft_dif(X, tw);
#pragma unroll
  for (int i = 0; i < 32; ++i) { int idx = i * NT + tid; X[idx] = cmul(X[idx], F[i]); }
  __syncthreads();
  fft_dit_inv(X, tw);
#pragma unroll 2
  for (int i = 0; i < 16; ++i) {
    int t = i * NT + tid;
    float2 z = zp[CTX + t], y = X[t];
    zp[CTX + t] = make_float2(y.x + bias * z.x, y.y + bias * z.y);
  }
  __syncthreads();
  {
    float* hFc = (float*)smem;
    float* hBc = hFc + 256;
    float2* zc = (float2*)(hBc + 256);
    float l1c = 0.f;
    if (tid < 256) {
      int t = tid;
      const float* hc = (const float*)(p.ws + WS_HID2C) + (size_t)l * 64 * 256 + t;
      float hf = 0.f, hb = 0.f;
#pragma unroll 8
      for (int k = 0; k < 64; ++k) { float v = hc[k * 256]; hf += v * aux[k]; hb += v * aux[64 + k]; }
      float tl = (float)t * (1.f / 255.f);
      hf *= expf(-tl * dF);
      hb *= expf(-tl * dB);
      hFc[t] = hf;
      hBc[t] = hb;
      l1c = fabsf(hf) + (t >= 1 ? fabsf(hb) : 0.f);
      zc[t] = zp[t];
    }
    float l1ct = block_sum(l1c, red);
    const int bb = tid >> 8, t = tid & 255;
    float acc = 0.f;
    for (int s = 0; s < 256; ++s) {
      float kf = (s <= t) ? hFc[t - s] : hBc[s - t];
      float2 z = zc[s];
      acc += kf * (bb ? z.y : z.x);
    }
    float2 z = zc[t];
    ((float*)zp)[t * 2 + bb] = acc / l1ct + bias * (bb ? z.y : z.x);
    __syncthreads();
  }
}

constexpr int AT_KP = 208, AT_VP = 136, AT_STAGE = 64 * AT_KP + 64 * AT_VP;
__device__ __forceinline__ void attn_task(const Ctx& p, int bh, int qb, char* smem) {
  const int tid = tid_l(), wid = tid >> 6, lane = tid & 63, r = lane & 31, hh = lane >> 5;
  const u16* Qp = (const u16*)(p.ws + WS_Q) + ((size_t)bh * SP + qb * 256) * 96;
  const u16* Kp = (const u16*)(p.ws + WS_K) + (size_t)bh * SP * 96;
  const u16* Vp = (const u16*)(p.ws + WS_VT) + (size_t)bh * 64 * SP;
  const int nkt = (qb == 0) ? 4 : 132;
  bf16x8 qf[6];
#pragma unroll
  for (int ks = 0; ks < 6; ++ks) qf[ks] = *(const bf16x8*)(Qp + (size_t)(wid * 32 + r) * 96 + ks * 16 + hh * 8);
  f32x16 o0, o1;
#pragma unroll
  for (int i = 0; i < 16; ++i) { o0[i] = 0.f; o1[i] = 0.f; }
  float mrun = -1e30f, lrun = 0.f;
  const u16* src[3];
  int dst[3], kstep[3];
#pragma unroll
  for (int i = 0; i < 3; ++i) {
    int ch = tid + i * NT;
    if (ch < 768) { int row = ch / 12, cc = ch - row * 12; src[i] = Kp + (size_t)row * 96 + cc * 8; dst[i] = row * AT_KP + cc * 16; kstep[i] = 64 * 96; }
    else { int v = ch - 768, row = (v >> 3) & 63, cc = v & 7; src[i] = Vp + (size_t)row * SP + cc * 8; dst[i] = 64 * AT_KP + row * AT_VP + cc * 16; kstep[i] = 64; }
  }
  const bool has3 = tid < 256;
  uint4 st[3];
#define AT_LOAD(t)                                                                                   \
  do {                                                                                               \
    st[0] = *(const uint4*)(src[0] + (size_t)(t) * kstep[0]);                                        \
    st[1] = *(const uint4*)(src[1] + (size_t)(t) * kstep[1]);                                        \
    if (has3) st[2] = *(const uint4*)(src[2] + (size_t)(t) * kstep[2]);                              \
  } while (0)
#define AT_WRITE1(i, base)                                                                           \
  do {                                                                                               \
    uint2* d_ = (uint2*)((base) + dst[i]);                                                           \
    d_[0] = make_uint2(st[i].x, st[i].y);                                                            \
    d_[1] = make_uint2(st[i].z, st[i].w);                                                            \
  } while (0)
#define AT_WRITE(buf)                                                                                \
  do {                                                                                               \
    char* base_ = smem + (buf) * AT_STAGE;                                                           \
    AT_WRITE1(0, base_); AT_WRITE1(1, base_);                                                        \
    if (has3) AT_WRITE1(2, base_);                                                                   \
  } while (0)
  AT_LOAD(0);
  AT_WRITE(0);
  __syncthreads();
  for (int t = 0; t < nkt; ++t) {
    const int cur = t & 1;
    if (t + 1 < nkt) AT_LOAD(t + 1);
    const char* Ks = smem + cur * AT_STAGE;
    const char* Vs = Ks + 64 * AT_KP;
    f32x16 s0, s1;
#pragma unroll
    for (int i = 0; i < 16; ++i) { s0[i] = 0.f; s1[i] = 0.f; }
#pragma unroll
    for (int ks = 0; ks < 6; ++ks) {
      bf16x8 a0 = *(const bf16x8*)(Ks + r * AT_KP + ks * 32 + hh * 16);
      bf16x8 a1 = *(const bf16x8*)(Ks + (32 + r) * AT_KP + ks * 32 + hh * 16);
      s0 = __builtin_amdgcn_mfma_f32_32x32x16_bf16(a0, qf[ks], s0, 0, 0, 0);
      s1 = __builtin_amdgcn_mfma_f32_32x32x16_bf16(a1, qf[ks], s1, 0, 0, 0);
    }
    float mx = s0[0];
#pragma unroll
    for (int i = 1; i < 16; ++i) mx = fmaxf(mx, s0[i]);
#pragma unroll
    for (int i = 0; i < 16; ++i) mx = fmaxf(mx, s1[i]);
    mx = fmaxf(mx, __shfl_xor(mx, 32));
    const float mnew = fmaxf(mrun, mx);
    const bool grow = __any(mnew > mrun);
    const float alpha = __builtin_amdgcn_exp2f(mrun - mnew);
    mrun = mnew;
    float ps = 0.f;
#pragma unroll
    for (int i = 0; i < 16; ++i) { s0[i] = __builtin_amdgcn_exp2f(s0[i] - mnew); ps += s0[i]; }
#pragma unroll
    for (int i = 0; i < 16; ++i) { s1[i] = __builtin_amdgcn_exp2f(s1[i] - mnew); ps += s1[i]; }
    lrun = lrun * alpha + ps;
    if (grow) {
#pragma unroll
      for (int i = 0; i < 16; ++i) { o0[i] *= alpha; o1[i] *= alpha; }
    }
#pragma unroll
    for (int kb = 0; kb < 2; ++kb) {
#pragma unroll
      for (int sI = 0; sI < 2; ++sI) {
        union { bf16x8 v; unsigned u[4]; } pu;
#pragma unroll
        for (int j = 0; j < 4; ++j) pu.u[j] = kb == 0 ? pk2(s0[8 * sI + 2 * j], s0[8 * sI + 2 * j + 1]) : pk2(s1[8 * sI + 2 * j], s1[8 * sI + 2 * j + 1]);
        const bf16x8 pf = pu.v;
        const int koff = (kb * 32 + 16 * sI + 4 * hh) * 2;
        union { bf16x8 v; uint2 h2[2]; } va, vb;
        va.h2[0] = *(const uint2*)(Vs + r * AT_VP + koff);
        va.h2[1] = *(const uint2*)(Vs + r * AT_VP + koff + 16);
        vb.h2[0] = *(const uint2*)(Vs + (32 + r) * AT_VP + koff);
        vb.h2[1] = *(const uint2*)(Vs + (32 + r) * AT_VP + koff + 16);
        o0 = __builtin_amdgcn_mfma_f32_32x32x16_bf16(va.v, pf, o0, 0, 0, 0);
        o1 = __builtin_amdgcn_mfma_f32_32x32x16_bf16(vb.v, pf, o1, 0, 0, 0);
      }
    }
    if (t + 1 < nkt) AT_WRITE(cur ^ 1);
    __syncthreads();
  }
  const float ltot = lrun + __shfl_xor(lrun, 32);
  const float inv = 1.f / ltot;
  const int b = bh >> 3, head = bh & 7;
  u16* Op = (u16*)(p.ws + WS_O) + ((size_t)b * SP + qb * 256 + wid * 32 + r) * 512 + head * 64;
#pragma unroll
  for (int g = 0; g < 4; ++g) {
    uint2 w0, w1;
    w0.x = pk2(o0[4 * g] * inv, o0[4 * g + 1] * inv);
    w0.y = pk2(o0[4 * g + 2] * inv, o0[4 * g + 3] * inv);
    w1.x = pk2(o1[4 * g] * inv, o1[4 * g + 1] * inv);
    w1.y = pk2(o1[4 * g + 2] * inv, o1[4 * g + 3] * inv);
    *(uint2*)(Op + 8 * g + 4 * hh) = w0;
    *(uint2*)(Op + 32 + 8 * g + 4 * hh) = w1;
  }
#undef AT_LOAD
#undef AT_WRITE
#undef AT_WRITE1
}

__device__ __forceinline__ void hypost_task(const Ctx& p, int task, char* smem) {
  const int tid = tid_l(), lane = tid & 63, wid = tid >> 6;
  const int tile64 = task >> 1, ch0 = (task & 1) * 256;
  const int m0 = tile64 * 64, b = m0 / SP, pos0 = m0 - b * SP;
  float* T = (float*)smem;
  const float* ZV = (const float*)(p.ws + WS_ZV);
  for (int cc = 0; cc < 32; ++cc) {
    int c = wid * 32 + cc;
    T[c * 65 + lane] = ZV[((size_t)(ch0 + c) * SP + pos0 + lane) * 2 + b];
  }
  __syncthreads();
  u16* Y = (u16*)(p.ws + WS_Y);
  const int c = tid & 255, th = tid >> 8;
  for (int tt = th * 32; tt < th * 32 + 32; ++tt) {
    size_t i = (size_t)(m0 + tt) * 512 + ch0 + c;
    Y[i] = f2bf(bf2f(Y[i]) * T[c * 65 + tt]);
  }
  __syncthreads();
}

#ifndef PHMASK
#define PHMASK 0xFFFF
#endif
#define PHON(k) (((PHMASK) >> (k)) & 1)
constexpr int NPH = 1 + 4 * 10 + 1;
__global__ void __launch_bounds__(NT, 2) mega(Params prm) {
  __shared__ __attribute__((aligned(1024))) char smem[LDS_BYTES];
  cg::grid_group grid = cg::this_grid();
  const int bid = blockIdx.x, nb = gridDim.x;
  {
    unsigned long long* it = (unsigned long long*)(smem + 131072 + 6144);
    if (threadIdx.x < 33) it[threadIdx.x] = (unsigned long long)prm.in[threadIdx.x];
    __syncthreads();
  }
  unsigned nbar = 0;
  for (int ph = prm.ph_lo; ph < prm.ph_hi; ++ph) {
    Ctx p;
    p.intab = (const unsigned long long*)(smem + 131072 + 6144);
    p.ws = prm.ws;
    p.out = prm.out;
    asm volatile("" : "+s"(p.ws), "+s"(p.out));
    float* modall = (float*)(p.ws + WS_MOD);
    u16* proj = (u16*)(p.ws + WS_PROJ);
    u16* xn = (u16*)(p.ws + WS_U);
    char* wo = (char*)p.out;
    if (ph == 0) {
      if (PHON(10)) {
      p0_misc(p);
      for (int t = bid; t < 192; t += nb) p0_mod_task(p, t, smem);
      for (int t = bid; t < 528; t += nb) p0_hid_task(p, t, smem);
      }
    } else if (ph == NPH - 1) {
      if (PHON(11)) final_norm(p);
    } else {
      const int l = (ph - 1) / 10, sp = (ph - 1) % 10;
      const float* modl = modall + (size_t)l * 3 * 6144;
      GD* tab = (GD*)(smem + 131072 + 4096);
      int ng = 0, nN0 = 0, nN1 = 0;
      bool seq = false;
      const float* gate = modl;
      if (sp == 0 && PHON(0)) {
        for (int t = bid; t < 4168; t += nb) {
          int r = t;
          if (r < 1472) { wt_task(pin(p, 8) + (size_t)l * 1024 * DIN, 1024, DIN, (u16*)(wo + WO_IN), r, 92, smem); continue; } r -= 1472;
          if (r < 1024) { wt_task(pin(p, 30) + (size_t)l * 1024 * 4096, 1024, 4096, (u16*)(wo + WO_FF1), r, 64, smem); continue; } r -= 1024;
          if (r < 1024) { wt_task(pin(p, 31) + (size_t)l * 4096 * 1024, 4096, 1024, (u16*)(wo + WO_FF2), r, 16, smem); continue; } r -= 1024;
          if (r < 256) { wt_task(pin(p, 29) + (size_t)l * 1024 * 1024, 1024, 1024, (u16*)(wo + WO_OUT), r, 16, smem); continue; } r -= 256;
          if (r < 128) { wt_task(pin(p, 23) + (size_t)l * 512 * 1024, 512, 1024, (u16*)(wo + WO_HY), r, 16, smem); continue; } r -= 128;
          if (r < 128) { wt_task(pin(p, 28) + (size_t)l * 512 * 1024, 512, 1024, (u16*)(wo + WO_WO), r, 16, smem); continue; } r -= 128;
          if (r < 72) { wt_task(pin(p, 25) + (size_t)l * 384 * 768, 384, 768, (u16*)(wo + WO_UQ), r, 12, smem); continue; } r -= 72;
          wt_task(pin(p, 27) + (size_t)l * 256 * 1024, 256, 1024, (u16*)(wo + WO_UKV), r, 16, smem);
        }
        for (int t = bid; t < 32; t += nb) wpe_task(p, l, (t + 128) & 31, smem);
        norm_rows(p, pin(p, 6) + l * 1024, modl, 0, 1, xn);
      } else if (sp == 1 && PHON(1)) {
        if (threadIdx.x == 0) tab[0] = GD{xn, 1024, (const u16*)(wo + WO_IN), 1024, 1024, 23, EM_PROJ, 1};
        ng = 1; nN0 = 23;
      } else if (sp == 2 && PHON(2)) {
        for (int t = bid; t < 264 * 4; t += nb) premix_task(p, l, t, smem);
      } else if (sp == 3 && PHON(3)) {
        for (int t = bid; t < 512; t += nb) fft_task(p, l, t, smem);
        if (threadIdx.x == 0) {
          tab[0] = GD{proj + OFF_Q, DINP, (const u16*)(wo + WO_UQ), 384, 384, 3, EM_Q, 1};
          tab[1] = GD{proj + OFF_KV, DINP, (const u16*)(wo + WO_UKV), 256, 256, 4, EM_KV, 1};
        }
        ng = 2; nN0 = 3; nN1 = 4;
      } else if (sp == 4 && PHON(4)) {
        for (int t = bid; t < 528; t += nb) {
          int bh, qb;
          if (t < 512) { int rnd = t >> 8, w = t & 255; bh = (w & 7) + 8 * rnd; qb = 1 + (w >> 3); }
          else { bh = t - 512; qb = 0; }
          attn_task(p, bh, qb, smem);
        }
        for (int t = bid; t < 528; t += nb) hypost_task(p, t, smem);
      } else if (sp == 5 && PHON(5)) {
        for (int t = bid; t < 132 * 4; t += nb) {
          int w = t;
          mix_tile(p, w >> 2, w & 3, smem);
        }
      } else if (sp == 6 && PHON(6)) {
        if (threadIdx.x == 0) tab[0] = GD{(const u16*)(p.ws + WS_ZV), 1024, (const u16*)(wo + WO_OUT), 1024, 512, 4, EM_RESID, 2};
        ng = 1; nN0 = 8;
        gate = modl + 2 * 1024;
      } else if (sp == 7 && PHON(7)) {
        norm_rows(p, pin(p, 7) + l * 1024, modl, 3, 4, xn);
      } else if (sp == 8 && PHON(8)) {
        if (threadIdx.x == 0) tab[0] = GD{xn, 1024, (const u16*)(wo + WO_FF1), 1024, 1024, 16, EM_SQRELU, 1};
        ng = 1; nN0 = 16;
      } else if (sp == 9 && PHON(9)) {
        if (threadIdx.x == 0) tab[0] = GD{proj, DFF, (const u16*)(wo + WO_FF2), 4096, 1024, 4, EM_RESID, 4};
        ng = 1; nN0 = 16;
        gate = modl + 5 * 1024;
      }
      if (ng > 0) {
        __syncthreads();
        const int nt0 = NMT * nN0, ntot = seq ? nt0 : nt0 + NMT * nN1;
        const int nseq = seq ? ng : 1;
        const int nitems = ((ntot - bid + nb - 1) / nb) * nseq;
#pragma unroll 1
        for (int it = 0; it < nitems; ++it) {
          int t = bid + (it / nseq) * nb, gi = it % nseq, tt = t;
          if (!seq && t >= nt0) { gi = 1; tt = t - nt0; }
          const volatile GD* gp = tab + gi;
          unsigned long long a64 = (unsigned long long)gp->A, b64 = (unsigned long long)gp->Bt;
          a64 = ((unsigned long long)(unsigned)__builtin_amdgcn_readfirstlane((unsigned)(a64 >> 32)) << 32) | (unsigned long long)(unsigned)__builtin_amdgcn_readfirstlane((unsigned)a64);
          b64 = ((unsigned long long)(unsigned)__builtin_amdgcn_readfirstlane((unsigned)(b64 >> 32)) << 32) | (unsigned long long)(unsigned)__builtin_amdgcn_readfirstlane((unsigned)b64);
          const int lda = __builtin_amdgcn_readfirstlane(gp->lda), ldb = __builtin_amdgcn_readfirstlane(gp->ldb);
          const int K = __builtin_amdgcn_readfirstlane(gp->K), nN = __builtin_amdgcn_readfirstlane(gp->nN);
          const int ks = __builtin_amdgcn_readfirstlane(gp->ks);
          const int kp = tt % ks;
          tt /= ks;
          a64 += (unsigned long long)kp * K * 2; b64 += (unsigned long long)kp * K * 2;
          const int mode = __builtin_amdgcn_readfirstlane(gp->mode);
          int pm, pn;
          tile_map(tt, NMT, nN, pm, pn);
          Epi e{mode, p.ws, gate};
          gemm_tile((const u16*)a64, lda, (const u16*)b64, ldb, K, pm * 256, pn * 256, smem, e);
        }
      }
    }
    if (ph + 1 < prm.ph_hi) {
      if (ph == prm.ph_lo) grid.sync();
      else { ++nbar; grid_barrier((unsigned*)(prm.ws + WS_BAR), nbar * gridDim.x); }
    }
  }
}

extern "C" void kernel_launch(void* const* d_in, const int* in_sizes, int n_in, void* d_out, int out_size, void* d_ws,
                              size_t ws_size, hipStream_t stream) {
  static int grid_blocks = 0;
  if (grid_blocks == 0) {
    if (n_in != 33 || ws_size < WS_END || (size_t)out_size * 4 < WO_END) {
      fprintf(stderr, "kernel_launch: unexpected sizes n_in=%d ws=%zu (need %zu) out=%d\n", n_in, ws_size, (size_t)WS_END, out_size);
      grid_blocks = -1;
      return;
    }
    int dev = 0, cus = 0, per_cu = 0;
    hipGetDevice(&dev);
    hipDeviceGetAttribute(&cus, hipDeviceAttributeMultiprocessorCount, dev);
    hipOccupancyMaxActiveBlocksPerMultiprocessor(&per_cu, mega, NT, 0);
    if (per_cu < 1) per_cu = 1;
    if (per_cu > 1) per_cu = 1;
    grid_blocks = cus * per_cu;
  }
  if (grid_blocks < 0) return;
  Params p{};
  for (int i = 0; i < 33; ++i) p.in[i] = (const float*)d_in[i];
  p.out = (float*)d_out;
  p.ws = (char*)d_ws;
  p.ph_lo = 0;
  p.ph_hi = NPH;
  (void)hipMemsetAsync((char*)d_ws + WS_BAR, 0, 1024, stream);
  void* args[] = {&p};
  hipError_t e = hipLaunchCooperativeKernel((void*)mega, dim3(grid_blocks), dim3(NT), args, 0, stream);
  if (e != hipSuccess) fprintf(stderr, "cooperative launch failed: %s (grid %d)\n", hipGetErrorString(e), grid_blocks);
}
```

```cpp
#include <hip/hip_runtime.h>
#include <hip/hip_cooperative_groups.h>
#include <cstdio>
namespace cg = cooperative_groups;

typedef unsigned short u16;
using bf16x8 = __attribute__((ext_vector_type(8))) short;
using f32x4 = __attribute__((ext_vector_type(4))) float;
using f32x16 = __attribute__((ext_vector_type(16))) float;

constexpr int D = 1024, SEQ = 8192, CTX = 256, SP = 8448, MROWS = 16896, NMT = 66;
constexpr int DIN = 5792, DINP = 5888, DFF = 4096;
constexpr int OFF_HY = 512, OFF_Q = 2048, OFF_KV = 2432, OFF_GATE = 2720;
constexpr int NT = 512;
constexpr float EPS = 1e-6f;

constexpr size_t WS_H = 0;
constexpr size_t WS_PROJ = WS_H + (size_t)MROWS * D * 4;
constexpr size_t WS_U = WS_PROJ + (size_t)MROWS * DINP * 2;
constexpr size_t WS_Y = WS_U + (size_t)MROWS * 512 * 2;
constexpr size_t WS_O = WS_Y + (size_t)MROWS * 512 * 2;
constexpr size_t WS_Q = WS_O + (size_t)MROWS * 512 * 2;
constexpr size_t WS_K = WS_Q + (size_t)16 * SP * 96 * 2;
constexpr size_t WS_VT = WS_K + (size_t)16 * SP * 96 * 2;
constexpr size_t WS_ZV = WS_VT + (size_t)16 * 64 * SP * 2;
constexpr size_t WS_HID2 = WS_ZV + (size_t)512 * SP * 8;
constexpr size_t WS_HID2C = WS_HID2 + (size_t)4 * 8192 * 64 * 4;
constexpr size_t WS_MOD = WS_HID2C + (size_t)4 * 256 * 64 * 4;
constexpr size_t WS_ROPE = WS_MOD + (size_t)4 * 3 * 6144 * 4;
constexpr size_t WS_TW = WS_ROPE + (size_t)128 * 8 * 8;
constexpr size_t WS_BAR = WS_TW + (size_t)16384 * 8;
constexpr size_t WS_END = WS_BAR + 1024;
constexpr size_t WO_IN = 0;
constexpr size_t WO_FF1 = WO_IN + (size_t)DINP * 1024 * 2;
constexpr size_t WO_FF2 = WO_FF1 + (size_t)4096 * 1024 * 2;
constexpr size_t WO_OUT = WO_FF2 + (size_t)4096 * 1024 * 2;
constexpr size_t WO_HY = WO_OUT + (size_t)1024 * 1024 * 2;
constexpr size_t WO_WO = WO_HY + (size_t)1024 * 512 * 2;
constexpr size_t WO_PE = WO_WO + (size_t)1024 * 512 * 2;
constexpr size_t WO_UQ = WO_PE + (size_t)1024 * 512 * 2;
constexpr size_t WO_UKV = WO_UQ + (size_t)768 * 384 * 2;
constexpr size_t WO_END = WO_UKV + (size_t)1024 * 256 * 2;

constexpr int LDS_BYTES = 131072 + 8192;

struct Params {
  const float* in[33];
  float* out;
  char* ws;
  int ph_lo, ph_hi;
};

struct Ctx { const unsigned long long* intab; char* ws; float* out; };
__device__ __forceinline__ const float* pin(const Ctx& c, int i) {
  unsigned long long v = c.intab[i];
  unsigned lo = __builtin_amdgcn_readfirstlane((unsigned)v), hi = __builtin_amdgcn_readfirstlane((unsigned)(v >> 32));
  return (const float*)(((unsigned long long)hi << 32) | lo);
}

typedef __bf16 hwbf2 __attribute__((ext_vector_type(2)));
typedef float hwf2 __attribute__((ext_vector_type(2)));
__device__ __forceinline__ unsigned pk2(float a, float b) {
  hwf2 v = {a, b};
  hwbf2 r = __builtin_convertvector(v, hwbf2);
  return __builtin_bit_cast(unsigned, r);
}
__device__ __forceinline__ u16 f2bf(float f) { return (u16)(pk2(f, 0.f) & 0xffffu); }
__device__ __forceinline__ float bf2f(u16 b) { return __uint_as_float(((unsigned)b) << 16); }
__device__ __forceinline__ float wave_sum(float v) {
#pragma unroll
  for (int o = 1; o < 64; o <<= 1) v += __shfl_xor(v, o);
  return v;
}
__device__ __forceinline__ int grp_of_row(int m) {
  int tile = m >> 8, b = tile / 33, t33 = tile - b * 33;
  return t33 == 0 ? 2 : b;
}
__device__ __forceinline__ float2 cmul(float2 a, float2 b) { return make_float2(a.x * b.x - a.y * b.y, a.x * b.y + a.y * b.x); }

__device__ __forceinline__ int tid_l() { int t = threadIdx.x; asm volatile("" : "+v"(t)); return t; }
__device__ __forceinline__ void grid_barrier(unsigned* bar, unsigned target) {
  asm volatile("s_waitcnt vmcnt(0)" ::: "memory");
  __syncthreads();
  if (threadIdx.x == 0) {
    __builtin_amdgcn_fence(__ATOMIC_RELEASE, "agent");
    asm volatile("s_waitcnt vmcnt(0)" ::: "memory");
    __hip_atomic_fetch_add(bar, 1u, __ATOMIC_RELAXED, __HIP_MEMORY_SCOPE_AGENT);
    while (__hip_atomic_load(bar, __ATOMIC_RELAXED, __HIP_MEMORY_SCOPE_AGENT) < target) __builtin_amdgcn_s_sleep(2);
    __builtin_amdgcn_fence(__ATOMIC_ACQUIRE, "agent");
    asm volatile("s_waitcnt vmcnt(0)" ::: "memory");
  }
  __syncthreads();
}
#define WAIT_V(n) asm volatile("s_waitcnt vmcnt(%0)" ::"n"(n) : "memory")
#define SCHED() __builtin_amdgcn_sched_barrier(0)

constexpr float QSCALE = 0.10206207261596575f * 1.4426950408889634f;
enum { EM_PROJ = 0, EM_SQRELU = 1, EM_RESID = 2, EM_RESID_AT = 3, EM_Q = 6, EM_KV = 7 };
struct Epi {
  int mode;
  char* ws;
  const float* gate;
  __device__ __forceinline__ void proj(int row, int col, f32x4 v) const {
    {
      u16* out = (u16*)(ws + WS_PROJ);
#pragma unroll
      for (int j = 0; j < 4; ++j) out[(size_t)(row + j) * DINP + col] = f2bf(v[j]);
    }
  }
  __device__ __forceinline__ void sqrelu(int row, int col, f32x4 v) const {
    {
      u16* out = (u16*)(ws + WS_PROJ);
#pragma unroll
      for (int j = 0; j < 4; ++j) { float r = fmaxf(v[j], 0.f); out[(size_t)(row + j) * DFF + col] = f2bf(r * r); }
    }
  }
  __device__ __forceinline__ void resid(int row, int col, f32x4 v) const {
    {
      float* h = (float*)(ws + WS_H);
      float g = gate[grp_of_row(row) * 6144 + col];
#pragma unroll
      for (int j = 0; j < 4; ++j) unsafeAtomicAdd(h + (size_t)(row + j) * D + col, g * v[j]);
    }
  }
  __device__ __forceinline__ void q(int row, int col, f32x4 v) const {
    {
      u16* Q = (u16*)(ws + WS_Q);
      const float2* rope = (const float2*)(ws + WS_ROPE);
      int head = col / 96, d = col - head * 96;
      int b = row / SP, pos0 = row - b * SP;
      bool isrope = (d >= 64) && (pos0 >= CTX);
      int rd = d - 64;
#pragma unroll
      for (int j = 0; j < 4; ++j) {
        float val = v[j];
        float partner = __shfl_xor(val, 8);
        int pos = pos0 + j;
        if (isrope) {
          int t = pos - CTX, idx = (rd < 16) ? (t >> 6) : (t & 63);
          float2 cs = rope[idx * 8 + (rd & 7)];
          float sgn = (rd & 8) ? 1.f : -1.f;
          val = val * cs.x + sgn * partner * cs.y;
        }
        Q[((size_t)(b * 8 + head) * SP + pos) * 96 + d] = f2bf(val * QSCALE);
      }
    }
  }
  __device__ __forceinline__ void kv(int row, int col, f32x4 v) const {
    {
      u16* Kb = (u16*)(ws + WS_K);
      u16* Vt = (u16*)(ws + WS_VT);
      int head = col >> 7, j2 = col & 127;
      int b = row / SP, pos0 = row - b * SP;
      if (j2 < 64) {
#pragma unroll
        for (int j = 0; j < 4; ++j) Kb[((size_t)(b * 8 + head) * SP + pos0 + j) * 96 + j2] = f2bf(v[j]);
      } else {
        uint2 o;
        o.x = pk2(v[0], v[1]);
        o.y = pk2(v[2], v[3]);
        *(uint2*)(Vt + ((size_t)(b * 8 + head) * 64 + (j2 - 64)) * SP + pos0) = o;
      }
    }
  }
};
struct GD { const u16* A; int lda; const u16* Bt; int ldb; int K; int nN; int mode; int ks; };

constexpr int G_TILE_B = 256 * 64 * 2, G_STAGE_B = 2 * G_TILE_B;
__device__ __forceinline__ int lds_byte(int r, int c) {
  int st = (r >> 4) * 2 + (c >> 5), ob = (r & 15) * 64 + (c & 31) * 2;
  return st * 1024 + (ob ^ (((ob >> 9) & 1) << 5));
}
__device__ __forceinline__ void stage_rc(int b, int& R, int& C) {
  int st = b >> 10, sb = b & 1023, swz = sb ^ (((sb >> 9) & 1) << 5);
  R = (st / 2) * 16 + swz / 64;
  C = (st % 2) * 32 + (swz % 64) / 2;
}

template <int MI>
__device__ __forceinline__ void gemm_core(const u16* __restrict__ A, int lda, const u16* __restrict__ Bt, int ldb, int K,
                                          int brow, int bcol, char* shm, f32x4 (&acc)[MI][4]) {
  constexpr int TILE_A = MI * 32 * 64 * 2, TILE_BB = 256 * 64 * 2, STAGE = TILE_A + TILE_BB;
  const int tid = tid_l(), wid = tid >> 6, lane = tid & 63, wr = wid >> 2, wc = wid & 3, fr = lane & 15, fq = lane >> 4;
  const u16* Ab = A + (size_t)brow * lda;
  const u16* Bb = Bt + (size_t)bcol * ldb;
  int sR[4], sC[4];
#pragma unroll
  for (int i = 0; i < 4; ++i) stage_rc(wid * 1024 + i * 8192 + lane * 16, sR[i], sC[i]);
#define SA(b) (shm + (b) * STAGE)
#define SB(b) (shm + (b) * STAGE + TILE_A)
#define GLDS_STAGE(buf, kt)                                                                                              \
  do {                                                                                                                   \
    _Pragma("unroll") for (int i = 0; i < 4; ++i) {                                                                      \
      if (i < MI / 2)                                                                                                    \
        __builtin_amdgcn_global_load_lds((const unsigned*)(Ab + (size_t)sR[i] * lda + (kt) * 64 + sC[i]),                \
                                         (unsigned*)(SA(buf) + wid * 1024 + i * 8192), 16, 0, 0);                        \
      __builtin_amdgcn_global_load_lds((const unsigned*)(Bb + (size_t)sR[i] * ldb + (kt) * 64 + sC[i]),                  \
                                       (unsigned*)(SB(buf) + wid * 1024 + i * 8192), 16, 0, 0);                          \
    }                                                                                                                    \
  } while (0)
  const int nt = K / 64;
  GLDS_STAGE(0, 0);
  WAIT_V(0);
  __syncthreads();
  for (int t = 0; t < nt; ++t) {
    const int cur = t & 1;
    if (t + 1 < nt) GLDS_STAGE(cur ^ 1, t + 1);
#pragma unroll
    for (int ks = 0; ks < 2; ++ks) {
      bf16x8 At[MI], Bf[4];
#pragma unroll
      for (int m = 0; m < MI; ++m) At[m] = *(const bf16x8*)(SA(cur) + lds_byte(wr * (MI * 16) + m * 16 + fr, ks * 32 + fq * 8));
#pragma unroll
      for (int n = 0; n < 4; ++n) Bf[n] = *(const bf16x8*)(SB(cur) + lds_byte(wc * 64 + n * 16 + fr, ks * 32 + fq * 8));
#pragma unroll
      for (int m = 0; m < MI; ++m)
#pragma unroll
        for (int n = 0; n < 4; ++n) acc[m][n] = __builtin_amdgcn_mfma_f32_16x16x32_bf16(At[m], Bf[n], acc[m][n], 0, 0, 0);
      SCHED();
    }
    WAIT_V(0);
    __syncthreads();
  }
#undef SA
#undef SB
#undef GLDS_STAGE
}

template <class EpiT>
__device__ __forceinline__ void gemm_tile(const u16* __restrict__ A, int lda, const u16* __restrict__ Bt, int ldb, int K,
                                          int brow, int bcol, char* shm, const EpiT& epi) {
  const int tid = tid_l(), wid = tid >> 6, lane = tid & 63, wr = wid >> 2, wc = wid & 3, fr = lane & 15, fq = lane >> 4;
  f32x4 acc[8][4];
#pragma unroll
  for (int m = 0; m < 8; ++m)
#pragma unroll
    for (int n = 0; n < 4; ++n) acc[m][n] = (f32x4){0.f, 0.f, 0.f, 0.f};
  gemm_core<8>(A, lda, Bt, ldb, K, brow, bcol, shm, acc);
#define EPI_LOOP(CALL)                                                                              \
  _Pragma("unroll") for (int m = 0; m < 8; ++m) _Pragma("unroll") for (int n = 0; n < 4; ++n) {      \
    const int row = brow + wr * 128 + m * 16 + fq * 4, col = bcol + wc * 64 + n * 16 + fr;           \
    const f32x4 v = acc[m][n];                                                                        \
    CALL;                                                                                             \
  }
  if (epi.mode == EM_PROJ) { EPI_LOOP(epi.proj(row, col, v)) }
  else if (epi.mode == EM_SQRELU) { EPI_LOOP(epi.sqrelu(row, col, v)) }
  else if (epi.mode == EM_RESID_AT) { EPI_LOOP(epi.resid(row, col, v)) }
  else if (epi.mode == EM_RESID) {
    float* h = (float*)(epi.ws + WS_H);
    float g4[4];
#pragma unroll
    for (int n = 0; n < 4; ++n) g4[n] = epi.gate[grp_of_row(brow) * 6144 + bcol + wc * 64 + n * 16 + fr];
#pragma unroll
    for (int m = 0; m < 8; ++m) {
      float hv[4][4];
      float* hp = h + (size_t)(brow + wr * 128 + m * 16 + fq * 4) * D + bcol + wc * 64 + fr;
#pragma unroll
      for (int n = 0; n < 4; ++n)
#pragma unroll
        for (int j = 0; j < 4; ++j) hv[n][j] = hp[(size_t)j * D + n * 16];
#pragma unroll
      for (int n = 0; n < 4; ++n)
#pragma unroll
        for (int j = 0; j < 4; ++j) hp[(size_t)j * D + n * 16] = hv[n][j] + g4[n] * acc[m][n][j];
    }
  }
  else if (epi.mode == EM_Q) { EPI_LOOP(epi.q(row, col, v)) }
  else { EPI_LOOP(epi.kv(row, col, v)) }
#undef EPI_LOOP
}

__device__ __forceinline__ void mix_tile(const Ctx& p, int pm, int pn, char* shm) {
  constexpr int TILE_A = 128 * 64 * 2, TILE_BB = 256 * 64 * 2, STAGE = TILE_A + TILE_BB;
  const int tid = tid_l(), wid = tid >> 6, lane = tid & 63, wr = wid >> 2, wc = wid & 3, fr = lane & 15, fq = lane >> 4;
  const int brow = pm * 128, bcol = pn * 256;
  const u16* projb = (const u16*)(p.ws + WS_PROJ);
  char* wo = (char*)p.out;
  int sR[4], sC[4];
#pragma unroll
  for (int i = 0; i < 4; ++i) stage_rc(wid * 1024 + i * 8192 + lane * 16, sR[i], sC[i]);
#define SA(b) (shm + (b) * STAGE)
#define SB(b) (shm + (b) * STAGE + TILE_A)
#define MIX_STAGE(buf, kt)                                                                                               \
  do {                                                                                                                   \
    const int br_ = (kt) >> 3, ko_ = ((kt) & 7) * 64;                                                                    \
    const u16* Ab_ = (const u16*)(p.ws + (br_ == 0 ? WS_U : br_ == 1 ? WS_Y : WS_O)) + (size_t)brow * 512 + ko_;         \
    const u16* Bb_ = (const u16*)(wo + (br_ == 0 ? WO_PE : br_ == 1 ? WO_HY : WO_WO)) + (size_t)bcol * 512 + ko_;        \
    _Pragma("unroll") for (int i = 0; i < 4; ++i) {                                                                      \
      if (i < 2)                                                                                                         \
        __builtin_amdgcn_global_load_lds((const unsigned*)(Ab_ + (size_t)sR[i] * 512 + sC[i]),                           \
                                         (unsigned*)(SA(buf) + wid * 1024 + i * 8192), 16, 0, 0);                        \
      __builtin_amdgcn_global_load_lds((const unsigned*)(Bb_ + (size_t)sR[i] * 512 + sC[i]),                             \
                                       (unsigned*)(SB(buf) + wid * 1024 + i * 8192), 16, 0, 0);                          \
    }                                                                                                                    \
  } while (0)
  f32x4 tot[4][4], acc[4][4];
#pragma unroll
  for (int m = 0; m < 4; ++m)
#pragma unroll
    for (int n = 0; n < 4; ++n) { tot[m][n] = (f32x4){0.f, 0.f, 0.f, 0.f}; acc[m][n] = (f32x4){0.f, 0.f, 0.f, 0.f}; }
  MIX_STAGE(0, 0);
  WAIT_V(0);
  __syncthreads();
#pragma unroll 1
  for (int t = 0; t < 24; ++t) {
    const int cur = t & 1;
    if (t + 1 < 24) MIX_STAGE(cur ^ 1, t + 1);
#pragma unroll
    for (int ks = 0; ks < 2; ++ks) {
      bf16x8 At[4], Bf[4];
#pragma unroll
      for (int m = 0; m < 4; ++m) At[m] = *(const bf16x8*)(SA(cur) + lds_byte(wr * 64 + m * 16 + fr, ks * 32 + fq * 8));
#pragma unroll
      for (int n = 0; n < 4; ++n) Bf[n] = *(const bf16x8*)(SB(cur) + lds_byte(wc * 64 + n * 16 + fr, ks * 32 + fq * 8));
#pragma unroll
      for (int m = 0; m < 4; ++m)
#pragma unroll
        for (int n = 0; n < 4; ++n) acc[m][n] = __builtin_amdgcn_mfma_f32_16x16x32_bf16(At[m], Bf[n], acc[m][n], 0, 0, 0);
      SCHED();
    }
    if ((t & 7) == 7) {
      const int br = t >> 3;
      const u16* gp = projb + (size_t)(brow + wr * 64 + fq * 4) * DINP + OFF_GATE + br * 1024 + bcol + wc * 64 + fr;
#pragma unroll
      for (int m = 0; m < 4; ++m) {
        u16 gt[4][4];
#pragma unroll
        for (int n = 0; n < 4; ++n)
#pragma unroll
          for (int j = 0; j < 4; ++j) gt[n][j] = gp[(size_t)(m * 16 + j) * DINP + n * 16];
#pragma unroll
        for (int n = 0; n < 4; ++n)
#pragma unroll
          for (int j = 0; j < 4; ++j) {
            tot[m][n][j] += acc[m][n][j] / (1.f + __expf(-bf2f(gt[n][j])));
            acc[m][n][j] = 0.f;
          }
      }
    }
    WAIT_V(0);
    __syncthreads();
  }
  u16* mixb = (u16*)(p.ws + WS_ZV);
#pragma unroll
  for (int m = 0; m < 4; ++m)
#pragma unroll
    for (int n = 0; n < 4; ++n)
#pragma unroll
      for (int j = 0; j < 4; ++j)
        mixb[(size_t)(brow + wr * 64 + m * 16 + fq * 4 + j) * D + bcol + wc * 64 + n * 16 + fr] = f2bf(tot[m][n][j]);
#undef SA
#undef SB
#undef MIX_STAGE
}

__device__ __forceinline__ void tile_map(int t, int nM, int nN, int& pm, int& pn) {
  int nwg = nM * nN, wgid = t;
  {
    int q = nwg / 8, r = nwg % 8, xcd = wgid % 8, off = wgid / 8;
    wgid = (xcd < r ? xcd * (q + 1) : r * (q + 1) + (xcd - r) * q) + off;
  }
  int nig = 8 * nN, gid = wgid / nig, fm = gid * 8, gsz = min(nM - fm, 8);
  pm = fm + ((wgid % nig) % gsz);
  pn = (wgid % nig) / gsz;
}

__device__ __forceinline__ void p0_misc(const Ctx& p) {
  const int gtid = blockIdx.x * NT + tid_l(), gn = gridDim.x * NT;
  float4* h4 = (float4*)(p.ws + WS_H);
  const float4* x4 = (const float4*)pin(p, 0);
  const float4* c4 = (const float4*)pin(p, 2);
  for (int i = gtid; i < MROWS * 256; i += gn) {
    int m = i >> 8, q = i & 255, b = m / SP, pos = m - b * SP;
    float4 v = (pos < CTX) ? c4[(size_t)(b * CTX + pos) * 256 + q] : x4[(size_t)(b * SEQ + pos - CTX) * 256 + q];
    h4[i] = v;
  }
  float2* rope = (float2*)(p.ws + WS_ROPE);
  for (int i = gtid; i < 1024; i += gn) {
    int idx = i >> 3, f = i & 7;
    float inv = powf(10000.f, -(float)f / 8.f);
    float a = (float)idx * inv;
    rope[i] = make_float2(cosf(a), sinf(a));
  }
  float2* tw = (float2*)(p.ws + WS_TW);
  for (int i = gtid; i < 16384; i += gn) {
    float s, c;
    sincospif(-(float)i / 8192.f, &s, &c);
    tw[i] = make_float2(c, s);
  }
}

__device__ __forceinline__ void p0_mod_task(const Ctx& p, int task, char* smem) {
  float* s = (float*)smem;
  float* red = s + 3072;
  const int tid = tid_l();
  const int l = task / 48, chunk = task - l * 48;
  for (int i = tid; i < 3072; i += NT) {
    int g = i >> 10, k = i & 1023;
    float cv = (g < 2) ? pin(p, 1)[g * 1024 + k] : pin(p, 3)[k];
    s[i] = cv / (1.f + __expf(-cv));
  }
  __syncthreads();
  const int kq = tid >> 7, col = tid & 127, n = chunk * 128 + col;
  const float* W = pin(p, 4) + (size_t)l * 1024 * 6144 + n;
  float a0 = 0.f, a1 = 0.f, a2 = 0.f;
#pragma unroll 8
  for (int k = kq * 256; k < kq * 256 + 256; ++k) {
    float w = W[(size_t)k * 6144];
    a0 += s[k] * w; a1 += s[1024 + k] * w; a2 += s[2048 + k] * w;
  }
  red[(kq * 3 + 0) * 128 + col] = a0;
  red[(kq * 3 + 1) * 128 + col] = a1;
  red[(kq * 3 + 2) * 128 + col] = a2;
  __syncthreads();
  if (tid < 384) {
    int g = tid >> 7, c2 = tid & 127, n2 = chunk * 128 + c2;
    float v = red[(0 * 3 + g) * 128 + c2] + red[(1 * 3 + g) * 128 + c2] + red[(2 * 3 + g) * 128 + c2] + red[(3 * 3 + g) * 128 + c2];
    ((float*)(p.ws + WS_MOD))[(size_t)(l * 3 + g) * 6144 + n2] = v + pin(p, 5)[l * 6144 + n2];
  }
  __syncthreads();
}

__device__ __forceinline__ void p0_hid_task(const Ctx& p, int task, char* smem) {
  float* zs = (float*)smem;
  float* h1 = zs + 8 * 36;
  float* w1s = h1 + 8 * 64;
  float* w2s = w1s + 33 * 64;
  const int tid = tid_l(), tl = tid >> 6, j = tid & 63;
  const int l = task / 132, r = task - l * 132;
  const bool isctx = r >= 128;
  const int L = isctx ? 256 : 8192;
  const int tbase = (isctx ? (r - 128) : r) * 64;
  for (int i = tid; i < 33 * 64; i += NT) w1s[i] = pin(p, 14)[l * 33 * 64 + i];
  for (int i = tid; i < 64 * 64; i += NT) w2s[i] = pin(p, 17)[l * 64 * 64 + i];
  const float b1 = pin(p, 15)[l * 64 + j], f1 = pin(p, 16)[l * 64 + j], b2 = pin(p, 18)[l * 64 + j], f2 = pin(p, 19)[l * 64 + j];
  __syncthreads();
  for (int sub = 0; sub < 8; ++sub) {
    const int t = tbase + sub * 8 + tl;
    if (j < 33) {
      float z;
      if (j == 0) z = (float)t / (float)(L - 1);
      else {
        int i = (j - 1) & 15;
        float band = 1e-4f + (float)i * ((15.f - 1e-4f) / 15.f);
        float omega = 6.2831855f * (float)t / (float)L;
        float a = omega * band;
        z = (j <= 16) ? cosf(a) : -sinf(a);
      }
      zs[tl * 36 + j] = z;
    }
    __syncthreads();
    {
      float a = b1;
#pragma unroll
      for (int k = 0; k < 33; ++k) a += zs[tl * 36 + k] * w1s[k * 64 + j];
      h1[tl * 64 + j] = sinf(f1 * a);
    }
    __syncthreads();
    {
      float a = b2;
#pragma unroll 16
      for (int k = 0; k < 64; ++k) a += h1[tl * 64 + k] * w2s[k * 64 + j];
      float v = sinf(f2 * a);
      float* dst = isctx ? (float*)(p.ws + WS_HID2C) + ((size_t)l * 64 + j) * 256 + t : (float*)(p.ws + WS_HID2) + ((size_t)l * 64 + j) * 8192 + t;
      dst[0] = v;
    }
  }
  __syncthreads();
}

__device__ __forceinline__ void wt_task(const float* __restrict__ W, int K, int N, u16* __restrict__ WT, int item, int nblkN, char* smem) {
  float* tile = (float*)smem;
  const int tid = tid_l();
  const int kb = item / nblkN, nb = item - kb * nblkN, k0 = kb * 64, n0 = nb * 64;
#pragma unroll
  for (int r = 0; r < 8; ++r) {
    int kk = r * 8 + (tid >> 6), nn = tid & 63;
    float v = (n0 + nn < N) ? W[(size_t)(k0 + kk) * N + n0 + nn] : 0.f;
    tile[kk * 65 + nn] = v;
  }
  __syncthreads();
  {
    int n = tid >> 3, kc = (tid & 7) * 8;
    uint4 o;
    o.x = pk2(tile[(kc + 0) * 65 + n], tile[(kc + 1) * 65 + n]);
    o.y = pk2(tile[(kc + 2) * 65 + n], tile[(kc + 3) * 65 + n]);
    o.z = pk2(tile[(kc + 4) * 65 + n], tile[(kc + 5) * 65 + n]);
    o.w = pk2(tile[(kc + 6) * 65 + n], tile[(kc + 7) * 65 + n]);
    *(uint4*)(WT + (size_t)(n0 + n) * K + k0 + kc) = o;
  }
  __syncthreads();
}

__device__ __forceinline__ void wpe_task(const Ctx& p, int l, int task, char* smem) {
  const int g = task >> 3, c0 = (task & 7) * 16, tid = tid_l();
  const float* pw = pin(p, 9) + ((size_t)(l * 4 + g) * 128) * 128;
  const float* sc = pin(p, 10) + l * 512 + g * 128;
  const float* po = pin(p, 11) + ((size_t)l * 512 + g * 128) * 1024;
  u16* WpeT = (u16*)((char*)p.out + WO_PE);
  float* wl = (float*)smem;
  for (int i = tid; i < 16 * 128; i += NT) { int d = i & 127; wl[i] = pw[(c0 + (i >> 7)) * 128 + d] * sc[d]; }
  __syncthreads();
  float acc0[16], acc1[16];
#pragma unroll
  for (int i = 0; i < 16; ++i) { acc0[i] = 0.f; acc1[i] = 0.f; }
#pragma unroll 4
  for (int d = 0; d < 128; ++d) {
    float p0 = po[(size_t)d * 1024 + tid], p1 = po[(size_t)d * 1024 + 512 + tid];
#pragma unroll
    for (int i = 0; i < 16; ++i) { float w = wl[i * 128 + d]; acc0[i] += w * p0; acc1[i] += w * p1; }
  }
  uint4 o0, o1;
  o0.x = pk2(acc0[0], acc0[1]); o0.y = pk2(acc0[2], acc0[3]); o0.z = pk2(acc0[4], acc0[5]); o0.w = pk2(acc0[6], acc0[7]);
  o1.x = pk2(acc0[8], acc0[9]); o1.y = pk2(acc0[10], acc0[11]); o1.z = pk2(acc0[12], acc0[13]); o1.w = pk2(acc0[14], acc0[15]);
  uint4* dst = (uint4*)(WpeT + (size_t)tid * 512 + g * 128 + c0);
  dst[0] = o0; dst[1] = o1;
  o0.x = pk2(acc1[0], acc1[1]); o0.y = pk2(acc1[2], acc1[3]); o0.z = pk2(acc1[4], acc1[5]); o0.w = pk2(acc1[6], acc1[7]);
  o1.x = pk2(acc1[8], acc1[9]); o1.y = pk2(acc1[10], acc1[11]); o1.z = pk2(acc1[12], acc1[13]); o1.w = pk2(acc1[14], acc1[15]);
  dst = (uint4*)(WpeT + (size_t)(512 + tid) * 512 + g * 128 + c0);
  dst[0] = o0; dst[1] = o1;
  __syncthreads();
}

__device__ __forceinline__ void norm_rows(const Ctx& p, const float* gain, const float* modl, int sh_idx, int sc_idx, u16* outp) {
  const int tidx = tid_l(), lane = tidx & 63, gw = blockIdx.x * 8 + (tidx >> 6), ngw = gridDim.x * 8;
  const float* h = (const float*)(p.ws + WS_H);
  for (int m = gw; m < MROWS; m += ngw) {
    const float4* hr = (const float4*)(h + (size_t)m * D) + lane;
    float4 v[4];
    float ss = 0.f;
#pragma unroll
    for (int j = 0; j < 4; ++j) { v[j] = hr[64 * j]; ss += v[j].x * v[j].x + v[j].y * v[j].y + v[j].z * v[j].z + v[j].w * v[j].w; }
    ss = wave_sum(ss);
    float r = rsqrtf(ss * (1.f / D) + EPS);
    const float* mg = modl + grp_of_row(m) * 6144;
    uint2* o8 = (uint2*)(outp + (size_t)m * D) + lane;
#pragma unroll
    for (int j = 0; j < 4; ++j) {
      int n = lane * 4 + 256 * j;
      float4 g = *(const float4*)(gain + n), sc = *(const float4*)(mg + sc_idx * 1024 + n), sh = *(const float4*)(mg + sh_idx * 1024 + n);
      uint2 o;
      o.x = pk2(v[j].x * r * g.x * (1.f + sc.x) + sh.x, v[j].y * r * g.y * (1.f + sc.y) + sh.y);
      o.y = pk2(v[j].z * r * g.z * (1.f + sc.z) + sh.z, v[j].w * r * g.w * (1.f + sc.w) + sh.w);
      o8[64 * j] = o;
    }
  }
}

__device__ __forceinline__ void final_norm(const Ctx& p) {
  const int tidx = tid_l(), lane = tidx & 63, gw = blockIdx.x * 8 + (tidx >> 6), ngw = gridDim.x * 8;
  const float* h = (const float*)(p.ws + WS_H);
  const float* gain = pin(p, 32);
  for (int r0 = gw; r0 < 2 * SEQ; r0 += ngw) {
    int b = r0 >> 13, t = r0 & 8191, m = b * SP + CTX + t;
    const float4* hr = (const float4*)(h + (size_t)m * D) + lane;
    float4 v[4];
    float ss = 0.f;
#pragma unroll
    for (int j = 0; j < 4; ++j) { v[j] = hr[64 * j]; ss += v[j].x * v[j].x + v[j].y * v[j].y + v[j].z * v[j].z + v[j].w * v[j].w; }
    ss = wave_sum(ss);
    float r = rsqrtf(ss * (1.f / D) + EPS);
    float4* o = (float4*)(p.out + (size_t)r0 * D) + lane;
#pragma unroll
    for (int j = 0; j < 4; ++j) {
      float4 g = *(const float4*)(gain + lane * 4 + 256 * j);
      o[64 * j] = make_float4(v[j].x * r * g.x, v[j].y * r * g.y, v[j].z * r * g.z, v[j].w * r * g.w);
    }
  }
}

__device__ __forceinline__ void premix_task(const Ctx& p, int l, int task, char* smem) {
  const int tid = tid_l(), lane = tid & 63, wid = tid >> 6;
  const int part = task / 264, tile64 = task - part * 264;
  const int m0 = tile64 * 64, b = m0 / SP, pos0 = m0 - b * SP;
  const bool isctx = pos0 < CTX;
  const int s0 = isctx ? 0 : CTX, L = isctx ? CTX : SEQ, t0 = pos0 - s0;
  const size_t mb = (size_t)b * SP + s0;
  const u16* proj = (const u16*)(p.ws + WS_PROJ);
  if (part == 0) {
    u16* P = (u16*)smem;
    for (int i = tid; i < 80 * 64; i += NT) {
      int r = i >> 6, ch = i & 63, t = t0 - 8 + r;
      uint4 v = make_uint4(0, 0, 0, 0);
      if (t >= 0 && t < L) v = *(const uint4*)(proj + (mb + t) * DINP + ch * 8);
      *(uint4*)(P + r * 512 + ch * 8) = v;
    }
    __syncthreads();
    const int c = tid, g = c >> 7, hw = 1 << g;
    u16* U = (u16*)(p.ws + WS_U);
    float s = 0.f;
    for (int q = -hw; q < hw; ++q) s += bf2f(P[(8 + q) * 512 + c]);
#pragma unroll 4
    for (int tt = 0; tt < 64; ++tt) {
      int t = t0 + tt, lo = max(t - hw, 0), hi = min(t + hw, L);
      float u = s / (float)(hi - lo) - bf2f(P[(tt + 8) * 512 + c]);
      U[(mb + t) * 512 + c] = f2bf(u);
      s += bf2f(P[(tt + 8 + hw) * 512 + c]) - bf2f(P[(tt + 8 - hw) * 512 + c]);
    }
    __syncthreads();
  } else if (part <= 4) {
    const int ch0 = (part - 1) * 128;
    constexpr int PITCH = 136;
    u16* X = (u16*)smem;
    float* T = (float*)(smem + 3 * 66 * PITCH * 2 + 64);
    for (int i = tid; i < 3 * 66 * 16; i += NT) {
      int pr = i / (66 * 16), rem = i - pr * 66 * 16, r = rem >> 4, ch = rem & 15, t = t0 - 1 + r;
      uint4 v = make_uint4(0, 0, 0, 0);
      if (t >= 0 && t < L) v = *(const uint4*)(proj + (mb + t) * DINP + OFF_HY + pr * 512 + ch0 + ch * 8);
      *(uint4*)(X + (pr * 66 + r) * PITCH + ch * 8) = v;
    }
    __syncthreads();
    const float* cw = pin(p, 12) + l * 3 * 1536;
    const float* cb = pin(p, 13) + l * 1536;
    {
      const int c = tid & 127, tq = tid >> 7, col = ch0 + c;
      const float w00 = cw[col], w01 = cw[1536 + col], w02 = cw[3072 + col], b0 = cb[col];
      const float w10 = cw[512 + col], w11 = cw[1536 + 512 + col], w12 = cw[3072 + 512 + col], b1 = cb[512 + col];
      const float w20 = cw[1024 + col], w21 = cw[1536 + 1024 + col], w22 = cw[3072 + 1024 + col], b2 = cb[1024 + col];
      const u16* X0 = X, *X1 = X + 66 * PITCH, *XV = X + 2 * 66 * PITCH;
      u16* Y = (u16*)(p.ws + WS_Y);
#pragma unroll 4
      for (int tt = tq * 16; tt < tq * 16 + 16; ++tt) {
        float x0 = w00 * bf2f(X0[tt * PITCH + c]) + w01 * bf2f(X0[(tt + 1) * PITCH + c]) + w02 * bf2f(X0[(tt + 2) * PITCH + c]) + b0;
        float x1 = w10 * bf2f(X1[tt * PITCH + c]) + w11 * bf2f(X1[(tt + 1) * PITCH + c]) + w12 * bf2f(X1[(tt + 2) * PITCH + c]) + b1;
        float vv = w20 * bf2f(XV[tt * PITCH + c]) + w21 * bf2f(XV[(tt + 1) * PITCH + c]) + w22 * bf2f(XV[(tt + 2) * PITCH + c]) + b2;
        Y[(mb + t0 + tt) * 512 + col] = f2bf(x0);
        T[c * 65 + tt] = x1 * vv;
      }
    }
    __syncthreads();
    {
      float* ZV = (float*)(p.ws + WS_ZV);
#pragma unroll 4
      for (int cc = 0; cc < 16; ++cc) {
        int c = wid * 16 + cc;
        ZV[((size_t)(ch0 + c) * SP + pos0 + lane) * 2 + b] = T[c * 65 + lane];
      }
    }
    __syncthreads();
  } else {
    u16* projw = (u16*)(p.ws + WS_PROJ);
    const float* qg = pin(p, 24) + l * 384;
    const float* kg = pin(p, 26) + l * 256;
    const float2* rope = (const float2*)(p.ws + WS_ROPE);
    u16* Kb = (u16*)(p.ws + WS_K);
#pragma unroll 2
    for (int rr = 0; rr < 8; ++rr) {
      int tt = wid * 8 + rr, pos = pos0 + tt;
      u16* row = projw + ((size_t)b * SP + pos) * DINP;
      unsigned* q32 = (unsigned*)(row + OFF_Q);
      unsigned* k32 = (unsigned*)(row + OFF_KV);
      unsigned v[3], w[2];
      float ss = 0.f, s2 = 0.f;
#pragma unroll
      for (int j = 0; j < 3; ++j) v[j] = q32[lane + 64 * j];
#pragma unroll
      for (int j = 0; j < 2; ++j) w[j] = k32[lane + 64 * j];
      const int rd = lane & 31;
      float val = bf2f(row[OFF_KV + 256 + rd]);
#pragma unroll
      for (int j = 0; j < 3; ++j) { float a = bf2f(v[j] & 0xffff), c2 = bf2f(v[j] >> 16); ss += a * a + c2 * c2; }
#pragma unroll
      for (int j = 0; j < 2; ++j) { float a = bf2f(w[j] & 0xffff), c2 = bf2f(w[j] >> 16); s2 += a * a + c2 * c2; }
      ss = wave_sum(ss);
      s2 = wave_sum(s2);
      float r = rsqrtf(ss * (1.f / 384.f) + EPS), r2 = rsqrtf(s2 * (1.f / 256.f) + EPS);
#pragma unroll
      for (int j = 0; j < 3; ++j) {
        int n = (lane + 64 * j) * 2;
        q32[lane + 64 * j] = pk2(bf2f(v[j] & 0xffff) * r * qg[n], bf2f(v[j] >> 16) * r * qg[n + 1]);
      }
#pragma unroll
      for (int j = 0; j < 2; ++j) {
        int n = (lane + 64 * j) * 2;
        k32[lane + 64 * j] = pk2(bf2f(w[j] & 0xffff) * r2 * kg[n], bf2f(w[j] >> 16) * r2 * kg[n + 1]);
      }
      float partner = __shfl_xor(val, 8);
      if (!isctx) {
        int t = pos - CTX, idx = (rd < 16) ? (t >> 6) : (t & 63);
        float2 cs = rope[idx * 8 + (rd & 7)];
        float sgn = (rd & 8) ? 1.f : -1.f;
        val = val * cs.x + sgn * partner * cs.y;
      }
      if (lane < 32) {
        u16 o = f2bf(val);
#pragma unroll
        for (int hd = 0; hd < 8; ++hd) Kb[((size_t)(b * 8 + hd) * SP + pos) * 96 + 64 + rd] = o;
      }
    }
  }
}

__device__ __forceinline__ void bf_fwd(float2* X, int base, int q, float2 w1) {
  float2 w2 = cmul(w1, w1), w3 = cmul(w2, w1);
  float2 a0 = X[base], a1 = X[base + q], a2 = X[base + 2 * q], a3 = X[base + 3 * q];
  float2 s02 = make_float2(a0.x + a2.x, a0.y + a2.y), d02 = make_float2(a0.x - a2.x, a0.y - a2.y);
  float2 s13 = make_float2(a1.x + a3.x, a1.y + a3.y), d13 = make_float2(a1.x - a3.x, a1.y - a3.y);
  X[base] = make_float2(s02.x + s13.x, s02.y + s13.y);
  X[base + q] = cmul(make_float2(d02.x + d13.y, d02.y - d13.x), w1);
  X[base + 2 * q] = cmul(make_float2(s02.x - s13.x, s02.y - s13.y), w2);
  X[base + 3 * q] = cmul(make_float2(d02.x - d13.y, d02.y + d13.x), w3);
}
__device__ __forceinline__ void bf_inv(float2* X, int base, int q, float2 w1) {
  w1.y = -w1.y;
  float2 w2 = cmul(w1, w1), w3 = cmul(w2, w1);
  float2 b0 = X[base], c1 = cmul(X[base + q], w1), c2 = cmul(X[base + 2 * q], w2), c3 = cmul(X[base + 3 * q], w3);
  float2 s02 = make_float2(b0.x + c2.x, b0.y + c2.y), d02 = make_float2(b0.x - c2.x, b0.y - c2.y);
  float2 s13 = make_float2(c1.x + c3.x, c1.y + c3.y), d13 = make_float2(c1.x - c3.x, c1.y - c3.y);
  X[base] = make_float2(s02.x + s13.x, s02.y + s13.y);
  X[base + q] = make_float2(d02.x - d13.y, d02.y + d13.x);
  X[base + 2 * q] = make_float2(s02.x - s13.x, s02.y - s13.y);
  X[base + 3 * q] = make_float2(d02.x + d13.y, d02.y - d13.x);
}
template <bool INV>
__device__ __forceinline__ void fft_pass(float2* X, const float2* __restrict__ tw, int lq, int tid) {
  const int q = 1 << lq, sh = 12 - lq;
  if (lq == 12) {
    float2 w[8];
#pragma unroll
    for (int b8 = 0; b8 < 8; ++b8) w[b8] = tw[b8 * NT + tid];
#pragma unroll
    for (int b8 = 0; b8 < 8; ++b8) { int u = b8 * NT + tid; if (INV) bf_inv(X, u, q, w[b8]); else bf_fwd(X, u, q, w[b8]); }
  } else if (lq == 10) {
    float2 wA = tw[tid << 2], wB = tw[(512 + tid) << 2];
#pragma unroll 2
    for (int b8 = 0; b8 < 8; ++b8) {
      int u = b8 * NT + tid, j = u & 1023, base = ((u >> 10) << 12) + j;
      float2 w = (b8 & 1) ? wB : wA;
      if (INV) bf_inv(X, base, q, w); else bf_fwd(X, base, q, w);
    }
  } else {
    const int j = tid & (q - 1);
    float2 w = tw[j << sh];
#pragma unroll 2
    for (int b8 = 0; b8 < 8; ++b8) {
      int u = b8 * NT + tid, base = ((u >> lq) << (lq + 2)) + j;
      if (INV) bf_inv(X, base, q, w); else bf_fwd(X, base, q, w);
    }
  }
  __syncthreads();
}
__device__ __forceinline__ void fft_dif(float2* X, const float2* __restrict__ tw) {
  const int tid = tid_l();
  for (int lq = 12; lq >= 0; lq -= 2) fft_pass<false>(X, tw, lq, tid);
}
__device__ __forceinline__ void fft_dit_inv(float2* X, const float2* __restrict__ tw) {
  const int tid = tid_l();
  for (int lq = 0; lq <= 12; lq += 2) fft_pass<true>(X, tw, lq, tid);
}
__device__ __forceinline__ float block_sum(float v, float* red) {
  v = wave_sum(v);
  __syncthreads();
  if ((threadIdx.x & 63) == 0) red[threadIdx.x >> 6] = v;
  __syncthreads();
  float s = red[0] + red[1] + red[2] + red[3] + red[4] + red[5] + red[6] + red[7];
  __syncthreads();
  return s;
}

__device__ __forceinline__ void fft_task(const Ctx& p, int l, int c, char* smem) {
  float2* X = (float2*)smem;
  float* aux = (float*)(smem + 131072);
  float* red = aux + 128;
  const int tid = tid_l();
  const float2* tw = (const float2*)(p.ws + WS_TW);
  const float* w3 = pin(p, 20) + (size_t)l * 64 * 1024;
  if (tid < 64) { aux[tid] = w3[tid * 1024 + c]; aux[64 + tid] = w3[tid * 1024 + 512 + c]; }
  __syncthreads();
  const float dF = fabsf(pin(p, 21)[(l * 2 + 0) * 512 + c]), dB = fabsf(pin(p, 21)[(l * 2 + 1) * 512 + c]);
  const float bias = pin(p, 22)[l * 512 + c];
  float2* zp = (float2*)(p.ws + WS_ZV) + (size_t)c * SP;
  float l1 = 0.f;
  {
    const float* hid = (const float*)(p.ws + WS_HID2) + (size_t)l * 64 * 8192 + tid;
    float af[16], ab[16];
#pragma unroll
    for (int i = 0; i < 16; ++i) { af[i] = 0.f; ab[i] = 0.f; }
#pragma unroll 2
    for (int k = 0; k < 64; ++k) {
      const float wf = aux[k], wb = aux[64 + k];
#pragma unroll
      for (int i = 0; i < 16; ++i) { float v = hid[(size_t)k * 8192 + i * NT]; af[i] += v * wf; ab[i] += v * wb; }
    }
#pragma unroll
    for (int i = 0; i < 16; ++i) {
      int t = i * NT + tid;
      float tl = (float)t * (1.f / 8191.f);
      float hf = af[i] * expf(-tl * dF);
      float hb = ab[i] * expf(-tl * dB);
      X[t] = make_float2(hf, 0.f);
      if (t >= 1) { X[16384 - t] = make_float2(hb, 0.f); l1 += fabsf(hf) + fabsf(hb); }
      else { X[8192] = make_float2(0.f, 0.f); l1 += fabsf(hf); }
    }
  }
  float l1tot = block_sum(l1, red);
  fft_dif(X, tw);
  float2 F[32];
  {
    float s = 1.f / (l1tot * 16384.f);
#pragma unroll
    for (int i = 0; i < 32; ++i) { float2 v = X[i * NT + tid]; F[i] = make_float2(v.x * s, v.y * s); }
  }
  __syncthreads();
#pragma unroll 2
  for (int i = 0; i < 16; ++i) {
    int t = i * NT + tid;
    X[t] = zp[CTX + t];
    X[8192 + t] = make_float2(0.f, 0.f);
  }
  __syncthreads();
  fft_dif(X, tw);
#pragma unroll
  for (int i = 0; i < 32; ++i) { int idx = i * NT + tid; X[idx] = cmul(X[idx], F[i]); }
  __syncthreads();
  fft_dit_inv(X, tw);
#pragma unroll 2
  for (int i = 0; i < 16; ++i) {
    int t = i * NT + tid;
    float2 z = zp[CTX + t], y = X[t];
    zp[CTX + t] = make_float2(y.x + bias * z.x, y.y + bias * z.y);
  }
  __syncthreads();
  {
    float* hFc = (float*)smem;
    float* hBc = hFc + 256;
    float2* zc = (float2*)(hBc + 256);
    float l1c = 0.f;
    if (tid < 256) {
      int t = tid;
      const float* hc = (const float*)(p.ws + WS_HID2C) + (size_t)l * 64 * 256 + t;
      float hf = 0.f, hb = 0.f;
#pragma unroll 8
      for (int k = 0; k < 64; ++k) { float v = hc[k * 256]; hf += v * aux[k]; hb += v * aux[64 + k]; }
      float tl = (float)t * (1.f / 255.f);
      hf *= expf(-tl * dF);
      hb *= expf(-tl * dB);
      hFc[t] = hf;
      hBc[t] = hb;
      l1c = fabsf(hf) + (t >= 1 ? fabsf(hb) : 0.f);
      zc[t] = zp[t];
    }
    float l1ct = block_sum(l1c, red);
    const int bb = tid >> 8, t = tid & 255;
    float acc = 0.f;
    for (int s = 0; s < 256; ++s) {
      float kf = (s <= t) ? hFc[t - s] : hBc[s - t];
      float2 z = zc[s];
      acc += kf * (bb ? z.y : z.x);
    }
    float2 z = zc[t];
    ((float*)zp)[t * 2 + bb] = acc / l1ct + bias * (bb ? z.y : z.x);
    __syncthreads();
  }
}

constexpr int AT_KP = 208, AT_VP = 136, AT_STAGE = 64 * AT_KP + 64 * AT_VP;
__device__ __forceinline__ void attn_task(const Ctx& p, int bh, int qb, char* smem) {
  const int tid = tid_l(), wid = tid >> 6, lane = tid & 63, r = lane & 31, hh = lane >> 5;
  const u16* Qp = (const u16*)(p.ws + WS_Q) + ((size_t)bh * SP + qb * 256) * 96;
  const u16* Kp = (const u16*)(p.ws + WS_K) + (size_t)bh * SP * 96;
  const u16* Vp = (const u16*)(p.ws + WS_VT) + (size_t)bh * 64 * SP;
  const int nkt = (qb == 0) ? 4 : 132;
  bf16x8 qf[6];
#pragma unroll
  for (int ks = 0; ks < 6; ++ks) qf[ks] = *(const bf16x8*)(Qp + (size_t)(wid * 32 + r) * 96 + ks * 16 + hh * 8);
  f32x16 o0, o1;
#pragma unroll
  for (int i = 0; i < 16; ++i) { o0[i] = 0.f; o1[i] = 0.f; }
  float mrun = -1e30f, lrun = 0.f;
  const u16* src[3];
  int dst[3], kstep[3];
#pragma unroll
  for (int i = 0; i < 3; ++i) {
    int ch = tid + i * NT;
    if (ch < 768) { int row = ch / 12, cc = ch - row * 12; src[i] = Kp + (size_t)row * 96 + cc * 8; dst[i] = row * AT_KP + cc * 16; kstep[i] = 64 * 96; }
    else { int v = ch - 768, row = (v >> 3) & 63, cc = v & 7; src[i] = Vp + (size_t)row * SP + cc * 8; dst[i] = 64 * AT_KP + row * AT_VP + cc * 16; kstep[i] = 64; }
  }
  const bool has3 = tid < 256;
  uint4 st[3];
#define AT_LOAD(t)                                                                                   \
  do {                                                                                               \
    st[0] = *(const uint4*)(src[0] + (size_t)(t) * kstep[0]);                                        \
    st[1] = *(const uint4*)(src[1] + (size_t)(t) * kstep[1]);                                        \
    if (has3) st[2] = *(const uint4*)(src[2] + (size_t)(t) * kstep[2]);                              \
  } while (0)
#define AT_WRITE1(i, base)                                                                           \
  do {                                                                                               \
    uint2* d_ = (uint2*)((base) + dst[i]);                                                           \
    d_[0] = make_uint2(st[i].x, st[i].y);                                                            \
    d_[1] = make_uint2(st[i].z, st[i].w);                                                            \
  } while (0)
#define AT_WRITE(buf)                                                                                \
  do {                                                                                               \
    char* base_ = smem + (buf) * AT_STAGE;                                                           \
    AT_WRITE1(0, base_); AT_WRITE1(1, base_);                                                        \
    if (has3) AT_WRITE1(2, base_);                                                                   \
  } while (0)
  AT_LOAD(0);
  AT_WRITE(0);
  __syncthreads();
  for (int t = 0; t < nkt; ++t) {
    const int cur = t & 1;
    if (t + 1 < nkt) AT_LOAD(t + 1);
    const char* Ks = smem + cur * AT_STAGE;
    const char* Vs = Ks + 64 * AT_KP;
    f32x16 s0, s1;
#pragma unroll
    for (int i = 0; i < 16; ++i) { s0[i] = 0.f; s1[i] = 0.f; }
#pragma unroll
    for (int ks = 0; ks < 6; ++ks) {
      bf16x8 a0 = *(const bf16x8*)(Ks + r * AT_KP + ks * 32 + hh * 16);
      bf16x8 a1 = *(const bf16x8*)(Ks + (32 + r) * AT_KP + ks * 32 + hh * 16);
      s0 = __builtin_amdgcn_mfma_f32_32x32x16_bf16(a0, qf[ks], s0, 0, 0, 0);
      s1 = __builtin_amdgcn_mfma_f32_32x32x16_bf16(a1, qf[ks], s1, 0, 0, 0);
    }
    float mx = s0[0];
#pragma unroll
    for (int i = 1; i < 16; ++i) mx = fmaxf(mx, s0[i]);
#pragma unroll
    for (int i = 0; i < 16; ++i) mx = fmaxf(mx, s1[i]);
    mx = fmaxf(mx, __shfl_xor(mx, 32));
    const float mnew = fmaxf(mrun, mx);
    const bool grow = __any(mnew > mrun);
    const float alpha = __builtin_amdgcn_exp2f(mrun - mnew);
    mrun = mnew;
    float ps = 0.f;
#pragma unroll
    for (int i = 0; i < 16; ++i) { s0[i] = __builtin_amdgcn_exp2f(s0[i] - mnew); ps += s0[i]; }
#pragma unroll
    for (int i = 0; i < 16; ++i) { s1[i] = __builtin_amdgcn_exp2f(s1[i] - mnew); ps += s1[i]; }
    lrun = lrun * alpha + ps;
    if (grow) {
#pragma unroll
      for (int i = 0; i < 16; ++i) { o0[i] *= alpha; o1[i] *= alpha; }
    }
#pragma unroll
    for (int kb = 0; kb < 2; ++kb) {
#pragma unroll
      for (int sI = 0; sI < 2; ++sI) {
        union { bf16x8 v; unsigned u[4]; } pu;
#pragma unroll
        for (int j = 0; j < 4; ++j) pu.u[j] = kb == 0 ? pk2(s0[8 * sI + 2 * j], s0[8 * sI + 2 * j + 1]) : pk2(s1[8 * sI + 2 * j], s1[8 * sI + 2 * j + 1]);
        const bf16x8 pf = pu.v;
        const int koff = (kb * 32 + 16 * sI + 4 * hh) * 2;
        union { bf16x8 v; uint2 h2[2]; } va, vb;
        va.h2[0] = *(const uint2*)(Vs + r * AT_VP + koff);
        va.h2[1] = *(const uint2*)(Vs + r * AT_VP + koff + 16);
        vb.h2[0] = *(const uint2*)(Vs + (32 + r) * AT_VP + koff);
        vb.h2[1] = *(const uint2*)(Vs + (32 + r) * AT_VP + koff + 16);
        o0 = __builtin_amdgcn_mfma_f32_32x32x16_bf16(va.v, pf, o0, 0, 0, 0);
        o1 = __builtin_amdgcn_mfma_f32_32x32x16_bf16(vb.v, pf, o1, 0, 0, 0);
      }
    }
    if (t + 1 < nkt) AT_WRITE(cur ^ 1);
    __syncthreads();
  }
  const float ltot = lrun + __shfl_xor(lrun, 32);
  const float inv = 1.f / ltot;
  const int b = bh >> 3, head = bh & 7;
  u16* Op = (u16*)(p.ws + WS_O) + ((size_t)b * SP + qb * 256 + wid * 32 + r) * 512 + head * 64;
#pragma unroll
  for (int g = 0; g < 4; ++g) {
    uint2 w0, w1;
    w0.x = pk2(o0[4 * g] * inv, o0[4 * g + 1] * inv);
    w0.y = pk2(o0[4 * g + 2] * inv, o0[4 * g + 3] * inv);
    w1.x = pk2(o1[4 * g] * inv, o1[4 * g + 1] * inv);
    w1.y = pk2(o1[4 * g + 2] * inv, o1[4 * g + 3] * inv);
    *(uint2*)(Op + 8 * g + 4 * hh) = w0;
    *(uint2*)(Op + 32 + 8 * g + 4 * hh) = w1;
  }
#undef AT_LOAD
#undef AT_WRITE
#undef AT_WRITE1
}

__device__ __forceinline__ void hypost_task(const Ctx& p, int task, char* smem) {
  const int tid = tid_l(), lane = tid & 63, wid = tid >> 6;
  const int tile64 = task >> 1, ch0 = (task & 1) * 256;
  const int m0 = tile64 * 64, b = m0 / SP, pos0 = m0 - b * SP;
  float* T = (float*)smem;
  const float* ZV = (const float*)(p.ws + WS_ZV);
  for (int cc = 0; cc < 32; ++cc) {
    int c = wid * 32 + cc;
    T[c * 65 + lane] = ZV[((size_t)(ch0 + c) * SP + pos0 + lane) * 2 + b];
  }
  __syncthreads();
  u16* Y = (u16*)(p.ws + WS_Y);
  const int c = tid & 255, th = tid >> 8;
  u16* yp = Y + (size_t)(m0 + th * 32) * 512 + ch0 + c;
  u16 yv[32];
#pragma unroll
  for (int i = 0; i < 32; ++i) yv[i] = yp[(size_t)i * 512];
#pragma unroll
  for (int i = 0; i < 32; ++i) yp[(size_t)i * 512] = f2bf(bf2f(yv[i]) * T[c * 65 + th * 32 + i]);
  __syncthreads();
}

#ifndef PHMASK
#define PHMASK 0xFFFF
#endif
#define PHON(k) (((PHMASK) >> (k)) & 1)
constexpr int NPH = 1 + 4 * 10 + 1;
__global__ void __launch_bounds__(NT, 2) mega(Params prm) {
  __shared__ __attribute__((aligned(1024))) char smem[LDS_BYTES];
  cg::grid_group grid = cg::this_grid();
  const int bid = blockIdx.x, nb = gridDim.x;
  {
    unsigned long long* it = (unsigned long long*)(smem + 131072 + 6144);
    if (threadIdx.x < 33) it[threadIdx.x] = (unsigned long long)prm.in[threadIdx.x];
    __syncthreads();
  }
  unsigned nbar = 0;
  for (int ph = prm.ph_lo; ph < prm.ph_hi; ++ph) {
    Ctx p;
    p.intab = (const unsigned long long*)(smem + 131072 + 6144);
    p.ws = prm.ws;
    p.out = prm.out;
    asm volatile("" : "+s"(p.ws), "+s"(p.out));
    float* modall = (float*)(p.ws + WS_MOD);
    u16* proj = (u16*)(p.ws + WS_PROJ);
    u16* xn = (u16*)(p.ws + WS_U);
    char* wo = (char*)p.out;
    if (ph == 0) {
      if (PHON(10)) {
      p0_misc(p);
      for (int t = bid; t < 192; t += nb) p0_mod_task(p, t, smem);
      for (int t = bid; t < 528; t += nb) p0_hid_task(p, t, smem);
      }
    } else if (ph == NPH - 1) {
      if (PHON(11)) final_norm(p);
    } else {
      const int l = (ph - 1) / 10, sp = (ph - 1) % 10;
      const float* modl = modall + (size_t)l * 3 * 6144;
      GD* tab = (GD*)(smem + 131072 + 4096);
      int ng = 0, nN0 = 0, nN1 = 0, nsplit = 1;
      bool seq = false;
      const float* gate = modl;
      if (sp == 0 && PHON(0)) {
        for (int t = bid; t < 4168; t += nb) {
          int r = t;
          if (r < 1472) { wt_task(pin(p, 8) + (size_t)l * 1024 * DIN, 1024, DIN, (u16*)(wo + WO_IN), r, 92, smem); continue; } r -= 1472;
          if (r < 1024) { wt_task(pin(p, 30) + (size_t)l * 1024 * 4096, 1024, 4096, (u16*)(wo + WO_FF1), r, 64, smem); continue; } r -= 1024;
          if (r < 1024) { wt_task(pin(p, 31) + (size_t)l * 4096 * 1024, 4096, 1024, (u16*)(wo + WO_FF2), r, 16, smem); continue; } r -= 1024;
          if (r < 256) { wt_task(pin(p, 29) + (size_t)l * 1024 * 1024, 1024, 1024, (u16*)(wo + WO_OUT), r, 16, smem); continue; } r -= 256;
          if (r < 128) { wt_task(pin(p, 23) + (size_t)l * 512 * 1024, 512, 1024, (u16*)(wo + WO_HY), r, 16, smem); continue; } r -= 128;
          if (r < 128) { wt_task(pin(p, 28) + (size_t)l * 512 * 1024, 512, 1024, (u16*)(wo + WO_WO), r, 16, smem); continue; } r -= 128;
          if (r < 72) { wt_task(pin(p, 25) + (size_t)l * 384 * 768, 384, 768, (u16*)(wo + WO_UQ), r, 12, smem); continue; } r -= 72;
          wt_task(pin(p, 27) + (size_t)l * 256 * 1024, 256, 1024, (u16*)(wo + WO_UKV), r, 16, smem);
        }
        for (int t = bid; t < 32; t += nb) wpe_task(p, l, (t + 128) & 31, smem);
        norm_rows(p, pin(p, 6) + l * 1024, modl, 0, 1, xn);
      } else if (sp == 1 && PHON(1)) {
        if (threadIdx.x == 0) tab[0] = GD{xn, 1024, (const u16*)(wo + WO_IN), 1024, 1024, 23, EM_PROJ, 1};
        ng = 1; nN0 = 23;
      } else if (sp == 2 && PHON(2)) {
        for (int t = bid; t < 264 * 6; t += nb) premix_task(p, l, t, smem);
      } else if (sp == 3 && PHON(3)) {
        for (int t = bid; t < 512; t += nb) fft_task(p, l, t, smem);
        if (threadIdx.x == 0) {
          tab[0] = GD{proj + OFF_Q, DINP, (const u16*)(wo + WO_UQ), 384, 384, 3, EM_Q, 1};
          tab[1] = GD{proj + OFF_KV, DINP, (const u16*)(wo + WO_UKV), 256, 256, 4, EM_KV, 1};
        }
        ng = 2; nN0 = 3; nN1 = 4;
      } else if (sp == 4 && PHON(4)) {
        for (int t = bid; t < 528; t += nb) {
          int bh, qb;
          if (t < 512) { int rnd = t >> 8, w = t & 255; bh = (w & 7) + 8 * rnd; qb = 1 + (w >> 3); }
          else { bh = t - 512; qb = 0; }
          attn_task(p, bh, qb, smem);
        }
        for (int t = bid; t < 528; t += nb) hypost_task(p, t, smem);
      } else if (sp == 5 && PHON(5)) {
        for (int t = bid; t < 132 * 4; t += nb) {
          int w = t;
          mix_tile(p, w >> 2, w & 3, smem);
        }
      } else if (sp == 6 && PHON(6)) {
        if (threadIdx.x == 0) tab[0] = GD{(const u16*)(p.ws + WS_ZV), 1024, (const u16*)(wo + WO_OUT), 1024, 1024, 4, EM_RESID, 4};
        ng = 1; nN0 = 4; nsplit = 4;
        gate = modl + 2 * 1024;
      } else if (sp == 7 && PHON(7)) {
        norm_rows(p, pin(p, 7) + l * 1024, modl, 3, 4, xn);
      } else if (sp == 8 && PHON(8)) {
        if (threadIdx.x == 0) tab[0] = GD{xn, 1024, (const u16*)(wo + WO_FF1), 1024, 1024, 16, EM_SQRELU, 1};
        ng = 1; nN0 = 16;
      } else if (sp == 9 && PHON(9)) {
        if (threadIdx.x == 0) tab[0] = GD{proj, DFF, (const u16*)(wo + WO_FF2), 4096, 4096, 4, EM_RESID, 8};
        ng = 1; nN0 = 4; nsplit = 8;
        gate = modl + 5 * 1024;
      }
      if (ng > 0) {
        __syncthreads();
        const int nt0 = (nsplit > 1) ? (64 * nN0 + 2 * nN0 * nsplit) : NMT * nN0, ntot = seq ? nt0 : nt0 + NMT * nN1;
        const int nseq = seq ? ng : 1;
        const int nitems = ((ntot - bid + nb - 1) / nb) * nseq;
#pragma unroll 1
        for (int it = 0; it < nitems; ++it) {
          int t = bid + (it / nseq) * nb, gi = it % nseq, tt = t;
          if (!seq && t >= nt0) { gi = 1; tt = t - nt0; }
          const volatile GD* gp = tab + gi;
          unsigned long long a64 = (unsigned long long)gp->A, b64 = (unsigned long long)gp->Bt;
          a64 = ((unsigned long long)(unsigned)__builtin_amdgcn_readfirstlane((unsigned)(a64 >> 32)) << 32) | (unsigned long long)(unsigned)__builtin_amdgcn_readfirstlane((unsigned)a64);
          b64 = ((unsigned long long)(unsigned)__builtin_amdgcn_readfirstlane((unsigned)(b64 >> 32)) << 32) | (unsigned long long)(unsigned)__builtin_amdgcn_readfirstlane((unsigned)b64);
          const int lda = __builtin_amdgcn_readfirstlane(gp->lda), ldb = __builtin_amdgcn_readfirstlane(gp->ldb);
          const int K = __builtin_amdgcn_readfirstlane(gp->K), nN = __builtin_amdgcn_readfirstlane(gp->nN);
          const int ks = __builtin_amdgcn_readfirstlane(gp->ks);
          const int mode = __builtin_amdgcn_readfirstlane(gp->mode);
          int pm, pn, Kuse = K, emode = mode;
          if (ks > 1) {
            const int nlat = 64 * nN;
            if (tt < nlat) { int pm64; tile_map(tt, 64, nN, pm64, pn); pm = (pm64 >> 5) * 33 + 1 + (pm64 & 31); }
            else {
              int u = tt - nlat, kp = u % ks, tile = u / ks;
              pm = (tile / nN) * 33; pn = tile % nN;
              Kuse = K / ks; emode = EM_RESID_AT;
              a64 += (unsigned long long)kp * Kuse * 2; b64 += (unsigned long long)kp * Kuse * 2;
            }
          } else tile_map(tt, NMT, nN, pm, pn);
          Epi e{emode, p.ws, gate};
          gemm_tile((const u16*)a64, lda, (const u16*)b64, ldb, Kuse, pm * 256, pn * 256, smem, e);
        }
      }
    }
    if (ph + 1 < prm.ph_hi) {
      if (ph == prm.ph_lo) grid.sync();
      else { ++nbar; grid_barrier((unsigned*)(prm.ws + WS_BAR), nbar * gridDim.x); }
    }
  }
}

extern "C" void kernel_launch(void* const* d_in, const int* in_sizes, int n_in, void* d_out, int out_size, void* d_ws,
                              size_t ws_size, hipStream_t stream) {
  static int grid_blocks = 0;
  if (grid_blocks == 0) {
    if (n_in != 33 || ws_size < WS_END || (size_t)out_size * 4 < WO_END) {
      fprintf(stderr, "kernel_launch: unexpected sizes n_in=%d ws=%zu (need %zu) out=%d\n", n_in, ws_size, (size_t)WS_END, out_size);
      grid_blocks = -1;
      return;
    }
    int dev = 0, cus = 0, per_cu = 0;
    hipGetDevice(&dev);
    hipDeviceGetAttribute(&cus, hipDeviceAttributeMultiprocessorCount, dev);
    hipOccupancyMaxActiveBlocksPerMultiprocessor(&per_cu, mega, NT, 0);
    if (per_cu < 1) per_cu = 1;
    if (per_cu > 1) per_cu = 1;
    grid_blocks = cus * per_cu;
  }
  if (grid_blocks < 0) return;
  Params p{};
  for (int i = 0; i < 33; ++i) p.in[i] = (const float*)d_in[i];
  p.out = (float*)d_out;
  p.ws = (char*)d_ws;
  p.ph_lo = 0;
  p.ph_hi = NPH;
  (void)hipMemsetAsync((char*)d_ws + WS_BAR, 0, 1024, stream);
  void* args[] = {&p};
  hipError_t e = hipLaunchCooperativeKernel((void*)mega, dim3(grid_blocks), dim3(NT), args, 0, stream);
  if (e != hipSuccess) fprintf(stderr, "cooperative launch failed: %s (grid %d)\n", hipGetErrorString(e), grid_blocks);
}
```

```cpp
#include <hip/hip_runtime.h>
#include <hip/hip_cooperative_groups.h>
#include <cstdio>
namespace cg = cooperative_groups;

typedef unsigned short u16;
using bf16x8 = __attribute__((ext_vector_type(8))) short;
using f32x4 = __attribute__((ext_vector_type(4))) float;
using f32x16 = __attribute__((ext_vector_type(16))) float;

constexpr int D = 1024, SEQ = 8192, CTX = 256, SP = 8448, MROWS = 16896, NMT = 66;
constexpr int DIN = 5792, DINP = 5888, DFF = 4096;
constexpr int OFF_HY = 512, OFF_Q = 2048, OFF_KV = 2432, OFF_GATE = 2720;
constexpr int NT = 512;
constexpr float EPS = 1e-6f;

constexpr size_t WS_H = 0;
constexpr size_t WS_PROJ = WS_H + (size_t)MROWS * D * 4;
constexpr size_t WS_U = WS_PROJ + (size_t)MROWS * DINP * 2;
constexpr size_t WS_Y = WS_U + (size_t)MROWS * 512 * 2;
constexpr size_t WS_O = WS_Y + (size_t)MROWS * 512 * 2;
constexpr size_t WS_Q = WS_O + (size_t)MROWS * 512 * 2;
constexpr size_t WS_K = WS_Q + (size_t)16 * SP * 96 * 2;
constexpr size_t WS_VT = WS_K + (size_t)16 * SP * 96 * 2;
constexpr size_t WS_ZV = WS_VT + (size_t)16 * 64 * SP * 2;
constexpr size_t WS_HID2 = WS_ZV + (size_t)512 * SP * 8;
constexpr size_t WS_HID2C = WS_HID2 + (size_t)4 * 8192 * 64 * 4;
constexpr size_t WS_MOD = WS_HID2C + (size_t)4 * 256 * 64 * 4;
constexpr size_t WS_ROPE = WS_MOD + (size_t)4 * 3 * 6144 * 4;
constexpr size_t WS_TW = WS_ROPE + (size_t)128 * 8 * 8;
constexpr size_t WS_BAR = WS_TW + (size_t)16384 * 8;
constexpr size_t WS_END = WS_BAR + 1024;
constexpr size_t WO_IN = 0;
constexpr size_t WO_FF1 = WO_IN + (size_t)DINP * 1024 * 2;
constexpr size_t WO_FF2 = WO_FF1 + (size_t)4096 * 1024 * 2;
constexpr size_t WO_OUT = WO_FF2 + (size_t)4096 * 1024 * 2;
constexpr size_t WO_HY = WO_OUT + (size_t)1024 * 1024 * 2;
constexpr size_t WO_WO = WO_HY + (size_t)1024 * 512 * 2;
constexpr size_t WO_PE = WO_WO + (size_t)1024 * 512 * 2;
constexpr size_t WO_UQ = WO_PE + (size_t)1024 * 512 * 2;
constexpr size_t WO_UKV = WO_UQ + (size_t)768 * 384 * 2;
constexpr size_t WO_END = WO_UKV + (size_t)1024 * 256 * 2;

constexpr int AUX_OFF = 147456;
constexpr int LDS_BYTES = AUX_OFF + 8192;

struct Params {
  const float* in[33];
  float* out;
  char* ws;
  int ph_lo, ph_hi;
};

struct Ctx { const unsigned long long* intab; char* ws; float* out; };
__device__ __forceinline__ const float* pin(const Ctx& c, int i) {
  unsigned long long v = c.intab[i];
  unsigned lo = __builtin_amdgcn_readfirstlane((unsigned)v), hi = __builtin_amdgcn_readfirstlane((unsigned)(v >> 32));
  return (const float*)(((unsigned long long)hi << 32) | lo);
}

typedef __bf16 hwbf2 __attribute__((ext_vector_type(2)));
typedef float hwf2 __attribute__((ext_vector_type(2)));
__device__ __forceinline__ unsigned pk2(float a, float b) {
  hwf2 v = {a, b};
  hwbf2 r = __builtin_convertvector(v, hwbf2);
  return __builtin_bit_cast(unsigned, r);
}
__device__ __forceinline__ u16 f2bf(float f) { return (u16)(pk2(f, 0.f) & 0xffffu); }
__device__ __forceinline__ float bf2f(u16 b) { return __uint_as_float(((unsigned)b) << 16); }
__device__ __forceinline__ float shx(float v, int o) {
  int l = __builtin_amdgcn_mbcnt_hi(~0u, __builtin_amdgcn_mbcnt_lo(~0u, 0u));
  asm volatile("" : "+v"(l));
  return __int_as_float(__builtin_amdgcn_ds_bpermute((l ^ o) << 2, __float_as_int(v)));
}
__device__ __forceinline__ float wave_sum(float v) {
#pragma unroll
  for (int o = 1; o < 64; o <<= 1) v += shx(v, o);
  return v;
}
__device__ __forceinline__ int grp_of_row(int m) {
  int tile = m >> 8, b = tile / 33, t33 = tile - b * 33;
  return t33 == 0 ? 2 : b;
}
__device__ __forceinline__ float2 cmul(float2 a, float2 b) { return make_float2(a.x * b.x - a.y * b.y, a.x * b.y + a.y * b.x); }

__device__ __forceinline__ int tid_l() { int t = threadIdx.x; asm volatile("" : "+v"(t)); return t; }
__device__ __forceinline__ void grid_barrier(unsigned* bar, unsigned target) {
  asm volatile("s_waitcnt vmcnt(0)" ::: "memory");
  __syncthreads();
  if (threadIdx.x == 0) {
    __builtin_amdgcn_fence(__ATOMIC_RELEASE, "agent");
    asm volatile("s_waitcnt vmcnt(0)" ::: "memory");
    __hip_atomic_fetch_add(bar, 1u, __ATOMIC_RELAXED, __HIP_MEMORY_SCOPE_AGENT);
    while (__hip_atomic_load(bar, __ATOMIC_RELAXED, __HIP_MEMORY_SCOPE_AGENT) < target) __builtin_amdgcn_s_sleep(2);
    __builtin_amdgcn_fence(__ATOMIC_ACQUIRE, "agent");
    asm volatile("s_waitcnt vmcnt(0)" ::: "memory");
  }
  __syncthreads();
}
#define WAIT_V(n) asm volatile("s_waitcnt vmcnt(%0)" ::"n"(n) : "memory")
#define SCHED() __builtin_amdgcn_sched_barrier(0)
#define RAW_BARRIER() do { asm volatile("s_waitcnt lgkmcnt(0)" ::: "memory"); __builtin_amdgcn_s_barrier(); } while (0)

constexpr float QSCALE = 0.10206207261596575f * 1.4426950408889634f;
enum { EM_PROJ = 0, EM_SQRELU = 1, EM_RESID = 2, EM_RESID_AT = 3, EM_Q = 6, EM_KV = 7 };
struct Epi {
  int mode;
  char* ws;
  const float* gate;
  __device__ __forceinline__ void proj(int row, int col, f32x4 v) const {
    {
      u16* out = (u16*)(ws + WS_PROJ);
#pragma unroll
      for (int j = 0; j < 4; ++j) out[(size_t)(row + j) * DINP + col] = f2bf(v[j]);
    }
  }
  __device__ __forceinline__ void sqrelu(int row, int col, f32x4 v) const {
    {
      u16* out = (u16*)(ws + WS_PROJ);
#pragma unroll
      for (int j = 0; j < 4; ++j) { float r = fmaxf(v[j], 0.f); out[(size_t)(row + j) * DFF + col] = f2bf(r * r); }
    }
  }
  __device__ __forceinline__ void resid(int row, int col, f32x4 v) const {
    {
      float* h = (float*)(ws + WS_H);
      float g = gate[grp_of_row(row) * 6144 + col];
#pragma unroll
      for (int j = 0; j < 4; ++j) unsafeAtomicAdd(h + (size_t)(row + j) * D + col, g * v[j]);
    }
  }
  __device__ __forceinline__ void q(int row, int col, f32x4 v) const {
    {
      u16* Q = (u16*)(ws + WS_Q);
      const float2* rope = (const float2*)(ws + WS_ROPE);
      int head = col / 96, d = col - head * 96;
      int b = row / SP, pos0 = row - b * SP;
      bool isrope = (d >= 64) && (pos0 >= CTX);
      int rd = d - 64;
#pragma unroll
      for (int j = 0; j < 4; ++j) {
        float val = v[j];
        float partner = shx(val, 8);
        int pos = pos0 + j;
        if (isrope) {
          int t = pos - CTX, idx = (rd < 16) ? (t >> 6) : (t & 63);
          float2 cs = rope[idx * 8 + (rd & 7)];
          float sgn = (rd & 8) ? 1.f : -1.f;
          val = val * cs.x + sgn * partner * cs.y;
        }
        Q[((size_t)(b * 8 + head) * SP + pos) * 96 + d] = f2bf(val * QSCALE);
      }
    }
  }
  __device__ __forceinline__ void kv(int row, int col, f32x4 v) const {
    {
      u16* Kb = (u16*)(ws + WS_K);
      u16* Vt = (u16*)(ws + WS_VT);
      int head = col >> 7, j2 = col & 127;
      int b = row / SP, pos0 = row - b * SP;
      if (j2 < 64) {
#pragma unroll
        for (int j = 0; j < 4; ++j) Kb[((size_t)(b * 8 + head) * SP + pos0 + j) * 96 + j2] = f2bf(v[j]);
      } else {
        uint2 o;
        o.x = pk2(v[0], v[1]);
        o.y = pk2(v[2], v[3]);
        *(uint2*)(Vt + ((size_t)(b * 8 + head) * 64 + (j2 - 64)) * SP + pos0) = o;
      }
    }
  }
};
struct GD { const u16* A; int lda; const u16* Bt; int ldb; int K; int nN; int mode; int ks; };

constexpr int G_TILE_B = 256 * 64 * 2, G_STAGE_B = 2 * G_TILE_B;
__device__ __forceinline__ int lds_byte(int r, int c) {
  int st = (r >> 4) * 2 + (c >> 5), ob = (r & 15) * 64 + (c & 31) * 2;
  return st * 1024 + (ob ^ (((ob >> 9) & 1) << 5));
}
__device__ __forceinline__ void stage_rc(int b, int& R, int& C) {
  int st = b >> 10, sb = b & 1023, swz = sb ^ (((sb >> 9) & 1) << 5);
  R = (st / 2) * 16 + swz / 64;
  C = (st % 2) * 32 + (swz % 64) / 2;
}

template <int MI>
__device__ __forceinline__ void gemm_core(const u16* __restrict__ A, int lda, const u16* __restrict__ Bt, int ldb, int K,
                                          int brow, int bcol, char* shm, f32x4 (&acc)[MI][4]) {
  constexpr int TILE_A = MI * 32 * 64 * 2, TILE_BB = 256 * 64 * 2, STAGE = TILE_A + TILE_BB;
  const int tid = tid_l(), wid = tid >> 6, lane = tid & 63, wr = wid >> 2, wc = wid & 3, fr = lane & 15, fq = lane >> 4;
  const u16* Ab = A + (size_t)brow * lda;
  const u16* Bb = Bt + (size_t)bcol * ldb;
  int sR[4], sC[4];
#pragma unroll
  for (int i = 0; i < 4; ++i) stage_rc(wid * 1024 + i * 8192 + lane * 16, sR[i], sC[i]);
#define SA(b) (shm + (b) * STAGE)
#define SB(b) (shm + (b) * STAGE + TILE_A)
#define GLDS_STAGE(buf, kt)                                                                                              \
  do {                                                                                                                   \
    _Pragma("unroll") for (int i = 0; i < 4; ++i) {                                                                      \
      if (i < MI / 2)                                                                                                    \
        __builtin_amdgcn_global_load_lds((const unsigned*)(Ab + (size_t)sR[i] * lda + (kt) * 64 + sC[i]),                \
                                         (unsigned*)(SA(buf) + wid * 1024 + i * 8192), 16, 0, 0);                        \
      __builtin_amdgcn_global_load_lds((const unsigned*)(Bb + (size_t)sR[i] * ldb + (kt) * 64 + sC[i]),                  \
                                       (unsigned*)(SB(buf) + wid * 1024 + i * 8192), 16, 0, 0);                          \
    }                                                                                                                    \
  } while (0)
  const int nt = K / 64;
  GLDS_STAGE(0, 0);
  WAIT_V(0);
  __syncthreads();
  for (int t = 0; t < nt; ++t) {
    const int cur = t & 1;
    if (t + 1 < nt) GLDS_STAGE(cur ^ 1, t + 1);
#pragma unroll
    for (int ks = 0; ks < 2; ++ks) {
      bf16x8 At[MI], Bf[4];
#pragma unroll
      for (int m = 0; m < MI; ++m) At[m] = *(const bf16x8*)(SA(cur) + lds_byte(wr * (MI * 16) + m * 16 + fr, ks * 32 + fq * 8));
#pragma unroll
      for (int n = 0; n < 4; ++n) Bf[n] = *(const bf16x8*)(SB(cur) + lds_byte(wc * 64 + n * 16 + fr, ks * 32 + fq * 8));
#pragma unroll
      for (int m = 0; m < MI; ++m)
#pragma unroll
        for (int n = 0; n < 4; ++n) acc[m][n] = __builtin_amdgcn_mfma_f32_16x16x32_bf16(At[m], Bf[n], acc[m][n], 0, 0, 0);
      SCHED();
    }
    WAIT_V(0);
    __syncthreads();
  }
#undef SA
#undef SB
#undef GLDS_STAGE
}

template <class EpiT>
__device__ __forceinline__ void gemm_tile(const u16* __restrict__ A, int lda, const u16* __restrict__ Bt, int ldb, int K,
                                          int brow, int bcol, char* shm, const EpiT& epi) {
  const int tid = tid_l(), wid = tid >> 6, lane = tid & 63, wr = wid >> 2, wc = wid & 3, fr = lane & 15, fq = lane >> 4;
  f32x4 acc[8][4];
#pragma unroll
  for (int m = 0; m < 8; ++m)
#pragma unroll
    for (int n = 0; n < 4; ++n) acc[m][n] = (f32x4){0.f, 0.f, 0.f, 0.f};
  gemm_core<8>(A, lda, Bt, ldb, K, brow, bcol, shm, acc);
#define EPI_LOOP(CALL)                                                                              \
  _Pragma("unroll") for (int m = 0; m < 8; ++m) _Pragma("unroll") for (int n = 0; n < 4; ++n) {      \
    const int row = brow + wr * 128 + m * 16 + fq * 4, col = bcol + wc * 64 + n * 16 + fr;           \
    const f32x4 v = acc[m][n];                                                                        \
    CALL;                                                                                             \
  }
  if (epi.mode == EM_PROJ) { EPI_LOOP(epi.proj(row, col, v)) }
  else if (epi.mode == EM_SQRELU) { EPI_LOOP(epi.sqrelu(row, col, v)) }
  else if (epi.mode == EM_RESID_AT) { EPI_LOOP(epi.resid(row, col, v)) }
  else if (epi.mode == EM_RESID) {
    float* h = (float*)(epi.ws + WS_H);
    float g4[4];
#pragma unroll
    for (int n = 0; n < 4; ++n) g4[n] = epi.gate[grp_of_row(brow) * 6144 + bcol + wc * 64 + n * 16 + fr];
    float hv[8][4][4];
    float* hp0 = h + (size_t)(brow + wr * 128 + fq * 4) * D + bcol + wc * 64 + fr;
#define H_LOAD(m) _Pragma("unroll") for (int n = 0; n < 4; ++n) _Pragma("unroll") for (int j = 0; j < 4; ++j) hv[m][n][j] = hp0[(size_t)((m) * 16 + j) * D + n * 16]
#define H_STORE(m) _Pragma("unroll") for (int n = 0; n < 4; ++n) _Pragma("unroll") for (int j = 0; j < 4; ++j) hp0[(size_t)((m) * 16 + j) * D + n * 16] = hv[m][n][j] + g4[n] * acc[m][n][j]
    H_LOAD(0); H_LOAD(1);
    SCHED();
    H_STORE(0); H_LOAD(2); SCHED();
    H_STORE(1); H_LOAD(3); SCHED();
    H_STORE(2); H_LOAD(4); SCHED();
    H_STORE(3); H_LOAD(5); SCHED();
    H_STORE(4); H_LOAD(6); SCHED();
    H_STORE(5); H_LOAD(7); SCHED();
    H_STORE(6); H_STORE(7);
#undef H_LOAD
#undef H_STORE
  }
  else if (epi.mode == EM_Q) { EPI_LOOP(epi.q(row, col, v)) }
  else { EPI_LOOP(epi.kv(row, col, v)) }
#undef EPI_LOOP
}

__device__ __forceinline__ void mix_tile(const Ctx& p, int pm, int pn, char* shm) {
  constexpr int TILE_A = 128 * 64 * 2, TILE_BB = 256 * 64 * 2, STAGE = TILE_A + TILE_BB;
  const int tid = tid_l(), wid = tid >> 6, lane = tid & 63, wr = wid >> 2, wc = wid & 3, fr = lane & 15, fq = lane >> 4;
  const int brow = pm * 128, bcol = pn * 256;
  const u16* projb = (const u16*)(p.ws + WS_PROJ);
  char* wo = (char*)p.out;
#define SA(b) (shm + (b) * STAGE)
#define SB(b) (shm + (b) * STAGE + TILE_A)
#define MIX_STAGE(buf, kt)                                                                                               \
  do {                                                                                                                   \
    const int br_ = (kt) >> 3, ko_ = ((kt) & 7) * 64;                                                                    \
    const u16* Ab_ = (const u16*)(p.ws + (br_ == 0 ? WS_U : br_ == 1 ? WS_Y : WS_O)) + (size_t)brow * 512 + ko_;         \
    const u16* Bb_ = (const u16*)(wo + (br_ == 0 ? WO_PE : br_ == 1 ? WO_HY : WO_WO)) + (size_t)bcol * 512 + ko_;        \
    _Pragma("unroll") for (int i = 0; i < 4; ++i) {                                                                      \
      int sR_, sC_; stage_rc(wid * 1024 + i * 8192 + lane * 16, sR_, sC_);                                              \
      if (i < 2)                                                                                                         \
        __builtin_amdgcn_global_load_lds((const unsigned*)(Ab_ + sR_ * 512 + sC_),                           \
                                         (unsigned*)(SA(buf) + wid * 1024 + i * 8192), 16, 0, 0);                        \
      __builtin_amdgcn_global_load_lds((const unsigned*)(Bb_ + sR_ * 512 + sC_),                             \
                                       (unsigned*)(SB(buf) + wid * 1024 + i * 8192), 16, 0, 0);                          \
    }                                                                                                                    \
  } while (0)
  f32x4 tot[4][4], acc[4][4];
#pragma unroll
  for (int m = 0; m < 4; ++m)
#pragma unroll
    for (int n = 0; n < 4; ++n) { tot[m][n] = (f32x4){0.f, 0.f, 0.f, 0.f}; acc[m][n] = (f32x4){0.f, 0.f, 0.f, 0.f}; }
  MIX_STAGE(0, 0);
  MIX_STAGE(1, 1);
  WAIT_V(6);
  RAW_BARRIER();
  int cur = 0;
#pragma unroll 1
  for (int br = 0; br < 3; ++br) {
    unsigned gpk[4][4][2];
    const u16* gp = projb + (size_t)(brow + wr * 64 + fq * 4) * DINP + OFF_GATE + br * 1024 + bcol + wc * 64 + fr;
#define GATE_LOAD(m)                                                                                   \
    _Pragma("unroll") for (int n = 0; n < 4; ++n) _Pragma("unroll") for (int j2 = 0; j2 < 2; ++j2) {       \
      unsigned lo = gp[(size_t)((m) * 16 + 2 * j2) * DINP + n * 16], hi = gp[(size_t)((m) * 16 + 2 * j2 + 1) * DINP + n * 16]; \
      gpk[m][n][j2] = lo | (hi << 16);                                                                     \
    }
    GATE_LOAD(0); GATE_LOAD(1); GATE_LOAD(2);
#pragma unroll 1
    for (int kk = 0; kk < 8; ++kk) {
      const int t = br * 8 + kk;
      { int nx = cur + 2; if (nx >= 3) nx -= 3; if (t + 2 < 24) MIX_STAGE(nx, t + 2); }
#pragma unroll
      for (int ks = 0; ks < 2; ++ks) {
        bf16x8 At[2], Bf[4];
#pragma unroll
        for (int n = 0; n < 4; ++n) Bf[n] = *(const bf16x8*)(SB(cur) + lds_byte(wc * 64 + n * 16 + fr, ks * 32 + fq * 8));
#pragma unroll
        for (int mh = 0; mh < 2; ++mh) {
#pragma unroll
          for (int m = 0; m < 2; ++m) At[m] = *(const bf16x8*)(SA(cur) + lds_byte(wr * 64 + (mh * 2 + m) * 16 + fr, ks * 32 + fq * 8));
#pragma unroll
          for (int m = 0; m < 2; ++m)
#pragma unroll
            for (int n = 0; n < 4; ++n) acc[mh * 2 + m][n] = __builtin_amdgcn_mfma_f32_16x16x32_bf16(At[m], Bf[n], acc[mh * 2 + m][n], 0, 0, 0);
          SCHED();
        }
      }
      if (t + 2 < 24) WAIT_V(6); else WAIT_V(0);
      RAW_BARRIER();
      cur = (cur == 2) ? 0 : cur + 1;
    }
    GATE_LOAD(3);
#undef GATE_LOAD
#pragma unroll
    for (int m = 0; m < 4; ++m)
#pragma unroll
      for (int n = 0; n < 4; ++n)
#pragma unroll
        for (int j = 0; j < 4; ++j) {
          const unsigned w = gpk[m][n][j >> 1];
          const float gv = __uint_as_float((j & 1) ? (w & 0xffff0000u) : (w << 16));
          tot[m][n][j] += acc[m][n][j] / (1.f + __expf(-gv));
          acc[m][n][j] = 0.f;
        }
  }
  u16* mixb = (u16*)(p.ws + WS_ZV);
#pragma unroll
  for (int m = 0; m < 4; ++m)
#pragma unroll
    for (int n = 0; n < 4; ++n)
#pragma unroll
      for (int j = 0; j < 4; ++j)
        mixb[(size_t)(brow + wr * 64 + m * 16 + fq * 4 + j) * D + bcol + wc * 64 + n * 16 + fr] = f2bf(tot[m][n][j]);
#undef SA
#undef SB
#undef MIX_STAGE
}

__device__ __forceinline__ void tile_map(int t, int nM, int nN, int& pm, int& pn) {
  int nwg = nM * nN, wgid = t;
  {
    int q = nwg / 8, r = nwg % 8, xcd = wgid % 8, off = wgid / 8;
    wgid = (xcd < r ? xcd * (q + 1) : r * (q + 1) + (xcd - r) * q) + off;
  }
  int nig = 8 * nN, gid = wgid / nig, fm = gid * 8, gsz = min(nM - fm, 8);
  pm = fm + ((wgid % nig) % gsz);
  pn = (wgid % nig) / gsz;
}

__device__ __forceinline__ void p0_misc(const Ctx& p) {
  const int gtid = blockIdx.x * NT + tid_l(), gn = gridDim.x * NT;
  float4* h4 = (float4*)(p.ws + WS_H);
  const float4* x4 = (const float4*)pin(p, 0);
  const float4* c4 = (const float4*)pin(p, 2);
  for (int i = gtid; i < MROWS * 256; i += gn) {
    int m = i >> 8, q = i & 255, b = m / SP, pos = m - b * SP;
    float4 v = (pos < CTX) ? c4[(size_t)(b * CTX + pos) * 256 + q] : x4[(size_t)(b * SEQ + pos - CTX) * 256 + q];
    h4[i] = v;
  }
  float2* rope = (float2*)(p.ws + WS_ROPE);
  for (int i = gtid; i < 1024; i += gn) {
    int idx = i >> 3, f = i & 7;
    float inv = powf(10000.f, -(float)f / 8.f);
    float a = (float)idx * inv;
    rope[i] = make_float2(cosf(a), sinf(a));
  }
  float2* tw = (float2*)(p.ws + WS_TW);
  for (int i = gtid; i < 16384; i += gn) {
    float s, c;
    sincospif(-(float)i / 8192.f, &s, &c);
    tw[i] = make_float2(c, s);
  }
}

__device__ __forceinline__ void p0_mod_task(const Ctx& p, int task, char* smem) {
  float* s = (float*)smem;
  float* red = s + 3072;
  const int tid = tid_l();
  const int l = task / 48, chunk = task - l * 48;
  for (int i = tid; i < 3072; i += NT) {
    int g = i >> 10, k = i & 1023;
    float cv = (g < 2) ? pin(p, 1)[g * 1024 + k] : pin(p, 3)[k];
    s[i] = cv / (1.f + __expf(-cv));
  }
  __syncthreads();
  const int kq = tid >> 7, col = tid & 127, n = chunk * 128 + col;
  const float* W = pin(p, 4) + (size_t)l * 1024 * 6144 + n;
  float a0 = 0.f, a1 = 0.f, a2 = 0.f;
#pragma unroll 8
  for (int k = kq * 256; k < kq * 256 + 256; ++k) {
    float w = W[(size_t)k * 6144];
    a0 += s[k] * w; a1 += s[1024 + k] * w; a2 += s[2048 + k] * w;
  }
  red[(kq * 3 + 0) * 128 + col] = a0;
  red[(kq * 3 + 1) * 128 + col] = a1;
  red[(kq * 3 + 2) * 128 + col] = a2;
  __syncthreads();
  if (tid < 384) {
    int g = tid >> 7, c2 = tid & 127, n2 = chunk * 128 + c2;
    float v = red[(0 * 3 + g) * 128 + c2] + red[(1 * 3 + g) * 128 + c2] + red[(2 * 3 + g) * 128 + c2] + red[(3 * 3 + g) * 128 + c2];
    ((float*)(p.ws + WS_MOD))[(size_t)(l * 3 + g) * 6144 + n2] = v + pin(p, 5)[l * 6144 + n2];
  }
  __syncthreads();
}

__device__ __forceinline__ void p0_hid_task(const Ctx& p, int task, char* smem) {
  float* zs = (float*)smem;
  float* h1 = zs + 8 * 36;
  float* w1s = h1 + 8 * 64;
  float* w2s = w1s + 33 * 64;
  const int tid = tid_l(), tl = tid >> 6, j = tid & 63;
  const int l = task / 132, r = task - l * 132;
  const bool isctx = r >= 128;
  const int L = isctx ? 256 : 8192;
  const int tbase = (isctx ? (r - 128) : r) * 64;
  for (int i = tid; i < 33 * 64; i += NT) w1s[i] = pin(p, 14)[l * 33 * 64 + i];
  for (int i = tid; i < 64 * 64; i += NT) w2s[i] = pin(p, 17)[l * 64 * 64 + i];
  const float b1 = pin(p, 15)[l * 64 + j], f1 = pin(p, 16)[l * 64 + j], b2 = pin(p, 18)[l * 64 + j], f2 = pin(p, 19)[l * 64 + j];
  __syncthreads();
  for (int sub = 0; sub < 8; ++sub) {
    const int t = tbase + sub * 8 + tl;
    if (j < 33) {
      float z;
      if (j == 0) z = (float)t / (float)(L - 1);
      else {
        int i = (j - 1) & 15;
        float band = 1e-4f + (float)i * ((15.f - 1e-4f) / 15.f);
        float omega = 6.2831855f * (float)t / (float)L;
        float a = omega * band;
        z = (j <= 16) ? cosf(a) : -sinf(a);
      }
      zs[tl * 36 + j] = z;
    }
    __syncthreads();
    {
      float a = b1;
#pragma unroll
      for (int k = 0; k < 33; ++k) a += zs[tl * 36 + k] * w1s[k * 64 + j];
      h1[tl * 64 + j] = sinf(f1 * a);
    }
    __syncthreads();
    {
      float a = b2;
#pragma unroll 16
      for (int k = 0; k < 64; ++k) a += h1[tl * 64 + k] * w2s[k * 64 + j];
      float v = sinf(f2 * a);
      float* dst = isctx ? (float*)(p.ws + WS_HID2C) + ((size_t)l * 64 + j) * 256 + t : (float*)(p.ws + WS_HID2) + ((size_t)l * 64 + j) * 8192 + t;
      dst[0] = v;
    }
  }
  __syncthreads();
}

__device__ __forceinline__ void wt_task(const float* __restrict__ W, int K, int N, u16* __restrict__ WT, int item, int nblkN, char* smem) {
  float* tile = (float*)smem;
  const int tid = tid_l();
  const int kb = item / nblkN, nb = item - kb * nblkN, k0 = kb * 64, n0 = nb * 64;
#pragma unroll
  for (int r = 0; r < 8; ++r) {
    int kk = r * 8 + (tid >> 6), nn = tid & 63;
    float v = (n0 + nn < N) ? W[(size_t)(k0 + kk) * N + n0 + nn] : 0.f;
    tile[kk * 65 + nn] = v;
  }
  __syncthreads();
  {
    int n = tid >> 3, kc = (tid & 7) * 8;
    uint4 o;
    o.x = pk2(tile[(kc + 0) * 65 + n], tile[(kc + 1) * 65 + n]);
    o.y = pk2(tile[(kc + 2) * 65 + n], tile[(kc + 3) * 65 + n]);
    o.z = pk2(tile[(kc + 4) * 65 + n], tile[(kc + 5) * 65 + n]);
    o.w = pk2(tile[(kc + 6) * 65 + n], tile[(kc + 7) * 65 + n]);
    *(uint4*)(WT + (size_t)(n0 + n) * K + k0 + kc) = o;
  }
  __syncthreads();
}

__device__ __forceinline__ void wpe_task(const Ctx& p, int l, int task, char* smem) {
  const int g = task >> 3, c0 = (task & 7) * 16, tid = tid_l();
  const float* pw = pin(p, 9) + ((size_t)(l * 4 + g) * 128) * 128;
  const float* sc = pin(p, 10) + l * 512 + g * 128;
  const float* po = pin(p, 11) + ((size_t)l * 512 + g * 128) * 1024;
  u16* WpeT = (u16*)((char*)p.out + WO_PE);
  float* wl = (float*)smem;
  for (int i = tid; i < 16 * 128; i += NT) { int d = i & 127; wl[i] = pw[(c0 + (i >> 7)) * 128 + d] * sc[d]; }
  __syncthreads();
  float acc0[16], acc1[16];
#pragma unroll
  for (int i = 0; i < 16; ++i) { acc0[i] = 0.f; acc1[i] = 0.f; }
#pragma unroll 4
  for (int d = 0; d < 128; ++d) {
    float p0 = po[(size_t)d * 1024 + tid], p1 = po[(size_t)d * 1024 + 512 + tid];
#pragma unroll
    for (int i = 0; i < 16; ++i) { float w = wl[i * 128 + d]; acc0[i] += w * p0; acc1[i] += w * p1; }
  }
  uint4 o0, o1;
  o0.x = pk2(acc0[0], acc0[1]); o0.y = pk2(acc0[2], acc0[3]); o0.z = pk2(acc0[4], acc0[5]); o0.w = pk2(acc0[6], acc0[7]);
  o1.x = pk2(acc0[8], acc0[9]); o1.y = pk2(acc0[10], acc0[11]); o1.z = pk2(acc0[12], acc0[13]); o1.w = pk2(acc0[14], acc0[15]);
  uint4* dst = (uint4*)(WpeT + (size_t)tid * 512 + g * 128 + c0);
  dst[0] = o0; dst[1] = o1;
  o0.x = pk2(acc1[0], acc1[1]); o0.y = pk2(acc1[2], acc1[3]); o0.z = pk2(acc1[4], acc1[5]); o0.w = pk2(acc1[6], acc1[7]);
  o1.x = pk2(acc1[8], acc1[9]); o1.y = pk2(acc1[10], acc1[11]); o1.z = pk2(acc1[12], acc1[13]); o1.w = pk2(acc1[14], acc1[15]);
  dst = (uint4*)(WpeT + (size_t)(512 + tid) * 512 + g * 128 + c0);
  dst[0] = o0; dst[1] = o1;
  __syncthreads();
}

__device__ __forceinline__ void norm_rows(const Ctx& p, const float* gain, const float* modl, int sh_idx, int sc_idx, u16* outp) {
  const int tidx = tid_l(), lane = tidx & 63, gw = blockIdx.x * 8 + (tidx >> 6), ngw = gridDim.x * 8;
  const float* h = (const float*)(p.ws + WS_H);
  for (int m = gw; m < MROWS; m += ngw) {
    const float4* hr = (const float4*)(h + (size_t)m * D) + lane;
    float4 v[4];
    float ss = 0.f;
#pragma unroll
    for (int j = 0; j < 4; ++j) { v[j] = hr[64 * j]; ss += v[j].x * v[j].x + v[j].y * v[j].y + v[j].z * v[j].z + v[j].w * v[j].w; }
    ss = wave_sum(ss);
    float r = rsqrtf(ss * (1.f / D) + EPS);
    const float* mg = modl + grp_of_row(m) * 6144;
    uint2* o8 = (uint2*)(outp + (size_t)m * D) + lane;
#pragma unroll
    for (int j = 0; j < 4; ++j) {
      int n = lane * 4 + 256 * j;
      float4 g = *(const float4*)(gain + n), sc = *(const float4*)(mg + sc_idx * 1024 + n), sh = *(const float4*)(mg + sh_idx * 1024 + n);
      uint2 o;
      o.x = pk2(v[j].x * r * g.x * (1.f + sc.x) + sh.x, v[j].y * r * g.y * (1.f + sc.y) + sh.y);
      o.y = pk2(v[j].z * r * g.z * (1.f + sc.z) + sh.z, v[j].w * r * g.w * (1.f + sc.w) + sh.w);
      o8[64 * j] = o;
    }
  }
}

__device__ __forceinline__ void final_norm(const Ctx& p) {
  const int tidx = tid_l(), lane = tidx & 63, gw = blockIdx.x * 8 + (tidx >> 6), ngw = gridDim.x * 8;
  const float* h = (const float*)(p.ws + WS_H);
  const float* gain = pin(p, 32);
  for (int r0 = gw; r0 < 2 * SEQ; r0 += ngw) {
    int b = r0 >> 13, t = r0 & 8191, m = b * SP + CTX + t;
    const float4* hr = (const float4*)(h + (size_t)m * D) + lane;
    float4 v[4];
    float ss = 0.f;
#pragma unroll
    for (int j = 0; j < 4; ++j) { v[j] = hr[64 * j]; ss += v[j].x * v[j].x + v[j].y * v[j].y + v[j].z * v[j].z + v[j].w * v[j].w; }
    ss = wave_sum(ss);
    float r = rsqrtf(ss * (1.f / D) + EPS);
    float4* o = (float4*)(p.out + (size_t)r0 * D) + lane;
#pragma unroll
    for (int j = 0; j < 4; ++j) {
      float4 g = *(const float4*)(gain + lane * 4 + 256 * j);
      o[64 * j] = make_float4(v[j].x * r * g.x, v[j].y * r * g.y, v[j].z * r * g.z, v[j].w * r * g.w);
    }
  }
}

__device__ __forceinline__ void premix_task(const Ctx& p, int l, int task, char* smem) {
  const int tid = tid_l(), lane = tid & 63, wid = tid >> 6;
  const int part = task / 264, tile64 = task - part * 264;
  const int m0 = tile64 * 64, b = m0 / SP, pos0 = m0 - b * SP;
  const bool isctx = pos0 < CTX;
  const int s0 = isctx ? 0 : CTX, L = isctx ? CTX : SEQ, t0 = pos0 - s0;
  const size_t mb = (size_t)b * SP + s0;
  const u16* proj = (const u16*)(p.ws + WS_PROJ);
  if (part == 0) {
    u16* P = (u16*)smem;
    for (int i = tid; i < 80 * 64; i += NT) {
      int r = i >> 6, ch = i & 63, t = t0 - 8 + r;
      uint4 v = make_uint4(0, 0, 0, 0);
      if (t >= 0 && t < L) v = *(const uint4*)(proj + (mb + t) * DINP + ch * 8);
      *(uint4*)(P + r * 512 + ch * 8) = v;
    }
    __syncthreads();
    const int c = tid, g = c >> 7, hw = 1 << g;
    u16* U = (u16*)(p.ws + WS_U);
    float s = 0.f;
    for (int q = -hw; q < hw; ++q) s += bf2f(P[(8 + q) * 512 + c]);
#pragma unroll 4
    for (int tt = 0; tt < 64; ++tt) {
      int t = t0 + tt, lo = max(t - hw, 0), hi = min(t + hw, L);
      float u = s / (float)(hi - lo) - bf2f(P[(tt + 8) * 512 + c]);
      U[(mb + t) * 512 + c] = f2bf(u);
      s += bf2f(P[(tt + 8 + hw) * 512 + c]) - bf2f(P[(tt + 8 - hw) * 512 + c]);
    }
    __syncthreads();
  } else if (part <= 4) {
    const int ch0 = (part - 1) * 128;
    constexpr int PITCH = 136;
    u16* X = (u16*)smem;
    float* T = (float*)(smem + 3 * 66 * PITCH * 2 + 64);
    for (int i = tid; i < 3 * 66 * 16; i += NT) {
      int pr = i / (66 * 16), rem = i - pr * 66 * 16, r = rem >> 4, ch = rem & 15, t = t0 - 1 + r;
      uint4 v = make_uint4(0, 0, 0, 0);
      if (t >= 0 && t < L) v = *(const uint4*)(proj + (mb + t) * DINP + OFF_HY + pr * 512 + ch0 + ch * 8);
      *(uint4*)(X + (pr * 66 + r) * PITCH + ch * 8) = v;
    }
    __syncthreads();
    const float* cw = pin(p, 12) + l * 3 * 1536;
    const float* cb = pin(p, 13) + l * 1536;
    {
      const int c = tid & 127, tq = tid >> 7, col = ch0 + c;
      const float w00 = cw[col], w01 = cw[1536 + col], w02 = cw[3072 + col], b0 = cb[col];
      const float w10 = cw[512 + col], w11 = cw[1536 + 512 + col], w12 = cw[3072 + 512 + col], b1 = cb[512 + col];
      const float w20 = cw[1024 + col], w21 = cw[1536 + 1024 + col], w22 = cw[3072 + 1024 + col], b2 = cb[1024 + col];
      const u16* X0 = X, *X1 = X + 66 * PITCH, *XV = X + 2 * 66 * PITCH;
      u16* Y = (u16*)(p.ws + WS_Y);
#pragma unroll 4
      for (int tt = tq * 16; tt < tq * 16 + 16; ++tt) {
        float x0 = w00 * bf2f(X0[tt * PITCH + c]) + w01 * bf2f(X0[(tt + 1) * PITCH + c]) + w02 * bf2f(X0[(tt + 2) * PITCH + c]) + b0;
        float x1 = w10 * bf2f(X1[tt * PITCH + c]) + w11 * bf2f(X1[(tt + 1) * PITCH + c]) + w12 * bf2f(X1[(tt + 2) * PITCH + c]) + b1;
        float vv = w20 * bf2f(XV[tt * PITCH + c]) + w21 * bf2f(XV[(tt + 1) * PITCH + c]) + w22 * bf2f(XV[(tt + 2) * PITCH + c]) + b2;
        Y[(mb + t0 + tt) * 512 + col] = f2bf(x0);
        T[c * 65 + tt] = x1 * vv;
      }
    }
    __syncthreads();
    {
      float* ZV = (float*)(p.ws + WS_ZV);
#pragma unroll 4
      for (int cc = 0; cc < 16; ++cc) {
        int c = wid * 16 + cc;
        ZV[((size_t)(ch0 + c) * SP + pos0 + lane) * 2 + b] = T[c * 65 + lane];
      }
    }
    __syncthreads();
  } else {
    u16* projw = (u16*)(p.ws + WS_PROJ);
    const float* qg = pin(p, 24) + l * 384;
    const float* kg = pin(p, 26) + l * 256;
    const float2* rope = (const float2*)(p.ws + WS_ROPE);
    u16* Kb = (u16*)(p.ws + WS_K);
#pragma unroll 2
    for (int rr = 0; rr < 8; ++rr) {
      int tt = wid * 8 + rr, pos = pos0 + tt;
      u16* row = projw + ((size_t)b * SP + pos) * DINP;
      unsigned* q32 = (unsigned*)(row + OFF_Q);
      unsigned* k32 = (unsigned*)(row + OFF_KV);
      unsigned v[3], w[2];
      float ss = 0.f, s2 = 0.f;
#pragma unroll
      for (int j = 0; j < 3; ++j) v[j] = q32[lane + 64 * j];
#pragma unroll
      for (int j = 0; j < 2; ++j) w[j] = k32[lane + 64 * j];
      const int rd = lane & 31;
      float val = bf2f(row[OFF_KV + 256 + rd]);
#pragma unroll
      for (int j = 0; j < 3; ++j) { float a = bf2f(v[j] & 0xffff), c2 = bf2f(v[j] >> 16); ss += a * a + c2 * c2; }
#pragma unroll
      for (int j = 0; j < 2; ++j) { float a = bf2f(w[j] & 0xffff), c2 = bf2f(w[j] >> 16); s2 += a * a + c2 * c2; }
      ss = wave_sum(ss);
      s2 = wave_sum(s2);
      float r = rsqrtf(ss * (1.f / 384.f) + EPS), r2 = rsqrtf(s2 * (1.f / 256.f) + EPS);
#pragma unroll
      for (int j = 0; j < 3; ++j) {
        int n = (lane + 64 * j) * 2;
        q32[lane + 64 * j] = pk2(bf2f(v[j] & 0xffff) * r * qg[n], bf2f(v[j] >> 16) * r * qg[n + 1]);
      }
#pragma unroll
      for (int j = 0; j < 2; ++j) {
        int n = (lane + 64 * j) * 2;
        k32[lane + 64 * j] = pk2(bf2f(w[j] & 0xffff) * r2 * kg[n], bf2f(w[j] >> 16) * r2 * kg[n + 1]);
      }
      float partner = shx(val, 8);
      if (!isctx) {
        int t = pos - CTX, idx = (rd < 16) ? (t >> 6) : (t & 63);
        float2 cs = rope[idx * 8 + (rd & 7)];
        float sgn = (rd & 8) ? 1.f : -1.f;
        val = val * cs.x + sgn * partner * cs.y;
      }
      if (lane < 32) {
        u16 o = f2bf(val);
#pragma unroll
        for (int hd = 0; hd < 8; ++hd) Kb[((size_t)(b * 8 + hd) * SP + pos) * 96 + 64 + rd] = o;
      }
    }
  }
}

__device__ __forceinline__ void bf_fwd(float2* X, int base, int q, float2 w1) {
  float2 w2 = cmul(w1, w1), w3 = cmul(w2, w1);
  float2 a0 = X[base], a1 = X[base + q], a2 = X[base + 2 * q], a3 = X[base + 3 * q];
  float2 s02 = make_float2(a0.x + a2.x, a0.y + a2.y), d02 = make_float2(a0.x - a2.x, a0.y - a2.y);
  float2 s13 = make_float2(a1.x + a3.x, a1.y + a3.y), d13 = make_float2(a1.x - a3.x, a1.y - a3.y);
  X[base] = make_float2(s02.x + s13.x, s02.y + s13.y);
  X[base + q] = cmul(make_float2(d02.x + d13.y, d02.y - d13.x), w1);
  X[base + 2 * q] = cmul(make_float2(s02.x - s13.x, s02.y - s13.y), w2);
  X[base + 3 * q] = cmul(make_float2(d02.x - d13.y, d02.y + d13.x), w3);
}
__device__ __forceinline__ void bf_inv(float2* X, int base, int q, float2 w1) {
  w1.y = -w1.y;
  float2 w2 = cmul(w1, w1), w3 = cmul(w2, w1);
  float2 b0 = X[base], c1 = cmul(X[base + q], w1), c2 = cmul(X[base + 2 * q], w2), c3 = cmul(X[base + 3 * q], w3);
  float2 s02 = make_float2(b0.x + c2.x, b0.y + c2.y), d02 = make_float2(b0.x - c2.x, b0.y - c2.y);
  float2 s13 = make_float2(c1.x + c3.x, c1.y + c3.y), d13 = make_float2(c1.x - c3.x, c1.y - c3.y);
  X[base] = make_float2(s02.x + s13.x, s02.y + s13.y);
  X[base + q] = make_float2(d02.x - d13.y, d02.y + d13.x);
  X[base + 2 * q] = make_float2(s02.x - s13.x, s02.y - s13.y);
  X[base + 3 * q] = make_float2(d02.x + d13.y, d02.y - d13.x);
}
template <bool INV>
__device__ __forceinline__ void fft_pass(float2* X, const float2* __restrict__ tw, int lq, int tid) {
  const int q = 1 << lq, sh = 12 - lq;
  if (lq == 12) {
    float2 w[8];
#pragma unroll
    for (int b8 = 0; b8 < 8; ++b8) w[b8] = tw[b8 * NT + tid];
#pragma unroll
    for (int b8 = 0; b8 < 8; ++b8) { int u = b8 * NT + tid; if (INV) bf_inv(X, u, q, w[b8]); else bf_fwd(X, u, q, w[b8]); }
  } else if (lq == 10) {
    float2 wA = tw[tid << 2], wB = tw[(512 + tid) << 2];
#pragma unroll 2
    for (int b8 = 0; b8 < 8; ++b8) {
      int u = b8 * NT + tid, j = u & 1023, base = ((u >> 10) << 12) + j;
      float2 w = (b8 & 1) ? wB : wA;
      if (INV) bf_inv(X, base, q, w); else bf_fwd(X, base, q, w);
    }
  } else {
    const int j = tid & (q - 1);
    float2 w = tw[j << sh];
#pragma unroll 2
    for (int b8 = 0; b8 < 8; ++b8) {
      int u = b8 * NT + tid, base = ((u >> lq) << (lq + 2)) + j;
      if (INV) bf_inv(X, base, q, w); else bf_fwd(X, base, q, w);
    }
  }
  __syncthreads();
}
__device__ __forceinline__ void fft_dif(float2* X, const float2* __restrict__ tw) {
  const int tid = tid_l();
  for (int lq = 12; lq >= 0; lq -= 2) fft_pass<false>(X, tw, lq, tid);
}
__device__ __forceinline__ void fft_dit_inv(float2* X, const float2* __restrict__ tw) {
  const int tid = tid_l();
  for (int lq = 0; lq <= 12; lq += 2) fft_pass<true>(X, tw, lq, tid);
}
__device__ __forceinline__ float block_sum(float v, float* red) {
  v = wave_sum(v);
  __syncthreads();
  { const int tb = tid_l(); if ((tb & 63) == 0) red[tb >> 6] = v; }
  __syncthreads();
  float s = red[0] + red[1] + red[2] + red[3] + red[4] + red[5] + red[6] + red[7];
  __syncthreads();
  return s;
}

__device__ __forceinline__ void fft_task(const Ctx& p, int l, int c, char* smem) {
  float2* X = (float2*)smem;
  float* aux = (float*)(smem + AUX_OFF);
  float* red = aux + 128;
  const int tid = tid_l();
  const float2* tw = (const float2*)(p.ws + WS_TW);
  const float* w3 = pin(p, 20) + (size_t)l * 64 * 1024;
  if (tid < 64) { aux[tid] = w3[tid * 1024 + c]; aux[64 + tid] = w3[tid * 1024 + 512 + c]; }
  __syncthreads();
  const float dF = fabsf(pin(p, 21)[(l * 2 + 0) * 512 + c]), dB = fabsf(pin(p, 21)[(l * 2 + 1) * 512 + c]);
  const float bias = pin(p, 22)[l * 512 + c];
  float2* zp = (float2*)(p.ws + WS_ZV) + (size_t)c * SP;
  float l1 = 0.f;
  {
    const float* hid = (const float*)(p.ws + WS_HID2) + (size_t)l * 64 * 8192 + tid;
    float af[16], ab[16];
#pragma unroll
    for (int i = 0; i < 16; ++i) { af[i] = 0.f; ab[i] = 0.f; }
#pragma unroll 2
    for (int k = 0; k < 64; ++k) {
      const float wf = aux[k], wb = aux[64 + k];
#pragma unroll
      for (int i = 0; i < 16; ++i) { float v = hid[(size_t)k * 8192 + i * NT]; af[i] += v * wf; ab[i] += v * wb; }
    }
#pragma unroll
    for (int i = 0; i < 16; ++i) {
      int t = i * NT + tid;
      float tl = (float)t * (1.f / 8191.f);
      float hf = af[i] * expf(-tl * dF);
      float hb = ab[i] * expf(-tl * dB);
      X[t] = make_float2(hf, 0.f);
      if (t >= 1) { X[16384 - t] = make_float2(hb, 0.f); l1 += fabsf(hf) + fabsf(hb); }
      else { X[8192] = make_float2(0.f, 0.f); l1 += fabsf(hf); }
    }
  }
  float l1tot = block_sum(l1, red);
  fft_dif(X, tw);
  float2 F[32];
  {
    float s = 1.f / (l1tot * 16384.f);
#pragma unroll
    for (int i = 0; i < 32; ++i) { float2 v = X[i * NT + tid]; F[i] = make_float2(v.x * s, v.y * s); }
  }
  __syncthreads();
#pragma unroll 2
  for (int i = 0; i < 16; ++i) {
    int t = i * NT + tid;
    X[t] = zp[CTX + t];
    X[8192 + t] = make_float2(0.f, 0.f);
  }
  __syncthreads();
  fft_dif(X, tw);
#pragma unroll
  for (int i = 0; i < 32; ++i) { int idx = i * NT + tid; X[idx] = cmul(X[idx], F[i]); }
  __syncthreads();
  fft_dit_inv(X, tw);
#pragma unroll 2
  for (int i = 0; i < 16; ++i) {
    int t = i * NT + tid;
    float2 z = zp[CTX + t], y = X[t];
    zp[CTX + t] = make_float2(y.x + bias * z.x, y.y + bias * z.y);
  }
  __syncthreads();
  {
    float* hFc = (float*)smem;
    float* hBc = hFc + 256;
    float2* zc = (float2*)(hBc + 256);
    float l1c = 0.f;
    if (tid < 256) {
      int t = tid;
      const float* hc = (const float*)(p.ws + WS_HID2C) + (size_t)l * 64 * 256 + t;
      float hf = 0.f, hb = 0.f;
#pragma unroll 8
      for (int k = 0; k < 64; ++k) { float v = hc[k * 256]; hf += v * aux[k]; hb += v * aux[64 + k]; }
      float tl = (float)t * (1.f / 255.f);
      hf *= expf(-tl * dF);
      hb *= expf(-tl * dB);
      hFc[t] = hf;
      hBc[t] = hb;
      l1c = fabsf(hf) + (t >= 1 ? fabsf(hb) : 0.f);
      zc[t] = zp[t];
    }
    float l1ct = block_sum(l1c, red);
    const int bb = tid >> 8, t = tid & 255;
    float acc = 0.f;
    for (int s = 0; s < 256; ++s) {
      float kf = (s <= t) ? hFc[t - s] : hBc[s - t];
      float2 z = zc[s];
      acc += kf * (bb ? z.y : z.x);
    }
    float2 z = zc[t];
    ((float*)zp)[t * 2 + bb] = acc / l1ct + bias * (bb ? z.y : z.x);
    __syncthreads();
  }
}

constexpr int AT_KP = 208, AT_VP = 136, AT_STAGE = 64 * AT_KP + 64 * AT_VP;
__device__ __forceinline__ void attn_task(const Ctx& p, int bh, int qb, char* smem) {
  const int tid = tid_l(), wid = tid >> 6, lane = tid & 63, r = lane & 31, hh = lane >> 5;
  const u16* Qp = (const u16*)(p.ws + WS_Q) + ((size_t)bh * SP + qb * 256) * 96;
  const u16* Kp = (const u16*)(p.ws + WS_K) + (size_t)bh * SP * 96;
  const u16* Vp = (const u16*)(p.ws + WS_VT) + (size_t)bh * 64 * SP;
  const int nkt = (qb == 0) ? 4 : 132;
  bf16x8 qf[6];
#pragma unroll
  for (int ks = 0; ks < 6; ++ks) qf[ks] = *(const bf16x8*)(Qp + (size_t)(wid * 32 + r) * 96 + ks * 16 + hh * 8);
  f32x16 o0, o1;
#pragma unroll
  for (int i = 0; i < 16; ++i) { o0[i] = 0.f; o1[i] = 0.f; }
  float mrun = -1e30f, lrun = 0.f;
  const u16* src[3];
  int dst[3], kstep[3];
#pragma unroll
  for (int i = 0; i < 3; ++i) {
    int ch = tid + i * NT;
    if (ch < 768) { int row = ch / 12, cc = ch - row * 12; src[i] = Kp + (size_t)row * 96 + cc * 8; dst[i] = row * AT_KP + cc * 16; kstep[i] = 64 * 96; }
    else { int v = ch - 768, row = (v >> 3) & 63, cc = v & 7; src[i] = Vp + (size_t)row * SP + cc * 8; dst[i] = 64 * AT_KP + row * AT_VP + cc * 16; kstep[i] = 64; }
  }
  const bool has3 = tid < 256;
  uint4 st[3];
#define AT_LOAD(t)                                                                                   \
  do {                                                                                               \
    st[0] = *(const uint4*)(src[0] + (size_t)(t) * kstep[0]);                                        \
    st[1] = *(const uint4*)(src[1] + (size_t)(t) * kstep[1]);                                        \
    if (has3) st[2] = *(const uint4*)(src[2] + (size_t)(t) * kstep[2]);                              \
  } while (0)
#define AT_WRITE1(i, base)                                                                           \
  do {                                                                                               \
    uint2* d_ = (uint2*)((base) + dst[i]);                                                           \
    d_[0] = make_uint2(st[i].x, st[i].y);                                                            \
    d_[1] = make_uint2(st[i].z, st[i].w);                                                            \
  } while (0)
#define AT_WRITE(buf)                                                                                \
  do {                                                                                               \
    char* base_ = smem + (buf) * AT_STAGE;                                                           \
    AT_WRITE1(0, base_); AT_WRITE1(1, base_);                                                        \
    if (has3) AT_WRITE1(2, base_);                                                                   \
  } while (0)
  AT_LOAD(0);
  AT_WRITE(0);
  __syncthreads();
  for (int t = 0; t < nkt; ++t) {
    const int cur = t & 1;
    if (t + 1 < nkt) AT_LOAD(t + 1);
    const char* Ks = smem + cur * AT_STAGE;
    const char* Vs = Ks + 64 * AT_KP;
    f32x16 s0, s1;
#pragma unroll
    for (int i = 0; i < 16; ++i) { s0[i] = 0.f; s1[i] = 0.f; }
#pragma unroll
    for (int ks = 0; ks < 6; ++ks) {
      bf16x8 a0 = *(const bf16x8*)(Ks + r * AT_KP + ks * 32 + hh * 16);
      bf16x8 a1 = *(const bf16x8*)(Ks + (32 + r) * AT_KP + ks * 32 + hh * 16);
      s0 = __builtin_amdgcn_mfma_f32_32x32x16_bf16(a0, qf[ks], s0, 0, 0, 0);
      s1 = __builtin_amdgcn_mfma_f32_32x32x16_bf16(a1, qf[ks], s1, 0, 0, 0);
    }
    float mx = s0[0];
#pragma unroll
    for (int i = 1; i < 16; ++i) mx = fmaxf(mx, s0[i]);
#pragma unroll
    for (int i = 0; i < 16; ++i) mx = fmaxf(mx, s1[i]);
    mx = fmaxf(mx, shx(mx, 32));
    const float mnew = fmaxf(mrun, mx);
    const bool grow = __any(mnew > mrun);
    const float alpha = __builtin_amdgcn_exp2f(mrun - mnew);
    mrun = mnew;
    float ps = 0.f;
#pragma unroll
    for (int i = 0; i < 16; ++i) { s0[i] = __builtin_amdgcn_exp2f(s0[i] - mnew); ps += s0[i]; }
#pragma unroll
    for (int i = 0; i < 16; ++i) { s1[i] = __builtin_amdgcn_exp2f(s1[i] - mnew); ps += s1[i]; }
    lrun = lrun * alpha + ps;
    if (grow) {
#pragma unroll
      for (int i = 0; i < 16; ++i) { o0[i] *= alpha; o1[i] *= alpha; }
    }
#pragma unroll
    for (int kb = 0; kb < 2; ++kb) {
#pragma unroll
      for (int sI = 0; sI < 2; ++sI) {
        union { bf16x8 v; unsigned u[4]; } pu;
#pragma unroll
        for (int j = 0; j < 4; ++j) pu.u[j] = kb == 0 ? pk2(s0[8 * sI + 2 * j], s0[8 * sI + 2 * j + 1]) : pk2(s1[8 * sI + 2 * j], s1[8 * sI + 2 * j + 1]);
        const bf16x8 pf = pu.v;
        const int koff = (kb * 32 + 16 * sI + 4 * hh) * 2;
        union { bf16x8 v; uint2 h2[2]; } va, vb;
        va.h2[0] = *(const uint2*)(Vs + r * AT_VP + koff);
        va.h2[1] = *(const uint2*)(Vs + r * AT_VP + koff + 16);
        vb.h2[0] = *(const uint2*)(Vs + (32 + r) * AT_VP + koff);
        vb.h2[1] = *(const uint2*)(Vs + (32 + r) * AT_VP + koff + 16);
        o0 = __builtin_amdgcn_mfma_f32_32x32x16_bf16(va.v, pf, o0, 0, 0, 0);
        o1 = __builtin_amdgcn_mfma_f32_32x32x16_bf16(vb.v, pf, o1, 0, 0, 0);
      }
    }
    if (t + 1 < nkt) AT_WRITE(cur ^ 1);
    __syncthreads();
  }
  const float ltot = lrun + shx(lrun, 32);
  const float inv = 1.f / ltot;
  const int b = bh >> 3, head = bh & 7;
  u16* Op = (u16*)(p.ws + WS_O) + ((size_t)b * SP + qb * 256 + wid * 32 + r) * 512 + head * 64;
#pragma unroll
  for (int g = 0; g < 4; ++g) {
    uint2 w0, w1;
    w0.x = pk2(o0[4 * g] * inv, o0[4 * g + 1] * inv);
    w0.y = pk2(o0[4 * g + 2] * inv, o0[4 * g + 3] * inv);
    w1.x = pk2(o1[4 * g] * inv, o1[4 * g + 1] * inv);
    w1.y = pk2(o1[4 * g + 2] * inv, o1[4 * g + 3] * inv);
    *(uint2*)(Op + 8 * g + 4 * hh) = w0;
    *(uint2*)(Op + 32 + 8 * g + 4 * hh) = w1;
  }
#undef AT_LOAD
#undef AT_WRITE
#undef AT_WRITE1
}

__device__ __forceinline__ void hypost_task(const Ctx& p, int task, char* smem) {
  const int tid = tid_l(), lane = tid & 63, wid = tid >> 6;
  const int tile64 = task >> 1, ch0 = (task & 1) * 256;
  const int m0 = tile64 * 64, b = m0 / SP, pos0 = m0 - b * SP;
  float* T = (float*)smem;
  const float* ZV = (const float*)(p.ws + WS_ZV);
  for (int cc = 0; cc < 32; ++cc) {
    int c = wid * 32 + cc;
    T[c * 65 + lane] = ZV[((size_t)(ch0 + c) * SP + pos0 + lane) * 2 + b];
  }
  __syncthreads();
  u16* Y = (u16*)(p.ws + WS_Y);
  const int c = tid & 255, th = tid >> 8;
  u16* yp = Y + (size_t)(m0 + th * 32) * 512 + ch0 + c;
  u16 yv[32];
#pragma unroll
  for (int i = 0; i < 32; ++i) yv[i] = yp[(size_t)i * 512];
#pragma unroll
  for (int i = 0; i < 32; ++i) yp[(size_t)i * 512] = f2bf(bf2f(yv[i]) * T[c * 65 + th * 32 + i]);
  __syncthreads();
}

#ifndef PHMASK
#define PHMASK 0xFFFF
#endif
#define PHON(k) (((PHMASK) >> (k)) & 1)
constexpr int NPH = 1 + 4 * 10 + 1;
__global__ void __launch_bounds__(NT, 2) mega(Params prm) {
  __shared__ __attribute__((aligned(1024))) char smem[LDS_BYTES];
  cg::grid_group grid = cg::this_grid();
  const int bid = blockIdx.x, nb = gridDim.x;
  {
    unsigned long long* it = (unsigned long long*)(smem + AUX_OFF + 6144);
    if (threadIdx.x < 33) it[threadIdx.x] = (unsigned long long)prm.in[threadIdx.x];
    __syncthreads();
  }
  if (prm.ph_lo == 0) {
    Ctx p;
    p.intab = (const unsigned long long*)(smem + AUX_OFF + 6144);
    p.ws = prm.ws;
    p.out = prm.out;
    const int bid = blockIdx.x, nb = gridDim.x;
      if (PHON(10)) {
      p0_misc(p);
      for (int t = bid; t < 192; t += nb) p0_mod_task(p, t, smem);
      for (int t = bid; t < 528; t += nb) p0_hid_task(p, t, smem);
      }
  }
  unsigned nbar = 0;
  for (int ph = prm.ph_lo; ph < prm.ph_hi; ++ph) {
    Ctx p;
    p.intab = (const unsigned long long*)(smem + AUX_OFF + 6144);
    p.ws = prm.ws;
    p.out = prm.out;
    asm volatile("" : "+s"(p.ws), "+s"(p.out));
    float* modall = (float*)(p.ws + WS_MOD);
    u16* proj = (u16*)(p.ws + WS_PROJ);
    u16* xn = (u16*)(p.ws + WS_U);
    char* wo = (char*)p.out;
    if (ph == 0) {
    } else if (ph == NPH - 1) {
      if (PHON(11)) final_norm(p);
    } else {
      const int l = (ph - 1) / 10, sp = (ph - 1) % 10;
      const float* modl = modall + (size_t)l * 3 * 6144;
      GD* tab = (GD*)(smem + AUX_OFF + 4096);
      int ng = 0, nN0 = 0, nN1 = 0, nsplit = 1;
      bool seq = false;
      const float* gate = modl;
      if (sp == 0 && PHON(0)) {
        for (int t = bid; t < 4168; t += nb) {
          int r = t;
          if (r < 1472) { wt_task(pin(p, 8) + (size_t)l * 1024 * DIN, 1024, DIN, (u16*)(wo + WO_IN), r, 92, smem); continue; } r -= 1472;
          if (r < 1024) { wt_task(pin(p, 30) + (size_t)l * 1024 * 4096, 1024, 4096, (u16*)(wo + WO_FF1), r, 64, smem); continue; } r -= 1024;
          if (r < 1024) { wt_task(pin(p, 31) + (size_t)l * 4096 * 1024, 4096, 1024, (u16*)(wo + WO_FF2), r, 16, smem); continue; } r -= 1024;
          if (r < 256) { wt_task(pin(p, 29) + (size_t)l * 1024 * 1024, 1024, 1024, (u16*)(wo + WO_OUT), r, 16, smem); continue; } r -= 256;
          if (r < 128) { wt_task(pin(p, 23) + (size_t)l * 512 * 1024, 512, 1024, (u16*)(wo + WO_HY), r, 16, smem); continue; } r -= 128;
          if (r < 128) { wt_task(pin(p, 28) + (size_t)l * 512 * 1024, 512, 1024, (u16*)(wo + WO_WO), r, 16, smem); continue; } r -= 128;
          if (r < 72) { wt_task(pin(p, 25) + (size_t)l * 384 * 768, 384, 768, (u16*)(wo + WO_UQ), r, 12, smem); continue; } r -= 72;
          wt_task(pin(p, 27) + (size_t)l * 256 * 1024, 256, 1024, (u16*)(wo + WO_UKV), r, 16, smem);
        }
        for (int t = bid; t < 32; t += nb) wpe_task(p, l, (t + 128) & 31, smem);
        norm_rows(p, pin(p, 6) + l * 1024, modl, 0, 1, xn);
      } else if (sp == 1 && PHON(1)) {
        if (threadIdx.x == 0) tab[0] = GD{xn, 1024, (const u16*)(wo + WO_IN), 1024, 1024, 23, EM_PROJ, 1};
        ng = 1; nN0 = 23;
      } else if (sp == 2 && PHON(2)) {
        for (int t = bid; t < 264 * 6; t += nb) premix_task(p, l, t, smem);
      } else if (sp == 3 && PHON(3)) {
        for (int t = bid; t < 512; t += nb) fft_task(p, l, t, smem);
        if (threadIdx.x == 0) {
          tab[0] = GD{proj + OFF_Q, DINP, (const u16*)(wo + WO_UQ), 384, 384, 3, EM_Q, 1};
          tab[1] = GD{proj + OFF_KV, DINP, (const u16*)(wo + WO_UKV), 256, 256, 4, EM_KV, 1};
        }
        ng = 2; nN0 = 3; nN1 = 4;
      } else if (sp == 4 && PHON(4)) {
        for (int t = bid; t < 528; t += nb) {
          int bh, qb;
          if (t < 512) { int rnd = t >> 8, w = t & 255; bh = (w & 7) + 8 * rnd; qb = 1 + (w >> 3); }
          else { bh = t - 512; qb = 0; }
          attn_task(p, bh, qb, smem);
        }
        for (int t = bid; t < 528; t += nb) hypost_task(p, t, smem);
      } else if (sp == 5 && PHON(5)) {
        for (int t = bid; t < 8 * 68; t += nb) {
          const int x = t & 7, g = t >> 3, pm = (g >> 2) * 8 + x;
          if (pm < 132) mix_tile(p, pm, g & 3, smem);
        }
      } else if (sp == 6 && PHON(6)) {
        if (threadIdx.x == 0) tab[0] = GD{(const u16*)(p.ws + WS_ZV), 1024, (const u16*)(wo + WO_OUT), 1024, 1024, 4, EM_RESID, 4};
        ng = 1; nN0 = 4; nsplit = 4;
        gate = modl + 2 * 1024;
      } else if (sp == 7 && PHON(7)) {
        norm_rows(p, pin(p, 7) + l * 1024, modl, 3, 4, xn);
      } else if (sp == 8 && PHON(8)) {
        if (threadIdx.x == 0) tab[0] = GD{xn, 1024, (const u16*)(wo + WO_FF1), 1024, 1024, 16, EM_SQRELU, 1};
        ng = 1; nN0 = 16;
      } else if (sp == 9 && PHON(9)) {
        if (threadIdx.x == 0) tab[0] = GD{proj, DFF, (const u16*)(wo + WO_FF2), 4096, 4096, 4, EM_RESID, 8};
        ng = 1; nN0 = 4; nsplit = 8;
        gate = modl + 5 * 1024;
      }
      if (ng > 0) {
        __syncthreads();
        const int nt0 = (nsplit > 1) ? (64 * nN0 + 2 * nN0 * nsplit) : NMT * nN0, ntot = seq ? nt0 : nt0 + NMT * nN1;
        const int nseq = seq ? ng : 1;
        const int nitems = ((ntot - bid + nb - 1) / nb) * nseq;
#pragma unroll 1
        for (int it = 0; it < nitems; ++it) {
          int t = bid + (it / nseq) * nb, gi = it % nseq, tt = t;
          if (!seq && t >= nt0) { gi = 1; tt = t - nt0; }
          const volatile GD* gp = tab + gi;
          unsigned long long a64 = (unsigned long long)gp->A, b64 = (unsigned long long)gp->Bt;
          a64 = ((unsigned long long)(unsigned)__builtin_amdgcn_readfirstlane((unsigned)(a64 >> 32)) << 32) | (unsigned long long)(unsigned)__builtin_amdgcn_readfirstlane((unsigned)a64);
          b64 = ((unsigned long long)(unsigned)__builtin_amdgcn_readfirstlane((unsigned)(b64 >> 32)) << 32) | (unsigned long long)(unsigned)__builtin_amdgcn_readfirstlane((unsigned)b64);
          const int lda = __builtin_amdgcn_readfirstlane(gp->lda), ldb = __builtin_amdgcn_readfirstlane(gp->ldb);
          const int K = __builtin_amdgcn_readfirstlane(gp->K), nN = __builtin_amdgcn_readfirstlane(gp->nN);
          const int ks = __builtin_amdgcn_readfirstlane(gp->ks);
          const int mode = __builtin_amdgcn_readfirstlane(gp->mode);
          int pm, pn, Kuse = K, emode = mode;
          if (ks > 1) {
            const int nlat = 64 * nN;
            if (tt < nlat) { int pm64; tile_map(tt, 64, nN, pm64, pn); pm = (pm64 >> 5) * 33 + 1 + (pm64 & 31); }
            else {
              int u = tt - nlat, kp = u % ks, tile = u / ks;
              pm = (tile / nN) * 33; pn = tile % nN;
              Kuse = K / ks; emode = EM_RESID_AT;
              a64 += (unsigned long long)kp * Kuse * 2; b64 += (unsigned long long)kp * Kuse * 2;
            }
          } else tile_map(tt, NMT, nN, pm, pn);
          Epi e{emode, p.ws, gate};
          gemm_tile((const u16*)a64, lda, (const u16*)b64, ldb, Kuse, pm * 256, pn * 256, smem, e);
        }
      }
    }
    if (ph + 1 < prm.ph_hi) {
      if (ph == prm.ph_lo) grid.sync();
      else { ++nbar; grid_barrier((unsigned*)(prm.ws + WS_BAR), nbar * gridDim.x); }
    }
  }
}

extern "C" void kernel_launch(void* const* d_in, const int* in_sizes, int n_in, void* d_out, int out_size, void* d_ws,
                              size_t ws_size, hipStream_t stream) {
  static int grid_blocks = 0;
  if (grid_blocks == 0) {
    if (n_in != 33 || ws_size < WS_END || (size_t)out_size * 4 < WO_END) {
      fprintf(stderr, "kernel_launch: unexpected sizes n_in=%d ws=%zu (need %zu) out=%d\n", n_in, ws_size, (size_t)WS_END, out_size);
      grid_blocks = -1;
      return;
    }
    int dev = 0, cus = 0, per_cu = 0;
    hipGetDevice(&dev);
    hipDeviceGetAttribute(&cus, hipDeviceAttributeMultiprocessorCount, dev);
    hipOccupancyMaxActiveBlocksPerMultiprocessor(&per_cu, mega, NT, 0);
    if (per_cu < 1) per_cu = 1;
    if (per_cu > 1) per_cu = 1;
    grid_blocks = cus * per_cu;
  }
  if (grid_blocks < 0) return;
  Params p{};
  for (int i = 0; i < 33; ++i) p.in[i] = (const float*)d_in[i];
  p.out = (float*)d_out;
  p.ws = (char*)d_ws;
  p.ph_lo = 0;
  p.ph_hi = NPH;
  (void)hipMemsetAsync((char*)d_ws + WS_BAR, 0, 1024, stream);
  void* args[] = {&p};
  hipError_t e = hipLaunchCooperativeKernel((void*)mega, dim3(grid_blocks), dim3(NT), args, 0, stream);
  if (e != hipSuccess) fprintf(stderr, "cooperative launch failed: %s (grid %d)\n", hipGetErrorString(e), grid_blocks);
}
```

```cpp
#include <hip/hip_runtime.h>
#include <hip/hip_cooperative_groups.h>
#include <cstdio>
namespace cg = cooperative_groups;

typedef unsigned short u16;
using bf16x8 = __attribute__((ext_vector_type(8))) short;
using f32x4 = __attribute__((ext_vector_type(4))) float;
using f32x16 = __attribute__((ext_vector_type(16))) float;

constexpr int D = 1024, SEQ = 8192, CTX = 256, SP = 8448, MROWS = 16896, NMT = 66;
constexpr int DIN = 5792, DINP = 5888, DFF = 4096;
constexpr int OFF_HY = 512, OFF_Q = 2048, OFF_KV = 2432, OFF_GATE = 2720;
constexpr int NT = 512;
constexpr float EPS = 1e-6f;

constexpr size_t WS_H = 0;
constexpr size_t WS_PROJ = WS_H + (size_t)MROWS * D * 4;
constexpr size_t WS_U = WS_PROJ + (size_t)MROWS * DINP * 2;
constexpr size_t WS_Y = WS_U + (size_t)MROWS * 512 * 2;
constexpr size_t WS_O = WS_Y + (size_t)MROWS * 512 * 2;
constexpr size_t WS_Q = WS_O + (size_t)MROWS * 512 * 2;
constexpr size_t WS_K = WS_Q + (size_t)16 * SP * 96 * 2;
constexpr size_t WS_VT = WS_K + (size_t)16 * SP * 96 * 2;
constexpr size_t WS_ZV = WS_VT + (size_t)16 * 64 * SP * 2;
constexpr size_t WS_HID2 = WS_ZV + (size_t)512 * SP * 8;
constexpr size_t WS_HID2C = WS_HID2 + (size_t)4 * 8192 * 64 * 4;
constexpr size_t WS_MOD = WS_HID2C + (size_t)4 * 256 * 64 * 4;
constexpr size_t WS_ROPE = WS_MOD + (size_t)4 * 3 * 6144 * 4;
constexpr size_t WS_TW = WS_ROPE + (size_t)128 * 8 * 8;
constexpr size_t WS_WPE = WS_TW + (size_t)16384 * 8;
constexpr size_t WS_BAR = WS_WPE + (size_t)4 * 1024 * 512 * 2;
constexpr size_t WS_END = WS_BAR + 1024;
constexpr size_t WO_IN = 0;
constexpr size_t WO_FF1 = WO_IN + (size_t)DINP * 1024 * 2;
constexpr size_t WO_FF2 = WO_FF1 + (size_t)4096 * 1024 * 2;
constexpr size_t WO_OUT = WO_FF2 + (size_t)4096 * 1024 * 2;
constexpr size_t WO_HY = WO_OUT + (size_t)1024 * 1024 * 2;
constexpr size_t WO_WO = WO_HY + (size_t)1024 * 512 * 2;
constexpr size_t WO_PE = WO_WO + (size_t)1024 * 512 * 2;
constexpr size_t WO_UQ = WO_PE + (size_t)1024 * 512 * 2;
constexpr size_t WO_UKV = WO_UQ + (size_t)768 * 384 * 2;
constexpr size_t WO_FILT = WO_UKV + (size_t)1024 * 256 * 2;
constexpr size_t WO_END = WO_FILT + (size_t)1024 * 8192 * 2;
constexpr size_t WS_W3T = WS_HID2 + (size_t)4 * 8192 * 64 * 2;

constexpr int AUX_OFF = 147456;
constexpr int LDS_BYTES = AUX_OFF + 8192;

struct Params {
  const float* in[33];
  float* out;
  char* ws;
  int ph_lo, ph_hi;
};

struct Ctx { const unsigned long long* intab; char* ws; float* out; };
__device__ __forceinline__ const float* pin(const Ctx& c, int i) {
  unsigned long long v = c.intab[i];
  unsigned lo = __builtin_amdgcn_readfirstlane((unsigned)v), hi = __builtin_amdgcn_readfirstlane((unsigned)(v >> 32));
  return (const float*)(((unsigned long long)hi << 32) | lo);
}

typedef __bf16 hwbf2 __attribute__((ext_vector_type(2)));
typedef float hwf2 __attribute__((ext_vector_type(2)));
__device__ __forceinline__ unsigned pk2(float a, float b) {
  hwf2 v = {a, b};
  hwbf2 r = __builtin_convertvector(v, hwbf2);
  return __builtin_bit_cast(unsigned, r);
}
__device__ __forceinline__ u16 f2bf(float f) { return (u16)(pk2(f, 0.f) & 0xffffu); }
__device__ __forceinline__ float bf2f(u16 b) { return __uint_as_float(((unsigned)b) << 16); }
__device__ __forceinline__ float shx(float v, int o) {
  int l = __builtin_amdgcn_mbcnt_hi(~0u, __builtin_amdgcn_mbcnt_lo(~0u, 0u));
  asm volatile("" : "+v"(l));
  return __int_as_float(__builtin_amdgcn_ds_bpermute((l ^ o) << 2, __float_as_int(v)));
}
__device__ __forceinline__ float wave_sum(float v) {
#pragma unroll
  for (int o = 1; o < 64; o <<= 1) v += shx(v, o);
  return v;
}
__device__ __forceinline__ int grp_of_row(int m) {
  int tile = m >> 8, b = tile / 33, t33 = tile - b * 33;
  return t33 == 0 ? 2 : b;
}
__device__ __forceinline__ float2 cmul(float2 a, float2 b) { return make_float2(a.x * b.x - a.y * b.y, a.x * b.y + a.y * b.x); }

__device__ __forceinline__ int tid_l() { int t = threadIdx.x; asm volatile("" : "+v"(t)); return t; }
__device__ __forceinline__ void grid_barrier(unsigned* bar, unsigned target) {
  asm volatile("s_waitcnt vmcnt(0)" ::: "memory");
  __syncthreads();
  if (threadIdx.x == 0) {
    __builtin_amdgcn_fence(__ATOMIC_RELEASE, "agent");
    asm volatile("s_waitcnt vmcnt(0)" ::: "memory");
    __hip_atomic_fetch_add(bar, 1u, __ATOMIC_RELAXED, __HIP_MEMORY_SCOPE_AGENT);
    while (__hip_atomic_load(bar, __ATOMIC_RELAXED, __HIP_MEMORY_SCOPE_AGENT) < target) __builtin_amdgcn_s_sleep(2);
    __builtin_amdgcn_fence(__ATOMIC_ACQUIRE, "agent");
    asm volatile("s_waitcnt vmcnt(0)" ::: "memory");
  }
  __syncthreads();
}
#define WAIT_V(n) asm volatile("s_waitcnt vmcnt(%0)" ::"n"(n) : "memory")
#define SCHED() __builtin_amdgcn_sched_barrier(0)
#define RAW_BARRIER() do { asm volatile("s_waitcnt lgkmcnt(0)" ::: "memory"); __builtin_amdgcn_s_barrier(); } while (0)

constexpr float QSCALE = 0.10206207261596575f * 1.4426950408889634f;
enum { EM_PROJ = 0, EM_SQRELU = 1, EM_RESID = 2, EM_RESID_AT = 3, EM_FILT = 4, EM_Q = 6, EM_KV = 7 };
struct Epi {
  int mode;
  char* ws;
  const float* gate;
  const float2* rope_lds;
  u16* filt_out;
  __device__ __forceinline__ void proj(int row, int col, f32x4 v) const {
    {
      u16* out = (u16*)(ws + WS_PROJ);
#pragma unroll
      for (int j = 0; j < 4; ++j) out[(size_t)(row + j) * DINP + col] = f2bf(v[j]);
    }
  }
  __device__ __forceinline__ void sqrelu(int row, int col, f32x4 v) const {
    {
      u16* out = (u16*)(ws + WS_PROJ);
#pragma unroll
      for (int j = 0; j < 4; ++j) { float r = fmaxf(v[j], 0.f); out[(size_t)(row + j) * DFF + col] = f2bf(r * r); }
    }
  }
  __device__ __forceinline__ void resid(int row, int col, f32x4 v) const {
    {
      float* h = (float*)(ws + WS_H);
      float g = gate[grp_of_row(row) * 6144 + col];
#pragma unroll
      for (int j = 0; j < 4; ++j) unsafeAtomicAdd(h + (size_t)(row + j) * D + col, g * v[j]);
    }
  }
  __device__ __forceinline__ void filt(int row, int col, f32x4 v) const {
    uint2 o;
    o.x = pk2(v[0], v[1]);
    o.y = pk2(v[2], v[3]);
    *(uint2*)(filt_out + (size_t)col * 8192 + row) = o;
  }
  __device__ __forceinline__ void q(int row, int col, f32x4 v) const {
    {
      u16* Q = (u16*)(ws + WS_Q);
      const float2* rope = rope_lds;
      int head = col / 96, d = col - head * 96;
      int b = row / SP, pos0 = row - b * SP;
      bool isrope = (d >= 64) && (pos0 >= CTX);
      int rd = d - 64;
#pragma unroll
      for (int j = 0; j < 4; ++j) {
        float val = v[j];
        float partner = shx(val, 8);
        int pos = pos0 + j;
        if (isrope) {
          int t = pos - CTX, idx = (rd < 16) ? (t >> 6) : (t & 63);
          float2 cs = rope[idx * 8 + (rd & 7)];
          float sgn = (rd & 8) ? 1.f : -1.f;
          val = val * cs.x + sgn * partner * cs.y;
        }
        Q[((size_t)(b * 8 + head) * SP + pos) * 96 + d] = f2bf(val * QSCALE);
      }
    }
  }
  __device__ __forceinline__ void kv(int row, int col, f32x4 v) const {
    {
      u16* Kb = (u16*)(ws + WS_K);
      u16* Vt = (u16*)(ws + WS_VT);
      int head = col >> 7, j2 = col & 127;
      int b = row / SP, pos0 = row - b * SP;
      if (j2 < 64) {
#pragma unroll
        for (int j = 0; j < 4; ++j) Kb[((size_t)(b * 8 + head) * SP + pos0 + j) * 96 + j2] = f2bf(v[j]);
      } else {
        uint2 o;
        o.x = pk2(v[0], v[1]);
        o.y = pk2(v[2], v[3]);
        *(uint2*)(Vt + ((size_t)(b * 8 + head) * 64 + (j2 - 64)) * SP + pos0) = o;
      }
    }
  }
};
struct GD { const u16* A; int lda; const u16* Bt; int ldb; int K; int nN; int mode; int ks; };

constexpr int G_TILE_B = 256 * 64 * 2, G_STAGE_B = 2 * G_TILE_B;
__device__ __forceinline__ int lds_byte(int r, int c) {
  int st = (r >> 4) * 2 + (c >> 5), ob = (r & 15) * 64 + (c & 31) * 2;
  return st * 1024 + (ob ^ (((ob >> 9) & 1) << 5));
}
__device__ __forceinline__ void stage_rc(int b, int& R, int& C) {
  int st = b >> 10, sb = b & 1023, swz = sb ^ (((sb >> 9) & 1) << 5);
  R = (st / 2) * 16 + swz / 64;
  C = (st % 2) * 32 + (swz % 64) / 2;
}

template <int MI>
__device__ __forceinline__ void gemm_core(const u16* __restrict__ A, int lda, const u16* __restrict__ Bt, int ldb, int K,
                                          int brow, int bcol, char* shm, f32x4 (&acc)[MI][4]) {
  constexpr int TILE_A = MI * 32 * 64 * 2, TILE_BB = 256 * 64 * 2, STAGE = TILE_A + TILE_BB;
  const int tid = tid_l(), wid = tid >> 6, lane = tid & 63, wr = wid >> 2, wc = wid & 3, fr = lane & 15, fq = lane >> 4;
  const u16* Ab = A + (size_t)brow * lda;
  const u16* Bb = Bt + (size_t)bcol * ldb;
  int sR[4], sC[4];
#pragma unroll
  for (int i = 0; i < 4; ++i) stage_rc(wid * 1024 + i * 8192 + lane * 16, sR[i], sC[i]);
#define SA(b) (shm + (b) * STAGE)
#define SB(b) (shm + (b) * STAGE + TILE_A)
#define GLDS_STAGE(buf, kt)                                                                                              \
  do {                                                                                                                   \
    _Pragma("unroll") for (int i = 0; i < 4; ++i) {                                                                      \
      if (i < MI / 2)                                                                                                    \
        __builtin_amdgcn_global_load_lds((const unsigned*)(Ab + (size_t)sR[i] * lda + (kt) * 64 + sC[i]),                \
                                         (unsigned*)(SA(buf) + wid * 1024 + i * 8192), 16, 0, 0);                        \
      __builtin_amdgcn_global_load_lds((const unsigned*)(Bb + (size_t)sR[i] * ldb + (kt) * 64 + sC[i]),                  \
                                       (unsigned*)(SB(buf) + wid * 1024 + i * 8192), 16, 0, 0);                          \
    }                                                                                                                    \
  } while (0)
  const int nt = K / 64;
  GLDS_STAGE(0, 0);
  WAIT_V(0);
  __syncthreads();
  for (int t = 0; t < nt; ++t) {
    const int cur = t & 1;
    if (t + 1 < nt) GLDS_STAGE(cur ^ 1, t + 1);
#pragma unroll
    for (int ks = 0; ks < 2; ++ks) {
      bf16x8 At[MI], Bf[4];
#pragma unroll
      for (int m = 0; m < MI; ++m) At[m] = *(const bf16x8*)(SA(cur) + lds_byte(wr * (MI * 16) + m * 16 + fr, ks * 32 + fq * 8));
#pragma unroll
      for (int n = 0; n < 4; ++n) Bf[n] = *(const bf16x8*)(SB(cur) + lds_byte(wc * 64 + n * 16 + fr, ks * 32 + fq * 8));
#pragma unroll
      for (int m = 0; m < MI; ++m)
#pragma unroll
        for (int n = 0; n < 4; ++n) acc[m][n] = __builtin_amdgcn_mfma_f32_16x16x32_bf16(At[m], Bf[n], acc[m][n], 0, 0, 0);
      SCHED();
    }
    WAIT_V(0);
    __syncthreads();
  }
#undef SA
#undef SB
#undef GLDS_STAGE
}

template <class EpiT>
__device__ __forceinline__ void gemm_tile(const u16* __restrict__ A, int lda, const u16* __restrict__ Bt, int ldb, int K,
                                          int brow, int bcol, char* shm, const EpiT& epi) {
  const int tid = tid_l(), wid = tid >> 6, lane = tid & 63, wr = wid >> 2, wc = wid & 3, fr = lane & 15, fq = lane >> 4;
  f32x4 acc[8][4];
#pragma unroll
  for (int m = 0; m < 8; ++m)
#pragma unroll
    for (int n = 0; n < 4; ++n) acc[m][n] = (f32x4){0.f, 0.f, 0.f, 0.f};
  gemm_core<8>(A, lda, Bt, ldb, K, brow, bcol, shm, acc);
#define EPI_LOOP(CALL)                                                                              \
  _Pragma("unroll") for (int m = 0; m < 8; ++m) _Pragma("unroll") for (int n = 0; n < 4; ++n) {      \
    const int row = brow + wr * 128 + m * 16 + fq * 4, col = bcol + wc * 64 + n * 16 + fr;           \
    const f32x4 v = acc[m][n];                                                                        \
    CALL;                                                                                             \
  }
  if (epi.mode == EM_PROJ) { EPI_LOOP(epi.proj(row, col, v)) }
  else if (epi.mode == EM_SQRELU) { EPI_LOOP(epi.sqrelu(row, col, v)) }
  else if (epi.mode == EM_RESID_AT) { EPI_LOOP(epi.resid(row, col, v)) }
  else if (epi.mode == EM_RESID) {
    float* h = (float*)(epi.ws + WS_H);
    float g4[4];
#pragma unroll
    for (int n = 0; n < 4; ++n) g4[n] = epi.gate[grp_of_row(brow) * 6144 + bcol + wc * 64 + n * 16 + fr];
    float hv[8][4][4];
    float* hp0 = h + (size_t)(brow + wr * 128 + fq * 4) * D + bcol + wc * 64 + fr;
#define H_LOAD(m) _Pragma("unroll") for (int n = 0; n < 4; ++n) _Pragma("unroll") for (int j = 0; j < 4; ++j) hv[m][n][j] = hp0[(size_t)((m) * 16 + j) * D + n * 16]
#define H_STORE(m) _Pragma("unroll") for (int n = 0; n < 4; ++n) _Pragma("unroll") for (int j = 0; j < 4; ++j) hp0[(size_t)((m) * 16 + j) * D + n * 16] = hv[m][n][j] + g4[n] * acc[m][n][j]
    H_LOAD(0); H_LOAD(1);
    SCHED();
    H_STORE(0); H_LOAD(2); SCHED();
    H_STORE(1); H_LOAD(3); SCHED();
    H_STORE(2); H_LOAD(4); SCHED();
    H_STORE(3); H_LOAD(5); SCHED();
    H_STORE(4); H_LOAD(6); SCHED();
    H_STORE(5); H_LOAD(7); SCHED();
    H_STORE(6); H_STORE(7);
#undef H_LOAD
#undef H_STORE
  }
  else if (epi.mode == EM_FILT) { EPI_LOOP(epi.filt(row, col, v)) }
  else if (epi.mode == EM_Q) { EPI_LOOP(epi.q(row, col, v)) }
  else { EPI_LOOP(epi.kv(row, col, v)) }
#undef EPI_LOOP
}

__device__ __forceinline__ void mix_tile(const Ctx& p, int l, int pm, int pn, char* shm) {
  constexpr int TILE_A = 128 * 64 * 2, TILE_BB = 256 * 64 * 2, STAGE = TILE_A + TILE_BB;
  const int tid = tid_l(), wid = tid >> 6, lane = tid & 63, wr = wid >> 2, wc = wid & 3, fr = lane & 15, fq = lane >> 4;
  const int brow = pm * 128, bcol = pn * 256;
  const u16* projb = (const u16*)(p.ws + WS_PROJ);
  char* wo = (char*)p.out;
#define SA(b) (shm + (b) * STAGE)
#define SB(b) (shm + (b) * STAGE + TILE_A)
#define MIX_STAGE(buf, kt)                                                                                               \
  do {                                                                                                                   \
    const int br_ = (kt) >> 3, ko_ = ((kt) & 7) * 64;                                                                    \
    const u16* Ab_ = (const u16*)(p.ws + (br_ == 0 ? WS_U : br_ == 1 ? WS_Y : WS_O)) + (size_t)brow * 512 + ko_;         \
    const u16* Bb_ = (br_ == 0 ? (const u16*)(p.ws + WS_WPE) + (size_t)l * 1024 * 512 : (const u16*)(wo + (br_ == 1 ? WO_HY : WO_WO))) + (size_t)bcol * 512 + ko_;        \
    _Pragma("unroll") for (int i = 0; i < 4; ++i) {                                                                      \
      int sR_, sC_; stage_rc(wid * 1024 + i * 8192 + lane * 16, sR_, sC_);                                              \
      if (i < 2)                                                                                                         \
        __builtin_amdgcn_global_load_lds((const unsigned*)(Ab_ + sR_ * 512 + sC_),                           \
                                         (unsigned*)(SA(buf) + wid * 1024 + i * 8192), 16, 0, 0);                        \
      __builtin_amdgcn_global_load_lds((const unsigned*)(Bb_ + sR_ * 512 + sC_),                             \
                                       (unsigned*)(SB(buf) + wid * 1024 + i * 8192), 16, 0, 0);                          \
    }                                                                                                                    \
  } while (0)
  f32x4 tot[4][4], acc[4][4];
#pragma unroll
  for (int m = 0; m < 4; ++m)
#pragma unroll
    for (int n = 0; n < 4; ++n) { tot[m][n] = (f32x4){0.f, 0.f, 0.f, 0.f}; acc[m][n] = (f32x4){0.f, 0.f, 0.f, 0.f}; }
  MIX_STAGE(0, 0);
  MIX_STAGE(1, 1);
  WAIT_V(6);
  RAW_BARRIER();
  int cur = 0;
#pragma unroll 1
  for (int br = 0; br < 3; ++br) {
    unsigned gpk[4][4][2];
    const u16* gp = projb + (size_t)(brow + wr * 64 + fq * 4) * DINP + OFF_GATE + br * 1024 + bcol + wc * 64 + fr;
#define GATE_LOAD(m)                                                                                   \
    _Pragma("unroll") for (int n = 0; n < 4; ++n) _Pragma("unroll") for (int j2 = 0; j2 < 2; ++j2) {       \
      unsigned lo = gp[(size_t)((m) * 16 + 2 * j2) * DINP + n * 16], hi = gp[(size_t)((m) * 16 + 2 * j2 + 1) * DINP + n * 16]; \
      gpk[m][n][j2] = lo | (hi << 16);                                                                     \
    }
    GATE_LOAD(0); GATE_LOAD(1); GATE_LOAD(2);
#pragma unroll 1
    for (int kk = 0; kk < 8; ++kk) {
      const int t = br * 8 + kk;
      { int nx = cur + 2; if (nx >= 3) nx -= 3; if (t + 2 < 24) MIX_STAGE(nx, t + 2); }
#pragma unroll
      for (int ks = 0; ks < 2; ++ks) {
        bf16x8 At[2], Bf[4];
#pragma unroll
        for (int n = 0; n < 4; ++n) Bf[n] = *(const bf16x8*)(SB(cur) + lds_byte(wc * 64 + n * 16 + fr, ks * 32 + fq * 8));
#pragma unroll
        for (int mh = 0; mh < 2; ++mh) {
#pragma unroll
          for (int m = 0; m < 2; ++m) At[m] = *(const bf16x8*)(SA(cur) + lds_byte(wr * 64 + (mh * 2 + m) * 16 + fr, ks * 32 + fq * 8));
#pragma unroll
          for (int m = 0; m < 2; ++m)
#pragma unroll
            for (int n = 0; n < 4; ++n) acc[mh * 2 + m][n] = __builtin_amdgcn_mfma_f32_16x16x32_bf16(At[m], Bf[n], acc[mh * 2 + m][n], 0, 0, 0);
          SCHED();
        }
      }
      if (t + 2 < 24) WAIT_V(6); else WAIT_V(0);
      RAW_BARRIER();
      cur = (cur == 2) ? 0 : cur + 1;
    }
    GATE_LOAD(3);
#undef GATE_LOAD
#pragma unroll
    for (int m = 0; m < 4; ++m)
#pragma unroll
      for (int n = 0; n < 4; ++n)
#pragma unroll
        for (int j = 0; j < 4; ++j) {
          const unsigned w = gpk[m][n][j >> 1];
          const float gv = __uint_as_float((j & 1) ? (w & 0xffff0000u) : (w << 16));
          tot[m][n][j] += acc[m][n][j] / (1.f + __expf(-gv));
          acc[m][n][j] = 0.f;
        }
  }
  u16* mixb = (u16*)(p.ws + WS_ZV);
#pragma unroll
  for (int m = 0; m < 4; ++m)
#pragma unroll
    for (int n = 0; n < 4; ++n)
#pragma unroll
      for (int j = 0; j < 4; ++j)
        mixb[(size_t)(brow + wr * 64 + m * 16 + fq * 4 + j) * D + bcol + wc * 64 + n * 16 + fr] = f2bf(tot[m][n][j]);
#undef SA
#undef SB
#undef MIX_STAGE
}

__device__ __forceinline__ void tile_map(int t, int nM, int nN, int& pm, int& pn) {
  int nwg = nM * nN, wgid = t;
  {
    int q = nwg / 8, r = nwg % 8, xcd = wgid % 8, off = wgid / 8;
    wgid = (xcd < r ? xcd * (q + 1) : r * (q + 1) + (xcd - r) * q) + off;
  }
  int nig = 8 * nN, gid = wgid / nig, fm = gid * 8, gsz = min(nM - fm, 8);
  pm = fm + ((wgid % nig) % gsz);
  pn = (wgid % nig) / gsz;
}

__device__ __forceinline__ void p0_misc(const Ctx& p) {
  const int gtid = blockIdx.x * NT + tid_l(), gn = gridDim.x * NT;
  float4* h4 = (float4*)(p.ws + WS_H);
  const float4* x4 = (const float4*)pin(p, 0);
  const float4* c4 = (const float4*)pin(p, 2);
  for (int i = gtid; i < MROWS * 256; i += gn) {
    int m = i >> 8, q = i & 255, b = m / SP, pos = m - b * SP;
    float4 v = (pos < CTX) ? c4[(size_t)(b * CTX + pos) * 256 + q] : x4[(size_t)(b * SEQ + pos - CTX) * 256 + q];
    h4[i] = v;
  }
  float2* rope = (float2*)(p.ws + WS_ROPE);
  for (int i = gtid; i < 1024; i += gn) {
    int idx = i >> 3, f = i & 7;
    float inv = powf(10000.f, -(float)f / 8.f);
    float a = (float)idx * inv;
    rope[i] = make_float2(cosf(a), sinf(a));
  }
  {
    u16* w3t = (u16*)(p.ws + WS_W3T);
    const float* w3 = pin(p, 20);
    for (int i = gtid; i < 4 * 1024 * 64; i += gn) { int l = i >> 16, c2 = (i >> 6) & 1023, k = i & 63; w3t[i] = f2bf(w3[((size_t)l * 64 + k) * 1024 + c2]); }
  }
  float2* tw = (float2*)(p.ws + WS_TW);
  for (int i = gtid; i < 16384; i += gn) {
    float s, c;
    sincospif(-(float)i / 8192.f, &s, &c);
    tw[i] = make_float2(c, s);
  }
}

__device__ __forceinline__ void p0_mod_task(const Ctx& p, int task, char* smem) {
  float* s = (float*)smem;
  float* red = s + 3072;
  const int tid = tid_l();
  const int l = task / 48, chunk = task - l * 48;
  for (int i = tid; i < 3072; i += NT) {
    int g = i >> 10, k = i & 1023;
    float cv = (g < 2) ? pin(p, 1)[g * 1024 + k] : pin(p, 3)[k];
    s[i] = cv / (1.f + __expf(-cv));
  }
  __syncthreads();
  const int kq = tid >> 7, col = tid & 127, n = chunk * 128 + col;
  const float* W = pin(p, 4) + (size_t)l * 1024 * 6144 + n;
  float a0 = 0.f, a1 = 0.f, a2 = 0.f;
#pragma unroll 8
  for (int k = kq * 256; k < kq * 256 + 256; ++k) {
    float w = W[(size_t)k * 6144];
    a0 += s[k] * w; a1 += s[1024 + k] * w; a2 += s[2048 + k] * w;
  }
  red[(kq * 3 + 0) * 128 + col] = a0;
  red[(kq * 3 + 1) * 128 + col] = a1;
  red[(kq * 3 + 2) * 128 + col] = a2;
  __syncthreads();
  if (tid < 384) {
    int g = tid >> 7, c2 = tid & 127, n2 = chunk * 128 + c2;
    float v = red[(0 * 3 + g) * 128 + c2] + red[(1 * 3 + g) * 128 + c2] + red[(2 * 3 + g) * 128 + c2] + red[(3 * 3 + g) * 128 + c2];
    ((float*)(p.ws + WS_MOD))[(size_t)(l * 3 + g) * 6144 + n2] = v + pin(p, 5)[l * 6144 + n2];
  }
  __syncthreads();
}

__device__ __forceinline__ void p0_hid_task(const Ctx& p, int task, char* smem) {
  float* zs = (float*)smem;
  float* h1 = zs + 8 * 36;
  float* w1s = h1 + 8 * 64;
  float* w2s = w1s + 33 * 64;
  const int tid = tid_l(), tl = tid >> 6, j = tid & 63;
  const int l = task / 132, r = task - l * 132;
  const bool isctx = r >= 128;
  const int L = isctx ? 256 : 8192;
  const int tbase = (isctx ? (r - 128) : r) * 64;
  for (int i = tid; i < 33 * 64; i += NT) w1s[i] = pin(p, 14)[l * 33 * 64 + i];
  for (int i = tid; i < 64 * 64; i += NT) w2s[i] = pin(p, 17)[l * 64 * 64 + i];
  const float b1 = pin(p, 15)[l * 64 + j], f1 = pin(p, 16)[l * 64 + j], b2 = pin(p, 18)[l * 64 + j], f2 = pin(p, 19)[l * 64 + j];
  __syncthreads();
  for (int sub = 0; sub < 8; ++sub) {
    const int t = tbase + sub * 8 + tl;
    if (j < 33) {
      float z;
      if (j == 0) z = (float)t / (float)(L - 1);
      else {
        int i = (j - 1) & 15;
        float band = 1e-4f + (float)i * ((15.f - 1e-4f) / 15.f);
        float omega = 6.2831855f * (float)t / (float)L;
        float a = omega * band;
        z = (j <= 16) ? cosf(a) : -sinf(a);
      }
      zs[tl * 36 + j] = z;
    }
    __syncthreads();
    {
      float a = b1;
#pragma unroll
      for (int k = 0; k < 33; ++k) a += zs[tl * 36 + k] * w1s[k * 64 + j];
      h1[tl * 64 + j] = sinf(f1 * a);
    }
    __syncthreads();
    {
      float a = b2;
#pragma unroll 16
      for (int k = 0; k < 64; ++k) a += h1[tl * 64 + k] * w2s[k * 64 + j];
      float v = sinf(f2 * a);
      if (isctx) ((float*)(p.ws + WS_HID2C))[((size_t)l * 64 + j) * 256 + t] = v;
      else ((u16*)(p.ws + WS_HID2))[((size_t)l * 8192 + t) * 64 + j] = f2bf(v);
    }
  }
  __syncthreads();
}

__device__ __forceinline__ void wt_task(const float* __restrict__ W, int K, int N, u16* __restrict__ WT, int item, int nblkN, char* smem) {
  float* tile = (float*)smem;
  const int tid = tid_l();
  const int kb = item / nblkN, nb = item - kb * nblkN, k0 = kb * 64, n0 = nb * 64;
#pragma unroll
  for (int r = 0; r < 8; ++r) {
    int kk = r * 8 + (tid >> 6), nn = tid & 63;
    float v = (n0 + nn < N) ? W[(size_t)(k0 + kk) * N + n0 + nn] : 0.f;
    tile[kk * 65 + nn] = v;
  }
  __syncthreads();
  {
    int n = tid >> 3, kc = (tid & 7) * 8;
    uint4 o;
    o.x = pk2(tile[(kc + 0) * 65 + n], tile[(kc + 1) * 65 + n]);
    o.y = pk2(tile[(kc + 2) * 65 + n], tile[(kc + 3) * 65 + n]);
    o.z = pk2(tile[(kc + 4) * 65 + n], tile[(kc + 5) * 65 + n]);
    o.w = pk2(tile[(kc + 6) * 65 + n], tile[(kc + 7) * 65 + n]);
    *(uint4*)(WT + (size_t)(n0 + n) * K + k0 + kc) = o;
  }
  __syncthreads();
}

__device__ __forceinline__ void wpe_task(const Ctx& p, int l, int task, char* smem) {
  const int g = task >> 3, c0 = (task & 7) * 16, tid = tid_l();
  const float* pw = pin(p, 9) + ((size_t)(l * 4 + g) * 128) * 128;
  const float* sc = pin(p, 10) + l * 512 + g * 128;
  const float* po = pin(p, 11) + ((size_t)l * 512 + g * 128) * 1024;
  u16* WpeT = (u16*)(p.ws + WS_WPE) + (size_t)l * 1024 * 512;
  float* wl = (float*)smem;
  for (int i = tid; i < 16 * 128; i += NT) { int d = i & 127; wl[i] = pw[(c0 + (i >> 7)) * 128 + d] * sc[d]; }
  __syncthreads();
  float acc0[16], acc1[16];
#pragma unroll
  for (int i = 0; i < 16; ++i) { acc0[i] = 0.f; acc1[i] = 0.f; }
#pragma unroll 16
  for (int d = 0; d < 128; ++d) {
    float p0 = po[(size_t)d * 1024 + tid], p1 = po[(size_t)d * 1024 + 512 + tid];
#pragma unroll
    for (int i = 0; i < 16; ++i) { float w = wl[i * 128 + d]; acc0[i] += w * p0; acc1[i] += w * p1; }
  }
  uint4 o0, o1;
  o0.x = pk2(acc0[0], acc0[1]); o0.y = pk2(acc0[2], acc0[3]); o0.z = pk2(acc0[4], acc0[5]); o0.w = pk2(acc0[6], acc0[7]);
  o1.x = pk2(acc0[8], acc0[9]); o1.y = pk2(acc0[10], acc0[11]); o1.z = pk2(acc0[12], acc0[13]); o1.w = pk2(acc0[14], acc0[15]);
  uint4* dst = (uint4*)(WpeT + (size_t)tid * 512 + g * 128 + c0);
  dst[0] = o0; dst[1] = o1;
  o0.x = pk2(acc1[0], acc1[1]); o0.y = pk2(acc1[2], acc1[3]); o0.z = pk2(acc1[4], acc1[5]); o0.w = pk2(acc1[6], acc1[7]);
  o1.x = pk2(acc1[8], acc1[9]); o1.y = pk2(acc1[10], acc1[11]); o1.z = pk2(acc1[12], acc1[13]); o1.w = pk2(acc1[14], acc1[15]);
  dst = (uint4*)(WpeT + (size_t)(512 + tid) * 512 + g * 128 + c0);
  dst[0] = o0; dst[1] = o1;
  __syncthreads();
}

__device__ __forceinline__ void norm_rows(const Ctx& p, const float* gain, const float* modl, int sh_idx, int sc_idx, u16* outp) {
  const int tidx = tid_l(), lane = tidx & 63, gw = blockIdx.x * 8 + (tidx >> 6), ngw = gridDim.x * 8;
  const float* h = (const float*)(p.ws + WS_H);
  float4 g[4];
#pragma unroll
  for (int j = 0; j < 4; ++j) g[j] = *(const float4*)(gain + lane * 4 + 256 * j);
  for (int m0 = gw; m0 < MROWS; m0 += 2 * ngw) {
    const int m1 = m0 + ngw;
    const bool has1 = m1 < MROWS;
    const int m1c = has1 ? m1 : m0;
    const float4* hr0 = (const float4*)(h + (size_t)m0 * D) + lane;
    const float4* hr1 = (const float4*)(h + (size_t)m1c * D) + lane;
    float4 v0[4], v1[4];
#pragma unroll
    for (int j = 0; j < 4; ++j) { v0[j] = hr0[64 * j]; v1[j] = hr1[64 * j]; }
    const float* mg0 = modl + grp_of_row(m0) * 6144;
    const float* mg1 = modl + grp_of_row(m1c) * 6144;
    float s0 = 0.f, s1 = 0.f;
#pragma unroll
    for (int j = 0; j < 4; ++j) {
      s0 += v0[j].x * v0[j].x + v0[j].y * v0[j].y + v0[j].z * v0[j].z + v0[j].w * v0[j].w;
      s1 += v1[j].x * v1[j].x + v1[j].y * v1[j].y + v1[j].z * v1[j].z + v1[j].w * v1[j].w;
    }
    s0 = wave_sum(s0);
    s1 = wave_sum(s1);
    const float r0 = rsqrtf(s0 * (1.f / D) + EPS), r1 = rsqrtf(s1 * (1.f / D) + EPS);
    uint2* o0 = (uint2*)(outp + (size_t)m0 * D) + lane;
    uint2* o1 = (uint2*)(outp + (size_t)m1c * D) + lane;
#pragma unroll
    for (int j = 0; j < 4; ++j) {
      int n = lane * 4 + 256 * j;
      float4 sc = *(const float4*)(mg0 + sc_idx * 1024 + n), sh = *(const float4*)(mg0 + sh_idx * 1024 + n);
      uint2 o;
      o.x = pk2(v0[j].x * r0 * g[j].x * (1.f + sc.x) + sh.x, v0[j].y * r0 * g[j].y * (1.f + sc.y) + sh.y);
      o.y = pk2(v0[j].z * r0 * g[j].z * (1.f + sc.z) + sh.z, v0[j].w * r0 * g[j].w * (1.f + sc.w) + sh.w);
      o0[64 * j] = o;
    }
    if (has1) {
#pragma unroll
      for (int j = 0; j < 4; ++j) {
        int n = lane * 4 + 256 * j;
        float4 sc = *(const float4*)(mg1 + sc_idx * 1024 + n), sh = *(const float4*)(mg1 + sh_idx * 1024 + n);
        uint2 o;
        o.x = pk2(v1[j].x * r1 * g[j].x * (1.f + sc.x) + sh.x, v1[j].y * r1 * g[j].y * (1.f + sc.y) + sh.y);
        o.y = pk2(v1[j].z * r1 * g[j].z * (1.f + sc.z) + sh.z, v1[j].w * r1 * g[j].w * (1.f + sc.w) + sh.w);
        o1[64 * j] = o;
      }
    }
  }
}

__device__ __forceinline__ void final_norm(const Ctx& p) {
  const int tidx = tid_l(), lane = tidx & 63, gw = blockIdx.x * 8 + (tidx >> 6), ngw = gridDim.x * 8;
  const float* h = (const float*)(p.ws + WS_H);
  const float* gain = pin(p, 32);
  for (int r0 = gw; r0 < 2 * SEQ; r0 += ngw) {
    int b = r0 >> 13, t = r0 & 8191, m = b * SP + CTX + t;
    const float4* hr = (const float4*)(h + (size_t)m * D) + lane;
    float4 v[4];
    float ss = 0.f;
#pragma unroll
    for (int j = 0; j < 4; ++j) { v[j] = hr[64 * j]; ss += v[j].x * v[j].x + v[j].y * v[j].y + v[j].z * v[j].z + v[j].w * v[j].w; }
    ss = wave_sum(ss);
    float r = rsqrtf(ss * (1.f / D) + EPS);
    float4* o = (float4*)(p.out + (size_t)r0 * D) + lane;
#pragma unroll
    for (int j = 0; j < 4; ++j) {
      float4 g = *(const float4*)(gain + lane * 4 + 256 * j);
      o[64 * j] = make_float4(v[j].x * r * g.x, v[j].y * r * g.y, v[j].z * r * g.z, v[j].w * r * g.w);
    }
  }
}

__device__ __forceinline__ void premix_task(const Ctx& p, int l, int task, char* smem) {
  const int tid = tid_l(), lane = tid & 63, wid = tid >> 6;
  const int part = task / 264, tile64 = task - part * 264;
  const int m0 = tile64 * 64, b = m0 / SP, pos0 = m0 - b * SP;
  const bool isctx = pos0 < CTX;
  const int s0 = isctx ? 0 : CTX, L = isctx ? CTX : SEQ, t0 = pos0 - s0;
  const size_t mb = (size_t)b * SP + s0;
  const u16* proj = (const u16*)(p.ws + WS_PROJ);
  if (part == 0) {
    u16* P = (u16*)smem;
#pragma unroll
    for (int i = tid; i < 80 * 64; i += NT) {
      int r = i >> 6, ch = i & 63, t = t0 - 8 + r;
      uint4 v = make_uint4(0, 0, 0, 0);
      if (t >= 0 && t < L) v = *(const uint4*)(proj + (mb + t) * DINP + ch * 8);
      *(uint4*)(P + r * 512 + ch * 8) = v;
    }
    __syncthreads();
    const int c = tid, g = c >> 7, hw = 1 << g;
    u16* U = (u16*)(p.ws + WS_U);
    float s = 0.f;
    for (int q = -hw; q < hw; ++q) s += bf2f(P[(8 + q) * 512 + c]);
#pragma unroll 4
    for (int tt = 0; tt < 64; ++tt) {
      int t = t0 + tt, lo = max(t - hw, 0), hi = min(t + hw, L);
      float u = s / (float)(hi - lo) - bf2f(P[(tt + 8) * 512 + c]);
      U[(mb + t) * 512 + c] = f2bf(u);
      s += bf2f(P[(tt + 8 + hw) * 512 + c]) - bf2f(P[(tt + 8 - hw) * 512 + c]);
    }
    __syncthreads();
  } else if (part <= 4) {
    const int ch0 = (part - 1) * 128;
    constexpr int PITCH = 136;
    u16* X = (u16*)smem;
    float* T = (float*)(smem + 3 * 66 * PITCH * 2 + 64);
#pragma unroll
    for (int ii = 0; ii < 7; ++ii) {
      const int i = tid + ii * NT;
      if (i >= 3 * 66 * 16) break;
      int pr = i / (66 * 16), rem = i - pr * 66 * 16, r = rem >> 4, ch = rem & 15, t = t0 - 1 + r;
      uint4 v = make_uint4(0, 0, 0, 0);
      if (t >= 0 && t < L) v = *(const uint4*)(proj + (mb + t) * DINP + OFF_HY + pr * 512 + ch0 + ch * 8);
      *(uint4*)(X + (pr * 66 + r) * PITCH + ch * 8) = v;
    }
    __syncthreads();
    const float* cw = pin(p, 12) + l * 3 * 1536;
    const float* cb = pin(p, 13) + l * 1536;
    {
      const int c = tid & 127, tq = tid >> 7, col = ch0 + c;
      const float w00 = cw[col], w01 = cw[1536 + col], w02 = cw[3072 + col], b0 = cb[col];
      const float w10 = cw[512 + col], w11 = cw[1536 + 512 + col], w12 = cw[3072 + 512 + col], b1 = cb[512 + col];
      const float w20 = cw[1024 + col], w21 = cw[1536 + 1024 + col], w22 = cw[3072 + 1024 + col], b2 = cb[1024 + col];
      const u16* X0 = X, *X1 = X + 66 * PITCH, *XV = X + 2 * 66 * PITCH;
      u16* Y = (u16*)(p.ws + WS_Y);
#pragma unroll 4
      for (int tt = tq * 16; tt < tq * 16 + 16; ++tt) {
        float x0 = w00 * bf2f(X0[tt * PITCH + c]) + w01 * bf2f(X0[(tt + 1) * PITCH + c]) + w02 * bf2f(X0[(tt + 2) * PITCH + c]) + b0;
        float x1 = w10 * bf2f(X1[tt * PITCH + c]) + w11 * bf2f(X1[(tt + 1) * PITCH + c]) + w12 * bf2f(X1[(tt + 2) * PITCH + c]) + b1;
        float vv = w20 * bf2f(XV[tt * PITCH + c]) + w21 * bf2f(XV[(tt + 1) * PITCH + c]) + w22 * bf2f(XV[(tt + 2) * PITCH + c]) + b2;
        Y[(mb + t0 + tt) * 512 + col] = f2bf(x0);
        T[c * 65 + tt] = x1 * vv;
      }
    }
    __syncthreads();
    {
      float* ZV = (float*)(p.ws + WS_ZV);
#pragma unroll 4
      for (int cc = 0; cc < 16; ++cc) {
        int c = wid * 16 + cc;
        ZV[((size_t)(ch0 + c) * SP + pos0 + lane) * 2 + b] = T[c * 65 + lane];
      }
    }
    __syncthreads();
  } else {
    u16* projw = (u16*)(p.ws + WS_PROJ);
    const float* qg = pin(p, 24) + l * 384;
    const float* kg = pin(p, 26) + l * 256;
    const float2* rope = (const float2*)(p.ws + WS_ROPE);
    u16* Kb = (u16*)(p.ws + WS_K);
#pragma unroll 2
    for (int rr = 0; rr < 8; ++rr) {
      int tt = wid * 8 + rr, pos = pos0 + tt;
      u16* row = projw + ((size_t)b * SP + pos) * DINP;
      unsigned* q32 = (unsigned*)(row + OFF_Q);
      unsigned* k32 = (unsigned*)(row + OFF_KV);
      unsigned v[3], w[2];
      float ss = 0.f, s2 = 0.f;
#pragma unroll
      for (int j = 0; j < 3; ++j) v[j] = q32[lane + 64 * j];
#pragma unroll
      for (int j = 0; j < 2; ++j) w[j] = k32[lane + 64 * j];
      const int rd = lane & 31;
      float val = bf2f(row[OFF_KV + 256 + rd]);
#pragma unroll
      for (int j = 0; j < 3; ++j) { float a = bf2f(v[j] & 0xffff), c2 = bf2f(v[j] >> 16); ss += a * a + c2 * c2; }
#pragma unroll
      for (int j = 0; j < 2; ++j) { float a = bf2f(w[j] & 0xffff), c2 = bf2f(w[j] >> 16); s2 += a * a + c2 * c2; }
      ss = wave_sum(ss);
      s2 = wave_sum(s2);
      float r = rsqrtf(ss * (1.f / 384.f) + EPS), r2 = rsqrtf(s2 * (1.f / 256.f) + EPS);
#pragma unroll
      for (int j = 0; j < 3; ++j) {
        int n = (lane + 64 * j) * 2;
        q32[lane + 64 * j] = pk2(bf2f(v[j] & 0xffff) * r * qg[n], bf2f(v[j] >> 16) * r * qg[n + 1]);
      }
#pragma unroll
      for (int j = 0; j < 2; ++j) {
        int n = (lane + 64 * j) * 2;
        k32[lane + 64 * j] = pk2(bf2f(w[j] & 0xffff) * r2 * kg[n], bf2f(w[j] >> 16) * r2 * kg[n + 1]);
      }
      float partner = shx(val, 8);
      if (!isctx) {
        int t = pos - CTX, idx = (rd < 16) ? (t >> 6) : (t & 63);
        float2 cs = rope[idx * 8 + (rd & 7)];
        float sgn = (rd & 8) ? 1.f : -1.f;
        val = val * cs.x + sgn * partner * cs.y;
      }
      if (lane < 32) {
        u16 o = f2bf(val);
#pragma unroll
        for (int hd = 0; hd < 8; ++hd) Kb[((size_t)(b * 8 + hd) * SP + pos) * 96 + 64 + rd] = o;
      }
    }
  }
}

__device__ __forceinline__ void bf_fwd(float2* X, int base, int q, float2 w1) {
  float2 w2 = cmul(w1, w1), w3 = cmul(w2, w1);
  float2 a0 = X[base], a1 = X[base + q], a2 = X[base + 2 * q], a3 = X[base + 3 * q];
  float2 s02 = make_float2(a0.x + a2.x, a0.y + a2.y), d02 = make_float2(a0.x - a2.x, a0.y - a2.y);
  float2 s13 = make_float2(a1.x + a3.x, a1.y + a3.y), d13 = make_float2(a1.x - a3.x, a1.y - a3.y);
  X[base] = make_float2(s02.x + s13.x, s02.y + s13.y);
  X[base + q] = cmul(make_float2(d02.x + d13.y, d02.y - d13.x), w1);
  X[base + 2 * q] = cmul(make_float2(s02.x - s13.x, s02.y - s13.y), w2);
  X[base + 3 * q] = cmul(make_float2(d02.x - d13.y, d02.y + d13.x), w3);
}
__device__ __forceinline__ void bf_inv(float2* X, int base, int q, float2 w1) {
  w1.y = -w1.y;
  float2 w2 = cmul(w1, w1), w3 = cmul(w2, w1);
  float2 b0 = X[base], c1 = cmul(X[base + q], w1), c2 = cmul(X[base + 2 * q], w2), c3 = cmul(X[base + 3 * q], w3);
  float2 s02 = make_float2(b0.x + c2.x, b0.y + c2.y), d02 = make_float2(b0.x - c2.x, b0.y - c2.y);
  float2 s13 = make_float2(c1.x + c3.x, c1.y + c3.y), d13 = make_float2(c1.x - c3.x, c1.y - c3.y);
  X[base] = make_float2(s02.x + s13.x, s02.y + s13.y);
  X[base + q] = make_float2(d02.x - d13.y, d02.y + d13.x);
  X[base + 2 * q] = make_float2(s02.x - s13.x, s02.y - s13.y);
  X[base + 3 * q] = make_float2(d02.x + d13.y, d02.y - d13.x);
}
template <bool INV>
__device__ __forceinline__ void fft_pass(float2* X, const float2* __restrict__ tw, int lq, int tid) {
  const int q = 1 << lq, sh = 12 - lq;
  if (lq == 12) {
    float2 w[8];
#pragma unroll
    for (int b8 = 0; b8 < 8; ++b8) w[b8] = tw[b8 * NT + tid];
#pragma unroll
    for (int b8 = 0; b8 < 8; ++b8) { int u = b8 * NT + tid; if (INV) bf_inv(X, u, q, w[b8]); else bf_fwd(X, u, q, w[b8]); }
  } else if (lq == 10) {
    float2 wA = tw[tid << 2], wB = tw[(512 + tid) << 2];
#pragma unroll 2
    for (int b8 = 0; b8 < 8; ++b8) {
      int u = b8 * NT + tid, j = u & 1023, base = ((u >> 10) << 12) + j;
      float2 w = (b8 & 1) ? wB : wA;
      if (INV) bf_inv(X, base, q, w); else bf_fwd(X, base, q, w);
    }
  } else {
    const int j = tid & (q - 1);
    float2 w = tw[j << sh];
#pragma unroll 2
    for (int b8 = 0; b8 < 8; ++b8) {
      int u = b8 * NT + tid, base = ((u >> lq) << (lq + 2)) + j;
      if (INV) bf_inv(X, base, q, w); else bf_fwd(X, base, q, w);
    }
  }
  __syncthreads();
}
__device__ __forceinline__ void fft_dif(float2* X, const float2* __restrict__ tw) {
  const int tid = tid_l();
  for (int lq = 12; lq >= 0; lq -= 2) fft_pass<false>(X, tw, lq, tid);
}
__device__ __forceinline__ void fft_dit_inv(float2* X, const float2* __restrict__ tw) {
  const int tid = tid_l();
  for (int lq = 0; lq <= 12; lq += 2) fft_pass<true>(X, tw, lq, tid);
}
__device__ __forceinline__ float block_sum(float v, float* red) {
  v = wave_sum(v);
  __syncthreads();
  { const int tb = tid_l(); if ((tb & 63) == 0) red[tb >> 6] = v; }
  __syncthreads();
  float s = red[0] + red[1] + red[2] + red[3] + red[4] + red[5] + red[6] + red[7];
  __syncthreads();
  return s;
}

__device__ __forceinline__ void fft_task(const Ctx& p, int l, int c, char* smem) {
  float2* X = (float2*)smem;
  float* aux = (float*)(smem + AUX_OFF);
  float* red = aux + 128;
  const int tid = tid_l();
  const float2* tw = (const float2*)(p.ws + WS_TW);
  const float* w3 = pin(p, 20) + (size_t)l * 64 * 1024;
  if (tid < 64) { aux[tid] = w3[tid * 1024 + c]; aux[64 + tid] = w3[tid * 1024 + 512 + c]; }
  __syncthreads();
  const float dF = fabsf(pin(p, 21)[(l * 2 + 0) * 512 + c]), dB = fabsf(pin(p, 21)[(l * 2 + 1) * 512 + c]);
  const float bias = pin(p, 22)[l * 512 + c];
  float2* zp = (float2*)(p.ws + WS_ZV) + (size_t)c * SP;
  float l1 = 0.f;
  {
    const u16* ff = (const u16*)((const char*)p.out + WO_FILT) + (size_t)c * 8192 + tid;
    const u16* fb = ff + (size_t)512 * 8192;
    u16 rf[16], rb[16];
#pragma unroll
    for (int i = 0; i < 16; ++i) { rf[i] = ff[i * NT]; rb[i] = fb[i * NT]; }
#pragma unroll
    for (int i = 0; i < 16; ++i) {
      int t = i * NT + tid;
      float tl = (float)t * (1.f / 8191.f);
      float hf = bf2f(rf[i]) * expf(-tl * dF);
      float hb = bf2f(rb[i]) * expf(-tl * dB);
      X[t] = make_float2(hf, 0.f);
      if (t >= 1) { X[16384 - t] = make_float2(hb, 0.f); l1 += fabsf(hf) + fabsf(hb); }
      else { X[8192] = make_float2(0.f, 0.f); l1 += fabsf(hf); }
    }
  }
  float l1tot = block_sum(l1, red);
  fft_dif(X, tw);
  float2 F[32];
  {
    float s = 1.f / (l1tot * 16384.f);
#pragma unroll
    for (int i = 0; i < 32; ++i) { float2 v = X[i * NT + tid]; F[i] = make_float2(v.x * s, v.y * s); }
  }
  __syncthreads();
#pragma unroll 8
  for (int i = 0; i < 16; ++i) {
    int t = i * NT + tid;
    X[t] = zp[CTX + t];
    X[8192 + t] = make_float2(0.f, 0.f);
  }
  __syncthreads();
  fft_dif(X, tw);
#pragma unroll
  for (int i = 0; i < 32; ++i) { int idx = i * NT + tid; X[idx] = cmul(X[idx], F[i]); }
  __syncthreads();
  fft_dit_inv(X, tw);
  {
    float2 zz[16];
#pragma unroll
    for (int i = 0; i < 16; ++i) zz[i] = zp[CTX + i * NT + tid];
#pragma unroll
    for (int i = 0; i < 16; ++i) {
      int t = i * NT + tid;
      float2 y = X[t];
      zp[CTX + t] = make_float2(y.x + bias * zz[i].x, y.y + bias * zz[i].y);
    }
  }
  __syncthreads();
  {
    float* hFc = (float*)smem;
    float* hBc = hFc + 256;
    float2* zc = (float2*)(hBc + 256);
    float l1c = 0.f;
    if (tid < 256) {
      int t = tid;
      const float* hc = (const float*)(p.ws + WS_HID2C) + (size_t)l * 64 * 256 + t;
      float hf = 0.f, hb = 0.f;
#pragma unroll 16
      for (int k = 0; k < 64; ++k) { float v = hc[k * 256]; hf += v * aux[k]; hb += v * aux[64 + k]; }
      float tl = (float)t * (1.f / 255.f);
      hf *= expf(-tl * dF);
      hb *= expf(-tl * dB);
      hFc[t] = hf;
      hBc[t] = hb;
      l1c = fabsf(hf) + (t >= 1 ? fabsf(hb) : 0.f);
      zc[t] = zp[t];
    }
    float l1ct = block_sum(l1c, red);
    const int bb = tid >> 8, t = tid & 255;
    float acc = 0.f;
    for (int s = 0; s < 256; ++s) {
      float kf = (s <= t) ? hFc[t - s] : hBc[s - t];
      float2 z = zc[s];
      acc += kf * (bb ? z.y : z.x);
    }
    float2 z = zc[t];
    ((float*)zp)[t * 2 + bb] = acc / l1ct + bias * (bb ? z.y : z.x);
    __syncthreads();
  }
}

constexpr int AT_KP = 208, AT_VP = 136, AT_STAGE = 64 * AT_KP + 64 * AT_VP;
__device__ __forceinline__ void attn_task(const Ctx& p, int bh, int qb, char* smem) {
  const int tid = tid_l(), wid = tid >> 6, lane = tid & 63, r = lane & 31, hh = lane >> 5;
  const u16* Qp = (const u16*)(p.ws + WS_Q) + ((size_t)bh * SP + qb * 256) * 96;
  const u16* Kp = (const u16*)(p.ws + WS_K) + (size_t)bh * SP * 96;
  const u16* Vp = (const u16*)(p.ws + WS_VT) + (size_t)bh * 64 * SP;
  const int nkt = (qb == 0) ? 4 : 132;
  bf16x8 qf[6];
#pragma unroll
  for (int ks = 0; ks < 6; ++ks) qf[ks] = *(const bf16x8*)(Qp + (size_t)(wid * 32 + r) * 96 + ks * 16 + hh * 8);
  f32x16 o0, o1;
#pragma unroll
  for (int i = 0; i < 16; ++i) { o0[i] = 0.f; o1[i] = 0.f; }
  float mrun = -1e30f, lrun = 0.f;
  const u16* src[3];
  int dst[3], kstep[3];
#pragma unroll
  for (int i = 0; i < 3; ++i) {
    int ch = tid + i * NT;
    if (ch < 768) { int row = ch / 12, cc = ch - row * 12; src[i] = Kp + (size_t)row * 96 + cc * 8; dst[i] = row * AT_KP + cc * 16; kstep[i] = 64 * 96; }
    else { int v = ch - 768, row = (v >> 3) & 63, cc = v & 7; src[i] = Vp + (size_t)row * SP + cc * 8; dst[i] = 64 * AT_KP + row * AT_VP + cc * 16; kstep[i] = 64; }
  }
  const bool has3 = tid < 256;
  uint4 st[3];
#define AT_LOAD(t)                                                                                   \
  do {                                                                                               \
    st[0] = *(const uint4*)(src[0] + (size_t)(t) * kstep[0]);                                        \
    st[1] = *(const uint4*)(src[1] + (size_t)(t) * kstep[1]);                                        \
    if (has3) st[2] = *(const uint4*)(src[2] + (size_t)(t) * kstep[2]);                              \
  } while (0)
#define AT_WRITE1(i, base)                                                                           \
  do {                                                                                               \
    uint2* d_ = (uint2*)((base) + dst[i]);                                                           \
    d_[0] = make_uint2(st[i].x, st[i].y);                                                            \
    d_[1] = make_uint2(st[i].z, st[i].w);                                                            \
  } while (0)
#define AT_WRITE(buf)                                                                                \
  do {                                                                                               \
    char* base_ = smem + (buf) * AT_STAGE;                                                           \
    AT_WRITE1(0, base_); AT_WRITE1(1, base_);                                                        \
    if (has3) AT_WRITE1(2, base_);                                                                   \
  } while (0)
  AT_LOAD(0);
  AT_WRITE(0);
  __syncthreads();
  for (int t = 0; t < nkt; ++t) {
    const int cur = t & 1;
    if (t + 1 < nkt) AT_LOAD(t + 1);
    const char* Ks = smem + cur * AT_STAGE;
    const char* Vs = Ks + 64 * AT_KP;
    f32x16 s0, s1;
#pragma unroll
    for (int i = 0; i < 16; ++i) { s0[i] = 0.f; s1[i] = 0.f; }
#pragma unroll
    for (int ks = 0; ks < 6; ++ks) {
      bf16x8 a0 = *(const bf16x8*)(Ks + r * AT_KP + ks * 32 + hh * 16);
      bf16x8 a1 = *(const bf16x8*)(Ks + (32 + r) * AT_KP + ks * 32 + hh * 16);
      s0 = __builtin_amdgcn_mfma_f32_32x32x16_bf16(a0, qf[ks], s0, 0, 0, 0);
      s1 = __builtin_amdgcn_mfma_f32_32x32x16_bf16(a1, qf[ks], s1, 0, 0, 0);
    }
    float mx = s0[0];
#pragma unroll
    for (int i = 1; i < 16; ++i) mx = fmaxf(mx, s0[i]);
#pragma unroll
    for (int i = 0; i < 16; ++i) mx = fmaxf(mx, s1[i]);
    mx = fmaxf(mx, shx(mx, 32));
    const float mnew = fmaxf(mrun, mx);
    const bool grow = __any(mnew > mrun);
    const float alpha = __builtin_amdgcn_exp2f(mrun - mnew);
    mrun = mnew;
    float ps = 0.f;
#pragma unroll
    for (int i = 0; i < 16; ++i) { s0[i] = __builtin_amdgcn_exp2f(s0[i] - mnew); ps += s0[i]; }
#pragma unroll
    for (int i = 0; i < 16; ++i) { s1[i] = __builtin_amdgcn_exp2f(s1[i] - mnew); ps += s1[i]; }
    lrun = lrun * alpha + ps;
    if (grow) {
#pragma unroll
      for (int i = 0; i < 16; ++i) { o0[i] *= alpha; o1[i] *= alpha; }
    }
#pragma unroll
    for (int kb = 0; kb < 2; ++kb) {
#pragma unroll
      for (int sI = 0; sI < 2; ++sI) {
        union { bf16x8 v; unsigned u[4]; } pu;
#pragma unroll
        for (int j = 0; j < 4; ++j) pu.u[j] = kb == 0 ? pk2(s0[8 * sI + 2 * j], s0[8 * sI + 2 * j + 1]) : pk2(s1[8 * sI + 2 * j], s1[8 * sI + 2 * j + 1]);
        const bf16x8 pf = pu.v;
        const int koff = (kb * 32 + 16 * sI + 4 * hh) * 2;
        union { bf16x8 v; uint2 h2[2]; } va, vb;
        va.h2[0] = *(const uint2*)(Vs + r * AT_VP + koff);
        va.h2[1] = *(const uint2*)(Vs + r * AT_VP + koff + 16);
        vb.h2[0] = *(const uint2*)(Vs + (32 + r) * AT_VP + koff);
        vb.h2[1] = *(const uint2*)(Vs + (32 + r) * AT_VP + koff + 16);
        o0 = __builtin_amdgcn_mfma_f32_32x32x16_bf16(va.v, pf, o0, 0, 0, 0);
        o1 = __builtin_amdgcn_mfma_f32_32x32x16_bf16(vb.v, pf, o1, 0, 0, 0);
      }
    }
    if (t + 1 < nkt) AT_WRITE(cur ^ 1);
    __syncthreads();
  }
  const float ltot = lrun + shx(lrun, 32);
  const float inv = 1.f / ltot;
  const int b = bh >> 3, head = bh & 7;
  u16* Op = (u16*)(p.ws + WS_O) + ((size_t)b * SP + qb * 256 + wid * 32 + r) * 512 + head * 64;
#pragma unroll
  for (int g = 0; g < 4; ++g) {
    uint2 w0, w1;
    w0.x = pk2(o0[4 * g] * inv, o0[4 * g + 1] * inv);
    w0.y = pk2(o0[4 * g + 2] * inv, o0[4 * g + 3] * inv);
    w1.x = pk2(o1[4 * g] * inv, o1[4 * g + 1] * inv);
    w1.y = pk2(o1[4 * g + 2] * inv, o1[4 * g + 3] * inv);
    *(uint2*)(Op + 8 * g + 4 * hh) = w0;
    *(uint2*)(Op + 32 + 8 * g + 4 * hh) = w1;
  }
#undef AT_LOAD
#undef AT_WRITE
#undef AT_WRITE1
}

__device__ __forceinline__ void hypost_task(const Ctx& p, int task, char* smem) {
  const int tid = tid_l(), lane = tid & 63, wid = tid >> 6;
  const int tile64 = task >> 1, ch0 = (task & 1) * 256;
  const int m0 = tile64 * 64, b = m0 / SP, pos0 = m0 - b * SP;
  float* T = (float*)smem;
  const float* ZV = (const float*)(p.ws + WS_ZV);
#pragma unroll 8
  for (int cc = 0; cc < 32; ++cc) {
    int c = wid * 32 + cc;
    T[c * 65 + lane] = ZV[((size_t)(ch0 + c) * SP + pos0 + lane) * 2 + b];
  }
  __syncthreads();
  u16* Y = (u16*)(p.ws + WS_Y);
  const int c = tid & 255, th = tid >> 8;
  u16* yp = Y + (size_t)(m0 + th * 32) * 512 + ch0 + c;
  u16 yv[32];
#pragma unroll
  for (int i = 0; i < 32; ++i) yv[i] = yp[(size_t)i * 512];
#pragma unroll
  for (int i = 0; i < 32; ++i) yp[(size_t)i * 512] = f2bf(bf2f(yv[i]) * T[c * 65 + th * 32 + i]);
  __syncthreads();
}

#ifndef PHMASK
#define PHMASK 0xFFFF
#endif
#define PHON(k) (((PHMASK) >> (k)) & 1)
constexpr int NPH = 1 + 4 * 10 + 1;
__global__ void __launch_bounds__(NT, 2) mega(Params prm) {
  __shared__ __attribute__((aligned(1024))) char smem[LDS_BYTES];
  cg::grid_group grid = cg::this_grid();
  const int bid = blockIdx.x, nb = gridDim.x;
  {
    unsigned long long* it = (unsigned long long*)(smem + AUX_OFF + 6144);
    if (threadIdx.x < 33) it[threadIdx.x] = (unsigned long long)prm.in[threadIdx.x];
    __syncthreads();
  }
  if (prm.ph_lo == 0) {
    Ctx p;
    p.intab = (const unsigned long long*)(smem + AUX_OFF + 6144);
    p.ws = prm.ws;
    p.out = prm.out;
    const int bid = blockIdx.x, nb = gridDim.x;
      if (PHON(10)) {
      p0_misc(p);
      for (int t = bid; t < 192; t += nb) p0_mod_task(p, t, smem);
      for (int t = bid; t < 528; t += nb) p0_hid_task(p, t, smem);
      for (int t = bid; t < 128; t += nb) { const int w = (t + 64) & 127; wpe_task(p, w >> 5, w & 31, smem); }
      }
  }
  unsigned nbar = 0;
  for (int ph = prm.ph_lo; ph < prm.ph_hi; ++ph) {
    Ctx p;
    p.intab = (const unsigned long long*)(smem + AUX_OFF + 6144);
    p.ws = prm.ws;
    p.out = prm.out;
    asm volatile("" : "+s"(p.ws), "+s"(p.out));
    float* modall = (float*)(p.ws + WS_MOD);
    u16* proj = (u16*)(p.ws + WS_PROJ);
    u16* xn = (u16*)(p.ws + WS_U);
    char* wo = (char*)p.out;
    if (ph == 0) {
    } else if (ph == NPH - 1) {
      if (PHON(11)) final_norm(p);
    } else {
      const int l = (ph - 1) / 10, sp = (ph - 1) % 10;
      const float* modl = modall + (size_t)l * 3 * 6144;
      GD* tab = (GD*)(smem + AUX_OFF + 4096);
      int ng = 0, nN0 = 0, nN1 = 0, nsplit = 1;
      bool seq = false;
      const float* gate = modl;
      if (sp == 0 && PHON(0)) {
        for (int t = bid; t < 4168; t += nb) {
          int r = t;
          if (r < 1472) { wt_task(pin(p, 8) + (size_t)l * 1024 * DIN, 1024, DIN, (u16*)(wo + WO_IN), r, 92, smem); continue; } r -= 1472;
          if (r < 1024) { wt_task(pin(p, 30) + (size_t)l * 1024 * 4096, 1024, 4096, (u16*)(wo + WO_FF1), r, 64, smem); continue; } r -= 1024;
          if (r < 1024) { wt_task(pin(p, 31) + (size_t)l * 4096 * 1024, 4096, 1024, (u16*)(wo + WO_FF2), r, 16, smem); continue; } r -= 1024;
          if (r < 256) { wt_task(pin(p, 29) + (size_t)l * 1024 * 1024, 1024, 1024, (u16*)(wo + WO_OUT), r, 16, smem); continue; } r -= 256;
          if (r < 128) { wt_task(pin(p, 23) + (size_t)l * 512 * 1024, 512, 1024, (u16*)(wo + WO_HY), r, 16, smem); continue; } r -= 128;
          if (r < 128) { wt_task(pin(p, 28) + (size_t)l * 512 * 1024, 512, 1024, (u16*)(wo + WO_WO), r, 16, smem); continue; } r -= 128;
          if (r < 72) { wt_task(pin(p, 25) + (size_t)l * 384 * 768, 384, 768, (u16*)(wo + WO_UQ), r, 12, smem); continue; } r -= 72;
          wt_task(pin(p, 27) + (size_t)l * 256 * 1024, 256, 1024, (u16*)(wo + WO_UKV), r, 16, smem);
        }
        norm_rows(p, pin(p, 6) + l * 1024, modl, 0, 1, xn);
      } else if (sp == 1 && PHON(1)) {
        if (threadIdx.x == 0) tab[0] = GD{xn, 1024, (const u16*)(wo + WO_IN), 1024, 1024, 23, EM_PROJ, 1};
        ng = 1; nN0 = 23;
      } else if (sp == 2 && PHON(2)) {
        for (int t = bid; t < 264 * 6; t += nb) premix_task(p, l, t, smem);
        {
          Epi ef{EM_FILT, p.ws, gate, nullptr, (u16*)(wo + WO_FILT)};
          const u16* hA = (const u16*)(p.ws + WS_HID2) + (size_t)l * 8192 * 64;
          const u16* wB = (const u16*)(p.ws + WS_W3T) + (size_t)l * 1024 * 64;
#pragma unroll 1
          for (int t = nb - 1 - bid; t < 128; t += nb) gemm_tile(hA, 64, wB, 64, 64, (t >> 2) * 256, (t & 3) * 256, smem, ef);
        }
      } else if (sp == 3 && PHON(3)) {
        for (int t = bid; t < 512; t += nb) fft_task(p, l, t, smem);
        if (threadIdx.x == 0) {
          tab[0] = GD{proj + OFF_Q, DINP, (const u16*)(wo + WO_UQ), 384, 384, 3, EM_Q, 1};
          tab[1] = GD{proj + OFF_KV, DINP, (const u16*)(wo + WO_UKV), 256, 256, 4, EM_KV, 1};
        }
        ng = 2; nN0 = 3; nN1 = 4;
        for (int i = tid_l(); i < 1024; i += NT) ((float2*)(smem + 131072))[i] = ((const float2*)(p.ws + WS_ROPE))[i];
      } else if (sp == 4 && PHON(4)) {
        for (int t = bid; t < 528; t += nb) {
          int bh, qb;
          if (t < 512) { int rnd = t >> 8, w = t & 255; bh = (w & 7) + 8 * rnd; qb = 1 + (w >> 3); }
          else { bh = t - 512; qb = 0; }
          attn_task(p, bh, qb, smem);
        }
        for (int t = bid; t < 528; t += nb) hypost_task(p, t, smem);
      } else if (sp == 5 && PHON(5)) {
        for (int t = bid; t < 8 * 68; t += nb) {
          const int x = t & 7, g = t >> 3, pm = (g >> 2) * 8 + x;
          if (pm < 132) mix_tile(p, l, pm, g & 3, smem);
        }
      } else if (sp == 6 && PHON(6)) {
        if (threadIdx.x == 0) tab[0] = GD{(const u16*)(p.ws + WS_ZV), 1024, (const u16*)(wo + WO_OUT), 1024, 1024, 4, EM_RESID, 4};
        ng = 1; nN0 = 4; nsplit = 4;
        gate = modl + 2 * 1024;
      } else if (sp == 7 && PHON(7)) {
        norm_rows(p, pin(p, 7) + l * 1024, modl, 3, 4, xn);
      } else if (sp == 8 && PHON(8)) {
        if (threadIdx.x == 0) tab[0] = GD{xn, 1024, (const u16*)(wo + WO_FF1), 1024, 1024, 16, EM_SQRELU, 1};
        ng = 1; nN0 = 16;
      } else if (sp == 9 && PHON(9)) {
        if (threadIdx.x == 0) tab[0] = GD{proj, DFF, (const u16*)(wo + WO_FF2), 4096, 4096, 4, EM_RESID, 8};
        ng = 1; nN0 = 4; nsplit = 8;
        gate = modl + 5 * 1024;
      }
      if (ng > 0) {
        __syncthreads();
        const int nt0 = (nsplit > 1) ? (64 * nN0 + 2 * nN0 * nsplit) : NMT * nN0, ntot = seq ? nt0 : nt0 + NMT * nN1;
        const int nseq = seq ? ng : 1;
        const int nitems = ((ntot - bid + nb - 1) / nb) * nseq;
#pragma unroll 1
        for (int it = 0; it < nitems; ++it) {
          int t = bid + (it / nseq) * nb, gi = it % nseq, tt = t;
          if (!seq && t >= nt0) { gi = 1; tt = t - nt0; }
          const volatile GD* gp = tab + gi;
          unsigned long long a64 = (unsigned long long)gp->A, b64 = (unsigned long long)gp->Bt;
          a64 = ((unsigned long long)(unsigned)__builtin_amdgcn_readfirstlane((unsigned)(a64 >> 32)) << 32) | (unsigned long long)(unsigned)__builtin_amdgcn_readfirstlane((unsigned)a64);
          b64 = ((unsigned long long)(unsigned)__builtin_amdgcn_readfirstlane((unsigned)(b64 >> 32)) << 32) | (unsigned long long)(unsigned)__builtin_amdgcn_readfirstlane((unsigned)b64);
          const int lda = __builtin_amdgcn_readfirstlane(gp->lda), ldb = __builtin_amdgcn_readfirstlane(gp->ldb);
          const int K = __builtin_amdgcn_readfirstlane(gp->K), nN = __builtin_amdgcn_readfirstlane(gp->nN);
          const int ks = __builtin_amdgcn_readfirstlane(gp->ks);
          const int mode = __builtin_amdgcn_readfirstlane(gp->mode);
          int pm, pn, Kuse = K, emode = mode;
          if (ks > 1) {
            const int nlat = 64 * nN;
            if (tt < nlat) { int pm64; tile_map(tt, 64, nN, pm64, pn); pm = (pm64 >> 5) * 33 + 1 + (pm64 & 31); }
            else {
              int u = tt - nlat, kp = u % ks, tile = u / ks;
              pm = (tile / nN) * 33; pn = tile % nN;
              Kuse = K / ks; emode = EM_RESID_AT;
              a64 += (unsigned long long)kp * Kuse * 2; b64 += (unsigned long long)kp * Kuse * 2;
            }
          } else tile_map(tt, NMT, nN, pm, pn);
          Epi e{emode, p.ws, gate, (const float2*)(smem + 131072), nullptr};
          gemm_tile((const u16*)a64, lda, (const u16*)b64, ldb, Kuse, pm * 256, pn * 256, smem, e);
        }
      }
    }
    if (ph + 1 < prm.ph_hi) {
      if (ph == prm.ph_lo) grid.sync();
      else { ++nbar; grid_barrier((unsigned*)(prm.ws + WS_BAR), nbar * gridDim.x); }
    }
  }
}

extern "C" void kernel_launch(void* const* d_in, const int* in_sizes, int n_in, void* d_out, int out_size, void* d_ws,
                              size_t ws_size, hipStream_t stream) {
  static int grid_blocks = 0;
  if (grid_blocks == 0) {
    if (n_in != 33 || ws_size < WS_END || (size_t)out_size * 4 < WO_END) {
      fprintf(stderr, "kernel_launch: unexpected sizes n_in=%d ws=%zu (need %zu) out=%d\n", n_in, ws_size, (size_t)WS_END, out_size);
      grid_blocks = -1;
      return;
    }
    int dev = 0, cus = 0, per_cu = 0;
    hipGetDevice(&dev);
    hipDeviceGetAttribute(&cus, hipDeviceAttributeMultiprocessorCount, dev);
    hipOccupancyMaxActiveBlocksPerMultiprocessor(&per_cu, mega, NT, 0);
    if (per_cu < 1) per_cu = 1;
    if (per_cu > 1) per_cu = 1;
    grid_blocks = cus * per_cu;
  }
  if (grid_blocks < 0) return;
  Params p{};
  for (int i = 0; i < 33; ++i) p.in[i] = (const float*)d_in[i];
  p.out = (float*)d_out;
  p.ws = (char*)d_ws;
  p.ph_lo = 0;
  p.ph_hi = NPH;
  (void)hipMemsetAsync((char*)d_ws + WS_BAR, 0, 1024, stream);
  void* args[] = {&p};
  hipError_t e = hipLaunchCooperativeKernel((void*)mega, dim3(grid_blocks), dim3(NT), args, 0, stream);
  if (e != hipSuccess) fprintf(stderr, "cooperative launch failed: %s (grid %d)\n", hipGetErrorString(e), grid_blocks);
}
```

```cpp
#include <hip/hip_runtime.h>
#include <hip/hip_cooperative_groups.h>
#include <cstdio>
namespace cg = cooperative_groups;

typedef unsigned short u16;
using bf16x8 = __attribute__((ext_vector_type(8))) short;
using f32x4 = __attribute__((ext_vector_type(4))) float;
using f32x16 = __attribute__((ext_vector_type(16))) float;

constexpr int D = 1024, SEQ = 8192, CTX = 256, SP = 8448, MROWS = 16896, NMT = 66;
constexpr int DIN = 5792, DINP = 5888, DFF = 4096;
constexpr int OFF_HY = 512, OFF_Q = 2048, OFF_KV = 2432, OFF_GATE = 2720;
constexpr int NT = 512;
constexpr float EPS = 1e-6f;

constexpr size_t WS_H = 0;
constexpr size_t WS_PROJ = WS_H + (size_t)MROWS * D * 4;
constexpr size_t WS_U = WS_PROJ + (size_t)MROWS * DINP * 2;
constexpr size_t WS_Y = WS_U + (size_t)MROWS * 512 * 2;
constexpr size_t WS_O = WS_Y + (size_t)MROWS * 512 * 2;
constexpr size_t WS_Q = WS_O + (size_t)MROWS * 512 * 2;
constexpr size_t WS_K = WS_Q + (size_t)16 * SP * 96 * 2;
constexpr size_t WS_VT = WS_K + (size_t)16 * SP * 96 * 2;
constexpr size_t WS_ZV = WS_VT + (size_t)16 * 64 * SP * 2;
constexpr size_t WS_HID2 = WS_ZV + (size_t)512 * SP * 8;
constexpr size_t WS_HID2C = WS_HID2 + (size_t)4 * 8192 * 64 * 4;
constexpr size_t WS_MOD = WS_HID2C + (size_t)4 * 256 * 64 * 4;
constexpr size_t WS_ROPE = WS_MOD + (size_t)4 * 3 * 6144 * 4;
constexpr size_t WS_TW = WS_ROPE + (size_t)128 * 8 * 8;
constexpr size_t WS_WPE = WS_TW + (size_t)16384 * 8;
constexpr size_t WS_BAR = WS_WPE + (size_t)4 * 1024 * 512 * 2;
constexpr size_t WS_END = WS_BAR + 1024;
constexpr size_t WO_IN = 0;
constexpr size_t WO_FF1 = WO_IN + (size_t)DINP * 1024 * 2;
constexpr size_t WO_FF2 = WO_FF1 + (size_t)4096 * 1024 * 2;
constexpr size_t WO_OUT = WO_FF2 + (size_t)4096 * 1024 * 2;
constexpr size_t WO_HY = WO_OUT + (size_t)1024 * 1024 * 2;
constexpr size_t WO_WO = WO_HY + (size_t)1024 * 512 * 2;
constexpr size_t WO_PE = WO_WO + (size_t)1024 * 512 * 2;
constexpr size_t WO_UQ = WO_PE + (size_t)1024 * 512 * 2;
constexpr size_t WO_UKV = WO_UQ + (size_t)768 * 384 * 2;
constexpr size_t WO_FILT = WO_UKV + (size_t)1024 * 256 * 2;
constexpr size_t WO_END = WO_FILT + (size_t)1024 * 8192 * 2;
constexpr size_t WS_W3T = WS_HID2 + (size_t)4 * 8192 * 64 * 2;

constexpr int AUX_OFF = 147456;
constexpr int LDS_BYTES = AUX_OFF + 8192;

struct Params {
  const float* in[33];
  float* out;
  char* ws;
  int ph_lo, ph_hi;
};

struct Ctx { const unsigned long long* intab; char* ws; float* out; };
__device__ __forceinline__ const float* pin(const Ctx& c, int i) {
  unsigned long long v = c.intab[i];
  unsigned lo = __builtin_amdgcn_readfirstlane((unsigned)v), hi = __builtin_amdgcn_readfirstlane((unsigned)(v >> 32));
  return (const float*)(((unsigned long long)hi << 32) | lo);
}

typedef __bf16 hwbf2 __attribute__((ext_vector_type(2)));
typedef float hwf2 __attribute__((ext_vector_type(2)));
__device__ __forceinline__ unsigned pk2(float a, float b) {
  hwf2 v = {a, b};
  hwbf2 r = __builtin_convertvector(v, hwbf2);
  return __builtin_bit_cast(unsigned, r);
}
__device__ __forceinline__ u16 f2bf(float f) { return (u16)(pk2(f, 0.f) & 0xffffu); }
__device__ __forceinline__ float bf2f(u16 b) { return __uint_as_float(((unsigned)b) << 16); }
__device__ __forceinline__ float shx(float v, int o) {
  int l = __builtin_amdgcn_mbcnt_hi(~0u, __builtin_amdgcn_mbcnt_lo(~0u, 0u));
  asm volatile("" : "+v"(l));
  return __int_as_float(__builtin_amdgcn_ds_bpermute((l ^ o) << 2, __float_as_int(v)));
}
__device__ __forceinline__ float wave_sum(float v) {
#pragma unroll
  for (int o = 1; o < 64; o <<= 1) v += shx(v, o);
  return v;
}
__device__ __forceinline__ int grp_of_row(int m) {
  int tile = m >> 8, b = tile / 33, t33 = tile - b * 33;
  return t33 == 0 ? 2 : b;
}
__device__ __forceinline__ float2 cmul(float2 a, float2 b) { return make_float2(a.x * b.x - a.y * b.y, a.x * b.y + a.y * b.x); }

__device__ __forceinline__ int tid_l() { int t = threadIdx.x; asm volatile("" : "+v"(t)); return t; }
__device__ __forceinline__ void grid_barrier(unsigned* bar, unsigned target) {
  asm volatile("s_waitcnt vmcnt(0)" ::: "memory");
  __syncthreads();
  if (threadIdx.x == 0) {
    __builtin_amdgcn_fence(__ATOMIC_RELEASE, "agent");
    asm volatile("s_waitcnt vmcnt(0)" ::: "memory");
    __hip_atomic_fetch_add(bar, 1u, __ATOMIC_RELAXED, __HIP_MEMORY_SCOPE_AGENT);
    while (__hip_atomic_load(bar, __ATOMIC_RELAXED, __HIP_MEMORY_SCOPE_AGENT) < target) __builtin_amdgcn_s_sleep(2);
    __builtin_amdgcn_fence(__ATOMIC_ACQUIRE, "agent");
    asm volatile("s_waitcnt vmcnt(0)" ::: "memory");
  }
  __syncthreads();
}
#define WAIT_V(n) asm volatile("s_waitcnt vmcnt(%0)" ::"n"(n) : "memory")
#define SCHED() __builtin_amdgcn_sched_barrier(0)
#define RAW_BARRIER() do { asm volatile("s_waitcnt lgkmcnt(0)" ::: "memory"); __builtin_amdgcn_s_barrier(); } while (0)

constexpr float QSCALE = 0.10206207261596575f * 1.4426950408889634f;
enum { EM_PROJ = 0, EM_SQRELU = 1, EM_RESID = 2, EM_RESID_AT = 3, EM_FILT = 4, EM_Q = 6, EM_KV = 7 };
struct Epi {
  int mode;
  char* ws;
  const float* gate;
  const float2* rope_lds;
  u16* filt_out;
  __device__ __forceinline__ void proj(int row, int col, f32x4 v) const {
    {
      u16* out = (u16*)(ws + WS_PROJ);
#pragma unroll
      for (int j = 0; j < 4; ++j) out[(size_t)(row + j) * DINP + col] = f2bf(v[j]);
    }
  }
  __device__ __forceinline__ void sqrelu(int row, int col, f32x4 v) const {
    {
      u16* out = (u16*)(ws + WS_PROJ);
#pragma unroll
      for (int j = 0; j < 4; ++j) { float r = fmaxf(v[j], 0.f); out[(size_t)(row + j) * DFF + col] = f2bf(r * r); }
    }
  }
  __device__ __forceinline__ void resid(int row, int col, f32x4 v) const {
    {
      float* h = (float*)(ws + WS_H);
      float g = gate[grp_of_row(row) * 6144 + col];
#pragma unroll
      for (int j = 0; j < 4; ++j) unsafeAtomicAdd(h + (size_t)(row + j) * D + col, g * v[j]);
    }
  }
  __device__ __forceinline__ void filt(int row, int col, f32x4 v) const {
    uint2 o;
    o.x = pk2(v[0], v[1]);
    o.y = pk2(v[2], v[3]);
    *(uint2*)(filt_out + (size_t)col * 8192 + row) = o;
  }
  __device__ __forceinline__ void q(int row, int col, f32x4 v) const {
    {
      u16* Q = (u16*)(ws + WS_Q);
      const float2* rope = rope_lds;
      int head = col / 96, d = col - head * 96;
      int b = row / SP, pos0 = row - b * SP;
      bool isrope = (d >= 64) && (pos0 >= CTX);
      int rd = d - 64;
#pragma unroll
      for (int j = 0; j < 4; ++j) {
        float val = v[j];
        float partner = shx(val, 8);
        int pos = pos0 + j;
        if (isrope) {
          int t = pos - CTX, idx = (rd < 16) ? (t >> 6) : (t & 63);
          float2 cs = rope[idx * 8 + (rd & 7)];
          float sgn = (rd & 8) ? 1.f : -1.f;
          val = val * cs.x + sgn * partner * cs.y;
        }
        Q[((size_t)(b * 8 + head) * SP + pos) * 96 + d] = f2bf(val * QSCALE);
      }
    }
  }
  __device__ __forceinline__ void kv(int row, int col, f32x4 v) const {
    {
      u16* Kb = (u16*)(ws + WS_K);
      u16* Vt = (u16*)(ws + WS_VT);
      int head = col >> 7, j2 = col & 127;
      int b = row / SP, pos0 = row - b * SP;
      if (j2 < 64) {
#pragma unroll
        for (int j = 0; j < 4; ++j) Kb[((size_t)(b * 8 + head) * SP + pos0 + j) * 96 + j2] = f2bf(v[j]);
      } else {
        uint2 o;
        o.x = pk2(v[0], v[1]);
        o.y = pk2(v[2], v[3]);
        *(uint2*)(Vt + ((size_t)(b * 8 + head) * 64 + (j2 - 64)) * SP + pos0) = o;
      }
    }
  }
};
struct GD { const u16* A; int lda; const u16* Bt; int ldb; int K; int nN; int mode; int ks; };

constexpr int G_TILE_B = 256 * 64 * 2, G_STAGE_B = 2 * G_TILE_B;
__device__ __forceinline__ int lds_byte(int r, int c) {
  int st = (r >> 4) * 2 + (c >> 5), ob = (r & 15) * 64 + (c & 31) * 2;
  return st * 1024 + (ob ^ (((ob >> 9) & 1) << 5));
}
__device__ __forceinline__ void stage_rc(int b, int& R, int& C) {
  int st = b >> 10, sb = b & 1023, swz = sb ^ (((sb >> 9) & 1) << 5);
  R = (st / 2) * 16 + swz / 64;
  C = (st % 2) * 32 + (swz % 64) / 2;
}

template <int MI>
__device__ __forceinline__ void gemm_core(const u16* __restrict__ A, int lda, const u16* __restrict__ Bt, int ldb, int K,
                                          int brow, int bcol, char* shm, f32x4 (&acc)[MI][4]) {
  constexpr int TILE_A = MI * 32 * 64 * 2, TILE_BB = 256 * 64 * 2, STAGE = TILE_A + TILE_BB;
  const int tid = tid_l(), wid = tid >> 6, lane = tid & 63, wr = wid >> 2, wc = wid & 3, fr = lane & 15, fq = lane >> 4;
  const u16* Ab = A + (size_t)brow * lda;
  const u16* Bb = Bt + (size_t)bcol * ldb;
  int sR[4], sC[4];
#pragma unroll
  for (int i = 0; i < 4; ++i) stage_rc(wid * 1024 + i * 8192 + lane * 16, sR[i], sC[i]);
#define SA(b) (shm + (b) * STAGE)
#define SB(b) (shm + (b) * STAGE + TILE_A)
#define GLDS_STAGE(buf, kt)                                                                                              \
  do {                                                                                                                   \
    _Pragma("unroll") for (int i = 0; i < 4; ++i) {                                                                      \
      if (i < MI / 2)                                                                                                    \
        __builtin_amdgcn_global_load_lds((const unsigned*)(Ab + (size_t)sR[i] * lda + (kt) * 64 + sC[i]),                \
                                         (unsigned*)(SA(buf) + wid * 1024 + i * 8192), 16, 0, 0);                        \
      __builtin_amdgcn_global_load_lds((const unsigned*)(Bb + (size_t)sR[i] * ldb + (kt) * 64 + sC[i]),                  \
                                       (unsigned*)(SB(buf) + wid * 1024 + i * 8192), 16, 0, 0);                          \
    }                                                                                                                    \
  } while (0)
  const int nt = K / 64;
  GLDS_STAGE(0, 0);
  WAIT_V(0);
  __syncthreads();
  for (int t = 0; t < nt; ++t) {
    const int cur = t & 1;
    if (t + 1 < nt) GLDS_STAGE(cur ^ 1, t + 1);
#pragma unroll
    for (int ks = 0; ks < 2; ++ks) {
      bf16x8 At[MI], Bf[4];
#pragma unroll
      for (int m = 0; m < MI; ++m) At[m] = *(const bf16x8*)(SA(cur) + lds_byte(wr * (MI * 16) + m * 16 + fr, ks * 32 + fq * 8));
#pragma unroll
      for (int n = 0; n < 4; ++n) Bf[n] = *(const bf16x8*)(SB(cur) + lds_byte(wc * 64 + n * 16 + fr, ks * 32 + fq * 8));
#pragma unroll
      for (int m = 0; m < MI; ++m)
#pragma unroll
        for (int n = 0; n < 4; ++n) acc[m][n] = __builtin_amdgcn_mfma_f32_16x16x32_bf16(At[m], Bf[n], acc[m][n], 0, 0, 0);
      SCHED();
    }
    WAIT_V(0);
    __syncthreads();
  }
#undef SA
#undef SB
#undef GLDS_STAGE
}

template <class EpiT>
__device__ __forceinline__ void gemm_tile(const u16* __restrict__ A, int lda, const u16* __restrict__ Bt, int ldb, int K,
                                          int brow, int bcol, char* shm, const EpiT& epi) {
  const int tid = tid_l(), wid = tid >> 6, lane = tid & 63, wr = wid >> 2, wc = wid & 3, fr = lane & 15, fq = lane >> 4;
  f32x4 acc[8][4];
#pragma unroll
  for (int m = 0; m < 8; ++m)
#pragma unroll
    for (int n = 0; n < 4; ++n) acc[m][n] = (f32x4){0.f, 0.f, 0.f, 0.f};
  gemm_core<8>(A, lda, Bt, ldb, K, brow, bcol, shm, acc);
#define EPI_LOOP(CALL)                                                                              \
  _Pragma("unroll") for (int m = 0; m < 8; ++m) _Pragma("unroll") for (int n = 0; n < 4; ++n) {      \
    const int row = brow + wr * 128 + m * 16 + fq * 4, col = bcol + wc * 64 + n * 16 + fr;           \
    const f32x4 v = acc[m][n];                                                                        \
    CALL;                                                                                             \
  }
  if (epi.mode == EM_PROJ) { EPI_LOOP(epi.proj(row, col, v)) }
  else if (epi.mode == EM_SQRELU) { EPI_LOOP(epi.sqrelu(row, col, v)) }
  else if (epi.mode == EM_RESID_AT) { EPI_LOOP(epi.resid(row, col, v)) }
  else if (epi.mode == EM_RESID) {
    float* h = (float*)(epi.ws + WS_H);
    float g4[4];
#pragma unroll
    for (int n = 0; n < 4; ++n) g4[n] = epi.gate[grp_of_row(brow) * 6144 + bcol + wc * 64 + n * 16 + fr];
    float hv[8][4][4];
    float* hp0 = h + (size_t)(brow + wr * 128 + fq * 4) * D + bcol + wc * 64 + fr;
#define H_LOAD(m) _Pragma("unroll") for (int n = 0; n < 4; ++n) _Pragma("unroll") for (int j = 0; j < 4; ++j) hv[m][n][j] = hp0[(size_t)((m) * 16 + j) * D + n * 16]
#define H_STORE(m) _Pragma("unroll") for (int n = 0; n < 4; ++n) _Pragma("unroll") for (int j = 0; j < 4; ++j) hp0[(size_t)((m) * 16 + j) * D + n * 16] = hv[m][n][j] + g4[n] * acc[m][n][j]
    H_LOAD(0); H_LOAD(1);
    SCHED();
    H_STORE(0); H_LOAD(2); SCHED();
    H_STORE(1); H_LOAD(3); SCHED();
    H_STORE(2); H_LOAD(4); SCHED();
    H_STORE(3); H_LOAD(5); SCHED();
    H_STORE(4); H_LOAD(6); SCHED();
    H_STORE(5); H_LOAD(7); SCHED();
    H_STORE(6); H_STORE(7);
#undef H_LOAD
#undef H_STORE
  }
  else if (epi.mode == EM_FILT) { EPI_LOOP(epi.filt(row, col, v)) }
  else if (epi.mode == EM_Q) { EPI_LOOP(epi.q(row, col, v)) }
  else { EPI_LOOP(epi.kv(row, col, v)) }
#undef EPI_LOOP
}

__device__ __forceinline__ void mix_tile(const Ctx& p, int l, int pm, int pn, char* shm) {
  constexpr int TILE_A = 128 * 64 * 2, TILE_BB = 256 * 64 * 2, STAGE = TILE_A + TILE_BB;
  const int tid = tid_l(), wid = tid >> 6, lane = tid & 63, wr = wid >> 2, wc = wid & 3, fr = lane & 15, fq = lane >> 4;
  const int brow = pm * 128, bcol = pn * 256;
  const u16* projb = (const u16*)(p.ws + WS_PROJ);
  char* wo = (char*)p.out;
#define SA(b) (shm + (b) * STAGE)
#define SB(b) (shm + (b) * STAGE + TILE_A)
#define MIX_STAGE(buf, kt)                                                                                               \
  do {                                                                                                                   \
    const int br_ = (kt) >> 3, ko_ = ((kt) & 7) * 64;                                                                    \
    const u16* Ab_ = (const u16*)(p.ws + (br_ == 0 ? WS_U : br_ == 1 ? WS_Y : WS_O)) + (size_t)brow * 512 + ko_;         \
    const u16* Bb_ = (br_ == 0 ? (const u16*)(p.ws + WS_WPE) + (size_t)l * 1024 * 512 : (const u16*)(wo + (br_ == 1 ? WO_HY : WO_WO))) + (size_t)bcol * 512 + ko_;        \
    _Pragma("unroll") for (int i = 0; i < 4; ++i) {                                                                      \
      int sR_, sC_; stage_rc(wid * 1024 + i * 8192 + lane * 16, sR_, sC_);                                              \
      if (i < 2)                                                                                                         \
        __builtin_amdgcn_global_load_lds((const unsigned*)(Ab_ + sR_ * 512 + sC_),                           \
                                         (unsigned*)(SA(buf) + wid * 1024 + i * 8192), 16, 0, 0);                        \
      __builtin_amdgcn_global_load_lds((const unsigned*)(Bb_ + sR_ * 512 + sC_),                             \
                                       (unsigned*)(SB(buf) + wid * 1024 + i * 8192), 16, 0, 0);                          \
    }                                                                                                                    \
  } while (0)
  f32x4 tot[4][4], acc[4][4];
#pragma unroll
  for (int m = 0; m < 4; ++m)
#pragma unroll
    for (int n = 0; n < 4; ++n) { tot[m][n] = (f32x4){0.f, 0.f, 0.f, 0.f}; acc[m][n] = (f32x4){0.f, 0.f, 0.f, 0.f}; }
  MIX_STAGE(0, 0);
  MIX_STAGE(1, 1);
  WAIT_V(6);
  RAW_BARRIER();
  int cur = 0;
#pragma unroll 1
  for (int br = 0; br < 3; ++br) {
    unsigned gpk[4][4][2];
    const u16* gp = projb + (size_t)(brow + wr * 64 + fq * 4) * DINP + OFF_GATE + br * 1024 + bcol + wc * 64 + fr;
#define GATE_LOAD(m)                                                                                   \
    _Pragma("unroll") for (int n = 0; n < 4; ++n) _Pragma("unroll") for (int j2 = 0; j2 < 2; ++j2) {       \
      unsigned lo = gp[(size_t)((m) * 16 + 2 * j2) * DINP + n * 16], hi = gp[(size_t)((m) * 16 + 2 * j2 + 1) * DINP + n * 16]; \
      gpk[m][n][j2] = lo | (hi << 16);                                                                     \
    }
    GATE_LOAD(0); GATE_LOAD(1); GATE_LOAD(2);
#pragma unroll 1
    for (int kk = 0; kk < 8; ++kk) {
      const int t = br * 8 + kk;
      { int nx = cur + 2; if (nx >= 3) nx -= 3; if (t + 2 < 24) MIX_STAGE(nx, t + 2); }
#pragma unroll
      for (int ks = 0; ks < 2; ++ks) {
        bf16x8 At[2], Bf[4];
#pragma unroll
        for (int n = 0; n < 4; ++n) Bf[n] = *(const bf16x8*)(SB(cur) + lds_byte(wc * 64 + n * 16 + fr, ks * 32 + fq * 8));
#pragma unroll
        for (int mh = 0; mh < 2; ++mh) {
#pragma unroll
          for (int m = 0; m < 2; ++m) At[m] = *(const bf16x8*)(SA(cur) + lds_byte(wr * 64 + (mh * 2 + m) * 16 + fr, ks * 32 + fq * 8));
#pragma unroll
          for (int m = 0; m < 2; ++m)
#pragma unroll
            for (int n = 0; n < 4; ++n) acc[mh * 2 + m][n] = __builtin_amdgcn_mfma_f32_16x16x32_bf16(At[m], Bf[n], acc[mh * 2 + m][n], 0, 0, 0);
          SCHED();
        }
      }
      if (t + 2 < 24) WAIT_V(6); else WAIT_V(0);
      RAW_BARRIER();
      cur = (cur == 2) ? 0 : cur + 1;
    }
    GATE_LOAD(3);
#undef GATE_LOAD
#pragma unroll
    for (int m = 0; m < 4; ++m)
#pragma unroll
      for (int n = 0; n < 4; ++n)
#pragma unroll
        for (int j = 0; j < 4; ++j) {
          const unsigned w = gpk[m][n][j >> 1];
          const float gv = __uint_as_float((j & 1) ? (w & 0xffff0000u) : (w << 16));
          tot[m][n][j] += acc[m][n][j] / (1.f + __expf(-gv));
          acc[m][n][j] = 0.f;
        }
  }
  u16* mixb = (u16*)(p.ws + WS_ZV);
#pragma unroll
  for (int m = 0; m < 4; ++m)
#pragma unroll
    for (int n = 0; n < 4; ++n)
#pragma unroll
      for (int j = 0; j < 4; ++j)
        mixb[(size_t)(brow + wr * 64 + m * 16 + fq * 4 + j) * D + bcol + wc * 64 + n * 16 + fr] = f2bf(tot[m][n][j]);
#undef SA
#undef SB
#undef MIX_STAGE
}

__device__ __forceinline__ void tile_map(int t, int nM, int nN, int& pm, int& pn) {
  int nwg = nM * nN, wgid = t;
  {
    int q = nwg / 8, r = nwg % 8, xcd = wgid % 8, off = wgid / 8;
    wgid = (xcd < r ? xcd * (q + 1) : r * (q + 1) + (xcd - r) * q) + off;
  }
  int nig = 8 * nN, gid = wgid / nig, fm = gid * 8, gsz = min(nM - fm, 8);
  pm = fm + ((wgid % nig) % gsz);
  pn = (wgid % nig) / gsz;
}

__device__ __forceinline__ void p0_misc(const Ctx& p) {
  const int gtid = blockIdx.x * NT + tid_l(), gn = gridDim.x * NT;
  float4* h4 = (float4*)(p.ws + WS_H);
  const float4* x4 = (const float4*)pin(p, 0);
  const float4* c4 = (const float4*)pin(p, 2);
  for (int i = gtid; i < MROWS * 256; i += gn) {
    int m = i >> 8, q = i & 255, b = m / SP, pos = m - b * SP;
    float4 v = (pos < CTX) ? c4[(size_t)(b * CTX + pos) * 256 + q] : x4[(size_t)(b * SEQ + pos - CTX) * 256 + q];
    h4[i] = v;
  }
  float2* rope = (float2*)(p.ws + WS_ROPE);
  for (int i = gtid; i < 1024; i += gn) {
    int idx = i >> 3, f = i & 7;
    float inv = powf(10000.f, -(float)f / 8.f);
    float a = (float)idx * inv;
    rope[i] = make_float2(cosf(a), sinf(a));
  }
  {
    u16* w3t = (u16*)(p.ws + WS_W3T);
    const float* w3 = pin(p, 20);
    for (int i = gtid; i < 4 * 1024 * 64; i += gn) { int l = i >> 16, c2 = (i >> 6) & 1023, k = i & 63; w3t[i] = f2bf(w3[((size_t)l * 64 + k) * 1024 + c2]); }
  }
  float2* tw = (float2*)(p.ws + WS_TW);
  for (int i = gtid; i < 16384; i += gn) {
    float s, c;
    sincospif(-(float)i / 8192.f, &s, &c);
    tw[i] = make_float2(c, s);
  }
}

__device__ __forceinline__ void p0_mod_task(const Ctx& p, int task, char* smem) {
  float* s = (float*)smem;
  float* red = s + 3072;
  const int tid = tid_l();
  const int l = task / 48, chunk = task - l * 48;
  for (int i = tid; i < 3072; i += NT) {
    int g = i >> 10, k = i & 1023;
    float cv = (g < 2) ? pin(p, 1)[g * 1024 + k] : pin(p, 3)[k];
    s[i] = cv / (1.f + __expf(-cv));
  }
  __syncthreads();
  const int kq = tid >> 7, col = tid & 127, n = chunk * 128 + col;
  const float* W = pin(p, 4) + (size_t)l * 1024 * 6144 + n;
  float a0 = 0.f, a1 = 0.f, a2 = 0.f;
#pragma unroll 32
  for (int k = kq * 256; k < kq * 256 + 256; ++k) {
    float w = W[(size_t)k * 6144];
    a0 += s[k] * w; a1 += s[1024 + k] * w; a2 += s[2048 + k] * w;
  }
  red[(kq * 3 + 0) * 128 + col] = a0;
  red[(kq * 3 + 1) * 128 + col] = a1;
  red[(kq * 3 + 2) * 128 + col] = a2;
  __syncthreads();
  if (tid < 384) {
    int g = tid >> 7, c2 = tid & 127, n2 = chunk * 128 + c2;
    float v = red[(0 * 3 + g) * 128 + c2] + red[(1 * 3 + g) * 128 + c2] + red[(2 * 3 + g) * 128 + c2] + red[(3 * 3 + g) * 128 + c2];
    ((float*)(p.ws + WS_MOD))[(size_t)(l * 3 + g) * 6144 + n2] = v + pin(p, 5)[l * 6144 + n2];
  }
  __syncthreads();
}

__device__ __forceinline__ void p0_hid_task(const Ctx& p, int task, char* smem) {
  float* zs = (float*)smem;
  float* h1 = zs + 8 * 36;
  float* w1s = h1 + 8 * 64;
  float* w2s = w1s + 33 * 64;
  const int tid = tid_l(), tl = tid >> 6, j = tid & 63;
  const int l = task / 132, r = task - l * 132;
  const bool isctx = r >= 128;
  const int L = isctx ? 256 : 8192;
  const int tbase = (isctx ? (r - 128) : r) * 64;
  for (int i = tid; i < 33 * 64; i += NT) w1s[i] = pin(p, 14)[l * 33 * 64 + i];
  for (int i = tid; i < 64 * 64; i += NT) w2s[i] = pin(p, 17)[l * 64 * 64 + i];
  const float b1 = pin(p, 15)[l * 64 + j], f1 = pin(p, 16)[l * 64 + j], b2 = pin(p, 18)[l * 64 + j], f2 = pin(p, 19)[l * 64 + j];
  __syncthreads();
  for (int sub = 0; sub < 8; ++sub) {
    const int t = tbase + sub * 8 + tl;
    if (j < 33) {
      float z;
      if (j == 0) z = (float)t / (float)(L - 1);
      else {
        int i = (j - 1) & 15;
        float band = 1e-4f + (float)i * ((15.f - 1e-4f) / 15.f);
        float omega = 6.2831855f * (float)t / (float)L;
        float a = omega * band;
        z = (j <= 16) ? cosf(a) : -sinf(a);
      }
      zs[tl * 36 + j] = z;
    }
    __syncthreads();
    {
      float a = b1;
#pragma unroll
      for (int k = 0; k < 33; ++k) a += zs[tl * 36 + k] * w1s[k * 64 + j];
      h1[tl * 64 + j] = sinf(f1 * a);
    }
    __syncthreads();
    {
      float a = b2;
#pragma unroll 16
      for (int k = 0; k < 64; ++k) a += h1[tl * 64 + k] * w2s[k * 64 + j];
      float v = sinf(f2 * a);
      if (isctx) ((float*)(p.ws + WS_HID2C))[((size_t)l * 64 + j) * 256 + t] = v;
      else ((u16*)(p.ws + WS_HID2))[((size_t)l * 8192 + t) * 64 + j] = f2bf(v);
    }
  }
  __syncthreads();
}

struct WtItem { const float* W; u16* WT; int K, N, k0, n0; };
__device__ __forceinline__ WtItem wt_decode(const Ctx& p, int l, int r) {
  char* wo = (char*)p.out;
  WtItem it;
  int nblk;
  if (r < 1472) { it.W = pin(p, 8) + (size_t)l * 1024 * DIN; it.K = 1024; it.N = DIN; it.WT = (u16*)(wo + WO_IN); nblk = 92; }
  else if ((r -= 1472) < 1024) { it.W = pin(p, 30) + (size_t)l * 1024 * 4096; it.K = 1024; it.N = 4096; it.WT = (u16*)(wo + WO_FF1); nblk = 64; }
  else if ((r -= 1024) < 1024) { it.W = pin(p, 31) + (size_t)l * 4096 * 1024; it.K = 4096; it.N = 1024; it.WT = (u16*)(wo + WO_FF2); nblk = 16; }
  else if ((r -= 1024) < 256) { it.W = pin(p, 29) + (size_t)l * 1024 * 1024; it.K = 1024; it.N = 1024; it.WT = (u16*)(wo + WO_OUT); nblk = 16; }
  else if ((r -= 256) < 128) { it.W = pin(p, 23) + (size_t)l * 512 * 1024; it.K = 512; it.N = 1024; it.WT = (u16*)(wo + WO_HY); nblk = 16; }
  else if ((r -= 128) < 128) { it.W = pin(p, 28) + (size_t)l * 512 * 1024; it.K = 512; it.N = 1024; it.WT = (u16*)(wo + WO_WO); nblk = 16; }
  else if ((r -= 128) < 72) { it.W = pin(p, 25) + (size_t)l * 384 * 768; it.K = 384; it.N = 768; it.WT = (u16*)(wo + WO_UQ); nblk = 12; }
  else { r -= 72; it.W = pin(p, 27) + (size_t)l * 256 * 1024; it.K = 256; it.N = 1024; it.WT = (u16*)(wo + WO_UKV); nblk = 16; }
  const int kb = r / nblk, nb2 = r - kb * nblk;
  it.k0 = kb * 64; it.n0 = nb2 * 64;
  return it;
}
__device__ __forceinline__ void wt_load(const WtItem& it, int tid, float (&v)[8]) {
  const int nn = tid & 63, kq = tid >> 6;
  const bool ok = it.n0 + nn < it.N;
  const float* src = it.W + (size_t)(it.k0 + kq) * it.N + it.n0 + (ok ? nn : 0);
#pragma unroll
  for (int r = 0; r < 8; ++r) { float x = src[(size_t)(r * 8) * it.N]; v[r] = ok ? x : 0.f; }
}
__device__ __forceinline__ void wt_phase(const Ctx& p, int l, char* smem) {
  float* tile = (float*)smem;
  const int tid = tid_l();
  const int bid = blockIdx.x, nb = gridDim.x;
  int t = bid;
  if (t >= 4168) return;
  WtItem cur = wt_decode(p, l, t);
  float v[8];
  wt_load(cur, tid, v);
#pragma unroll 1
  while (true) {
    const int tn = t + nb;
    const bool more = tn < 4168;
    WtItem nxt = cur;
    float vn[8];
    if (more) { nxt = wt_decode(p, l, tn); wt_load(nxt, tid, vn); }
#pragma unroll
    for (int r = 0; r < 8; ++r) tile[(r * 8 + (tid >> 6)) * 65 + (tid & 63)] = v[r];
    __syncthreads();
    {
      int n = tid >> 3, kc = (tid & 7) * 8;
      uint4 o;
      o.x = pk2(tile[(kc + 0) * 65 + n], tile[(kc + 1) * 65 + n]);
      o.y = pk2(tile[(kc + 2) * 65 + n], tile[(kc + 3) * 65 + n]);
      o.z = pk2(tile[(kc + 4) * 65 + n], tile[(kc + 5) * 65 + n]);
      o.w = pk2(tile[(kc + 6) * 65 + n], tile[(kc + 7) * 65 + n]);
      *(uint4*)(cur.WT + (size_t)(cur.n0 + n) * cur.K + cur.k0 + kc) = o;
    }
    __syncthreads();
    if (!more) break;
    cur = nxt;
#pragma unroll
    for (int r = 0; r < 8; ++r) v[r] = vn[r];
    t = tn;
  }
}

__device__ __forceinline__ void wpe_task(const Ctx& p, int l, int task, char* smem) {
  const int g = task >> 3, c0 = (task & 7) * 16, tid = tid_l();
  const float* pw = pin(p, 9) + ((size_t)(l * 4 + g) * 128) * 128;
  const float* sc = pin(p, 10) + l * 512 + g * 128;
  const float* po = pin(p, 11) + ((size_t)l * 512 + g * 128) * 1024;
  u16* WpeT = (u16*)(p.ws + WS_WPE) + (size_t)l * 1024 * 512;
  float* wl = (float*)smem;
  for (int i = tid; i < 16 * 128; i += NT) { int d = i & 127; wl[i] = pw[(c0 + (i >> 7)) * 128 + d] * sc[d]; }
  __syncthreads();
  float acc0[16], acc1[16];
#pragma unroll
  for (int i = 0; i < 16; ++i) { acc0[i] = 0.f; acc1[i] = 0.f; }
#pragma unroll 16
  for (int d = 0; d < 128; ++d) {
    float p0 = po[(size_t)d * 1024 + tid], p1 = po[(size_t)d * 1024 + 512 + tid];
#pragma unroll
    for (int i = 0; i < 16; ++i) { float w = wl[i * 128 + d]; acc0[i] += w * p0; acc1[i] += w * p1; }
  }
  uint4 o0, o1;
  o0.x = pk2(acc0[0], acc0[1]); o0.y = pk2(acc0[2], acc0[3]); o0.z = pk2(acc0[4], acc0[5]); o0.w = pk2(acc0[6], acc0[7]);
  o1.x = pk2(acc0[8], acc0[9]); o1.y = pk2(acc0[10], acc0[11]); o1.z = pk2(acc0[12], acc0[13]); o1.w = pk2(acc0[14], acc0[15]);
  uint4* dst = (uint4*)(WpeT + (size_t)tid * 512 + g * 128 + c0);
  dst[0] = o0; dst[1] = o1;
  o0.x = pk2(acc1[0], acc1[1]); o0.y = pk2(acc1[2], acc1[3]); o0.z = pk2(acc1[4], acc1[5]); o0.w = pk2(acc1[6], acc1[7]);
  o1.x = pk2(acc1[8], acc1[9]); o1.y = pk2(acc1[10], acc1[11]); o1.z = pk2(acc1[12], acc1[13]); o1.w = pk2(acc1[14], acc1[15]);
  dst = (uint4*)(WpeT + (size_t)(512 + tid) * 512 + g * 128 + c0);
  dst[0] = o0; dst[1] = o1;
  __syncthreads();
}

__device__ __forceinline__ void norm_rows(const Ctx& p, const float* gain, const float* modl, int sh_idx, int sc_idx, u16* outp) {
  const int tidx = tid_l(), lane = tidx & 63, gw = blockIdx.x * 8 + (tidx >> 6), ngw = gridDim.x * 8;
  const float* h = (const float*)(p.ws + WS_H);
  float4 g[4];
#pragma unroll
  for (int j = 0; j < 4; ++j) g[j] = *(const float4*)(gain + lane * 4 + 256 * j);
  for (int m0 = gw; m0 < MROWS; m0 += 2 * ngw) {
    const int m1 = m0 + ngw;
    const bool has1 = m1 < MROWS;
    const int m1c = has1 ? m1 : m0;
    const float4* hr0 = (const float4*)(h + (size_t)m0 * D) + lane;
    const float4* hr1 = (const float4*)(h + (size_t)m1c * D) + lane;
    float4 v0[4], v1[4];
#pragma unroll
    for (int j = 0; j < 4; ++j) { v0[j] = hr0[64 * j]; v1[j] = hr1[64 * j]; }
    const float* mg0 = modl + grp_of_row(m0) * 6144;
    const float* mg1 = modl + grp_of_row(m1c) * 6144;
    float s0 = 0.f, s1 = 0.f;
#pragma unroll
    for (int j = 0; j < 4; ++j) {
      s0 += v0[j].x * v0[j].x + v0[j].y * v0[j].y + v0[j].z * v0[j].z + v0[j].w * v0[j].w;
      s1 += v1[j].x * v1[j].x + v1[j].y * v1[j].y + v1[j].z * v1[j].z + v1[j].w * v1[j].w;
    }
    s0 = wave_sum(s0);
    s1 = wave_sum(s1);
    const float r0 = rsqrtf(s0 * (1.f / D) + EPS), r1 = rsqrtf(s1 * (1.f / D) + EPS);
    uint2* o0 = (uint2*)(outp + (size_t)m0 * D) + lane;
    uint2* o1 = (uint2*)(outp + (size_t)m1c * D) + lane;
#pragma unroll
    for (int j = 0; j < 4; ++j) {
      int n = lane * 4 + 256 * j;
      float4 sc = *(const float4*)(mg0 + sc_idx * 1024 + n), sh = *(const float4*)(mg0 + sh_idx * 1024 + n);
      uint2 o;
      o.x = pk2(v0[j].x * r0 * g[j].x * (1.f + sc.x) + sh.x, v0[j].y * r0 * g[j].y * (1.f + sc.y) + sh.y);
      o.y = pk2(v0[j].z * r0 * g[j].z * (1.f + sc.z) + sh.z, v0[j].w * r0 * g[j].w * (1.f + sc.w) + sh.w);
      o0[64 * j] = o;
    }
    if (has1) {
#pragma unroll
      for (int j = 0; j < 4; ++j) {
        int n = lane * 4 + 256 * j;
        float4 sc = *(const float4*)(mg1 + sc_idx * 1024 + n), sh = *(const float4*)(mg1 + sh_idx * 1024 + n);
        uint2 o;
        o.x = pk2(v1[j].x * r1 * g[j].x * (1.f + sc.x) + sh.x, v1[j].y * r1 * g[j].y * (1.f + sc.y) + sh.y);
        o.y = pk2(v1[j].z * r1 * g[j].z * (1.f + sc.z) + sh.z, v1[j].w * r1 * g[j].w * (1.f + sc.w) + sh.w);
        o1[64 * j] = o;
      }
    }
  }
}

__device__ __forceinline__ void final_norm(const Ctx& p) {
  const int tidx = tid_l(), lane = tidx & 63, gw = blockIdx.x * 8 + (tidx >> 6), ngw = gridDim.x * 8;
  const float* h = (const float*)(p.ws + WS_H);
  const float* gain = pin(p, 32);
  for (int r0 = gw; r0 < 2 * SEQ; r0 += ngw) {
    int b = r0 >> 13, t = r0 & 8191, m = b * SP + CTX + t;
    const float4* hr = (const float4*)(h + (size_t)m * D) + lane;
    float4 v[4];
    float ss = 0.f;
#pragma unroll
    for (int j = 0; j < 4; ++j) { v[j] = hr[64 * j]; ss += v[j].x * v[j].x + v[j].y * v[j].y + v[j].z * v[j].z + v[j].w * v[j].w; }
    ss = wave_sum(ss);
    float r = rsqrtf(ss * (1.f / D) + EPS);
    float4* o = (float4*)(p.out + (size_t)r0 * D) + lane;
#pragma unroll
    for (int j = 0; j < 4; ++j) {
      float4 g = *(const float4*)(gain + lane * 4 + 256 * j);
      o[64 * j] = make_float4(v[j].x * r * g.x, v[j].y * r * g.y, v[j].z * r * g.z, v[j].w * r * g.w);
    }
  }
}

__device__ __forceinline__ void premix_task(const Ctx& p, int l, int task, char* smem) {
  const int tid = tid_l(), lane = tid & 63, wid = tid >> 6;
  const int part = task / 264, tile64 = task - part * 264;
  const int m0 = tile64 * 64, b = m0 / SP, pos0 = m0 - b * SP;
  const bool isctx = pos0 < CTX;
  const int s0 = isctx ? 0 : CTX, L = isctx ? CTX : SEQ, t0 = pos0 - s0;
  const size_t mb = (size_t)b * SP + s0;
  const u16* proj = (const u16*)(p.ws + WS_PROJ);
  if (part == 0) {
    u16* P = (u16*)smem;
#pragma unroll
    for (int i = tid; i < 80 * 64; i += NT) {
      int r = i >> 6, ch = i & 63, t = t0 - 8 + r;
      uint4 v = make_uint4(0, 0, 0, 0);
      if (t >= 0 && t < L) v = *(const uint4*)(proj + (mb + t) * DINP + ch * 8);
      *(uint4*)(P + r * 512 + ch * 8) = v;
    }
    __syncthreads();
    const int c = tid, g = c >> 7, hw = 1 << g;
    u16* U = (u16*)(p.ws + WS_U);
    float s = 0.f;
    for (int q = -hw; q < hw; ++q) s += bf2f(P[(8 + q) * 512 + c]);
#pragma unroll 4
    for (int tt = 0; tt < 64; ++tt) {
      int t = t0 + tt, lo = max(t - hw, 0), hi = min(t + hw, L);
      float u = s / (float)(hi - lo) - bf2f(P[(tt + 8) * 512 + c]);
      U[(mb + t) * 512 + c] = f2bf(u);
      s += bf2f(P[(tt + 8 + hw) * 512 + c]) - bf2f(P[(tt + 8 - hw) * 512 + c]);
    }
    __syncthreads();
  } else if (part <= 4) {
    const int ch0 = (part - 1) * 128;
    constexpr int PITCH = 136;
    u16* X = (u16*)smem;
    float* T = (float*)(smem + 3 * 66 * PITCH * 2 + 64);
#pragma unroll
    for (int ii = 0; ii < 7; ++ii) {
      const int i = tid + ii * NT;
      if (i >= 3 * 66 * 16) break;
      int pr = i / (66 * 16), rem = i - pr * 66 * 16, r = rem >> 4, ch = rem & 15, t = t0 - 1 + r;
      uint4 v = make_uint4(0, 0, 0, 0);
      if (t >= 0 && t < L) v = *(const uint4*)(proj + (mb + t) * DINP + OFF_HY + pr * 512 + ch0 + ch * 8);
      *(uint4*)(X + (pr * 66 + r) * PITCH + ch * 8) = v;
    }
    __syncthreads();
    const float* cw = pin(p, 12) + l * 3 * 1536;
    const float* cb = pin(p, 13) + l * 1536;
    {
      const int c = tid & 127, tq = tid >> 7, col = ch0 + c;
      const float w00 = cw[col], w01 = cw[1536 + col], w02 = cw[3072 + col], b0 = cb[col];
      const float w10 = cw[512 + col], w11 = cw[1536 + 512 + col], w12 = cw[3072 + 512 + col], b1 = cb[512 + col];
      const float w20 = cw[1024 + col], w21 = cw[1536 + 1024 + col], w22 = cw[3072 + 1024 + col], b2 = cb[1024 + col];
      const u16* X0 = X, *X1 = X + 66 * PITCH, *XV = X + 2 * 66 * PITCH;
      u16* Y = (u16*)(p.ws + WS_Y);
#pragma unroll 4
      for (int tt = tq * 16; tt < tq * 16 + 16; ++tt) {
        float x0 = w00 * bf2f(X0[tt * PITCH + c]) + w01 * bf2f(X0[(tt + 1) * PITCH + c]) + w02 * bf2f(X0[(tt + 2) * PITCH + c]) + b0;
        float x1 = w10 * bf2f(X1[tt * PITCH + c]) + w11 * bf2f(X1[(tt + 1) * PITCH + c]) + w12 * bf2f(X1[(tt + 2) * PITCH + c]) + b1;
        float vv = w20 * bf2f(XV[tt * PITCH + c]) + w21 * bf2f(XV[(tt + 1) * PITCH + c]) + w22 * bf2f(XV[(tt + 2) * PITCH + c]) + b2;
        Y[(mb + t0 + tt) * 512 + col] = f2bf(x0);
        T[c * 65 + tt] = x1 * vv;
      }
    }
    __syncthreads();
    {
      float* ZV = (float*)(p.ws + WS_ZV);
#pragma unroll 4
      for (int cc = 0; cc < 16; ++cc) {
        int c = wid * 16 + cc;
        ZV[((size_t)(ch0 + c) * SP + pos0 + lane) * 2 + b] = T[c * 65 + lane];
      }
    }
    __syncthreads();
  } else {
    u16* projw = (u16*)(p.ws + WS_PROJ);
    const float* qg = pin(p, 24) + l * 384;
    const float* kg = pin(p, 26) + l * 256;
    const float2* rope = (const float2*)(p.ws + WS_ROPE);
    u16* Kb = (u16*)(p.ws + WS_K);
#pragma unroll 2
    for (int rr = 0; rr < 8; ++rr) {
      int tt = wid * 8 + rr, pos = pos0 + tt;
      u16* row = projw + ((size_t)b * SP + pos) * DINP;
      unsigned* q32 = (unsigned*)(row + OFF_Q);
      unsigned* k32 = (unsigned*)(row + OFF_KV);
      unsigned v[3], w[2];
      float ss = 0.f, s2 = 0.f;
#pragma unroll
      for (int j = 0; j < 3; ++j) v[j] = q32[lane + 64 * j];
#pragma unroll
      for (int j = 0; j < 2; ++j) w[j] = k32[lane + 64 * j];
      const int rd = lane & 31;
      float val = bf2f(row[OFF_KV + 256 + rd]);
#pragma unroll
      for (int j = 0; j < 3; ++j) { float a = bf2f(v[j] & 0xffff), c2 = bf2f(v[j] >> 16); ss += a * a + c2 * c2; }
#pragma unroll
      for (int j = 0; j < 2; ++j) { float a = bf2f(w[j] & 0xffff), c2 = bf2f(w[j] >> 16); s2 += a * a + c2 * c2; }
      ss = wave_sum(ss);
      s2 = wave_sum(s2);
      float r = rsqrtf(ss * (1.f / 384.f) + EPS), r2 = rsqrtf(s2 * (1.f / 256.f) + EPS);
#pragma unroll
      for (int j = 0; j < 3; ++j) {
        int n = (lane + 64 * j) * 2;
        q32[lane + 64 * j] = pk2(bf2f(v[j] & 0xffff) * r * qg[n], bf2f(v[j] >> 16) * r * qg[n + 1]);
      }
#pragma unroll
      for (int j = 0; j < 2; ++j) {
        int n = (lane + 64 * j) * 2;
        k32[lane + 64 * j] = pk2(bf2f(w[j] & 0xffff) * r2 * kg[n], bf2f(w[j] >> 16) * r2 * kg[n + 1]);
      }
      float partner = shx(val, 8);
      if (!isctx) {
        int t = pos - CTX, idx = (rd < 16) ? (t >> 6) : (t & 63);
        float2 cs = rope[idx * 8 + (rd & 7)];
        float sgn = (rd & 8) ? 1.f : -1.f;
        val = val * cs.x + sgn * partner * cs.y;
      }
      if (lane < 32) {
        u16 o = f2bf(val);
#pragma unroll
        for (int hd = 0; hd < 8; ++hd) Kb[((size_t)(b * 8 + hd) * SP + pos) * 96 + 64 + rd] = o;
      }
    }
  }
}

__device__ __forceinline__ void bf_fwd(float2* X, int base, int q, float2 w1) {
  float2 w2 = cmul(w1, w1), w3 = cmul(w2, w1);
  float2 a0 = X[base], a1 = X[base + q], a2 = X[base + 2 * q], a3 = X[base + 3 * q];
  float2 s02 = make_float2(a0.x + a2.x, a0.y + a2.y), d02 = make_float2(a0.x - a2.x, a0.y - a2.y);
  float2 s13 = make_float2(a1.x + a3.x, a1.y + a3.y), d13 = make_float2(a1.x - a3.x, a1.y - a3.y);
  X[base] = make_float2(s02.x + s13.x, s02.y + s13.y);
  X[base + q] = cmul(make_float2(d02.x + d13.y, d02.y - d13.x), w1);
  X[base + 2 * q] = cmul(make_float2(s02.x - s13.x, s02.y - s13.y), w2);
  X[base + 3 * q] = cmul(make_float2(d02.x - d13.y, d02.y + d13.x), w3);
}
__device__ __forceinline__ void bf_inv(float2* X, int base, int q, float2 w1) {
  w1.y = -w1.y;
  float2 w2 = cmul(w1, w1), w3 = cmul(w2, w1);
  float2 b0 = X[base], c1 = cmul(X[base + q], w1), c2 = cmul(X[base + 2 * q], w2), c3 = cmul(X[base + 3 * q], w3);
  float2 s02 = make_float2(b0.x + c2.x, b0.y + c2.y), d02 = make_float2(b0.x - c2.x, b0.y - c2.y);
  float2 s13 = make_float2(c1.x + c3.x, c1.y + c3.y), d13 = make_float2(c1.x - c3.x, c1.y - c3.y);
  X[base] = make_float2(s02.x + s13.x, s02.y + s13.y);
  X[base + q] = make_float2(d02.x - d13.y, d02.y + d13.x);
  X[base + 2 * q] = make_float2(s02.x - s13.x, s02.y - s13.y);
  X[base + 3 * q] = make_float2(d02.x + d13.y, d02.y - d13.x);
}
template <bool INV>
__device__ __forceinline__ void fft_pass(float2* X, const float2* __restrict__ tw, int lq, int tid) {
  const int q = 1 << lq, sh = 12 - lq;
  if (lq == 12) {
    float2 w[8];
#pragma unroll
    for (int b8 = 0; b8 < 8; ++b8) w[b8] = tw[b8 * NT + tid];
#pragma unroll
    for (int b8 = 0; b8 < 8; ++b8) { int u = b8 * NT + tid; if (INV) bf_inv(X, u, q, w[b8]); else bf_fwd(X, u, q, w[b8]); }
  } else if (lq == 10) {
    float2 wA = tw[tid << 2], wB = tw[(512 + tid) << 2];
#pragma unroll 2
    for (int b8 = 0; b8 < 8; ++b8) {
      int u = b8 * NT + tid, j = u & 1023, base = ((u >> 10) << 12) + j;
      float2 w = (b8 & 1) ? wB : wA;
      if (INV) bf_inv(X, base, q, w); else bf_fwd(X, base, q, w);
    }
  } else {
    const int j = tid & (q - 1);
    float2 w = tw[j << sh];
#pragma unroll 2
    for (int b8 = 0; b8 < 8; ++b8) {
      int u = b8 * NT + tid, base = ((u >> lq) << (lq + 2)) + j;
      if (INV) bf_inv(X, base, q, w); else bf_fwd(X, base, q, w);
    }
  }
  __syncthreads();
}
__device__ __forceinline__ void fft_dif(float2* X, const float2* __restrict__ tw) {
  const int tid = tid_l();
  for (int lq = 12; lq >= 0; lq -= 2) fft_pass<false>(X, tw, lq, tid);
}
__device__ __forceinline__ void fft_dit_inv(float2* X, const float2* __restrict__ tw) {
  const int tid = tid_l();
  for (int lq = 0; lq <= 12; lq += 2) fft_pass<true>(X, tw, lq, tid);
}
__device__ __forceinline__ float block_sum(float v, float* red) {
  v = wave_sum(v);
  __syncthreads();
  { const int tb = tid_l(); if ((tb & 63) == 0) red[tb >> 6] = v; }
  __syncthreads();
  float s = red[0] + red[1] + red[2] + red[3] + red[4] + red[5] + red[6] + red[7];
  __syncthreads();
  return s;
}

__device__ __forceinline__ void fft_task(const Ctx& p, int l, int c, char* smem) {
  float2* X = (float2*)smem;
  float* aux = (float*)(smem + AUX_OFF);
  float* red = aux + 128;
  const int tid = tid_l();
  const float2* tw = (const float2*)(p.ws + WS_TW);
  const float* w3 = pin(p, 20) + (size_t)l * 64 * 1024;
  if (tid < 64) { aux[tid] = w3[tid * 1024 + c]; aux[64 + tid] = w3[tid * 1024 + 512 + c]; }
  __syncthreads();
  const float dF = fabsf(pin(p, 21)[(l * 2 + 0) * 512 + c]), dB = fabsf(pin(p, 21)[(l * 2 + 1) * 512 + c]);
  const float bias = pin(p, 22)[l * 512 + c];
  float2* zp = (float2*)(p.ws + WS_ZV) + (size_t)c * SP;
  float l1 = 0.f;
  {
    const u16* ff = (const u16*)((const char*)p.out + WO_FILT) + (size_t)c * 8192 + tid;
    const u16* fb = ff + (size_t)512 * 8192;
    u16 rf[16], rb[16];
#pragma unroll
    for (int i = 0; i < 16; ++i) { rf[i] = ff[i * NT]; rb[i] = fb[i * NT]; }
#pragma unroll
    for (int i = 0; i < 16; ++i) {
      int t = i * NT + tid;
      float tl = (float)t * (1.f / 8191.f);
      float hf = bf2f(rf[i]) * expf(-tl * dF);
      float hb = bf2f(rb[i]) * expf(-tl * dB);
      X[t] = make_float2(hf, 0.f);
      if (t >= 1) { X[16384 - t] = make_float2(hb, 0.f); l1 += fabsf(hf) + fabsf(hb); }
      else { X[8192] = make_float2(0.f, 0.f); l1 += fabsf(hf); }
    }
  }
  float l1tot = block_sum(l1, red);
  fft_dif(X, tw);
  float2 F[32];
  {
    float s = 1.f / (l1tot * 16384.f);
#pragma unroll
    for (int i = 0; i < 32; ++i) { float2 v = X[i * NT + tid]; F[i] = make_float2(v.x * s, v.y * s); }
  }
  __syncthreads();
#pragma unroll 8
  for (int i = 0; i < 16; ++i) {
    int t = i * NT + tid;
    X[t] = zp[CTX + t];
    X[8192 + t] = make_float2(0.f, 0.f);
  }
  __syncthreads();
  fft_dif(X, tw);
#pragma unroll
  for (int i = 0; i < 32; ++i) { int idx = i * NT + tid; X[idx] = cmul(X[idx], F[i]); }
  __syncthreads();
  fft_dit_inv(X, tw);
  {
    float2 zz[16];
#pragma unroll
    for (int i = 0; i < 16; ++i) zz[i] = zp[CTX + i * NT + tid];
#pragma unroll
    for (int i = 0; i < 16; ++i) {
      int t = i * NT + tid;
      float2 y = X[t];
      zp[CTX + t] = make_float2(y.x + bias * zz[i].x, y.y + bias * zz[i].y);
    }
  }
  __syncthreads();
  {
    float* hFc = (float*)smem;
    float* hBc = hFc + 256;
    float2* zc = (float2*)(hBc + 256);
    float l1c = 0.f;
    if (tid < 256) {
      int t = tid;
      const float* hc = (const float*)(p.ws + WS_HID2C) + (size_t)l * 64 * 256 + t;
      float hf = 0.f, hb = 0.f;
#pragma unroll 16
      for (int k = 0; k < 64; ++k) { float v = hc[k * 256]; hf += v * aux[k]; hb += v * aux[64 + k]; }
      float tl = (float)t * (1.f / 255.f);
      hf *= expf(-tl * dF);
      hb *= expf(-tl * dB);
      hFc[t] = hf;
      hBc[t] = hb;
      l1c = fabsf(hf) + (t >= 1 ? fabsf(hb) : 0.f);
      zc[t] = zp[t];
    }
    float l1ct = block_sum(l1c, red);
    const int bb = tid >> 8, t = tid & 255;
    float acc = 0.f;
    for (int s = 0; s < 256; ++s) {
      float kf = (s <= t) ? hFc[t - s] : hBc[s - t];
      float2 z = zc[s];
      acc += kf * (bb ? z.y : z.x);
    }
    float2 z = zc[t];
    ((float*)zp)[t * 2 + bb] = acc / l1ct + bias * (bb ? z.y : z.x);
    __syncthreads();
  }
}

constexpr int AT_KP = 208, AT_VP = 136, AT_STAGE = 64 * AT_KP + 64 * AT_VP;
__device__ __forceinline__ void attn_task(const Ctx& p, int bh, int qb, char* smem) {
  const int tid = tid_l(), wid = tid >> 6, lane = tid & 63, r = lane & 31, hh = lane >> 5;
  const u16* Qp = (const u16*)(p.ws + WS_Q) + ((size_t)bh * SP + qb * 256) * 96;
  const u16* Kp = (const u16*)(p.ws + WS_K) + (size_t)bh * SP * 96;
  const u16* Vp = (const u16*)(p.ws + WS_VT) + (size_t)bh * 64 * SP;
  const int nkt = (qb == 0) ? 4 : 132;
  bf16x8 qf[6];
#pragma unroll
  for (int ks = 0; ks < 6; ++ks) qf[ks] = *(const bf16x8*)(Qp + (size_t)(wid * 32 + r) * 96 + ks * 16 + hh * 8);
  f32x16 o0, o1;
#pragma unroll
  for (int i = 0; i < 16; ++i) { o0[i] = 0.f; o1[i] = 0.f; }
  float mrun = 0.f, lrun = 0.f;
  const u16* src[3];
  int dst[3], kstep[3];
#pragma unroll
  for (int i = 0; i < 3; ++i) {
    int ch = tid + i * NT;
    if (ch < 768) { int row = ch / 12, cc = ch - row * 12; src[i] = Kp + (size_t)row * 96 + cc * 8; dst[i] = row * AT_KP + cc * 16; kstep[i] = 64 * 96; }
    else { int v = ch - 768, row = (v >> 3) & 63, cc = v & 7; src[i] = Vp + (size_t)row * SP + cc * 8; dst[i] = 64 * AT_KP + row * AT_VP + cc * 16; kstep[i] = 64; }
  }
  const bool has3 = tid < 256;
  uint4 st[3];
#define AT_LOAD(t)                                                                                   \
  do {                                                                                               \
    st[0] = *(const uint4*)(src[0] + (size_t)(t) * kstep[0]);                                        \
    st[1] = *(const uint4*)(src[1] + (size_t)(t) * kstep[1]);                                        \
    if (has3) st[2] = *(const uint4*)(src[2] + (size_t)(t) * kstep[2]);                              \
  } while (0)
#define AT_WRITE1(i, base)                                                                           \
  do {                                                                                               \
    uint2* d_ = (uint2*)((base) + dst[i]);                                                           \
    d_[0] = make_uint2(st[i].x, st[i].y);                                                            \
    d_[1] = make_uint2(st[i].z, st[i].w);                                                            \
  } while (0)
#define AT_WRITE(buf)                                                                                \
  do {                                                                                               \
    char* base_ = smem + (buf) * AT_STAGE;                                                           \
    AT_WRITE1(0, base_); AT_WRITE1(1, base_);                                                        \
    if (has3) AT_WRITE1(2, base_);                                                                   \
  } while (0)
  AT_LOAD(0);
  AT_WRITE(0);
  __syncthreads();
  for (int t = 0; t < nkt; ++t) {
    const int cur = t & 1;
    if (t + 1 < nkt) AT_LOAD(t + 1);
    const char* Ks = smem + cur * AT_STAGE;
    const char* Vs = Ks + 64 * AT_KP;
    f32x16 s0, s1;
    {
      const float nm = -mrun;
#pragma unroll
      for (int i = 0; i < 16; ++i) { s0[i] = nm; s1[i] = nm; }
    }
#pragma unroll
    for (int ks = 0; ks < 6; ++ks) {
      bf16x8 a0 = *(const bf16x8*)(Ks + r * AT_KP + ks * 32 + hh * 16);
      bf16x8 a1 = *(const bf16x8*)(Ks + (32 + r) * AT_KP + ks * 32 + hh * 16);
      s0 = __builtin_amdgcn_mfma_f32_32x32x16_bf16(a0, qf[ks], s0, 0, 0, 0);
      s1 = __builtin_amdgcn_mfma_f32_32x32x16_bf16(a1, qf[ks], s1, 0, 0, 0);
    }
    float mx = fmaxf(s0[0], s1[0]);
#pragma unroll
    for (int i = 1; i < 16; ++i) mx = fmaxf(mx, fmaxf(s0[i], s1[i]));
    mx = fmaxf(mx, shx(mx, 32));
    if (__any(mx > 8.f)) {
      const float delta = mx > 8.f ? mx : 0.f;
      const float alpha = __builtin_amdgcn_exp2f(-delta);
      mrun += delta;
      lrun *= alpha;
#pragma unroll
      for (int i = 0; i < 16; ++i) { s0[i] -= delta; s1[i] -= delta; o0[i] *= alpha; o1[i] *= alpha; }
    }
    float ps = 0.f;
#pragma unroll
    for (int i = 0; i < 16; ++i) { s0[i] = __builtin_amdgcn_exp2f(s0[i]); s1[i] = __builtin_amdgcn_exp2f(s1[i]); ps += s0[i] + s1[i]; }
    lrun += ps;
#pragma unroll
    for (int kb = 0; kb < 2; ++kb) {
#pragma unroll
      for (int sI = 0; sI < 2; ++sI) {
        union { bf16x8 v; unsigned u[4]; } pu;
#pragma unroll
        for (int j = 0; j < 4; ++j) pu.u[j] = kb == 0 ? pk2(s0[8 * sI + 2 * j], s0[8 * sI + 2 * j + 1]) : pk2(s1[8 * sI + 2 * j], s1[8 * sI + 2 * j + 1]);
        const bf16x8 pf = pu.v;
        const int koff = (kb * 32 + 16 * sI + 4 * hh) * 2;
        union { bf16x8 v; uint2 h2[2]; } va, vb;
        va.h2[0] = *(const uint2*)(Vs + r * AT_VP + koff);
        va.h2[1] = *(const uint2*)(Vs + r * AT_VP + koff + 16);
        vb.h2[0] = *(const uint2*)(Vs + (32 + r) * AT_VP + koff);
        vb.h2[1] = *(const uint2*)(Vs + (32 + r) * AT_VP + koff + 16);
        o0 = __builtin_amdgcn_mfma_f32_32x32x16_bf16(va.v, pf, o0, 0, 0, 0);
        o1 = __builtin_amdgcn_mfma_f32_32x32x16_bf16(vb.v, pf, o1, 0, 0, 0);
      }
    }
    if (t + 1 < nkt) AT_WRITE(cur ^ 1);
    __syncthreads();
  }
  const float ltot = lrun + shx(lrun, 32);
  const float inv = 1.f / ltot;
  const int b = bh >> 3, head = bh & 7;
  u16* Op = (u16*)(p.ws + WS_O) + ((size_t)b * SP + qb * 256 + wid * 32 + r) * 512 + head * 64;
#pragma unroll
  for (int g = 0; g < 4; ++g) {
    uint2 w0, w1;
    w0.x = pk2(o0[4 * g] * inv, o0[4 * g + 1] * inv);
    w0.y = pk2(o0[4 * g + 2] * inv, o0[4 * g + 3] * inv);
    w1.x = pk2(o1[4 * g] * inv, o1[4 * g + 1] * inv);
    w1.y = pk2(o1[4 * g + 2] * inv, o1[4 * g + 3] * inv);
    *(uint2*)(Op + 8 * g + 4 * hh) = w0;
    *(uint2*)(Op + 32 + 8 * g + 4 * hh) = w1;
  }
#undef AT_LOAD
#undef AT_WRITE
#undef AT_WRITE1
}

__device__ __forceinline__ void hypost_task(const Ctx& p, int task, char* smem) {
  const int tid = tid_l(), lane = tid & 63, wid = tid >> 6;
  const int tile64 = task >> 1, ch0 = (task & 1) * 256;
  const int m0 = tile64 * 64, b = m0 / SP, pos0 = m0 - b * SP;
  float* T = (float*)smem;
  const float* ZV = (const float*)(p.ws + WS_ZV);
#pragma unroll 8
  for (int cc = 0; cc < 32; ++cc) {
    int c = wid * 32 + cc;
    T[c * 65 + lane] = ZV[((size_t)(ch0 + c) * SP + pos0 + lane) * 2 + b];
  }
  __syncthreads();
  u16* Y = (u16*)(p.ws + WS_Y);
  const int c = tid & 255, th = tid >> 8;
  u16* yp = Y + (size_t)(m0 + th * 32) * 512 + ch0 + c;
  u16 yv[32];
#pragma unroll
  for (int i = 0; i < 32; ++i) yv[i] = yp[(size_t)i * 512];
#pragma unroll
  for (int i = 0; i < 32; ++i) yp[(size_t)i * 512] = f2bf(bf2f(yv[i]) * T[c * 65 + th * 32 + i]);
  __syncthreads();
}

#ifndef PHMASK
#define PHMASK 0xFFFF
#endif
#define PHON(k) (((PHMASK) >> (k)) & 1)
constexpr int NPH = 1 + 4 * 10 + 1;
__global__ void __launch_bounds__(NT, 2) mega(Params prm) {
  __shared__ __attribute__((aligned(1024))) char smem[LDS_BYTES];
  cg::grid_group grid = cg::this_grid();
  const int bid = blockIdx.x, nb = gridDim.x;
  {
    unsigned long long* it = (unsigned long long*)(smem + AUX_OFF + 6144);
    if (threadIdx.x < 33) it[threadIdx.x] = (unsigned long long)prm.in[threadIdx.x];
    __syncthreads();
  }
  if (prm.ph_lo == 0) {
    Ctx p;
    p.intab = (const unsigned long long*)(smem + AUX_OFF + 6144);
    p.ws = prm.ws;
    p.out = prm.out;
    const int bid = blockIdx.x, nb = gridDim.x;
      if (PHON(10)) {
      p0_misc(p);
      for (int t = bid; t < 192; t += nb) p0_mod_task(p, t, smem);
      for (int t = bid; t < 528; t += nb) p0_hid_task(p, t, smem);
      for (int t = bid; t < 128; t += nb) { const int w = (t + 64) & 127; wpe_task(p, w >> 5, w & 31, smem); }
      }
  }
  unsigned nbar = 0;
  for (int ph = prm.ph_lo; ph < prm.ph_hi; ++ph) {
    Ctx p;
    p.intab = (const unsigned long long*)(smem + AUX_OFF + 6144);
    p.ws = prm.ws;
    p.out = prm.out;
    asm volatile("" : "+s"(p.ws), "+s"(p.out));
    float* modall = (float*)(p.ws + WS_MOD);
    u16* proj = (u16*)(p.ws + WS_PROJ);
    u16* xn = (u16*)(p.ws + WS_U);
    char* wo = (char*)p.out;
    if (ph == 0) {
    } else if (ph == NPH - 1) {
      if (PHON(11)) final_norm(p);
    } else {
      const int l = (ph - 1) / 10, sp = (ph - 1) % 10;
      const float* modl = modall + (size_t)l * 3 * 6144;
      GD* tab = (GD*)(smem + AUX_OFF + 4096);
      int ng = 0, nN0 = 0, nN1 = 0, nsplit = 1;
      bool seq = false;
      const float* gate = modl;
      if (sp == 0 && PHON(0)) {
        wt_phase(p, l, smem);
        norm_rows(p, pin(p, 6) + l * 1024, modl, 0, 1, xn);
      } else if (sp == 1 && PHON(1)) {
        if (threadIdx.x == 0) tab[0] = GD{xn, 1024, (const u16*)(wo + WO_IN), 1024, 1024, 23, EM_PROJ, 1};
        ng = 1; nN0 = 23;
      } else if (sp == 2 && PHON(2)) {
        for (int t = bid; t < 264 * 6; t += nb) premix_task(p, l, t, smem);
        {
          Epi ef{EM_FILT, p.ws, gate, nullptr, (u16*)(wo + WO_FILT)};
          const u16* hA = (const u16*)(p.ws + WS_HID2) + (size_t)l * 8192 * 64;
          const u16* wB = (const u16*)(p.ws + WS_W3T) + (size_t)l * 1024 * 64;
#pragma unroll 1
          for (int t = nb - 1 - bid; t < 128; t += nb) gemm_tile(hA, 64, wB, 64, 64, (t >> 2) * 256, (t & 3) * 256, smem, ef);
        }
      } else if (sp == 3 && PHON(3)) {
        for (int t = bid; t < 512; t += nb) fft_task(p, l, t, smem);
        if (threadIdx.x == 0) {
          tab[0] = GD{proj + OFF_Q, DINP, (const u16*)(wo + WO_UQ), 384, 384, 3, EM_Q, 1};
          tab[1] = GD{proj + OFF_KV, DINP, (const u16*)(wo + WO_UKV), 256, 256, 4, EM_KV, 1};
        }
        ng = 2; nN0 = 3; nN1 = 4;
        for (int i = tid_l(); i < 1024; i += NT) ((float2*)(smem + 131072))[i] = ((const float2*)(p.ws + WS_ROPE))[i];
      } else if (sp == 4 && PHON(4)) {
        for (int t = bid; t < 528; t += nb) {
          int bh, qb;
          if (t < 512) { int rnd = t >> 8, w = t & 255; bh = (w & 7) + 8 * rnd; qb = 1 + (w >> 3); }
          else { bh = t - 512; qb = 0; }
          attn_task(p, bh, qb, smem);
        }
        for (int t = bid; t < 528; t += nb) hypost_task(p, t, smem);
      } else if (sp == 5 && PHON(5)) {
        for (int t = bid; t < 8 * 68; t += nb) {
          const int x = t & 7, g = t >> 3, pm = (g >> 2) * 8 + x;
          if (pm < 132) mix_tile(p, l, pm, g & 3, smem);
        }
      } else if (sp == 6 && PHON(6)) {
        if (threadIdx.x == 0) tab[0] = GD{(const u16*)(p.ws + WS_ZV), 1024, (const u16*)(wo + WO_OUT), 1024, 1024, 4, EM_RESID, 4};
        ng = 1; nN0 = 4; nsplit = 4;
        gate = modl + 2 * 1024;
      } else if (sp == 7 && PHON(7)) {
        norm_rows(p, pin(p, 7) + l * 1024, modl, 3, 4, xn);
      } else if (sp == 8 && PHON(8)) {
        if (threadIdx.x == 0) tab[0] = GD{xn, 1024, (const u16*)(wo + WO_FF1), 1024, 1024, 16, EM_SQRELU, 1};
        ng = 1; nN0 = 16;
      } else if (sp == 9 && PHON(9)) {
        if (threadIdx.x == 0) tab[0] = GD{proj, DFF, (const u16*)(wo + WO_FF2), 4096, 4096, 4, EM_RESID, 8};
        ng = 1; nN0 = 4; nsplit = 8;
        gate = modl + 5 * 1024;
      }
      if (ng > 0) {
        __syncthreads();
        const int nt0 = (nsplit > 1) ? (64 * nN0 + 2 * nN0 * nsplit) : NMT * nN0, ntot = seq ? nt0 : nt0 + NMT * nN1;
        const int nseq = seq ? ng : 1;
        const int nitems = ((ntot - bid + nb - 1) / nb) * nseq;
#pragma unroll 1
        for (int it = 0; it < nitems; ++it) {
          int t = bid + (it / nseq) * nb, gi = it % nseq, tt = t;
          if (!seq && t >= nt0) { gi = 1; tt = t - nt0; }
          const volatile GD* gp = tab + gi;
          unsigned long long a64 = (unsigned long long)gp->A, b64 = (unsigned long long)gp->Bt;
          a64 = ((unsigned long long)(unsigned)__builtin_amdgcn_readfirstlane((unsigned)(a64 >> 32)) << 32) | (unsigned long long)(unsigned)__builtin_amdgcn_readfirstlane((unsigned)a64);
          b64 = ((unsigned long long)(unsigned)__builtin_amdgcn_readfirstlane((unsigned)(b64 >> 32)) << 32) | (unsigned long long)(unsigned)__builtin_amdgcn_readfirstlane((unsigned)b64);
          const int lda = __builtin_amdgcn_readfirstlane(gp->lda), ldb = __builtin_amdgcn_readfirstlane(gp->ldb);
          const int K = __builtin_amdgcn_readfirstlane(gp->K), nN = __builtin_amdgcn_readfirstlane(gp->nN);
          const int ks = __builtin_amdgcn_readfirstlane(gp->ks);
          const int mode = __builtin_amdgcn_readfirstlane(gp->mode);
          int pm, pn, Kuse = K, emode = mode;
          if (ks > 1) {
            const int nlat = 64 * nN;
            if (tt < nlat) { int pm64; tile_map(tt, 64, nN, pm64, pn); pm = (pm64 >> 5) * 33 + 1 + (pm64 & 31); }
            else {
              int u = tt - nlat, kp = u % ks, tile = u / ks;
              pm = (tile / nN) * 33; pn = tile % nN;
              Kuse = K / ks; emode = EM_RESID_AT;
              a64 += (unsigned long long)kp * Kuse * 2; b64 += (unsigned long long)kp * Kuse * 2;
            }
          } else tile_map(tt, NMT, nN, pm, pn);
          Epi e{emode, p.ws, gate, (const float2*)(smem + 131072), nullptr};
          gemm_tile((const u16*)a64, lda, (const u16*)b64, ldb, Kuse, pm * 256, pn * 256, smem, e);
        }
      }
    }
    if (ph + 1 < prm.ph_hi) {
      if (ph == prm.ph_lo) grid.sync();
      else { ++nbar; grid_barrier((unsigned*)(prm.ws + WS_BAR), nbar * gridDim.x); }
    }
  }
}

extern "C" void kernel_launch(void* const* d_in, const int* in_sizes, int n_in, void* d_out, int out_size, void* d_ws,
                              size_t ws_size, hipStream_t stream) {
  static int grid_blocks = 0;
  if (grid_blocks == 0) {
    if (n_in != 33 || ws_size < WS_END || (size_t)out_size * 4 < WO_END) {
      fprintf(stderr, "kernel_launch: unexpected sizes n_in=%d ws=%zu (need %zu) out=%d\n", n_in, ws_size, (size_t)WS_END, out_size);
      grid_blocks = -1;
      return;
    }
    int dev = 0, cus = 0, per_cu = 0;
    hipGetDevice(&dev);
    hipDeviceGetAttribute(&cus, hipDeviceAttributeMultiprocessorCount, dev);
    hipOccupancyMaxActiveBlocksPerMultiprocessor(&per_cu, mega, NT, 0);
    if (per_cu < 1) per_cu = 1;
    if (per_cu > 1) per_cu = 1;
    grid_blocks = cus * per_cu;
  }
  if (grid_blocks < 0) return;
  Params p{};
  for (int i = 0; i < 33; ++i) p.in[i] = (const float*)d_in[i];
  p.out = (float*)d_out;
  p.ws = (char*)d_ws;
  p.ph_lo = 0;
  p.ph_hi = NPH;
  (void)hipMemsetAsync((char*)d_ws + WS_BAR, 0, 1024, stream);
  void* args[] = {&p};
  hipError_t e = hipLaunchCooperativeKernel((void*)mega, dim3(grid_blocks), dim3(NT), args, 0, stream);
  if (e != hipSuccess) fprintf(stderr, "cooperative launch failed: %s (grid %d)\n", hipGetErrorString(e), grid_blocks);
}
```

```cpp
#include <hip/hip_runtime.h>
#include <hip/hip_cooperative_groups.h>
#include <cstdio>
namespace cg = cooperative_groups;

typedef unsigned short u16;
using bf16x8 = __attribute__((ext_vector_type(8))) short;
using f32x4 = __attribute__((ext_vector_type(4))) float;
using f32x16 = __attribute__((ext_vector_type(16))) float;

constexpr int D = 1024, SEQ = 8192, CTX = 256, SP = 8448, MROWS = 16896, NMT = 66;
constexpr int DIN = 5792, DINP = 5888, DFF = 4096;
constexpr int OFF_HY = 512, OFF_Q = 2048, OFF_KV = 2432, OFF_GATE = 2720;
constexpr int NT = 512;
constexpr float EPS = 1e-6f;

constexpr size_t WS_H = 0;
constexpr size_t WS_PROJ = WS_H + (size_t)MROWS * D * 4;
constexpr size_t WS_U = WS_PROJ + (size_t)MROWS * DINP * 2;
constexpr size_t WS_Y = WS_U + (size_t)MROWS * 512 * 2;
constexpr size_t WS_O = WS_Y + (size_t)MROWS * 512 * 2;
constexpr size_t WS_Q = WS_O + (size_t)MROWS * 512 * 2;
constexpr size_t WS_K = WS_Q + (size_t)16 * SP * 96 * 2;
constexpr size_t WS_VT = WS_K + (size_t)16 * SP * 96 * 2;
constexpr size_t WS_ZV = WS_VT + (size_t)16 * 64 * SP * 2;
constexpr size_t WS_HID2 = WS_ZV + (size_t)512 * SP * 8;
constexpr size_t WS_HID2C = WS_HID2 + (size_t)4 * 8192 * 64 * 4;
constexpr size_t WS_MOD = WS_HID2C + (size_t)4 * 256 * 64 * 4;
constexpr size_t WS_ROPE = WS_MOD + (size_t)4 * 3 * 6144 * 4;
constexpr size_t WS_TW = WS_ROPE + (size_t)128 * 8 * 8;
constexpr size_t WS_WPE = WS_TW + (size_t)16384 * 8;
constexpr size_t WS_BAR = WS_WPE + (size_t)4 * 1024 * 512 * 2;
constexpr size_t WS_END = WS_BAR + 1024;
constexpr size_t WO_IN = 0;
constexpr size_t WO_FF1 = WO_IN + (size_t)DINP * 1024 * 2;
constexpr size_t WO_FF2 = WO_FF1 + (size_t)4096 * 1024 * 2;
constexpr size_t WO_OUT = WO_FF2 + (size_t)4096 * 1024 * 2;
constexpr size_t WO_HY = WO_OUT + (size_t)1024 * 1024 * 2;
constexpr size_t WO_WO = WO_HY + (size_t)1024 * 512 * 2;
constexpr size_t WO_PE = WO_WO + (size_t)1024 * 512 * 2;
constexpr size_t WO_UQ = WO_PE + (size_t)1024 * 512 * 2;
constexpr size_t WO_UKV = WO_UQ + (size_t)768 * 384 * 2;
constexpr size_t WO_FILT = WO_UKV + (size_t)1024 * 256 * 2;
constexpr size_t WO_END = WO_FILT + (size_t)1024 * 8192 * 2;
constexpr size_t WS_W3T = WS_HID2 + (size_t)4 * 8192 * 64 * 2;

constexpr int AUX_OFF = 147456;
constexpr int LDS_BYTES = AUX_OFF + 8192;

struct Params {
  const float* in[33];
  float* out;
  char* ws;
  int ph_lo, ph_hi;
};

struct Ctx { const unsigned long long* intab; char* ws; float* out; };
__device__ __forceinline__ const float* pin(const Ctx& c, int i) {
  unsigned long long v = c.intab[i];
  unsigned lo = __builtin_amdgcn_readfirstlane((unsigned)v), hi = __builtin_amdgcn_readfirstlane((unsigned)(v >> 32));
  return (const float*)(((unsigned long long)hi << 32) | lo);
}

typedef __bf16 hwbf2 __attribute__((ext_vector_type(2)));
typedef float hwf2 __attribute__((ext_vector_type(2)));
__device__ __forceinline__ unsigned pk2(float a, float b) {
  hwf2 v = {a, b};
  hwbf2 r = __builtin_convertvector(v, hwbf2);
  return __builtin_bit_cast(unsigned, r);
}
__device__ __forceinline__ u16 f2bf(float f) { return (u16)(pk2(f, 0.f) & 0xffffu); }
__device__ __forceinline__ float bf2f(u16 b) { return __uint_as_float(((unsigned)b) << 16); }
__device__ __forceinline__ float shx(float v, int o) {
  int l = __builtin_amdgcn_mbcnt_hi(~0u, __builtin_amdgcn_mbcnt_lo(~0u, 0u));
  asm volatile("" : "+v"(l));
  return __int_as_float(__builtin_amdgcn_ds_bpermute((l ^ o) << 2, __float_as_int(v)));
}
__device__ __forceinline__ float wave_sum(float v) {
#pragma unroll
  for (int o = 1; o < 64; o <<= 1) v += shx(v, o);
  return v;
}
__device__ __forceinline__ int grp_of_row(int m) {
  int tile = m >> 8, b = tile / 33, t33 = tile - b * 33;
  return t33 == 0 ? 2 : b;
}
__device__ __forceinline__ float2 cmul(float2 a, float2 b) { return make_float2(a.x * b.x - a.y * b.y, a.x * b.y + a.y * b.x); }

__device__ __forceinline__ int tid_l() { int t = threadIdx.x; asm volatile("" : "+v"(t)); return t; }
__device__ __forceinline__ void grid_barrier(unsigned* bar, unsigned target) {
  asm volatile("s_waitcnt vmcnt(0)" ::: "memory");
  __syncthreads();
  if (threadIdx.x == 0) {
    __builtin_amdgcn_fence(__ATOMIC_RELEASE, "agent");
    asm volatile("s_waitcnt vmcnt(0)" ::: "memory");
    __hip_atomic_fetch_add(bar, 1u, __ATOMIC_RELAXED, __HIP_MEMORY_SCOPE_AGENT);
    while (__hip_atomic_load(bar, __ATOMIC_RELAXED, __HIP_MEMORY_SCOPE_AGENT) < target) __builtin_amdgcn_s_sleep(2);
    __builtin_amdgcn_fence(__ATOMIC_ACQUIRE, "agent");
    asm volatile("s_waitcnt vmcnt(0)" ::: "memory");
  }
  __syncthreads();
}
#define WAIT_V(n) asm volatile("s_waitcnt vmcnt(%0)" ::"n"(n) : "memory")
#define SCHED() __builtin_amdgcn_sched_barrier(0)
#define RAW_BARRIER() do { asm volatile("s_waitcnt lgkmcnt(0)" ::: "memory"); __builtin_amdgcn_s_barrier(); } while (0)

constexpr float QSCALE = 0.10206207261596575f * 1.4426950408889634f;
enum { EM_PROJ = 0, EM_SQRELU = 1, EM_RESID = 2, EM_RESID_AT = 3, EM_FILT = 4, EM_Q = 6, EM_KV = 7 };
struct Epi {
  int mode;
  char* ws;
  const float* gate;
  const float2* rope_lds;
  u16* filt_out;
  __device__ __forceinline__ void proj(int row, int col, f32x4 v) const {
    {
      u16* out = (u16*)(ws + WS_PROJ);
#pragma unroll
      for (int j = 0; j < 4; ++j) out[(size_t)(row + j) * DINP + col] = f2bf(v[j]);
    }
  }
  __device__ __forceinline__ void sqrelu(int row, int col, f32x4 v) const {
    {
      u16* out = (u16*)(ws + WS_PROJ);
#pragma unroll
      for (int j = 0; j < 4; ++j) { float r = fmaxf(v[j], 0.f); out[(size_t)(row + j) * DFF + col] = f2bf(r * r); }
    }
  }
  __device__ __forceinline__ void resid(int row, int col, f32x4 v) const {
    {
      float* h = (float*)(ws + WS_H);
      float g = gate[grp_of_row(row) * 6144 + col];
#pragma unroll
      for (int j = 0; j < 4; ++j) unsafeAtomicAdd(h + (size_t)(row + j) * D + col, g * v[j]);
    }
  }
  __device__ __forceinline__ void filt(int row, int col, f32x4 v) const {
    uint2 o;
    o.x = pk2(v[0], v[1]);
    o.y = pk2(v[2], v[3]);
    *(uint2*)(filt_out + (size_t)col * 8192 + row) = o;
  }
  __device__ __forceinline__ void q(int row, int col, f32x4 v) const {
    {
      u16* Q = (u16*)(ws + WS_Q);
      const float2* rope = rope_lds;
      int head = col / 96, d = col - head * 96;
      int b = row / SP, pos0 = row - b * SP;
      bool isrope = (d >= 64) && (pos0 >= CTX);
      int rd = d - 64;
#pragma unroll
      for (int j = 0; j < 4; ++j) {
        float val = v[j];
        float partner = shx(val, 8);
        int pos = pos0 + j;
        if (isrope) {
          int t = pos - CTX, idx = (rd < 16) ? (t >> 6) : (t & 63);
          float2 cs = rope[idx * 8 + (rd & 7)];
          float sgn = (rd & 8) ? 1.f : -1.f;
          val = val * cs.x + sgn * partner * cs.y;
        }
        Q[((size_t)(b * 8 + head) * SP + pos) * 96 + d] = f2bf(val * QSCALE);
      }
    }
  }
  __device__ __forceinline__ void kv(int row, int col, f32x4 v) const {
    {
      u16* Kb = (u16*)(ws + WS_K);
      u16* Vt = (u16*)(ws + WS_VT);
      int head = col >> 7, j2 = col & 127;
      int b = row / SP, pos0 = row - b * SP;
      if (j2 < 64) {
#pragma unroll
        for (int j = 0; j < 4; ++j) Kb[((size_t)(b * 8 + head) * SP + pos0 + j) * 96 + j2] = f2bf(v[j]);
      } else {
        uint2 o;
        o.x = pk2(v[0], v[1]);
        o.y = pk2(v[2], v[3]);
        *(uint2*)(Vt + ((size_t)(b * 8 + head) * 64 + (j2 - 64)) * SP + pos0) = o;
      }
    }
  }
};
struct GD { const u16* A; int lda; const u16* Bt; int ldb; int K; int nN; int mode; int ks; };

constexpr int G_TILE_B = 256 * 64 * 2, G_STAGE_B = 2 * G_TILE_B;
__device__ __forceinline__ int lds_byte(int r, int c) {
  int st = (r >> 4) * 2 + (c >> 5), ob = (r & 15) * 64 + (c & 31) * 2;
  return st * 1024 + (ob ^ (((ob >> 9) & 1) << 5));
}
__device__ __forceinline__ void stage_rc(int b, int& R, int& C) {
  int st = b >> 10, sb = b & 1023, swz = sb ^ (((sb >> 9) & 1) << 5);
  R = (st / 2) * 16 + swz / 64;
  C = (st % 2) * 32 + (swz % 64) / 2;
}

template <int MI>
__device__ __forceinline__ void gemm_core(const u16* __restrict__ A, int lda, const u16* __restrict__ Bt, int ldb, int K,
                                          int brow, int bcol, char* shm, f32x4 (&acc)[MI][4]) {
  constexpr int TILE_A = MI * 32 * 64 * 2, TILE_BB = 256 * 64 * 2, STAGE = TILE_A + TILE_BB;
  const int tid = tid_l(), wid = tid >> 6, lane = tid & 63, wr = wid >> 2, wc = wid & 3, fr = lane & 15, fq = lane >> 4;
  const u16* Ab = A + (size_t)brow * lda;
  const u16* Bb = Bt + (size_t)bcol * ldb;
  int sR[4], sC[4];
#pragma unroll
  for (int i = 0; i < 4; ++i) stage_rc(wid * 1024 + i * 8192 + lane * 16, sR[i], sC[i]);
#define SA(b) (shm + (b) * STAGE)
#define SB(b) (shm + (b) * STAGE + TILE_A)
#define GLDS_STAGE(buf, kt)                                                                                              \
  do {                                                                                                                   \
    _Pragma("unroll") for (int i = 0; i < 4; ++i) {                                                                      \
      if (i < MI / 2)                                                                                                    \
        __builtin_amdgcn_global_load_lds((const unsigned*)(Ab + (size_t)sR[i] * lda + (kt) * 64 + sC[i]),                \
                                         (unsigned*)(SA(buf) + wid * 1024 + i * 8192), 16, 0, 0);                        \
      __builtin_amdgcn_global_load_lds((const unsigned*)(Bb + (size_t)sR[i] * ldb + (kt) * 64 + sC[i]),                  \
                                       (unsigned*)(SB(buf) + wid * 1024 + i * 8192), 16, 0, 0);                          \
    }                                                                                                                    \
  } while (0)
  const int nt = K / 64;
  GLDS_STAGE(0, 0);
  WAIT_V(0);
  __syncthreads();
  for (int t = 0; t < nt; ++t) {
    const int cur = t & 1;
    if (t + 1 < nt) GLDS_STAGE(cur ^ 1, t + 1);
#pragma unroll
    for (int ks = 0; ks < 2; ++ks) {
      bf16x8 At[MI], Bf[4];
#pragma unroll
      for (int m = 0; m < MI; ++m) At[m] = *(const bf16x8*)(SA(cur) + lds_byte(wr * (MI * 16) + m * 16 + fr, ks * 32 + fq * 8));
#pragma unroll
      for (int n = 0; n < 4; ++n) Bf[n] = *(const bf16x8*)(SB(cur) + lds_byte(wc * 64 + n * 16 + fr, ks * 32 + fq * 8));
#pragma unroll
      for (int m = 0; m < MI; ++m)
#pragma unroll
        for (int n = 0; n < 4; ++n) acc[m][n] = __builtin_amdgcn_mfma_f32_16x16x32_bf16(At[m], Bf[n], acc[m][n], 0, 0, 0);
      SCHED();
    }
    WAIT_V(0);
    __syncthreads();
  }
#undef SA
#undef SB
#undef GLDS_STAGE
}

template <class EpiT>
__device__ __forceinline__ void gemm_tile(const u16* __restrict__ A, int lda, const u16* __restrict__ Bt, int ldb, int K,
                                          int brow, int bcol, char* shm, const EpiT& epi) {
  const int tid = tid_l(), wid = tid >> 6, lane = tid & 63, wr = wid >> 2, wc = wid & 3, fr = lane & 15, fq = lane >> 4;
  f32x4 acc[8][4];
#pragma unroll
  for (int m = 0; m < 8; ++m)
#pragma unroll
    for (int n = 0; n < 4; ++n) acc[m][n] = (f32x4){0.f, 0.f, 0.f, 0.f};
  gemm_core<8>(A, lda, Bt, ldb, K, brow, bcol, shm, acc);
#define EPI_LOOP(CALL)                                                                              \
  _Pragma("unroll") for (int m = 0; m < 8; ++m) _Pragma("unroll") for (int n = 0; n < 4; ++n) {      \
    const int row = brow + wr * 128 + m * 16 + fq * 4, col = bcol + wc * 64 + n * 16 + fr;           \
    const f32x4 v = acc[m][n];                                                                        \
    CALL;                                                                                             \
  }
  if (epi.mode == EM_PROJ) { EPI_LOOP(epi.proj(row, col, v)) }
  else if (epi.mode == EM_SQRELU) { EPI_LOOP(epi.sqrelu(row, col, v)) }
  else if (epi.mode == EM_RESID_AT) { EPI_LOOP(epi.resid(row, col, v)) }
  else if (epi.mode == EM_RESID) {
    float* h = (float*)(epi.ws + WS_H);
    float g4[4];
#pragma unroll
    for (int n = 0; n < 4; ++n) g4[n] = epi.gate[grp_of_row(brow) * 6144 + bcol + wc * 64 + n * 16 + fr];
    float hv[8][4][4];
    float* hp0 = h + (size_t)(brow + wr * 128 + fq * 4) * D + bcol + wc * 64 + fr;
#define H_LOAD(m) _Pragma("unroll") for (int n = 0; n < 4; ++n) _Pragma("unroll") for (int j = 0; j < 4; ++j) hv[m][n][j] = hp0[(size_t)((m) * 16 + j) * D + n * 16]
#define H_STORE(m) _Pragma("unroll") for (int n = 0; n < 4; ++n) _Pragma("unroll") for (int j = 0; j < 4; ++j) hp0[(size_t)((m) * 16 + j) * D + n * 16] = hv[m][n][j] + g4[n] * acc[m][n][j]
    H_LOAD(0); H_LOAD(1);
    SCHED();
    H_STORE(0); H_LOAD(2); SCHED();
    H_STORE(1); H_LOAD(3); SCHED();
    H_STORE(2); H_LOAD(4); SCHED();
    H_STORE(3); H_LOAD(5); SCHED();
    H_STORE(4); H_LOAD(6); SCHED();
    H_STORE(5); H_LOAD(7); SCHED();
    H_STORE(6); H_STORE(7);
#undef H_LOAD
#undef H_STORE
  }
  else if (epi.mode == EM_FILT) { EPI_LOOP(epi.filt(row, col, v)) }
  else if (epi.mode == EM_Q) { EPI_LOOP(epi.q(row, col, v)) }
  else { EPI_LOOP(epi.kv(row, col, v)) }
#undef EPI_LOOP
}

__device__ __forceinline__ void mix_tile(const Ctx& p, int l, int pm, int pn, char* shm) {
  constexpr int TILE_A = 128 * 64 * 2, TILE_BB = 256 * 64 * 2, STAGE = TILE_A + TILE_BB;
  const int tid = tid_l(), wid = tid >> 6, lane = tid & 63, wr = wid >> 2, wc = wid & 3, fr = lane & 15, fq = lane >> 4;
  const int brow = pm * 128, bcol = pn * 256;
  const u16* projb = (const u16*)(p.ws + WS_PROJ);
  char* wo = (char*)p.out;
#define SA(b) (shm + (b) * STAGE)
#define SB(b) (shm + (b) * STAGE + TILE_A)
#define MIX_STAGE(buf, kt)                                                                                               \
  do {                                                                                                                   \
    const int br_ = (kt) >> 3, ko_ = ((kt) & 7) * 64;                                                                    \
    const u16* Ab_ = (const u16*)(p.ws + (br_ == 0 ? WS_U : br_ == 1 ? WS_Y : WS_O)) + (size_t)brow * 512 + ko_;         \
    const u16* Bb_ = (br_ == 0 ? (const u16*)(p.ws + WS_WPE) + (size_t)l * 1024 * 512 : (const u16*)(wo + (br_ == 1 ? WO_HY : WO_WO))) + (size_t)bcol * 512 + ko_;        \
    _Pragma("unroll") for (int i = 0; i < 4; ++i) {                                                                      \
      int sR_, sC_; stage_rc(wid * 1024 + i * 8192 + lane * 16, sR_, sC_);                                              \
      if (i < 2)                                                                                                         \
        __builtin_amdgcn_global_load_lds((const unsigned*)(Ab_ + sR_ * 512 + sC_),                           \
                                         (unsigned*)(SA(buf) + wid * 1024 + i * 8192), 16, 0, 0);                        \
      __builtin_amdgcn_global_load_lds((const unsigned*)(Bb_ + sR_ * 512 + sC_),                             \
                                       (unsigned*)(SB(buf) + wid * 1024 + i * 8192), 16, 0, 0);                          \
    }                                                                                                                    \
  } while (0)
  f32x4 tot[4][4], acc[4][4];
#pragma unroll
  for (int m = 0; m < 4; ++m)
#pragma unroll
    for (int n = 0; n < 4; ++n) { tot[m][n] = (f32x4){0.f, 0.f, 0.f, 0.f}; acc[m][n] = (f32x4){0.f, 0.f, 0.f, 0.f}; }
  MIX_STAGE(0, 0);
  MIX_STAGE(1, 1);
  WAIT_V(6);
  RAW_BARRIER();
  int cur = 0;
#pragma unroll 1
  for (int br = 0; br < 3; ++br) {
    unsigned gpk[4][4][2];
    const u16* gp = projb + (size_t)(brow + wr * 64 + fq * 4) * DINP + OFF_GATE + br * 1024 + bcol + wc * 64 + fr;
#define GATE_LOAD(m)                                                                                   \
    _Pragma("unroll") for (int n = 0; n < 4; ++n) _Pragma("unroll") for (int j2 = 0; j2 < 2; ++j2) {       \
      unsigned lo = gp[(size_t)((m) * 16 + 2 * j2) * DINP + n * 16], hi = gp[(size_t)((m) * 16 + 2 * j2 + 1) * DINP + n * 16]; \
      gpk[m][n][j2] = lo | (hi << 16);                                                                     \
    }
    GATE_LOAD(0); GATE_LOAD(1); GATE_LOAD(2);
#pragma unroll 1
    for (int kk = 0; kk < 8; ++kk) {
      const int t = br * 8 + kk;
      { int nx = cur + 2; if (nx >= 3) nx -= 3; if (t + 2 < 24) MIX_STAGE(nx, t + 2); }
#pragma unroll
      for (int ks = 0; ks < 2; ++ks) {
        bf16x8 At[2], Bf[4];
#pragma unroll
        for (int n = 0; n < 4; ++n) Bf[n] = *(const bf16x8*)(SB(cur) + lds_byte(wc * 64 + n * 16 + fr, ks * 32 + fq * 8));
#pragma unroll
        for (int mh = 0; mh < 2; ++mh) {
#pragma unroll
          for (int m = 0; m < 2; ++m) At[m] = *(const bf16x8*)(SA(cur) + lds_byte(wr * 64 + (mh * 2 + m) * 16 + fr, ks * 32 + fq * 8));
#pragma unroll
          for (int m = 0; m < 2; ++m)
#pragma unroll
            for (int n = 0; n < 4; ++n) acc[mh * 2 + m][n] = __builtin_amdgcn_mfma_f32_16x16x32_bf16(At[m], Bf[n], acc[mh * 2 + m][n], 0, 0, 0);
          SCHED();
        }
      }
      if (t + 2 < 24) WAIT_V(6); else WAIT_V(0);
      RAW_BARRIER();
      cur = (cur == 2) ? 0 : cur + 1;
    }
    GATE_LOAD(3);
#undef GATE_LOAD
#pragma unroll
    for (int m = 0; m < 4; ++m)
#pragma unroll
      for (int n = 0; n < 4; ++n)
#pragma unroll
        for (int j = 0; j < 4; ++j) {
          const unsigned w = gpk[m][n][j >> 1];
          const float gv = __uint_as_float((j & 1) ? (w & 0xffff0000u) : (w << 16));
          tot[m][n][j] += acc[m][n][j] / (1.f + __expf(-gv));
          acc[m][n][j] = 0.f;
        }
  }
  u16* mixb = (u16*)(p.ws + WS_ZV);
#pragma unroll
  for (int m = 0; m < 4; ++m)
#pragma unroll
    for (int n = 0; n < 4; ++n)
#pragma unroll
      for (int j = 0; j < 4; ++j)
        mixb[(size_t)(brow + wr * 64 + m * 16 + fq * 4 + j) * D + bcol + wc * 64 + n * 16 + fr] = f2bf(tot[m][n][j]);
#undef SA
#undef SB
#undef MIX_STAGE
}

__device__ __forceinline__ void tile_map(int t, int nM, int nN, int& pm, int& pn) {
  int nwg = nM * nN, wgid = t;
  {
    int q = nwg / 8, r = nwg % 8, xcd = wgid % 8, off = wgid / 8;
    wgid = (xcd < r ? xcd * (q + 1) : r * (q + 1) + (xcd - r) * q) + off;
  }
  int nig = 8 * nN, gid = wgid / nig, fm = gid * 8, gsz = min(nM - fm, 8);
  pm = fm + ((wgid % nig) % gsz);
  pn = (wgid % nig) / gsz;
}

__device__ __forceinline__ void p0_misc(const Ctx& p) {
  const int gtid = blockIdx.x * NT + tid_l(), gn = gridDim.x * NT;
  float4* h4 = (float4*)(p.ws + WS_H);
  const float4* x4 = (const float4*)pin(p, 0);
  const float4* c4 = (const float4*)pin(p, 2);
  for (int i = gtid; i < MROWS * 256; i += gn) {
    int m = i >> 8, q = i & 255, b = m / SP, pos = m - b * SP;
    float4 v = (pos < CTX) ? c4[(size_t)(b * CTX + pos) * 256 + q] : x4[(size_t)(b * SEQ + pos - CTX) * 256 + q];
    h4[i] = v;
  }
  float2* rope = (float2*)(p.ws + WS_ROPE);
  for (int i = gtid; i < 1024; i += gn) {
    int idx = i >> 3, f = i & 7;
    float inv = powf(10000.f, -(float)f / 8.f);
    float a = (float)idx * inv;
    rope[i] = make_float2(cosf(a), sinf(a));
  }
  {
    u16* w3t = (u16*)(p.ws + WS_W3T);
    const float* w3 = pin(p, 20);
    for (int i = gtid; i < 4 * 1024 * 64; i += gn) { int l = i >> 16, c2 = (i >> 6) & 1023, k = i & 63; w3t[i] = f2bf(w3[((size_t)l * 64 + k) * 1024 + c2]); }
  }
  float2* tw = (float2*)(p.ws + WS_TW);
  for (int i = gtid; i < 16384; i += gn) {
    float s, c;
    sincospif(-(float)i / 8192.f, &s, &c);
    tw[i] = make_float2(c, s);
  }
}

__device__ __forceinline__ void p0_mod_task(const Ctx& p, int task, char* smem) {
  float* s = (float*)smem;
  float* red = s + 3072;
  const int tid = tid_l();
  const int l = task / 48, chunk = task - l * 48;
  for (int i = tid; i < 3072; i += NT) {
    int g = i >> 10, k = i & 1023;
    float cv = (g < 2) ? pin(p, 1)[g * 1024 + k] : pin(p, 3)[k];
    s[i] = cv / (1.f + __expf(-cv));
  }
  __syncthreads();
  const int kq = tid >> 7, col = tid & 127, n = chunk * 128 + col;
  const float* W = pin(p, 4) + (size_t)l * 1024 * 6144 + n;
  float a0 = 0.f, a1 = 0.f, a2 = 0.f;
#pragma unroll 32
  for (int k = kq * 256; k < kq * 256 + 256; ++k) {
    float w = W[(size_t)k * 6144];
    a0 += s[k] * w; a1 += s[1024 + k] * w; a2 += s[2048 + k] * w;
  }
  red[(kq * 3 + 0) * 128 + col] = a0;
  red[(kq * 3 + 1) * 128 + col] = a1;
  red[(kq * 3 + 2) * 128 + col] = a2;
  __syncthreads();
  if (tid < 384) {
    int g = tid >> 7, c2 = tid & 127, n2 = chunk * 128 + c2;
    float v = red[(0 * 3 + g) * 128 + c2] + red[(1 * 3 + g) * 128 + c2] + red[(2 * 3 + g) * 128 + c2] + red[(3 * 3 + g) * 128 + c2];
    ((float*)(p.ws + WS_MOD))[(size_t)(l * 3 + g) * 6144 + n2] = v + pin(p, 5)[l * 6144 + n2];
  }
  __syncthreads();
}

__device__ __forceinline__ void p0_hid_task(const Ctx& p, int task, char* smem) {
  float* zs = (float*)smem;
  float* h1 = zs + 8 * 36;
  float* w1s = h1 + 8 * 64;
  float* w2s = w1s + 33 * 64;
  const int tid = tid_l(), tl = tid >> 6, j = tid & 63;
  const int l = task / 132, r = task - l * 132;
  const bool isctx = r >= 128;
  const int L = isctx ? 256 : 8192;
  const int tbase = (isctx ? (r - 128) : r) * 64;
  for (int i = tid; i < 33 * 64; i += NT) w1s[i] = pin(p, 14)[l * 33 * 64 + i];
  for (int i = tid; i < 64 * 64; i += NT) w2s[i] = pin(p, 17)[l * 64 * 64 + i];
  const float b1 = pin(p, 15)[l * 64 + j], f1 = pin(p, 16)[l * 64 + j], b2 = pin(p, 18)[l * 64 + j], f2 = pin(p, 19)[l * 64 + j];
  __syncthreads();
  for (int sub = 0; sub < 8; ++sub) {
    const int t = tbase + sub * 8 + tl;
    if (j < 33) {
      float z;
      if (j == 0) z = (float)t / (float)(L - 1);
      else {
        int i = (j - 1) & 15;
        float band = 1e-4f + (float)i * ((15.f - 1e-4f) / 15.f);
        float omega = 6.2831855f * (float)t / (float)L;
        float a = omega * band;
        z = (j <= 16) ? cosf(a) : -sinf(a);
      }
      zs[tl * 36 + j] = z;
    }
    __syncthreads();
    {
      float a = b1;
#pragma unroll
      for (int k = 0; k < 33; ++k) a += zs[tl * 36 + k] * w1s[k * 64 + j];
      h1[tl * 64 + j] = sinf(f1 * a);
    }
    __syncthreads();
    {
      float a = b2;
#pragma unroll 16
      for (int k = 0; k < 64; ++k) a += h1[tl * 64 + k] * w2s[k * 64 + j];
      float v = sinf(f2 * a);
      if (isctx) ((float*)(p.ws + WS_HID2C))[((size_t)l * 64 + j) * 256 + t] = v;
      else ((u16*)(p.ws + WS_HID2))[((size_t)l * 8192 + t) * 64 + j] = f2bf(v);
    }
  }
  __syncthreads();
}

struct WtItem { const float* W; u16* WT; int K, N, k0, n0; };
__device__ __forceinline__ WtItem wt_decode(const Ctx& p, int l, int r) {
  char* wo = (char*)p.out;
  WtItem it;
  int nblk;
  if (r < 1472) { it.W = pin(p, 8) + (size_t)l * 1024 * DIN; it.K = 1024; it.N = DIN; it.WT = (u16*)(wo + WO_IN); nblk = 92; }
  else if ((r -= 1472) < 1024) { it.W = pin(p, 30) + (size_t)l * 1024 * 4096; it.K = 1024; it.N = 4096; it.WT = (u16*)(wo + WO_FF1); nblk = 64; }
  else if ((r -= 1024) < 1024) { it.W = pin(p, 31) + (size_t)l * 4096 * 1024; it.K = 4096; it.N = 1024; it.WT = (u16*)(wo + WO_FF2); nblk = 16; }
  else if ((r -= 1024) < 256) { it.W = pin(p, 29) + (size_t)l * 1024 * 1024; it.K = 1024; it.N = 1024; it.WT = (u16*)(wo + WO_OUT); nblk = 16; }
  else if ((r -= 256) < 128) { it.W = pin(p, 23) + (size_t)l * 512 * 1024; it.K = 512; it.N = 1024; it.WT = (u16*)(wo + WO_HY); nblk = 16; }
  else if ((r -= 128) < 128) { it.W = pin(p, 28) + (size_t)l * 512 * 1024; it.K = 512; it.N = 1024; it.WT = (u16*)(wo + WO_WO); nblk = 16; }
  else if ((r -= 128) < 72) { it.W = pin(p, 25) + (size_t)l * 384 * 768; it.K = 384; it.N = 768; it.WT = (u16*)(wo + WO_UQ); nblk = 12; }
  else { r -= 72; it.W = pin(p, 27) + (size_t)l * 256 * 1024; it.K = 256; it.N = 1024; it.WT = (u16*)(wo + WO_UKV); nblk = 16; }
  const int kb = r / nblk, nb2 = r - kb * nblk;
  it.k0 = kb * 64; it.n0 = nb2 * 64;
  return it;
}
__device__ __forceinline__ void wt_load(const WtItem& it, int tid, float (&v)[8]) {
  const int nn = tid & 63, kq = tid >> 6;
  const bool ok = it.n0 + nn < it.N;
  const float* src = it.W + (size_t)(it.k0 + kq) * it.N + it.n0 + (ok ? nn : 0);
#pragma unroll
  for (int r = 0; r < 8; ++r) { float x = src[(size_t)(r * 8) * it.N]; v[r] = ok ? x : 0.f; }
}
__device__ __forceinline__ void wt_phase(const Ctx& p, int l, char* smem) {
  float* tile = (float*)smem;
  const int tid = tid_l();
  const int bid = blockIdx.x, nb = gridDim.x;
  int t = bid;
  if (t >= 4168) return;
  WtItem cur = wt_decode(p, l, t);
  float v[8];
  wt_load(cur, tid, v);
#pragma unroll 1
  while (true) {
    const int tn = t + nb;
    const bool more = tn < 4168;
    WtItem nxt = cur;
    float vn[8];
    if (more) { nxt = wt_decode(p, l, tn); wt_load(nxt, tid, vn); }
#pragma unroll
    for (int r = 0; r < 8; ++r) tile[(r * 8 + (tid >> 6)) * 65 + (tid & 63)] = v[r];
    __syncthreads();
    {
      int n = tid >> 3, kc = (tid & 7) * 8;
      uint4 o;
      o.x = pk2(tile[(kc + 0) * 65 + n], tile[(kc + 1) * 65 + n]);
      o.y = pk2(tile[(kc + 2) * 65 + n], tile[(kc + 3) * 65 + n]);
      o.z = pk2(tile[(kc + 4) * 65 + n], tile[(kc + 5) * 65 + n]);
      o.w = pk2(tile[(kc + 6) * 65 + n], tile[(kc + 7) * 65 + n]);
      *(uint4*)(cur.WT + (size_t)(cur.n0 + n) * cur.K + cur.k0 + kc) = o;
    }
    __syncthreads();
    if (!more) break;
    cur = nxt;
#pragma unroll
    for (int r = 0; r < 8; ++r) v[r] = vn[r];
    t = tn;
  }
}

__device__ __forceinline__ void wpe_task(const Ctx& p, int l, int task, char* smem) {
  const int g = task >> 3, c0 = (task & 7) * 16, tid = tid_l();
  const float* pw = pin(p, 9) + ((size_t)(l * 4 + g) * 128) * 128;
  const float* sc = pin(p, 10) + l * 512 + g * 128;
  const float* po = pin(p, 11) + ((size_t)l * 512 + g * 128) * 1024;
  u16* WpeT = (u16*)(p.ws + WS_WPE) + (size_t)l * 1024 * 512;
  float* wl = (float*)smem;
  for (int i = tid; i < 16 * 128; i += NT) { int d = i & 127; wl[i] = pw[(c0 + (i >> 7)) * 128 + d] * sc[d]; }
  __syncthreads();
  float acc0[16], acc1[16];
#pragma unroll
  for (int i = 0; i < 16; ++i) { acc0[i] = 0.f; acc1[i] = 0.f; }
#pragma unroll 16
  for (int d = 0; d < 128; ++d) {
    float p0 = po[(size_t)d * 1024 + tid], p1 = po[(size_t)d * 1024 + 512 + tid];
#pragma unroll
    for (int i = 0; i < 16; ++i) { float w = wl[i * 128 + d]; acc0[i] += w * p0; acc1[i] += w * p1; }
  }
  uint4 o0, o1;
  o0.x = pk2(acc0[0], acc0[1]); o0.y = pk2(acc0[2], acc0[3]); o0.z = pk2(acc0[4], acc0[5]); o0.w = pk2(acc0[6], acc0[7]);
  o1.x = pk2(acc0[8], acc0[9]); o1.y = pk2(acc0[10], acc0[11]); o1.z = pk2(acc0[12], acc0[13]); o1.w = pk2(acc0[14], acc0[15]);
  uint4* dst = (uint4*)(WpeT + (size_t)tid * 512 + g * 128 + c0);
  dst[0] = o0; dst[1] = o1;
  o0.x = pk2(acc1[0], acc1[1]); o0.y = pk2(acc1[2], acc1[3]); o0.z = pk2(acc1[4], acc1[5]); o0.w = pk2(acc1[6], acc1[7]);
  o1.x = pk2(acc1[8], acc1[9]); o1.y = pk2(acc1[10], acc1[11]); o1.z = pk2(acc1[12], acc1[13]); o1.w = pk2(acc1[14], acc1[15]);
  dst = (uint4*)(WpeT + (size_t)(512 + tid) * 512 + g * 128 + c0);
  dst[0] = o0; dst[1] = o1;
  __syncthreads();
}

__device__ __forceinline__ void norm_rows(const Ctx& p, const float* gain, const float* modl, int sh_idx, int sc_idx, u16* outp) {
  const int tidx = tid_l(), lane = tidx & 63, gw = blockIdx.x * 8 + (tidx >> 6), ngw = gridDim.x * 8;
  const float* h = (const float*)(p.ws + WS_H);
  float4 g[4];
#pragma unroll
  for (int j = 0; j < 4; ++j) g[j] = *(const float4*)(gain + lane * 4 + 256 * j);
  for (int m0 = gw; m0 < MROWS; m0 += 2 * ngw) {
    const int m1 = m0 + ngw;
    const bool has1 = m1 < MROWS;
    const int m1c = has1 ? m1 : m0;
    const float4* hr0 = (const float4*)(h + (size_t)m0 * D) + lane;
    const float4* hr1 = (const float4*)(h + (size_t)m1c * D) + lane;
    float4 v0[4], v1[4];
#pragma unroll
    for (int j = 0; j < 4; ++j) { v0[j] = hr0[64 * j]; v1[j] = hr1[64 * j]; }
    const float* mg0 = modl + grp_of_row(m0) * 6144;
    const float* mg1 = modl + grp_of_row(m1c) * 6144;
    float s0 = 0.f, s1 = 0.f;
#pragma unroll
    for (int j = 0; j < 4; ++j) {
      s0 += v0[j].x * v0[j].x + v0[j].y * v0[j].y + v0[j].z * v0[j].z + v0[j].w * v0[j].w;
      s1 += v1[j].x * v1[j].x + v1[j].y * v1[j].y + v1[j].z * v1[j].z + v1[j].w * v1[j].w;
    }
    s0 = wave_sum(s0);
    s1 = wave_sum(s1);
    const float r0 = rsqrtf(s0 * (1.f / D) + EPS), r1 = rsqrtf(s1 * (1.f / D) + EPS);
    uint2* o0 = (uint2*)(outp + (size_t)m0 * D) + lane;
    uint2* o1 = (uint2*)(outp + (size_t)m1c * D) + lane;
#pragma unroll
    for (int j = 0; j < 4; ++j) {
      int n = lane * 4 + 256 * j;
      float4 sc = *(const float4*)(mg0 + sc_idx * 1024 + n), sh = *(const float4*)(mg0 + sh_idx * 1024 + n);
      uint2 o;
      o.x = pk2(v0[j].x * r0 * g[j].x * (1.f + sc.x) + sh.x, v0[j].y * r0 * g[j].y * (1.f + sc.y) + sh.y);
      o.y = pk2(v0[j].z * r0 * g[j].z * (1.f + sc.z) + sh.z, v0[j].w * r0 * g[j].w * (1.f + sc.w) + sh.w);
      o0[64 * j] = o;
    }
    if (has1) {
#pragma unroll
      for (int j = 0; j < 4; ++j) {
        int n = lane * 4 + 256 * j;
        float4 sc = *(const float4*)(mg1 + sc_idx * 1024 + n), sh = *(const float4*)(mg1 + sh_idx * 1024 + n);
        uint2 o;
        o.x = pk2(v1[j].x * r1 * g[j].x * (1.f + sc.x) + sh.x, v1[j].y * r1 * g[j].y * (1.f + sc.y) + sh.y);
        o.y = pk2(v1[j].z * r1 * g[j].z * (1.f + sc.z) + sh.z, v1[j].w * r1 * g[j].w * (1.f + sc.w) + sh.w);
        o1[64 * j] = o;
      }
    }
  }
}

__device__ __forceinline__ void final_norm(const Ctx& p) {
  const int tidx = tid_l(), lane = tidx & 63, gw = blockIdx.x * 8 + (tidx >> 6), ngw = gridDim.x * 8;
  const float* h = (const float*)(p.ws + WS_H);
  const float* gain = pin(p, 32);
  for (int r0 = gw; r0 < 2 * SEQ; r0 += ngw) {
    int b = r0 >> 13, t = r0 & 8191, m = b * SP + CTX + t;
    const float4* hr = (const float4*)(h + (size_t)m * D) + lane;
    float4 v[4];
    float ss = 0.f;
#pragma unroll
    for (int j = 0; j < 4; ++j) { v[j] = hr[64 * j]; ss += v[j].x * v[j].x + v[j].y * v[j].y + v[j].z * v[j].z + v[j].w * v[j].w; }
    ss = wave_sum(ss);
    float r = rsqrtf(ss * (1.f / D) + EPS);
    float4* o = (float4*)(p.out + (size_t)r0 * D) + lane;
#pragma unroll
    for (int j = 0; j < 4; ++j) {
      float4 g = *(const float4*)(gain + lane * 4 + 256 * j);
      o[64 * j] = make_float4(v[j].x * r * g.x, v[j].y * r * g.y, v[j].z * r * g.z, v[j].w * r * g.w);
    }
  }
}

__device__ __forceinline__ void premix_task(const Ctx& p, int l, int task, char* smem) {
  const int tid = tid_l(), lane = tid & 63, wid = tid >> 6;
  const int part = task / 264, tile64 = task - part * 264;
  const int m0 = tile64 * 64, b = m0 / SP, pos0 = m0 - b * SP;
  const bool isctx = pos0 < CTX;
  const int s0 = isctx ? 0 : CTX, L = isctx ? CTX : SEQ, t0 = pos0 - s0;
  const size_t mb = (size_t)b * SP + s0;
  const u16* proj = (const u16*)(p.ws + WS_PROJ);
  if (part == 0) {
    u16* P = (u16*)smem;
#pragma unroll
    for (int i = tid; i < 80 * 64; i += NT) {
      int r = i >> 6, ch = i & 63, t = t0 - 8 + r;
      uint4 v = make_uint4(0, 0, 0, 0);
      if (t >= 0 && t < L) v = *(const uint4*)(proj + (mb + t) * DINP + ch * 8);
      *(uint4*)(P + r * 512 + ch * 8) = v;
    }
    __syncthreads();
    const int c = tid, g = c >> 7, hw = 1 << g;
    u16* U = (u16*)(p.ws + WS_U);
    float s = 0.f;
    for (int q = -hw; q < hw; ++q) s += bf2f(P[(8 + q) * 512 + c]);
#pragma unroll 4
    for (int tt = 0; tt < 64; ++tt) {
      int t = t0 + tt, lo = max(t - hw, 0), hi = min(t + hw, L);
      float u = s / (float)(hi - lo) - bf2f(P[(tt + 8) * 512 + c]);
      U[(mb + t) * 512 + c] = f2bf(u);
      s += bf2f(P[(tt + 8 + hw) * 512 + c]) - bf2f(P[(tt + 8 - hw) * 512 + c]);
    }
    __syncthreads();
  } else if (part <= 4) {
    const int ch0 = (part - 1) * 128;
    constexpr int PITCH = 136;
    u16* X = (u16*)smem;
    float* T = (float*)(smem + 3 * 66 * PITCH * 2 + 64);
#pragma unroll
    for (int ii = 0; ii < 7; ++ii) {
      const int i = tid + ii * NT;
      if (i >= 3 * 66 * 16) break;
      int pr = i / (66 * 16), rem = i - pr * 66 * 16, r = rem >> 4, ch = rem & 15, t = t0 - 1 + r;
      uint4 v = make_uint4(0, 0, 0, 0);
      if (t >= 0 && t < L) v = *(const uint4*)(proj + (mb + t) * DINP + OFF_HY + pr * 512 + ch0 + ch * 8);
      *(uint4*)(X + (pr * 66 + r) * PITCH + ch * 8) = v;
    }
    __syncthreads();
    const float* cw = pin(p, 12) + l * 3 * 1536;
    const float* cb = pin(p, 13) + l * 1536;
    {
      const int c = tid & 127, tq = tid >> 7, col = ch0 + c;
      const float w00 = cw[col], w01 = cw[1536 + col], w02 = cw[3072 + col], b0 = cb[col];
      const float w10 = cw[512 + col], w11 = cw[1536 + 512 + col], w12 = cw[3072 + 512 + col], b1 = cb[512 + col];
      const float w20 = cw[1024 + col], w21 = cw[1536 + 1024 + col], w22 = cw[3072 + 1024 + col], b2 = cb[1024 + col];
      const u16* X0 = X, *X1 = X + 66 * PITCH, *XV = X + 2 * 66 * PITCH;
      u16* Y = (u16*)(p.ws + WS_Y);
#pragma unroll 4
      for (int tt = tq * 16; tt < tq * 16 + 16; ++tt) {
        float x0 = w00 * bf2f(X0[tt * PITCH + c]) + w01 * bf2f(X0[(tt + 1) * PITCH + c]) + w02 * bf2f(X0[(tt + 2) * PITCH + c]) + b0;
        float x1 = w10 * bf2f(X1[tt * PITCH + c]) + w11 * bf2f(X1[(tt + 1) * PITCH + c]) + w12 * bf2f(X1[(tt + 2) * PITCH + c]) + b1;
        float vv = w20 * bf2f(XV[tt * PITCH + c]) + w21 * bf2f(XV[(tt + 1) * PITCH + c]) + w22 * bf2f(XV[(tt + 2) * PITCH + c]) + b2;
        Y[(mb + t0 + tt) * 512 + col] = f2bf(x0);
        T[c * 65 + tt] = x1 * vv;
      }
    }
    __syncthreads();
    {
      float* ZV = (float*)(p.ws + WS_ZV);
#pragma unroll 4
      for (int cc = 0; cc < 16; ++cc) {
        int c = wid * 16 + cc;
        ZV[((size_t)(ch0 + c) * SP + pos0 + lane) * 2 + b] = T[c * 65 + lane];
      }
    }
    __syncthreads();
  } else {
    u16* projw = (u16*)(p.ws + WS_PROJ);
    const float* qg = pin(p, 24) + l * 384;
    const float* kg = pin(p, 26) + l * 256;
    const float2* rope = (const float2*)(p.ws + WS_ROPE);
    u16* Kb = (u16*)(p.ws + WS_K);
#pragma unroll 2
    for (int rr = 0; rr < 8; ++rr) {
      int tt = wid * 8 + rr, pos = pos0 + tt;
      u16* row = projw + ((size_t)b * SP + pos) * DINP;
      unsigned* q32 = (unsigned*)(row + OFF_Q);
      unsigned* k32 = (unsigned*)(row + OFF_KV);
      unsigned v[3], w[2];
      float ss = 0.f, s2 = 0.f;
#pragma unroll
      for (int j = 0; j < 3; ++j) v[j] = q32[lane + 64 * j];
#pragma unroll
      for (int j = 0; j < 2; ++j) w[j] = k32[lane + 64 * j];
      const int rd = lane & 31;
      float val = bf2f(row[OFF_KV + 256 + rd]);
#pragma unroll
      for (int j = 0; j < 3; ++j) { float a = bf2f(v[j] & 0xffff), c2 = bf2f(v[j] >> 16); ss += a * a + c2 * c2; }
#pragma unroll
      for (int j = 0; j < 2; ++j) { float a = bf2f(w[j] & 0xffff), c2 = bf2f(w[j] >> 16); s2 += a * a + c2 * c2; }
      ss = wave_sum(ss);
      s2 = wave_sum(s2);
      float r = rsqrtf(ss * (1.f / 384.f) + EPS), r2 = rsqrtf(s2 * (1.f / 256.f) + EPS);
#pragma unroll
      for (int j = 0; j < 3; ++j) {
        int n = (lane + 64 * j) * 2;
        q32[lane + 64 * j] = pk2(bf2f(v[j] & 0xffff) * r * qg[n], bf2f(v[j] >> 16) * r * qg[n + 1]);
      }
#pragma unroll
      for (int j = 0; j < 2; ++j) {
        int n = (lane + 64 * j) * 2;
        k32[lane + 64 * j] = pk2(bf2f(w[j] & 0xffff) * r2 * kg[n], bf2f(w[j] >> 16) * r2 * kg[n + 1]);
      }
      float partner = shx(val, 8);
      if (!isctx) {
        int t = pos - CTX, idx = (rd < 16) ? (t >> 6) : (t & 63);
        float2 cs = rope[idx * 8 + (rd & 7)];
        float sgn = (rd & 8) ? 1.f : -1.f;
        val = val * cs.x + sgn * partner * cs.y;
      }
      if (lane < 32) {
        u16 o = f2bf(val);
#pragma unroll
        for (int hd = 0; hd < 8; ++hd) Kb[((size_t)(b * 8 + hd) * SP + pos) * 96 + 64 + rd] = o;
      }
    }
  }
}

__device__ __forceinline__ int xi(int i) { const int h = i >> 5; return i ^ (((h & 3) * 5) | ((h & 2) << 3)); }
__device__ __forceinline__ void bf_fwd(float2* X, int base, int q, float2 w1) {
  float2 w2 = cmul(w1, w1), w3 = cmul(w2, w1);
  const int i0 = xi(base), i1 = xi(base + q), i2 = xi(base + 2 * q), i3 = xi(base + 3 * q);
  float2 a0 = X[i0], a1 = X[i1], a2 = X[i2], a3 = X[i3];
  float2 s02 = make_float2(a0.x + a2.x, a0.y + a2.y), d02 = make_float2(a0.x - a2.x, a0.y - a2.y);
  float2 s13 = make_float2(a1.x + a3.x, a1.y + a3.y), d13 = make_float2(a1.x - a3.x, a1.y - a3.y);
  X[i0] = make_float2(s02.x + s13.x, s02.y + s13.y);
  X[i1] = cmul(make_float2(d02.x + d13.y, d02.y - d13.x), w1);
  X[i2] = cmul(make_float2(s02.x - s13.x, s02.y - s13.y), w2);
  X[i3] = cmul(make_float2(d02.x - d13.y, d02.y + d13.x), w3);
}
__device__ __forceinline__ void bf_inv(float2* X, int base, int q, float2 w1) {
  w1.y = -w1.y;
  float2 w2 = cmul(w1, w1), w3 = cmul(w2, w1);
  const int i0 = xi(base), i1 = xi(base + q), i2 = xi(base + 2 * q), i3 = xi(base + 3 * q);
  float2 b0 = X[i0], c1 = cmul(X[i1], w1), c2 = cmul(X[i2], w2), c3 = cmul(X[i3], w3);
  float2 s02 = make_float2(b0.x + c2.x, b0.y + c2.y), d02 = make_float2(b0.x - c2.x, b0.y - c2.y);
  float2 s13 = make_float2(c1.x + c3.x, c1.y + c3.y), d13 = make_float2(c1.x - c3.x, c1.y - c3.y);
  X[i0] = make_float2(s02.x + s13.x, s02.y + s13.y);
  X[i1] = make_float2(d02.x - d13.y, d02.y + d13.x);
  X[i2] = make_float2(s02.x - s13.x, s02.y - s13.y);
  X[i3] = make_float2(d02.x + d13.y, d02.y - d13.x);
}
template <bool INV, int LQ>
__device__ __forceinline__ void fft_pass(float2* X, const float2* __restrict__ tw, const float2 (&twr)[6], int tid) {
  constexpr int q = 1 << LQ;
  if (LQ == 12) {
    float2 w[8];
#pragma unroll
    for (int b8 = 0; b8 < 8; ++b8) w[b8] = tw[b8 * NT + tid];
#pragma unroll
    for (int b8 = 0; b8 < 8; ++b8) { int u = b8 * NT + tid; if (INV) bf_inv(X, u, q, w[b8]); else bf_fwd(X, u, q, w[b8]); }
  } else if (LQ == 10) {
#pragma unroll 2
    for (int b8 = 0; b8 < 8; ++b8) {
      int u = b8 * NT + tid, j = u & 1023, base = ((u >> 10) << 12) + j;
      float2 w = (b8 & 1) ? twr[1] : twr[0];
      if (INV) bf_inv(X, base, q, w); else bf_fwd(X, base, q, w);
    }
  } else {
    const int j = tid & (q - 1);
    const float2 w = (LQ == 0) ? make_float2(1.f, 0.f) : twr[2 + (8 - LQ) / 2];
#pragma unroll 2
    for (int b8 = 0; b8 < 8; ++b8) {
      int u = b8 * NT + tid, base = ((u >> LQ) << (LQ + 2)) + j;
      if (INV) bf_inv(X, base, q, w); else bf_fwd(X, base, q, w);
    }
  }
  __syncthreads();
}
__device__ __forceinline__ void fft_load_tw(const float2* __restrict__ tw, int tid, float2 (&twr)[6]) {
  twr[0] = tw[tid << 2];
  twr[1] = tw[(512 + tid) << 2];
  twr[2] = tw[(tid & 255) << 4];
  twr[3] = tw[(tid & 63) << 6];
  twr[4] = tw[(tid & 15) << 8];
  twr[5] = tw[(tid & 3) << 10];
}
__device__ __forceinline__ void fft_dif(float2* X, const float2* __restrict__ tw, const float2 (&twr)[6]) {
  const int tid = tid_l();
  fft_pass<false, 12>(X, tw, twr, tid); fft_pass<false, 10>(X, tw, twr, tid); fft_pass<false, 8>(X, tw, twr, tid); fft_pass<false, 6>(X, tw, twr, tid);
  fft_pass<false, 4>(X, tw, twr, tid); fft_pass<false, 2>(X, tw, twr, tid); fft_pass<false, 0>(X, tw, twr, tid);
}
__device__ __forceinline__ void fft_dit_inv(float2* X, const float2* __restrict__ tw, const float2 (&twr)[6]) {
  const int tid = tid_l();
  fft_pass<true, 0>(X, tw, twr, tid); fft_pass<true, 2>(X, tw, twr, tid); fft_pass<true, 4>(X, tw, twr, tid); fft_pass<true, 6>(X, tw, twr, tid);
  fft_pass<true, 8>(X, tw, twr, tid); fft_pass<true, 10>(X, tw, twr, tid); fft_pass<true, 12>(X, tw, twr, tid);
}
__device__ __forceinline__ float block_sum(float v, float* red) {
  v = wave_sum(v);
  __syncthreads();
  { const int tb = tid_l(); if ((tb & 63) == 0) red[tb >> 6] = v; }
  __syncthreads();
  float s = red[0] + red[1] + red[2] + red[3] + red[4] + red[5] + red[6] + red[7];
  __syncthreads();
  return s;
}

__device__ __forceinline__ void fft_task(const Ctx& p, int l, int c, char* smem) {
  float2* X = (float2*)smem;
  float* aux = (float*)(smem + AUX_OFF);
  float* red = aux + 128;
  const int tid = tid_l();
  const float2* tw = (const float2*)(p.ws + WS_TW);
  float2 twr[6];
  fft_load_tw(tw, tid, twr);
  const float* w3 = pin(p, 20) + (size_t)l * 64 * 1024;
  if (tid < 64) { aux[tid] = w3[tid * 1024 + c]; aux[64 + tid] = w3[tid * 1024 + 512 + c]; }
  __syncthreads();
  const float dF = fabsf(pin(p, 21)[(l * 2 + 0) * 512 + c]), dB = fabsf(pin(p, 21)[(l * 2 + 1) * 512 + c]);
  const float bias = pin(p, 22)[l * 512 + c];
  float2* zp = (float2*)(p.ws + WS_ZV) + (size_t)c * SP;
  float l1 = 0.f;
  {
    const u16* ff = (const u16*)((const char*)p.out + WO_FILT) + (size_t)c * 8192 + tid;
    const u16* fb = ff + (size_t)512 * 8192;
    u16 rf[16], rb[16];
#pragma unroll
    for (int i = 0; i < 16; ++i) { rf[i] = ff[i * NT]; rb[i] = fb[i * NT]; }
#pragma unroll
    for (int i = 0; i < 16; ++i) {
      int t = i * NT + tid;
      float tl = (float)t * (1.f / 8191.f);
      float hf = bf2f(rf[i]) * expf(-tl * dF);
      float hb = bf2f(rb[i]) * expf(-tl * dB);
      X[xi(t)] = make_float2(hf, 0.f);
      if (t >= 1) { X[xi(16384 - t)] = make_float2(hb, 0.f); l1 += fabsf(hf) + fabsf(hb); }
      else { X[xi(8192)] = make_float2(0.f, 0.f); l1 += fabsf(hf); }
    }
  }
  float l1tot = block_sum(l1, red);
  fft_dif(X, tw, twr);
  float2 F[32];
  {
    float s = 1.f / (l1tot * 16384.f);
#pragma unroll
    for (int i = 0; i < 32; ++i) { float2 v = X[xi(i * NT + tid)]; F[i] = make_float2(v.x * s, v.y * s); }
  }
  __syncthreads();
#pragma unroll 8
  for (int i = 0; i < 16; ++i) {
    int t = i * NT + tid;
    X[xi(t)] = zp[CTX + t];
    X[xi(8192 + t)] = make_float2(0.f, 0.f);
  }
  __syncthreads();
  fft_dif(X, tw, twr);
#pragma unroll
  for (int i = 0; i < 32; ++i) { int idx = xi(i * NT + tid); X[idx] = cmul(X[idx], F[i]); }
  __syncthreads();
  fft_dit_inv(X, tw, twr);
  {
    float2 zz[16];
#pragma unroll
    for (int i = 0; i < 16; ++i) zz[i] = zp[CTX + i * NT + tid];
#pragma unroll
    for (int i = 0; i < 16; ++i) {
      int t = i * NT + tid;
      float2 y = X[xi(t)];
      zp[CTX + t] = make_float2(y.x + bias * zz[i].x, y.y + bias * zz[i].y);
    }
  }
  __syncthreads();
  {
    float* hFc = (float*)smem;
    float* hBc = hFc + 256;
    float2* zc = (float2*)(hBc + 256);
    float l1c = 0.f;
    if (tid < 256) {
      int t = tid;
      const float* hc = (const float*)(p.ws + WS_HID2C) + (size_t)l * 64 * 256 + t;
      float hf = 0.f, hb = 0.f;
#pragma unroll 16
      for (int k = 0; k < 64; ++k) { float v = hc[k * 256]; hf += v * aux[k]; hb += v * aux[64 + k]; }
      float tl = (float)t * (1.f / 255.f);
      hf *= expf(-tl * dF);
      hb *= expf(-tl * dB);
      hFc[t] = hf;
      hBc[t] = hb;
      l1c = fabsf(hf) + (t >= 1 ? fabsf(hb) : 0.f);
      zc[t] = zp[t];
    }
    float l1ct = block_sum(l1c, red);
    const int bb = tid >> 8, t = tid & 255;
    float acc = 0.f;
    for (int s = 0; s < 256; ++s) {
      float kf = (s <= t) ? hFc[t - s] : hBc[s - t];
      float2 z = zc[s];
      acc += kf * (bb ? z.y : z.x);
    }
    float2 z = zc[t];
    ((float*)zp)[t * 2 + bb] = acc / l1ct + bias * (bb ? z.y : z.x);
    __syncthreads();
  }
}

constexpr int AT_KP = 208, AT_VP = 136, AT_STAGE = 64 * AT_KP + 64 * AT_VP;
__device__ __forceinline__ void attn_task(const Ctx& p, int bh, int qb, char* smem) {
  const int tid = tid_l(), wid = tid >> 6, lane = tid & 63, r = lane & 31, hh = lane >> 5;
  const u16* Qp = (const u16*)(p.ws + WS_Q) + ((size_t)bh * SP + qb * 256) * 96;
  const u16* Kp = (const u16*)(p.ws + WS_K) + (size_t)bh * SP * 96;
  const u16* Vp = (const u16*)(p.ws + WS_VT) + (size_t)bh * 64 * SP;
  const int nkt = (qb == 0) ? 4 : 132;
  bf16x8 qf[6];
#pragma unroll
  for (int ks = 0; ks < 6; ++ks) qf[ks] = *(const bf16x8*)(Qp + (size_t)(wid * 32 + r) * 96 + ks * 16 + hh * 8);
  f32x16 o0, o1;
#pragma unroll
  for (int i = 0; i < 16; ++i) { o0[i] = 0.f; o1[i] = 0.f; }
  float mrun = 0.f, lrun = 0.f;
  const u16* src[3];
  int dst[3], kstep[3];
#pragma unroll
  for (int i = 0; i < 3; ++i) {
    int ch = tid + i * NT;
    if (ch < 768) { int row = ch / 12, cc = ch - row * 12; src[i] = Kp + (size_t)row * 96 + cc * 8; dst[i] = row * AT_KP + cc * 16; kstep[i] = 64 * 96; }
    else { int v = ch - 768, row = (v >> 3) & 63, cc = v & 7; src[i] = Vp + (size_t)row * SP + cc * 8; dst[i] = 64 * AT_KP + row * AT_VP + cc * 16; kstep[i] = 64; }
  }
  const bool has3 = tid < 256;
  uint4 st[3];
#define AT_LOAD(t)                                                                                   \
  do {                                                                                               \
    st[0] = *(const uint4*)(src[0] + (size_t)(t) * kstep[0]);                                        \
    st[1] = *(const uint4*)(src[1] + (size_t)(t) * kstep[1]);                                        \
    if (has3) st[2] = *(const uint4*)(src[2] + (size_t)(t) * kstep[2]);                              \
  } while (0)
#define AT_WRITE1(i, base)                                                                           \
  do {                                                                                               \
    uint2* d_ = (uint2*)((base) + dst[i]);                                                           \
    d_[0] = make_uint2(st[i].x, st[i].y);                                                            \
    d_[1] = make_uint2(st[i].z, st[i].w);                                                            \
  } while (0)
#define AT_WRITE(buf)                                                                                \
  do {                                                                                               \
    char* base_ = smem + (buf) * AT_STAGE;                                                           \
    AT_WRITE1(0, base_); AT_WRITE1(1, base_);                                                        \
    if (has3) AT_WRITE1(2, base_);                                                                   \
  } while (0)
  AT_LOAD(0);
  AT_WRITE(0);
  __syncthreads();
  for (int t = 0; t < nkt; ++t) {
    const int cur = t & 1;
    if (t + 1 < nkt) AT_LOAD(t + 1);
    const char* Ks = smem + cur * AT_STAGE;
    const char* Vs = Ks + 64 * AT_KP;
    f32x16 s0, s1;
    {
      const float nm = -mrun;
#pragma unroll
      for (int i = 0; i < 16; ++i) { s0[i] = nm; s1[i] = nm; }
    }
#pragma unroll
    for (int ks = 0; ks < 6; ++ks) {
      bf16x8 a0 = *(const bf16x8*)(Ks + r * AT_KP + ks * 32 + hh * 16);
      s0 = __builtin_amdgcn_mfma_f32_32x32x16_bf16(a0, qf[ks], s0, 0, 0, 0);
    }
#pragma unroll
    for (int ks = 0; ks < 6; ++ks) {
      bf16x8 a1 = *(const bf16x8*)(Ks + (32 + r) * AT_KP + ks * 32 + hh * 16);
      s1 = __builtin_amdgcn_mfma_f32_32x32x16_bf16(a1, qf[ks], s1, 0, 0, 0);
    }
    float ps = 0.f, pmx = 0.f;
#pragma unroll
    for (int i = 0; i < 16; ++i) { s0[i] = __builtin_amdgcn_exp2f(s0[i]); ps += s0[i]; pmx = fmaxf(pmx, s0[i]); }
#pragma unroll
    for (int sI = 0; sI < 2; ++sI) {
      union { bf16x8 v; unsigned u[4]; } pu;
#pragma unroll
      for (int j = 0; j < 4; ++j) pu.u[j] = pk2(s0[8 * sI + 2 * j], s0[8 * sI + 2 * j + 1]);
      const int koff = (16 * sI + 4 * hh) * 2;
      union { bf16x8 v; uint2 h2[2]; } va, vb;
      va.h2[0] = *(const uint2*)(Vs + r * AT_VP + koff);
      va.h2[1] = *(const uint2*)(Vs + r * AT_VP + koff + 16);
      vb.h2[0] = *(const uint2*)(Vs + (32 + r) * AT_VP + koff);
      vb.h2[1] = *(const uint2*)(Vs + (32 + r) * AT_VP + koff + 16);
      o0 = __builtin_amdgcn_mfma_f32_32x32x16_bf16(va.v, pu.v, o0, 0, 0, 0);
      o1 = __builtin_amdgcn_mfma_f32_32x32x16_bf16(vb.v, pu.v, o1, 0, 0, 0);
    }
#pragma unroll
    for (int i = 0; i < 16; ++i) { s1[i] = __builtin_amdgcn_exp2f(s1[i]); ps += s1[i]; pmx = fmaxf(pmx, s1[i]); }
#pragma unroll
    for (int sI = 0; sI < 2; ++sI) {
      union { bf16x8 v; unsigned u[4]; } pu;
#pragma unroll
      for (int j = 0; j < 4; ++j) pu.u[j] = pk2(s1[8 * sI + 2 * j], s1[8 * sI + 2 * j + 1]);
      const int koff = (32 + 16 * sI + 4 * hh) * 2;
      union { bf16x8 v; uint2 h2[2]; } va, vb;
      va.h2[0] = *(const uint2*)(Vs + r * AT_VP + koff);
      va.h2[1] = *(const uint2*)(Vs + r * AT_VP + koff + 16);
      vb.h2[0] = *(const uint2*)(Vs + (32 + r) * AT_VP + koff);
      vb.h2[1] = *(const uint2*)(Vs + (32 + r) * AT_VP + koff + 16);
      o0 = __builtin_amdgcn_mfma_f32_32x32x16_bf16(va.v, pu.v, o0, 0, 0, 0);
      o1 = __builtin_amdgcn_mfma_f32_32x32x16_bf16(vb.v, pu.v, o1, 0, 0, 0);
    }
    lrun += ps;
    pmx = fmaxf(pmx, shx(pmx, 32));
    if (__any(pmx > 256.f)) {
      const float delta = pmx > 256.f ? ceilf(__log2f(pmx)) : 0.f;
      const float alpha = __builtin_amdgcn_exp2f(-delta);
      mrun += delta;
      lrun *= alpha;
#pragma unroll
      for (int i = 0; i < 16; ++i) { o0[i] *= alpha; o1[i] *= alpha; }
    }
    if (t + 1 < nkt) AT_WRITE(cur ^ 1);
    __syncthreads();
  }
  const float ltot = lrun + shx(lrun, 32);
  const float inv = 1.f / ltot;
  const int b = bh >> 3, head = bh & 7;
  u16* Op = (u16*)(p.ws + WS_O) + ((size_t)b * SP + qb * 256 + wid * 32 + r) * 512 + head * 64;
#pragma unroll
  for (int g = 0; g < 4; ++g) {
    uint2 w0, w1;
    w0.x = pk2(o0[4 * g] * inv, o0[4 * g + 1] * inv);
    w0.y = pk2(o0[4 * g + 2] * inv, o0[4 * g + 3] * inv);
    w1.x = pk2(o1[4 * g] * inv, o1[4 * g + 1] * inv);
    w1.y = pk2(o1[4 * g + 2] * inv, o1[4 * g + 3] * inv);
    *(uint2*)(Op + 8 * g + 4 * hh) = w0;
    *(uint2*)(Op + 32 + 8 * g + 4 * hh) = w1;
  }
#undef AT_LOAD
#undef AT_WRITE
#undef AT_WRITE1
}

__device__ __forceinline__ void hypost_task(const Ctx& p, int task, char* smem) {
  const int tid = tid_l(), lane = tid & 63, wid = tid >> 6;
  const int tile64 = task >> 1, ch0 = (task & 1) * 256;
  const int m0 = tile64 * 64, b = m0 / SP, pos0 = m0 - b * SP;
  float* T = (float*)smem;
  const float* ZV = (const float*)(p.ws + WS_ZV);
#pragma unroll 8
  for (int cc = 0; cc < 32; ++cc) {
    int c = wid * 32 + cc;
    T[c * 65 + lane] = ZV[((size_t)(ch0 + c) * SP + pos0 + lane) * 2 + b];
  }
  __syncthreads();
  u16* Y = (u16*)(p.ws + WS_Y);
  const int c = tid & 255, th = tid >> 8;
  u16* yp = Y + (size_t)(m0 + th * 32) * 512 + ch0 + c;
  u16 yv[32];
#pragma unroll
  for (int i = 0; i < 32; ++i) yv[i] = yp[(size_t)i * 512];
#pragma unroll
  for (int i = 0; i < 32; ++i) yp[(size_t)i * 512] = f2bf(bf2f(yv[i]) * T[c * 65 + th * 32 + i]);
  __syncthreads();
}

#ifndef PHMASK
#define PHMASK 0xFFFF
#endif
#define PHON(k) (((PHMASK) >> (k)) & 1)
constexpr int NPH = 1 + 4 * 10 + 1;
__global__ void __launch_bounds__(NT, 2) mega(Params prm) {
  __shared__ __attribute__((aligned(1024))) char smem[LDS_BYTES];
  cg::grid_group grid = cg::this_grid();
  const int bid = blockIdx.x, nb = gridDim.x;
  {
    unsigned long long* it = (unsigned long long*)(smem + AUX_OFF + 6144);
    if (threadIdx.x < 33) it[threadIdx.x] = (unsigned long long)prm.in[threadIdx.x];
    __syncthreads();
  }
  if (prm.ph_lo == 0) {
    Ctx p;
    p.intab = (const unsigned long long*)(smem + AUX_OFF + 6144);
    p.ws = prm.ws;
    p.out = prm.out;
    const int bid = blockIdx.x, nb = gridDim.x;
      if (PHON(10)) {
      p0_misc(p);
      for (int t = bid; t < 192; t += nb) p0_mod_task(p, t, smem);
      for (int t = bid; t < 528; t += nb) p0_hid_task(p, t, smem);
      for (int t = bid; t < 128; t += nb) { const int w = (t + 64) & 127; wpe_task(p, w >> 5, w & 31, smem); }
      }
  }
  unsigned nbar = 0;
  for (int ph = prm.ph_lo; ph < prm.ph_hi; ++ph) {
    Ctx p;
    p.intab = (const unsigned long long*)(smem + AUX_OFF + 6144);
    p.ws = prm.ws;
    p.out = prm.out;
    asm volatile("" : "+s"(p.ws), "+s"(p.out));
    float* modall = (float*)(p.ws + WS_MOD);
    u16* proj = (u16*)(p.ws + WS_PROJ);
    u16* xn = (u16*)(p.ws + WS_U);
    char* wo = (char*)p.out;
    if (ph == 0) {
    } else if (ph == NPH - 1) {
      if (PHON(11)) final_norm(p);
    } else {
      const int l = (ph - 1) / 10, sp = (ph - 1) % 10;
      const float* modl = modall + (size_t)l * 3 * 6144;
      GD* tab = (GD*)(smem + AUX_OFF + 4096);
      int ng = 0, nN0 = 0, nN1 = 0, nsplit = 1;
      bool seq = false;
      const float* gate = modl;
      if (sp == 0 && PHON(0)) {
        wt_phase(p, l, smem);
        norm_rows(p, pin(p, 6) + l * 1024, modl, 0, 1, xn);
      } else if (sp == 1 && PHON(1)) {
        if (threadIdx.x == 0) tab[0] = GD{xn, 1024, (const u16*)(wo + WO_IN), 1024, 1024, 23, EM_PROJ, 1};
        ng = 1; nN0 = 23;
      } else if (sp == 2 && PHON(2)) {
        for (int t = bid; t < 264 * 6; t += nb) premix_task(p, l, t, smem);
        {
          Epi ef{EM_FILT, p.ws, gate, nullptr, (u16*)(wo + WO_FILT)};
          const u16* hA = (const u16*)(p.ws + WS_HID2) + (size_t)l * 8192 * 64;
          const u16* wB = (const u16*)(p.ws + WS_W3T) + (size_t)l * 1024 * 64;
#pragma unroll 1
          for (int t = nb - 1 - bid; t < 128; t += nb) gemm_tile(hA, 64, wB, 64, 64, (t >> 2) * 256, (t & 3) * 256, smem, ef);
        }
      } else if (sp == 3 && PHON(3)) {
        for (int t = bid; t < 512; t += nb) fft_task(p, l, t, smem);
        if (threadIdx.x == 0) {
          tab[0] = GD{proj + OFF_Q, DINP, (const u16*)(wo + WO_UQ), 384, 384, 3, EM_Q, 1};
          tab[1] = GD{proj + OFF_KV, DINP, (const u16*)(wo + WO_UKV), 256, 256, 4, EM_KV, 1};
        }
        ng = 2; nN0 = 3; nN1 = 4;
        for (int i = tid_l(); i < 1024; i += NT) ((float2*)(smem + 131072))[i] = ((const float2*)(p.ws + WS_ROPE))[i];
      } else if (sp == 4 && PHON(4)) {
        for (int t = bid; t < 528; t += nb) {
          int bh, qb;
          if (t < 512) { int rnd = t >> 8, w = t & 255; bh = (w & 7) + 8 * rnd; qb = 1 + (w >> 3); }
          else { bh = t - 512; qb = 0; }
          attn_task(p, bh, qb, smem);
        }
        for (int t = bid; t < 528; t += nb) hypost_task(p, t, smem);
      } else if (sp == 5 && PHON(5)) {
        for (int t = bid; t < 8 * 68; t += nb) {
          const int x = t & 7, g = t >> 3, pm = (g >> 2) * 8 + x;
          if (pm < 132) mix_tile(p, l, pm, g & 3, smem);
        }
      } else if (sp == 6 && PHON(6)) {
        if (threadIdx.x == 0) tab[0] = GD{(const u16*)(p.ws + WS_ZV), 1024, (const u16*)(wo + WO_OUT), 1024, 1024, 4, EM_RESID, 4};
        ng = 1; nN0 = 4; nsplit = 4;
        gate = modl + 2 * 1024;
      } else if (sp == 7 && PHON(7)) {
        norm_rows(p, pin(p, 7) + l * 1024, modl, 3, 4, xn);
      } else if (sp == 8 && PHON(8)) {
        if (threadIdx.x == 0) tab[0] = GD{xn, 1024, (const u16*)(wo + WO_FF1), 1024, 1024, 16, EM_SQRELU, 1};
        ng = 1; nN0 = 16;
      } else if (sp == 9 && PHON(9)) {
        if (threadIdx.x == 0) tab[0] = GD{proj, DFF, (const u16*)(wo + WO_FF2), 4096, 4096, 4, EM_RESID, 8};
        ng = 1; nN0 = 4; nsplit = 8;
        gate = modl + 5 * 1024;
      }
      if (ng > 0) {
        __syncthreads();
        const int nt0 = (nsplit > 1) ? (64 * nN0 + 2 * nN0 * nsplit) : NMT * nN0, ntot = seq ? nt0 : nt0 + NMT * nN1;
        const int nseq = seq ? ng : 1;
        const int nitems = ((ntot - bid + nb - 1) / nb) * nseq;
#pragma unroll 1
        for (int it = 0; it < nitems; ++it) {
          int t = bid + (it / nseq) * nb, gi = it % nseq, tt = t;
          if (!seq && t >= nt0) { gi = 1; tt = t - nt0; }
          const volatile GD* gp = tab + gi;
          unsigned long long a64 = (unsigned long long)gp->A, b64 = (unsigned long long)gp->Bt;
          a64 = ((unsigned long long)(unsigned)__builtin_amdgcn_readfirstlane((unsigned)(a64 >> 32)) << 32) | (unsigned long long)(unsigned)__builtin_amdgcn_readfirstlane((unsigned)a64);
          b64 = ((unsigned long long)(unsigned)__builtin_amdgcn_readfirstlane((unsigned)(b64 >> 32)) << 32) | (unsigned long long)(unsigned)__builtin_amdgcn_readfirstlane((unsigned)b64);
          const int lda = __builtin_amdgcn_readfirstlane(gp->lda), ldb = __builtin_amdgcn_readfirstlane(gp->ldb);
          const int K = __builtin_amdgcn_readfirstlane(gp->K), nN = __builtin_amdgcn_readfirstlane(gp->nN);
          const int ks = __builtin_amdgcn_readfirstlane(gp->ks);
          const int mode = __builtin_amdgcn_readfirstlane(gp->mode);
          int pm, pn, Kuse = K, emode = mode;
          if (ks > 1) {
            const int nlat = 64 * nN;
            if (tt < nlat) { int pm64; tile_map(tt, 64, nN, pm64, pn); pm = (pm64 >> 5) * 33 + 1 + (pm64 & 31); }
            else {
              int u = tt - nlat, kp = u % ks, tile = u / ks;
              pm = (tile / nN) * 33; pn = tile % nN;
              Kuse = K / ks; emode = EM_RESID_AT;
              a64 += (unsigned long long)kp * Kuse * 2; b64 += (unsigned long long)kp * Kuse * 2;
            }
          } else tile_map(tt, NMT, nN, pm, pn);
          Epi e{emode, p.ws, gate, (const float2*)(smem + 131072), nullptr};
          gemm_tile((const u16*)a64, lda, (const u16*)b64, ldb, Kuse, pm * 256, pn * 256, smem, e);
        }
      }
    }
    if (ph + 1 < prm.ph_hi) {
      if (ph == prm.ph_lo) grid.sync();
      else { ++nbar; grid_barrier((unsigned*)(prm.ws + WS_BAR), nbar * gridDim.x); }
    }
  }
}

extern "C" void kernel_launch(void* const* d_in, const int* in_sizes, int n_in, void* d_out, int out_size, void* d_ws,
                              size_t ws_size, hipStream_t stream) {
  static int grid_blocks = 0;
  if (grid_blocks == 0) {
    if (n_in != 33 || ws_size < WS_END || (size_t)out_size * 4 < WO_END) {
      fprintf(stderr, "kernel_launch: unexpected sizes n_in=%d ws=%zu (need %zu) out=%d\n", n_in, ws_size, (size_t)WS_END, out_size);
      grid_blocks = -1;
      return;
    }
    int dev = 0, cus = 0, per_cu = 0;
    hipGetDevice(&dev);
    hipDeviceGetAttribute(&cus, hipDeviceAttributeMultiprocessorCount, dev);
    hipOccupancyMaxActiveBlocksPerMultiprocessor(&per_cu, mega, NT, 0);
    if (per_cu < 1) per_cu = 1;
    if (per_cu > 1) per_cu = 1;
    grid_blocks = cus * per_cu;
  }
  if (grid_blocks < 0) return;
  Params p{};
  for (int i = 0; i < 33; ++i) p.in[i] = (const float*)d_in[i];
  p.out = (float*)d_out;
  p.ws = (char*)d_ws;
  p.ph_lo = 0;
  p.ph_hi = NPH;
  (void)hipMemsetAsync((char*)d_ws + WS_BAR, 0, 1024, stream);
  void* args[] = {&p};
  hipError_t e = hipLaunchCooperativeKernel((void*)mega, dim3(grid_blocks), dim3(NT), args, 0, stream);
  if (e != hipSuccess) fprintf(stderr, "cooperative launch failed: %s (grid %d)\n", hipGetErrorString(e), grid_blocks);
}
```

```cpp
#include <hip/hip_runtime.h>
#include <hip/hip_cooperative_groups.h>
#include <cstdio>
namespace cg = cooperative_groups;

typedef unsigned short u16;
using bf16x8 = __attribute__((ext_vector_type(8))) short;
using f32x4 = __attribute__((ext_vector_type(4))) float;
using f32x16 = __attribute__((ext_vector_type(16))) float;

constexpr int D = 1024, SEQ = 8192, CTX = 256, SP = 8448, MROWS = 16896, NMT = 66;
constexpr int DIN = 5792, DINP = 5888, DFF = 4096;
constexpr int OFF_HY = 512, OFF_Q = 2048, OFF_KV = 2432, OFF_GATE = 2720;
constexpr int NT = 512;
constexpr float EPS = 1e-6f;

constexpr size_t WS_H = 0;
constexpr size_t WS_PROJ = WS_H + (size_t)MROWS * D * 4;
constexpr size_t WS_U = WS_PROJ + (size_t)MROWS * DINP * 2;
constexpr size_t WS_Y = WS_U + (size_t)MROWS * 512 * 2;
constexpr size_t WS_O = WS_Y + (size_t)MROWS * 512 * 2;
constexpr size_t WS_Q = WS_O + (size_t)MROWS * 512 * 2;
constexpr size_t WS_K = WS_Q + (size_t)16 * SP * 96 * 2;
constexpr size_t WS_VT = WS_K + (size_t)16 * SP * 96 * 2;
constexpr size_t WS_ZV = WS_VT + (size_t)16 * 64 * SP * 2;
constexpr size_t WS_HID2 = WS_ZV + (size_t)512 * SP * 8;
constexpr size_t WS_HID2C = WS_HID2 + (size_t)4 * 8192 * 64 * 4;
constexpr size_t WS_MOD = WS_HID2C + (size_t)4 * 256 * 64 * 4;
constexpr size_t WS_ROPE = WS_MOD + (size_t)4 * 3 * 6144 * 4;
constexpr size_t WS_TW = WS_ROPE + (size_t)128 * 8 * 8;
constexpr size_t WS_WPE = WS_TW + (size_t)16384 * 8;
constexpr size_t WS_BAR = WS_WPE + (size_t)4 * 1024 * 512 * 2;
constexpr size_t WS_END = WS_BAR + 1024;
constexpr size_t WO_IN = 0;
constexpr size_t WO_FF1 = WO_IN + (size_t)DINP * 1024 * 2;
constexpr size_t WO_FF2 = WO_FF1 + (size_t)4096 * 1024 * 2;
constexpr size_t WO_OUT = WO_FF2 + (size_t)4096 * 1024 * 2;
constexpr size_t WO_HY = WO_OUT + (size_t)1024 * 1024 * 2;
constexpr size_t WO_WO = WO_HY + (size_t)1024 * 512 * 2;
constexpr size_t WO_PE = WO_WO + (size_t)1024 * 512 * 2;
constexpr size_t WO_UQ = WO_PE + (size_t)1024 * 512 * 2;
constexpr size_t WO_UKV = WO_UQ + (size_t)768 * 384 * 2;
constexpr size_t WO_FILT = WO_UKV + (size_t)1024 * 256 * 2;
constexpr size_t WO_END = WO_FILT + (size_t)1024 * 8192 * 2;
constexpr size_t WS_W3T = WS_HID2 + (size_t)4 * 8192 * 64 * 2;

constexpr int AUX_OFF = 147456;
constexpr int LDS_BYTES = AUX_OFF + 8192;

struct Params {
  const float* in[33];
  float* out;
  char* ws;
  int ph_lo, ph_hi;
};

struct Ctx { const unsigned long long* intab; char* ws; float* out; };
__device__ __forceinline__ const float* pin(const Ctx& c, int i) {
  unsigned long long v = c.intab[i];
  unsigned lo = __builtin_amdgcn_readfirstlane((unsigned)v), hi = __builtin_amdgcn_readfirstlane((unsigned)(v >> 32));
  return (const float*)(((unsigned long long)hi << 32) | lo);
}

typedef __bf16 hwbf2 __attribute__((ext_vector_type(2)));
typedef float hwf2 __attribute__((ext_vector_type(2)));
__device__ __forceinline__ unsigned pk2(float a, float b) {
  hwf2 v = {a, b};
  hwbf2 r = __builtin_convertvector(v, hwbf2);
  return __builtin_bit_cast(unsigned, r);
}
__device__ __forceinline__ u16 f2bf(float f) { return (u16)(pk2(f, 0.f) & 0xffffu); }
__device__ __forceinline__ float bf2f(u16 b) { return __uint_as_float(((unsigned)b) << 16); }
__device__ __forceinline__ float shx(float v, int o) {
  int l = __builtin_amdgcn_mbcnt_hi(~0u, __builtin_amdgcn_mbcnt_lo(~0u, 0u));
  asm volatile("" : "+v"(l));
  return __int_as_float(__builtin_amdgcn_ds_bpermute((l ^ o) << 2, __float_as_int(v)));
}
__device__ __forceinline__ float wave_sum(float v) {
#pragma unroll
  for (int o = 1; o < 64; o <<= 1) v += shx(v, o);
  return v;
}
__device__ __forceinline__ int grp_of_row(int m) {
  int tile = m >> 8, b = tile / 33, t33 = tile - b * 33;
  return t33 == 0 ? 2 : b;
}
__device__ __forceinline__ float2 cmul(float2 a, float2 b) { return make_float2(a.x * b.x - a.y * b.y, a.x * b.y + a.y * b.x); }

__device__ __forceinline__ int tid_l() { int t = threadIdx.x; asm volatile("" : "+v"(t)); return t; }
__device__ __forceinline__ void grid_barrier(unsigned* bar, unsigned target) {
  asm volatile("s_waitcnt vmcnt(0)" ::: "memory");
  __syncthreads();
  if (threadIdx.x == 0) {
    __builtin_amdgcn_fence(__ATOMIC_RELEASE, "agent");
    asm volatile("s_waitcnt vmcnt(0)" ::: "memory");
    __hip_atomic_fetch_add(bar, 1u, __ATOMIC_RELAXED, __HIP_MEMORY_SCOPE_AGENT);
    while (__hip_atomic_load(bar, __ATOMIC_RELAXED, __HIP_MEMORY_SCOPE_AGENT) < target) __builtin_amdgcn_s_sleep(2);
    __builtin_amdgcn_fence(__ATOMIC_ACQUIRE, "agent");
    asm volatile("s_waitcnt vmcnt(0)" ::: "memory");
  }
  __syncthreads();
}
#define WAIT_V(n) asm volatile("s_waitcnt vmcnt(%0)" ::"n"(n) : "memory")
#define SCHED() __builtin_amdgcn_sched_barrier(0)
#define RAW_BARRIER() do { asm volatile("s_waitcnt lgkmcnt(0)" ::: "memory"); __builtin_amdgcn_s_barrier(); } while (0)

constexpr float QSCALE = 0.10206207261596575f * 1.4426950408889634f;
enum { EM_PROJ = 0, EM_SQRELU = 1, EM_RESID = 2, EM_RESID_AT = 3, EM_FILT = 4, EM_Q = 6, EM_KV = 7 };
struct Epi {
  int mode;
  char* ws;
  const float* gate;
  const float2* rope_lds;
  u16* filt_out;
  __device__ __forceinline__ void proj(int row, int col, f32x4 v) const {
    {
      u16* out = (u16*)(ws + WS_PROJ);
#pragma unroll
      for (int j = 0; j < 4; ++j) out[(size_t)(row + j) * DINP + col] = f2bf(v[j]);
    }
  }
  __device__ __forceinline__ void sqrelu(int row, int col, f32x4 v) const {
    {
      u16* out = (u16*)(ws + WS_PROJ);
#pragma unroll
      for (int j = 0; j < 4; ++j) { float r = fmaxf(v[j], 0.f); out[(size_t)(row + j) * DFF + col] = f2bf(r * r); }
    }
  }
  __device__ __forceinline__ void resid(int row, int col, f32x4 v) const {
    {
      float* h = (float*)(ws + WS_H);
      float g = gate[grp_of_row(row) * 6144 + col];
#pragma unroll
      for (int j = 0; j < 4; ++j) unsafeAtomicAdd(h + (size_t)(row + j) * D + col, g * v[j]);
    }
  }
  __device__ __forceinline__ void filt(int row, int col, f32x4 v) const {
    uint2 o;
    o.x = pk2(v[0], v[1]);
    o.y = pk2(v[2], v[3]);
    *(uint2*)(filt_out + (size_t)col * 8192 + row) = o;
  }
  __device__ __forceinline__ void q(int row, int col, f32x4 v) const {
    {
      u16* Q = (u16*)(ws + WS_Q);
      const float2* rope = rope_lds;
      int head = col / 96, d = col - head * 96;
      int b = row / SP, pos0 = row - b * SP;
      bool isrope = (d >= 64) && (pos0 >= CTX);
      int rd = d - 64;
#pragma unroll
      for (int j = 0; j < 4; ++j) {
        float val = v[j];
        float partner = shx(val, 8);
        int pos = pos0 + j;
        if (isrope) {
          int t = pos - CTX, idx = (rd < 16) ? (t >> 6) : (t & 63);
          float2 cs = rope[idx * 8 + (rd & 7)];
          float sgn = (rd & 8) ? 1.f : -1.f;
          val = val * cs.x + sgn * partner * cs.y;
        }
        Q[((size_t)(b * 8 + head) * SP + pos) * 96 + d] = f2bf(val * QSCALE);
      }
    }
  }
  __device__ __forceinline__ void kv(int row, int col, f32x4 v) const {
    {
      u16* Kb = (u16*)(ws + WS_K);
      u16* Vt = (u16*)(ws + WS_VT);
      int head = col >> 7, j2 = col & 127;
      int b = row / SP, pos0 = row - b * SP;
      if (j2 < 64) {
#pragma unroll
        for (int j = 0; j < 4; ++j) Kb[((size_t)(b * 8 + head) * SP + pos0 + j) * 96 + j2] = f2bf(v[j]);
      } else {
        uint2 o;
        o.x = pk2(v[0], v[1]);
        o.y = pk2(v[2], v[3]);
        *(uint2*)(Vt + ((size_t)(b * 8 + head) * 64 + (j2 - 64)) * SP + pos0) = o;
      }
    }
  }
};
struct GD { const u16* A; int lda; const u16* Bt; int ldb; int K; int nN; int mode; int ks; };

constexpr int G_TILE_B = 256 * 64 * 2, G_STAGE_B = 2 * G_TILE_B;
__device__ __forceinline__ int lds_byte(int r, int c) {
  int st = (r >> 4) * 2 + (c >> 5), ob = (r & 15) * 64 + (c & 31) * 2;
  return st * 1024 + (ob ^ (((ob >> 9) & 1) << 5));
}
__device__ __forceinline__ void stage_rc(int b, int& R, int& C) {
  int st = b >> 10, sb = b & 1023, swz = sb ^ (((sb >> 9) & 1) << 5);
  R = (st / 2) * 16 + swz / 64;
  C = (st % 2) * 32 + (swz % 64) / 2;
}

template <int MI>
__device__ __forceinline__ void gemm_core(const u16* __restrict__ A, int lda, const u16* __restrict__ Bt, int ldb, int K,
                                          int brow, int bcol, char* shm, f32x4 (&acc)[MI][4]) {
  constexpr int TILE_A = MI * 32 * 64 * 2, TILE_BB = 256 * 64 * 2, STAGE = TILE_A + TILE_BB;
  const int tid = tid_l(), wid = tid >> 6, lane = tid & 63, wr = wid >> 2, wc = wid & 3, fr = lane & 15, fq = lane >> 4;
  const u16* Ab = A + (size_t)brow * lda;
  const u16* Bb = Bt + (size_t)bcol * ldb;
  int sR[4], sC[4];
#pragma unroll
  for (int i = 0; i < 4; ++i) stage_rc(wid * 1024 + i * 8192 + lane * 16, sR[i], sC[i]);
#define SA(b) (shm + (b) * STAGE)
#define SB(b) (shm + (b) * STAGE + TILE_A)
#define GLDS_STAGE(buf, kt)                                                                                              \
  do {                                                                                                                   \
    _Pragma("unroll") for (int i = 0; i < 4; ++i) {                                                                      \
      if (i < MI / 2)                                                                                                    \
        __builtin_amdgcn_global_load_lds((const unsigned*)(Ab + (size_t)sR[i] * lda + (kt) * 64 + sC[i]),                \
                                         (unsigned*)(SA(buf) + wid * 1024 + i * 8192), 16, 0, 0);                        \
      __builtin_amdgcn_global_load_lds((const unsigned*)(Bb + (size_t)sR[i] * ldb + (kt) * 64 + sC[i]),                  \
                                       (unsigned*)(SB(buf) + wid * 1024 + i * 8192), 16, 0, 0);                          \
    }                                                                                                                    \
  } while (0)
  const int nt = K / 64;
  GLDS_STAGE(0, 0);
  WAIT_V(0);
  __syncthreads();
  for (int t = 0; t < nt; ++t) {
    const int cur = t & 1;
    if (t + 1 < nt) GLDS_STAGE(cur ^ 1, t + 1);
#pragma unroll
    for (int ks = 0; ks < 2; ++ks) {
      bf16x8 At[MI], Bf[4];
#pragma unroll
      for (int m = 0; m < MI; ++m) At[m] = *(const bf16x8*)(SA(cur) + lds_byte(wr * (MI * 16) + m * 16 + fr, ks * 32 + fq * 8));
#pragma unroll
      for (int n = 0; n < 4; ++n) Bf[n] = *(const bf16x8*)(SB(cur) + lds_byte(wc * 64 + n * 16 + fr, ks * 32 + fq * 8));
#pragma unroll
      for (int m = 0; m < MI; ++m)
#pragma unroll
        for (int n = 0; n < 4; ++n) acc[m][n] = __builtin_amdgcn_mfma_f32_16x16x32_bf16(At[m], Bf[n], acc[m][n], 0, 0, 0);
      SCHED();
    }
    WAIT_V(0);
    __syncthreads();
  }
#undef SA
#undef SB
#undef GLDS_STAGE
}

template <class EpiT>
__device__ __forceinline__ void gemm_tile(const u16* __restrict__ A, int lda, const u16* __restrict__ Bt, int ldb, int K,
                                          int brow, int bcol, char* shm, const EpiT& epi) {
  const int tid = tid_l(), wid = tid >> 6, lane = tid & 63, wr = wid >> 2, wc = wid & 3, fr = lane & 15, fq = lane >> 4;
  f32x4 acc[8][4];
#pragma unroll
  for (int m = 0; m < 8; ++m)
#pragma unroll
    for (int n = 0; n < 4; ++n) acc[m][n] = (f32x4){0.f, 0.f, 0.f, 0.f};
  gemm_core<8>(A, lda, Bt, ldb, K, brow, bcol, shm, acc);
#define EPI_LOOP(CALL)                                                                              \
  _Pragma("unroll") for (int m = 0; m < 8; ++m) _Pragma("unroll") for (int n = 0; n < 4; ++n) {      \
    const int row = brow + wr * 128 + m * 16 + fq * 4, col = bcol + wc * 64 + n * 16 + fr;           \
    const f32x4 v = acc[m][n];                                                                        \
    CALL;                                                                                             \
  }
  if (epi.mode == EM_PROJ) { EPI_LOOP(epi.proj(row, col, v)) }
  else if (epi.mode == EM_SQRELU) { EPI_LOOP(epi.sqrelu(row, col, v)) }
  else if (epi.mode == EM_RESID_AT) { EPI_LOOP(epi.resid(row, col, v)) }
  else if (epi.mode == EM_RESID) {
    float* h = (float*)(epi.ws + WS_H);
    float g4[4];
#pragma unroll
    for (int n = 0; n < 4; ++n) g4[n] = epi.gate[grp_of_row(brow) * 6144 + bcol + wc * 64 + n * 16 + fr];
    float hv[8][4][4];
    float* hp0 = h + (size_t)(brow + wr * 128 + fq * 4) * D + bcol + wc * 64 + fr;
#define H_LOAD(m) _Pragma("unroll") for (int n = 0; n < 4; ++n) _Pragma("unroll") for (int j = 0; j < 4; ++j) hv[m][n][j] = hp0[(size_t)((m) * 16 + j) * D + n * 16]
#define H_STORE(m) _Pragma("unroll") for (int n = 0; n < 4; ++n) _Pragma("unroll") for (int j = 0; j < 4; ++j) hp0[(size_t)((m) * 16 + j) * D + n * 16] = hv[m][n][j] + g4[n] * acc[m][n][j]
    H_LOAD(0); H_LOAD(1);
    SCHED();
    H_STORE(0); H_LOAD(2); SCHED();
    H_STORE(1); H_LOAD(3); SCHED();
    H_STORE(2); H_LOAD(4); SCHED();
    H_STORE(3); H_LOAD(5); SCHED();
    H_STORE(4); H_LOAD(6); SCHED();
    H_STORE(5); H_LOAD(7); SCHED();
    H_STORE(6); H_STORE(7);
#undef H_LOAD
#undef H_STORE
  }
  else if (epi.mode == EM_FILT) { EPI_LOOP(epi.filt(row, col, v)) }
  else if (epi.mode == EM_Q) { EPI_LOOP(epi.q(row, col, v)) }
  else { EPI_LOOP(epi.kv(row, col, v)) }
#undef EPI_LOOP
}

__device__ __forceinline__ void mix_tile(const Ctx& p, int l, int pm, int pn, char* shm) {
  constexpr int TILE_A = 128 * 64 * 2, TILE_BB = 256 * 64 * 2, STAGE = TILE_A + TILE_BB;
  const int tid = tid_l(), wid = tid >> 6, lane = tid & 63, wr = wid >> 2, wc = wid & 3, fr = lane & 15, fq = lane >> 4;
  const int brow = pm * 128, bcol = pn * 256;
  const u16* projb = (const u16*)(p.ws + WS_PROJ);
  char* wo = (char*)p.out;
#define SA(b) (shm + (b) * STAGE)
#define SB(b) (shm + (b) * STAGE + TILE_A)
#define MIX_STAGE(buf, kt)                                                                                               \
  do {                                                                                                                   \
    const int br_ = (kt) >> 3, ko_ = ((kt) & 7) * 64;                                                                    \
    const u16* Ab_ = (const u16*)(p.ws + (br_ == 0 ? WS_U : br_ == 1 ? WS_Y : WS_O)) + (size_t)brow * 512 + ko_;         \
    const u16* Bb_ = (br_ == 0 ? (const u16*)(p.ws + WS_WPE) + (size_t)l * 1024 * 512 : (const u16*)(wo + (br_ == 1 ? WO_HY : WO_WO))) + (size_t)bcol * 512 + ko_;        \
    _Pragma("unroll") for (int i = 0; i < 4; ++i) {                                                                      \
      int sR_, sC_; stage_rc(wid * 1024 + i * 8192 + lane * 16, sR_, sC_);                                              \
      if (i < 2)                                                                                                         \
        __builtin_amdgcn_global_load_lds((const unsigned*)(Ab_ + sR_ * 512 + sC_),                           \
                                         (unsigned*)(SA(buf) + wid * 1024 + i * 8192), 16, 0, 0);                        \
      __builtin_amdgcn_global_load_lds((const unsigned*)(Bb_ + sR_ * 512 + sC_),                             \
                                       (unsigned*)(SB(buf) + wid * 1024 + i * 8192), 16, 0, 0);                          \
    }                                                                                                                    \
  } while (0)
  f32x4 tot[4][4], acc[4][4];
#pragma unroll
  for (int m = 0; m < 4; ++m)
#pragma unroll
    for (int n = 0; n < 4; ++n) { tot[m][n] = (f32x4){0.f, 0.f, 0.f, 0.f}; acc[m][n] = (f32x4){0.f, 0.f, 0.f, 0.f}; }
  MIX_STAGE(0, 0);
  MIX_STAGE(1, 1);
  WAIT_V(6);
  RAW_BARRIER();
  int cur = 0;
#pragma unroll 1
  for (int br = 0; br < 3; ++br) {
    unsigned gpk[4][4][2];
    const u16* gp = projb + (size_t)(brow + wr * 64 + fq * 4) * DINP + OFF_GATE + br * 1024 + bcol + wc * 64 + fr;
#define GATE_LOAD(m)                                                                                   \
    _Pragma("unroll") for (int n = 0; n < 4; ++n) _Pragma("unroll") for (int j2 = 0; j2 < 2; ++j2) {       \
      unsigned lo = gp[(size_t)((m) * 16 + 2 * j2) * DINP + n * 16], hi = gp[(size_t)((m) * 16 + 2 * j2 + 1) * DINP + n * 16]; \
      gpk[m][n][j2] = lo | (hi << 16);                                                                     \
    }
    GATE_LOAD(0); GATE_LOAD(1); GATE_LOAD(2);
#pragma unroll 1
    for (int kk = 0; kk < 8; ++kk) {
      const int t = br * 8 + kk;
      { int nx = cur + 2; if (nx >= 3) nx -= 3; if (t + 2 < 24) MIX_STAGE(nx, t + 2); }
#pragma unroll
      for (int ks = 0; ks < 2; ++ks) {
        bf16x8 At[2], Bf[4];
#pragma unroll
        for (int n = 0; n < 4; ++n) Bf[n] = *(const bf16x8*)(SB(cur) + lds_byte(wc * 64 + n * 16 + fr, ks * 32 + fq * 8));
#pragma unroll
        for (int mh = 0; mh < 2; ++mh) {
#pragma unroll
          for (int m = 0; m < 2; ++m) At[m] = *(const bf16x8*)(SA(cur) + lds_byte(wr * 64 + (mh * 2 + m) * 16 + fr, ks * 32 + fq * 8));
#pragma unroll
          for (int m = 0; m < 2; ++m)
#pragma unroll
            for (int n = 0; n < 4; ++n) acc[mh * 2 + m][n] = __builtin_amdgcn_mfma_f32_16x16x32_bf16(At[m], Bf[n], acc[mh * 2 + m][n], 0, 0, 0);
          SCHED();
        }
      }
      if (t + 2 < 24) WAIT_V(6); else WAIT_V(0);
      RAW_BARRIER();
      cur = (cur == 2) ? 0 : cur + 1;
    }
    GATE_LOAD(3);
#undef GATE_LOAD
#pragma unroll
    for (int m = 0; m < 4; ++m)
#pragma unroll
      for (int n = 0; n < 4; ++n)
#pragma unroll
        for (int j = 0; j < 4; ++j) {
          const unsigned w = gpk[m][n][j >> 1];
          const float gv = __uint_as_float((j & 1) ? (w & 0xffff0000u) : (w << 16));
          tot[m][n][j] += acc[m][n][j] / (1.f + __expf(-gv));
          acc[m][n][j] = 0.f;
        }
  }
  u16* mixb = (u16*)(p.ws + WS_ZV);
#pragma unroll
  for (int m = 0; m < 4; ++m)
#pragma unroll
    for (int n = 0; n < 4; ++n)
#pragma unroll
      for (int j = 0; j < 4; ++j)
        mixb[(size_t)(brow + wr * 64 + m * 16 + fq * 4 + j) * D + bcol + wc * 64 + n * 16 + fr] = f2bf(tot[m][n][j]);
#undef SA
#undef SB
#undef MIX_STAGE
}

__device__ __forceinline__ void tile_map(int t, int nM, int nN, int& pm, int& pn) {
  int nwg = nM * nN, wgid = t;
  {
    int q = nwg / 8, r = nwg % 8, xcd = wgid % 8, off = wgid / 8;
    wgid = (xcd < r ? xcd * (q + 1) : r * (q + 1) + (xcd - r) * q) + off;
  }
  int nig = 8 * nN, gid = wgid / nig, fm = gid * 8, gsz = min(nM - fm, 8);
  pm = fm + ((wgid % nig) % gsz);
  pn = (wgid % nig) / gsz;
}

__device__ __forceinline__ void p0_misc(const Ctx& p) {
  const int gtid = blockIdx.x * NT + tid_l(), gn = gridDim.x * NT;
  float4* h4 = (float4*)(p.ws + WS_H);
  const float4* x4 = (const float4*)pin(p, 0);
  const float4* c4 = (const float4*)pin(p, 2);
#pragma unroll 8
  for (int i = gtid; i < MROWS * 256; i += gn) {
    int m = i >> 8, q = i & 255, b = m / SP, pos = m - b * SP;
    float4 v = (pos < CTX) ? c4[(size_t)(b * CTX + pos) * 256 + q] : x4[(size_t)(b * SEQ + pos - CTX) * 256 + q];
    h4[i] = v;
  }
  float2* rope = (float2*)(p.ws + WS_ROPE);
  for (int i = gtid; i < 1024; i += gn) {
    int idx = i >> 3, f = i & 7;
    float inv = powf(10000.f, -(float)f / 8.f);
    float a = (float)idx * inv;
    rope[i] = make_float2(cosf(a), sinf(a));
  }
  {
    u16* w3t = (u16*)(p.ws + WS_W3T);
    const float* w3 = pin(p, 20);
    for (int i = gtid; i < 4 * 1024 * 64; i += gn) { int l = i >> 16, c2 = (i >> 6) & 1023, k = i & 63; w3t[i] = f2bf(w3[((size_t)l * 64 + k) * 1024 + c2]); }
  }
  float2* tw = (float2*)(p.ws + WS_TW);
  for (int i = gtid; i < 16384; i += gn) {
    float s, c;
    sincospif(-(float)i / 8192.f, &s, &c);
    tw[i] = make_float2(c, s);
  }
}

__device__ __forceinline__ void p0_mod_task(const Ctx& p, int task, char* smem) {
  float* s = (float*)smem;
  float* red = s + 3072;
  const int tid = tid_l();
  const int l = task / 48, chunk = task - l * 48;
  for (int i = tid; i < 3072; i += NT) {
    int g = i >> 10, k = i & 1023;
    float cv = (g < 2) ? pin(p, 1)[g * 1024 + k] : pin(p, 3)[k];
    s[i] = cv / (1.f + __expf(-cv));
  }
  __syncthreads();
  const int kq = tid >> 7, col = tid & 127, n = chunk * 128 + col;
  const float* W = pin(p, 4) + (size_t)l * 1024 * 6144 + n;
  float a0 = 0.f, a1 = 0.f, a2 = 0.f;
#pragma unroll 32
  for (int k = kq * 256; k < kq * 256 + 256; ++k) {
    float w = W[(size_t)k * 6144];
    a0 += s[k] * w; a1 += s[1024 + k] * w; a2 += s[2048 + k] * w;
  }
  red[(kq * 3 + 0) * 128 + col] = a0;
  red[(kq * 3 + 1) * 128 + col] = a1;
  red[(kq * 3 + 2) * 128 + col] = a2;
  __syncthreads();
  if (tid < 384) {
    int g = tid >> 7, c2 = tid & 127, n2 = chunk * 128 + c2;
    float v = red[(0 * 3 + g) * 128 + c2] + red[(1 * 3 + g) * 128 + c2] + red[(2 * 3 + g) * 128 + c2] + red[(3 * 3 + g) * 128 + c2];
    ((float*)(p.ws + WS_MOD))[(size_t)(l * 3 + g) * 6144 + n2] = v + pin(p, 5)[l * 6144 + n2];
  }
  __syncthreads();
}

__device__ __forceinline__ void p0_hid_task(const Ctx& p, int task, char* smem) {
  float* zs = (float*)smem;
  float* h1 = zs + 8 * 36;
  float* w1s = h1 + 8 * 64;
  float* w2s = w1s + 33 * 64;
  const int tid = tid_l(), tl = tid >> 6, j = tid & 63;
  const int l = task / 132, r = task - l * 132;
  const bool isctx = r >= 128;
  const int L = isctx ? 256 : 8192;
  const int tbase = (isctx ? (r - 128) : r) * 64;
  for (int i = tid; i < 33 * 64; i += NT) w1s[i] = pin(p, 14)[l * 33 * 64 + i];
  for (int i = tid; i < 64 * 64; i += NT) w2s[i] = pin(p, 17)[l * 64 * 64 + i];
  const float b1 = pin(p, 15)[l * 64 + j], f1 = pin(p, 16)[l * 64 + j], b2 = pin(p, 18)[l * 64 + j], f2 = pin(p, 19)[l * 64 + j];
  __syncthreads();
  for (int sub = 0; sub < 8; ++sub) {
    const int t = tbase + sub * 8 + tl;
    if (j < 33) {
      float z;
      if (j == 0) z = (float)t / (float)(L - 1);
      else {
        int i = (j - 1) & 15;
        float band = 1e-4f + (float)i * ((15.f - 1e-4f) / 15.f);
        float omega = 6.2831855f * (float)t / (float)L;
        float a = omega * band;
        z = (j <= 16) ? cosf(a) : -sinf(a);
      }
      zs[tl * 36 + j] = z;
    }
    __syncthreads();
    {
      float a = b1;
#pragma unroll
      for (int k = 0; k < 33; ++k) a += zs[tl * 36 + k] * w1s[k * 64 + j];
      h1[tl * 64 + j] = sinf(f1 * a);
    }
    __syncthreads();
    {
      float a = b2;
#pragma unroll 16
      for (int k = 0; k < 64; ++k) a += h1[tl * 64 + k] * w2s[k * 64 + j];
      float v = sinf(f2 * a);
      if (isctx) ((float*)(p.ws + WS_HID2C))[((size_t)l * 64 + j) * 256 + t] = v;
      else ((u16*)(p.ws + WS_HID2))[((size_t)l * 8192 + t) * 64 + j] = f2bf(v);
    }
  }
  __syncthreads();
}

struct WtItem { const float* W; u16* WT; int K, N, k0, n0; };
__device__ __forceinline__ WtItem wt_decode(const Ctx& p, int l, int r) {
  char* wo = (char*)p.out;
  WtItem it;
  int nblk;
  if (r < 1472) { it.W = pin(p, 8) + (size_t)l * 1024 * DIN; it.K = 1024; it.N = DIN; it.WT = (u16*)(wo + WO_IN); nblk = 92; }
  else if ((r -= 1472) < 1024) { it.W = pin(p, 30) + (size_t)l * 1024 * 4096; it.K = 1024; it.N = 4096; it.WT = (u16*)(wo + WO_FF1); nblk = 64; }
  else if ((r -= 1024) < 1024) { it.W = pin(p, 31) + (size_t)l * 4096 * 1024; it.K = 4096; it.N = 1024; it.WT = (u16*)(wo + WO_FF2); nblk = 16; }
  else if ((r -= 1024) < 256) { it.W = pin(p, 29) + (size_t)l * 1024 * 1024; it.K = 1024; it.N = 1024; it.WT = (u16*)(wo + WO_OUT); nblk = 16; }
  else if ((r -= 256) < 128) { it.W = pin(p, 23) + (size_t)l * 512 * 1024; it.K = 512; it.N = 1024; it.WT = (u16*)(wo + WO_HY); nblk = 16; }
  else if ((r -= 128) < 128) { it.W = pin(p, 28) + (size_t)l * 512 * 1024; it.K = 512; it.N = 1024; it.WT = (u16*)(wo + WO_WO); nblk = 16; }
  else if ((r -= 128) < 72) { it.W = pin(p, 25) + (size_t)l * 384 * 768; it.K = 384; it.N = 768; it.WT = (u16*)(wo + WO_UQ); nblk = 12; }
  else { r -= 72; it.W = pin(p, 27) + (size_t)l * 256 * 1024; it.K = 256; it.N = 1024; it.WT = (u16*)(wo + WO_UKV); nblk = 16; }
  const int kb = r / nblk, nb2 = r - kb * nblk;
  it.k0 = kb * 64; it.n0 = nb2 * 64;
  return it;
}
__device__ __forceinline__ void wt_load(const WtItem& it, int tid, float (&v)[8]) {
  const int nn = tid & 63, kq = tid >> 6;
  const bool ok = it.n0 + nn < it.N;
  const float* src = it.W + (size_t)(it.k0 + kq) * it.N + it.n0 + (ok ? nn : 0);
#pragma unroll
  for (int r = 0; r < 8; ++r) { float x = src[(size_t)(r * 8) * it.N]; v[r] = ok ? x : 0.f; }
}
__device__ __forceinline__ void wt_phase(const Ctx& p, int l, char* smem) {
  float* tile = (float*)smem;
  const int tid = tid_l();
  const int bid = blockIdx.x, nb = gridDim.x;
  int t = bid;
  if (t >= 4168) return;
  WtItem cur = wt_decode(p, l, t);
  float v[8];
  wt_load(cur, tid, v);
#pragma unroll 1
  while (true) {
    const int tn = t + nb;
    const bool more = tn < 4168;
    WtItem nxt = cur;
    float vn[8];
    if (more) { nxt = wt_decode(p, l, tn); wt_load(nxt, tid, vn); }
#pragma unroll
    for (int r = 0; r < 8; ++r) tile[(r * 8 + (tid >> 6)) * 65 + (tid & 63)] = v[r];
    __syncthreads();
    {
      int n = tid >> 3, kc = (tid & 7) * 8;
      uint4 o;
      o.x = pk2(tile[(kc + 0) * 65 + n], tile[(kc + 1) * 65 + n]);
      o.y = pk2(tile[(kc + 2) * 65 + n], tile[(kc + 3) * 65 + n]);
      o.z = pk2(tile[(kc + 4) * 65 + n], tile[(kc + 5) * 65 + n]);
      o.w = pk2(tile[(kc + 6) * 65 + n], tile[(kc + 7) * 65 + n]);
      *(uint4*)(cur.WT + (size_t)(cur.n0 + n) * cur.K + cur.k0 + kc) = o;
    }
    __syncthreads();
    if (!more) break;
    cur = nxt;
#pragma unroll
    for (int r = 0; r < 8; ++r) v[r] = vn[r];
    t = tn;
  }
}

__device__ __forceinline__ void wpe_task(const Ctx& p, int l, int task, char* smem) {
  const int g = task >> 3, c0 = (task & 7) * 16, tid = tid_l();
  const float* pw = pin(p, 9) + ((size_t)(l * 4 + g) * 128) * 128;
  const float* sc = pin(p, 10) + l * 512 + g * 128;
  const float* po = pin(p, 11) + ((size_t)l * 512 + g * 128) * 1024;
  u16* WpeT = (u16*)(p.ws + WS_WPE) + (size_t)l * 1024 * 512;
  float* wl = (float*)smem;
  for (int i = tid; i < 16 * 128; i += NT) { int d = i & 127; wl[i] = pw[(c0 + (i >> 7)) * 128 + d] * sc[d]; }
  __syncthreads();
  float acc0[16], acc1[16];
#pragma unroll
  for (int i = 0; i < 16; ++i) { acc0[i] = 0.f; acc1[i] = 0.f; }
#pragma unroll 16
  for (int d = 0; d < 128; ++d) {
    float p0 = po[(size_t)d * 1024 + tid], p1 = po[(size_t)d * 1024 + 512 + tid];
#pragma unroll
    for (int i = 0; i < 16; ++i) { float w = wl[i * 128 + d]; acc0[i] += w * p0; acc1[i] += w * p1; }
  }
  uint4 o0, o1;
  o0.x = pk2(acc0[0], acc0[1]); o0.y = pk2(acc0[2], acc0[3]); o0.z = pk2(acc0[4], acc0[5]); o0.w = pk2(acc0[6], acc0[7]);
  o1.x = pk2(acc0[8], acc0[9]); o1.y = pk2(acc0[10], acc0[11]); o1.z = pk2(acc0[12], acc0[13]); o1.w = pk2(acc0[14], acc0[15]);
  uint4* dst = (uint4*)(WpeT + (size_t)tid * 512 + g * 128 + c0);
  dst[0] = o0; dst[1] = o1;
  o0.x = pk2(acc1[0], acc1[1]); o0.y = pk2(acc1[2], acc1[3]); o0.z = pk2(acc1[4], acc1[5]); o0.w = pk2(acc1[6], acc1[7]);
  o1.x = pk2(acc1[8], acc1[9]); o1.y = pk2(acc1[10], acc1[11]); o1.z = pk2(acc1[12], acc1[13]); o1.w = pk2(acc1[14], acc1[15]);
  dst = (uint4*)(WpeT + (size_t)(512 + tid) * 512 + g * 128 + c0);
  dst[0] = o0; dst[1] = o1;
  __syncthreads();
}

__device__ __forceinline__ void norm_rows(const Ctx& p, const float* gain, const float* modl, int sh_idx, int sc_idx, u16* outp) {
  const int tidx = tid_l(), lane = tidx & 63, gw = blockIdx.x * 8 + (tidx >> 6), ngw = gridDim.x * 8;
  const float* h = (const float*)(p.ws + WS_H);
  float4 g[4];
#pragma unroll
  for (int j = 0; j < 4; ++j) g[j] = *(const float4*)(gain + lane * 4 + 256 * j);
  for (int m0 = gw; m0 < MROWS; m0 += 2 * ngw) {
    const int m1 = m0 + ngw;
    const bool has1 = m1 < MROWS;
    const int m1c = has1 ? m1 : m0;
    const float4* hr0 = (const float4*)(h + (size_t)m0 * D) + lane;
    const float4* hr1 = (const float4*)(h + (size_t)m1c * D) + lane;
    float4 v0[4], v1[4];
#pragma unroll
    for (int j = 0; j < 4; ++j) { v0[j] = hr0[64 * j]; v1[j] = hr1[64 * j]; }
    const float* mg0 = modl + grp_of_row(m0) * 6144;
    const float* mg1 = modl + grp_of_row(m1c) * 6144;
    float s0 = 0.f, s1 = 0.f;
#pragma unroll
    for (int j = 0; j < 4; ++j) {
      s0 += v0[j].x * v0[j].x + v0[j].y * v0[j].y + v0[j].z * v0[j].z + v0[j].w * v0[j].w;
      s1 += v1[j].x * v1[j].x + v1[j].y * v1[j].y + v1[j].z * v1[j].z + v1[j].w * v1[j].w;
    }
    s0 = wave_sum(s0);
    s1 = wave_sum(s1);
    const float r0 = rsqrtf(s0 * (1.f / D) + EPS), r1 = rsqrtf(s1 * (1.f / D) + EPS);
    uint2* o0 = (uint2*)(outp + (size_t)m0 * D) + lane;
    uint2* o1 = (uint2*)(outp + (size_t)m1c * D) + lane;
#pragma unroll
    for (int j = 0; j < 4; ++j) {
      int n = lane * 4 + 256 * j;
      float4 sc = *(const float4*)(mg0 + sc_idx * 1024 + n), sh = *(const float4*)(mg0 + sh_idx * 1024 + n);
      uint2 o;
      o.x = pk2(v0[j].x * r0 * g[j].x * (1.f + sc.x) + sh.x, v0[j].y * r0 * g[j].y * (1.f + sc.y) + sh.y);
      o.y = pk2(v0[j].z * r0 * g[j].z * (1.f + sc.z) + sh.z, v0[j].w * r0 * g[j].w * (1.f + sc.w) + sh.w);
      o0[64 * j] = o;
    }
    if (has1) {
#pragma unroll
      for (int j = 0; j < 4; ++j) {
        int n = lane * 4 + 256 * j;
        float4 sc = *(const float4*)(mg1 + sc_idx * 1024 + n), sh = *(const float4*)(mg1 + sh_idx * 1024 + n);
        uint2 o;
        o.x = pk2(v1[j].x * r1 * g[j].x * (1.f + sc.x) + sh.x, v1[j].y * r1 * g[j].y * (1.f + sc.y) + sh.y);
        o.y = pk2(v1[j].z * r1 * g[j].z * (1.f + sc.z) + sh.z, v1[j].w * r1 * g[j].w * (1.f + sc.w) + sh.w);
        o1[64 * j] = o;
      }
    }
  }
}

__device__ __forceinline__ void final_norm(const Ctx& p) {
  const int tidx = tid_l(), lane = tidx & 63, gw = blockIdx.x * 8 + (tidx >> 6), ngw = gridDim.x * 8;
  const float* h = (const float*)(p.ws + WS_H);
  const float* gain = pin(p, 32);
  for (int r0 = gw; r0 < 2 * SEQ; r0 += ngw) {
    int b = r0 >> 13, t = r0 & 8191, m = b * SP + CTX + t;
    const float4* hr = (const float4*)(h + (size_t)m * D) + lane;
    float4 v[4];
    float ss = 0.f;
#pragma unroll
    for (int j = 0; j < 4; ++j) { v[j] = hr[64 * j]; ss += v[j].x * v[j].x + v[j].y * v[j].y + v[j].z * v[j].z + v[j].w * v[j].w; }
    ss = wave_sum(ss);
    float r = rsqrtf(ss * (1.f / D) + EPS);
    float4* o = (float4*)(p.out + (size_t)r0 * D) + lane;
#pragma unroll
    for (int j = 0; j < 4; ++j) {
      float4 g = *(const float4*)(gain + lane * 4 + 256 * j);
      o[64 * j] = make_float4(v[j].x * r * g.x, v[j].y * r * g.y, v[j].z * r * g.z, v[j].w * r * g.w);
    }
  }
}

__device__ __forceinline__ void premix_task(const Ctx& p, int l, int task, char* smem) {
  const int tid = tid_l(), lane = tid & 63, wid = tid >> 6;
  const int part = task / 264, tile64 = task - part * 264;
  const int m0 = tile64 * 64, b = m0 / SP, pos0 = m0 - b * SP;
  const bool isctx = pos0 < CTX;
  const int s0 = isctx ? 0 : CTX, L = isctx ? CTX : SEQ, t0 = pos0 - s0;
  const size_t mb = (size_t)b * SP + s0;
  const u16* proj = (const u16*)(p.ws + WS_PROJ);
  if (part == 0) {
    u16* P = (u16*)smem;
#pragma unroll
    for (int i = tid; i < 80 * 64; i += NT) {
      int r = i >> 6, ch = i & 63, t = t0 - 8 + r;
      uint4 v = make_uint4(0, 0, 0, 0);
      if (t >= 0 && t < L) v = *(const uint4*)(proj + (mb + t) * DINP + ch * 8);
      *(uint4*)(P + r * 512 + ch * 8) = v;
    }
    __syncthreads();
    const int c = tid, g = c >> 7, hw = 1 << g;
    u16* U = (u16*)(p.ws + WS_U);
    float s = 0.f;
    for (int q = -hw; q < hw; ++q) s += bf2f(P[(8 + q) * 512 + c]);
#pragma unroll 4
    for (int tt = 0; tt < 64; ++tt) {
      int t = t0 + tt, lo = max(t - hw, 0), hi = min(t + hw, L);
      float u = s / (float)(hi - lo) - bf2f(P[(tt + 8) * 512 + c]);
      U[(mb + t) * 512 + c] = f2bf(u);
      s += bf2f(P[(tt + 8 + hw) * 512 + c]) - bf2f(P[(tt + 8 - hw) * 512 + c]);
    }
    __syncthreads();
  } else if (part <= 4) {
    const int ch0 = (part - 1) * 128;
    constexpr int PITCH = 136;
    u16* X = (u16*)smem;
    float* T = (float*)(smem + 3 * 66 * PITCH * 2 + 64);
#pragma unroll
    for (int ii = 0; ii < 7; ++ii) {
      const int i = tid + ii * NT;
      if (i >= 3 * 66 * 16) break;
      int pr = i / (66 * 16), rem = i - pr * 66 * 16, r = rem >> 4, ch = rem & 15, t = t0 - 1 + r;
      uint4 v = make_uint4(0, 0, 0, 0);
      if (t >= 0 && t < L) v = *(const uint4*)(proj + (mb + t) * DINP + OFF_HY + pr * 512 + ch0 + ch * 8);
      *(uint4*)(X + (pr * 66 + r) * PITCH + ch * 8) = v;
    }
    __syncthreads();
    const float* cw = pin(p, 12) + l * 3 * 1536;
    const float* cb = pin(p, 13) + l * 1536;
    {
      const int c = tid & 127, tq = tid >> 7, col = ch0 + c;
      const float w00 = cw[col], w01 = cw[1536 + col], w02 = cw[3072 + col], b0 = cb[col];
      const float w10 = cw[512 + col], w11 = cw[1536 + 512 + col], w12 = cw[3072 + 512 + col], b1 = cb[512 + col];
      const float w20 = cw[1024 + col], w21 = cw[1536 + 1024 + col], w22 = cw[3072 + 1024 + col], b2 = cb[1024 + col];
      const u16* X0 = X, *X1 = X + 66 * PITCH, *XV = X + 2 * 66 * PITCH;
      u16* Y = (u16*)(p.ws + WS_Y);
#pragma unroll 4
      for (int tt = tq * 16; tt < tq * 16 + 16; ++tt) {
        float x0 = w00 * bf2f(X0[tt * PITCH + c]) + w01 * bf2f(X0[(tt + 1) * PITCH + c]) + w02 * bf2f(X0[(tt + 2) * PITCH + c]) + b0;
        float x1 = w10 * bf2f(X1[tt * PITCH + c]) + w11 * bf2f(X1[(tt + 1) * PITCH + c]) + w12 * bf2f(X1[(tt + 2) * PITCH + c]) + b1;
        float vv = w20 * bf2f(XV[tt * PITCH + c]) + w21 * bf2f(XV[(tt + 1) * PITCH + c]) + w22 * bf2f(XV[(tt + 2) * PITCH + c]) + b2;
        Y[(mb + t0 + tt) * 512 + col] = f2bf(x0);
        T[c * 65 + tt] = x1 * vv;
      }
    }
    __syncthreads();
    {
      float* ZV = (float*)(p.ws + WS_ZV);
#pragma unroll 4
      for (int cc = 0; cc < 16; ++cc) {
        int c = wid * 16 + cc;
        ZV[((size_t)(ch0 + c) * SP + pos0 + lane) * 2 + b] = T[c * 65 + lane];
      }
    }
    __syncthreads();
  } else {
    u16* projw = (u16*)(p.ws + WS_PROJ);
    const float* qg = pin(p, 24) + l * 384;
    const float* kg = pin(p, 26) + l * 256;
    const float2* rope = (const float2*)(p.ws + WS_ROPE);
    u16* Kb = (u16*)(p.ws + WS_K);
#pragma unroll 2
    for (int rr = 0; rr < 8; ++rr) {
      int tt = wid * 8 + rr, pos = pos0 + tt;
      u16* row = projw + ((size_t)b * SP + pos) * DINP;
      unsigned* q32 = (unsigned*)(row + OFF_Q);
      unsigned* k32 = (unsigned*)(row + OFF_KV);
      unsigned v[3], w[2];
      float ss = 0.f, s2 = 0.f;
#pragma unroll
      for (int j = 0; j < 3; ++j) v[j] = q32[lane + 64 * j];
#pragma unroll
      for (int j = 0; j < 2; ++j) w[j] = k32[lane + 64 * j];
      const int rd = lane & 31;
      float val = bf2f(row[OFF_KV + 256 + rd]);
#pragma unroll
      for (int j = 0; j < 3; ++j) { float a = bf2f(v[j] & 0xffff), c2 = bf2f(v[j] >> 16); ss += a * a + c2 * c2; }
#pragma unroll
      for (int j = 0; j < 2; ++j) { float a = bf2f(w[j] & 0xffff), c2 = bf2f(w[j] >> 16); s2 += a * a + c2 * c2; }
      ss = wave_sum(ss);
      s2 = wave_sum(s2);
      float r = rsqrtf(ss * (1.f / 384.f) + EPS), r2 = rsqrtf(s2 * (1.f / 256.f) + EPS);
#pragma unroll
      for (int j = 0; j < 3; ++j) {
        int n = (lane + 64 * j) * 2;
        q32[lane + 64 * j] = pk2(bf2f(v[j] & 0xffff) * r * qg[n], bf2f(v[j] >> 16) * r * qg[n + 1]);
      }
#pragma unroll
      for (int j = 0; j < 2; ++j) {
        int n = (lane + 64 * j) * 2;
        k32[lane + 64 * j] = pk2(bf2f(w[j] & 0xffff) * r2 * kg[n], bf2f(w[j] >> 16) * r2 * kg[n + 1]);
      }
      float partner = shx(val, 8);
      if (!isctx) {
        int t = pos - CTX, idx = (rd < 16) ? (t >> 6) : (t & 63);
        float2 cs = rope[idx * 8 + (rd & 7)];
        float sgn = (rd & 8) ? 1.f : -1.f;
        val = val * cs.x + sgn * partner * cs.y;
      }
      if (lane < 32) {
        u16 o = f2bf(val);
#pragma unroll
        for (int hd = 0; hd < 8; ++hd) Kb[((size_t)(b * 8 + hd) * SP + pos) * 96 + 64 + rd] = o;
      }
    }
  }
}

__device__ __forceinline__ int xi(int i) { const int h = i >> 5; return i ^ (((h & 3) * 5) | ((h & 2) << 3)); }
__device__ __forceinline__ void bf_fwd(float2* X, int base, int q, float2 w1) {
  float2 w2 = cmul(w1, w1), w3 = cmul(w2, w1);
  const int i0 = xi(base), i1 = xi(base + q), i2 = xi(base + 2 * q), i3 = xi(base + 3 * q);
  float2 a0 = X[i0], a1 = X[i1], a2 = X[i2], a3 = X[i3];
  float2 s02 = make_float2(a0.x + a2.x, a0.y + a2.y), d02 = make_float2(a0.x - a2.x, a0.y - a2.y);
  float2 s13 = make_float2(a1.x + a3.x, a1.y + a3.y), d13 = make_float2(a1.x - a3.x, a1.y - a3.y);
  X[i0] = make_float2(s02.x + s13.x, s02.y + s13.y);
  X[i1] = cmul(make_float2(d02.x + d13.y, d02.y - d13.x), w1);
  X[i2] = cmul(make_float2(s02.x - s13.x, s02.y - s13.y), w2);
  X[i3] = cmul(make_float2(d02.x - d13.y, d02.y + d13.x), w3);
}
__device__ __forceinline__ void bf_inv(float2* X, int base, int q, float2 w1) {
  w1.y = -w1.y;
  float2 w2 = cmul(w1, w1), w3 = cmul(w2, w1);
  const int i0 = xi(base), i1 = xi(base + q), i2 = xi(base + 2 * q), i3 = xi(base + 3 * q);
  float2 b0 = X[i0], c1 = cmul(X[i1], w1), c2 = cmul(X[i2], w2), c3 = cmul(X[i3], w3);
  float2 s02 = make_float2(b0.x + c2.x, b0.y + c2.y), d02 = make_float2(b0.x - c2.x, b0.y - c2.y);
  float2 s13 = make_float2(c1.x + c3.x, c1.y + c3.y), d13 = make_float2(c1.x - c3.x, c1.y - c3.y);
  X[i0] = make_float2(s02.x + s13.x, s02.y + s13.y);
  X[i1] = make_float2(d02.x - d13.y, d02.y + d13.x);
  X[i2] = make_float2(s02.x - s13.x, s02.y - s13.y);
  X[i3] = make_float2(d02.x + d13.y, d02.y - d13.x);
}
template <bool INV, int LQ>
__device__ __forceinline__ void fft_pass(float2* X, const float2* __restrict__ tw, const float2 (&twr)[6], int tid) {
  constexpr int q = 1 << LQ;
  if (LQ == 12) {
    float2 w[8];
#pragma unroll
    for (int b8 = 0; b8 < 8; ++b8) w[b8] = tw[b8 * NT + tid];
#pragma unroll
    for (int b8 = 0; b8 < 8; ++b8) { int u = b8 * NT + tid; if (INV) bf_inv(X, u, q, w[b8]); else bf_fwd(X, u, q, w[b8]); }
  } else if (LQ == 10) {
#pragma unroll 2
    for (int b8 = 0; b8 < 8; ++b8) {
      int u = b8 * NT + tid, j = u & 1023, base = ((u >> 10) << 12) + j;
      float2 w = (b8 & 1) ? twr[1] : twr[0];
      if (INV) bf_inv(X, base, q, w); else bf_fwd(X, base, q, w);
    }
  } else {
    const int j = tid & (q - 1);
    const float2 w = (LQ == 0) ? make_float2(1.f, 0.f) : twr[2 + (8 - LQ) / 2];
#pragma unroll 2
    for (int b8 = 0; b8 < 8; ++b8) {
      int u = b8 * NT + tid, base = ((u >> LQ) << (LQ + 2)) + j;
      if (INV) bf_inv(X, base, q, w); else bf_fwd(X, base, q, w);
    }
  }
  __syncthreads();
}
__device__ __forceinline__ void fft_load_tw(const float2* __restrict__ tw, int tid, float2 (&twr)[6]) {
  twr[0] = tw[tid << 2];
  twr[1] = tw[(512 + tid) << 2];
  twr[2] = tw[(tid & 255) << 4];
  twr[3] = tw[(tid & 63) << 6];
  twr[4] = tw[(tid & 15) << 8];
  twr[5] = tw[(tid & 3) << 10];
}
__device__ __forceinline__ void fft_dif(float2* X, const float2* __restrict__ tw, const float2 (&twr)[6]) {
  const int tid = tid_l();
  fft_pass<false, 12>(X, tw, twr, tid); fft_pass<false, 10>(X, tw, twr, tid); fft_pass<false, 8>(X, tw, twr, tid); fft_pass<false, 6>(X, tw, twr, tid);
  fft_pass<false, 4>(X, tw, twr, tid); fft_pass<false, 2>(X, tw, twr, tid); fft_pass<false, 0>(X, tw, twr, tid);
}
__device__ __forceinline__ void fft_dit_inv(float2* X, const float2* __restrict__ tw, const float2 (&twr)[6]) {
  const int tid = tid_l();
  fft_pass<true, 0>(X, tw, twr, tid); fft_pass<true, 2>(X, tw, twr, tid); fft_pass<true, 4>(X, tw, twr, tid); fft_pass<true, 6>(X, tw, twr, tid);
  fft_pass<true, 8>(X, tw, twr, tid); fft_pass<true, 10>(X, tw, twr, tid); fft_pass<true, 12>(X, tw, twr, tid);
}
__device__ __forceinline__ float block_sum(float v, float* red) {
  v = wave_sum(v);
  __syncthreads();
  { const int tb = tid_l(); if ((tb & 63) == 0) red[tb >> 6] = v; }
  __syncthreads();
  float s = red[0] + red[1] + red[2] + red[3] + red[4] + red[5] + red[6] + red[7];
  __syncthreads();
  return s;
}

__device__ __forceinline__ void fft_task(const Ctx& p, int l, int c, char* smem) {
  float2* X = (float2*)smem;
  float* aux = (float*)(smem + AUX_OFF);
  float* red = aux + 128;
  const int tid = tid_l();
  const float2* tw = (const float2*)(p.ws + WS_TW);
  float2 twr[6];
  fft_load_tw(tw, tid, twr);
  const float* w3 = pin(p, 20) + (size_t)l * 64 * 1024;
  if (tid < 64) { aux[tid] = w3[tid * 1024 + c]; aux[64 + tid] = w3[tid * 1024 + 512 + c]; }
  __syncthreads();
  const float dF = fabsf(pin(p, 21)[(l * 2 + 0) * 512 + c]), dB = fabsf(pin(p, 21)[(l * 2 + 1) * 512 + c]);
  const float bias = pin(p, 22)[l * 512 + c];
  float2* zp = (float2*)(p.ws + WS_ZV) + (size_t)c * SP;
  float l1 = 0.f;
  {
    const u16* ff = (const u16*)((const char*)p.out + WO_FILT) + (size_t)c * 8192 + tid;
    const u16* fb = ff + (size_t)512 * 8192;
    u16 rf[16], rb[16];
#pragma unroll
    for (int i = 0; i < 16; ++i) { rf[i] = ff[i * NT]; rb[i] = fb[i * NT]; }
#pragma unroll
    for (int i = 0; i < 16; ++i) {
      int t = i * NT + tid;
      float tl = (float)t * (1.f / 8191.f);
      float hf = bf2f(rf[i]) * expf(-tl * dF);
      float hb = bf2f(rb[i]) * expf(-tl * dB);
      X[xi(t)] = make_float2(hf, 0.f);
      if (t >= 1) { X[xi(16384 - t)] = make_float2(hb, 0.f); l1 += fabsf(hf) + fabsf(hb); }
      else { X[xi(8192)] = make_float2(0.f, 0.f); l1 += fabsf(hf); }
    }
  }
  float l1tot = block_sum(l1, red);
  fft_dif(X, tw, twr);
  float2 F[32];
  {
    float s = 1.f / (l1tot * 16384.f);
#pragma unroll
    for (int i = 0; i < 32; ++i) { float2 v = X[xi(i * NT + tid)]; F[i] = make_float2(v.x * s, v.y * s); }
  }
  __syncthreads();
#pragma unroll 8
  for (int i = 0; i < 16; ++i) {
    int t = i * NT + tid;
    X[xi(t)] = zp[CTX + t];
    X[xi(8192 + t)] = make_float2(0.f, 0.f);
  }
  __syncthreads();
  fft_dif(X, tw, twr);
#pragma unroll
  for (int i = 0; i < 32; ++i) { int idx = xi(i * NT + tid); X[idx] = cmul(X[idx], F[i]); }
  __syncthreads();
  fft_dit_inv(X, tw, twr);
  {
    float2 zz[16];
#pragma unroll
    for (int i = 0; i < 16; ++i) zz[i] = zp[CTX + i * NT + tid];
#pragma unroll
    for (int i = 0; i < 16; ++i) {
      int t = i * NT + tid;
      float2 y = X[xi(t)];
      zp[CTX + t] = make_float2(y.x + bias * zz[i].x, y.y + bias * zz[i].y);
    }
  }
  __syncthreads();
  {
    float* hFc = (float*)smem;
    float* hBc = hFc + 256;
    float2* zc = (float2*)(hBc + 256);
    float l1c = 0.f;
    if (tid < 256) {
      int t = tid;
      const float* hc = (const float*)(p.ws + WS_HID2C) + (size_t)l * 64 * 256 + t;
      float hf = 0.f, hb = 0.f;
#pragma unroll 16
      for (int k = 0; k < 64; ++k) { float v = hc[k * 256]; hf += v * aux[k]; hb += v * aux[64 + k]; }
      float tl = (float)t * (1.f / 255.f);
      hf *= expf(-tl * dF);
      hb *= expf(-tl * dB);
      hFc[t] = hf;
      hBc[t] = hb;
      l1c = fabsf(hf) + (t >= 1 ? fabsf(hb) : 0.f);
      zc[t] = zp[t];
    }
    float l1ct = block_sum(l1c, red);
    const int bb = tid >> 8, t = tid & 255;
    float acc = 0.f;
    for (int s = 0; s < 256; ++s) {
      float kf = (s <= t) ? hFc[t - s] : hBc[s - t];
      float2 z = zc[s];
      acc += kf * (bb ? z.y : z.x);
    }
    float2 z = zc[t];
    ((float*)zp)[t * 2 + bb] = acc / l1ct + bias * (bb ? z.y : z.x);
    __syncthreads();
  }
}

constexpr int AT_KT = 128, AT_KP = 208, AT_VP = 264, AT_STAGE = AT_KT * AT_KP + 64 * AT_VP;
__device__ __forceinline__ void attn_task(const Ctx& p, int bh, int qb, char* smem) {
  const int tid = tid_l(), wid = tid >> 6, lane = tid & 63, r = lane & 31, hh = lane >> 5;
  const u16* Qp = (const u16*)(p.ws + WS_Q) + ((size_t)bh * SP + qb * 256) * 96;
  const u16* Kp = (const u16*)(p.ws + WS_K) + (size_t)bh * SP * 96;
  const u16* Vp = (const u16*)(p.ws + WS_VT) + (size_t)bh * 64 * SP;
  const int nkt = (qb == 0) ? 2 : 66;
  bf16x8 qf[6];
#pragma unroll
  for (int ks = 0; ks < 6; ++ks) qf[ks] = *(const bf16x8*)(Qp + (size_t)(wid * 32 + r) * 96 + ks * 16 + hh * 8);
  f32x16 o0, o1;
#pragma unroll
  for (int i = 0; i < 16; ++i) { o0[i] = 0.f; o1[i] = 0.f; }
  float mrun = 0.f, lrun = 0.f;
  const u16* src[5];
  int dst[5];
#pragma unroll
  for (int i = 0; i < 5; ++i) {
    int ch = tid + i * NT;
    if (i < 3) { int row = ch / 12, cc = ch - row * 12; src[i] = Kp + (size_t)row * 96 + cc * 8; dst[i] = row * AT_KP + cc * 16; }
    else { int v = ch - 1536, row = v >> 4, cc = v & 15; src[i] = Vp + (size_t)row * SP + cc * 8; dst[i] = AT_KT * AT_KP + row * AT_VP + cc * 16; }
  }
  uint4 st[5];
#define AT_LOAD(t)                                                                                   \
  do {                                                                                               \
    _Pragma("unroll") for (int i = 0; i < 5; ++i) st[i] = *(const uint4*)(src[i] + (size_t)(t) * (i < 3 ? AT_KT * 96 : AT_KT)); \
  } while (0)
#define AT_WRITE(buf)                                                                                \
  do {                                                                                               \
    char* base_ = smem + (buf) * AT_STAGE;                                                           \
    _Pragma("unroll") for (int i = 0; i < 5; ++i) {                                                  \
      uint2* d_ = (uint2*)(base_ + dst[i]);                                                          \
      d_[0] = make_uint2(st[i].x, st[i].y);                                                          \
      d_[1] = make_uint2(st[i].z, st[i].w);                                                          \
    }                                                                                                \
  } while (0)
#define AT_QK(S, kb)                                                                                 \
  __builtin_amdgcn_s_setprio(1);                                                                     \
  _Pragma("unroll") for (int ks = 0; ks < 6; ++ks) {                                                 \
    bf16x8 a_ = *(const bf16x8*)(Ks + ((kb) * 32 + r) * AT_KP + ks * 32 + hh * 16);                  \
    S = __builtin_amdgcn_mfma_f32_32x32x16_bf16(a_, qf[ks], S, 0, 0, 0);                             \
  }                                                                                                  \
  __builtin_amdgcn_s_setprio(0);
#define AT_SOFT_PV(S, kb)                                                                            \
  _Pragma("unroll") for (int i = 0; i < 16; ++i) { S[i] = __builtin_amdgcn_exp2f(S[i]); ps += S[i]; pmx = fmaxf(pmx, S[i]); } \
  _Pragma("unroll") for (int sI = 0; sI < 2; ++sI) {                                                 \
    union { bf16x8 v; unsigned u[4]; } pu;                                                           \
    _Pragma("unroll") for (int j = 0; j < 4; ++j) pu.u[j] = pk2(S[8 * sI + 2 * j], S[8 * sI + 2 * j + 1]); \
    const int koff = ((kb) * 32 + 16 * sI + 4 * hh) * 2;                                             \
    union { bf16x8 v; uint2 h2[2]; } va, vb;                                                         \
    va.h2[0] = *(const uint2*)(Vs + r * AT_VP + koff);                                               \
    va.h2[1] = *(const uint2*)(Vs + r * AT_VP + koff + 16);                                          \
    vb.h2[0] = *(const uint2*)(Vs + (32 + r) * AT_VP + koff);                                        \
    vb.h2[1] = *(const uint2*)(Vs + (32 + r) * AT_VP + koff + 16);                                   \
    o0 = __builtin_amdgcn_mfma_f32_32x32x16_bf16(va.v, pu.v, o0, 0, 0, 0);                           \
    o1 = __builtin_amdgcn_mfma_f32_32x32x16_bf16(vb.v, pu.v, o1, 0, 0, 0);                           \
  }
  AT_LOAD(0);
  AT_WRITE(0);
  __syncthreads();
  for (int t = 0; t < nkt; ++t) {
    const int cur = t & 1;
    if (t + 1 < nkt) AT_LOAD(t + 1);
    const char* Ks = smem + cur * AT_STAGE;
    const char* Vs = Ks + AT_KT * AT_KP;
    const float nm = -mrun;
    f32x16 sA, sB;
    float ps = 0.f, pmx = 0.f;
#pragma unroll
    for (int i = 0; i < 16; ++i) sA[i] = nm;
    AT_QK(sA, 0)
#pragma unroll
    for (int i = 0; i < 16; ++i) sB[i] = nm;
    AT_QK(sB, 1)
    AT_SOFT_PV(sA, 0)
#pragma unroll
    for (int i = 0; i < 16; ++i) sA[i] = nm;
    AT_QK(sA, 2)
    AT_SOFT_PV(sB, 1)
#pragma unroll
    for (int i = 0; i < 16; ++i) sB[i] = nm;
    AT_QK(sB, 3)
    AT_SOFT_PV(sA, 2)
    AT_SOFT_PV(sB, 3)
    lrun += ps;
    pmx = fmaxf(pmx, shx(pmx, 32));
    if (__any(pmx > 256.f)) {
      const float delta = pmx > 256.f ? ceilf(__log2f(pmx)) : 0.f;
      const float alpha = __builtin_amdgcn_exp2f(-delta);
      mrun += delta;
      lrun *= alpha;
#pragma unroll
      for (int i = 0; i < 16; ++i) { o0[i] *= alpha; o1[i] *= alpha; }
    }
    if (t + 1 < nkt) AT_WRITE(cur ^ 1);
    __syncthreads();
  }
  const float ltot = lrun + shx(lrun, 32);
  const float inv = 1.f / ltot;
  const int b = bh >> 3, head = bh & 7;
  u16* Op = (u16*)(p.ws + WS_O) + ((size_t)b * SP + qb * 256 + wid * 32 + r) * 512 + head * 64;
#pragma unroll
  for (int g = 0; g < 4; ++g) {
    uint2 w0, w1;
    w0.x = pk2(o0[4 * g] * inv, o0[4 * g + 1] * inv);
    w0.y = pk2(o0[4 * g + 2] * inv, o0[4 * g + 3] * inv);
    w1.x = pk2(o1[4 * g] * inv, o1[4 * g + 1] * inv);
    w1.y = pk2(o1[4 * g + 2] * inv, o1[4 * g + 3] * inv);
    *(uint2*)(Op + 8 * g + 4 * hh) = w0;
    *(uint2*)(Op + 32 + 8 * g + 4 * hh) = w1;
  }
#undef AT_LOAD
#undef AT_WRITE
#undef AT_QK
#undef AT_SOFT_PV
}

__device__ __forceinline__ void hypost_task(const Ctx& p, int task, char* smem) {
  const int tid = tid_l(), lane = tid & 63, wid = tid >> 6;
  const int tile64 = task >> 1, ch0 = (task & 1) * 256;
  const int m0 = tile64 * 64, b = m0 / SP, pos0 = m0 - b * SP;
  float* T = (float*)smem;
  const float* ZV = (const float*)(p.ws + WS_ZV);
#pragma unroll 8
  for (int cc = 0; cc < 32; ++cc) {
    int c = wid * 32 + cc;
    T[c * 65 + lane] = ZV[((size_t)(ch0 + c) * SP + pos0 + lane) * 2 + b];
  }
  __syncthreads();
  u16* Y = (u16*)(p.ws + WS_Y);
  const int c = tid & 255, th = tid >> 8;
  u16* yp = Y + (size_t)(m0 + th * 32) * 512 + ch0 + c;
  u16 yv[32];
#pragma unroll
  for (int i = 0; i < 32; ++i) yv[i] = yp[(size_t)i * 512];
#pragma unroll
  for (int i = 0; i < 32; ++i) yp[(size_t)i * 512] = f2bf(bf2f(yv[i]) * T[c * 65 + th * 32 + i]);
  __syncthreads();
}

#ifndef PHMASK
#define PHMASK 0xFFFF
#endif
#define PHON(k) (((PHMASK) >> (k)) & 1)
constexpr int NPH = 1 + 4 * 10 + 1;
__global__ void __launch_bounds__(NT, 2) mega(Params prm) {
  __shared__ __attribute__((aligned(1024))) char smem[LDS_BYTES];
  cg::grid_group grid = cg::this_grid();
  const int bid = blockIdx.x, nb = gridDim.x;
  {
    unsigned long long* it = (unsigned long long*)(smem + AUX_OFF + 6144);
    if (threadIdx.x < 33) it[threadIdx.x] = (unsigned long long)prm.in[threadIdx.x];
    __syncthreads();
  }
  if (prm.ph_lo == 0) {
    Ctx p;
    p.intab = (const unsigned long long*)(smem + AUX_OFF + 6144);
    p.ws = prm.ws;
    p.out = prm.out;
    const int bid = blockIdx.x, nb = gridDim.x;
      if (PHON(10)) {
      p0_misc(p);
      for (int t = bid; t < 192; t += nb) p0_mod_task(p, t, smem);
      for (int t = bid; t < 528; t += nb) p0_hid_task(p, t, smem);
      for (int t = bid; t < 128; t += nb) { const int w = (t + 64) & 127; wpe_task(p, w >> 5, w & 31, smem); }
      }
  }
  unsigned nbar = 0;
  for (int ph = prm.ph_lo; ph < prm.ph_hi; ++ph) {
    Ctx p;
    p.intab = (const unsigned long long*)(smem + AUX_OFF + 6144);
    p.ws = prm.ws;
    p.out = prm.out;
    asm volatile("" : "+s"(p.ws), "+s"(p.out));
    float* modall = (float*)(p.ws + WS_MOD);
    u16* proj = (u16*)(p.ws + WS_PROJ);
    u16* xn = (u16*)(p.ws + WS_U);
    char* wo = (char*)p.out;
    if (ph == 0) {
    } else if (ph == NPH - 1) {
      if (PHON(11)) final_norm(p);
    } else {
      const int l = (ph - 1) / 10, sp = (ph - 1) % 10;
      const float* modl = modall + (size_t)l * 3 * 6144;
      GD* tab = (GD*)(smem + AUX_OFF + 4096);
      int ng = 0, nN0 = 0, nN1 = 0, nsplit = 1;
      bool seq = false;
      const float* gate = modl;
      if (sp == 0 && PHON(0)) {
        wt_phase(p, l, smem);
        norm_rows(p, pin(p, 6) + l * 1024, modl, 0, 1, xn);
      } else if (sp == 1 && PHON(1)) {
        if (threadIdx.x == 0) tab[0] = GD{xn, 1024, (const u16*)(wo + WO_IN), 1024, 1024, 23, EM_PROJ, 1};
        ng = 1; nN0 = 23;
      } else if (sp == 2 && PHON(2)) {
        for (int t = bid; t < 264 * 6; t += nb) premix_task(p, l, t, smem);
        {
          Epi ef{EM_FILT, p.ws, gate, nullptr, (u16*)(wo + WO_FILT)};
          const u16* hA = (const u16*)(p.ws + WS_HID2) + (size_t)l * 8192 * 64;
          const u16* wB = (const u16*)(p.ws + WS_W3T) + (size_t)l * 1024 * 64;
#pragma unroll 1
          for (int t = nb - 1 - bid; t < 128; t += nb) gemm_tile(hA, 64, wB, 64, 64, (t >> 2) * 256, (t & 3) * 256, smem, ef);
        }
      } else if (sp == 3 && PHON(3)) {
        for (int t = bid; t < 512; t += nb) fft_task(p, l, t, smem);
        if (threadIdx.x == 0) {
          tab[0] = GD{proj + OFF_Q, DINP, (const u16*)(wo + WO_UQ), 384, 384, 3, EM_Q, 1};
          tab[1] = GD{proj + OFF_KV, DINP, (const u16*)(wo + WO_UKV), 256, 256, 4, EM_KV, 1};
        }
        ng = 2; nN0 = 3; nN1 = 4;
        for (int i = tid_l(); i < 1024; i += NT) ((float2*)(smem + 131072))[i] = ((const float2*)(p.ws + WS_ROPE))[i];
      } else if (sp == 4 && PHON(4)) {
        for (int t = bid; t < 528; t += nb) {
          int bh, qb;
          if (t < 512) { int rnd = t >> 8, w = t & 255; bh = (w & 7) + 8 * rnd; qb = 1 + (w >> 3); }
          else { bh = t - 512; qb = 0; }
          attn_task(p, bh, qb, smem);
        }
        for (int t = bid; t < 528; t += nb) hypost_task(p, t, smem);
      } else if (sp == 5 && PHON(5)) {
        for (int t = bid; t < 8 * 68; t += nb) {
          const int x = t & 7, g = t >> 3, pm = (g >> 2) * 8 + x;
          if (pm < 132) mix_tile(p, l, pm, g & 3, smem);
        }
      } else if (sp == 6 && PHON(6)) {
        if (threadIdx.x == 0) tab[0] = GD{(const u16*)(p.ws + WS_ZV), 1024, (const u16*)(wo + WO_OUT), 1024, 1024, 4, EM_RESID, 4};
        ng = 1; nN0 = 4; nsplit = 4;
        gate = modl + 2 * 1024;
      } else if (sp == 7 && PHON(7)) {
        norm_rows(p, pin(p, 7) + l * 1024, modl, 3, 4, xn);
      } else if (sp == 8 && PHON(8)) {
        if (threadIdx.x == 0) tab[0] = GD{xn, 1024, (const u16*)(wo + WO_FF1), 1024, 1024, 16, EM_SQRELU, 1};
        ng = 1; nN0 = 16;
      } else if (sp == 9 && PHON(9)) {
        if (threadIdx.x == 0) tab[0] = GD{proj, DFF, (const u16*)(wo + WO_FF2), 4096, 4096, 4, EM_RESID, 8};
        ng = 1; nN0 = 4; nsplit = 8;
        gate = modl + 5 * 1024;
      }
      if (ng > 0) {
        __syncthreads();
        const int nt0 = (nsplit > 1) ? (64 * nN0 + 2 * nN0 * nsplit) : NMT * nN0, ntot = seq ? nt0 : nt0 + NMT * nN1;
        const int nseq = seq ? ng : 1;
        const int nitems = ((ntot - bid + nb - 1) / nb) * nseq;
#pragma unroll 1
        for (int it = 0; it < nitems; ++it) {
          int t = bid + (it / nseq) * nb, gi = it % nseq, tt = t;
          if (!seq && t >= nt0) { gi = 1; tt = t - nt0; }
          const volatile GD* gp = tab + gi;
          unsigned long long a64 = (unsigned long long)gp->A, b64 = (unsigned long long)gp->Bt;
          a64 = ((unsigned long long)(unsigned)__builtin_amdgcn_readfirstlane((unsigned)(a64 >> 32)) << 32) | (unsigned long long)(unsigned)__builtin_amdgcn_readfirstlane((unsigned)a64);
          b64 = ((unsigned long long)(unsigned)__builtin_amdgcn_readfirstlane((unsigned)(b64 >> 32)) << 32) | (unsigned long long)(unsigned)__builtin_amdgcn_readfirstlane((unsigned)b64);
          const int lda = __builtin_amdgcn_readfirstlane(gp->lda), ldb = __builtin_amdgcn_readfirstlane(gp->ldb);
          const int K = __builtin_amdgcn_readfirstlane(gp->K), nN = __builtin_amdgcn_readfirstlane(gp->nN);
          const int ks = __builtin_amdgcn_readfirstlane(gp->ks);
          const int mode = __builtin_amdgcn_readfirstlane(gp->mode);
          int pm, pn, Kuse = K, emode = mode;
          if (ks > 1) {
            const int nlat = 64 * nN;
            if (tt < nlat) { int pm64; tile_map(tt, 64, nN, pm64, pn); pm = (pm64 >> 5) * 33 + 1 + (pm64 & 31); }
            else {
              int u = tt - nlat, kp = u % ks, tile = u / ks;
              pm = (tile / nN) * 33; pn = tile % nN;
              Kuse = K / ks; emode = EM_RESID_AT;
              a64 += (unsigned long long)kp * Kuse * 2; b64 += (unsigned long long)kp * Kuse * 2;
            }
          } else tile_map(tt, NMT, nN, pm, pn);
          Epi e{emode, p.ws, gate, (const float2*)(smem + 131072), nullptr};
          gemm_tile((const u16*)a64, lda, (const u16*)b64, ldb, Kuse, pm * 256, pn * 256, smem, e);
        }
      }
    }
    if (ph + 1 < prm.ph_hi) {
      if (ph == prm.ph_lo) grid.sync();
      else { ++nbar; grid_barrier((unsigned*)(prm.ws + WS_BAR), nbar * gridDim.x); }
    }
  }
}

extern "C" void kernel_launch(void* const* d_in, const int* in_sizes, int n_in, void* d_out, int out_size, void* d_ws,
                              size_t ws_size, hipStream_t stream) {
  static int grid_blocks = 0;
  if (grid_blocks == 0) {
    if (n_in != 33 || ws_size < WS_END || (size_t)out_size * 4 < WO_END) {
      fprintf(stderr, "kernel_launch: unexpected sizes n_in=%d ws=%zu (need %zu) out=%d\n", n_in, ws_size, (size_t)WS_END, out_size);
      grid_blocks = -1;
      return;
    }
    int dev = 0, cus = 0, per_cu = 0;
    hipGetDevice(&dev);
    hipDeviceGetAttribute(&cus, hipDeviceAttributeMultiprocessorCount, dev);
    hipOccupancyMaxActiveBlocksPerMultiprocessor(&per_cu, mega, NT, 0);
    if (per_cu < 1) per_cu = 1;
    if (per_cu > 1) per_cu = 1;
    grid_blocks = cus * per_cu;
  }
  if (grid_blocks < 0) return;
  Params p{};
  for (int i = 0; i < 33; ++i) p.in[i] = (const float*)d_in[i];
  p.out = (float*)d_out;
  p.ws = (char*)d_ws;
  p.ph_lo = 0;
  p.ph_hi = NPH;
  (void)hipMemsetAsync((char*)d_ws + WS_BAR, 0, 1024, stream);
  void* args[] = {&p};
  hipError_t e = hipLaunchCooperativeKernel((void*)mega, dim3(grid_blocks), dim3(NT), args, 0, stream);
  if (e != hipSuccess) fprintf(stderr, "cooperative launch failed: %s (grid %d)\n", hipGetErrorString(e), grid_blocks);
}
```

```cpp
#include <hip/hip_runtime.h>
#include <hip/hip_cooperative_groups.h>
#include <cstdio>
namespace cg = cooperative_groups;

typedef unsigned short u16;
using bf16x8 = __attribute__((ext_vector_type(8))) short;
using f32x4 = __attribute__((ext_vector_type(4))) float;
using f32x16 = __attribute__((ext_vector_type(16))) float;

constexpr int D = 1024, SEQ = 8192, CTX = 256, SP = 8448, MROWS = 16896, NMT = 66;
constexpr int DIN = 5792, DINP = 5888, DFF = 4096;
constexpr int OFF_HY = 512, OFF_Q = 2048, OFF_KV = 2432, OFF_GATE = 2720;
constexpr int NT = 512;
constexpr float EPS = 1e-6f;

constexpr size_t WS_H = 0;
constexpr size_t WS_PROJ = WS_H + (size_t)MROWS * D * 4;
constexpr size_t WS_U = WS_PROJ + (size_t)MROWS * DINP * 2;
constexpr size_t WS_Y = WS_U + (size_t)MROWS * 512 * 2;
constexpr size_t WS_O = WS_Y + (size_t)MROWS * 512 * 2;
constexpr size_t WS_Q = WS_O + (size_t)MROWS * 512 * 2;
constexpr size_t WS_K = WS_Q + (size_t)16 * SP * 96 * 2;
constexpr size_t WS_VT = WS_K + (size_t)16 * SP * 96 * 2;
constexpr size_t WS_ZV = WS_VT + (size_t)16 * 64 * SP * 2;
constexpr size_t WS_HID2 = WS_ZV + (size_t)512 * SP * 8;
constexpr size_t WS_HID2C = WS_HID2 + (size_t)4 * 8192 * 64 * 4;
constexpr size_t WS_MOD = WS_HID2C + (size_t)4 * 256 * 64 * 4;
constexpr size_t WS_ROPE = WS_MOD + (size_t)4 * 3 * 6144 * 4;
constexpr size_t WS_TW = WS_ROPE + (size_t)128 * 8 * 8;
constexpr size_t WS_WPE = WS_TW + (size_t)16384 * 8;
constexpr size_t WS_BAR = WS_WPE + (size_t)4 * 1024 * 512 * 2;
constexpr size_t WS_END = WS_BAR + 16384;
constexpr size_t WO_IN = 0;
constexpr size_t WO_FF1 = WO_IN + (size_t)DINP * 1024 * 2;
constexpr size_t WO_FF2 = WO_FF1 + (size_t)4096 * 1024 * 2;
constexpr size_t WO_OUT = WO_FF2 + (size_t)4096 * 1024 * 2;
constexpr size_t WO_HY = WO_OUT + (size_t)1024 * 1024 * 2;
constexpr size_t WO_WO = WO_HY + (size_t)1024 * 512 * 2;
constexpr size_t WO_PE = WO_WO + (size_t)1024 * 512 * 2;
constexpr size_t WO_UQ = WO_PE + (size_t)1024 * 512 * 2;
constexpr size_t WO_UKV = WO_UQ + (size_t)768 * 384 * 2;
constexpr size_t WO_FILT = WO_UKV + (size_t)1024 * 256 * 2;
constexpr size_t WO_END = WO_FILT + (size_t)1024 * 8192 * 2;
constexpr size_t WS_W3T = WS_HID2 + (size_t)4 * 8192 * 64 * 2;

constexpr int AUX_OFF = 147456;
constexpr int LDS_BYTES = AUX_OFF + 8192;

struct Params {
  const float* in[33];
  float* out;
  char* ws;
  int ph_lo, ph_hi;
};

struct Ctx { const unsigned long long* intab; char* ws; float* out; };
__device__ __forceinline__ const float* pin(const Ctx& c, int i) {
  unsigned long long v = c.intab[i];
  unsigned lo = __builtin_amdgcn_readfirstlane((unsigned)v), hi = __builtin_amdgcn_readfirstlane((unsigned)(v >> 32));
  return (const float*)(((unsigned long long)hi << 32) | lo);
}

typedef __bf16 hwbf2 __attribute__((ext_vector_type(2)));
typedef float hwf2 __attribute__((ext_vector_type(2)));
__device__ __forceinline__ unsigned pk2(float a, float b) {
  hwf2 v = {a, b};
  hwbf2 r = __builtin_convertvector(v, hwbf2);
  return __builtin_bit_cast(unsigned, r);
}
__device__ __forceinline__ u16 f2bf(float f) { return (u16)(pk2(f, 0.f) & 0xffffu); }
__device__ __forceinline__ float bf2f(u16 b) { return __uint_as_float(((unsigned)b) << 16); }
__device__ __forceinline__ float shx(float v, int o) {
  int l = __builtin_amdgcn_mbcnt_hi(~0u, __builtin_amdgcn_mbcnt_lo(~0u, 0u));
  asm volatile("" : "+v"(l));
  return __int_as_float(__builtin_amdgcn_ds_bpermute((l ^ o) << 2, __float_as_int(v)));
}
__device__ __forceinline__ float wave_sum(float v) {
#pragma unroll
  for (int o = 1; o < 64; o <<= 1) v += shx(v, o);
  return v;
}
__device__ __forceinline__ int grp_of_row(int m) {
  int tile = m >> 8, b = tile / 33, t33 = tile - b * 33;
  return t33 == 0 ? 2 : b;
}
__device__ __forceinline__ float2 cmul(float2 a, float2 b) { return make_float2(a.x * b.x - a.y * b.y, a.x * b.y + a.y * b.x); }

__device__ __forceinline__ int tid_l() { int t = threadIdx.x; asm volatile("" : "+v"(t)); return t; }
#define XB_TMO      128
#define XB_XCNT(j)  (256  + 64 * (j))
#define XB_XSUB(j)  (1280 + 64 * (j))
#define XB_XGEN(j)  (2304 + 64 * (j))
#define XB_TOP      3328
#define XB_TOPGEN   3392
#define XCD_BAR_WORDS 3456
#define XB_SPIN_CAP (1u << 18)
#define LAS __attribute__((address_space(3)))
__device__ __forceinline__ unsigned xb_ld(unsigned* p)              { return __hip_atomic_load(p, __ATOMIC_RELAXED, __HIP_MEMORY_SCOPE_AGENT); }
__device__ __forceinline__ unsigned xb_add(unsigned* p, unsigned v) { return __hip_atomic_fetch_add(p, v, __ATOMIC_RELAXED, __HIP_MEMORY_SCOPE_AGENT); }
__device__ __forceinline__ unsigned xb_xcc_id() { return (unsigned)__builtin_amdgcn_s_getreg((3 << 11) | 20) & 0xFu; }
#define XB_SPIN(cond, bar) do { unsigned _sp = 0; while (cond) { __builtin_amdgcn_s_sleep(1); \
    if ((++_sp & 255u) == 0u) { if (xb_ld(&(bar)[XB_TMO])) break; if (_sp > XB_SPIN_CAP) { atomicAdd(&(bar)[XB_TMO], 1u); break; } } } } while (0)
struct XcdBarrier { unsigned* bar; unsigned x; volatile LAS unsigned* st; };
__device__ __forceinline__ XcdBarrier xcd_barrier_post(unsigned* bar, volatile LAS unsigned* st) {
    XcdBarrier b; b.bar = bar; b.x = xb_xcc_id(); b.st = st;
    if (threadIdx.x == 0) (void)xb_add(&bar[XB_XCNT(b.x)], 1u);
    return b;
}
__device__ __forceinline__ void xcd_barrier_complete(unsigned* bar, unsigned x, unsigned& nloc, unsigned& nx) {
    const unsigned G = gridDim.x * gridDim.y * gridDim.z;
    unsigned sum, cnt, mine, sp = 0u;
    for (;;) {
        sum = 0u; cnt = 0u; mine = 0u;
#pragma unroll
        for (unsigned j = 0; j < 16; ++j) { const unsigned c = xb_ld(&bar[XB_XCNT(j)]); sum += c; cnt += (c > 0u) ? 1u : 0u; mine = (j == x) ? c : mine; }
        if (sum == G) break;
        __builtin_amdgcn_s_sleep(1);
        if ((++sp & 255u) == 0u) { if (xb_ld(&bar[XB_TMO])) break; if (sp > XB_SPIN_CAP) { atomicAdd(&bar[XB_TMO], 1u); break; } }
    }
    nloc = mine > 0u ? mine : 1u; nx = cnt > 0u ? cnt : 1u;
}
__device__ __forceinline__ void xcd_barrier(const XcdBarrier& b) {
    asm volatile("s_waitcnt vmcnt(0)" ::: "memory");
    __syncthreads();
    if (threadIdx.x == 0) {
        unsigned* bar = b.bar;
        __builtin_amdgcn_s_waitcnt(0);
        unsigned nloc = b.st[0], nx = b.st[1];
        if (nloc == 0u) { xcd_barrier_complete(bar, b.x, nloc, nx); b.st[0] = nloc; b.st[1] = nx; }
        const unsigned old = xb_add(&bar[XB_XSUB(b.x)], 1u);
        const unsigned gen = old / nloc;
        if (old + 1u == (gen + 1u) * nloc) {
            __builtin_amdgcn_fence(__ATOMIC_RELEASE, "agent");
            asm volatile("s_waitcnt vmcnt(0)" ::: "memory");
            const unsigned og = xb_add(&bar[XB_TOP], 1u);
            const unsigned tg = og / nx;
            if (og + 1u == (tg + 1u) * nx) xb_add(&bar[XB_TOPGEN], 1u);
            else XB_SPIN(xb_ld(&bar[XB_TOPGEN]) == tg, bar);
            __builtin_amdgcn_fence(__ATOMIC_ACQUIRE, "agent");
            xb_add(&bar[XB_XGEN(b.x)], 1u);
            asm volatile("s_waitcnt vmcnt(0)" ::: "memory");
        } else {
            XB_SPIN(xb_ld(&bar[XB_XGEN(b.x)]) == gen, bar);
            __builtin_amdgcn_fence(__ATOMIC_ACQUIRE, "agent");
            asm volatile("s_waitcnt vmcnt(0)" ::: "memory");
        }
    }
    __syncthreads();
}

__device__ __forceinline__ void grid_barrier(unsigned* bar, unsigned target) {
  asm volatile("s_waitcnt vmcnt(0)" ::: "memory");
  __syncthreads();
  if (threadIdx.x == 0) {
    __builtin_amdgcn_fence(__ATOMIC_RELEASE, "agent");
    asm volatile("s_waitcnt vmcnt(0)" ::: "memory");
    __hip_atomic_fetch_add(bar, 1u, __ATOMIC_RELAXED, __HIP_MEMORY_SCOPE_AGENT);
    while (__hip_atomic_load(bar, __ATOMIC_RELAXED, __HIP_MEMORY_SCOPE_AGENT) < target) __builtin_amdgcn_s_sleep(2);
    __builtin_amdgcn_fence(__ATOMIC_ACQUIRE, "agent");
    asm volatile("s_waitcnt vmcnt(0)" ::: "memory");
  }
  __syncthreads();
}
#define WAIT_V(n) asm volatile("s_waitcnt vmcnt(%0)" ::"n"(n) : "memory")
#define SCHED() __builtin_amdgcn_sched_barrier(0)
#define RAW_BARRIER() do { asm volatile("s_waitcnt lgkmcnt(0)" ::: "memory"); __builtin_amdgcn_s_barrier(); } while (0)

constexpr float QSCALE = 0.10206207261596575f * 1.4426950408889634f;
enum { EM_PROJ = 0, EM_SQRELU = 1, EM_RESID = 2, EM_RESID_AT = 3, EM_FILT = 4, EM_Q = 6, EM_KV = 7 };
struct Epi {
  int mode;
  char* ws;
  const float* gate;
  const float2* rope_lds;
  u16* filt_out;
  __device__ __forceinline__ void proj(int row, int col, f32x4 v) const {
    {
      u16* out = (u16*)(ws + WS_PROJ);
#pragma unroll
      for (int j = 0; j < 4; ++j) out[(size_t)(row + j) * DINP + col] = f2bf(v[j]);
    }
  }
  __device__ __forceinline__ void sqrelu(int row, int col, f32x4 v) const {
    {
      u16* out = (u16*)(ws + WS_PROJ);
#pragma unroll
      for (int j = 0; j < 4; ++j) { float r = fmaxf(v[j], 0.f); out[(size_t)(row + j) * DFF + col] = f2bf(r * r); }
    }
  }
  __device__ __forceinline__ void resid(int row, int col, f32x4 v) const {
    {
      float* h = (float*)(ws + WS_H);
      float g = gate[grp_of_row(row) * 6144 + col];
#pragma unroll
      for (int j = 0; j < 4; ++j) unsafeAtomicAdd(h + (size_t)(row + j) * D + col, g * v[j]);
    }
  }
  __device__ __forceinline__ void filt(int row, int col, f32x4 v) const {
    uint2 o;
    o.x = pk2(v[0], v[1]);
    o.y = pk2(v[2], v[3]);
    *(uint2*)(filt_out + (size_t)col * 8192 + row) = o;
  }
  __device__ __forceinline__ void q(int row, int col, f32x4 v) const {
    {
      u16* Q = (u16*)(ws + WS_Q);
      const float2* rope = rope_lds;
      int head = col / 96, d = col - head * 96;
      int b = row / SP, pos0 = row - b * SP;
      bool isrope = (d >= 64) && (pos0 >= CTX);
      int rd = d - 64;
#pragma unroll
      for (int j = 0; j < 4; ++j) {
        float val = v[j];
        float partner = shx(val, 8);
        int pos = pos0 + j;
        if (isrope) {
          int t = pos - CTX, idx = (rd < 16) ? (t >> 6) : (t & 63);
          float2 cs = rope[idx * 8 + (rd & 7)];
          float sgn = (rd & 8) ? 1.f : -1.f;
          val = val * cs.x + sgn * partner * cs.y;
        }
        Q[((size_t)(b * 8 + head) * SP + pos) * 96 + d] = f2bf(val * QSCALE);
      }
    }
  }
  __device__ __forceinline__ void kv(int row, int col, f32x4 v) const {
    {
      u16* Kb = (u16*)(ws + WS_K);
      u16* Vt = (u16*)(ws + WS_VT);
      int head = col >> 7, j2 = col & 127;
      int b = row / SP, pos0 = row - b * SP;
      if (j2 < 64) {
#pragma unroll
        for (int j = 0; j < 4; ++j) Kb[((size_t)(b * 8 + head) * SP + pos0 + j) * 96 + j2] = f2bf(v[j]);
      } else {
        uint2 o;
        o.x = pk2(v[0], v[1]);
        o.y = pk2(v[2], v[3]);
        *(uint2*)(Vt + ((size_t)(b * 8 + head) * 64 + (j2 - 64)) * SP + pos0) = o;
      }
    }
  }
};
struct GD { const u16* A; int lda; const u16* Bt; int ldb; int K; int nN; int mode; int ks; };

constexpr int G_TILE_B = 256 * 64 * 2, G_STAGE_B = 2 * G_TILE_B;
__device__ __forceinline__ int lds_byte(int r, int c) {
  int st = (r >> 4) * 2 + (c >> 5), ob = (r & 15) * 64 + (c & 31) * 2;
  return st * 1024 + (ob ^ (((ob >> 9) & 1) << 5));
}
__device__ __forceinline__ void stage_rc(int b, int& R, int& C) {
  int st = b >> 10, sb = b & 1023, swz = sb ^ (((sb >> 9) & 1) << 5);
  R = (st / 2) * 16 + swz / 64;
  C = (st % 2) * 32 + (swz % 64) / 2;
}

template <int MI>
__device__ __forceinline__ void gemm_core(const u16* __restrict__ A, int lda, const u16* __restrict__ Bt, int ldb, int K,
                                          int brow, int bcol, char* shm, f32x4 (&acc)[MI][4]) {
  constexpr int TILE_A = MI * 32 * 64 * 2, TILE_BB = 256 * 64 * 2, STAGE = TILE_A + TILE_BB;
  const int tid = tid_l(), wid = tid >> 6, lane = tid & 63, wr = wid >> 2, wc = wid & 3, fr = lane & 15, fq = lane >> 4;
  const u16* Ab = A + (size_t)brow * lda;
  const u16* Bb = Bt + (size_t)bcol * ldb;
  int sR[4], sC[4];
#pragma unroll
  for (int i = 0; i < 4; ++i) stage_rc(wid * 1024 + i * 8192 + lane * 16, sR[i], sC[i]);
#define SA(b) (shm + (b) * STAGE)
#define SB(b) (shm + (b) * STAGE + TILE_A)
#define GLDS_STAGE(buf, kt)                                                                                              \
  do {                                                                                                                   \
    _Pragma("unroll") for (int i = 0; i < 4; ++i) {                                                                      \
      if (i < MI / 2)                                                                                                    \
        __builtin_amdgcn_global_load_lds((const unsigned*)(Ab + (size_t)sR[i] * lda + (kt) * 64 + sC[i]),                \
                                         (unsigned*)(SA(buf) + wid * 1024 + i * 8192), 16, 0, 0);                        \
      __builtin_amdgcn_global_load_lds((const unsigned*)(Bb + (size_t)sR[i] * ldb + (kt) * 64 + sC[i]),                  \
                                       (unsigned*)(SB(buf) + wid * 1024 + i * 8192), 16, 0, 0);                          \
    }                                                                                                                    \
  } while (0)
  const int nt = K / 64;
  GLDS_STAGE(0, 0);
  WAIT_V(0);
  __syncthreads();
  for (int t = 0; t < nt; ++t) {
    const int cur = t & 1;
    if (t + 1 < nt) GLDS_STAGE(cur ^ 1, t + 1);
#pragma unroll
    for (int ks = 0; ks < 2; ++ks) {
      bf16x8 At[MI], Bf[4];
#pragma unroll
      for (int m = 0; m < MI; ++m) At[m] = *(const bf16x8*)(SA(cur) + lds_byte(wr * (MI * 16) + m * 16 + fr, ks * 32 + fq * 8));
#pragma unroll
      for (int n = 0; n < 4; ++n) Bf[n] = *(const bf16x8*)(SB(cur) + lds_byte(wc * 64 + n * 16 + fr, ks * 32 + fq * 8));
#pragma unroll
      for (int m = 0; m < MI; ++m)
#pragma unroll
        for (int n = 0; n < 4; ++n) acc[m][n] = __builtin_amdgcn_mfma_f32_16x16x32_bf16(At[m], Bf[n], acc[m][n], 0, 0, 0);
      SCHED();
    }
    WAIT_V(0);
    __syncthreads();
  }
#undef SA
#undef SB
#undef GLDS_STAGE
}

template <class EpiT>
__device__ __forceinline__ void gemm_tile(const u16* __restrict__ A, int lda, const u16* __restrict__ Bt, int ldb, int K,
                                          int brow, int bcol, char* shm, const EpiT& epi) {
  const int tid = tid_l(), wid = tid >> 6, lane = tid & 63, wr = wid >> 2, wc = wid & 3, fr = lane & 15, fq = lane >> 4;
  f32x4 acc[8][4];
#pragma unroll
  for (int m = 0; m < 8; ++m)
#pragma unroll
    for (int n = 0; n < 4; ++n) acc[m][n] = (f32x4){0.f, 0.f, 0.f, 0.f};
  gemm_core<8>(A, lda, Bt, ldb, K, brow, bcol, shm, acc);
#define EPI_LOOP(CALL)                                                                              \
  _Pragma("unroll") for (int m = 0; m < 8; ++m) _Pragma("unroll") for (int n = 0; n < 4; ++n) {      \
    const int row = brow + wr * 128 + m * 16 + fq * 4, col = bcol + wc * 64 + n * 16 + fr;           \
    const f32x4 v = acc[m][n];                                                                        \
    CALL;                                                                                             \
  }
  if (epi.mode == EM_PROJ) { EPI_LOOP(epi.proj(row, col, v)) }
  else if (epi.mode == EM_SQRELU) { EPI_LOOP(epi.sqrelu(row, col, v)) }
  else if (epi.mode == EM_RESID_AT) { EPI_LOOP(epi.resid(row, col, v)) }
  else if (epi.mode == EM_RESID) {
    float* h = (float*)(epi.ws + WS_H);
    float g4[4];
#pragma unroll
    for (int n = 0; n < 4; ++n) g4[n] = epi.gate[grp_of_row(brow) * 6144 + bcol + wc * 64 + n * 16 + fr];
    float hv[8][4][4];
    float* hp0 = h + (size_t)(brow + wr * 128 + fq * 4) * D + bcol + wc * 64 + fr;
#define H_LOAD(m) _Pragma("unroll") for (int n = 0; n < 4; ++n) _Pragma("unroll") for (int j = 0; j < 4; ++j) hv[m][n][j] = hp0[(size_t)((m) * 16 + j) * D + n * 16]
#define H_STORE(m) _Pragma("unroll") for (int n = 0; n < 4; ++n) _Pragma("unroll") for (int j = 0; j < 4; ++j) hp0[(size_t)((m) * 16 + j) * D + n * 16] = hv[m][n][j] + g4[n] * acc[m][n][j]
    H_LOAD(0); H_LOAD(1);
    SCHED();
    H_STORE(0); H_LOAD(2); SCHED();
    H_STORE(1); H_LOAD(3); SCHED();
    H_STORE(2); H_LOAD(4); SCHED();
    H_STORE(3); H_LOAD(5); SCHED();
    H_STORE(4); H_LOAD(6); SCHED();
    H_STORE(5); H_LOAD(7); SCHED();
    H_STORE(6); H_STORE(7);
#undef H_LOAD
#undef H_STORE
  }
  else if (epi.mode == EM_FILT) { EPI_LOOP(epi.filt(row, col, v)) }
  else if (epi.mode == EM_Q) { EPI_LOOP(epi.q(row, col, v)) }
  else { EPI_LOOP(epi.kv(row, col, v)) }
#undef EPI_LOOP
}

__device__ __forceinline__ void mix_tile(const Ctx& p, int l, int pm, int pn, char* shm) {
  constexpr int TILE_A = 128 * 64 * 2, TILE_BB = 256 * 64 * 2, STAGE = TILE_A + TILE_BB;
  const int tid = tid_l(), wid = tid >> 6, lane = tid & 63, wr = wid >> 2, wc = wid & 3, fr = lane & 15, fq = lane >> 4;
  const int brow = pm * 128, bcol = pn * 256;
  const u16* projb = (const u16*)(p.ws + WS_PROJ);
  char* wo = (char*)p.out;
#define SA(b) (shm + (b) * STAGE)
#define SB(b) (shm + (b) * STAGE + TILE_A)
#define MIX_STAGE(buf, kt)                                                                                               \
  do {                                                                                                                   \
    const int br_ = (kt) >> 3, ko_ = ((kt) & 7) * 64;                                                                    \
    const u16* Ab_ = (const u16*)(p.ws + (br_ == 0 ? WS_U : br_ == 1 ? WS_Y : WS_O)) + (size_t)brow * 512 + ko_;         \
    const u16* Bb_ = (br_ == 0 ? (const u16*)(p.ws + WS_WPE) + (size_t)l * 1024 * 512 : (const u16*)(wo + (br_ == 1 ? WO_HY : WO_WO))) + (size_t)bcol * 512 + ko_;        \
    _Pragma("unroll") for (int i = 0; i < 4; ++i) {                                                                      \
      int sR_, sC_; stage_rc(wid * 1024 + i * 8192 + lane * 16, sR_, sC_);                                              \
      if (i < 2)                                                                                                         \
        __builtin_amdgcn_global_load_lds((const unsigned*)(Ab_ + sR_ * 512 + sC_),                           \
                                         (unsigned*)(SA(buf) + wid * 1024 + i * 8192), 16, 0, 0);                        \
      __builtin_amdgcn_global_load_lds((const unsigned*)(Bb_ + sR_ * 512 + sC_),                             \
                                       (unsigned*)(SB(buf) + wid * 1024 + i * 8192), 16, 0, 0);                          \
    }                                                                                                                    \
  } while (0)
  f32x4 tot[4][4], acc[4][4];
#pragma unroll
  for (int m = 0; m < 4; ++m)
#pragma unroll
    for (int n = 0; n < 4; ++n) { tot[m][n] = (f32x4){0.f, 0.f, 0.f, 0.f}; acc[m][n] = (f32x4){0.f, 0.f, 0.f, 0.f}; }
  MIX_STAGE(0, 0);
  MIX_STAGE(1, 1);
  WAIT_V(6);
  RAW_BARRIER();
  int cur = 0;
#pragma unroll 1
  for (int br = 0; br < 3; ++br) {
    unsigned gpk[4][4][2];
    const u16* gp = projb + (size_t)(brow + wr * 64 + fq * 4) * DINP + OFF_GATE + br * 1024 + bcol + wc * 64 + fr;
#define GATE_LOAD(m)                                                                                   \
    _Pragma("unroll") for (int n = 0; n < 4; ++n) _Pragma("unroll") for (int j2 = 0; j2 < 2; ++j2) {       \
      unsigned lo = gp[(size_t)((m) * 16 + 2 * j2) * DINP + n * 16], hi = gp[(size_t)((m) * 16 + 2 * j2 + 1) * DINP + n * 16]; \
      gpk[m][n][j2] = lo | (hi << 16);                                                                     \
    }
    GATE_LOAD(0); GATE_LOAD(1); GATE_LOAD(2);
#pragma unroll 1
    for (int kk = 0; kk < 8; ++kk) {
      const int t = br * 8 + kk;
      { int nx = cur + 2; if (nx >= 3) nx -= 3; if (t + 2 < 24) MIX_STAGE(nx, t + 2); }
#pragma unroll
      for (int ks = 0; ks < 2; ++ks) {
        bf16x8 At[2], Bf[4];
#pragma unroll
        for (int n = 0; n < 4; ++n) Bf[n] = *(const bf16x8*)(SB(cur) + lds_byte(wc * 64 + n * 16 + fr, ks * 32 + fq * 8));
#pragma unroll
        for (int mh = 0; mh < 2; ++mh) {
#pragma unroll
          for (int m = 0; m < 2; ++m) At[m] = *(const bf16x8*)(SA(cur) + lds_byte(wr * 64 + (mh * 2 + m) * 16 + fr, ks * 32 + fq * 8));
#pragma unroll
          for (int m = 0; m < 2; ++m)
#pragma unroll
            for (int n = 0; n < 4; ++n) acc[mh * 2 + m][n] = __builtin_amdgcn_mfma_f32_16x16x32_bf16(At[m], Bf[n], acc[mh * 2 + m][n], 0, 0, 0);
          SCHED();
        }
      }
      if (t + 2 < 24) WAIT_V(6); else WAIT_V(0);
      RAW_BARRIER();
      cur = (cur == 2) ? 0 : cur + 1;
    }
    GATE_LOAD(3);
#undef GATE_LOAD
#pragma unroll
    for (int m = 0; m < 4; ++m)
#pragma unroll
      for (int n = 0; n < 4; ++n)
#pragma unroll
        for (int j = 0; j < 4; ++j) {
          const unsigned w = gpk[m][n][j >> 1];
          const float gv = __uint_as_float((j & 1) ? (w & 0xffff0000u) : (w << 16));
          tot[m][n][j] += acc[m][n][j] / (1.f + __expf(-gv));
          acc[m][n][j] = 0.f;
        }
  }
  u16* mixb = (u16*)(p.ws + WS_ZV);
#pragma unroll
  for (int m = 0; m < 4; ++m)
#pragma unroll
    for (int n = 0; n < 4; ++n)
#pragma unroll
      for (int j = 0; j < 4; ++j)
        mixb[(size_t)(brow + wr * 64 + m * 16 + fq * 4 + j) * D + bcol + wc * 64 + n * 16 + fr] = f2bf(tot[m][n][j]);
#undef SA
#undef SB
#undef MIX_STAGE
}

__device__ __forceinline__ void tile_map(int t, int nM, int nN, int& pm, int& pn) {
  int nwg = nM * nN, wgid = t;
  {
    int q = nwg / 8, r = nwg % 8, xcd = wgid % 8, off = wgid / 8;
    wgid = (xcd < r ? xcd * (q + 1) : r * (q + 1) + (xcd - r) * q) + off;
  }
  int nig = 8 * nN, gid = wgid / nig, fm = gid * 8, gsz = min(nM - fm, 8);
  pm = fm + ((wgid % nig) % gsz);
  pn = (wgid % nig) / gsz;
}

__device__ __forceinline__ void p0_misc(const Ctx& p) {
  const int gtid = blockIdx.x * NT + tid_l(), gn = gridDim.x * NT;
  float4* h4 = (float4*)(p.ws + WS_H);
  const float4* x4 = (const float4*)pin(p, 0);
  const float4* c4 = (const float4*)pin(p, 2);
#pragma unroll 8
  for (int i = gtid; i < MROWS * 256; i += gn) {
    int m = i >> 8, q = i & 255, b = m / SP, pos = m - b * SP;
    float4 v = (pos < CTX) ? c4[(size_t)(b * CTX + pos) * 256 + q] : x4[(size_t)(b * SEQ + pos - CTX) * 256 + q];
    h4[i] = v;
  }
  float2* rope = (float2*)(p.ws + WS_ROPE);
  for (int i = gtid; i < 1024; i += gn) {
    int idx = i >> 3, f = i & 7;
    float inv = powf(10000.f, -(float)f / 8.f);
    float a = (float)idx * inv;
    rope[i] = make_float2(cosf(a), sinf(a));
  }
  {
    u16* w3t = (u16*)(p.ws + WS_W3T);
    const float* w3 = pin(p, 20);
    for (int i = gtid; i < 4 * 1024 * 64; i += gn) { int l = i >> 16, c2 = (i >> 6) & 1023, k = i & 63; w3t[i] = f2bf(w3[((size_t)l * 64 + k) * 1024 + c2]); }
  }
  float2* tw = (float2*)(p.ws + WS_TW);
  for (int i = gtid; i < 16384; i += gn) {
    float s, c;
    sincospif(-(float)i / 8192.f, &s, &c);
    tw[i] = make_float2(c, s);
  }
}

__device__ __forceinline__ void p0_mod_task(const Ctx& p, int task, char* smem) {
  float* s = (float*)smem;
  float* red = s + 3072;
  const int tid = tid_l();
  const int l = task / 48, chunk = task - l * 48;
  for (int i = tid; i < 3072; i += NT) {
    int g = i >> 10, k = i & 1023;
    float cv = (g < 2) ? pin(p, 1)[g * 1024 + k] : pin(p, 3)[k];
    s[i] = cv / (1.f + __expf(-cv));
  }
  __syncthreads();
  const int kq = tid >> 7, col = tid & 127, n = chunk * 128 + col;
  const float* W = pin(p, 4) + (size_t)l * 1024 * 6144 + n;
  float a0 = 0.f, a1 = 0.f, a2 = 0.f;
#pragma unroll 32
  for (int k = kq * 256; k < kq * 256 + 256; ++k) {
    float w = W[(size_t)k * 6144];
    a0 += s[k] * w; a1 += s[1024 + k] * w; a2 += s[2048 + k] * w;
  }
  red[(kq * 3 + 0) * 128 + col] = a0;
  red[(kq * 3 + 1) * 128 + col] = a1;
  red[(kq * 3 + 2) * 128 + col] = a2;
  __syncthreads();
  if (tid < 384) {
    int g = tid >> 7, c2 = tid & 127, n2 = chunk * 128 + c2;
    float v = red[(0 * 3 + g) * 128 + c2] + red[(1 * 3 + g) * 128 + c2] + red[(2 * 3 + g) * 128 + c2] + red[(3 * 3 + g) * 128 + c2];
    ((float*)(p.ws + WS_MOD))[(size_t)(l * 3 + g) * 6144 + n2] = v + pin(p, 5)[l * 6144 + n2];
  }
  __syncthreads();
}

__device__ __forceinline__ void p0_hid_task(const Ctx& p, int task, char* smem) {
  float* zs = (float*)smem;
  float* h1 = zs + 8 * 36;
  float* w1s = h1 + 8 * 64;
  float* w2s = w1s + 33 * 64;
  const int tid = tid_l(), tl = tid >> 6, j = tid & 63;
  const int l = task / 132, r = task - l * 132;
  const bool isctx = r >= 128;
  const int L = isctx ? 256 : 8192;
  const int tbase = (isctx ? (r - 128) : r) * 64;
  for (int i = tid; i < 33 * 64; i += NT) w1s[i] = pin(p, 14)[l * 33 * 64 + i];
  for (int i = tid; i < 64 * 64; i += NT) w2s[i] = pin(p, 17)[l * 64 * 64 + i];
  const float b1 = pin(p, 15)[l * 64 + j], f1 = pin(p, 16)[l * 64 + j], b2 = pin(p, 18)[l * 64 + j], f2 = pin(p, 19)[l * 64 + j];
  __syncthreads();
  for (int sub = 0; sub < 8; ++sub) {
    const int t = tbase + sub * 8 + tl;
    if (j < 33) {
      float z;
      if (j == 0) z = (float)t / (float)(L - 1);
      else {
        int i = (j - 1) & 15;
        float band = 1e-4f + (float)i * ((15.f - 1e-4f) / 15.f);
        float omega = 6.2831855f * (float)t / (float)L;
        float a = omega * band;
        z = (j <= 16) ? cosf(a) : -sinf(a);
      }
      zs[tl * 36 + j] = z;
    }
    __syncthreads();
    {
      float a = b1;
#pragma unroll
      for (int k = 0; k < 33; ++k) a += zs[tl * 36 + k] * w1s[k * 64 + j];
      h1[tl * 64 + j] = sinf(f1 * a);
    }
    __syncthreads();
    {
      float a = b2;
#pragma unroll 16
      for (int k = 0; k < 64; ++k) a += h1[tl * 64 + k] * w2s[k * 64 + j];
      float v = sinf(f2 * a);
      if (isctx) ((float*)(p.ws + WS_HID2C))[((size_t)l * 64 + j) * 256 + t] = v;
      else ((u16*)(p.ws + WS_HID2))[((size_t)l * 8192 + t) * 64 + j] = f2bf(v);
    }
  }
  __syncthreads();
}

struct WtItem { const float* W; u16* WT; int K, N, k0, n0; };
__device__ __forceinline__ WtItem wt_decode(const Ctx& p, int l, int r) {
  char* wo = (char*)p.out;
  WtItem it;
  int nblk;
  if (r < 1472) { it.W = pin(p, 8) + (size_t)l * 1024 * DIN; it.K = 1024; it.N = DIN; it.WT = (u16*)(wo + WO_IN); nblk = 92; }
  else if ((r -= 1472) < 1024) { it.W = pin(p, 30) + (size_t)l * 1024 * 4096; it.K = 1024; it.N = 4096; it.WT = (u16*)(wo + WO_FF1); nblk = 64; }
  else if ((r -= 1024) < 1024) { it.W = pin(p, 31) + (size_t)l * 4096 * 1024; it.K = 4096; it.N = 1024; it.WT = (u16*)(wo + WO_FF2); nblk = 16; }
  else if ((r -= 1024) < 256) { it.W = pin(p, 29) + (size_t)l * 1024 * 1024; it.K = 1024; it.N = 1024; it.WT = (u16*)(wo + WO_OUT); nblk = 16; }
  else if ((r -= 256) < 128) { it.W = pin(p, 23) + (size_t)l * 512 * 1024; it.K = 512; it.N = 1024; it.WT = (u16*)(wo + WO_HY); nblk = 16; }
  else if ((r -= 128) < 128) { it.W = pin(p, 28) + (size_t)l * 512 * 1024; it.K = 512; it.N = 1024; it.WT = (u16*)(wo + WO_WO); nblk = 16; }
  else if ((r -= 128) < 72) { it.W = pin(p, 25) + (size_t)l * 384 * 768; it.K = 384; it.N = 768; it.WT = (u16*)(wo + WO_UQ); nblk = 12; }
  else { r -= 72; it.W = pin(p, 27) + (size_t)l * 256 * 1024; it.K = 256; it.N = 1024; it.WT = (u16*)(wo + WO_UKV); nblk = 16; }
  const int kb = r / nblk, nb2 = r - kb * nblk;
  it.k0 = kb * 64; it.n0 = nb2 * 64;
  return it;
}
__device__ __forceinline__ void wt_load(const WtItem& it, int tid, float (&v)[8]) {
  const int nn = tid & 63, kq = tid >> 6;
  const bool ok = it.n0 + nn < it.N;
  const float* src = it.W + (size_t)(it.k0 + kq) * it.N + it.n0 + (ok ? nn : 0);
#pragma unroll
  for (int r = 0; r < 8; ++r) { float x = src[(size_t)(r * 8) * it.N]; v[r] = ok ? x : 0.f; }
}
__device__ __forceinline__ void wt_phase(const Ctx& p, int l, char* smem) {
  float* tile = (float*)smem;
  const int tid = tid_l();
  const int bid = blockIdx.x, nb = gridDim.x;
  int t = bid;
  if (t >= 4168) return;
  WtItem cur = wt_decode(p, l, t);
  float v[8];
  wt_load(cur, tid, v);
#pragma unroll 1
  while (true) {
    const int tn = t + nb;
    const bool more = tn < 4168;
    WtItem nxt = cur;
    float vn[8];
    if (more) { nxt = wt_decode(p, l, tn); wt_load(nxt, tid, vn); }
#pragma unroll
    for (int r = 0; r < 8; ++r) tile[(r * 8 + (tid >> 6)) * 65 + (tid & 63)] = v[r];
    __syncthreads();
    {
      int n = tid >> 3, kc = (tid & 7) * 8;
      uint4 o;
      o.x = pk2(tile[(kc + 0) * 65 + n], tile[(kc + 1) * 65 + n]);
      o.y = pk2(tile[(kc + 2) * 65 + n], tile[(kc + 3) * 65 + n]);
      o.z = pk2(tile[(kc + 4) * 65 + n], tile[(kc + 5) * 65 + n]);
      o.w = pk2(tile[(kc + 6) * 65 + n], tile[(kc + 7) * 65 + n]);
      *(uint4*)(cur.WT + (size_t)(cur.n0 + n) * cur.K + cur.k0 + kc) = o;
    }
    __syncthreads();
    if (!more) break;
    cur = nxt;
#pragma unroll
    for (int r = 0; r < 8; ++r) v[r] = vn[r];
    t = tn;
  }
}

__device__ __forceinline__ void wpe_task(const Ctx& p, int l, int task, char* smem) {
  const int g = task >> 3, c0 = (task & 7) * 16, tid = tid_l();
  const float* pw = pin(p, 9) + ((size_t)(l * 4 + g) * 128) * 128;
  const float* sc = pin(p, 10) + l * 512 + g * 128;
  const float* po = pin(p, 11) + ((size_t)l * 512 + g * 128) * 1024;
  u16* WpeT = (u16*)(p.ws + WS_WPE) + (size_t)l * 1024 * 512;
  float* wl = (float*)smem;
  for (int i = tid; i < 16 * 128; i += NT) { int d = i & 127; wl[i] = pw[(c0 + (i >> 7)) * 128 + d] * sc[d]; }
  __syncthreads();
  float acc0[16], acc1[16];
#pragma unroll
  for (int i = 0; i < 16; ++i) { acc0[i] = 0.f; acc1[i] = 0.f; }
#pragma unroll 16
  for (int d = 0; d < 128; ++d) {
    float p0 = po[(size_t)d * 1024 + tid], p1 = po[(size_t)d * 1024 + 512 + tid];
#pragma unroll
    for (int i = 0; i < 16; ++i) { float w = wl[i * 128 + d]; acc0[i] += w * p0; acc1[i] += w * p1; }
  }
  uint4 o0, o1;
  o0.x = pk2(acc0[0], acc0[1]); o0.y = pk2(acc0[2], acc0[3]); o0.z = pk2(acc0[4], acc0[5]); o0.w = pk2(acc0[6], acc0[7]);
  o1.x = pk2(acc0[8], acc0[9]); o1.y = pk2(acc0[10], acc0[11]); o1.z = pk2(acc0[12], acc0[13]); o1.w = pk2(acc0[14], acc0[15]);
  uint4* dst = (uint4*)(WpeT + (size_t)tid * 512 + g * 128 + c0);
  dst[0] = o0; dst[1] = o1;
  o0.x = pk2(acc1[0], acc1[1]); o0.y = pk2(acc1[2], acc1[3]); o0.z = pk2(acc1[4], acc1[5]); o0.w = pk2(acc1[6], acc1[7]);
  o1.x = pk2(acc1[8], acc1[9]); o1.y = pk2(acc1[10], acc1[11]); o1.z = pk2(acc1[12], acc1[13]); o1.w = pk2(acc1[14], acc1[15]);
  dst = (uint4*)(WpeT + (size_t)(512 + tid) * 512 + g * 128 + c0);
  dst[0] = o0; dst[1] = o1;
  __syncthreads();
}

__device__ __forceinline__ void norm_rows(const Ctx& p, const float* gain, const float* modl, int sh_idx, int sc_idx, u16* outp) {
  const int tidx = tid_l(), lane = tidx & 63, gw = blockIdx.x * 8 + (tidx >> 6), ngw = gridDim.x * 8;
  const float* h = (const float*)(p.ws + WS_H);
  float4 g[4];
#pragma unroll
  for (int j = 0; j < 4; ++j) g[j] = *(const float4*)(gain + lane * 4 + 256 * j);
  for (int m0 = gw; m0 < MROWS; m0 += 2 * ngw) {
    const int m1 = m0 + ngw;
    const bool has1 = m1 < MROWS;
    const int m1c = has1 ? m1 : m0;
    const float4* hr0 = (const float4*)(h + (size_t)m0 * D) + lane;
    const float4* hr1 = (const float4*)(h + (size_t)m1c * D) + lane;
    float4 v0[4], v1[4];
#pragma unroll
    for (int j = 0; j < 4; ++j) { v0[j] = hr0[64 * j]; v1[j] = hr1[64 * j]; }
    const float* mg0 = modl + grp_of_row(m0) * 6144;
    const float* mg1 = modl + grp_of_row(m1c) * 6144;
    float s0 = 0.f, s1 = 0.f;
#pragma unroll
    for (int j = 0; j < 4; ++j) {
      s0 += v0[j].x * v0[j].x + v0[j].y * v0[j].y + v0[j].z * v0[j].z + v0[j].w * v0[j].w;
      s1 += v1[j].x * v1[j].x + v1[j].y * v1[j].y + v1[j].z * v1[j].z + v1[j].w * v1[j].w;
    }
    s0 = wave_sum(s0);
    s1 = wave_sum(s1);
    const float r0 = rsqrtf(s0 * (1.f / D) + EPS), r1 = rsqrtf(s1 * (1.f / D) + EPS);
    uint2* o0 = (uint2*)(outp + (size_t)m0 * D) + lane;
    uint2* o1 = (uint2*)(outp + (size_t)m1c * D) + lane;
#pragma unroll
    for (int j = 0; j < 4; ++j) {
      int n = lane * 4 + 256 * j;
      float4 sc = *(const float4*)(mg0 + sc_idx * 1024 + n), sh = *(const float4*)(mg0 + sh_idx * 1024 + n);
      uint2 o;
      o.x = pk2(v0[j].x * r0 * g[j].x * (1.f + sc.x) + sh.x, v0[j].y * r0 * g[j].y * (1.f + sc.y) + sh.y);
      o.y = pk2(v0[j].z * r0 * g[j].z * (1.f + sc.z) + sh.z, v0[j].w * r0 * g[j].w * (1.f + sc.w) + sh.w);
      o0[64 * j] = o;
    }
    if (has1) {
#pragma unroll
      for (int j = 0; j < 4; ++j) {
        int n = lane * 4 + 256 * j;
        float4 sc = *(const float4*)(mg1 + sc_idx * 1024 + n), sh = *(const float4*)(mg1 + sh_idx * 1024 + n);
        uint2 o;
        o.x = pk2(v1[j].x * r1 * g[j].x * (1.f + sc.x) + sh.x, v1[j].y * r1 * g[j].y * (1.f + sc.y) + sh.y);
        o.y = pk2(v1[j].z * r1 * g[j].z * (1.f + sc.z) + sh.z, v1[j].w * r1 * g[j].w * (1.f + sc.w) + sh.w);
        o1[64 * j] = o;
      }
    }
  }
}

__device__ __forceinline__ void final_norm(const Ctx& p) {
  const int tidx = tid_l(), lane = tidx & 63, gw = blockIdx.x * 8 + (tidx >> 6), ngw = gridDim.x * 8;
  const float* h = (const float*)(p.ws + WS_H);
  const float* gain = pin(p, 32);
  for (int r0 = gw; r0 < 2 * SEQ; r0 += ngw) {
    int b = r0 >> 13, t = r0 & 8191, m = b * SP + CTX + t;
    const float4* hr = (const float4*)(h + (size_t)m * D) + lane;
    float4 v[4];
    float ss = 0.f;
#pragma unroll
    for (int j = 0; j < 4; ++j) { v[j] = hr[64 * j]; ss += v[j].x * v[j].x + v[j].y * v[j].y + v[j].z * v[j].z + v[j].w * v[j].w; }
    ss = wave_sum(ss);
    float r = rsqrtf(ss * (1.f / D) + EPS);
    float4* o = (float4*)(p.out + (size_t)r0 * D) + lane;
#pragma unroll
    for (int j = 0; j < 4; ++j) {
      float4 g = *(const float4*)(gain + lane * 4 + 256 * j);
      o[64 * j] = make_float4(v[j].x * r * g.x, v[j].y * r * g.y, v[j].z * r * g.z, v[j].w * r * g.w);
    }
  }
}

__device__ __forceinline__ void premix_task(const Ctx& p, int l, int task, char* smem) {
  const int tid = tid_l(), lane = tid & 63, wid = tid >> 6;
  const int part = task / 264, tile64 = task - part * 264;
  const int m0 = tile64 * 64, b = m0 / SP, pos0 = m0 - b * SP;
  const bool isctx = pos0 < CTX;
  const int s0 = isctx ? 0 : CTX, L = isctx ? CTX : SEQ, t0 = pos0 - s0;
  const size_t mb = (size_t)b * SP + s0;
  const u16* proj = (const u16*)(p.ws + WS_PROJ);
  if (part == 0) {
    u16* P = (u16*)smem;
#pragma unroll
    for (int i = tid; i < 80 * 64; i += NT) {
      int r = i >> 6, ch = i & 63, t = t0 - 8 + r;
      uint4 v = make_uint4(0, 0, 0, 0);
      if (t >= 0 && t < L) v = *(const uint4*)(proj + (mb + t) * DINP + ch * 8);
      *(uint4*)(P + r * 512 + ch * 8) = v;
    }
    __syncthreads();
    const int c = tid, g = c >> 7, hw = 1 << g;
    u16* U = (u16*)(p.ws + WS_U);
    float s = 0.f;
    for (int q = -hw; q < hw; ++q) s += bf2f(P[(8 + q) * 512 + c]);
#pragma unroll 4
    for (int tt = 0; tt < 64; ++tt) {
      int t = t0 + tt, lo = max(t - hw, 0), hi = min(t + hw, L);
      float u = s / (float)(hi - lo) - bf2f(P[(tt + 8) * 512 + c]);
      U[(mb + t) * 512 + c] = f2bf(u);
      s += bf2f(P[(tt + 8 + hw) * 512 + c]) - bf2f(P[(tt + 8 - hw) * 512 + c]);
    }
    __syncthreads();
  } else if (part <= 4) {
    const int ch0 = (part - 1) * 128;
    constexpr int PITCH = 136;
    u16* X = (u16*)smem;
    float* T = (float*)(smem + 3 * 66 * PITCH * 2 + 64);
#pragma unroll
    for (int ii = 0; ii < 7; ++ii) {
      const int i = tid + ii * NT;
      if (i >= 3 * 66 * 16) break;
      int pr = i / (66 * 16), rem = i - pr * 66 * 16, r = rem >> 4, ch = rem & 15, t = t0 - 1 + r;
      uint4 v = make_uint4(0, 0, 0, 0);
      if (t >= 0 && t < L) v = *(const uint4*)(proj + (mb + t) * DINP + OFF_HY + pr * 512 + ch0 + ch * 8);
      *(uint4*)(X + (pr * 66 + r) * PITCH + ch * 8) = v;
    }
    __syncthreads();
    const float* cw = pin(p, 12) + l * 3 * 1536;
    const float* cb = pin(p, 13) + l * 1536;
    {
      const int c = tid & 127, tq = tid >> 7, col = ch0 + c;
      const float w00 = cw[col], w01 = cw[1536 + col], w02 = cw[3072 + col], b0 = cb[col];
      const float w10 = cw[512 + col], w11 = cw[1536 + 512 + col], w12 = cw[3072 + 512 + col], b1 = cb[512 + col];
      const float w20 = cw[1024 + col], w21 = cw[1536 + 1024 + col], w22 = cw[3072 + 1024 + col], b2 = cb[1024 + col];
      const u16* X0 = X, *X1 = X + 66 * PITCH, *XV = X + 2 * 66 * PITCH;
      u16* Y = (u16*)(p.ws + WS_Y);
#pragma unroll 4
      for (int tt = tq * 16; tt < tq * 16 + 16; ++tt) {
        float x0 = w00 * bf2f(X0[tt * PITCH + c]) + w01 * bf2f(X0[(tt + 1) * PITCH + c]) + w02 * bf2f(X0[(tt + 2) * PITCH + c]) + b0;
        float x1 = w10 * bf2f(X1[tt * PITCH + c]) + w11 * bf2f(X1[(tt + 1) * PITCH + c]) + w12 * bf2f(X1[(tt + 2) * PITCH + c]) + b1;
        float vv = w20 * bf2f(XV[tt * PITCH + c]) + w21 * bf2f(XV[(tt + 1) * PITCH + c]) + w22 * bf2f(XV[(tt + 2) * PITCH + c]) + b2;
        Y[(mb + t0 + tt) * 512 + col] = f2bf(x0);
        T[c * 65 + tt] = x1 * vv;
      }
    }
    __syncthreads();
    {
      float* ZV = (float*)(p.ws + WS_ZV);
#pragma unroll 4
      for (int cc = 0; cc < 16; ++cc) {
        int c = wid * 16 + cc;
        ZV[((size_t)(ch0 + c) * SP + pos0 + lane) * 2 + b] = T[c * 65 + lane];
      }
    }
    __syncthreads();
  } else {
    u16* projw = (u16*)(p.ws + WS_PROJ);
    const float* qg = pin(p, 24) + l * 384;
    const float* kg = pin(p, 26) + l * 256;
    const float2* rope = (const float2*)(p.ws + WS_ROPE);
    u16* Kb = (u16*)(p.ws + WS_K);
#pragma unroll 2
    for (int rr = 0; rr < 8; ++rr) {
      int tt = wid * 8 + rr, pos = pos0 + tt;
      u16* row = projw + ((size_t)b * SP + pos) * DINP;
      unsigned* q32 = (unsigned*)(row + OFF_Q);
      unsigned* k32 = (unsigned*)(row + OFF_KV);
      unsigned v[3], w[2];
      float ss = 0.f, s2 = 0.f;
#pragma unroll
      for (int j = 0; j < 3; ++j) v[j] = q32[lane + 64 * j];
#pragma unroll
      for (int j = 0; j < 2; ++j) w[j] = k32[lane + 64 * j];
      const int rd = lane & 31;
      float val = bf2f(row[OFF_KV + 256 + rd]);
#pragma unroll
      for (int j = 0; j < 3; ++j) { float a = bf2f(v[j] & 0xffff), c2 = bf2f(v[j] >> 16); ss += a * a + c2 * c2; }
#pragma unroll
      for (int j = 0; j < 2; ++j) { float a = bf2f(w[j] & 0xffff), c2 = bf2f(w[j] >> 16); s2 += a * a + c2 * c2; }
      ss = wave_sum(ss);
      s2 = wave_sum(s2);
      float r = rsqrtf(ss * (1.f / 384.f) + EPS), r2 = rsqrtf(s2 * (1.f / 256.f) + EPS);
#pragma unroll
      for (int j = 0; j < 3; ++j) {
        int n = (lane + 64 * j) * 2;
        q32[lane + 64 * j] = pk2(bf2f(v[j] & 0xffff) * r * qg[n], bf2f(v[j] >> 16) * r * qg[n + 1]);
      }
#pragma unroll
      for (int j = 0; j < 2; ++j) {
        int n = (lane + 64 * j) * 2;
        k32[lane + 64 * j] = pk2(bf2f(w[j] & 0xffff) * r2 * kg[n], bf2f(w[j] >> 16) * r2 * kg[n + 1]);
      }
      float partner = shx(val, 8);
      if (!isctx) {
        int t = pos - CTX, idx = (rd < 16) ? (t >> 6) : (t & 63);
        float2 cs = rope[idx * 8 + (rd & 7)];
        float sgn = (rd & 8) ? 1.f : -1.f;
        val = val * cs.x + sgn * partner * cs.y;
      }
      if (lane < 32) {
        u16 o = f2bf(val);
#pragma unroll
        for (int hd = 0; hd < 8; ++hd) Kb[((size_t)(b * 8 + hd) * SP + pos) * 96 + 64 + rd] = o;
      }
    }
  }
}

__device__ __forceinline__ int xi(int i) { const int h = i >> 5; return i ^ (((h & 3) * 5) | ((h & 2) << 3)); }
__device__ __forceinline__ void bf_fwd(float2* X, int base, int q, float2 w1) {
  float2 w2 = cmul(w1, w1), w3 = cmul(w2, w1);
  const int i0 = xi(base), i1 = xi(base + q), i2 = xi(base + 2 * q), i3 = xi(base + 3 * q);
  float2 a0 = X[i0], a1 = X[i1], a2 = X[i2], a3 = X[i3];
  float2 s02 = make_float2(a0.x + a2.x, a0.y + a2.y), d02 = make_float2(a0.x - a2.x, a0.y - a2.y);
  float2 s13 = make_float2(a1.x + a3.x, a1.y + a3.y), d13 = make_float2(a1.x - a3.x, a1.y - a3.y);
  X[i0] = make_float2(s02.x + s13.x, s02.y + s13.y);
  X[i1] = cmul(make_float2(d02.x + d13.y, d02.y - d13.x), w1);
  X[i2] = cmul(make_float2(s02.x - s13.x, s02.y - s13.y), w2);
  X[i3] = cmul(make_float2(d02.x - d13.y, d02.y + d13.x), w3);
}
__device__ __forceinline__ void bf_inv(float2* X, int base, int q, float2 w1) {
  w1.y = -w1.y;
  float2 w2 = cmul(w1, w1), w3 = cmul(w2, w1);
  const int i0 = xi(base), i1 = xi(base + q), i2 = xi(base + 2 * q), i3 = xi(base + 3 * q);
  float2 b0 = X[i0], c1 = cmul(X[i1], w1), c2 = cmul(X[i2], w2), c3 = cmul(X[i3], w3);
  float2 s02 = make_float2(b0.x + c2.x, b0.y + c2.y), d02 = make_float2(b0.x - c2.x, b0.y - c2.y);
  float2 s13 = make_float2(c1.x + c3.x, c1.y + c3.y), d13 = make_float2(c1.x - c3.x, c1.y - c3.y);
  X[i0] = make_float2(s02.x + s13.x, s02.y + s13.y);
  X[i1] = make_float2(d02.x - d13.y, d02.y + d13.x);
  X[i2] = make_float2(s02.x - s13.x, s02.y - s13.y);
  X[i3] = make_float2(d02.x + d13.y, d02.y - d13.x);
}
template <bool INV, int LQ>
__device__ __forceinline__ void fft_pass(float2* X, const float2* __restrict__ tw, const float2 (&twr)[6], int tid) {
  constexpr int q = 1 << LQ;
  if (LQ == 12) {
    float2 w[8];
#pragma unroll
    for (int b8 = 0; b8 < 8; ++b8) w[b8] = tw[b8 * NT + tid];
#pragma unroll
    for (int b8 = 0; b8 < 8; ++b8) { int u = b8 * NT + tid; if (INV) bf_inv(X, u, q, w[b8]); else bf_fwd(X, u, q, w[b8]); }
  } else if (LQ == 10) {
#pragma unroll 2
    for (int b8 = 0; b8 < 8; ++b8) {
      int u = b8 * NT + tid, j = u & 1023, base = ((u >> 10) << 12) + j;
      float2 w = (b8 & 1) ? twr[1] : twr[0];
      if (INV) bf_inv(X, base, q, w); else bf_fwd(X, base, q, w);
    }
  } else {
    const int j = tid & (q - 1);
    const float2 w = (LQ == 0) ? make_float2(1.f, 0.f) : twr[2 + (8 - LQ) / 2];
#pragma unroll 2
    for (int b8 = 0; b8 < 8; ++b8) {
      int u = b8 * NT + tid, base = ((u >> LQ) << (LQ + 2)) + j;
      if (INV) bf_inv(X, base, q, w); else bf_fwd(X, base, q, w);
    }
  }
  __syncthreads();
}
__device__ __forceinline__ void fft_load_tw(const float2* __restrict__ tw, int tid, float2 (&twr)[6]) {
  twr[0] = tw[tid << 2];
  twr[1] = tw[(512 + tid) << 2];
  twr[2] = tw[(tid & 255) << 4];
  twr[3] = tw[(tid & 63) << 6];
  twr[4] = tw[(tid & 15) << 8];
  twr[5] = tw[(tid & 3) << 10];
}
__device__ __forceinline__ void fft_dif(float2* X, const float2* __restrict__ tw, const float2 (&twr)[6]) {
  const int tid = tid_l();
  fft_pass<false, 12>(X, tw, twr, tid); fft_pass<false, 10>(X, tw, twr, tid); fft_pass<false, 8>(X, tw, twr, tid); fft_pass<false, 6>(X, tw, twr, tid);
  fft_pass<false, 4>(X, tw, twr, tid); fft_pass<false, 2>(X, tw, twr, tid); fft_pass<false, 0>(X, tw, twr, tid);
}
__device__ __forceinline__ void fft_dit_inv(float2* X, const float2* __restrict__ tw, const float2 (&twr)[6]) {
  const int tid = tid_l();
  fft_pass<true, 0>(X, tw, twr, tid); fft_pass<true, 2>(X, tw, twr, tid); fft_pass<true, 4>(X, tw, twr, tid); fft_pass<true, 6>(X, tw, twr, tid);
  fft_pass<true, 8>(X, tw, twr, tid); fft_pass<true, 10>(X, tw, twr, tid); fft_pass<true, 12>(X, tw, twr, tid);
}
__device__ __forceinline__ float block_sum(float v, float* red) {
  v = wave_sum(v);
  __syncthreads();
  { const int tb = tid_l(); if ((tb & 63) == 0) red[tb >> 6] = v; }
  __syncthreads();
  float s = red[0] + red[1] + red[2] + red[3] + red[4] + red[5] + red[6] + red[7];
  __syncthreads();
  return s;
}

__device__ __forceinline__ void fft_task(const Ctx& p, int l, int c, char* smem) {
  float2* X = (float2*)smem;
  float* aux = (float*)(smem + AUX_OFF);
  float* red = aux + 128;
  const int tid = tid_l();
  const float2* tw = (const float2*)(p.ws + WS_TW);
  float2 twr[6];
  fft_load_tw(tw, tid, twr);
  const float* w3 = pin(p, 20) + (size_t)l * 64 * 1024;
  if (tid < 64) { aux[tid] = w3[tid * 1024 + c]; aux[64 + tid] = w3[tid * 1024 + 512 + c]; }
  __syncthreads();
  const float dF = fabsf(pin(p, 21)[(l * 2 + 0) * 512 + c]), dB = fabsf(pin(p, 21)[(l * 2 + 1) * 512 + c]);
  const float bias = pin(p, 22)[l * 512 + c];
  float2* zp = (float2*)(p.ws + WS_ZV) + (size_t)c * SP;
  float l1 = 0.f;
  {
    const u16* ff = (const u16*)((const char*)p.out + WO_FILT) + (size_t)c * 8192 + tid;
    const u16* fb = ff + (size_t)512 * 8192;
    u16 rf[16], rb[16];
#pragma unroll
    for (int i = 0; i < 16; ++i) { rf[i] = ff[i * NT]; rb[i] = fb[i * NT]; }
#pragma unroll
    for (int i = 0; i < 16; ++i) {
      int t = i * NT + tid;
      float tl = (float)t * (1.f / 8191.f);
      float hf = bf2f(rf[i]) * expf(-tl * dF);
      float hb = bf2f(rb[i]) * expf(-tl * dB);
      X[xi(t)] = make_float2(hf, 0.f);
      if (t >= 1) { X[xi(16384 - t)] = make_float2(hb, 0.f); l1 += fabsf(hf) + fabsf(hb); }
      else { X[xi(8192)] = make_float2(0.f, 0.f); l1 += fabsf(hf); }
    }
  }
  float l1tot = block_sum(l1, red);
  fft_dif(X, tw, twr);
  float2 F[32];
  {
    float s = 1.f / (l1tot * 16384.f);
#pragma unroll
    for (int i = 0; i < 32; ++i) { float2 v = X[xi(i * NT + tid)]; F[i] = make_float2(v.x * s, v.y * s); }
  }
  __syncthreads();
#pragma unroll 8
  for (int i = 0; i < 16; ++i) {
    int t = i * NT + tid;
    X[xi(t)] = zp[CTX + t];
    X[xi(8192 + t)] = make_float2(0.f, 0.f);
  }
  __syncthreads();
  fft_dif(X, tw, twr);
#pragma unroll
  for (int i = 0; i < 32; ++i) { int idx = xi(i * NT + tid); X[idx] = cmul(X[idx], F[i]); }
  __syncthreads();
  fft_dit_inv(X, tw, twr);
  {
    float2 zz[16];
#pragma unroll
    for (int i = 0; i < 16; ++i) zz[i] = zp[CTX + i * NT + tid];
#pragma unroll
    for (int i = 0; i < 16; ++i) {
      int t = i * NT + tid;
      float2 y = X[xi(t)];
      zp[CTX + t] = make_float2(y.x + bias * zz[i].x, y.y + bias * zz[i].y);
    }
  }
  __syncthreads();
  {
    float* hFc = (float*)smem;
    float* hBc = hFc + 256;
    float2* zc = (float2*)(hBc + 256);
    float l1c = 0.f;
    if (tid < 256) {
      int t = tid;
      const float* hc = (const float*)(p.ws + WS_HID2C) + (size_t)l * 64 * 256 + t;
      float hf = 0.f, hb = 0.f;
#pragma unroll 16
      for (int k = 0; k < 64; ++k) { float v = hc[k * 256]; hf += v * aux[k]; hb += v * aux[64 + k]; }
      float tl = (float)t * (1.f / 255.f);
      hf *= expf(-tl * dF);
      hb *= expf(-tl * dB);
      hFc[t] = hf;
      hBc[t] = hb;
      l1c = fabsf(hf) + (t >= 1 ? fabsf(hb) : 0.f);
      zc[t] = zp[t];
    }
    float l1ct = block_sum(l1c, red);
    const int bb = tid >> 8, t = tid & 255;
    float acc = 0.f;
    for (int s = 0; s < 256; ++s) {
      float kf = (s <= t) ? hFc[t - s] : hBc[s - t];
      float2 z = zc[s];
      acc += kf * (bb ? z.y : z.x);
    }
    float2 z = zc[t];
    ((float*)zp)[t * 2 + bb] = acc / l1ct + bias * (bb ? z.y : z.x);
    __syncthreads();
  }
}

constexpr int AT_KT = 128, AT_KP = 208, AT_VP = 264, AT_STAGE = AT_KT * AT_KP + 64 * AT_VP;
__device__ __forceinline__ void attn_task(const Ctx& p, int bh, int qb, char* smem) {
  const int tid = tid_l(), wid = tid >> 6, lane = tid & 63, r = lane & 31, hh = lane >> 5;
  const u16* Qp = (const u16*)(p.ws + WS_Q) + ((size_t)bh * SP + qb * 256) * 96;
  const u16* Kp = (const u16*)(p.ws + WS_K) + (size_t)bh * SP * 96;
  const u16* Vp = (const u16*)(p.ws + WS_VT) + (size_t)bh * 64 * SP;
  const int nkt = (qb == 0) ? 2 : 66;
  bf16x8 qf[6];
#pragma unroll
  for (int ks = 0; ks < 6; ++ks) qf[ks] = *(const bf16x8*)(Qp + (size_t)(wid * 32 + r) * 96 + ks * 16 + hh * 8);
  f32x16 o0, o1;
#pragma unroll
  for (int i = 0; i < 16; ++i) { o0[i] = 0.f; o1[i] = 0.f; }
  float mrun = 0.f, lrun = 0.f;
  const u16* src[5];
  int dst[5];
#pragma unroll
  for (int i = 0; i < 5; ++i) {
    int ch = tid + i * NT;
    if (i < 3) { int row = ch / 12, cc = ch - row * 12; src[i] = Kp + (size_t)row * 96 + cc * 8; dst[i] = row * AT_KP + cc * 16; }
    else { int v = ch - 1536, row = v >> 4, cc = v & 15; src[i] = Vp + (size_t)row * SP + cc * 8; dst[i] = AT_KT * AT_KP + row * AT_VP + cc * 16; }
  }
  uint4 st[5];
#define AT_LOAD(t)                                                                                   \
  do {                                                                                               \
    _Pragma("unroll") for (int i = 0; i < 5; ++i) st[i] = *(const uint4*)(src[i] + (size_t)(t) * (i < 3 ? AT_KT * 96 : AT_KT)); \
  } while (0)
#define AT_WRITE(buf)                                                                                \
  do {                                                                                               \
    char* base_ = smem + (buf) * AT_STAGE;                                                           \
    _Pragma("unroll") for (int i = 0; i < 5; ++i) {                                                  \
      uint2* d_ = (uint2*)(base_ + dst[i]);                                                          \
      d_[0] = make_uint2(st[i].x, st[i].y);                                                          \
      d_[1] = make_uint2(st[i].z, st[i].w);                                                          \
    }                                                                                                \
  } while (0)
#define AT_QK(S, kb)                                                                                 \
  __builtin_amdgcn_s_setprio(1);                                                                     \
  _Pragma("unroll") for (int ks = 0; ks < 6; ++ks) {                                                 \
    bf16x8 a_ = *(const bf16x8*)(Ks + ((kb) * 32 + r) * AT_KP + ks * 32 + hh * 16);                  \
    S = __builtin_amdgcn_mfma_f32_32x32x16_bf16(a_, qf[ks], S, 0, 0, 0);                             \
  }                                                                                                  \
  __builtin_amdgcn_s_setprio(0);
#define AT_SOFT_PV(S, kb)                                                                            \
  _Pragma("unroll") for (int i = 0; i < 16; ++i) { S[i] = __builtin_amdgcn_exp2f(S[i]); ps += S[i]; pmx = fmaxf(pmx, S[i]); } \
  _Pragma("unroll") for (int sI = 0; sI < 2; ++sI) {                                                 \
    union { bf16x8 v; unsigned u[4]; } pu;                                                           \
    _Pragma("unroll") for (int j = 0; j < 4; ++j) pu.u[j] = pk2(S[8 * sI + 2 * j], S[8 * sI + 2 * j + 1]); \
    const int koff = ((kb) * 32 + 16 * sI + 4 * hh) * 2;                                             \
    union { bf16x8 v; uint2 h2[2]; } va, vb;                                                         \
    va.h2[0] = *(const uint2*)(Vs + r * AT_VP + koff);                                               \
    va.h2[1] = *(const uint2*)(Vs + r * AT_VP + koff + 16);                                          \
    vb.h2[0] = *(const uint2*)(Vs + (32 + r) * AT_VP + koff);                                        \
    vb.h2[1] = *(const uint2*)(Vs + (32 + r) * AT_VP + koff + 16);                                   \
    o0 = __builtin_amdgcn_mfma_f32_32x32x16_bf16(va.v, pu.v, o0, 0, 0, 0);                           \
    o1 = __builtin_amdgcn_mfma_f32_32x32x16_bf16(vb.v, pu.v, o1, 0, 0, 0);                           \
  }
  AT_LOAD(0);
  AT_WRITE(0);
  __syncthreads();
  for (int t = 0; t < nkt; ++t) {
    const int cur = t & 1;
    if (t + 1 < nkt) AT_LOAD(t + 1);
    const char* Ks = smem + cur * AT_STAGE;
    const char* Vs = Ks + AT_KT * AT_KP;
    const float nm = -mrun;
    f32x16 sA, sB;
    float ps = 0.f, pmx = 0.f;
#pragma unroll
    for (int i = 0; i < 16; ++i) sA[i] = nm;
    AT_QK(sA, 0)
#pragma unroll
    for (int i = 0; i < 16; ++i) sB[i] = nm;
    AT_QK(sB, 1)
    AT_SOFT_PV(sA, 0)
#pragma unroll
    for (int i = 0; i < 16; ++i) sA[i] = nm;
    AT_QK(sA, 2)
    AT_SOFT_PV(sB, 1)
#pragma unroll
    for (int i = 0; i < 16; ++i) sB[i] = nm;
    AT_QK(sB, 3)
    AT_SOFT_PV(sA, 2)
    AT_SOFT_PV(sB, 3)
    lrun += ps;
    pmx = fmaxf(pmx, shx(pmx, 32));
    if (__any(pmx > 256.f)) {
      const float delta = pmx > 256.f ? ceilf(__log2f(pmx)) : 0.f;
      const float alpha = __builtin_amdgcn_exp2f(-delta);
      mrun += delta;
      lrun *= alpha;
#pragma unroll
      for (int i = 0; i < 16; ++i) { o0[i] *= alpha; o1[i] *= alpha; }
    }
    if (t + 1 < nkt) AT_WRITE(cur ^ 1);
    __syncthreads();
  }
  const float ltot = lrun + shx(lrun, 32);
  const float inv = 1.f / ltot;
  const int b = bh >> 3, head = bh & 7;
  u16* Op = (u16*)(p.ws + WS_O) + ((size_t)b * SP + qb * 256 + wid * 32 + r) * 512 + head * 64;
#pragma unroll
  for (int g = 0; g < 4; ++g) {
    uint2 w0, w1;
    w0.x = pk2(o0[4 * g] * inv, o0[4 * g + 1] * inv);
    w0.y = pk2(o0[4 * g + 2] * inv, o0[4 * g + 3] * inv);
    w1.x = pk2(o1[4 * g] * inv, o1[4 * g + 1] * inv);
    w1.y = pk2(o1[4 * g + 2] * inv, o1[4 * g + 3] * inv);
    *(uint2*)(Op + 8 * g + 4 * hh) = w0;
    *(uint2*)(Op + 32 + 8 * g + 4 * hh) = w1;
  }
#undef AT_LOAD
#undef AT_WRITE
#undef AT_QK
#undef AT_SOFT_PV
}

__device__ __forceinline__ void hypost_task(const Ctx& p, int task, char* smem) {
  const int tid = tid_l(), lane = tid & 63, wid = tid >> 6;
  const int tile64 = task >> 1, ch0 = (task & 1) * 256;
  const int m0 = tile64 * 64, b = m0 / SP, pos0 = m0 - b * SP;
  float* T = (float*)smem;
  const float* ZV = (const float*)(p.ws + WS_ZV);
#pragma unroll 8
  for (int cc = 0; cc < 32; ++cc) {
    int c = wid * 32 + cc;
    T[c * 65 + lane] = ZV[((size_t)(ch0 + c) * SP + pos0 + lane) * 2 + b];
  }
  __syncthreads();
  u16* Y = (u16*)(p.ws + WS_Y);
  const int c = tid & 255, th = tid >> 8;
  u16* yp = Y + (size_t)(m0 + th * 32) * 512 + ch0 + c;
  u16 yv[32];
#pragma unroll
  for (int i = 0; i < 32; ++i) yv[i] = yp[(size_t)i * 512];
#pragma unroll
  for (int i = 0; i < 32; ++i) yp[(size_t)i * 512] = f2bf(bf2f(yv[i]) * T[c * 65 + th * 32 + i]);
  __syncthreads();
}

#ifndef PHMASK
#define PHMASK 0xFFFF
#endif
#define PHON(k) (((PHMASK) >> (k)) & 1)
constexpr int NPH = 1 + 4 * 10 + 1;
__global__ void __launch_bounds__(NT, 2) mega(Params prm) {
  __shared__ __attribute__((aligned(1024))) char smem[LDS_BYTES];
  cg::grid_group grid = cg::this_grid();
  const int bid = blockIdx.x, nb = gridDim.x;
  {
    unsigned long long* it = (unsigned long long*)(smem + AUX_OFF + 6144);
    if (threadIdx.x < 33) it[threadIdx.x] = (unsigned long long)prm.in[threadIdx.x];
    if (threadIdx.x == 0) *(uint4*)(smem + AUX_OFF + 7168) = make_uint4(0u, 0u, 0u, 0u);
    __syncthreads();
  }
  XcdBarrier xbar = xcd_barrier_post((unsigned*)(prm.ws + WS_BAR), (volatile LAS unsigned*)(smem + AUX_OFF + 7168));
  if (prm.ph_lo == 0) {
    Ctx p;
    p.intab = (const unsigned long long*)(smem + AUX_OFF + 6144);
    p.ws = prm.ws;
    p.out = prm.out;
    const int bid = blockIdx.x, nb = gridDim.x;
      if (PHON(10)) {
      p0_misc(p);
      for (int t = bid; t < 192; t += nb) p0_mod_task(p, t, smem);
      for (int t = bid; t < 528; t += nb) p0_hid_task(p, t, smem);
      for (int t = bid; t < 128; t += nb) { const int w = (t + 64) & 127; wpe_task(p, w >> 5, w & 31, smem); }
      }
  }
  unsigned nbar = 0;
  for (int ph = prm.ph_lo; ph < prm.ph_hi; ++ph) {
    Ctx p;
    p.intab = (const unsigned long long*)(smem + AUX_OFF + 6144);
    p.ws = prm.ws;
    p.out = prm.out;
    asm volatile("" : "+s"(p.ws), "+s"(p.out));
    float* modall = (float*)(p.ws + WS_MOD);
    u16* proj = (u16*)(p.ws + WS_PROJ);
    u16* xn = (u16*)(p.ws + WS_U);
    char* wo = (char*)p.out;
    if (ph == 0) {
    } else if (ph == NPH - 1) {
      if (PHON(11)) final_norm(p);
    } else {
      const int l = (ph - 1) / 10, sp = (ph - 1) % 10;
      const float* modl = modall + (size_t)l * 3 * 6144;
      GD* tab = (GD*)(smem + AUX_OFF + 4096);
      int ng = 0, nN0 = 0, nN1 = 0, nsplit = 1;
      bool seq = false;
      const float* gate = modl;
      if (sp == 0 && PHON(0)) {
        wt_phase(p, l, smem);
        norm_rows(p, pin(p, 6) + l * 1024, modl, 0, 1, xn);
      } else if (sp == 1 && PHON(1)) {
        if (threadIdx.x == 0) tab[0] = GD{xn, 1024, (const u16*)(wo + WO_IN), 1024, 1024, 23, EM_PROJ, 1};
        ng = 1; nN0 = 23;
      } else if (sp == 2 && PHON(2)) {
        for (int t = bid; t < 264 * 6; t += nb) premix_task(p, l, t, smem);
        {
          Epi ef{EM_FILT, p.ws, gate, nullptr, (u16*)(wo + WO_FILT)};
          const u16* hA = (const u16*)(p.ws + WS_HID2) + (size_t)l * 8192 * 64;
          const u16* wB = (const u16*)(p.ws + WS_W3T) + (size_t)l * 1024 * 64;
#pragma unroll 1
          for (int t = nb - 1 - bid; t < 128; t += nb) gemm_tile(hA, 64, wB, 64, 64, (t >> 2) * 256, (t & 3) * 256, smem, ef);
        }
      } else if (sp == 3 && PHON(3)) {
        for (int t = bid; t < 512; t += nb) fft_task(p, l, t, smem);
        if (threadIdx.x == 0) {
          tab[0] = GD{proj + OFF_Q, DINP, (const u16*)(wo + WO_UQ), 384, 384, 3, EM_Q, 1};
          tab[1] = GD{proj + OFF_KV, DINP, (const u16*)(wo + WO_UKV), 256, 256, 4, EM_KV, 1};
        }
        ng = 2; nN0 = 3; nN1 = 4;
        for (int i = tid_l(); i < 1024; i += NT) ((float2*)(smem + 131072))[i] = ((const float2*)(p.ws + WS_ROPE))[i];
      } else if (sp == 4 && PHON(4)) {
        for (int t = bid; t < 528; t += nb) {
          int bh, qb;
          if (t < 512) { int rnd = t >> 8, w = t & 255; bh = (w & 7) + 8 * rnd; qb = 1 + (w >> 3); }
          else { bh = t - 512; qb = 0; }
          attn_task(p, bh, qb, smem);
        }
        for (int t = bid; t < 528; t += nb) hypost_task(p, t, smem);
      } else if (sp == 5 && PHON(5)) {
        for (int t = bid; t < 8 * 68; t += nb) {
          const int x = t & 7, g = t >> 3, pm = (g >> 2) * 8 + x;
          if (pm < 132) mix_tile(p, l, pm, g & 3, smem);
        }
      } else if (sp == 6 && PHON(6)) {
        if (threadIdx.x == 0) tab[0] = GD{(const u16*)(p.ws + WS_ZV), 1024, (const u16*)(wo + WO_OUT), 1024, 1024, 4, EM_RESID, 4};
        ng = 1; nN0 = 4; nsplit = 4;
        gate = modl + 2 * 1024;
      } else if (sp == 7 && PHON(7)) {
        norm_rows(p, pin(p, 7) + l * 1024, modl, 3, 4, xn);
      } else if (sp == 8 && PHON(8)) {
        if (threadIdx.x == 0) tab[0] = GD{xn, 1024, (const u16*)(wo + WO_FF1), 1024, 1024, 16, EM_SQRELU, 1};
        ng = 1; nN0 = 16;
      } else if (sp == 9 && PHON(9)) {
        if (threadIdx.x == 0) tab[0] = GD{proj, DFF, (const u16*)(wo + WO_FF2), 4096, 4096, 4, EM_RESID, 8};
        ng = 1; nN0 = 4; nsplit = 8;
        gate = modl + 5 * 1024;
      }
      if (ng > 0) {
        __syncthreads();
        const int nt0 = (nsplit > 1) ? (64 * nN0 + 2 * nN0 * nsplit) : NMT * nN0, ntot = seq ? nt0 : nt0 + NMT * nN1;
        const int nseq = seq ? ng : 1;
        const int nitems = ((ntot - bid + nb - 1) / nb) * nseq;
#pragma unroll 1
        for (int it = 0; it < nitems; ++it) {
          int t = bid + (it / nseq) * nb, gi = it % nseq, tt = t;
          if (!seq && t >= nt0) { gi = 1; tt = t - nt0; }
          const volatile GD* gp = tab + gi;
          unsigned long long a64 = (unsigned long long)gp->A, b64 = (unsigned long long)gp->Bt;
          a64 = ((unsigned long long)(unsigned)__builtin_amdgcn_readfirstlane((unsigned)(a64 >> 32)) << 32) | (unsigned long long)(unsigned)__builtin_amdgcn_readfirstlane((unsigned)a64);
          b64 = ((unsigned long long)(unsigned)__builtin_amdgcn_readfirstlane((unsigned)(b64 >> 32)) << 32) | (unsigned long long)(unsigned)__builtin_amdgcn_readfirstlane((unsigned)b64);
          const int lda = __builtin_amdgcn_readfirstlane(gp->lda), ldb = __builtin_amdgcn_readfirstlane(gp->ldb);
          const int K = __builtin_amdgcn_readfirstlane(gp->K), nN = __builtin_amdgcn_readfirstlane(gp->nN);
          const int ks = __builtin_amdgcn_readfirstlane(gp->ks);
          const int mode = __builtin_amdgcn_readfirstlane(gp->mode);
          int pm, pn, Kuse = K, emode = mode;
          if (ks > 1) {
            const int nlat = 64 * nN;
            if (tt < nlat) { int pm64; tile_map(tt, 64, nN, pm64, pn); pm = (pm64 >> 5) * 33 + 1 + (pm64 & 31); }
            else {
              int u = tt - nlat, kp = u % ks, tile = u / ks;
              pm = (tile / nN) * 33; pn = tile % nN;
              Kuse = K / ks; emode = EM_RESID_AT;
              a64 += (unsigned long long)kp * Kuse * 2; b64 += (unsigned long long)kp * Kuse * 2;
            }
          } else tile_map(tt, NMT, nN, pm, pn);
          Epi e{emode, p.ws, gate, (const float2*)(smem + 131072), nullptr};
          gemm_tile((const u16*)a64, lda, (const u16*)b64, ldb, Kuse, pm * 256, pn * 256, smem, e);
        }
      }
    }
    if (ph + 1 < prm.ph_hi) {
      if (ph == prm.ph_lo) grid.sync();
      else xcd_barrier(xbar);
    }
  }
}

extern "C" void kernel_launch(void* const* d_in, const int* in_sizes, int n_in, void* d_out, int out_size, void* d_ws,
                              size_t ws_size, hipStream_t stream) {
  static int grid_blocks = 0;
  if (grid_blocks == 0) {
    if (n_in != 33 || ws_size < WS_END || (size_t)out_size * 4 < WO_END) {
      fprintf(stderr, "kernel_launch: unexpected sizes n_in=%d ws=%zu (need %zu) out=%d\n", n_in, ws_size, (size_t)WS_END, out_size);
      grid_blocks = -1;
      return;
    }
    int dev = 0, cus = 0, per_cu = 0;
    hipGetDevice(&dev);
    hipDeviceGetAttribute(&cus, hipDeviceAttributeMultiprocessorCount, dev);
    hipOccupancyMaxActiveBlocksPerMultiprocessor(&per_cu, mega, NT, 0);
    if (per_cu < 1) per_cu = 1;
    if (per_cu > 1) per_cu = 1;
    grid_blocks = cus * per_cu;
  }
  if (grid_blocks < 0) return;
  Params p{};
  for (int i = 0; i < 33; ++i) p.in[i] = (const float*)d_in[i];
  p.out = (float*)d_out;
  p.ws = (char*)d_ws;
  p.ph_lo = 0;
  p.ph_hi = NPH;
  (void)hipMemsetAsync((char*)d_ws + WS_BAR, 0, 16384, stream);
  void* args[] = {&p};
  hipError_t e = hipLaunchCooperativeKernel((void*)mega, dim3(grid_blocks), dim3(NT), args, 0, stream);
  if (e != hipSuccess) fprintf(stderr, "cooperative launch failed: %s (grid %d)\n", hipGetErrorString(e), grid_blocks);
}
```

```cpp
#include <hip/hip_runtime.h>
#include <hip/hip_cooperative_groups.h>
#include <cstdio>
namespace cg = cooperative_groups;

typedef unsigned short u16;
using bf16x8 = __attribute__((ext_vector_type(8))) short;
using f32x4 = __attribute__((ext_vector_type(4))) float;
using f32x16 = __attribute__((ext_vector_type(16))) float;

constexpr int D = 1024, SEQ = 8192, CTX = 256, SP = 8448, MROWS = 16896, NMT = 66;
constexpr int DIN = 5792, DINP = 5888, DFF = 4096;
constexpr int OFF_HY = 512, OFF_Q = 2048, OFF_KV = 2432, OFF_GATE = 2720;
constexpr int NT = 512;
constexpr float EPS = 1e-6f;

constexpr size_t WS_H = 0;
constexpr size_t WS_PROJ = WS_H + (size_t)MROWS * D * 4;
constexpr size_t WS_U = WS_PROJ + (size_t)MROWS * DINP * 2;
constexpr size_t WS_Y = WS_U + (size_t)MROWS * 512 * 2;
constexpr size_t WS_O = WS_Y + (size_t)MROWS * 512 * 2;
constexpr size_t WS_Q = WS_O + (size_t)MROWS * 512 * 2;
constexpr size_t WS_K = WS_Q + (size_t)16 * SP * 96 * 2;
constexpr size_t WS_VT = WS_K + (size_t)16 * SP * 96 * 2;
constexpr size_t WS_ZV = WS_VT + (size_t)16 * 64 * SP * 2;
constexpr size_t WS_HID2 = WS_ZV + (size_t)512 * SP * 8;
constexpr size_t WS_HID2C = WS_HID2 + (size_t)4 * 8192 * 64 * 4;
constexpr size_t WS_MOD = WS_HID2C + (size_t)4 * 256 * 64 * 4;
constexpr size_t WS_ROPE = WS_MOD + (size_t)4 * 3 * 6144 * 4;
constexpr size_t WS_TW = WS_ROPE + (size_t)128 * 8 * 8;
constexpr size_t WS_WPE = WS_TW + (size_t)16384 * 8;
constexpr size_t WS_BAR = WS_WPE + (size_t)4 * 1024 * 512 * 2;
constexpr size_t WS_END = WS_BAR + 16384;
constexpr size_t WO_IN = 0;
constexpr size_t WO_FF1 = WO_IN + (size_t)DINP * 1024 * 2;
constexpr size_t WO_FF2 = WO_FF1 + (size_t)4096 * 1024 * 2;
constexpr size_t WO_OUT = WO_FF2 + (size_t)4096 * 1024 * 2;
constexpr size_t WO_HY = WO_OUT + (size_t)1024 * 1024 * 2;
constexpr size_t WO_WO = WO_HY + (size_t)1024 * 512 * 2;
constexpr size_t WO_PE = WO_WO + (size_t)1024 * 512 * 2;
constexpr size_t WO_UQ = WO_PE + (size_t)1024 * 512 * 2;
constexpr size_t WO_UKV = WO_UQ + (size_t)768 * 384 * 2;
constexpr size_t WO_FILT = WO_UKV + (size_t)1024 * 256 * 2;
constexpr size_t WO_END = WO_FILT + (size_t)1024 * 8192 * 2;
constexpr size_t WS_W3T = WS_HID2 + (size_t)4 * 8192 * 64 * 2;

constexpr int AUX_OFF = 147456;
constexpr int LDS_BYTES = AUX_OFF + 8192;

struct Params {
  const float* in[33];
  float* out;
  char* ws;
  int ph_lo, ph_hi;
};

struct Ctx { const unsigned long long* intab; char* ws; float* out; };
__device__ __forceinline__ const float* pin(const Ctx& c, int i) {
  unsigned long long v = c.intab[i];
  unsigned lo = __builtin_amdgcn_readfirstlane((unsigned)v), hi = __builtin_amdgcn_readfirstlane((unsigned)(v >> 32));
  return (const float*)(((unsigned long long)hi << 32) | lo);
}

typedef __bf16 hwbf2 __attribute__((ext_vector_type(2)));
typedef float hwf2 __attribute__((ext_vector_type(2)));
__device__ __forceinline__ unsigned pk2(float a, float b) {
  hwf2 v = {a, b};
  hwbf2 r = __builtin_convertvector(v, hwbf2);
  return __builtin_bit_cast(unsigned, r);
}
__device__ __forceinline__ u16 f2bf(float f) { return (u16)(pk2(f, 0.f) & 0xffffu); }
__device__ __forceinline__ float bf2f(u16 b) { return __uint_as_float(((unsigned)b) << 16); }
__device__ __forceinline__ float shx(float v, int o) {
  int l = __builtin_amdgcn_mbcnt_hi(~0u, __builtin_amdgcn_mbcnt_lo(~0u, 0u));
  asm volatile("" : "+v"(l));
  return __int_as_float(__builtin_amdgcn_ds_bpermute((l ^ o) << 2, __float_as_int(v)));
}
__device__ __forceinline__ float wave_sum(float v) {
#pragma unroll
  for (int o = 1; o < 64; o <<= 1) v += shx(v, o);
  return v;
}
__device__ __forceinline__ int grp_of_row(int m) {
  int tile = m >> 8, b = tile / 33, t33 = tile - b * 33;
  return t33 == 0 ? 2 : b;
}
__device__ __forceinline__ float2 cmul(float2 a, float2 b) { return make_float2(a.x * b.x - a.y * b.y, a.x * b.y + a.y * b.x); }

__device__ __forceinline__ int tid_l() { int t = threadIdx.x; asm volatile("" : "+v"(t)); return t; }
#define XB_TMO      128
#define XB_XCNT(j)  (256  + 64 * (j))
#define XB_XSUB(j)  (1280 + 64 * (j))
#define XB_XGEN(j)  (2304 + 64 * (j))
#define XB_TOP      3328
#define XB_TOPGEN   3392
#define XCD_BAR_WORDS 3456
#define XB_SPIN_CAP (1u << 18)
#define LAS __attribute__((address_space(3)))
__device__ __forceinline__ unsigned xb_ld(unsigned* p)              { return __hip_atomic_load(p, __ATOMIC_RELAXED, __HIP_MEMORY_SCOPE_AGENT); }
__device__ __forceinline__ unsigned xb_add(unsigned* p, unsigned v) { return __hip_atomic_fetch_add(p, v, __ATOMIC_RELAXED, __HIP_MEMORY_SCOPE_AGENT); }
__device__ __forceinline__ unsigned xb_xcc_id() { return (unsigned)__builtin_amdgcn_s_getreg((3 << 11) | 20) & 0xFu; }
#define XB_SPIN(cond, bar) do { unsigned _sp = 0; while (cond) { __builtin_amdgcn_s_sleep(1); \
    if ((++_sp & 255u) == 0u) { if (xb_ld(&(bar)[XB_TMO])) break; if (_sp > XB_SPIN_CAP) { atomicAdd(&(bar)[XB_TMO], 1u); break; } } } } while (0)
struct XcdBarrier { unsigned* bar; unsigned x; volatile LAS unsigned* st; };
__device__ __forceinline__ XcdBarrier xcd_barrier_post(unsigned* bar, volatile LAS unsigned* st) {
    XcdBarrier b; b.bar = bar; b.x = xb_xcc_id(); b.st = st;
    if (threadIdx.x == 0) (void)xb_add(&bar[XB_XCNT(b.x)], 1u);
    return b;
}
__device__ __forceinline__ void xcd_barrier_complete(unsigned* bar, unsigned x, unsigned& nloc, unsigned& nx) {
    const unsigned G = gridDim.x * gridDim.y * gridDim.z;
    unsigned sum, cnt, mine, sp = 0u;
    for (;;) {
        sum = 0u; cnt = 0u; mine = 0u;
#pragma unroll
        for (unsigned j = 0; j < 16; ++j) { const unsigned c = xb_ld(&bar[XB_XCNT(j)]); sum += c; cnt += (c > 0u) ? 1u : 0u; mine = (j == x) ? c : mine; }
        if (sum == G) break;
        __builtin_amdgcn_s_sleep(1);
        if ((++sp & 255u) == 0u) { if (xb_ld(&bar[XB_TMO])) break; if (sp > XB_SPIN_CAP) { atomicAdd(&bar[XB_TMO], 1u); break; } }
    }
    nloc = mine > 0u ? mine : 1u; nx = cnt > 0u ? cnt : 1u;
}
__device__ __forceinline__ void xcd_barrier(const XcdBarrier& b) {
    asm volatile("s_waitcnt vmcnt(0)" ::: "memory");
    __syncthreads();
    if (threadIdx.x == 0) {
        unsigned* bar = b.bar;
        __builtin_amdgcn_s_waitcnt(0);
        unsigned nloc = b.st[0], nx = b.st[1];
        if (nloc == 0u) { xcd_barrier_complete(bar, b.x, nloc, nx); b.st[0] = nloc; b.st[1] = nx; }
        const unsigned old = xb_add(&bar[XB_XSUB(b.x)], 1u);
        const unsigned gen = old / nloc;
        if (old + 1u == (gen + 1u) * nloc) {
            __builtin_amdgcn_fence(__ATOMIC_RELEASE, "agent");
            asm volatile("s_waitcnt vmcnt(0)" ::: "memory");
            const unsigned og = xb_add(&bar[XB_TOP], 1u);
            const unsigned tg = og / nx;
            if (og + 1u == (tg + 1u) * nx) xb_add(&bar[XB_TOPGEN], 1u);
            else XB_SPIN(xb_ld(&bar[XB_TOPGEN]) == tg, bar);
            __builtin_amdgcn_fence(__ATOMIC_ACQUIRE, "agent");
            xb_add(&bar[XB_XGEN(b.x)], 1u);
            asm volatile("s_waitcnt vmcnt(0)" ::: "memory");
        } else {
            XB_SPIN(xb_ld(&bar[XB_XGEN(b.x)]) == gen, bar);
            __builtin_amdgcn_fence(__ATOMIC_ACQUIRE, "agent");
            asm volatile("s_waitcnt vmcnt(0)" ::: "memory");
        }
    }
    __syncthreads();
}

__device__ __forceinline__ void grid_barrier(unsigned* bar, unsigned target) {
  asm volatile("s_waitcnt vmcnt(0)" ::: "memory");
  __syncthreads();
  if (threadIdx.x == 0) {
    __builtin_amdgcn_fence(__ATOMIC_RELEASE, "agent");
    asm volatile("s_waitcnt vmcnt(0)" ::: "memory");
    __hip_atomic_fetch_add(bar, 1u, __ATOMIC_RELAXED, __HIP_MEMORY_SCOPE_AGENT);
    while (__hip_atomic_load(bar, __ATOMIC_RELAXED, __HIP_MEMORY_SCOPE_AGENT) < target) __builtin_amdgcn_s_sleep(2);
    __builtin_amdgcn_fence(__ATOMIC_ACQUIRE, "agent");
    asm volatile("s_waitcnt vmcnt(0)" ::: "memory");
  }
  __syncthreads();
}
#define WAIT_V(n) asm volatile("s_waitcnt vmcnt(%0)" ::"n"(n) : "memory")
#define SCHED() __builtin_amdgcn_sched_barrier(0)
#define RAW_BARRIER() do { asm volatile("s_waitcnt lgkmcnt(0)" ::: "memory"); __builtin_amdgcn_s_barrier(); } while (0)

constexpr float QSCALE = 0.10206207261596575f * 1.4426950408889634f;
enum { EM_PROJ = 0, EM_SQRELU = 1, EM_RESID = 2, EM_RESID_AT = 3, EM_FILT = 4, EM_Q = 6, EM_KV = 7 };
struct Epi {
  int mode;
  char* ws;
  const float* gate;
  const float2* rope_lds;
  u16* filt_out;
  __device__ __forceinline__ void proj(int row, int col, f32x4 v) const {
    {
      u16* out = (u16*)(ws + WS_PROJ);
#pragma unroll
      for (int j = 0; j < 4; ++j) out[(size_t)(row + j) * DINP + col] = f2bf(v[j]);
    }
  }
  __device__ __forceinline__ void sqrelu(int row, int col, f32x4 v) const {
    {
      u16* out = (u16*)(ws + WS_PROJ);
#pragma unroll
      for (int j = 0; j < 4; ++j) { float r = fmaxf(v[j], 0.f); out[(size_t)(row + j) * DFF + col] = f2bf(r * r); }
    }
  }
  __device__ __forceinline__ void resid(int row, int col, f32x4 v) const {
    {
      float* h = (float*)(ws + WS_H);
      float g = gate[grp_of_row(row) * 6144 + col];
#pragma unroll
      for (int j = 0; j < 4; ++j) unsafeAtomicAdd(h + (size_t)(row + j) * D + col, g * v[j]);
    }
  }
  __device__ __forceinline__ void filt(int row, int col, f32x4 v) const {
    uint2 o;
    o.x = pk2(v[0], v[1]);
    o.y = pk2(v[2], v[3]);
    *(uint2*)(filt_out + (size_t)col * 8192 + row) = o;
  }
  __device__ __forceinline__ void q(int row, int col, f32x4 v) const {
    {
      u16* Q = (u16*)(ws + WS_Q);
      const float2* rope = rope_lds;
      int head = col / 96, d = col - head * 96;
      int b = row / SP, pos0 = row - b * SP;
      bool isrope = (d >= 64) && (pos0 >= CTX);
      int rd = d - 64;
#pragma unroll
      for (int j = 0; j < 4; ++j) {
        float val = v[j];
        float partner = shx(val, 8);
        int pos = pos0 + j;
        if (isrope) {
          int t = pos - CTX, idx = (rd < 16) ? (t >> 6) : (t & 63);
          float2 cs = rope[idx * 8 + (rd & 7)];
          float sgn = (rd & 8) ? 1.f : -1.f;
          val = val * cs.x + sgn * partner * cs.y;
        }
        Q[((size_t)(b * 8 + head) * SP + pos) * 96 + d] = f2bf(val * QSCALE);
      }
    }
  }
  __device__ __forceinline__ void kv(int row, int col, f32x4 v) const {
    {
      u16* Kb = (u16*)(ws + WS_K);
      u16* Vt = (u16*)(ws + WS_VT);
      int head = col >> 7, j2 = col & 127;
      int b = row / SP, pos0 = row - b * SP;
      if (j2 < 64) {
#pragma unroll
        for (int j = 0; j < 4; ++j) Kb[((size_t)(b * 8 + head) * SP + pos0 + j) * 96 + j2] = f2bf(v[j]);
      } else {
        uint2 o;
        o.x = pk2(v[0], v[1]);
        o.y = pk2(v[2], v[3]);
        *(uint2*)(Vt + ((size_t)(b * 8 + head) * 64 + (j2 - 64)) * SP + pos0) = o;
      }
    }
  }
};
struct GD { const u16* A; int lda; const u16* Bt; int ldb; int K; int nN; int mode; int ks; };

constexpr int G_TILE_B = 256 * 64 * 2, G_STAGE_B = 2 * G_TILE_B;
__device__ __forceinline__ int lds_byte(int r, int c) {
  int st = (r >> 4) * 2 + (c >> 5), ob = (r & 15) * 64 + (c & 31) * 2;
  return st * 1024 + (ob ^ (((ob >> 9) & 1) << 5));
}
__device__ __forceinline__ void stage_rc(int b, int& R, int& C) {
  int st = b >> 10, sb = b & 1023, swz = sb ^ (((sb >> 9) & 1) << 5);
  R = (st / 2) * 16 + swz / 64;
  C = (st % 2) * 32 + (swz % 64) / 2;
}

template <int MI>
__device__ __forceinline__ void gemm_core(const u16* __restrict__ A, int lda, const u16* __restrict__ Bt, int ldb, int K,
                                          int brow, int bcol, char* shm, f32x4 (&acc)[MI][4]) {
  constexpr int TILE_A = MI * 32 * 64 * 2, TILE_BB = 256 * 64 * 2, STAGE = TILE_A + TILE_BB;
  const int tid = tid_l(), wid = tid >> 6, lane = tid & 63, wr = wid >> 2, wc = wid & 3, fr = lane & 15, fq = lane >> 4;
  const u16* Ab = A + (size_t)brow * lda;
  const u16* Bb = Bt + (size_t)bcol * ldb;
  int sR[4], sC[4];
#pragma unroll
  for (int i = 0; i < 4; ++i) stage_rc(wid * 1024 + i * 8192 + lane * 16, sR[i], sC[i]);
#define SA(b) (shm + (b) * STAGE)
#define SB(b) (shm + (b) * STAGE + TILE_A)
#define GLDS_STAGE(buf, kt)                                                                                              \
  do {                                                                                                                   \
    _Pragma("unroll") for (int i = 0; i < 4; ++i) {                                                                      \
      if (i < MI / 2)                                                                                                    \
        __builtin_amdgcn_global_load_lds((const unsigned*)(Ab + (size_t)sR[i] * lda + (kt) * 64 + sC[i]),                \
                                         (unsigned*)(SA(buf) + wid * 1024 + i * 8192), 16, 0, 0);                        \
      __builtin_amdgcn_global_load_lds((const unsigned*)(Bb + (size_t)sR[i] * ldb + (kt) * 64 + sC[i]),                  \
                                       (unsigned*)(SB(buf) + wid * 1024 + i * 8192), 16, 0, 0);                          \
    }                                                                                                                    \
  } while (0)
  const int nt = K / 64;
  GLDS_STAGE(0, 0);
  WAIT_V(0);
  __syncthreads();
  for (int t = 0; t < nt; ++t) {
    const int cur = t & 1;
    if (t + 1 < nt) GLDS_STAGE(cur ^ 1, t + 1);
#pragma unroll
    for (int ks = 0; ks < 2; ++ks) {
      bf16x8 At[MI], Bf[4];
#pragma unroll
      for (int m = 0; m < MI; ++m) At[m] = *(const bf16x8*)(SA(cur) + lds_byte(wr * (MI * 16) + m * 16 + fr, ks * 32 + fq * 8));
#pragma unroll
      for (int n = 0; n < 4; ++n) Bf[n] = *(const bf16x8*)(SB(cur) + lds_byte(wc * 64 + n * 16 + fr, ks * 32 + fq * 8));
#pragma unroll
      for (int m = 0; m < MI; ++m)
#pragma unroll
        for (int n = 0; n < 4; ++n) acc[m][n] = __builtin_amdgcn_mfma_f32_16x16x32_bf16(At[m], Bf[n], acc[m][n], 0, 0, 0);
      SCHED();
    }
    WAIT_V(0);
    __syncthreads();
  }
#undef SA
#undef SB
#undef GLDS_STAGE
}

template <class EpiT>
__device__ __forceinline__ void gemm_tile(const u16* __restrict__ A, int lda, const u16* __restrict__ Bt, int ldb, int K,
                                          int brow, int bcol, char* shm, const EpiT& epi) {
  const int tid = tid_l(), wid = tid >> 6, lane = tid & 63, wr = wid >> 2, wc = wid & 3, fr = lane & 15, fq = lane >> 4;
  f32x4 acc[8][4];
#pragma unroll
  for (int m = 0; m < 8; ++m)
#pragma unroll
    for (int n = 0; n < 4; ++n) acc[m][n] = (f32x4){0.f, 0.f, 0.f, 0.f};
  gemm_core<8>(A, lda, Bt, ldb, K, brow, bcol, shm, acc);
#define EPI_LOOP(CALL)                                                                              \
  _Pragma("unroll") for (int m = 0; m < 8; ++m) _Pragma("unroll") for (int n = 0; n < 4; ++n) {      \
    const int row = brow + wr * 128 + m * 16 + fq * 4, col = bcol + wc * 64 + n * 16 + fr;           \
    const f32x4 v = acc[m][n];                                                                        \
    CALL;                                                                                             \
  }
  if (epi.mode == EM_PROJ) { EPI_LOOP(epi.proj(row, col, v)) }
  else if (epi.mode == EM_SQRELU) { EPI_LOOP(epi.sqrelu(row, col, v)) }
  else if (epi.mode == EM_RESID_AT) { EPI_LOOP(epi.resid(row, col, v)) }
  else if (epi.mode == EM_RESID) {
    float* h = (float*)(epi.ws + WS_H);
    float g4[4];
#pragma unroll
    for (int n = 0; n < 4; ++n) g4[n] = epi.gate[grp_of_row(brow) * 6144 + bcol + wc * 64 + n * 16 + fr];
    float hv[8][4][4];
    float* hp0 = h + (size_t)(brow + wr * 128 + fq * 4) * D + bcol + wc * 64 + fr;
#define H_LOAD(m) _Pragma("unroll") for (int n = 0; n < 4; ++n) _Pragma("unroll") for (int j = 0; j < 4; ++j) hv[m][n][j] = hp0[(size_t)((m) * 16 + j) * D + n * 16]
#define H_STORE(m) _Pragma("unroll") for (int n = 0; n < 4; ++n) _Pragma("unroll") for (int j = 0; j < 4; ++j) hp0[(size_t)((m) * 16 + j) * D + n * 16] = hv[m][n][j] + g4[n] * acc[m][n][j]
    H_LOAD(0); H_LOAD(1);
    SCHED();
    H_STORE(0); H_LOAD(2); SCHED();
    H_STORE(1); H_LOAD(3); SCHED();
    H_STORE(2); H_LOAD(4); SCHED();
    H_STORE(3); H_LOAD(5); SCHED();
    H_STORE(4); H_LOAD(6); SCHED();
    H_STORE(5); H_LOAD(7); SCHED();
    H_STORE(6); H_STORE(7);
#undef H_LOAD
#undef H_STORE
  }
  else if (epi.mode == EM_FILT) { EPI_LOOP(epi.filt(row, col, v)) }
  else if (epi.mode == EM_Q) { EPI_LOOP(epi.q(row, col, v)) }
  else { EPI_LOOP(epi.kv(row, col, v)) }
#undef EPI_LOOP
}

__device__ __forceinline__ void mix_tile(const Ctx& p, int l, int pm, int pn, char* shm) {
  constexpr int TILE_A = 128 * 64 * 2, TILE_BB = 256 * 64 * 2, STAGE = TILE_A + TILE_BB;
  const int tid = tid_l(), wid = tid >> 6, lane = tid & 63, wr = wid >> 2, wc = wid & 3, fr = lane & 15, fq = lane >> 4;
  const int brow = pm * 128, bcol = pn * 256;
  const u16* projb = (const u16*)(p.ws + WS_PROJ);
  char* wo = (char*)p.out;
#define SA(b) (shm + (b) * STAGE)
#define SB(b) (shm + (b) * STAGE + TILE_A)
#define MIX_STAGE(buf, kt)                                                                                               \
  do {                                                                                                                   \
    const int br_ = (kt) >> 3, ko_ = ((kt) & 7) * 64;                                                                    \
    const u16* Ab_ = (const u16*)(p.ws + (br_ == 0 ? WS_U : br_ == 1 ? WS_Y : WS_O)) + (size_t)brow * 512 + ko_;         \
    const u16* Bb_ = (br_ == 0 ? (const u16*)(p.ws + WS_WPE) + (size_t)l * 1024 * 512 : (const u16*)(wo + (br_ == 1 ? WO_HY : WO_WO))) + (size_t)bcol * 512 + ko_;        \
    _Pragma("unroll") for (int i = 0; i < 4; ++i) {                                                                      \
      int sR_, sC_; stage_rc(wid * 1024 + i * 8192 + lane * 16, sR_, sC_);                                              \
      if (i < 2)                                                                                                         \
        __builtin_amdgcn_global_load_lds((const unsigned*)(Ab_ + sR_ * 512 + sC_),                           \
                                         (unsigned*)(SA(buf) + wid * 1024 + i * 8192), 16, 0, 0);                        \
      __builtin_amdgcn_global_load_lds((const unsigned*)(Bb_ + sR_ * 512 + sC_),                             \
                                       (unsigned*)(SB(buf) + wid * 1024 + i * 8192), 16, 0, 0);                          \
    }                                                                                                                    \
  } while (0)
  f32x4 tot[4][4], acc[4][4];
#pragma unroll
  for (int m = 0; m < 4; ++m)
#pragma unroll
    for (int n = 0; n < 4; ++n) { tot[m][n] = (f32x4){0.f, 0.f, 0.f, 0.f}; acc[m][n] = (f32x4){0.f, 0.f, 0.f, 0.f}; }
  MIX_STAGE(0, 0);
  MIX_STAGE(1, 1);
  WAIT_V(6);
  RAW_BARRIER();
  int cur = 0;
#pragma unroll 1
  for (int br = 0; br < 3; ++br) {
    unsigned gpk[4][4][2];
    const u16* gp = projb + (size_t)(brow + wr * 64 + fq * 4) * DINP + OFF_GATE + br * 1024 + bcol + wc * 64 + fr;
#define GATE_LOAD(m)                                                                                   \
    _Pragma("unroll") for (int n = 0; n < 4; ++n) _Pragma("unroll") for (int j2 = 0; j2 < 2; ++j2) {       \
      unsigned lo = gp[(size_t)((m) * 16 + 2 * j2) * DINP + n * 16], hi = gp[(size_t)((m) * 16 + 2 * j2 + 1) * DINP + n * 16]; \
      gpk[m][n][j2] = lo | (hi << 16);                                                                     \
    }
    GATE_LOAD(0); GATE_LOAD(1); GATE_LOAD(2);
#pragma unroll 1
    for (int kk = 0; kk < 8; ++kk) {
      const int t = br * 8 + kk;
      { int nx = cur + 2; if (nx >= 3) nx -= 3; if (t + 2 < 24) MIX_STAGE(nx, t + 2); }
#pragma unroll
      for (int ks = 0; ks < 2; ++ks) {
        bf16x8 At[2], Bf[4];
#pragma unroll
        for (int n = 0; n < 4; ++n) Bf[n] = *(const bf16x8*)(SB(cur) + lds_byte(wc * 64 + n * 16 + fr, ks * 32 + fq * 8));
#pragma unroll
        for (int mh = 0; mh < 2; ++mh) {
#pragma unroll
          for (int m = 0; m < 2; ++m) At[m] = *(const bf16x8*)(SA(cur) + lds_byte(wr * 64 + (mh * 2 + m) * 16 + fr, ks * 32 + fq * 8));
#pragma unroll
          for (int m = 0; m < 2; ++m)
#pragma unroll
            for (int n = 0; n < 4; ++n) acc[mh * 2 + m][n] = __builtin_amdgcn_mfma_f32_16x16x32_bf16(At[m], Bf[n], acc[mh * 2 + m][n], 0, 0, 0);
          SCHED();
        }
      }
      if (t + 2 < 24) WAIT_V(6); else WAIT_V(0);
      RAW_BARRIER();
      cur = (cur == 2) ? 0 : cur + 1;
    }
    GATE_LOAD(3);
#undef GATE_LOAD
#pragma unroll
    for (int m = 0; m < 4; ++m)
#pragma unroll
      for (int n = 0; n < 4; ++n)
#pragma unroll
        for (int j = 0; j < 4; ++j) {
          const unsigned w = gpk[m][n][j >> 1];
          const float gv = __uint_as_float((j & 1) ? (w & 0xffff0000u) : (w << 16));
          tot[m][n][j] += acc[m][n][j] / (1.f + __expf(-gv));
          acc[m][n][j] = 0.f;
        }
  }
  u16* mixb = (u16*)(p.ws + WS_ZV);
#pragma unroll
  for (int m = 0; m < 4; ++m)
#pragma unroll
    for (int n = 0; n < 4; ++n)
#pragma unroll
      for (int j = 0; j < 4; ++j)
        mixb[(size_t)(brow + wr * 64 + m * 16 + fq * 4 + j) * D + bcol + wc * 64 + n * 16 + fr] = f2bf(tot[m][n][j]);
#undef SA
#undef SB
#undef MIX_STAGE
}

__device__ __forceinline__ void tile_map(int t, int nM, int nN, int& pm, int& pn) {
  int nwg = nM * nN, wgid = t;
  {
    int q = nwg / 8, r = nwg % 8, xcd = wgid % 8, off = wgid / 8;
    wgid = (xcd < r ? xcd * (q + 1) : r * (q + 1) + (xcd - r) * q) + off;
  }
  int nig = 8 * nN, gid = wgid / nig, fm = gid * 8, gsz = min(nM - fm, 8);
  pm = fm + ((wgid % nig) % gsz);
  pn = (wgid % nig) / gsz;
}

__device__ __forceinline__ void p0_misc(const Ctx& p) {
  const int gtid = blockIdx.x * NT + tid_l(), gn = gridDim.x * NT;
  float4* h4 = (float4*)(p.ws + WS_H);
  const float4* x4 = (const float4*)pin(p, 0);
  const float4* c4 = (const float4*)pin(p, 2);
#pragma unroll 8
  for (int i = gtid; i < MROWS * 256; i += gn) {
    int m = i >> 8, q = i & 255, b = m / SP, pos = m - b * SP;
    float4 v = (pos < CTX) ? c4[(size_t)(b * CTX + pos) * 256 + q] : x4[(size_t)(b * SEQ + pos - CTX) * 256 + q];
    h4[i] = v;
  }
  float2* rope = (float2*)(p.ws + WS_ROPE);
  for (int i = gtid; i < 1024; i += gn) {
    int idx = i >> 3, f = i & 7;
    float inv = powf(10000.f, -(float)f / 8.f);
    float a = (float)idx * inv;
    rope[i] = make_float2(cosf(a), sinf(a));
  }
  {
    u16* w3t = (u16*)(p.ws + WS_W3T);
    const float* w3 = pin(p, 20);
    for (int i = gtid; i < 4 * 1024 * 64; i += gn) { int l = i >> 16, c2 = (i >> 6) & 1023, k = i & 63; w3t[i] = f2bf(w3[((size_t)l * 64 + k) * 1024 + c2]); }
  }
  float2* tw = (float2*)(p.ws + WS_TW);
  for (int i = gtid; i < 16384; i += gn) {
    float s, c;
    sincospif(-(float)i / 8192.f, &s, &c);
    tw[i] = make_float2(c, s);
  }
}

__device__ __forceinline__ void p0_mod_task(const Ctx& p, int task, char* smem) {
  float* s = (float*)smem;
  float* red = s + 3072;
  const int tid = tid_l();
  const int l = task / 48, chunk = task - l * 48;
  for (int i = tid; i < 3072; i += NT) {
    int g = i >> 10, k = i & 1023;
    float cv = (g < 2) ? pin(p, 1)[g * 1024 + k] : pin(p, 3)[k];
    s[i] = cv / (1.f + __expf(-cv));
  }
  __syncthreads();
  const int kq = tid >> 7, col = tid & 127, n = chunk * 128 + col;
  const float* W = pin(p, 4) + (size_t)l * 1024 * 6144 + n;
  float a0 = 0.f, a1 = 0.f, a2 = 0.f;
#pragma unroll 32
  for (int k = kq * 256; k < kq * 256 + 256; ++k) {
    float w = W[(size_t)k * 6144];
    a0 += s[k] * w; a1 += s[1024 + k] * w; a2 += s[2048 + k] * w;
  }
  red[(kq * 3 + 0) * 128 + col] = a0;
  red[(kq * 3 + 1) * 128 + col] = a1;
  red[(kq * 3 + 2) * 128 + col] = a2;
  __syncthreads();
  if (tid < 384) {
    int g = tid >> 7, c2 = tid & 127, n2 = chunk * 128 + c2;
    float v = red[(0 * 3 + g) * 128 + c2] + red[(1 * 3 + g) * 128 + c2] + red[(2 * 3 + g) * 128 + c2] + red[(3 * 3 + g) * 128 + c2];
    ((float*)(p.ws + WS_MOD))[(size_t)(l * 3 + g) * 6144 + n2] = v + pin(p, 5)[l * 6144 + n2];
  }
  __syncthreads();
}

__device__ __forceinline__ void p0_hid_task(const Ctx& p, int task, char* smem) {
  float* zs = (float*)smem;
  float* h1 = zs + 8 * 36;
  float* w1s = h1 + 8 * 64;
  float* w2s = w1s + 33 * 64;
  const int tid = tid_l(), tl = tid >> 6, j = tid & 63;
  const int l = task / 132, r = task - l * 132;
  const bool isctx = r >= 128;
  const int L = isctx ? 256 : 8192;
  const int tbase = (isctx ? (r - 128) : r) * 64;
  for (int i = tid; i < 33 * 64; i += NT) w1s[i] = pin(p, 14)[l * 33 * 64 + i];
  for (int i = tid; i < 64 * 64; i += NT) w2s[i] = pin(p, 17)[l * 64 * 64 + i];
  const float b1 = pin(p, 15)[l * 64 + j], f1 = pin(p, 16)[l * 64 + j], b2 = pin(p, 18)[l * 64 + j], f2 = pin(p, 19)[l * 64 + j];
  __syncthreads();
  for (int sub = 0; sub < 8; ++sub) {
    const int t = tbase + sub * 8 + tl;
    if (j < 33) {
      float z;
      if (j == 0) z = (float)t / (float)(L - 1);
      else {
        int i = (j - 1) & 15;
        float band = 1e-4f + (float)i * ((15.f - 1e-4f) / 15.f);
        float omega = 6.2831855f * (float)t / (float)L;
        float a = omega * band;
        z = (j <= 16) ? cosf(a) : -sinf(a);
      }
      zs[tl * 36 + j] = z;
    }
    __syncthreads();
    {
      float a = b1;
#pragma unroll
      for (int k = 0; k < 33; ++k) a += zs[tl * 36 + k] * w1s[k * 64 + j];
      h1[tl * 64 + j] = sinf(f1 * a);
    }
    __syncthreads();
    {
      float a = b2;
#pragma unroll 16
      for (int k = 0; k < 64; ++k) a += h1[tl * 64 + k] * w2s[k * 64 + j];
      float v = sinf(f2 * a);
      if (isctx) ((float*)(p.ws + WS_HID2C))[((size_t)l * 64 + j) * 256 + t] = v;
      else ((u16*)(p.ws + WS_HID2))[((size_t)l * 8192 + t) * 64 + j] = f2bf(v);
    }
  }
  __syncthreads();
}

struct WtItem { const float* W; u16* WT; int K, N, k0, n0; };
__device__ __forceinline__ WtItem wt_decode(const Ctx& p, int l, int r) {
  char* wo = (char*)p.out;
  WtItem it;
  int nblk;
  if (r < 1472) { it.W = pin(p, 8) + (size_t)l * 1024 * DIN; it.K = 1024; it.N = DIN; it.WT = (u16*)(wo + WO_IN); nblk = 92; }
  else if ((r -= 1472) < 1024) { it.W = pin(p, 30) + (size_t)l * 1024 * 4096; it.K = 1024; it.N = 4096; it.WT = (u16*)(wo + WO_FF1); nblk = 64; }
  else if ((r -= 1024) < 1024) { it.W = pin(p, 31) + (size_t)l * 4096 * 1024; it.K = 4096; it.N = 1024; it.WT = (u16*)(wo + WO_FF2); nblk = 16; }
  else if ((r -= 1024) < 256) { it.W = pin(p, 29) + (size_t)l * 1024 * 1024; it.K = 1024; it.N = 1024; it.WT = (u16*)(wo + WO_OUT); nblk = 16; }
  else if ((r -= 256) < 128) { it.W = pin(p, 23) + (size_t)l * 512 * 1024; it.K = 512; it.N = 1024; it.WT = (u16*)(wo + WO_HY); nblk = 16; }
  else if ((r -= 128) < 128) { it.W = pin(p, 28) + (size_t)l * 512 * 1024; it.K = 512; it.N = 1024; it.WT = (u16*)(wo + WO_WO); nblk = 16; }
  else if ((r -= 128) < 72) { it.W = pin(p, 25) + (size_t)l * 384 * 768; it.K = 384; it.N = 768; it.WT = (u16*)(wo + WO_UQ); nblk = 12; }
  else { r -= 72; it.W = pin(p, 27) + (size_t)l * 256 * 1024; it.K = 256; it.N = 1024; it.WT = (u16*)(wo + WO_UKV); nblk = 16; }
  const int kb = r / nblk, nb2 = r - kb * nblk;
  it.k0 = kb * 64; it.n0 = nb2 * 64;
  return it;
}
__device__ __forceinline__ void wt_load(const WtItem& it, int tid, float (&v)[8]) {
  const int nn = tid & 63, kq = tid >> 6;
  const bool ok = it.n0 + nn < it.N;
  const float* src = it.W + (size_t)(it.k0 + kq) * it.N + it.n0 + (ok ? nn : 0);
#pragma unroll
  for (int r = 0; r < 8; ++r) { float x = src[(size_t)(r * 8) * it.N]; v[r] = ok ? x : 0.f; }
}
__device__ __forceinline__ void wt_phase(const Ctx& p, int l, char* smem) {
  float* tile = (float*)smem;
  const int tid = tid_l();
  const int bid = blockIdx.x, nb = gridDim.x;
  int t = bid;
  if (t >= 4168) return;
  WtItem cur = wt_decode(p, l, t);
  float v[8];
  wt_load(cur, tid, v);
#pragma unroll 1
  while (true) {
    const int tn = t + nb;
    const bool more = tn < 4168;
    WtItem nxt = cur;
    float vn[8];
    if (more) { nxt = wt_decode(p, l, tn); wt_load(nxt, tid, vn); }
#pragma unroll
    for (int r = 0; r < 8; ++r) tile[(r * 8 + (tid >> 6)) * 65 + (tid & 63)] = v[r];
    __syncthreads();
    {
      int n = tid >> 3, kc = (tid & 7) * 8;
      uint4 o;
      o.x = pk2(tile[(kc + 0) * 65 + n], tile[(kc + 1) * 65 + n]);
      o.y = pk2(tile[(kc + 2) * 65 + n], tile[(kc + 3) * 65 + n]);
      o.z = pk2(tile[(kc + 4) * 65 + n], tile[(kc + 5) * 65 + n]);
      o.w = pk2(tile[(kc + 6) * 65 + n], tile[(kc + 7) * 65 + n]);
      *(uint4*)(cur.WT + (size_t)(cur.n0 + n) * cur.K + cur.k0 + kc) = o;
    }
    __syncthreads();
    if (!more) break;
    cur = nxt;
#pragma unroll
    for (int r = 0; r < 8; ++r) v[r] = vn[r];
    t = tn;
  }
}

__device__ __forceinline__ void wpe_task(const Ctx& p, int l, int task, char* smem) {
  const int g = task >> 3, c0 = (task & 7) * 16, tid = tid_l();
  const float* pw = pin(p, 9) + ((size_t)(l * 4 + g) * 128) * 128;
  const float* sc = pin(p, 10) + l * 512 + g * 128;
  const float* po = pin(p, 11) + ((size_t)l * 512 + g * 128) * 1024;
  u16* WpeT = (u16*)(p.ws + WS_WPE) + (size_t)l * 1024 * 512;
  float* wl = (float*)smem;
  for (int i = tid; i < 16 * 128; i += NT) { int d = i & 127; wl[i] = pw[(c0 + (i >> 7)) * 128 + d] * sc[d]; }
  __syncthreads();
  float acc0[16], acc1[16];
#pragma unroll
  for (int i = 0; i < 16; ++i) { acc0[i] = 0.f; acc1[i] = 0.f; }
#pragma unroll 16
  for (int d = 0; d < 128; ++d) {
    float p0 = po[(size_t)d * 1024 + tid], p1 = po[(size_t)d * 1024 + 512 + tid];
#pragma unroll
    for (int i = 0; i < 16; ++i) { float w = wl[i * 128 + d]; acc0[i] += w * p0; acc1[i] += w * p1; }
  }
  uint4 o0, o1;
  o0.x = pk2(acc0[0], acc0[1]); o0.y = pk2(acc0[2], acc0[3]); o0.z = pk2(acc0[4], acc0[5]); o0.w = pk2(acc0[6], acc0[7]);
  o1.x = pk2(acc0[8], acc0[9]); o1.y = pk2(acc0[10], acc0[11]); o1.z = pk2(acc0[12], acc0[13]); o1.w = pk2(acc0[14], acc0[15]);
  uint4* dst = (uint4*)(WpeT + (size_t)tid * 512 + g * 128 + c0);
  dst[0] = o0; dst[1] = o1;
  o0.x = pk2(acc1[0], acc1[1]); o0.y = pk2(acc1[2], acc1[3]); o0.z = pk2(acc1[4], acc1[5]); o0.w = pk2(acc1[6], acc1[7]);
  o1.x = pk2(acc1[8], acc1[9]); o1.y = pk2(acc1[10], acc1[11]); o1.z = pk2(acc1[12], acc1[13]); o1.w = pk2(acc1[14], acc1[15]);
  dst = (uint4*)(WpeT + (size_t)(512 + tid) * 512 + g * 128 + c0);
  dst[0] = o0; dst[1] = o1;
  __syncthreads();
}

__device__ __forceinline__ void norm_rows(const Ctx& p, const float* gain, const float* modl, int sh_idx, int sc_idx, u16* outp) {
  const int tidx = tid_l(), lane = tidx & 63, gw = blockIdx.x * 8 + (tidx >> 6), ngw = gridDim.x * 8;
  const float* h = (const float*)(p.ws + WS_H);
  float4 g[4];
#pragma unroll
  for (int j = 0; j < 4; ++j) g[j] = *(const float4*)(gain + lane * 4 + 256 * j);
  for (int m0 = gw; m0 < MROWS; m0 += 2 * ngw) {
    const int m1 = m0 + ngw;
    const bool has1 = m1 < MROWS;
    const int m1c = has1 ? m1 : m0;
    const float4* hr0 = (const float4*)(h + (size_t)m0 * D) + lane;
    const float4* hr1 = (const float4*)(h + (size_t)m1c * D) + lane;
    float4 v0[4], v1[4];
#pragma unroll
    for (int j = 0; j < 4; ++j) { v0[j] = hr0[64 * j]; v1[j] = hr1[64 * j]; }
    const float* mg0 = modl + grp_of_row(m0) * 6144;
    const float* mg1 = modl + grp_of_row(m1c) * 6144;
    float s0 = 0.f, s1 = 0.f;
#pragma unroll
    for (int j = 0; j < 4; ++j) {
      s0 += v0[j].x * v0[j].x + v0[j].y * v0[j].y + v0[j].z * v0[j].z + v0[j].w * v0[j].w;
      s1 += v1[j].x * v1[j].x + v1[j].y * v1[j].y + v1[j].z * v1[j].z + v1[j].w * v1[j].w;
    }
    s0 = wave_sum(s0);
    s1 = wave_sum(s1);
    const float r0 = rsqrtf(s0 * (1.f / D) + EPS), r1 = rsqrtf(s1 * (1.f / D) + EPS);
    uint2* o0 = (uint2*)(outp + (size_t)m0 * D) + lane;
    uint2* o1 = (uint2*)(outp + (size_t)m1c * D) + lane;
#pragma unroll
    for (int j = 0; j < 4; ++j) {
      int n = lane * 4 + 256 * j;
      float4 sc = *(const float4*)(mg0 + sc_idx * 1024 + n), sh = *(const float4*)(mg0 + sh_idx * 1024 + n);
      uint2 o;
      o.x = pk2(v0[j].x * r0 * g[j].x * (1.f + sc.x) + sh.x, v0[j].y * r0 * g[j].y * (1.f + sc.y) + sh.y);
      o.y = pk2(v0[j].z * r0 * g[j].z * (1.f + sc.z) + sh.z, v0[j].w * r0 * g[j].w * (1.f + sc.w) + sh.w);
      o0[64 * j] = o;
    }
    if (has1) {
#pragma unroll
      for (int j = 0; j < 4; ++j) {
        int n = lane * 4 + 256 * j;
        float4 sc = *(const float4*)(mg1 + sc_idx * 1024 + n), sh = *(const float4*)(mg1 + sh_idx * 1024 + n);
        uint2 o;
        o.x = pk2(v1[j].x * r1 * g[j].x * (1.f + sc.x) + sh.x, v1[j].y * r1 * g[j].y * (1.f + sc.y) + sh.y);
        o.y = pk2(v1[j].z * r1 * g[j].z * (1.f + sc.z) + sh.z, v1[j].w * r1 * g[j].w * (1.f + sc.w) + sh.w);
        o1[64 * j] = o;
      }
    }
  }
}

__device__ __forceinline__ void final_norm(const Ctx& p) {
  const int tidx = tid_l(), lane = tidx & 63, gw = blockIdx.x * 8 + (tidx >> 6), ngw = gridDim.x * 8;
  const float* h = (const float*)(p.ws + WS_H);
  const float* gain = pin(p, 32);
  for (int r0 = gw; r0 < 2 * SEQ; r0 += ngw) {
    int b = r0 >> 13, t = r0 & 8191, m = b * SP + CTX + t;
    const float4* hr = (const float4*)(h + (size_t)m * D) + lane;
    float4 v[4];
    float ss = 0.f;
#pragma unroll
    for (int j = 0; j < 4; ++j) { v[j] = hr[64 * j]; ss += v[j].x * v[j].x + v[j].y * v[j].y + v[j].z * v[j].z + v[j].w * v[j].w; }
    ss = wave_sum(ss);
    float r = rsqrtf(ss * (1.f / D) + EPS);
    float4* o = (float4*)(p.out + (size_t)r0 * D) + lane;
#pragma unroll
    for (int j = 0; j < 4; ++j) {
      float4 g = *(const float4*)(gain + lane * 4 + 256 * j);
      o[64 * j] = make_float4(v[j].x * r * g.x, v[j].y * r * g.y, v[j].z * r * g.z, v[j].w * r * g.w);
    }
  }
}

__device__ __forceinline__ void premix_task(const Ctx& p, int l, int task, char* smem) {
  const int tid = tid_l(), lane = tid & 63, wid = tid >> 6;
  const int part = task / 264, tile64 = task - part * 264;
  const int m0 = tile64 * 64, b = m0 / SP, pos0 = m0 - b * SP;
  const bool isctx = pos0 < CTX;
  const int s0 = isctx ? 0 : CTX, L = isctx ? CTX : SEQ, t0 = pos0 - s0;
  const size_t mb = (size_t)b * SP + s0;
  const u16* proj = (const u16*)(p.ws + WS_PROJ);
  if (part == 0) {
    u16* P = (u16*)smem;
#pragma unroll
    for (int i = tid; i < 80 * 64; i += NT) {
      int r = i >> 6, ch = i & 63, t = t0 - 8 + r;
      uint4 v = make_uint4(0, 0, 0, 0);
      if (t >= 0 && t < L) v = *(const uint4*)(proj + (mb + t) * DINP + ch * 8);
      *(uint4*)(P + r * 512 + ch * 8) = v;
    }
    __syncthreads();
    const int c = tid, g = c >> 7, hw = 1 << g;
    u16* U = (u16*)(p.ws + WS_U);
    float s = 0.f;
    for (int q = -hw; q < hw; ++q) s += bf2f(P[(8 + q) * 512 + c]);
#pragma unroll 4
    for (int tt = 0; tt < 64; ++tt) {
      int t = t0 + tt, lo = max(t - hw, 0), hi = min(t + hw, L);
      float u = s / (float)(hi - lo) - bf2f(P[(tt + 8) * 512 + c]);
      U[(mb + t) * 512 + c] = f2bf(u);
      s += bf2f(P[(tt + 8 + hw) * 512 + c]) - bf2f(P[(tt + 8 - hw) * 512 + c]);
    }
    __syncthreads();
  } else if (part <= 4) {
    const int ch0 = (part - 1) * 128;
    constexpr int PITCH = 136;
    u16* X = (u16*)smem;
    float* T = (float*)(smem + 3 * 66 * PITCH * 2 + 64);
#pragma unroll
    for (int ii = 0; ii < 7; ++ii) {
      const int i = tid + ii * NT;
      if (i >= 3 * 66 * 16) break;
      int pr = i / (66 * 16), rem = i - pr * 66 * 16, r = rem >> 4, ch = rem & 15, t = t0 - 1 + r;
      uint4 v = make_uint4(0, 0, 0, 0);
      if (t >= 0 && t < L) v = *(const uint4*)(proj + (mb + t) * DINP + OFF_HY + pr * 512 + ch0 + ch * 8);
      *(uint4*)(X + (pr * 66 + r) * PITCH + ch * 8) = v;
    }
    __syncthreads();
    const float* cw = pin(p, 12) + l * 3 * 1536;
    const float* cb = pin(p, 13) + l * 1536;
    {
      const int c = tid & 127, tq = tid >> 7, col = ch0 + c;
      const float w00 = cw[col], w01 = cw[1536 + col], w02 = cw[3072 + col], b0 = cb[col];
      const float w10 = cw[512 + col], w11 = cw[1536 + 512 + col], w12 = cw[3072 + 512 + col], b1 = cb[512 + col];
      const float w20 = cw[1024 + col], w21 = cw[1536 + 1024 + col], w22 = cw[3072 + 1024 + col], b2 = cb[1024 + col];
      const u16* X0 = X, *X1 = X + 66 * PITCH, *XV = X + 2 * 66 * PITCH;
      u16* Y = (u16*)(p.ws + WS_Y);
#pragma unroll 4
      for (int tt = tq * 16; tt < tq * 16 + 16; ++tt) {
        float x0 = w00 * bf2f(X0[tt * PITCH + c]) + w01 * bf2f(X0[(tt + 1) * PITCH + c]) + w02 * bf2f(X0[(tt + 2) * PITCH + c]) + b0;
        float x1 = w10 * bf2f(X1[tt * PITCH + c]) + w11 * bf2f(X1[(tt + 1) * PITCH + c]) + w12 * bf2f(X1[(tt + 2) * PITCH + c]) + b1;
        float vv = w20 * bf2f(XV[tt * PITCH + c]) + w21 * bf2f(XV[(tt + 1) * PITCH + c]) + w22 * bf2f(XV[(tt + 2) * PITCH + c]) + b2;
        Y[(mb + t0 + tt) * 512 + col] = f2bf(x0);
        T[c * 65 + tt] = x1 * vv;
      }
    }
    __syncthreads();
    {
      float* ZV = (float*)(p.ws + WS_ZV);
#pragma unroll 4
      for (int cc = 0; cc < 16; ++cc) {
        int c = wid * 16 + cc;
        ZV[((size_t)(ch0 + c) * SP + pos0 + lane) * 2 + b] = T[c * 65 + lane];
      }
    }
    __syncthreads();
  } else {
    u16* projw = (u16*)(p.ws + WS_PROJ);
    const float* qg = pin(p, 24) + l * 384;
    const float* kg = pin(p, 26) + l * 256;
    const float2* rope = (const float2*)(p.ws + WS_ROPE);
    u16* Kb = (u16*)(p.ws + WS_K);
#pragma unroll 2
    for (int rr = 0; rr < 8; ++rr) {
      int tt = wid * 8 + rr, pos = pos0 + tt;
      u16* row = projw + ((size_t)b * SP + pos) * DINP;
      unsigned* q32 = (unsigned*)(row + OFF_Q);
      unsigned* k32 = (unsigned*)(row + OFF_KV);
      unsigned v[3], w[2];
      float ss = 0.f, s2 = 0.f;
#pragma unroll
      for (int j = 0; j < 3; ++j) v[j] = q32[lane + 64 * j];
#pragma unroll
      for (int j = 0; j < 2; ++j) w[j] = k32[lane + 64 * j];
      const int rd = lane & 31;
      float val = bf2f(row[OFF_KV + 256 + rd]);
#pragma unroll
      for (int j = 0; j < 3; ++j) { float a = bf2f(v[j] & 0xffff), c2 = bf2f(v[j] >> 16); ss += a * a + c2 * c2; }
#pragma unroll
      for (int j = 0; j < 2; ++j) { float a = bf2f(w[j] & 0xffff), c2 = bf2f(w[j] >> 16); s2 += a * a + c2 * c2; }
      ss = wave_sum(ss);
      s2 = wave_sum(s2);
      float r = rsqrtf(ss * (1.f / 384.f) + EPS), r2 = rsqrtf(s2 * (1.f / 256.f) + EPS);
#pragma unroll
      for (int j = 0; j < 3; ++j) {
        int n = (lane + 64 * j) * 2;
        q32[lane + 64 * j] = pk2(bf2f(v[j] & 0xffff) * r * qg[n], bf2f(v[j] >> 16) * r * qg[n + 1]);
      }
#pragma unroll
      for (int j = 0; j < 2; ++j) {
        int n = (lane + 64 * j) * 2;
        k32[lane + 64 * j] = pk2(bf2f(w[j] & 0xffff) * r2 * kg[n], bf2f(w[j] >> 16) * r2 * kg[n + 1]);
      }
      float partner = shx(val, 8);
      if (!isctx) {
        int t = pos - CTX, idx = (rd < 16) ? (t >> 6) : (t & 63);
        float2 cs = rope[idx * 8 + (rd & 7)];
        float sgn = (rd & 8) ? 1.f : -1.f;
        val = val * cs.x + sgn * partner * cs.y;
      }
      if (lane < 32) {
        u16 o = f2bf(val);
#pragma unroll
        for (int hd = 0; hd < 8; ++hd) Kb[((size_t)(b * 8 + hd) * SP + pos) * 96 + 64 + rd] = o;
      }
    }
  }
}

__device__ __forceinline__ int xi(int i) { const int h = i >> 5; return i ^ (((h & 3) * 5) | ((h & 2) << 3)); }
typedef float v2f __attribute__((ext_vector_type(2)));
__device__ __forceinline__ v2f cmulv(v2f a, v2f b) {
  v2f bs = {-b.y, b.x};
  return a.xx * b + a.yy * bs;
}
__device__ __forceinline__ void bf_fwd(float2* Xf, int base, int q, float2 w1f) {
  v2f* X = (v2f*)Xf;
  const v2f w1 = {w1f.x, w1f.y};
  const v2f w2 = cmulv(w1, w1), w3 = cmulv(w2, w1);
  const int i0 = xi(base), i1 = xi(base + q), i2 = xi(base + 2 * q), i3 = xi(base + 3 * q);
  v2f a0 = X[i0], a1 = X[i1], a2 = X[i2], a3 = X[i3];
  v2f s02 = a0 + a2, d02 = a0 - a2, s13 = a1 + a3, d13 = a1 - a3;
  v2f d13r = {d13.y, -d13.x};
  X[i0] = s02 + s13;
  X[i1] = cmulv(d02 + d13r, w1);
  X[i2] = cmulv(s02 - s13, w2);
  X[i3] = cmulv(d02 - d13r, w3);
}
__device__ __forceinline__ void bf_inv(float2* Xf, int base, int q, float2 w1f) {
  v2f* X = (v2f*)Xf;
  const v2f w1 = {w1f.x, -w1f.y};
  const v2f w2 = cmulv(w1, w1), w3 = cmulv(w2, w1);
  const int i0 = xi(base), i1 = xi(base + q), i2 = xi(base + 2 * q), i3 = xi(base + 3 * q);
  v2f b0 = X[i0], c1 = cmulv(X[i1], w1), c2 = cmulv(X[i2], w2), c3 = cmulv(X[i3], w3);
  v2f s02 = b0 + c2, d02 = b0 - c2, s13 = c1 + c3, d13 = c1 - c3;
  v2f d13r = {-d13.y, d13.x};
  X[i0] = s02 + s13;
  X[i1] = d02 + d13r;
  X[i2] = s02 - s13;
  X[i3] = d02 - d13r;
}
template <bool INV, int LQ>
__device__ __forceinline__ void fft_pass(float2* X, const float2* __restrict__ tw, const float2 (&twr)[6], int tid) {
  constexpr int q = 1 << LQ;
  if (LQ == 12) {
    float2 w[8];
#pragma unroll
    for (int b8 = 0; b8 < 8; ++b8) w[b8] = tw[b8 * NT + tid];
#pragma unroll
    for (int b8 = 0; b8 < 8; ++b8) { int u = b8 * NT + tid; if (INV) bf_inv(X, u, q, w[b8]); else bf_fwd(X, u, q, w[b8]); }
  } else if (LQ == 10) {
#pragma unroll 2
    for (int b8 = 0; b8 < 8; ++b8) {
      int u = b8 * NT + tid, j = u & 1023, base = ((u >> 10) << 12) + j;
      float2 w = (b8 & 1) ? twr[1] : twr[0];
      if (INV) bf_inv(X, base, q, w); else bf_fwd(X, base, q, w);
    }
  } else {
    const int j = tid & (q - 1);
    const float2 w = (LQ == 0) ? make_float2(1.f, 0.f) : twr[2 + (8 - LQ) / 2];
#pragma unroll 2
    for (int b8 = 0; b8 < 8; ++b8) {
      int u = b8 * NT + tid, base = ((u >> LQ) << (LQ + 2)) + j;
      if (INV) bf_inv(X, base, q, w); else bf_fwd(X, base, q, w);
    }
  }
  __syncthreads();
}
__device__ __forceinline__ void fft_load_tw(const float2* __restrict__ tw, int tid, float2 (&twr)[6]) {
  twr[0] = tw[tid << 2];
  twr[1] = tw[(512 + tid) << 2];
  twr[2] = tw[(tid & 255) << 4];
  twr[3] = tw[(tid & 63) << 6];
  twr[4] = tw[(tid & 15) << 8];
  twr[5] = tw[(tid & 3) << 10];
}
__device__ __forceinline__ void fft_dif(float2* X, const float2* __restrict__ tw, const float2 (&twr)[6]) {
  const int tid = tid_l();
  fft_pass<false, 12>(X, tw, twr, tid); fft_pass<false, 10>(X, tw, twr, tid); fft_pass<false, 8>(X, tw, twr, tid); fft_pass<false, 6>(X, tw, twr, tid);
  fft_pass<false, 4>(X, tw, twr, tid); fft_pass<false, 2>(X, tw, twr, tid); fft_pass<false, 0>(X, tw, twr, tid);
}
__device__ __forceinline__ void fft_dit_inv(float2* X, const float2* __restrict__ tw, const float2 (&twr)[6]) {
  const int tid = tid_l();
  fft_pass<true, 0>(X, tw, twr, tid); fft_pass<true, 2>(X, tw, twr, tid); fft_pass<true, 4>(X, tw, twr, tid); fft_pass<true, 6>(X, tw, twr, tid);
  fft_pass<true, 8>(X, tw, twr, tid); fft_pass<true, 10>(X, tw, twr, tid); fft_pass<true, 12>(X, tw, twr, tid);
}
__device__ __forceinline__ float block_sum(float v, float* red) {
  v = wave_sum(v);
  __syncthreads();
  { const int tb = tid_l(); if ((tb & 63) == 0) red[tb >> 6] = v; }
  __syncthreads();
  float s = red[0] + red[1] + red[2] + red[3] + red[4] + red[5] + red[6] + red[7];
  __syncthreads();
  return s;
}

__device__ __forceinline__ void fft_task(const Ctx& p, int l, int c, char* smem) {
  float2* X = (float2*)smem;
  float* aux = (float*)(smem + AUX_OFF);
  float* red = aux + 128;
  const int tid = tid_l();
  const float2* tw = (const float2*)(p.ws + WS_TW);
  float2 twr[6];
  fft_load_tw(tw, tid, twr);
  const float* w3 = pin(p, 20) + (size_t)l * 64 * 1024;
  if (tid < 64) { aux[tid] = w3[tid * 1024 + c]; aux[64 + tid] = w3[tid * 1024 + 512 + c]; }
  __syncthreads();
  const float dF = fabsf(pin(p, 21)[(l * 2 + 0) * 512 + c]), dB = fabsf(pin(p, 21)[(l * 2 + 1) * 512 + c]);
  const float bias = pin(p, 22)[l * 512 + c];
  float2* zp = (float2*)(p.ws + WS_ZV) + (size_t)c * SP;
  float l1 = 0.f;
  {
    const u16* ff = (const u16*)((const char*)p.out + WO_FILT) + (size_t)c * 8192 + tid;
    const u16* fb = ff + (size_t)512 * 8192;
    u16 rf[16], rb[16];
#pragma unroll
    for (int i = 0; i < 16; ++i) { rf[i] = ff[i * NT]; rb[i] = fb[i * NT]; }
#pragma unroll
    for (int i = 0; i < 16; ++i) {
      int t = i * NT + tid;
      float tl = (float)t * (1.f / 8191.f);
      float hf = bf2f(rf[i]) * expf(-tl * dF);
      float hb = bf2f(rb[i]) * expf(-tl * dB);
      X[xi(t)] = make_float2(hf, 0.f);
      if (t >= 1) { X[xi(16384 - t)] = make_float2(hb, 0.f); l1 += fabsf(hf) + fabsf(hb); }
      else { X[xi(8192)] = make_float2(0.f, 0.f); l1 += fabsf(hf); }
    }
  }
  float l1tot = block_sum(l1, red);
  fft_dif(X, tw, twr);
  float2 F[32];
  {
    float s = 1.f / (l1tot * 16384.f);
#pragma unroll
    for (int i = 0; i < 32; ++i) { float2 v = X[xi(i * NT + tid)]; F[i] = make_float2(v.x * s, v.y * s); }
  }
  __syncthreads();
#pragma unroll 8
  for (int i = 0; i < 16; ++i) {
    int t = i * NT + tid;
    X[xi(t)] = zp[CTX + t];
    X[xi(8192 + t)] = make_float2(0.f, 0.f);
  }
  __syncthreads();
  fft_dif(X, tw, twr);
#pragma unroll
  for (int i = 0; i < 32; ++i) { int idx = xi(i * NT + tid); X[idx] = cmul(X[idx], F[i]); }
  __syncthreads();
  fft_dit_inv(X, tw, twr);
  {
    float2 zz[16];
#pragma unroll
    for (int i = 0; i < 16; ++i) zz[i] = zp[CTX + i * NT + tid];
#pragma unroll
    for (int i = 0; i < 16; ++i) {
      int t = i * NT + tid;
      float2 y = X[xi(t)];
      zp[CTX + t] = make_float2(y.x + bias * zz[i].x, y.y + bias * zz[i].y);
    }
  }
  __syncthreads();
  {
    float* hFc = (float*)smem;
    float* hBc = hFc + 256;
    float2* zc = (float2*)(hBc + 256);
    float l1c = 0.f;
    if (tid < 256) {
      int t = tid;
      const float* hc = (const float*)(p.ws + WS_HID2C) + (size_t)l * 64 * 256 + t;
      float hf = 0.f, hb = 0.f;
#pragma unroll 16
      for (int k = 0; k < 64; ++k) { float v = hc[k * 256]; hf += v * aux[k]; hb += v * aux[64 + k]; }
      float tl = (float)t * (1.f / 255.f);
      hf *= expf(-tl * dF);
      hb *= expf(-tl * dB);
      hFc[t] = hf;
      hBc[t] = hb;
      l1c = fabsf(hf) + (t >= 1 ? fabsf(hb) : 0.f);
      zc[t] = zp[t];
    }
    float l1ct = block_sum(l1c, red);
    const int bb = tid >> 8, t = tid & 255;
    float acc = 0.f;
    for (int s = 0; s < 256; ++s) {
      float kf = (s <= t) ? hFc[t - s] : hBc[s - t];
      float2 z = zc[s];
      acc += kf * (bb ? z.y : z.x);
    }
    float2 z = zc[t];
    ((float*)zp)[t * 2 + bb] = acc / l1ct + bias * (bb ? z.y : z.x);
    __syncthreads();
  }
}

constexpr int AT_KT = 128, AT_KP = 208, AT_VP = 264, AT_STAGE = AT_KT * AT_KP + 64 * AT_VP;
__device__ __forceinline__ void attn_task(const Ctx& p, int bh, int qb, char* smem) {
  const int tid = tid_l(), wid = tid >> 6, lane = tid & 63, r = lane & 31, hh = lane >> 5;
  const u16* Qp = (const u16*)(p.ws + WS_Q) + ((size_t)bh * SP + qb * 256) * 96;
  const u16* Kp = (const u16*)(p.ws + WS_K) + (size_t)bh * SP * 96;
  const u16* Vp = (const u16*)(p.ws + WS_VT) + (size_t)bh * 64 * SP;
  const int nkt = (qb == 0) ? 2 : 66;
  bf16x8 qf[6];
#pragma unroll
  for (int ks = 0; ks < 6; ++ks) qf[ks] = *(const bf16x8*)(Qp + (size_t)(wid * 32 + r) * 96 + ks * 16 + hh * 8);
  f32x16 o0, o1;
#pragma unroll
  for (int i = 0; i < 16; ++i) { o0[i] = 0.f; o1[i] = 0.f; }
  float mrun = 0.f, lrun = 0.f;
  const u16* src[5];
  int dst[5];
#pragma unroll
  for (int i = 0; i < 5; ++i) {
    int ch = tid + i * NT;
    if (i < 3) { int row = ch / 12, cc = ch - row * 12; src[i] = Kp + (size_t)row * 96 + cc * 8; dst[i] = row * AT_KP + cc * 16; }
    else { int v = ch - 1536, row = v >> 4, cc = v & 15; src[i] = Vp + (size_t)row * SP + cc * 8; dst[i] = AT_KT * AT_KP + row * AT_VP + cc * 16; }
  }
  uint4 st[5];
#define AT_LOAD(t)                                                                                   \
  do {                                                                                               \
    _Pragma("unroll") for (int i = 0; i < 5; ++i) st[i] = *(const uint4*)(src[i] + (size_t)(t) * (i < 3 ? AT_KT * 96 : AT_KT)); \
  } while (0)
#define AT_WRITE(buf)                                                                                \
  do {                                                                                               \
    char* base_ = smem + (buf) * AT_STAGE;                                                           \
    _Pragma("unroll") for (int i = 0; i < 5; ++i) {                                                  \
      uint2* d_ = (uint2*)(base_ + dst[i]);                                                          \
      d_[0] = make_uint2(st[i].x, st[i].y);                                                          \
      d_[1] = make_uint2(st[i].z, st[i].w);                                                          \
    }                                                                                                \
  } while (0)
#define AT_QK(S, kb)                                                                                 \
  __builtin_amdgcn_s_setprio(1);                                                                     \
  _Pragma("unroll") for (int ks = 0; ks < 6; ++ks) {                                                 \
    bf16x8 a_ = *(const bf16x8*)(Ks + ((kb) * 32 + r) * AT_KP + ks * 32 + hh * 16);                  \
    S = __builtin_amdgcn_mfma_f32_32x32x16_bf16(a_, qf[ks], S, 0, 0, 0);                             \
  }                                                                                                  \
  __builtin_amdgcn_s_setprio(0);
#define AT_SOFT_PV(S, kb)                                                                            \
  _Pragma("unroll") for (int i = 0; i < 16; ++i) { S[i] = __builtin_amdgcn_exp2f(S[i]); ps += S[i]; pmx = fmaxf(pmx, S[i]); } \
  _Pragma("unroll") for (int sI = 0; sI < 2; ++sI) {                                                 \
    union { bf16x8 v; unsigned u[4]; } pu;                                                           \
    _Pragma("unroll") for (int j = 0; j < 4; ++j) pu.u[j] = pk2(S[8 * sI + 2 * j], S[8 * sI + 2 * j + 1]); \
    const int koff = ((kb) * 32 + 16 * sI + 4 * hh) * 2;                                             \
    union { bf16x8 v; uint2 h2[2]; } va, vb;                                                         \
    va.h2[0] = *(const uint2*)(Vs + r * AT_VP + koff);                                               \
    va.h2[1] = *(const uint2*)(Vs + r * AT_VP + koff + 16);                                          \
    vb.h2[0] = *(const uint2*)(Vs + (32 + r) * AT_VP + koff);                                        \
    vb.h2[1] = *(const uint2*)(Vs + (32 + r) * AT_VP + koff + 16);                                   \
    o0 = __builtin_amdgcn_mfma_f32_32x32x16_bf16(va.v, pu.v, o0, 0, 0, 0);                           \
    o1 = __builtin_amdgcn_mfma_f32_32x32x16_bf16(vb.v, pu.v, o1, 0, 0, 0);                           \
  }
  AT_LOAD(0);
  AT_WRITE(0);
  __syncthreads();
  for (int t = 0; t < nkt; ++t) {
    const int cur = t & 1;
    if (t + 1 < nkt) AT_LOAD(t + 1);
    const char* Ks = smem + cur * AT_STAGE;
    const char* Vs = Ks + AT_KT * AT_KP;
    const float nm = -mrun;
    f32x16 sA, sB;
    float ps = 0.f, pmx = 0.f;
#pragma unroll
    for (int i = 0; i < 16; ++i) sA[i] = nm;
    AT_QK(sA, 0)
#pragma unroll
    for (int i = 0; i < 16; ++i) sB[i] = nm;
    AT_QK(sB, 1)
    AT_SOFT_PV(sA, 0)
#pragma unroll
    for (int i = 0; i < 16; ++i) sA[i] = nm;
    AT_QK(sA, 2)
    AT_SOFT_PV(sB, 1)
#pragma unroll
    for (int i = 0; i < 16; ++i) sB[i] = nm;
    AT_QK(sB, 3)
    AT_SOFT_PV(sA, 2)
    AT_SOFT_PV(sB, 3)
    lrun += ps;
    pmx = fmaxf(pmx, shx(pmx, 32));
    if (__any(pmx > 256.f)) {
      const float delta = pmx > 256.f ? ceilf(__log2f(pmx)) : 0.f;
      const float alpha = __builtin_amdgcn_exp2f(-delta);
      mrun += delta;
      lrun *= alpha;
#pragma unroll
      for (int i = 0; i < 16; ++i) { o0[i] *= alpha; o1[i] *= alpha; }
    }
    if (t + 1 < nkt) AT_WRITE(cur ^ 1);
    __syncthreads();
  }
  const float ltot = lrun + shx(lrun, 32);
  const float inv = 1.f / ltot;
  const int b = bh >> 3, head = bh & 7;
  u16* Op = (u16*)(p.ws + WS_O) + ((size_t)b * SP + qb * 256 + wid * 32 + r) * 512 + head * 64;
#pragma unroll
  for (int g = 0; g < 4; ++g) {
    uint2 w0, w1;
    w0.x = pk2(o0[4 * g] * inv, o0[4 * g + 1] * inv);
    w0.y = pk2(o0[4 * g + 2] * inv, o0[4 * g + 3] * inv);
    w1.x = pk2(o1[4 * g] * inv, o1[4 * g + 1] * inv);
    w1.y = pk2(o1[4 * g + 2] * inv, o1[4 * g + 3] * inv);
    *(uint2*)(Op + 8 * g + 4 * hh) = w0;
    *(uint2*)(Op + 32 + 8 * g + 4 * hh) = w1;
  }
#undef AT_LOAD
#undef AT_WRITE
#undef AT_QK
#undef AT_SOFT_PV
}

__device__ __forceinline__ void hypost_task(const Ctx& p, int task, char* smem) {
  const int tid = tid_l(), lane = tid & 63, wid = tid >> 6;
  const int tile64 = task >> 1, ch0 = (task & 1) * 256;
  const int m0 = tile64 * 64, b = m0 / SP, pos0 = m0 - b * SP;
  float* T = (float*)smem;
  const float* ZV = (const float*)(p.ws + WS_ZV);
#pragma unroll 8
  for (int cc = 0; cc < 32; ++cc) {
    int c = wid * 32 + cc;
    T[c * 65 + lane] = ZV[((size_t)(ch0 + c) * SP + pos0 + lane) * 2 + b];
  }
  __syncthreads();
  u16* Y = (u16*)(p.ws + WS_Y);
  const int c = tid & 255, th = tid >> 8;
  u16* yp = Y + (size_t)(m0 + th * 32) * 512 + ch0 + c;
  u16 yv[32];
#pragma unroll
  for (int i = 0; i < 32; ++i) yv[i] = yp[(size_t)i * 512];
#pragma unroll
  for (int i = 0; i < 32; ++i) yp[(size_t)i * 512] = f2bf(bf2f(yv[i]) * T[c * 65 + th * 32 + i]);
  __syncthreads();
}

#ifndef PHMASK
#define PHMASK 0xFFFF
#endif
#define PHON(k) (((PHMASK) >> (k)) & 1)
constexpr int NPH = 1 + 4 * 10 + 1;
__global__ void __launch_bounds__(NT, 2) mega(Params prm) {
  __shared__ __attribute__((aligned(1024))) char smem[LDS_BYTES];
  cg::grid_group grid = cg::this_grid();
  const int bid = blockIdx.x, nb = gridDim.x;
  {
    unsigned long long* it = (unsigned long long*)(smem + AUX_OFF + 6144);
    if (threadIdx.x < 33) it[threadIdx.x] = (unsigned long long)prm.in[threadIdx.x];
    if (threadIdx.x == 0) *(uint4*)(smem + AUX_OFF + 7168) = make_uint4(0u, 0u, 0u, 0u);
    __syncthreads();
  }
  XcdBarrier xbar = xcd_barrier_post((unsigned*)(prm.ws + WS_BAR), (volatile LAS unsigned*)(smem + AUX_OFF + 7168));
  if (prm.ph_lo == 0) {
    Ctx p;
    p.intab = (const unsigned long long*)(smem + AUX_OFF + 6144);
    p.ws = prm.ws;
    p.out = prm.out;
    const int bid = blockIdx.x, nb = gridDim.x;
      if (PHON(10)) {
      p0_misc(p);
      for (int t = bid; t < 192; t += nb) p0_mod_task(p, t, smem);
      for (int t = bid; t < 528; t += nb) p0_hid_task(p, t, smem);
      for (int t = bid; t < 128; t += nb) { const int w = (t + 64) & 127; wpe_task(p, w >> 5, w & 31, smem); }
      }
  }
  unsigned nbar = 0;
  for (int ph = prm.ph_lo; ph < prm.ph_hi; ++ph) {
    Ctx p;
    p.intab = (const unsigned long long*)(smem + AUX_OFF + 6144);
    p.ws = prm.ws;
    p.out = prm.out;
    asm volatile("" : "+s"(p.ws), "+s"(p.out));
    float* modall = (float*)(p.ws + WS_MOD);
    u16* proj = (u16*)(p.ws + WS_PROJ);
    u16* xn = (u16*)(p.ws + WS_U);
    char* wo = (char*)p.out;
    if (ph == 0) {
    } else if (ph == NPH - 1) {
      if (PHON(11)) final_norm(p);
    } else {
      const int l = (ph - 1) / 10, sp = (ph - 1) % 10;
      const float* modl = modall + (size_t)l * 3 * 6144;
      GD* tab = (GD*)(smem + AUX_OFF + 4096);
      int ng = 0, nN0 = 0, nN1 = 0, nsplit = 1;
      bool seq = false;
      const float* gate = modl;
      if (sp == 0 && PHON(0)) {
        wt_phase(p, l, smem);
        norm_rows(p, pin(p, 6) + l * 1024, modl, 0, 1, xn);
      } else if (sp == 1 && PHON(1)) {
        if (threadIdx.x == 0) tab[0] = GD{xn, 1024, (const u16*)(wo + WO_IN), 1024, 1024, 23, EM_PROJ, 1};
        ng = 1; nN0 = 23;
      } else if (sp == 2 && PHON(2)) {
        for (int t = bid; t < 264 * 6; t += nb) premix_task(p, l, t, smem);
        {
          Epi ef{EM_FILT, p.ws, gate, nullptr, (u16*)(wo + WO_FILT)};
          const u16* hA = (const u16*)(p.ws + WS_HID2) + (size_t)l * 8192 * 64;
          const u16* wB = (const u16*)(p.ws + WS_W3T) + (size_t)l * 1024 * 64;
#pragma unroll 1
          for (int t = nb - 1 - bid; t < 128; t += nb) gemm_tile(hA, 64, wB, 64, 64, (t >> 2) * 256, (t & 3) * 256, smem, ef);
        }
      } else if (sp == 3 && PHON(3)) {
        for (int t = bid; t < 512; t += nb) fft_task(p, l, t, smem);
        if (threadIdx.x == 0) {
          tab[0] = GD{proj + OFF_Q, DINP, (const u16*)(wo + WO_UQ), 384, 384, 3, EM_Q, 1};
          tab[1] = GD{proj + OFF_KV, DINP, (const u16*)(wo + WO_UKV), 256, 256, 4, EM_KV, 1};
        }
        ng = 2; nN0 = 3; nN1 = 4;
        for (int i = tid_l(); i < 1024; i += NT) ((float2*)(smem + 131072))[i] = ((const float2*)(p.ws + WS_ROPE))[i];
      } else if (sp == 4 && PHON(4)) {
        for (int t = bid; t < 528; t += nb) {
          int bh, qb;
          if (t < 512) { int rnd = t >> 8, w = t & 255; bh = (w & 7) + 8 * rnd; qb = 1 + (w >> 3); }
          else { bh = t - 512; qb = 0; }
          attn_task(p, bh, qb, smem);
        }
        for (int t = bid; t < 528; t += nb) hypost_task(p, t, smem);
      } else if (sp == 5 && PHON(5)) {
        for (int t = bid; t < 8 * 68; t += nb) {
          const int x = t & 7, g = t >> 3, pm = (g >> 2) * 8 + x;
          if (pm < 132) mix_tile(p, l, pm, g & 3, smem);
        }
      } else if (sp == 6 && PHON(6)) {
        if (threadIdx.x == 0) tab[0] = GD{(const u16*)(p.ws + WS_ZV), 1024, (const u16*)(wo + WO_OUT), 1024, 1024, 4, EM_RESID, 4};
        ng = 1; nN0 = 4; nsplit = 4;
        gate = modl + 2 * 1024;
      } else if (sp == 7 && PHON(7)) {
        norm_rows(p, pin(p, 7) + l * 1024, modl, 3, 4, xn);
      } else if (sp == 8 && PHON(8)) {
        if (threadIdx.x == 0) tab[0] = GD{xn, 1024, (const u16*)(wo + WO_FF1), 1024, 1024, 16, EM_SQRELU, 1};
        ng = 1; nN0 = 16;
      } else if (sp == 9 && PHON(9)) {
        if (threadIdx.x == 0) tab[0] = GD{proj, DFF, (const u16*)(wo + WO_FF2), 4096, 4096, 4, EM_RESID, 8};
        ng = 1; nN0 = 4; nsplit = 8;
        gate = modl + 5 * 1024;
      }
      if (ng > 0) {
        __syncthreads();
        const int nt0 = (nsplit > 1) ? (64 * nN0 + 2 * nN0 * nsplit) : NMT * nN0, ntot = seq ? nt0 : nt0 + NMT * nN1;
        const int nseq = seq ? ng : 1;
        const int nitems = ((ntot - bid + nb - 1) / nb) * nseq;
#pragma unroll 1
        for (int it = 0; it < nitems; ++it) {
          int t = bid + (it / nseq) * nb, gi = it % nseq, tt = t;
          if (!seq && t >= nt0) { gi = 1; tt = t - nt0; }
          const volatile GD* gp = tab + gi;
          unsigned long long a64 = (unsigned long long)gp->A, b64 = (unsigned long long)gp->Bt;
          a64 = ((unsigned long long)(unsigned)__builtin_amdgcn_readfirstlane((unsigned)(a64 >> 32)) << 32) | (unsigned long long)(unsigned)__builtin_amdgcn_readfirstlane((unsigned)a64);
          b64 = ((unsigned long long)(unsigned)__builtin_amdgcn_readfirstlane((unsigned)(b64 >> 32)) << 32) | (unsigned long long)(unsigned)__builtin_amdgcn_readfirstlane((unsigned)b64);
          const int lda = __builtin_amdgcn_readfirstlane(gp->lda), ldb = __builtin_amdgcn_readfirstlane(gp->ldb);
          const int K = __builtin_amdgcn_readfirstlane(gp->K), nN = __builtin_amdgcn_readfirstlane(gp->nN);
          const int ks = __builtin_amdgcn_readfirstlane(gp->ks);
          const int mode = __builtin_amdgcn_readfirstlane(gp->mode);
          int pm, pn, Kuse = K, emode = mode;
          if (ks > 1) {
            const int nlat = 64 * nN;
            if (tt < nlat) { int pm64; tile_map(tt, 64, nN, pm64, pn); pm = (pm64 >> 5) * 33 + 1 + (pm64 & 31); }
            else {
              int u = tt - nlat, kp = u % ks, tile = u / ks;
              pm = (tile / nN) * 33; pn = tile % nN;
              Kuse = K / ks; emode = EM_RESID_AT;
              a64 += (unsigned long long)kp * Kuse * 2; b64 += (unsigned long long)kp * Kuse * 2;
            }
          } else tile_map(tt, NMT, nN, pm, pn);
          Epi e{emode, p.ws, gate, (const float2*)(smem + 131072), nullptr};
          gemm_tile((const u16*)a64, lda, (const u16*)b64, ldb, Kuse, pm * 256, pn * 256, smem, e);
        }
      }
    }
    if (ph + 1 < prm.ph_hi) {
      if (ph == prm.ph_lo) grid.sync();
      else xcd_barrier(xbar);
    }
  }
}

extern "C" void kernel_launch(void* const* d_in, const int* in_sizes, int n_in, void* d_out, int out_size, void* d_ws,
                              size_t ws_size, hipStream_t stream) {
  static int grid_blocks = 0;
  if (grid_blocks == 0) {
    if (n_in != 33 || ws_size < WS_END || (size_t)out_size * 4 < WO_END) {
      fprintf(stderr, "kernel_launch: unexpected sizes n_in=%d ws=%zu (need %zu) out=%d\n", n_in, ws_size, (size_t)WS_END, out_size);
      grid_blocks = -1;
      return;
    }
    int dev = 0, cus = 0, per_cu = 0;
    hipGetDevice(&dev);
    hipDeviceGetAttribute(&cus, hipDeviceAttributeMultiprocessorCount, dev);
    hipOccupancyMaxActiveBlocksPerMultiprocessor(&per_cu, mega, NT, 0);
    if (per_cu < 1) per_cu = 1;
    if (per_cu > 1) per_cu = 1;
    grid_blocks = cus * per_cu;
  }
  if (grid_blocks < 0) return;
  Params p{};
  for (int i = 0; i < 33; ++i) p.in[i] = (const float*)d_in[i];
  p.out = (float*)d_out;
  p.ws = (char*)d_ws;
  p.ph_lo = 0;
  p.ph_hi = NPH;
  (void)hipMemsetAsync((char*)d_ws + WS_BAR, 0, 16384, stream);
  void* args[] = {&p};
  hipError_t e = hipLaunchCooperativeKernel((void*)mega, dim3(grid_blocks), dim3(NT), args, 0, stream);
  if (e != hipSuccess) fprintf(stderr, "cooperative launch failed: %s (grid %d)\n", hipGetErrorString(e), grid_blocks);
}
```

```cpp
#include <hip/hip_runtime.h>
#include <hip/hip_cooperative_groups.h>
#include <cstdio>
namespace cg = cooperative_groups;

typedef unsigned short u16;
using bf16x8 = __attribute__((ext_vector_type(8))) short;
using f32x4 = __attribute__((ext_vector_type(4))) float;
using f32x16 = __attribute__((ext_vector_type(16))) float;

constexpr int D = 1024, SEQ = 8192, CTX = 256, SP = 8448, MROWS = 16896, NMT = 66;
constexpr int DIN = 5792, DINP = 5888, DFF = 4096;
constexpr int OFF_HY = 512, OFF_Q = 2048, OFF_KV = 2432, OFF_GATE = 2720;
constexpr int NT = 512;
constexpr float EPS = 1e-6f;

constexpr size_t WS_H = 0;
constexpr size_t WS_PROJ = WS_H + (size_t)MROWS * D * 4;
constexpr size_t WS_U = WS_PROJ + (size_t)MROWS * DINP * 2;
constexpr size_t WS_Y = WS_U + (size_t)MROWS * 512 * 2;
constexpr size_t WS_O = WS_Y + (size_t)MROWS * 512 * 2;
constexpr size_t WS_Q = WS_O + (size_t)MROWS * 512 * 2;
constexpr size_t WS_K = WS_Q + (size_t)16 * SP * 96 * 2;
constexpr size_t WS_VT = WS_K + (size_t)16 * SP * 96 * 2;
constexpr size_t WS_ZV = WS_VT + (size_t)16 * 64 * SP * 2;
constexpr size_t WS_HID2 = WS_ZV + (size_t)512 * SP * 8;
constexpr size_t WS_HID2C = WS_HID2 + (size_t)4 * 8192 * 64 * 4;
constexpr size_t WS_MOD = WS_HID2C + (size_t)4 * 256 * 64 * 4;
constexpr size_t WS_ROPE = WS_MOD + (size_t)4 * 3 * 6144 * 4;
constexpr size_t WS_TW = WS_ROPE + (size_t)128 * 8 * 8;
constexpr size_t WS_WPE = WS_TW + (size_t)16384 * 8;
constexpr size_t WS_BAR = WS_WPE + (size_t)4 * 1024 * 512 * 2;
constexpr size_t WS_END = WS_BAR + 16384;
constexpr size_t WO_IN = 0;
constexpr size_t WO_FF1 = WO_IN + (size_t)DINP * 1024 * 2;
constexpr size_t WO_FF2 = WO_FF1 + (size_t)4096 * 1024 * 2;
constexpr size_t WO_OUT = WO_FF2 + (size_t)4096 * 1024 * 2;
constexpr size_t WO_HY = WO_OUT + (size_t)1024 * 1024 * 2;
constexpr size_t WO_WO = WO_HY + (size_t)1024 * 512 * 2;
constexpr size_t WO_PE = WO_WO + (size_t)1024 * 512 * 2;
constexpr size_t WO_UQ = WO_PE + (size_t)1024 * 512 * 2;
constexpr size_t WO_UKV = WO_UQ + (size_t)768 * 384 * 2;
constexpr size_t WO_FILT = WO_UKV + (size_t)1024 * 256 * 2;
constexpr size_t WO_END = WO_FILT + (size_t)1024 * 8192 * 2;
constexpr size_t WS_W3T = WS_HID2 + (size_t)4 * 8192 * 64 * 2;

constexpr int AUX_OFF = 147456;
constexpr int LDS_BYTES = AUX_OFF + 8192;

struct Params {
  const float* in[33];
  float* out;
  char* ws;
  int ph_lo, ph_hi;
};

struct Ctx { const unsigned long long* intab; char* ws; float* out; };
__device__ __forceinline__ const float* pin(const Ctx& c, int i) {
  unsigned long long v = c.intab[i];
  unsigned lo = __builtin_amdgcn_readfirstlane((unsigned)v), hi = __builtin_amdgcn_readfirstlane((unsigned)(v >> 32));
  return (const float*)(((unsigned long long)hi << 32) | lo);
}

typedef __bf16 hwbf2 __attribute__((ext_vector_type(2)));
typedef float hwf2 __attribute__((ext_vector_type(2)));
__device__ __forceinline__ unsigned pk2(float a, float b) {
  hwf2 v = {a, b};
  hwbf2 r = __builtin_convertvector(v, hwbf2);
  return __builtin_bit_cast(unsigned, r);
}
__device__ __forceinline__ u16 f2bf(float f) { return (u16)(pk2(f, 0.f) & 0xffffu); }
__device__ __forceinline__ float bf2f(u16 b) { return __uint_as_float(((unsigned)b) << 16); }
__device__ __forceinline__ float shx(float v, int o) {
  int l = __builtin_amdgcn_mbcnt_hi(~0u, __builtin_amdgcn_mbcnt_lo(~0u, 0u));
  asm volatile("" : "+v"(l));
  return __int_as_float(__builtin_amdgcn_ds_bpermute((l ^ o) << 2, __float_as_int(v)));
}
__device__ __forceinline__ float wave_sum(float v) {
#pragma unroll
  for (int o = 1; o < 64; o <<= 1) v += shx(v, o);
  return v;
}
__device__ __forceinline__ int grp_of_row(int m) {
  int tile = m >> 8, b = tile / 33, t33 = tile - b * 33;
  return t33 == 0 ? 2 : b;
}
__device__ __forceinline__ float2 cmul(float2 a, float2 b) { return make_float2(a.x * b.x - a.y * b.y, a.x * b.y + a.y * b.x); }

__device__ __forceinline__ int tid_l() { int t = threadIdx.x; asm volatile("" : "+v"(t)); return t; }
#define XB_TMO      128
#define XB_XCNT(j)  (256  + 64 * (j))
#define XB_XSUB(j)  (1280 + 64 * (j))
#define XB_XGEN(j)  (2304 + 64 * (j))
#define XB_TOP      3328
#define XB_TOPGEN   3392
#define XCD_BAR_WORDS 3456
#define XB_SPIN_CAP (1u << 18)
#define LAS __attribute__((address_space(3)))
__device__ __forceinline__ unsigned xb_ld(unsigned* p)              { return __hip_atomic_load(p, __ATOMIC_RELAXED, __HIP_MEMORY_SCOPE_AGENT); }
__device__ __forceinline__ unsigned xb_add(unsigned* p, unsigned v) { return __hip_atomic_fetch_add(p, v, __ATOMIC_RELAXED, __HIP_MEMORY_SCOPE_AGENT); }
__device__ __forceinline__ unsigned xb_xcc_id() { return (unsigned)__builtin_amdgcn_s_getreg((3 << 11) | 20) & 0xFu; }
#define XB_SPIN(cond, bar) do { unsigned _sp = 0; while (cond) { __builtin_amdgcn_s_sleep(1); \
    if ((++_sp & 255u) == 0u) { if (xb_ld(&(bar)[XB_TMO])) break; if (_sp > XB_SPIN_CAP) { atomicAdd(&(bar)[XB_TMO], 1u); break; } } } } while (0)
struct XcdBarrier { unsigned* bar; unsigned x; volatile LAS unsigned* st; };
__device__ __forceinline__ XcdBarrier xcd_barrier_post(unsigned* bar, volatile LAS unsigned* st) {
    XcdBarrier b; b.bar = bar; b.x = xb_xcc_id(); b.st = st;
    if (threadIdx.x == 0) (void)xb_add(&bar[XB_XCNT(b.x)], 1u);
    return b;
}
__device__ __forceinline__ void xcd_barrier_complete(unsigned* bar, unsigned x, unsigned& nloc, unsigned& nx) {
    const unsigned G = gridDim.x * gridDim.y * gridDim.z;
    unsigned sum, cnt, mine, sp = 0u;
    for (;;) {
        sum = 0u; cnt = 0u; mine = 0u;
#pragma unroll
        for (unsigned j = 0; j < 16; ++j) { const unsigned c = xb_ld(&bar[XB_XCNT(j)]); sum += c; cnt += (c > 0u) ? 1u : 0u; mine = (j == x) ? c : mine; }
        if (sum == G) break;
        __builtin_amdgcn_s_sleep(1);
        if ((++sp & 255u) == 0u) { if (xb_ld(&bar[XB_TMO])) break; if (sp > XB_SPIN_CAP) { atomicAdd(&bar[XB_TMO], 1u); break; } }
    }
    nloc = mine > 0u ? mine : 1u; nx = cnt > 0u ? cnt : 1u;
}
__device__ __forceinline__ void xcd_barrier(const XcdBarrier& b) {
    asm volatile("s_waitcnt vmcnt(0)" ::: "memory");
    __syncthreads();
    if (threadIdx.x == 0) {
        unsigned* bar = b.bar;
        __builtin_amdgcn_s_waitcnt(0);
        unsigned nloc = b.st[0], nx = b.st[1];
        if (nloc == 0u) { xcd_barrier_complete(bar, b.x, nloc, nx); b.st[0] = nloc; b.st[1] = nx; }
        const unsigned old = xb_add(&bar[XB_XSUB(b.x)], 1u);
        const unsigned gen = old / nloc;
        if (old + 1u == (gen + 1u) * nloc) {
            __builtin_amdgcn_fence(__ATOMIC_RELEASE, "agent");
            asm volatile("s_waitcnt vmcnt(0)" ::: "memory");
            const unsigned og = xb_add(&bar[XB_TOP], 1u);
            const unsigned tg = og / nx;
            if (og + 1u == (tg + 1u) * nx) xb_add(&bar[XB_TOPGEN], 1u);
            else XB_SPIN(xb_ld(&bar[XB_TOPGEN]) == tg, bar);
            __builtin_amdgcn_fence(__ATOMIC_ACQUIRE, "agent");
            xb_add(&bar[XB_XGEN(b.x)], 1u);
            asm volatile("s_waitcnt vmcnt(0)" ::: "memory");
        } else {
            XB_SPIN(xb_ld(&bar[XB_XGEN(b.x)]) == gen, bar);
            __builtin_amdgcn_fence(__ATOMIC_ACQUIRE, "agent");
            asm volatile("s_waitcnt vmcnt(0)" ::: "memory");
        }
    }
    __syncthreads();
}

__device__ __forceinline__ void grid_barrier(unsigned* bar, unsigned target) {
  asm volatile("s_waitcnt vmcnt(0)" ::: "memory");
  __syncthreads();
  if (threadIdx.x == 0) {
    __builtin_amdgcn_fence(__ATOMIC_RELEASE, "agent");
    asm volatile("s_waitcnt vmcnt(0)" ::: "memory");
    __hip_atomic_fetch_add(bar, 1u, __ATOMIC_RELAXED, __HIP_MEMORY_SCOPE_AGENT);
    while (__hip_atomic_load(bar, __ATOMIC_RELAXED, __HIP_MEMORY_SCOPE_AGENT) < target) __builtin_amdgcn_s_sleep(2);
    __builtin_amdgcn_fence(__ATOMIC_ACQUIRE, "agent");
    asm volatile("s_waitcnt vmcnt(0)" ::: "memory");
  }
  __syncthreads();
}
#define WAIT_V(n) asm volatile("s_waitcnt vmcnt(%0)" ::"n"(n) : "memory")
#define SCHED() __builtin_amdgcn_sched_barrier(0)
#define RAW_BARRIER() do { asm volatile("s_waitcnt lgkmcnt(0)" ::: "memory"); __builtin_amdgcn_s_barrier(); } while (0)

constexpr float QSCALE = 0.10206207261596575f * 1.4426950408889634f;
enum { EM_PROJ = 0, EM_SQRELU = 1, EM_RESID = 2, EM_RESID_AT = 3, EM_FILT = 4, EM_Q = 6, EM_KV = 7 };
struct Epi {
  int mode;
  char* ws;
  const float* gate;
  const float2* rope_lds;
  u16* filt_out;
  __device__ __forceinline__ void proj(int row, int col, f32x4 v) const {
    {
      u16* out = (u16*)(ws + WS_PROJ);
#pragma unroll
      for (int j = 0; j < 4; ++j) out[(size_t)(row + j) * DINP + col] = f2bf(v[j]);
    }
  }
  __device__ __forceinline__ void sqrelu(int row, int col, f32x4 v) const {
    {
      u16* out = (u16*)(ws + WS_PROJ);
#pragma unroll
      for (int j = 0; j < 4; ++j) { float r = fmaxf(v[j], 0.f); out[(size_t)(row + j) * DFF + col] = f2bf(r * r); }
    }
  }
  __device__ __forceinline__ void resid(int row, int col, f32x4 v) const {
    {
      float* h = (float*)(ws + WS_H);
      float g = gate[grp_of_row(row) * 6144 + col];
#pragma unroll
      for (int j = 0; j < 4; ++j) unsafeAtomicAdd(h + (size_t)(row + j) * D + col, g * v[j]);
    }
  }
  __device__ __forceinline__ void filt(int row, int col, f32x4 v) const {
    uint2 o;
    o.x = pk2(v[0], v[1]);
    o.y = pk2(v[2], v[3]);
    *(uint2*)(filt_out + (size_t)col * 8192 + row) = o;
  }
  __device__ __forceinline__ void q(int row, int col, f32x4 v) const {
    {
      u16* Q = (u16*)(ws + WS_Q);
      const float2* rope = rope_lds;
      int head = col / 96, d = col - head * 96;
      int b = row / SP, pos0 = row - b * SP;
      bool isrope = (d >= 64) && (pos0 >= CTX);
      int rd = d - 64;
#pragma unroll
      for (int j = 0; j < 4; ++j) {
        float val = v[j];
        float partner = shx(val, 8);
        int pos = pos0 + j;
        if (isrope) {
          int t = pos - CTX, idx = (rd < 16) ? (t >> 6) : (t & 63);
          float2 cs = rope[idx * 8 + (rd & 7)];
          float sgn = (rd & 8) ? 1.f : -1.f;
          val = val * cs.x + sgn * partner * cs.y;
        }
        Q[((size_t)(b * 8 + head) * SP + pos) * 96 + d] = f2bf(val * QSCALE);
      }
    }
  }
  __device__ __forceinline__ void kv(int row, int col, f32x4 v) const {
    {
      u16* Kb = (u16*)(ws + WS_K);
      u16* Vt = (u16*)(ws + WS_VT);
      int head = col >> 7, j2 = col & 127;
      int b = row / SP, pos0 = row - b * SP;
      if (j2 < 64) {
#pragma unroll
        for (int j = 0; j < 4; ++j) Kb[((size_t)(b * 8 + head) * SP + pos0 + j) * 96 + j2] = f2bf(v[j]);
      } else {
        uint2 o;
        o.x = pk2(v[0], v[1]);
        o.y = pk2(v[2], v[3]);
        *(uint2*)(Vt + ((size_t)(b * 8 + head) * 64 + (j2 - 64)) * SP + pos0) = o;
      }
    }
  }
};
struct GD { const u16* A; int lda; const u16* Bt; int ldb; int K; int nN; int mode; int ks; };

constexpr int G_TILE_B = 256 * 64 * 2, G_STAGE_B = 2 * G_TILE_B;
__device__ __forceinline__ int lds_byte(int r, int c) {
  int st = (r >> 4) * 2 + (c >> 5), ob = (r & 15) * 64 + (c & 31) * 2;
  return st * 1024 + (ob ^ (((ob >> 9) & 1) << 5));
}
__device__ __forceinline__ void stage_rc(int b, int& R, int& C) {
  int st = b >> 10, sb = b & 1023, swz = sb ^ (((sb >> 9) & 1) << 5);
  R = (st / 2) * 16 + swz / 64;
  C = (st % 2) * 32 + (swz % 64) / 2;
}

template <int MI>
__device__ __forceinline__ void gemm_core(const u16* __restrict__ A, int lda, const u16* __restrict__ Bt, int ldb, int K,
                                          int brow, int bcol, char* shm, f32x4 (&acc)[MI][4]) {
  constexpr int TILE_A = MI * 32 * 64 * 2, TILE_BB = 256 * 64 * 2, STAGE = TILE_A + TILE_BB;
  const int tid = tid_l(), wid = tid >> 6, lane = tid & 63, wr = wid >> 2, wc = wid & 3, fr = lane & 15, fq = lane >> 4;
  const u16* Ab = A + (size_t)brow * lda;
  const u16* Bb = Bt + (size_t)bcol * ldb;
  int sR[4], sC[4];
#pragma unroll
  for (int i = 0; i < 4; ++i) stage_rc(wid * 1024 + i * 8192 + lane * 16, sR[i], sC[i]);
#define SA(b) (shm + (b) * STAGE)
#define SB(b) (shm + (b) * STAGE + TILE_A)
#define GLDS_STAGE(buf, kt)                                                                                              \
  do {                                                                                                                   \
    _Pragma("unroll") for (int i = 0; i < 4; ++i) {                                                                      \
      if (i < MI / 2)                                                                                                    \
        __builtin_amdgcn_global_load_lds((const unsigned*)(Ab + (size_t)sR[i] * lda + (kt) * 64 + sC[i]),                \
                                         (unsigned*)(SA(buf) + wid * 1024 + i * 8192), 16, 0, 0);                        \
      __builtin_amdgcn_global_load_lds((const unsigned*)(Bb + (size_t)sR[i] * ldb + (kt) * 64 + sC[i]),                  \
                                       (unsigned*)(SB(buf) + wid * 1024 + i * 8192), 16, 0, 0);                          \
    }                                                                                                                    \
  } while (0)
  const int nt = K / 64;
  GLDS_STAGE(0, 0);
  WAIT_V(0);
  __syncthreads();
  for (int t = 0; t < nt; ++t) {
    const int cur = t & 1;
    if (t + 1 < nt) GLDS_STAGE(cur ^ 1, t + 1);
#pragma unroll
    for (int ks = 0; ks < 2; ++ks) {
      bf16x8 At[MI], Bf[4];
#pragma unroll
      for (int m = 0; m < MI; ++m) At[m] = *(const bf16x8*)(SA(cur) + lds_byte(wr * (MI * 16) + m * 16 + fr, ks * 32 + fq * 8));
#pragma unroll
      for (int n = 0; n < 4; ++n) Bf[n] = *(const bf16x8*)(SB(cur) + lds_byte(wc * 64 + n * 16 + fr, ks * 32 + fq * 8));
#pragma unroll
      for (int m = 0; m < MI; ++m)
#pragma unroll
        for (int n = 0; n < 4; ++n) acc[m][n] = __builtin_amdgcn_mfma_f32_16x16x32_bf16(At[m], Bf[n], acc[m][n], 0, 0, 0);
      SCHED();
    }
    WAIT_V(0);
    __syncthreads();
  }
#undef SA
#undef SB
#undef GLDS_STAGE
}

template <class EpiT>
__device__ __forceinline__ void gemm_tile(const u16* __restrict__ A, int lda, const u16* __restrict__ Bt, int ldb, int K,
                                          int brow, int bcol, char* shm, const EpiT& epi) {
  const int tid = tid_l(), wid = tid >> 6, lane = tid & 63, wr = wid >> 2, wc = wid & 3, fr = lane & 15, fq = lane >> 4;
  f32x4 acc[8][4];
#pragma unroll
  for (int m = 0; m < 8; ++m)
#pragma unroll
    for (int n = 0; n < 4; ++n) acc[m][n] = (f32x4){0.f, 0.f, 0.f, 0.f};
  gemm_core<8>(A, lda, Bt, ldb, K, brow, bcol, shm, acc);
#define EPI_LOOP(CALL)                                                                              \
  _Pragma("unroll") for (int m = 0; m < 8; ++m) _Pragma("unroll") for (int n = 0; n < 4; ++n) {      \
    const int row = brow + wr * 128 + m * 16 + fq * 4, col = bcol + wc * 64 + n * 16 + fr;           \
    const f32x4 v = acc[m][n];                                                                        \
    CALL;                                                                                             \
  }
  if (epi.mode == EM_PROJ) { EPI_LOOP(epi.proj(row, col, v)) }
  else if (epi.mode == EM_SQRELU) { EPI_LOOP(epi.sqrelu(row, col, v)) }
  else if (epi.mode == EM_RESID_AT) { EPI_LOOP(epi.resid(row, col, v)) }
  else if (epi.mode == EM_RESID) {
    float* h = (float*)(epi.ws + WS_H);
    float g4[4];
#pragma unroll
    for (int n = 0; n < 4; ++n) g4[n] = epi.gate[grp_of_row(brow) * 6144 + bcol + wc * 64 + n * 16 + fr];
    float hv[8][4][4];
    float* hp0 = h + (size_t)(brow + wr * 128 + fq * 4) * D + bcol + wc * 64 + fr;
#define H_LOAD(m) _Pragma("unroll") for (int n = 0; n < 4; ++n) _Pragma("unroll") for (int j = 0; j < 4; ++j) hv[m][n][j] = hp0[(size_t)((m) * 16 + j) * D + n * 16]
#define H_STORE(m) _Pragma("unroll") for (int n = 0; n < 4; ++n) _Pragma("unroll") for (int j = 0; j < 4; ++j) hp0[(size_t)((m) * 16 + j) * D + n * 16] = hv[m][n][j] + g4[n] * acc[m][n][j]
    H_LOAD(0); H_LOAD(1);
    SCHED();
    H_STORE(0); H_LOAD(2); SCHED();
    H_STORE(1); H_LOAD(3); SCHED();
    H_STORE(2); H_LOAD(4); SCHED();
    H_STORE(3); H_LOAD(5); SCHED();
    H_STORE(4); H_LOAD(6); SCHED();
    H_STORE(5); H_LOAD(7); SCHED();
    H_STORE(6); H_STORE(7);
#undef H_LOAD
#undef H_STORE
  }
  else if (epi.mode == EM_FILT) { EPI_LOOP(epi.filt(row, col, v)) }
  else if (epi.mode == EM_Q) { EPI_LOOP(epi.q(row, col, v)) }
  else { EPI_LOOP(epi.kv(row, col, v)) }
#undef EPI_LOOP
}

__device__ __forceinline__ void mix_tile(const Ctx& p, int l, int pm, int pn, char* shm) {
  constexpr int TILE_A = 128 * 64 * 2, TILE_BB = 256 * 64 * 2, STAGE = TILE_A + TILE_BB;
  const int tid = tid_l(), wid = tid >> 6, lane = tid & 63, wr = wid >> 2, wc = wid & 3, fr = lane & 15, fq = lane >> 4;
  const int brow = pm * 128, bcol = pn * 256;
  const u16* projb = (const u16*)(p.ws + WS_PROJ);
  char* wo = (char*)p.out;
#define SA(b) (shm + (b) * STAGE)
#define SB(b) (shm + (b) * STAGE + TILE_A)
#define MIX_STAGE(buf, kt)                                                                                               \
  do {                                                                                                                   \
    const int br_ = (kt) >> 3, ko_ = ((kt) & 7) * 64;                                                                    \
    const u16* Ab_ = (const u16*)(p.ws + (br_ == 0 ? WS_U : br_ == 1 ? WS_Y : WS_O)) + (size_t)brow * 512 + ko_;         \
    const u16* Bb_ = (br_ == 0 ? (const u16*)(p.ws + WS_WPE) + (size_t)l * 1024 * 512 : (const u16*)(wo + (br_ == 1 ? WO_HY : WO_WO))) + (size_t)bcol * 512 + ko_;        \
    _Pragma("unroll") for (int i = 0; i < 4; ++i) {                                                                      \
      int sR_, sC_; stage_rc(wid * 1024 + i * 8192 + lane * 16, sR_, sC_);                                              \
      if (i < 2)                                                                                                         \
        __builtin_amdgcn_global_load_lds((const unsigned*)(Ab_ + sR_ * 512 + sC_),                           \
                                         (unsigned*)(SA(buf) + wid * 1024 + i * 8192), 16, 0, 0);                        \
      __builtin_amdgcn_global_load_lds((const unsigned*)(Bb_ + sR_ * 512 + sC_),                             \
                                       (unsigned*)(SB(buf) + wid * 1024 + i * 8192), 16, 0, 0);                          \
    }                                                                                                                    \
  } while (0)
  f32x4 tot[4][4], acc[4][4];
#pragma unroll
  for (int m = 0; m < 4; ++m)
#pragma unroll
    for (int n = 0; n < 4; ++n) { tot[m][n] = (f32x4){0.f, 0.f, 0.f, 0.f}; acc[m][n] = (f32x4){0.f, 0.f, 0.f, 0.f}; }
  MIX_STAGE(0, 0);
  MIX_STAGE(1, 1);
  WAIT_V(6);
  RAW_BARRIER();
  int cur = 0;
#pragma unroll 1
  for (int br = 0; br < 3; ++br) {
    unsigned gpk[4][4][2];
    const u16* gp = projb + (size_t)(brow + wr * 64 + fq * 4) * DINP + OFF_GATE + br * 1024 + bcol + wc * 64 + fr;
#define GATE_LOAD(m)                                                                                   \
    _Pragma("unroll") for (int n = 0; n < 4; ++n) _Pragma("unroll") for (int j2 = 0; j2 < 2; ++j2) {       \
      unsigned lo = gp[(size_t)((m) * 16 + 2 * j2) * DINP + n * 16], hi = gp[(size_t)((m) * 16 + 2 * j2 + 1) * DINP + n * 16]; \
      gpk[m][n][j2] = lo | (hi << 16);                                                                     \
    }
    GATE_LOAD(0); GATE_LOAD(1); GATE_LOAD(2);
#pragma unroll 1
    for (int kk = 0; kk < 8; ++kk) {
      const int t = br * 8 + kk;
      { int nx = cur + 2; if (nx >= 3) nx -= 3; if (t + 2 < 24) MIX_STAGE(nx, t + 2); }
#pragma unroll
      for (int ks = 0; ks < 2; ++ks) {
        bf16x8 At[2], Bf[4];
#pragma unroll
        for (int n = 0; n < 4; ++n) Bf[n] = *(const bf16x8*)(SB(cur) + lds_byte(wc * 64 + n * 16 + fr, ks * 32 + fq * 8));
#pragma unroll
        for (int mh = 0; mh < 2; ++mh) {
#pragma unroll
          for (int m = 0; m < 2; ++m) At[m] = *(const bf16x8*)(SA(cur) + lds_byte(wr * 64 + (mh * 2 + m) * 16 + fr, ks * 32 + fq * 8));
#pragma unroll
          for (int m = 0; m < 2; ++m)
#pragma unroll
            for (int n = 0; n < 4; ++n) acc[mh * 2 + m][n] = __builtin_amdgcn_mfma_f32_16x16x32_bf16(At[m], Bf[n], acc[mh * 2 + m][n], 0, 0, 0);
          SCHED();
        }
      }
      if (t + 2 < 24) WAIT_V(6); else WAIT_V(0);
      RAW_BARRIER();
      cur = (cur == 2) ? 0 : cur + 1;
    }
    GATE_LOAD(3);
#undef GATE_LOAD
#pragma unroll
    for (int m = 0; m < 4; ++m)
#pragma unroll
      for (int n = 0; n < 4; ++n)
#pragma unroll
        for (int j = 0; j < 4; ++j) {
          const unsigned w = gpk[m][n][j >> 1];
          const float gv = __uint_as_float((j & 1) ? (w & 0xffff0000u) : (w << 16));
          tot[m][n][j] += acc[m][n][j] / (1.f + __expf(-gv));
          acc[m][n][j] = 0.f;
        }
  }
  u16* mixb = (u16*)(p.ws + WS_ZV);
#pragma unroll
  for (int m = 0; m < 4; ++m)
#pragma unroll
    for (int n = 0; n < 4; ++n)
#pragma unroll
      for (int j = 0; j < 4; ++j)
        mixb[(size_t)(brow + wr * 64 + m * 16 + fq * 4 + j) * D + bcol + wc * 64 + n * 16 + fr] = f2bf(tot[m][n][j]);
#undef SA
#undef SB
#undef MIX_STAGE
}

__device__ __forceinline__ void tile_map(int t, int nM, int nN, int& pm, int& pn) {
  int nwg = nM * nN, wgid = t;
  {
    int q = nwg / 8, r = nwg % 8, xcd = wgid % 8, off = wgid / 8;
    wgid = (xcd < r ? xcd * (q + 1) : r * (q + 1) + (xcd - r) * q) + off;
  }
  int nig = 8 * nN, gid = wgid / nig, fm = gid * 8, gsz = min(nM - fm, 8);
  pm = fm + ((wgid % nig) % gsz);
  pn = (wgid % nig) / gsz;
}

__device__ __forceinline__ void p0_misc(const Ctx& p) {
  const int gtid = blockIdx.x * NT + tid_l(), gn = gridDim.x * NT;
  float4* h4 = (float4*)(p.ws + WS_H);
  const float4* x4 = (const float4*)pin(p, 0);
  const float4* c4 = (const float4*)pin(p, 2);
#pragma unroll 8
  for (int i = gtid; i < MROWS * 256; i += gn) {
    int m = i >> 8, q = i & 255, b = m / SP, pos = m - b * SP;
    float4 v = (pos < CTX) ? c4[(size_t)(b * CTX + pos) * 256 + q] : x4[(size_t)(b * SEQ + pos - CTX) * 256 + q];
    h4[i] = v;
  }
  float2* rope = (float2*)(p.ws + WS_ROPE);
  for (int i = gtid; i < 1024; i += gn) {
    int idx = i >> 3, f = i & 7;
    float inv = powf(10000.f, -(float)f / 8.f);
    float a = (float)idx * inv;
    rope[i] = make_float2(cosf(a), sinf(a));
  }
  {
    u16* w3t = (u16*)(p.ws + WS_W3T);
    const float* w3 = pin(p, 20);
    for (int i = gtid; i < 4 * 1024 * 64; i += gn) { int l = i >> 16, c2 = (i >> 6) & 1023, k = i & 63; w3t[i] = f2bf(w3[((size_t)l * 64 + k) * 1024 + c2]); }
  }
  float2* tw = (float2*)(p.ws + WS_TW);
  for (int i = gtid; i < 16384; i += gn) {
    float s, c;
    sincospif(-(float)i / 8192.f, &s, &c);
    tw[i] = make_float2(c, s);
  }
}

__device__ __forceinline__ void p0_mod_task(const Ctx& p, int task, char* smem) {
  float* s = (float*)smem;
  float* red = s + 3072;
  const int tid = tid_l();
  const int l = task / 48, chunk = task - l * 48;
  for (int i = tid; i < 3072; i += NT) {
    int g = i >> 10, k = i & 1023;
    float cv = (g < 2) ? pin(p, 1)[g * 1024 + k] : pin(p, 3)[k];
    s[i] = cv / (1.f + __expf(-cv));
  }
  __syncthreads();
  const int kq = tid >> 7, col = tid & 127, n = chunk * 128 + col;
  const float* W = pin(p, 4) + (size_t)l * 1024 * 6144 + n;
  float a0 = 0.f, a1 = 0.f, a2 = 0.f;
#pragma unroll 32
  for (int k = kq * 256; k < kq * 256 + 256; ++k) {
    float w = W[(size_t)k * 6144];
    a0 += s[k] * w; a1 += s[1024 + k] * w; a2 += s[2048 + k] * w;
  }
  red[(kq * 3 + 0) * 128 + col] = a0;
  red[(kq * 3 + 1) * 128 + col] = a1;
  red[(kq * 3 + 2) * 128 + col] = a2;
  __syncthreads();
  if (tid < 384) {
    int g = tid >> 7, c2 = tid & 127, n2 = chunk * 128 + c2;
    float v = red[(0 * 3 + g) * 128 + c2] + red[(1 * 3 + g) * 128 + c2] + red[(2 * 3 + g) * 128 + c2] + red[(3 * 3 + g) * 128 + c2];
    ((float*)(p.ws + WS_MOD))[(size_t)(l * 3 + g) * 6144 + n2] = v + pin(p, 5)[l * 6144 + n2];
  }
  __syncthreads();
}

__device__ __forceinline__ void p0_hid_task(const Ctx& p, int task, char* smem) {
  float* zs = (float*)smem;
  float* h1 = zs + 8 * 36;
  float* w1s = h1 + 8 * 64;
  float* w2s = w1s + 33 * 64;
  const int tid = tid_l(), tl = tid >> 6, j = tid & 63;
  const int l = task / 132, r = task - l * 132;
  const bool isctx = r >= 128;
  const int L = isctx ? 256 : 8192;
  const int tbase = (isctx ? (r - 128) : r) * 64;
  for (int i = tid; i < 33 * 64; i += NT) w1s[i] = pin(p, 14)[l * 33 * 64 + i];
  for (int i = tid; i < 64 * 64; i += NT) w2s[i] = pin(p, 17)[l * 64 * 64 + i];
  const float b1 = pin(p, 15)[l * 64 + j], f1 = pin(p, 16)[l * 64 + j], b2 = pin(p, 18)[l * 64 + j], f2 = pin(p, 19)[l * 64 + j];
  __syncthreads();
  for (int sub = 0; sub < 8; ++sub) {
    const int t = tbase + sub * 8 + tl;
    if (j < 33) {
      float z;
      if (j == 0) z = (float)t / (float)(L - 1);
      else {
        int i = (j - 1) & 15;
        float band = 1e-4f + (float)i * ((15.f - 1e-4f) / 15.f);
        float omega = 6.2831855f * (float)t / (float)L;
        float a = omega * band;
        z = (j <= 16) ? cosf(a) : -sinf(a);
      }
      zs[tl * 36 + j] = z;
    }
    __syncthreads();
    {
      float a = b1;
#pragma unroll
      for (int k = 0; k < 33; ++k) a += zs[tl * 36 + k] * w1s[k * 64 + j];
      h1[tl * 64 + j] = sinf(f1 * a);
    }
    __syncthreads();
    {
      float a = b2;
#pragma unroll 16
      for (int k = 0; k < 64; ++k) a += h1[tl * 64 + k] * w2s[k * 64 + j];
      float v = sinf(f2 * a);
      if (isctx) ((float*)(p.ws + WS_HID2C))[((size_t)l * 64 + j) * 256 + t] = v;
      else ((u16*)(p.ws + WS_HID2))[((size_t)l * 8192 + t) * 64 + j] = f2bf(v);
    }
  }
  __syncthreads();
}

struct WtItem { const float* W; u16* WT; int K, N, k0, n0; };
__device__ __forceinline__ WtItem wt_decode(const Ctx& p, int l, int r) {
  char* wo = (char*)p.out;
  WtItem it;
  int nblk;
  if (r < 1472) { it.W = pin(p, 8) + (size_t)l * 1024 * DIN; it.K = 1024; it.N = DIN; it.WT = (u16*)(wo + WO_IN); nblk = 92; }
  else if ((r -= 1472) < 1024) { it.W = pin(p, 30) + (size_t)l * 1024 * 4096; it.K = 1024; it.N = 4096; it.WT = (u16*)(wo + WO_FF1); nblk = 64; }
  else if ((r -= 1024) < 1024) { it.W = pin(p, 31) + (size_t)l * 4096 * 1024; it.K = 4096; it.N = 1024; it.WT = (u16*)(wo + WO_FF2); nblk = 16; }
  else if ((r -= 1024) < 256) { it.W = pin(p, 29) + (size_t)l * 1024 * 1024; it.K = 1024; it.N = 1024; it.WT = (u16*)(wo + WO_OUT); nblk = 16; }
  else if ((r -= 256) < 128) { it.W = pin(p, 23) + (size_t)l * 512 * 1024; it.K = 512; it.N = 1024; it.WT = (u16*)(wo + WO_HY); nblk = 16; }
  else if ((r -= 128) < 128) { it.W = pin(p, 28) + (size_t)l * 512 * 1024; it.K = 512; it.N = 1024; it.WT = (u16*)(wo + WO_WO); nblk = 16; }
  else if ((r -= 128) < 72) { it.W = pin(p, 25) + (size_t)l * 384 * 768; it.K = 384; it.N = 768; it.WT = (u16*)(wo + WO_UQ); nblk = 12; }
  else { r -= 72; it.W = pin(p, 27) + (size_t)l * 256 * 1024; it.K = 256; it.N = 1024; it.WT = (u16*)(wo + WO_UKV); nblk = 16; }
  const int kb = r / nblk, nb2 = r - kb * nblk;
  it.k0 = kb * 64; it.n0 = nb2 * 64;
  return it;
}
__device__ __forceinline__ void wt_load(const WtItem& it, int tid, float (&v)[8]) {
  const int nn = tid & 63, kq = tid >> 6;
  const bool ok = it.n0 + nn < it.N;
  const float* src = it.W + (size_t)(it.k0 + kq) * it.N + it.n0 + (ok ? nn : 0);
#pragma unroll
  for (int r = 0; r < 8; ++r) { float x = src[(size_t)(r * 8) * it.N]; v[r] = ok ? x : 0.f; }
}
__device__ __forceinline__ void wt_phase(const Ctx& p, int l, char* smem) {
  float* tile = (float*)smem;
  const int tid = tid_l();
  const int bid = blockIdx.x, nb = gridDim.x;
  int t = bid;
  if (t >= 4168) return;
  WtItem cur = wt_decode(p, l, t);
  float v[8];
  wt_load(cur, tid, v);
#pragma unroll 1
  while (true) {
    const int tn = t + nb;
    const bool more = tn < 4168;
    WtItem nxt = cur;
    float vn[8];
    if (more) { nxt = wt_decode(p, l, tn); wt_load(nxt, tid, vn); }
#pragma unroll
    for (int r = 0; r < 8; ++r) tile[(r * 8 + (tid >> 6)) * 65 + (tid & 63)] = v[r];
    __syncthreads();
    {
      int n = tid >> 3, kc = (tid & 7) * 8;
      uint4 o;
      o.x = pk2(tile[(kc + 0) * 65 + n], tile[(kc + 1) * 65 + n]);
      o.y = pk2(tile[(kc + 2) * 65 + n], tile[(kc + 3) * 65 + n]);
      o.z = pk2(tile[(kc + 4) * 65 + n], tile[(kc + 5) * 65 + n]);
      o.w = pk2(tile[(kc + 6) * 65 + n], tile[(kc + 7) * 65 + n]);
      *(uint4*)(cur.WT + (size_t)(cur.n0 + n) * cur.K + cur.k0 + kc) = o;
    }
    __syncthreads();
    if (!more) break;
    cur = nxt;
#pragma unroll
    for (int r = 0; r < 8; ++r) v[r] = vn[r];
    t = tn;
  }
}

__device__ __forceinline__ void wpe_task(const Ctx& p, int l, int task, char* smem) {
  const int g = task >> 3, c0 = (task & 7) * 16, tid = tid_l();
  const float* pw = pin(p, 9) + ((size_t)(l * 4 + g) * 128) * 128;
  const float* sc = pin(p, 10) + l * 512 + g * 128;
  const float* po = pin(p, 11) + ((size_t)l * 512 + g * 128) * 1024;
  u16* WpeT = (u16*)(p.ws + WS_WPE) + (size_t)l * 1024 * 512;
  float* wl = (float*)smem;
  for (int i = tid; i < 16 * 128; i += NT) { int d = i & 127; wl[i] = pw[(c0 + (i >> 7)) * 128 + d] * sc[d]; }
  __syncthreads();
  float acc0[16], acc1[16];
#pragma unroll
  for (int i = 0; i < 16; ++i) { acc0[i] = 0.f; acc1[i] = 0.f; }
#pragma unroll 16
  for (int d = 0; d < 128; ++d) {
    float p0 = po[(size_t)d * 1024 + tid], p1 = po[(size_t)d * 1024 + 512 + tid];
#pragma unroll
    for (int i = 0; i < 16; ++i) { float w = wl[i * 128 + d]; acc0[i] += w * p0; acc1[i] += w * p1; }
  }
  uint4 o0, o1;
  o0.x = pk2(acc0[0], acc0[1]); o0.y = pk2(acc0[2], acc0[3]); o0.z = pk2(acc0[4], acc0[5]); o0.w = pk2(acc0[6], acc0[7]);
  o1.x = pk2(acc0[8], acc0[9]); o1.y = pk2(acc0[10], acc0[11]); o1.z = pk2(acc0[12], acc0[13]); o1.w = pk2(acc0[14], acc0[15]);
  uint4* dst = (uint4*)(WpeT + (size_t)tid * 512 + g * 128 + c0);
  dst[0] = o0; dst[1] = o1;
  o0.x = pk2(acc1[0], acc1[1]); o0.y = pk2(acc1[2], acc1[3]); o0.z = pk2(acc1[4], acc1[5]); o0.w = pk2(acc1[6], acc1[7]);
  o1.x = pk2(acc1[8], acc1[9]); o1.y = pk2(acc1[10], acc1[11]); o1.z = pk2(acc1[12], acc1[13]); o1.w = pk2(acc1[14], acc1[15]);
  dst = (uint4*)(WpeT + (size_t)(512 + tid) * 512 + g * 128 + c0);
  dst[0] = o0; dst[1] = o1;
  __syncthreads();
}

__device__ __forceinline__ void norm_rows(const Ctx& p, const float* gain, const float* modl, int sh_idx, int sc_idx, u16* outp) {
  const int tidx = tid_l(), lane = tidx & 63, gw = blockIdx.x * 8 + (tidx >> 6), ngw = gridDim.x * 8;
  const float* h = (const float*)(p.ws + WS_H);
  float4 g[4];
#pragma unroll
  for (int j = 0; j < 4; ++j) g[j] = *(const float4*)(gain + lane * 4 + 256 * j);
  for (int m0 = gw; m0 < MROWS; m0 += 2 * ngw) {
    const int m1 = m0 + ngw;
    const bool has1 = m1 < MROWS;
    const int m1c = has1 ? m1 : m0;
    const float4* hr0 = (const float4*)(h + (size_t)m0 * D) + lane;
    const float4* hr1 = (const float4*)(h + (size_t)m1c * D) + lane;
    float4 v0[4], v1[4];
#pragma unroll
    for (int j = 0; j < 4; ++j) { v0[j] = hr0[64 * j]; v1[j] = hr1[64 * j]; }
    const float* mg0 = modl + grp_of_row(m0) * 6144;
    const float* mg1 = modl + grp_of_row(m1c) * 6144;
    float s0 = 0.f, s1 = 0.f;
#pragma unroll
    for (int j = 0; j < 4; ++j) {
      s0 += v0[j].x * v0[j].x + v0[j].y * v0[j].y + v0[j].z * v0[j].z + v0[j].w * v0[j].w;
      s1 += v1[j].x * v1[j].x + v1[j].y * v1[j].y + v1[j].z * v1[j].z + v1[j].w * v1[j].w;
    }
    s0 = wave_sum(s0);
    s1 = wave_sum(s1);
    const float r0 = rsqrtf(s0 * (1.f / D) + EPS), r1 = rsqrtf(s1 * (1.f / D) + EPS);
    uint2* o0 = (uint2*)(outp + (size_t)m0 * D) + lane;
    uint2* o1 = (uint2*)(outp + (size_t)m1c * D) + lane;
#pragma unroll
    for (int j = 0; j < 4; ++j) {
      int n = lane * 4 + 256 * j;
      float4 sc = *(const float4*)(mg0 + sc_idx * 1024 + n), sh = *(const float4*)(mg0 + sh_idx * 1024 + n);
      uint2 o;
      o.x = pk2(v0[j].x * r0 * g[j].x * (1.f + sc.x) + sh.x, v0[j].y * r0 * g[j].y * (1.f + sc.y) + sh.y);
      o.y = pk2(v0[j].z * r0 * g[j].z * (1.f + sc.z) + sh.z, v0[j].w * r0 * g[j].w * (1.f + sc.w) + sh.w);
      o0[64 * j] = o;
    }
    if (has1) {
#pragma unroll
      for (int j = 0; j < 4; ++j) {
        int n = lane * 4 + 256 * j;
        float4 sc = *(const float4*)(mg1 + sc_idx * 1024 + n), sh = *(const float4*)(mg1 + sh_idx * 1024 + n);
        uint2 o;
        o.x = pk2(v1[j].x * r1 * g[j].x * (1.f + sc.x) + sh.x, v1[j].y * r1 * g[j].y * (1.f + sc.y) + sh.y);
        o.y = pk2(v1[j].z * r1 * g[j].z * (1.f + sc.z) + sh.z, v1[j].w * r1 * g[j].w * (1.f + sc.w) + sh.w);
        o1[64 * j] = o;
      }
    }
  }
}

__device__ __forceinline__ void final_norm(const Ctx& p) {
  const int tidx = tid_l(), lane = tidx & 63, gw = blockIdx.x * 8 + (tidx >> 6), ngw = gridDim.x * 8;
  const float* h = (const float*)(p.ws + WS_H);
  const float* gain = pin(p, 32);
  for (int r0 = gw; r0 < 2 * SEQ; r0 += ngw) {
    int b = r0 >> 13, t = r0 & 8191, m = b * SP + CTX + t;
    const float4* hr = (const float4*)(h + (size_t)m * D) + lane;
    float4 v[4];
    float ss = 0.f;
#pragma unroll
    for (int j = 0; j < 4; ++j) { v[j] = hr[64 * j]; ss += v[j].x * v[j].x + v[j].y * v[j].y + v[j].z * v[j].z + v[j].w * v[j].w; }
    ss = wave_sum(ss);
    float r = rsqrtf(ss * (1.f / D) + EPS);
    float4* o = (float4*)(p.out + (size_t)r0 * D) + lane;
#pragma unroll
    for (int j = 0; j < 4; ++j) {
      float4 g = *(const float4*)(gain + lane * 4 + 256 * j);
      o[64 * j] = make_float4(v[j].x * r * g.x, v[j].y * r * g.y, v[j].z * r * g.z, v[j].w * r * g.w);
    }
  }
}

__device__ __forceinline__ void premix_task(const Ctx& p, int l, int task, char* smem) {
  const int tid = tid_l(), lane = tid & 63, wid = tid >> 6;
  const int part = task / 264, tile64 = task - part * 264;
  const int m0 = tile64 * 64, b = m0 / SP, pos0 = m0 - b * SP;
  const bool isctx = pos0 < CTX;
  const int s0 = isctx ? 0 : CTX, L = isctx ? CTX : SEQ, t0 = pos0 - s0;
  const size_t mb = (size_t)b * SP + s0;
  const u16* proj = (const u16*)(p.ws + WS_PROJ);
  if (part == 0) {
    u16* P = (u16*)smem;
#pragma unroll
    for (int i = tid; i < 80 * 64; i += NT) {
      int r = i >> 6, ch = i & 63, t = t0 - 8 + r;
      uint4 v = make_uint4(0, 0, 0, 0);
      if (t >= 0 && t < L) v = *(const uint4*)(proj + (mb + t) * DINP + ch * 8);
      *(uint4*)(P + r * 512 + ch * 8) = v;
    }
    __syncthreads();
    const int c = tid, g = c >> 7, hw = 1 << g;
    u16* U = (u16*)(p.ws + WS_U);
    float s = 0.f;
    for (int q = -hw; q < hw; ++q) s += bf2f(P[(8 + q) * 512 + c]);
#pragma unroll 4
    for (int tt = 0; tt < 64; ++tt) {
      int t = t0 + tt, lo = max(t - hw, 0), hi = min(t + hw, L);
      float u = s / (float)(hi - lo) - bf2f(P[(tt + 8) * 512 + c]);
      U[(mb + t) * 512 + c] = f2bf(u);
      s += bf2f(P[(tt + 8 + hw) * 512 + c]) - bf2f(P[(tt + 8 - hw) * 512 + c]);
    }
    __syncthreads();
  } else if (part <= 4) {
    const int ch0 = (part - 1) * 128;
    constexpr int PITCH = 136;
    u16* X = (u16*)smem;
    float* T = (float*)(smem + 3 * 66 * PITCH * 2 + 64);
#pragma unroll
    for (int ii = 0; ii < 7; ++ii) {
      const int i = tid + ii * NT;
      if (i >= 3 * 66 * 16) break;
      int pr = i / (66 * 16), rem = i - pr * 66 * 16, r = rem >> 4, ch = rem & 15, t = t0 - 1 + r;
      uint4 v = make_uint4(0, 0, 0, 0);
      if (t >= 0 && t < L) v = *(const uint4*)(proj + (mb + t) * DINP + OFF_HY + pr * 512 + ch0 + ch * 8);
      *(uint4*)(X + (pr * 66 + r) * PITCH + ch * 8) = v;
    }
    __syncthreads();
    const float* cw = pin(p, 12) + l * 3 * 1536;
    const float* cb = pin(p, 13) + l * 1536;
    {
      const int c = tid & 127, tq = tid >> 7, col = ch0 + c;
      const float w00 = cw[col], w01 = cw[1536 + col], w02 = cw[3072 + col], b0 = cb[col];
      const float w10 = cw[512 + col], w11 = cw[1536 + 512 + col], w12 = cw[3072 + 512 + col], b1 = cb[512 + col];
      const float w20 = cw[1024 + col], w21 = cw[1536 + 1024 + col], w22 = cw[3072 + 1024 + col], b2 = cb[1024 + col];
      const u16* X0 = X, *X1 = X + 66 * PITCH, *XV = X + 2 * 66 * PITCH;
      u16* Y = (u16*)(p.ws + WS_Y);
#pragma unroll 4
      for (int tt = tq * 16; tt < tq * 16 + 16; ++tt) {
        float x0 = w00 * bf2f(X0[tt * PITCH + c]) + w01 * bf2f(X0[(tt + 1) * PITCH + c]) + w02 * bf2f(X0[(tt + 2) * PITCH + c]) + b0;
        float x1 = w10 * bf2f(X1[tt * PITCH + c]) + w11 * bf2f(X1[(tt + 1) * PITCH + c]) + w12 * bf2f(X1[(tt + 2) * PITCH + c]) + b1;
        float vv = w20 * bf2f(XV[tt * PITCH + c]) + w21 * bf2f(XV[(tt + 1) * PITCH + c]) + w22 * bf2f(XV[(tt + 2) * PITCH + c]) + b2;
        Y[(mb + t0 + tt) * 512 + col] = f2bf(x0);
        T[c * 65 + tt] = x1 * vv;
      }
    }
    __syncthreads();
    {
      float* ZV = (float*)(p.ws + WS_ZV);
#pragma unroll 4
      for (int cc = 0; cc < 16; ++cc) {
        int c = wid * 16 + cc;
        ZV[((size_t)(ch0 + c) * SP + pos0 + lane) * 2 + b] = T[c * 65 + lane];
      }
    }
    __syncthreads();
  } else {
    u16* projw = (u16*)(p.ws + WS_PROJ);
    const float* qg = pin(p, 24) + l * 384;
    const float* kg = pin(p, 26) + l * 256;
    const float2* rope = (const float2*)(p.ws + WS_ROPE);
    u16* Kb = (u16*)(p.ws + WS_K);
#pragma unroll 2
    for (int rr = 0; rr < 8; ++rr) {
      int tt = wid * 8 + rr, pos = pos0 + tt;
      u16* row = projw + ((size_t)b * SP + pos) * DINP;
      unsigned* q32 = (unsigned*)(row + OFF_Q);
      unsigned* k32 = (unsigned*)(row + OFF_KV);
      unsigned v[3], w[2];
      float ss = 0.f, s2 = 0.f;
#pragma unroll
      for (int j = 0; j < 3; ++j) v[j] = q32[lane + 64 * j];
#pragma unroll
      for (int j = 0; j < 2; ++j) w[j] = k32[lane + 64 * j];
      const int rd = lane & 31;
      float val = bf2f(row[OFF_KV + 256 + rd]);
#pragma unroll
      for (int j = 0; j < 3; ++j) { float a = bf2f(v[j] & 0xffff), c2 = bf2f(v[j] >> 16); ss += a * a + c2 * c2; }
#pragma unroll
      for (int j = 0; j < 2; ++j) { float a = bf2f(w[j] & 0xffff), c2 = bf2f(w[j] >> 16); s2 += a * a + c2 * c2; }
      ss = wave_sum(ss);
      s2 = wave_sum(s2);
      float r = rsqrtf(ss * (1.f / 384.f) + EPS), r2 = rsqrtf(s2 * (1.f / 256.f) + EPS);
#pragma unroll
      for (int j = 0; j < 3; ++j) {
        int n = (lane + 64 * j) * 2;
        q32[lane + 64 * j] = pk2(bf2f(v[j] & 0xffff) * r * qg[n], bf2f(v[j] >> 16) * r * qg[n + 1]);
      }
#pragma unroll
      for (int j = 0; j < 2; ++j) {
        int n = (lane + 64 * j) * 2;
        k32[lane + 64 * j] = pk2(bf2f(w[j] & 0xffff) * r2 * kg[n], bf2f(w[j] >> 16) * r2 * kg[n + 1]);
      }
      float partner = shx(val, 8);
      if (!isctx) {
        int t = pos - CTX, idx = (rd < 16) ? (t >> 6) : (t & 63);
        float2 cs = rope[idx * 8 + (rd & 7)];
        float sgn = (rd & 8) ? 1.f : -1.f;
        val = val * cs.x + sgn * partner * cs.y;
      }
      if (lane < 32) {
        u16 o = f2bf(val);
#pragma unroll
        for (int hd = 0; hd < 8; ++hd) Kb[((size_t)(b * 8 + hd) * SP + pos) * 96 + 64 + rd] = o;
      }
    }
  }
}

__device__ __forceinline__ int xi(int i) { const int h = i >> 5; return i ^ (((h & 3) * 5) | ((h & 2) << 3)); }
typedef float v2f __attribute__((ext_vector_type(2)));
__device__ __forceinline__ v2f cmulv(v2f a, v2f b) {
  v2f bs = {-b.y, b.x};
  return a.xx * b + a.yy * bs;
}
__device__ __forceinline__ void bf_fwd(float2* Xf, int base, int q, float2 w1f) {
  v2f* X = (v2f*)Xf;
  const v2f w1 = {w1f.x, w1f.y};
  const v2f w2 = cmulv(w1, w1), w3 = cmulv(w2, w1);
  const int i0 = xi(base), i1 = xi(base + q), i2 = xi(base + 2 * q), i3 = xi(base + 3 * q);
  v2f a0 = X[i0], a1 = X[i1], a2 = X[i2], a3 = X[i3];
  v2f s02 = a0 + a2, d02 = a0 - a2, s13 = a1 + a3, d13 = a1 - a3;
  v2f d13r = {d13.y, -d13.x};
  X[i0] = s02 + s13;
  X[i1] = cmulv(d02 + d13r, w1);
  X[i2] = cmulv(s02 - s13, w2);
  X[i3] = cmulv(d02 - d13r, w3);
}
__device__ __forceinline__ void bf_inv(float2* Xf, int base, int q, float2 w1f) {
  v2f* X = (v2f*)Xf;
  const v2f w1 = {w1f.x, -w1f.y};
  const v2f w2 = cmulv(w1, w1), w3 = cmulv(w2, w1);
  const int i0 = xi(base), i1 = xi(base + q), i2 = xi(base + 2 * q), i3 = xi(base + 3 * q);
  v2f b0 = X[i0], c1 = cmulv(X[i1], w1), c2 = cmulv(X[i2], w2), c3 = cmulv(X[i3], w3);
  v2f s02 = b0 + c2, d02 = b0 - c2, s13 = c1 + c3, d13 = c1 - c3;
  v2f d13r = {-d13.y, d13.x};
  X[i0] = s02 + s13;
  X[i1] = d02 + d13r;
  X[i2] = s02 - s13;
  X[i3] = d02 - d13r;
}
template <bool INV, int LQ>
__device__ __forceinline__ void fft_pass(float2* X, const float2* __restrict__ tw, const float2 (&twr)[6], int tid) {
  constexpr int q = 1 << LQ;
  if (LQ == 12) {
    float2 w[8];
#pragma unroll
    for (int b8 = 0; b8 < 8; ++b8) w[b8] = tw[b8 * NT + tid];
#pragma unroll
    for (int b8 = 0; b8 < 8; ++b8) { int u = b8 * NT + tid; if (INV) bf_inv(X, u, q, w[b8]); else bf_fwd(X, u, q, w[b8]); }
  } else if (LQ == 10) {
#pragma unroll 2
    for (int b8 = 0; b8 < 8; ++b8) {
      int u = b8 * NT + tid, j = u & 1023, base = ((u >> 10) << 12) + j;
      float2 w = (b8 & 1) ? twr[1] : twr[0];
      if (INV) bf_inv(X, base, q, w); else bf_fwd(X, base, q, w);
    }
  } else {
    const int j = tid & (q - 1);
    const float2 w = (LQ == 0) ? make_float2(1.f, 0.f) : twr[2 + (8 - LQ) / 2];
#pragma unroll 2
    for (int b8 = 0; b8 < 8; ++b8) {
      int u = b8 * NT + tid, base = ((u >> LQ) << (LQ + 2)) + j;
      if (INV) bf_inv(X, base, q, w); else bf_fwd(X, base, q, w);
    }
  }
  __syncthreads();
}
__device__ __forceinline__ void fft_load_tw(const float2* __restrict__ tw, int tid, float2 (&twr)[6]) {
  twr[0] = tw[tid << 2];
  twr[1] = tw[(512 + tid) << 2];
  twr[2] = tw[(tid & 255) << 4];
  twr[3] = tw[(tid & 63) << 6];
  twr[4] = tw[(tid & 15) << 8];
  twr[5] = tw[(tid & 3) << 10];
}
__device__ __forceinline__ void fft_dif(float2* X, const float2* __restrict__ tw, const float2 (&twr)[6]) {
  const int tid = tid_l();
  fft_pass<false, 12>(X, tw, twr, tid); fft_pass<false, 10>(X, tw, twr, tid); fft_pass<false, 8>(X, tw, twr, tid); fft_pass<false, 6>(X, tw, twr, tid);
  fft_pass<false, 4>(X, tw, twr, tid); fft_pass<false, 2>(X, tw, twr, tid); fft_pass<false, 0>(X, tw, twr, tid);
}
__device__ __forceinline__ void fft_dit_inv(float2* X, const float2* __restrict__ tw, const float2 (&twr)[6]) {
  const int tid = tid_l();
  fft_pass<true, 0>(X, tw, twr, tid); fft_pass<true, 2>(X, tw, twr, tid); fft_pass<true, 4>(X, tw, twr, tid); fft_pass<true, 6>(X, tw, twr, tid);
  fft_pass<true, 8>(X, tw, twr, tid); fft_pass<true, 10>(X, tw, twr, tid); fft_pass<true, 12>(X, tw, twr, tid);
}
__device__ __forceinline__ float block_sum(float v, float* red) {
  v = wave_sum(v);
  __syncthreads();
  { const int tb = tid_l(); if ((tb & 63) == 0) red[tb >> 6] = v; }
  __syncthreads();
  float s = red[0] + red[1] + red[2] + red[3] + red[4] + red[5] + red[6] + red[7];
  __syncthreads();
  return s;
}

__device__ __forceinline__ void fft_task(const Ctx& p, int l, int c, char* smem) {
  float2* X = (float2*)smem;
  float* aux = (float*)(smem + AUX_OFF);
  float* red = aux + 128;
  const int tid = tid_l();
  const float2* tw = (const float2*)(p.ws + WS_TW);
  float2 twr[6];
  fft_load_tw(tw, tid, twr);
  const float* w3 = pin(p, 20) + (size_t)l * 64 * 1024;
  if (tid < 64) { aux[tid] = w3[tid * 1024 + c]; aux[64 + tid] = w3[tid * 1024 + 512 + c]; }
  __syncthreads();
  const float dF = fabsf(pin(p, 21)[(l * 2 + 0) * 512 + c]), dB = fabsf(pin(p, 21)[(l * 2 + 1) * 512 + c]);
  const float bias = pin(p, 22)[l * 512 + c];
  float2* zp = (float2*)(p.ws + WS_ZV) + (size_t)c * SP;
  float l1 = 0.f;
  {
    const u16* ff = (const u16*)((const char*)p.out + WO_FILT) + (size_t)c * 8192 + tid;
    const u16* fb = ff + (size_t)512 * 8192;
    u16 rf[16], rb[16];
#pragma unroll
    for (int i = 0; i < 16; ++i) { rf[i] = ff[i * NT]; rb[i] = fb[i * NT]; }
#pragma unroll
    for (int i = 0; i < 16; ++i) {
      int t = i * NT + tid;
      float tl = (float)t * (1.f / 8191.f);
      float hf = bf2f(rf[i]) * expf(-tl * dF);
      float hb = bf2f(rb[i]) * expf(-tl * dB);
      X[xi(t)] = make_float2(hf, 0.f);
      if (t >= 1) { X[xi(16384 - t)] = make_float2(hb, 0.f); l1 += fabsf(hf) + fabsf(hb); }
      else { X[xi(8192)] = make_float2(0.f, 0.f); l1 += fabsf(hf); }
    }
  }
  float l1tot = block_sum(l1, red);
  fft_dif(X, tw, twr);
  float2 F[32];
  {
    float s = 1.f / (l1tot * 16384.f);
#pragma unroll
    for (int i = 0; i < 32; ++i) { float2 v = X[xi(i * NT + tid)]; F[i] = make_float2(v.x * s, v.y * s); }
  }
  __syncthreads();
#pragma unroll 8
  for (int i = 0; i < 16; ++i) {
    int t = i * NT + tid;
    X[xi(t)] = zp[CTX + t];
    X[xi(8192 + t)] = make_float2(0.f, 0.f);
  }
  __syncthreads();
  fft_dif(X, tw, twr);
#pragma unroll
  for (int i = 0; i < 32; ++i) { int idx = xi(i * NT + tid); X[idx] = cmul(X[idx], F[i]); }
  __syncthreads();
  fft_dit_inv(X, tw, twr);
  {
    float2 zz[16];
#pragma unroll
    for (int i = 0; i < 16; ++i) zz[i] = zp[CTX + i * NT + tid];
#pragma unroll
    for (int i = 0; i < 16; ++i) {
      int t = i * NT + tid;
      float2 y = X[xi(t)];
      zp[CTX + t] = make_float2(y.x + bias * zz[i].x, y.y + bias * zz[i].y);
    }
  }
  __syncthreads();
  {
    float* hFc = (float*)smem;
    float* hBc = hFc + 256;
    float2* zc = (float2*)(hBc + 256);
    float l1c = 0.f;
    if (tid < 256) {
      int t = tid;
      const float* hc = (const float*)(p.ws + WS_HID2C) + (size_t)l * 64 * 256 + t;
      float hf = 0.f, hb = 0.f;
#pragma unroll 16
      for (int k = 0; k < 64; ++k) { float v = hc[k * 256]; hf += v * aux[k]; hb += v * aux[64 + k]; }
      float tl = (float)t * (1.f / 255.f);
      hf *= expf(-tl * dF);
      hb *= expf(-tl * dB);
      hFc[t] = hf;
      hBc[t] = hb;
      l1c = fabsf(hf) + (t >= 1 ? fabsf(hb) : 0.f);
      zc[t] = zp[t];
    }
    float l1ct = block_sum(l1c, red);
    const int bb = tid >> 8, t = tid & 255;
    float acc = 0.f;
    for (int s = 0; s < 256; ++s) {
      float kf = (s <= t) ? hFc[t - s] : hBc[s - t];
      float2 z = zc[s];
      acc += kf * (bb ? z.y : z.x);
    }
    float2 z = zc[t];
    ((float*)zp)[t * 2 + bb] = acc / l1ct + bias * (bb ? z.y : z.x);
    __syncthreads();
  }
}

constexpr int AT_KT = 128, AT_KP = 208, AT_VP = 264, AT_STAGE = AT_KT * AT_KP + 64 * AT_VP;
__device__ __forceinline__ void attn_task(const Ctx& p, int bh, int qb, char* smem) {
  const int tid = tid_l(), wid = tid >> 6, lane = tid & 63, r = lane & 31, hh = lane >> 5;
  const u16* Qp = (const u16*)(p.ws + WS_Q) + ((size_t)bh * SP + qb * 256) * 96;
  const u16* Kp = (const u16*)(p.ws + WS_K) + (size_t)bh * SP * 96;
  const u16* Vp = (const u16*)(p.ws + WS_VT) + (size_t)bh * 64 * SP;
  const int nkt = (qb == 0) ? 2 : 66;
  bf16x8 qf[6];
#pragma unroll
  for (int ks = 0; ks < 6; ++ks) qf[ks] = *(const bf16x8*)(Qp + (size_t)(wid * 32 + r) * 96 + ks * 16 + hh * 8);
  f32x16 o0, o1;
#pragma unroll
  for (int i = 0; i < 16; ++i) { o0[i] = 0.f; o1[i] = 0.f; }
  float mrun = 0.f, lrun = 0.f;
  const u16* src[5];
  int dst[5];
#pragma unroll
  for (int i = 0; i < 5; ++i) {
    int ch = tid + i * NT;
    if (i < 3) { int row = ch / 12, cc = ch - row * 12; src[i] = Kp + (size_t)row * 96 + cc * 8; dst[i] = row * AT_KP + cc * 16; }
    else { int v = ch - 1536, row = v >> 4, cc = v & 15; src[i] = Vp + (size_t)row * SP + cc * 8; dst[i] = AT_KT * AT_KP + row * AT_VP + cc * 16; }
  }
  uint4 st[5];
#define AT_LOAD(t)                                                                                   \
  do {                                                                                               \
    _Pragma("unroll") for (int i = 0; i < 5; ++i) st[i] = *(const uint4*)(src[i] + (size_t)(t) * (i < 3 ? AT_KT * 96 : AT_KT)); \
  } while (0)
#define AT_WRITE(buf)                                                                                \
  do {                                                                                               \
    char* base_ = smem + (buf) * AT_STAGE;                                                           \
    _Pragma("unroll") for (int i = 0; i < 5; ++i) {                                                  \
      uint2* d_ = (uint2*)(base_ + dst[i]);                                                          \
      d_[0] = make_uint2(st[i].x, st[i].y);                                                          \
      d_[1] = make_uint2(st[i].z, st[i].w);                                                          \
    }                                                                                                \
  } while (0)
#define AT_QK(S, kb)                                                                                 \
  __builtin_amdgcn_s_setprio(1);                                                                     \
  _Pragma("unroll") for (int ks = 0; ks < 6; ++ks) {                                                 \
    bf16x8 a_ = *(const bf16x8*)(Ks + ((kb) * 32 + r) * AT_KP + ks * 32 + hh * 16);                  \
    S = __builtin_amdgcn_mfma_f32_32x32x16_bf16(a_, qf[ks], S, 0, 0, 0);                             \
  }                                                                                                  \
  __builtin_amdgcn_s_setprio(0);
#define AT_SOFT_PV(S, kb)                                                                            \
  _Pragma("unroll") for (int i = 0; i < 16; ++i) { S[i] = __builtin_amdgcn_exp2f(S[i]); ps += S[i]; pmx = fmaxf(pmx, S[i]); } \
  _Pragma("unroll") for (int sI = 0; sI < 2; ++sI) {                                                 \
    union { bf16x8 v; unsigned u[4]; } pu;                                                           \
    _Pragma("unroll") for (int j = 0; j < 4; ++j) pu.u[j] = pk2(S[8 * sI + 2 * j], S[8 * sI + 2 * j + 1]); \
    const int koff = ((kb) * 32 + 16 * sI + 4 * hh) * 2;                                             \
    union { bf16x8 v; uint2 h2[2]; } va, vb;                                                         \
    va.h2[0] = *(const uint2*)(Vs + r * AT_VP + koff);                                               \
    va.h2[1] = *(const uint2*)(Vs + r * AT_VP + koff + 16);                                          \
    vb.h2[0] = *(const uint2*)(Vs + (32 + r) * AT_VP + koff);                                        \
    vb.h2[1] = *(const uint2*)(Vs + (32 + r) * AT_VP + koff + 16);                                   \
    o0 = __builtin_amdgcn_mfma_f32_32x32x16_bf16(va.v, pu.v, o0, 0, 0, 0);                           \
    o1 = __builtin_amdgcn_mfma_f32_32x32x16_bf16(vb.v, pu.v, o1, 0, 0, 0);                           \
  }
  AT_LOAD(0);
  AT_WRITE(0);
  __syncthreads();
  for (int t = 0; t < nkt; ++t) {
    const int cur = t & 1;
    if (t + 1 < nkt) AT_LOAD(t + 1);
    const char* Ks = smem + cur * AT_STAGE;
    const char* Vs = Ks + AT_KT * AT_KP;
    const float nm = -mrun;
    f32x16 sA, sB;
    float ps = 0.f, pmx = 0.f;
#pragma unroll
    for (int i = 0; i < 16; ++i) sA[i] = nm;
    AT_QK(sA, 0)
#pragma unroll
    for (int i = 0; i < 16; ++i) sB[i] = nm;
    AT_QK(sB, 1)
    AT_SOFT_PV(sA, 0)
#pragma unroll
    for (int i = 0; i < 16; ++i) sA[i] = nm;
    AT_QK(sA, 2)
    AT_SOFT_PV(sB, 1)
#pragma unroll
    for (int i = 0; i < 16; ++i) sB[i] = nm;
    AT_QK(sB, 3)
    AT_SOFT_PV(sA, 2)
    AT_SOFT_PV(sB, 3)
    lrun += ps;
    pmx = fmaxf(pmx, shx(pmx, 32));
    if (__any(pmx > 256.f)) {
      const float delta = pmx > 256.f ? ceilf(__log2f(pmx)) : 0.f;
      const float alpha = __builtin_amdgcn_exp2f(-delta);
      mrun += delta;
      lrun *= alpha;
#pragma unroll
      for (int i = 0; i < 16; ++i) { o0[i] *= alpha; o1[i] *= alpha; }
    }
    if (t + 1 < nkt) AT_WRITE(cur ^ 1);
    __syncthreads();
  }
  const float ltot = lrun + shx(lrun, 32);
  const float inv = 1.f / ltot;
  const int b = bh >> 3, head = bh & 7;
  u16* Op = (u16*)(p.ws + WS_O) + ((size_t)b * SP + qb * 256 + wid * 32 + r) * 512 + head * 64;
#pragma unroll
  for (int g = 0; g < 4; ++g) {
    uint2 w0, w1;
    w0.x = pk2(o0[4 * g] * inv, o0[4 * g + 1] * inv);
    w0.y = pk2(o0[4 * g + 2] * inv, o0[4 * g + 3] * inv);
    w1.x = pk2(o1[4 * g] * inv, o1[4 * g + 1] * inv);
    w1.y = pk2(o1[4 * g + 2] * inv, o1[4 * g + 3] * inv);
    *(uint2*)(Op + 8 * g + 4 * hh) = w0;
    *(uint2*)(Op + 32 + 8 * g + 4 * hh) = w1;
  }
#undef AT_LOAD
#undef AT_WRITE
#undef AT_QK
#undef AT_SOFT_PV
}

__device__ __forceinline__ void hypost_task(const Ctx& p, int task, char* smem) {
  const int tid = tid_l(), lane = tid & 63, wid = tid >> 6;
  const int tile64 = task >> 1, ch0 = (task & 1) * 256;
  const int m0 = tile64 * 64, b = m0 / SP, pos0 = m0 - b * SP;
  float* T = (float*)smem;
  const float* ZV = (const float*)(p.ws + WS_ZV);
#pragma unroll 8
  for (int cc = 0; cc < 32; ++cc) {
    int c = wid * 32 + cc;
    T[c * 65 + lane] = ZV[((size_t)(ch0 + c) * SP + pos0 + lane) * 2 + b];
  }
  __syncthreads();
  u16* Y = (u16*)(p.ws + WS_Y);
  const int c = tid & 255, th = tid >> 8;
  u16* yp = Y + (size_t)(m0 + th * 32) * 512 + ch0 + c;
  u16 yv[32];
#pragma unroll
  for (int i = 0; i < 32; ++i) yv[i] = yp[(size_t)i * 512];
#pragma unroll
  for (int i = 0; i < 32; ++i) yp[(size_t)i * 512] = f2bf(bf2f(yv[i]) * T[c * 65 + th * 32 + i]);
  __syncthreads();
}

#ifndef PHMASK
#define PHMASK 0xFFFF
#endif
#define PHON(k) (((PHMASK) >> (k)) & 1)
constexpr int NPH = 1 + 4 * 10 + 1;
__global__ void __launch_bounds__(NT, 2) mega(Params prm) {
  __shared__ __attribute__((aligned(1024))) char smem[LDS_BYTES];
  cg::grid_group grid = cg::this_grid();
  const int bid = blockIdx.x, nb = gridDim.x;
  {
    unsigned long long* it = (unsigned long long*)(smem + AUX_OFF + 6144);
    if (threadIdx.x < 33) it[threadIdx.x] = (unsigned long long)prm.in[threadIdx.x];
    if (threadIdx.x == 0) *(uint4*)(smem + AUX_OFF + 7168) = make_uint4(0u, 0u, 0u, 0u);
    __syncthreads();
  }
  XcdBarrier xbar = xcd_barrier_post((unsigned*)(prm.ws + WS_BAR), (volatile LAS unsigned*)(smem + AUX_OFF + 7168));
  if (prm.ph_lo == 0) {
    Ctx p;
    p.intab = (const unsigned long long*)(smem + AUX_OFF + 6144);
    p.ws = prm.ws;
    p.out = prm.out;
    const int bid = blockIdx.x, nb = gridDim.x;
      if (PHON(10)) {
      p0_misc(p);
      for (int t = bid; t < 192; t += nb) p0_mod_task(p, t, smem);
      for (int t = bid; t < 528; t += nb) p0_hid_task(p, t, smem);
      for (int t = bid; t < 128; t += nb) { const int w = (t + 64) & 127; wpe_task(p, w >> 5, w & 31, smem); }
      }
  }
  unsigned nbar = 0;
  for (int ph = prm.ph_lo; ph < prm.ph_hi; ++ph) {
    Ctx p;
    p.intab = (const unsigned long long*)(smem + AUX_OFF + 6144);
    p.ws = prm.ws;
    p.out = prm.out;
    asm volatile("" : "+s"(p.ws), "+s"(p.out));
    float* modall = (float*)(p.ws + WS_MOD);
    u16* proj = (u16*)(p.ws + WS_PROJ);
    u16* xn = (u16*)(p.ws + WS_U);
    char* wo = (char*)p.out;
    if (ph == 0) {
    } else if (ph == NPH - 1) {
      if (PHON(11)) final_norm(p);
    } else {
      const int l = (ph - 1) / 10, sp = (ph - 1) % 10;
      const float* modl = modall + (size_t)l * 3 * 6144;
      GD* tab = (GD*)(smem + AUX_OFF + 4096);
      int ng = 0, nN0 = 0, nN1 = 0, nsplit = 1;
      const bool last = (l == 3);
      const float* gate = modl;
      if (sp == 0 && PHON(0)) {
        wt_phase(p, l, smem);
        norm_rows(p, pin(p, 6) + l * 1024, modl, 0, 1, xn);
      } else if (sp == 1 && PHON(1)) {
        if (threadIdx.x == 0) tab[0] = GD{xn, 1024, (const u16*)(wo + WO_IN), 1024, 1024, 23, EM_PROJ, 1};
        ng = 1; nN0 = 23;
      } else if (sp == 2 && PHON(2)) {
        for (int t = bid; t < 264 * 6; t += nb) premix_task(p, l, t, smem);
        {
          Epi ef{EM_FILT, p.ws, gate, nullptr, (u16*)(wo + WO_FILT)};
          const u16* hA = (const u16*)(p.ws + WS_HID2) + (size_t)l * 8192 * 64;
          const u16* wB = (const u16*)(p.ws + WS_W3T) + (size_t)l * 1024 * 64;
#pragma unroll 1
          for (int t = nb - 1 - bid; t < 128; t += nb) gemm_tile(hA, 64, wB, 64, 64, (t >> 2) * 256, (t & 3) * 256, smem, ef);
        }
      } else if (sp == 3 && PHON(3)) {
        for (int t = bid; t < 512; t += nb) fft_task(p, l, t, smem);
        if (threadIdx.x == 0) {
          tab[0] = GD{proj + OFF_Q, DINP, (const u16*)(wo + WO_UQ), 384, 384, 3, EM_Q, 1};
          tab[1] = GD{proj + OFF_KV, DINP, (const u16*)(wo + WO_UKV), 256, 256, 4, EM_KV, 1};
        }
        ng = 2; nN0 = 3; nN1 = 4;
        for (int i = tid_l(); i < 1024; i += NT) ((float2*)(smem + 131072))[i] = ((const float2*)(p.ws + WS_ROPE))[i];
      } else if (sp == 4 && PHON(4)) {
        for (int t = bid; t < (last ? 512 : 528); t += nb) {
          int bh, qb;
          if (t < 512) { int rnd = t >> 8, w = t & 255; bh = (w & 7) + 8 * rnd; qb = 1 + (w >> 3); }
          else { bh = t - 512; qb = 0; }
          attn_task(p, bh, qb, smem);
        }
        for (int t = bid; t < 528; t += nb) hypost_task(p, t, smem);
      } else if (sp == 5 && PHON(5)) {
        for (int t = bid; t < 8 * 68; t += nb) {
          const int x = t & 7, g = t >> 3, pm = (g >> 2) * 8 + x;
          if (pm < 132 && !(last && (pm % 66) < 2)) mix_tile(p, l, pm, g & 3, smem);
        }
      } else if (sp == 6 && PHON(6)) {
        if (threadIdx.x == 0) tab[0] = GD{(const u16*)(p.ws + WS_ZV), 1024, (const u16*)(wo + WO_OUT), 1024, 1024, 4, EM_RESID, 4};
        ng = 1; nN0 = 4; nsplit = 4;
        gate = modl + 2 * 1024;
      } else if (sp == 7 && PHON(7)) {
        norm_rows(p, pin(p, 7) + l * 1024, modl, 3, 4, xn);
      } else if (sp == 8 && PHON(8)) {
        if (threadIdx.x == 0) tab[0] = GD{xn, 1024, (const u16*)(wo + WO_FF1), 1024, 1024, 16, EM_SQRELU, last ? 2 : 1};
        ng = 1; nN0 = 16; nsplit = last ? 2 : 1;
      } else if (sp == 9 && PHON(9)) {
        if (threadIdx.x == 0) tab[0] = GD{proj, DFF, (const u16*)(wo + WO_FF2), 4096, 4096, 4, EM_RESID, 8};
        ng = 1; nN0 = 4; nsplit = 8;
        gate = modl + 5 * 1024;
      }
      if (ng > 0) {
        __syncthreads();
        const int nt0 = (nsplit > 1) ? (64 * nN0 + (last ? 0 : 2 * nN0 * nsplit)) : NMT * nN0, ntot = nt0 + NMT * nN1;
#pragma unroll 1
        for (int t = bid; t < ntot; t += nb) {
          int gi = 0, tt = t;
          if (t >= nt0) { gi = 1; tt = t - nt0; }
          const volatile GD* gp = tab + gi;
          unsigned long long a64 = (unsigned long long)gp->A, b64 = (unsigned long long)gp->Bt;
          a64 = ((unsigned long long)(unsigned)__builtin_amdgcn_readfirstlane((unsigned)(a64 >> 32)) << 32) | (unsigned long long)(unsigned)__builtin_amdgcn_readfirstlane((unsigned)a64);
          b64 = ((unsigned long long)(unsigned)__builtin_amdgcn_readfirstlane((unsigned)(b64 >> 32)) << 32) | (unsigned long long)(unsigned)__builtin_amdgcn_readfirstlane((unsigned)b64);
          const int lda = __builtin_amdgcn_readfirstlane(gp->lda), ldb = __builtin_amdgcn_readfirstlane(gp->ldb);
          const int K = __builtin_amdgcn_readfirstlane(gp->K), nN = __builtin_amdgcn_readfirstlane(gp->nN);
          const int ks = __builtin_amdgcn_readfirstlane(gp->ks);
          const int mode = __builtin_amdgcn_readfirstlane(gp->mode);
          int pm, pn, Kuse = K, emode = mode;
          if (ks > 1) {
            const int nlat = 64 * nN;
            if (tt < nlat) { int pm64; tile_map(tt, 64, nN, pm64, pn); pm = (pm64 >> 5) * 33 + 1 + (pm64 & 31); }
            else {
              int u = tt - nlat, kp = u % ks, tile = u / ks;
              pm = (tile / nN) * 33; pn = tile % nN;
              Kuse = K / ks; emode = EM_RESID_AT;
              a64 += (unsigned long long)kp * Kuse * 2; b64 += (unsigned long long)kp * Kuse * 2;
            }
          } else tile_map(tt, NMT, nN, pm, pn);
          Epi e{emode, p.ws, gate, (const float2*)(smem + 131072), nullptr};
          gemm_tile((const u16*)a64, lda, (const u16*)b64, ldb, Kuse, pm * 256, pn * 256, smem, e);
        }
      }
    }
    if (ph + 1 < prm.ph_hi) {
      if (ph == prm.ph_lo) grid.sync();
      else xcd_barrier(xbar);
    }
  }
}

extern "C" void kernel_launch(void* const* d_in, const int* in_sizes, int n_in, void* d_out, int out_size, void* d_ws,
                              size_t ws_size, hipStream_t stream) {
  static int grid_blocks = 0;
  if (grid_blocks == 0) {
    if (n_in != 33 || ws_size < WS_END || (size_t)out_size * 4 < WO_END) {
      fprintf(stderr, "kernel_launch: unexpected sizes n_in=%d ws=%zu (need %zu) out=%d\n", n_in, ws_size, (size_t)WS_END, out_size);
      grid_blocks = -1;
      return;
    }
    int dev = 0, cus = 0, per_cu = 0;
    hipGetDevice(&dev);
    hipDeviceGetAttribute(&cus, hipDeviceAttributeMultiprocessorCount, dev);
    hipOccupancyMaxActiveBlocksPerMultiprocessor(&per_cu, mega, NT, 0);
    if (per_cu < 1) per_cu = 1;
    if (per_cu > 1) per_cu = 1;
    grid_blocks = cus * per_cu;
  }
  if (grid_blocks < 0) return;
  Params p{};
  for (int i = 0; i < 33; ++i) p.in[i] = (const float*)d_in[i];
  p.out = (float*)d_out;
  p.ws = (char*)d_ws;
  p.ph_lo = 0;
  p.ph_hi = NPH;
  (void)hipMemsetAsync((char*)d_ws + WS_BAR, 0, 16384, stream);
  void* args[] = {&p};
  hipError_t e = hipLaunchCooperativeKernel((void*)mega, dim3(grid_blocks), dim3(NT), args, 0, stream);
  if (e != hipSuccess) fprintf(stderr, "cooperative launch failed: %s (grid %d)\n", hipGetErrorString(e), grid_blocks);
}
```

```cpp
#include <hip/hip_runtime.h>
#include <hip/hip_cooperative_groups.h>
#include <cstdio>
namespace cg = cooperative_groups;

typedef unsigned short u16;
using bf16x8 = __attribute__((ext_vector_type(8))) short;
using f32x4 = __attribute__((ext_vector_type(4))) float;
using f32x16 = __attribute__((ext_vector_type(16))) float;

constexpr int D = 1024, SEQ = 8192, CTX = 256, SP = 8448, MROWS = 16896, NMT = 66;
constexpr int DIN = 5792, DINP = 5888, DFF = 4096;
constexpr int OFF_HY = 512, OFF_Q = 2048, OFF_KV = 2432, OFF_GATE = 2720;
constexpr int NT = 512;
constexpr float EPS = 1e-6f;

constexpr size_t WS_H = 0;
constexpr size_t WS_PROJ = WS_H + (size_t)MROWS * D * 4;
constexpr size_t WS_U = WS_PROJ + (size_t)MROWS * DINP * 2;
constexpr size_t WS_Y = WS_U + (size_t)MROWS * 512 * 2;
constexpr size_t WS_O = WS_Y + (size_t)MROWS * 512 * 2;
constexpr size_t WS_Q = WS_O + (size_t)MROWS * 512 * 2;
constexpr size_t WS_K = WS_Q + (size_t)16 * SP * 96 * 2;
constexpr size_t WS_VT = WS_K + (size_t)16 * SP * 96 * 2;
constexpr size_t WS_ZV = WS_VT + (size_t)16 * 64 * SP * 2;
constexpr size_t WS_HID2 = WS_ZV + (size_t)512 * SP * 8;
constexpr size_t WS_HID2C = WS_HID2 + (size_t)4 * 8192 * 64 * 4;
constexpr size_t WS_MOD = WS_HID2C + (size_t)4 * 256 * 64 * 4;
constexpr size_t WS_ROPE = WS_MOD + (size_t)4 * 3 * 6144 * 4;
constexpr size_t WS_TW = WS_ROPE + (size_t)128 * 8 * 8;
constexpr size_t WS_WPE = WS_TW + (size_t)16384 * 8;
constexpr size_t WS_BAR = WS_WPE + (size_t)4 * 1024 * 512 * 2;
constexpr size_t WS_END = WS_BAR + 16384;
constexpr size_t WO_IN = 0;
constexpr size_t WO_FF1 = WO_IN + (size_t)DINP * 1024 * 2;
constexpr size_t WO_FF2 = WO_FF1 + (size_t)4096 * 1024 * 2;
constexpr size_t WO_OUT = WO_FF2 + (size_t)4096 * 1024 * 2;
constexpr size_t WO_HY = WO_OUT + (size_t)1024 * 1024 * 2;
constexpr size_t WO_WO = WO_HY + (size_t)1024 * 512 * 2;
constexpr size_t WO_PE = WO_WO + (size_t)1024 * 512 * 2;
constexpr size_t WO_UQ = WO_PE + (size_t)1024 * 512 * 2;
constexpr size_t WO_UKV = WO_UQ + (size_t)768 * 384 * 2;
constexpr size_t WO_FILT = WO_UKV + (size_t)1024 * 256 * 2;
constexpr size_t WO_END = WO_FILT + (size_t)1024 * 8192 * 2;
constexpr size_t WS_W3T = WS_HID2 + (size_t)4 * 8192 * 64 * 2;

constexpr int AUX_OFF = 147456;
constexpr int LDS_BYTES = AUX_OFF + 8192;

struct Params {
  const float* in[33];
  float* out;
  char* ws;
  int ph_lo, ph_hi;
};

struct Ctx { const unsigned long long* intab; char* ws; float* out; };
__device__ __forceinline__ const float* pin(const Ctx& c, int i) {
  unsigned long long v = c.intab[i];
  unsigned lo = __builtin_amdgcn_readfirstlane((unsigned)v), hi = __builtin_amdgcn_readfirstlane((unsigned)(v >> 32));
  return (const float*)(((unsigned long long)hi << 32) | lo);
}

typedef __bf16 hwbf2 __attribute__((ext_vector_type(2)));
typedef float hwf2 __attribute__((ext_vector_type(2)));
__device__ __forceinline__ unsigned pk2(float a, float b) {
  hwf2 v = {a, b};
  hwbf2 r = __builtin_convertvector(v, hwbf2);
  return __builtin_bit_cast(unsigned, r);
}
__device__ __forceinline__ u16 f2bf(float f) { return (u16)(pk2(f, 0.f) & 0xffffu); }
__device__ __forceinline__ float bf2f(u16 b) { return __uint_as_float(((unsigned)b) << 16); }
__device__ __forceinline__ float shx(float v, int o) {
  int l = __builtin_amdgcn_mbcnt_hi(~0u, __builtin_amdgcn_mbcnt_lo(~0u, 0u));
  asm volatile("" : "+v"(l));
  return __int_as_float(__builtin_amdgcn_ds_bpermute((l ^ o) << 2, __float_as_int(v)));
}
__device__ __forceinline__ float wave_sum(float v) {
#pragma unroll
  for (int o = 1; o < 64; o <<= 1) v += shx(v, o);
  return v;
}
__device__ __forceinline__ int grp_of_row(int m) {
  int tile = m >> 8, b = tile / 33, t33 = tile - b * 33;
  return t33 == 0 ? 2 : b;
}
__device__ __forceinline__ float2 cmul(float2 a, float2 b) { return make_float2(a.x * b.x - a.y * b.y, a.x * b.y + a.y * b.x); }

__device__ __forceinline__ int tid_l() { int t = threadIdx.x; asm volatile("" : "+v"(t)); return t; }
#define XB_TMO      128
#define XB_XCNT(j)  (256  + 64 * (j))
#define XB_XSUB(j)  (1280 + 64 * (j))
#define XB_XGEN(j)  (2304 + 64 * (j))
#define XB_TOP      3328
#define XB_TOPGEN   3392
#define XCD_BAR_WORDS 3456
#define XB_SPIN_CAP (1u << 18)
#define LAS __attribute__((address_space(3)))
__device__ __forceinline__ unsigned xb_ld(unsigned* p)              { return __hip_atomic_load(p, __ATOMIC_RELAXED, __HIP_MEMORY_SCOPE_AGENT); }
__device__ __forceinline__ unsigned xb_add(unsigned* p, unsigned v) { return __hip_atomic_fetch_add(p, v, __ATOMIC_RELAXED, __HIP_MEMORY_SCOPE_AGENT); }
__device__ __forceinline__ unsigned xb_xcc_id() { return (unsigned)__builtin_amdgcn_s_getreg((3 << 11) | 20) & 0xFu; }
#define XB_SPIN(cond, bar) do { unsigned _sp = 0; while (cond) { __builtin_amdgcn_s_sleep(1); \
    if ((++_sp & 255u) == 0u) { if (xb_ld(&(bar)[XB_TMO])) break; if (_sp > XB_SPIN_CAP) { atomicAdd(&(bar)[XB_TMO], 1u); break; } } } } while (0)
struct XcdBarrier { unsigned* bar; unsigned x; volatile LAS unsigned* st; };
__device__ __forceinline__ XcdBarrier xcd_barrier_post(unsigned* bar, volatile LAS unsigned* st) {
    XcdBarrier b; b.bar = bar; b.x = xb_xcc_id(); b.st = st;
    if (threadIdx.x == 0) (void)xb_add(&bar[XB_XCNT(b.x)], 1u);
    return b;
}
__device__ __forceinline__ void xcd_barrier_complete(unsigned* bar, unsigned x, unsigned& nloc, unsigned& nx) {
    const unsigned G = gridDim.x * gridDim.y * gridDim.z;
    unsigned sum, cnt, mine, sp = 0u;
    for (;;) {
        sum = 0u; cnt = 0u; mine = 0u;
#pragma unroll
        for (unsigned j = 0; j < 16; ++j) { const unsigned c = xb_ld(&bar[XB_XCNT(j)]); sum += c; cnt += (c > 0u) ? 1u : 0u; mine = (j == x) ? c : mine; }
        if (sum == G) break;
        __builtin_amdgcn_s_sleep(1);
        if ((++sp & 255u) == 0u) { if (xb_ld(&bar[XB_TMO])) break; if (sp > XB_SPIN_CAP) { atomicAdd(&bar[XB_TMO], 1u); break; } }
    }
    nloc = mine > 0u ? mine : 1u; nx = cnt > 0u ? cnt : 1u;
}
__device__ __forceinline__ void xcd_barrier(const XcdBarrier& b) {
    asm volatile("s_waitcnt vmcnt(0)" ::: "memory");
    __syncthreads();
    if (threadIdx.x == 0) {
        unsigned* bar = b.bar;
        __builtin_amdgcn_s_waitcnt(0);
        unsigned nloc = b.st[0], nx = b.st[1];
        if (nloc == 0u) { xcd_barrier_complete(bar, b.x, nloc, nx); b.st[0] = nloc; b.st[1] = nx; }
        const unsigned old = xb_add(&bar[XB_XSUB(b.x)], 1u);
        const unsigned gen = old / nloc;
        if (old + 1u == (gen + 1u) * nloc) {
            __builtin_amdgcn_fence(__ATOMIC_RELEASE, "agent");
            asm volatile("s_waitcnt vmcnt(0)" ::: "memory");
            const unsigned og = xb_add(&bar[XB_TOP], 1u);
            const unsigned tg = og / nx;
            if (og + 1u == (tg + 1u) * nx) xb_add(&bar[XB_TOPGEN], 1u);
            else XB_SPIN(xb_ld(&bar[XB_TOPGEN]) == tg, bar);
            __builtin_amdgcn_fence(__ATOMIC_ACQUIRE, "agent");
            xb_add(&bar[XB_XGEN(b.x)], 1u);
            asm volatile("s_waitcnt vmcnt(0)" ::: "memory");
        } else {
            XB_SPIN(xb_ld(&bar[XB_XGEN(b.x)]) == gen, bar);
            __builtin_amdgcn_fence(__ATOMIC_ACQUIRE, "agent");
            asm volatile("s_waitcnt vmcnt(0)" ::: "memory");
        }
    }
    __syncthreads();
}

__device__ __forceinline__ void grid_barrier(unsigned* bar, unsigned target) {
  asm volatile("s_waitcnt vmcnt(0)" ::: "memory");
  __syncthreads();
  if (threadIdx.x == 0) {
    __builtin_amdgcn_fence(__ATOMIC_RELEASE, "agent");
    asm volatile("s_waitcnt vmcnt(0)" ::: "memory");
    __hip_atomic_fetch_add(bar, 1u, __ATOMIC_RELAXED, __HIP_MEMORY_SCOPE_AGENT);
    while (__hip_atomic_load(bar, __ATOMIC_RELAXED, __HIP_MEMORY_SCOPE_AGENT) < target) __builtin_amdgcn_s_sleep(2);
    __builtin_amdgcn_fence(__ATOMIC_ACQUIRE, "agent");
    asm volatile("s_waitcnt vmcnt(0)" ::: "memory");
  }
  __syncthreads();
}
#define WAIT_V(n) asm volatile("s_waitcnt vmcnt(%0)" ::"n"(n) : "memory")
#define SCHED() __builtin_amdgcn_sched_barrier(0)
#define RAW_BARRIER() do { asm volatile("s_waitcnt lgkmcnt(0)" ::: "memory"); __builtin_amdgcn_s_barrier(); } while (0)

constexpr float QSCALE = 0.10206207261596575f * 1.4426950408889634f;
enum { EM_PROJ = 0, EM_SQRELU = 1, EM_RESID = 2, EM_RESID_AT = 3, EM_FILT = 4, EM_Q = 6, EM_KV = 7 };
struct Epi {
  int mode;
  char* ws;
  const float* gate;
  const float2* rope_lds;
  u16* filt_out;
  __device__ __forceinline__ void proj(int row, int col, f32x4 v) const {
    {
      u16* out = (u16*)(ws + WS_PROJ);
#pragma unroll
      for (int j = 0; j < 4; ++j) out[(size_t)(row + j) * DINP + col] = f2bf(v[j]);
    }
  }
  __device__ __forceinline__ void sqrelu(int row, int col, f32x4 v) const {
    {
      u16* out = (u16*)(ws + WS_PROJ);
#pragma unroll
      for (int j = 0; j < 4; ++j) { float r = fmaxf(v[j], 0.f); out[(size_t)(row + j) * DFF + col] = f2bf(r * r); }
    }
  }
  __device__ __forceinline__ void resid(int row, int col, f32x4 v) const {
    {
      float* h = (float*)(ws + WS_H);
      float g = gate[grp_of_row(row) * 6144 + col];
#pragma unroll
      for (int j = 0; j < 4; ++j) unsafeAtomicAdd(h + (size_t)(row + j) * D + col, g * v[j]);
    }
  }
  __device__ __forceinline__ void filt(int row, int col, f32x4 v) const {
    uint2 o;
    o.x = pk2(v[0], v[1]);
    o.y = pk2(v[2], v[3]);
    *(uint2*)(filt_out + (size_t)col * 8192 + row) = o;
  }
  __device__ __forceinline__ void q(int row, int col, f32x4 v) const {
    {
      u16* Q = (u16*)(ws + WS_Q);
      const float2* rope = rope_lds;
      int head = col / 96, d = col - head * 96;
      int b = row / SP, pos0 = row - b * SP;
      bool isrope = (d >= 64) && (pos0 >= CTX);
      int rd = d - 64;
#pragma unroll
      for (int j = 0; j < 4; ++j) {
        float val = v[j];
        float partner = shx(val, 8);
        int pos = pos0 + j;
        if (isrope) {
          int t = pos - CTX, idx = (rd < 16) ? (t >> 6) : (t & 63);
          float2 cs = rope[idx * 8 + (rd & 7)];
          float sgn = (rd & 8) ? 1.f : -1.f;
          val = val * cs.x + sgn * partner * cs.y;
        }
        Q[((size_t)(b * 8 + head) * SP + pos) * 96 + d] = f2bf(val * QSCALE);
      }
    }
  }
  __device__ __forceinline__ void kv(int row, int col, f32x4 v) const {
    {
      u16* Kb = (u16*)(ws + WS_K);
      u16* Vt = (u16*)(ws + WS_VT);
      int head = col >> 7, j2 = col & 127;
      int b = row / SP, pos0 = row - b * SP;
      if (j2 < 64) {
#pragma unroll
        for (int j = 0; j < 4; ++j) Kb[((size_t)(b * 8 + head) * SP + pos0 + j) * 96 + j2] = f2bf(v[j]);
      } else {
        uint2 o;
        o.x = pk2(v[0], v[1]);
        o.y = pk2(v[2], v[3]);
        *(uint2*)(Vt + ((size_t)(b * 8 + head) * 64 + (j2 - 64)) * SP + pos0) = o;
      }
    }
  }
};
struct GD { const u16* A; int lda; const u16* Bt; int ldb; int K; int nN; int mode; int ks; };

constexpr int G_TILE_B = 256 * 64 * 2, G_STAGE_B = 2 * G_TILE_B;
__device__ __forceinline__ int lds_byte(int r, int c) {
  int st = (r >> 4) * 2 + (c >> 5), ob = (r & 15) * 64 + (c & 31) * 2;
  return st * 1024 + (ob ^ (((ob >> 9) & 1) << 5));
}
__device__ __forceinline__ void stage_rc(int b, int& R, int& C) {
  int st = b >> 10, sb = b & 1023, swz = sb ^ (((sb >> 9) & 1) << 5);
  R = (st / 2) * 16 + swz / 64;
  C = (st % 2) * 32 + (swz % 64) / 2;
}

template <int MI>
__device__ __forceinline__ void gemm_core(const u16* __restrict__ A, int lda, const u16* __restrict__ Bt, int ldb, int K,
                                          int brow, int bcol, char* shm, f32x4 (&acc)[MI][4]) {
  constexpr int TILE_A = MI * 32 * 64 * 2, TILE_BB = 256 * 64 * 2, STAGE = TILE_A + TILE_BB;
  const int tid = tid_l(), wid = tid >> 6, lane = tid & 63, wr = wid >> 2, wc = wid & 3, fr = lane & 15, fq = lane >> 4;
  const u16* Ab = A + (size_t)brow * lda;
  const u16* Bb = Bt + (size_t)bcol * ldb;
  int sR[4], sC[4];
#pragma unroll
  for (int i = 0; i < 4; ++i) stage_rc(wid * 1024 + i * 8192 + lane * 16, sR[i], sC[i]);
#define SA(b) (shm + (b) * STAGE)
#define SB(b) (shm + (b) * STAGE + TILE_A)
#define GLDS_STAGE(buf, kt)                                                                                              \
  do {                                                                                                                   \
    _Pragma("unroll") for (int i = 0; i < 4; ++i) {                                                                      \
      if (i < MI / 2)                                                                                                    \
        __builtin_amdgcn_global_load_lds((const unsigned*)(Ab + (size_t)sR[i] * lda + (kt) * 64 + sC[i]),                \
                                         (unsigned*)(SA(buf) + wid * 1024 + i * 8192), 16, 0, 0);                        \
      __builtin_amdgcn_global_load_lds((const unsigned*)(Bb + (size_t)sR[i] * ldb + (kt) * 64 + sC[i]),                  \
                                       (unsigned*)(SB(buf) + wid * 1024 + i * 8192), 16, 0, 0);                          \
    }                                                                                                                    \
  } while (0)
  const int nt = K / 64;
  GLDS_STAGE(0, 0);
  WAIT_V(0);
  __syncthreads();
  for (int t = 0; t < nt; ++t) {
    const int cur = t & 1;
    if (t + 1 < nt) GLDS_STAGE(cur ^ 1, t + 1);
#pragma unroll
    for (int ks = 0; ks < 2; ++ks) {
      bf16x8 At[MI], Bf[4];
#pragma unroll
      for (int m = 0; m < MI; ++m) At[m] = *(const bf16x8*)(SA(cur) + lds_byte(wr * (MI * 16) + m * 16 + fr, ks * 32 + fq * 8));
#pragma unroll
      for (int n = 0; n < 4; ++n) Bf[n] = *(const bf16x8*)(SB(cur) + lds_byte(wc * 64 + n * 16 + fr, ks * 32 + fq * 8));
#pragma unroll
      for (int m = 0; m < MI; ++m)
#pragma unroll
        for (int n = 0; n < 4; ++n) acc[m][n] = __builtin_amdgcn_mfma_f32_16x16x32_bf16(At[m], Bf[n], acc[m][n], 0, 0, 0);
      SCHED();
    }
    WAIT_V(0);
    __syncthreads();
  }
#undef SA
#undef SB
#undef GLDS_STAGE
}

template <class EpiT>
__device__ __forceinline__ void gemm_tile(const u16* __restrict__ A, int lda, const u16* __restrict__ Bt, int ldb, int K,
                                          int brow, int bcol, char* shm, const EpiT& epi) {
  const int tid = tid_l(), wid = tid >> 6, lane = tid & 63, wr = wid >> 2, wc = wid & 3, fr = lane & 15, fq = lane >> 4;
  f32x4 acc[8][4];
#pragma unroll
  for (int m = 0; m < 8; ++m)
#pragma unroll
    for (int n = 0; n < 4; ++n) acc[m][n] = (f32x4){0.f, 0.f, 0.f, 0.f};
  gemm_core<8>(A, lda, Bt, ldb, K, brow, bcol, shm, acc);
#define EPI_LOOP(CALL)                                                                              \
  _Pragma("unroll") for (int m = 0; m < 8; ++m) _Pragma("unroll") for (int n = 0; n < 4; ++n) {      \
    const int row = brow + wr * 128 + m * 16 + fq * 4, col = bcol + wc * 64 + n * 16 + fr;           \
    const f32x4 v = acc[m][n];                                                                        \
    CALL;                                                                                             \
  }
  if (epi.mode == EM_PROJ) { EPI_LOOP(epi.proj(row, col, v)) }
  else if (epi.mode == EM_SQRELU) { EPI_LOOP(epi.sqrelu(row, col, v)) }
  else if (epi.mode == EM_RESID_AT) { EPI_LOOP(epi.resid(row, col, v)) }
  else if (epi.mode == EM_RESID) {
    float* h = (float*)(epi.ws + WS_H);
    float g4[4];
#pragma unroll
    for (int n = 0; n < 4; ++n) g4[n] = epi.gate[grp_of_row(brow) * 6144 + bcol + wc * 64 + n * 16 + fr];
    float hv[8][4][4];
    float* hp0 = h + (size_t)(brow + wr * 128 + fq * 4) * D + bcol + wc * 64 + fr;
#define H_LOAD(m) _Pragma("unroll") for (int n = 0; n < 4; ++n) _Pragma("unroll") for (int j = 0; j < 4; ++j) hv[m][n][j] = hp0[(size_t)((m) * 16 + j) * D + n * 16]
#define H_STORE(m) _Pragma("unroll") for (int n = 0; n < 4; ++n) _Pragma("unroll") for (int j = 0; j < 4; ++j) hp0[(size_t)((m) * 16 + j) * D + n * 16] = hv[m][n][j] + g4[n] * acc[m][n][j]
    H_LOAD(0); H_LOAD(1);
    SCHED();
    H_STORE(0); H_LOAD(2); SCHED();
    H_STORE(1); H_LOAD(3); SCHED();
    H_STORE(2); H_LOAD(4); SCHED();
    H_STORE(3); H_LOAD(5); SCHED();
    H_STORE(4); H_LOAD(6); SCHED();
    H_STORE(5); H_LOAD(7); SCHED();
    H_STORE(6); H_STORE(7);
#undef H_LOAD
#undef H_STORE
  }
  else if (epi.mode == EM_FILT) { EPI_LOOP(epi.filt(row, col, v)) }
  else if (epi.mode == EM_Q) { EPI_LOOP(epi.q(row, col, v)) }
  else { EPI_LOOP(epi.kv(row, col, v)) }
#undef EPI_LOOP
}

__device__ __forceinline__ void mix_tile(const Ctx& p, int l, int pm, int pn, char* shm) {
  constexpr int TILE_A = 128 * 64 * 2, TILE_BB = 256 * 64 * 2, STAGE = TILE_A + TILE_BB;
  const int tid = tid_l(), wid = tid >> 6, lane = tid & 63, wr = wid >> 2, wc = wid & 3, fr = lane & 15, fq = lane >> 4;
  const int brow = pm * 128, bcol = pn * 256;
  const u16* projb = (const u16*)(p.ws + WS_PROJ);
  char* wo = (char*)p.out;
#define SA(b) (shm + (b) * STAGE)
#define SB(b) (shm + (b) * STAGE + TILE_A)
#define MIX_STAGE(buf, kt)                                                                                               \
  do {                                                                                                                   \
    const int br_ = (kt) >> 3, ko_ = ((kt) & 7) * 64;                                                                    \
    const u16* Ab_ = (const u16*)(p.ws + (br_ == 0 ? WS_U : br_ == 1 ? WS_Y : WS_O)) + (size_t)brow * 512 + ko_;         \
    const u16* Bb_ = (br_ == 0 ? (const u16*)(p.ws + WS_WPE) + (size_t)l * 1024 * 512 : (const u16*)(wo + (br_ == 1 ? WO_HY : WO_WO))) + (size_t)bcol * 512 + ko_;        \
    _Pragma("unroll") for (int i = 0; i < 4; ++i) {                                                                      \
      int sR_, sC_; stage_rc(wid * 1024 + i * 8192 + lane * 16, sR_, sC_);                                              \
      if (i < 2)                                                                                                         \
        __builtin_amdgcn_global_load_lds((const unsigned*)(Ab_ + sR_ * 512 + sC_),                           \
                                         (unsigned*)(SA(buf) + wid * 1024 + i * 8192), 16, 0, 0);                        \
      __builtin_amdgcn_global_load_lds((const unsigned*)(Bb_ + sR_ * 512 + sC_),                             \
                                       (unsigned*)(SB(buf) + wid * 1024 + i * 8192), 16, 0, 0);                          \
    }                                                                                                                    \
  } while (0)
  f32x4 tot[4][4], acc[4][4];
#pragma unroll
  for (int m = 0; m < 4; ++m)
#pragma unroll
    for (int n = 0; n < 4; ++n) { tot[m][n] = (f32x4){0.f, 0.f, 0.f, 0.f}; acc[m][n] = (f32x4){0.f, 0.f, 0.f, 0.f}; }
  MIX_STAGE(0, 0);
  MIX_STAGE(1, 1);
  WAIT_V(6);
  RAW_BARRIER();
  int cur = 0;
#pragma unroll 1
  for (int br = 0; br < 3; ++br) {
    unsigned gpk[4][4][2];
    const u16* gp = projb + (size_t)(brow + wr * 64 + fq * 4) * DINP + OFF_GATE + br * 1024 + bcol + wc * 64 + fr;
#define GATE_LOAD(m)                                                                                   \
    _Pragma("unroll") for (int n = 0; n < 4; ++n) _Pragma("unroll") for (int j2 = 0; j2 < 2; ++j2) {       \
      unsigned lo = gp[(size_t)((m) * 16 + 2 * j2) * DINP + n * 16], hi = gp[(size_t)((m) * 16 + 2 * j2 + 1) * DINP + n * 16]; \
      gpk[m][n][j2] = lo | (hi << 16);                                                                     \
    }
    GATE_LOAD(0); GATE_LOAD(1); GATE_LOAD(2);
#pragma unroll 1
    for (int kk = 0; kk < 8; ++kk) {
      const int t = br * 8 + kk;
      { int nx = cur + 2; if (nx >= 3) nx -= 3; if (t + 2 < 24) MIX_STAGE(nx, t + 2); }
#pragma unroll
      for (int ks = 0; ks < 2; ++ks) {
        bf16x8 At[2], Bf[4];
#pragma unroll
        for (int n = 0; n < 4; ++n) Bf[n] = *(const bf16x8*)(SB(cur) + lds_byte(wc * 64 + n * 16 + fr, ks * 32 + fq * 8));
#pragma unroll
        for (int mh = 0; mh < 2; ++mh) {
#pragma unroll
          for (int m = 0; m < 2; ++m) At[m] = *(const bf16x8*)(SA(cur) + lds_byte(wr * 64 + (mh * 2 + m) * 16 + fr, ks * 32 + fq * 8));
#pragma unroll
          for (int m = 0; m < 2; ++m)
#pragma unroll
            for (int n = 0; n < 4; ++n) acc[mh * 2 + m][n] = __builtin_amdgcn_mfma_f32_16x16x32_bf16(At[m], Bf[n], acc[mh * 2 + m][n], 0, 0, 0);
          SCHED();
        }
      }
      if (t + 2 < 24) WAIT_V(6); else WAIT_V(0);
      RAW_BARRIER();
      cur = (cur == 2) ? 0 : cur + 1;
    }
    GATE_LOAD(3);
#undef GATE_LOAD
#pragma unroll
    for (int m = 0; m < 4; ++m)
#pragma unroll
      for (int n = 0; n < 4; ++n)
#pragma unroll
        for (int j = 0; j < 4; ++j) {
          const unsigned w = gpk[m][n][j >> 1];
          const float gv = __uint_as_float((j & 1) ? (w & 0xffff0000u) : (w << 16));
          tot[m][n][j] += acc[m][n][j] / (1.f + __expf(-gv));
          acc[m][n][j] = 0.f;
        }
  }
  u16* mixb = (u16*)(p.ws + WS_ZV);
#pragma unroll
  for (int m = 0; m < 4; ++m)
#pragma unroll
    for (int n = 0; n < 4; ++n)
#pragma unroll
      for (int j = 0; j < 4; ++j)
        mixb[(size_t)(brow + wr * 64 + m * 16 + fq * 4 + j) * D + bcol + wc * 64 + n * 16 + fr] = f2bf(tot[m][n][j]);
#undef SA
#undef SB
#undef MIX_STAGE
}

__device__ __forceinline__ void tile_map(int t, int nM, int nN, int& pm, int& pn) {
  int nwg = nM * nN, wgid = t;
  {
    int q = nwg / 8, r = nwg % 8, xcd = wgid % 8, off = wgid / 8;
    wgid = (xcd < r ? xcd * (q + 1) : r * (q + 1) + (xcd - r) * q) + off;
  }
  constexpr int WGM = 4;
  int nig = WGM * nN, gid = wgid / nig, fm = gid * WGM, gsz = min(nM - fm, WGM);
  pm = fm + ((wgid % nig) % gsz);
  pn = (wgid % nig) / gsz;
}

__device__ __forceinline__ void p0_misc(const Ctx& p) {
  const int gtid = blockIdx.x * NT + tid_l(), gn = gridDim.x * NT;
  float4* h4 = (float4*)(p.ws + WS_H);
  const float4* x4 = (const float4*)pin(p, 0);
  const float4* c4 = (const float4*)pin(p, 2);
#pragma unroll 8
  for (int i = gtid; i < MROWS * 256; i += gn) {
    int m = i >> 8, q = i & 255, b = m / SP, pos = m - b * SP;
    float4 v = (pos < CTX) ? c4[(size_t)(b * CTX + pos) * 256 + q] : x4[(size_t)(b * SEQ + pos - CTX) * 256 + q];
    h4[i] = v;
  }
  float2* rope = (float2*)(p.ws + WS_ROPE);
  for (int i = gtid; i < 1024; i += gn) {
    int idx = i >> 3, f = i & 7;
    float inv = powf(10000.f, -(float)f / 8.f);
    float a = (float)idx * inv;
    rope[i] = make_float2(cosf(a), sinf(a));
  }
  {
    u16* w3t = (u16*)(p.ws + WS_W3T);
    const float* w3 = pin(p, 20);
    for (int i = gtid; i < 4 * 1024 * 64; i += gn) { int l = i >> 16, c2 = (i >> 6) & 1023, k = i & 63; w3t[i] = f2bf(w3[((size_t)l * 64 + k) * 1024 + c2]); }
  }
  float2* tw = (float2*)(p.ws + WS_TW);
  for (int i = gtid; i < 16384; i += gn) {
    float s, c;
    sincospif(-(float)i / 8192.f, &s, &c);
    tw[i] = make_float2(c, s);
  }
}

__device__ __forceinline__ void p0_mod_task(const Ctx& p, int task, char* smem) {
  float* s = (float*)smem;
  float* red = s + 3072;
  const int tid = tid_l();
  const int l = task / 48, chunk = task - l * 48;
  for (int i = tid; i < 3072; i += NT) {
    int g = i >> 10, k = i & 1023;
    float cv = (g < 2) ? pin(p, 1)[g * 1024 + k] : pin(p, 3)[k];
    s[i] = cv / (1.f + __expf(-cv));
  }
  __syncthreads();
  const int kq = tid >> 7, col = tid & 127, n = chunk * 128 + col;
  const float* W = pin(p, 4) + (size_t)l * 1024 * 6144 + n;
  float a0 = 0.f, a1 = 0.f, a2 = 0.f;
#pragma unroll 32
  for (int k = kq * 256; k < kq * 256 + 256; ++k) {
    float w = W[(size_t)k * 6144];
    a0 += s[k] * w; a1 += s[1024 + k] * w; a2 += s[2048 + k] * w;
  }
  red[(kq * 3 + 0) * 128 + col] = a0;
  red[(kq * 3 + 1) * 128 + col] = a1;
  red[(kq * 3 + 2) * 128 + col] = a2;
  __syncthreads();
  if (tid < 384) {
    int g = tid >> 7, c2 = tid & 127, n2 = chunk * 128 + c2;
    float v = red[(0 * 3 + g) * 128 + c2] + red[(1 * 3 + g) * 128 + c2] + red[(2 * 3 + g) * 128 + c2] + red[(3 * 3 + g) * 128 + c2];
    ((float*)(p.ws + WS_MOD))[(size_t)(l * 3 + g) * 6144 + n2] = v + pin(p, 5)[l * 6144 + n2];
  }
  __syncthreads();
}

__device__ __forceinline__ void p0_hid_task(const Ctx& p, int task, char* smem) {
  float* zs = (float*)smem;
  float* h1 = zs + 8 * 36;
  float* w1s = h1 + 8 * 64;
  float* w2s = w1s + 33 * 64;
  const int tid = tid_l(), tl = tid >> 6, j = tid & 63;
  const int l = task / 132, r = task - l * 132;
  const bool isctx = r >= 128;
  const int L = isctx ? 256 : 8192;
  const int tbase = (isctx ? (r - 128) : r) * 64;
  for (int i = tid; i < 33 * 64; i += NT) w1s[i] = pin(p, 14)[l * 33 * 64 + i];
  for (int i = tid; i < 64 * 64; i += NT) w2s[i] = pin(p, 17)[l * 64 * 64 + i];
  const float b1 = pin(p, 15)[l * 64 + j], f1 = pin(p, 16)[l * 64 + j], b2 = pin(p, 18)[l * 64 + j], f2 = pin(p, 19)[l * 64 + j];
  __syncthreads();
  for (int sub = 0; sub < 8; ++sub) {
    const int t = tbase + sub * 8 + tl;
    if (j < 33) {
      float z;
      if (j == 0) z = (float)t / (float)(L - 1);
      else {
        int i = (j - 1) & 15;
        float band = 1e-4f + (float)i * ((15.f - 1e-4f) / 15.f);
        float omega = 6.2831855f * (float)t / (float)L;
        float a = omega * band;
        z = (j <= 16) ? cosf(a) : -sinf(a);
      }
      zs[tl * 36 + j] = z;
    }
    __syncthreads();
    {
      float a = b1;
#pragma unroll
      for (int k = 0; k < 33; ++k) a += zs[tl * 36 + k] * w1s[k * 64 + j];
      h1[tl * 64 + j] = sinf(f1 * a);
    }
    __syncthreads();
    {
      float a = b2;
#pragma unroll 16
      for (int k = 0; k < 64; ++k) a += h1[tl * 64 + k] * w2s[k * 64 + j];
      float v = sinf(f2 * a);
      if (isctx) ((float*)(p.ws + WS_HID2C))[((size_t)l * 64 + j) * 256 + t] = v;
      else ((u16*)(p.ws + WS_HID2))[((size_t)l * 8192 + t) * 64 + j] = f2bf(v);
    }
  }
  __syncthreads();
}

struct WtItem { const float* W; u16* WT; int K, N, k0, n0; };
__device__ __forceinline__ WtItem wt_decode(const Ctx& p, int l, int r) {
  char* wo = (char*)p.out;
  WtItem it;
  int nblk;
  if (r < 1472) { it.W = pin(p, 8) + (size_t)l * 1024 * DIN; it.K = 1024; it.N = DIN; it.WT = (u16*)(wo + WO_IN); nblk = 92; }
  else if ((r -= 1472) < 1024) { it.W = pin(p, 30) + (size_t)l * 1024 * 4096; it.K = 1024; it.N = 4096; it.WT = (u16*)(wo + WO_FF1); nblk = 64; }
  else if ((r -= 1024) < 1024) { it.W = pin(p, 31) + (size_t)l * 4096 * 1024; it.K = 4096; it.N = 1024; it.WT = (u16*)(wo + WO_FF2); nblk = 16; }
  else if ((r -= 1024) < 256) { it.W = pin(p, 29) + (size_t)l * 1024 * 1024; it.K = 1024; it.N = 1024; it.WT = (u16*)(wo + WO_OUT); nblk = 16; }
  else if ((r -= 256) < 128) { it.W = pin(p, 23) + (size_t)l * 512 * 1024; it.K = 512; it.N = 1024; it.WT = (u16*)(wo + WO_HY); nblk = 16; }
  else if ((r -= 128) < 128) { it.W = pin(p, 28) + (size_t)l * 512 * 1024; it.K = 512; it.N = 1024; it.WT = (u16*)(wo + WO_WO); nblk = 16; }
  else if ((r -= 128) < 72) { it.W = pin(p, 25) + (size_t)l * 384 * 768; it.K = 384; it.N = 768; it.WT = (u16*)(wo + WO_UQ); nblk = 12; }
  else { r -= 72; it.W = pin(p, 27) + (size_t)l * 256 * 1024; it.K = 256; it.N = 1024; it.WT = (u16*)(wo + WO_UKV); nblk = 16; }
  const int kb = r / nblk, nb2 = r - kb * nblk;
  it.k0 = kb * 64; it.n0 = nb2 * 64;
  return it;
}
__device__ __forceinline__ void wt_load(const WtItem& it, int tid, float (&v)[8]) {
  const int nn = tid & 63, kq = tid >> 6;
  const bool ok = it.n0 + nn < it.N;
  const float* src = it.W + (size_t)(it.k0 + kq) * it.N + it.n0 + (ok ? nn : 0);
#pragma unroll
  for (int r = 0; r < 8; ++r) { float x = src[(size_t)(r * 8) * it.N]; v[r] = ok ? x : 0.f; }
}
__device__ __forceinline__ void wt_phase(const Ctx& p, int l, char* smem) {
  float* tile = (float*)smem;
  const int tid = tid_l();
  const int bid = blockIdx.x, nb = gridDim.x;
  int t = bid;
  if (t >= 4168) return;
  WtItem cur = wt_decode(p, l, t);
  float v[8];
  wt_load(cur, tid, v);
#pragma unroll 1
  while (true) {
    const int tn = t + nb;
    const bool more = tn < 4168;
    WtItem nxt = cur;
    float vn[8];
    if (more) { nxt = wt_decode(p, l, tn); wt_load(nxt, tid, vn); }
#pragma unroll
    for (int r = 0; r < 8; ++r) tile[(r * 8 + (tid >> 6)) * 65 + (tid & 63)] = v[r];
    __syncthreads();
    {
      int n = tid >> 3, kc = (tid & 7) * 8;
      uint4 o;
      o.x = pk2(tile[(kc + 0) * 65 + n], tile[(kc + 1) * 65 + n]);
      o.y = pk2(tile[(kc + 2) * 65 + n], tile[(kc + 3) * 65 + n]);
      o.z = pk2(tile[(kc + 4) * 65 + n], tile[(kc + 5) * 65 + n]);
      o.w = pk2(tile[(kc + 6) * 65 + n], tile[(kc + 7) * 65 + n]);
      *(uint4*)(cur.WT + (size_t)(cur.n0 + n) * cur.K + cur.k0 + kc) = o;
    }
    __syncthreads();
    if (!more) break;
    cur = nxt;
#pragma unroll
    for (int r = 0; r < 8; ++r) v[r] = vn[r];
    t = tn;
  }
}

__device__ __forceinline__ void wpe_task(const Ctx& p, int l, int task, char* smem) {
  const int g = task >> 3, c0 = (task & 7) * 16, tid = tid_l();
  const float* pw = pin(p, 9) + ((size_t)(l * 4 + g) * 128) * 128;
  const float* sc = pin(p, 10) + l * 512 + g * 128;
  const float* po = pin(p, 11) + ((size_t)l * 512 + g * 128) * 1024;
  u16* WpeT = (u16*)(p.ws + WS_WPE) + (size_t)l * 1024 * 512;
  float* wl = (float*)smem;
  for (int i = tid; i < 16 * 128; i += NT) { int d = i & 127; wl[i] = pw[(c0 + (i >> 7)) * 128 + d] * sc[d]; }
  __syncthreads();
  float acc0[16], acc1[16];
#pragma unroll
  for (int i = 0; i < 16; ++i) { acc0[i] = 0.f; acc1[i] = 0.f; }
#pragma unroll 16
  for (int d = 0; d < 128; ++d) {
    float p0 = po[(size_t)d * 1024 + tid], p1 = po[(size_t)d * 1024 + 512 + tid];
#pragma unroll
    for (int i = 0; i < 16; ++i) { float w = wl[i * 128 + d]; acc0[i] += w * p0; acc1[i] += w * p1; }
  }
  uint4 o0, o1;
  o0.x = pk2(acc0[0], acc0[1]); o0.y = pk2(acc0[2], acc0[3]); o0.z = pk2(acc0[4], acc0[5]); o0.w = pk2(acc0[6], acc0[7]);
  o1.x = pk2(acc0[8], acc0[9]); o1.y = pk2(acc0[10], acc0[11]); o1.z = pk2(acc0[12], acc0[13]); o1.w = pk2(acc0[14], acc0[15]);
  uint4* dst = (uint4*)(WpeT + (size_t)tid * 512 + g * 128 + c0);
  dst[0] = o0; dst[1] = o1;
  o0.x = pk2(acc1[0], acc1[1]); o0.y = pk2(acc1[2], acc1[3]); o0.z = pk2(acc1[4], acc1[5]); o0.w = pk2(acc1[6], acc1[7]);
  o1.x = pk2(acc1[8], acc1[9]); o1.y = pk2(acc1[10], acc1[11]); o1.z = pk2(acc1[12], acc1[13]); o1.w = pk2(acc1[14], acc1[15]);
  dst = (uint4*)(WpeT + (size_t)(512 + tid) * 512 + g * 128 + c0);
  dst[0] = o0; dst[1] = o1;
  __syncthreads();
}

__device__ __forceinline__ void norm_rows(const Ctx& p, const float* gain, const float* modl, int sh_idx, int sc_idx, u16* outp) {
  const int tidx = tid_l(), lane = tidx & 63, gw = blockIdx.x * 8 + (tidx >> 6), ngw = gridDim.x * 8;
  const float* h = (const float*)(p.ws + WS_H);
  float4 g[4];
#pragma unroll
  for (int j = 0; j < 4; ++j) g[j] = *(const float4*)(gain + lane * 4 + 256 * j);
  for (int m0 = gw; m0 < MROWS; m0 += 2 * ngw) {
    const int m1 = m0 + ngw;
    const bool has1 = m1 < MROWS;
    const int m1c = has1 ? m1 : m0;
    const float4* hr0 = (const float4*)(h + (size_t)m0 * D) + lane;
    const float4* hr1 = (const float4*)(h + (size_t)m1c * D) + lane;
    float4 v0[4], v1[4];
#pragma unroll
    for (int j = 0; j < 4; ++j) { v0[j] = hr0[64 * j]; v1[j] = hr1[64 * j]; }
    const float* mg0 = modl + grp_of_row(m0) * 6144;
    const float* mg1 = modl + grp_of_row(m1c) * 6144;
    float s0 = 0.f, s1 = 0.f;
#pragma unroll
    for (int j = 0; j < 4; ++j) {
      s0 += v0[j].x * v0[j].x + v0[j].y * v0[j].y + v0[j].z * v0[j].z + v0[j].w * v0[j].w;
      s1 += v1[j].x * v1[j].x + v1[j].y * v1[j].y + v1[j].z * v1[j].z + v1[j].w * v1[j].w;
    }
    s0 = wave_sum(s0);
    s1 = wave_sum(s1);
    const float r0 = rsqrtf(s0 * (1.f / D) + EPS), r1 = rsqrtf(s1 * (1.f / D) + EPS);
    uint2* o0 = (uint2*)(outp + (size_t)m0 * D) + lane;
    uint2* o1 = (uint2*)(outp + (size_t)m1c * D) + lane;
#pragma unroll
    for (int j = 0; j < 4; ++j) {
      int n = lane * 4 + 256 * j;
      float4 sc = *(const float4*)(mg0 + sc_idx * 1024 + n), sh = *(const float4*)(mg0 + sh_idx * 1024 + n);
      uint2 o;
      o.x = pk2(v0[j].x * r0 * g[j].x * (1.f + sc.x) + sh.x, v0[j].y * r0 * g[j].y * (1.f + sc.y) + sh.y);
      o.y = pk2(v0[j].z * r0 * g[j].z * (1.f + sc.z) + sh.z, v0[j].w * r0 * g[j].w * (1.f + sc.w) + sh.w);
      o0[64 * j] = o;
    }
    if (has1) {
#pragma unroll
      for (int j = 0; j < 4; ++j) {
        int n = lane * 4 + 256 * j;
        float4 sc = *(const float4*)(mg1 + sc_idx * 1024 + n), sh = *(const float4*)(mg1 + sh_idx * 1024 + n);
        uint2 o;
        o.x = pk2(v1[j].x * r1 * g[j].x * (1.f + sc.x) + sh.x, v1[j].y * r1 * g[j].y * (1.f + sc.y) + sh.y);
        o.y = pk2(v1[j].z * r1 * g[j].z * (1.f + sc.z) + sh.z, v1[j].w * r1 * g[j].w * (1.f + sc.w) + sh.w);
        o1[64 * j] = o;
      }
    }
  }
}

__device__ __forceinline__ void final_norm(const Ctx& p) {
  const int tidx = tid_l(), lane = tidx & 63, gw = blockIdx.x * 8 + (tidx >> 6), ngw = gridDim.x * 8;
  const float* h = (const float*)(p.ws + WS_H);
  const float* gain = pin(p, 32);
  for (int r0 = gw; r0 < 2 * SEQ; r0 += ngw) {
    int b = r0 >> 13, t = r0 & 8191, m = b * SP + CTX + t;
    const float4* hr = (const float4*)(h + (size_t)m * D) + lane;
    float4 v[4];
    float ss = 0.f;
#pragma unroll
    for (int j = 0; j < 4; ++j) { v[j] = hr[64 * j]; ss += v[j].x * v[j].x + v[j].y * v[j].y + v[j].z * v[j].z + v[j].w * v[j].w; }
    ss = wave_sum(ss);
    float r = rsqrtf(ss * (1.f / D) + EPS);
    float4* o = (float4*)(p.out + (size_t)r0 * D) + lane;
#pragma unroll
    for (int j = 0; j < 4; ++j) {
      float4 g = *(const float4*)(gain + lane * 4 + 256 * j);
      o[64 * j] = make_float4(v[j].x * r * g.x, v[j].y * r * g.y, v[j].z * r * g.z, v[j].w * r * g.w);
    }
  }
}

__device__ __forceinline__ void premix_task(const Ctx& p, int l, int task, char* smem) {
  const int tid = tid_l(), lane = tid & 63, wid = tid >> 6;
  const int part = task / 264, tile64 = task - part * 264;
  const int m0 = tile64 * 64, b = m0 / SP, pos0 = m0 - b * SP;
  const bool isctx = pos0 < CTX;
  const int s0 = isctx ? 0 : CTX, L = isctx ? CTX : SEQ, t0 = pos0 - s0;
  const size_t mb = (size_t)b * SP + s0;
  const u16* proj = (const u16*)(p.ws + WS_PROJ);
  if (part == 0) {
    u16* P = (u16*)smem;
#pragma unroll
    for (int i = tid; i < 80 * 64; i += NT) {
      int r = i >> 6, ch = i & 63, t = t0 - 8 + r;
      uint4 v = make_uint4(0, 0, 0, 0);
      if (t >= 0 && t < L) v = *(const uint4*)(proj + (mb + t) * DINP + ch * 8);
      *(uint4*)(P + r * 512 + ch * 8) = v;
    }
    __syncthreads();
    const int c = tid, g = c >> 7, hw = 1 << g;
    u16* U = (u16*)(p.ws + WS_U);
    float s = 0.f;
    for (int q = -hw; q < hw; ++q) s += bf2f(P[(8 + q) * 512 + c]);
#pragma unroll 4
    for (int tt = 0; tt < 64; ++tt) {
      int t = t0 + tt, lo = max(t - hw, 0), hi = min(t + hw, L);
      float u = s / (float)(hi - lo) - bf2f(P[(tt + 8) * 512 + c]);
      U[(mb + t) * 512 + c] = f2bf(u);
      s += bf2f(P[(tt + 8 + hw) * 512 + c]) - bf2f(P[(tt + 8 - hw) * 512 + c]);
    }
    __syncthreads();
  } else if (part <= 4) {
    const int ch0 = (part - 1) * 128;
    constexpr int PITCH = 136;
    u16* X = (u16*)smem;
    float* T = (float*)(smem + 3 * 66 * PITCH * 2 + 64);
#pragma unroll
    for (int ii = 0; ii < 7; ++ii) {
      const int i = tid + ii * NT;
      if (i >= 3 * 66 * 16) break;
      int pr = i / (66 * 16), rem = i - pr * 66 * 16, r = rem >> 4, ch = rem & 15, t = t0 - 1 + r;
      uint4 v = make_uint4(0, 0, 0, 0);
      if (t >= 0 && t < L) v = *(const uint4*)(proj + (mb + t) * DINP + OFF_HY + pr * 512 + ch0 + ch * 8);
      *(uint4*)(X + (pr * 66 + r) * PITCH + ch * 8) = v;
    }
    __syncthreads();
    const float* cw = pin(p, 12) + l * 3 * 1536;
    const float* cb = pin(p, 13) + l * 1536;
    {
      const int c = tid & 127, tq = tid >> 7, col = ch0 + c;
      const float w00 = cw[col], w01 = cw[1536 + col], w02 = cw[3072 + col], b0 = cb[col];
      const float w10 = cw[512 + col], w11 = cw[1536 + 512 + col], w12 = cw[3072 + 512 + col], b1 = cb[512 + col];
      const float w20 = cw[1024 + col], w21 = cw[1536 + 1024 + col], w22 = cw[3072 + 1024 + col], b2 = cb[1024 + col];
      const u16* X0 = X, *X1 = X + 66 * PITCH, *XV = X + 2 * 66 * PITCH;
      u16* Y = (u16*)(p.ws + WS_Y);
#pragma unroll 4
      for (int tt = tq * 16; tt < tq * 16 + 16; ++tt) {
        float x0 = w00 * bf2f(X0[tt * PITCH + c]) + w01 * bf2f(X0[(tt + 1) * PITCH + c]) + w02 * bf2f(X0[(tt + 2) * PITCH + c]) + b0;
        float x1 = w10 * bf2f(X1[tt * PITCH + c]) + w11 * bf2f(X1[(tt + 1) * PITCH + c]) + w12 * bf2f(X1[(tt + 2) * PITCH + c]) + b1;
        float vv = w20 * bf2f(XV[tt * PITCH + c]) + w21 * bf2f(XV[(tt + 1) * PITCH + c]) + w22 * bf2f(XV[(tt + 2) * PITCH + c]) + b2;
        Y[(mb + t0 + tt) * 512 + col] = f2bf(x0);
        T[c * 65 + tt] = x1 * vv;
      }
    }
    __syncthreads();
    {
      float* ZV = (float*)(p.ws + WS_ZV);
#pragma unroll 4
      for (int cc = 0; cc < 16; ++cc) {
        int c = wid * 16 + cc;
        ZV[((size_t)(ch0 + c) * SP + pos0 + lane) * 2 + b] = T[c * 65 + lane];
      }
    }
    __syncthreads();
  } else {
    u16* projw = (u16*)(p.ws + WS_PROJ);
    const float* qg = pin(p, 24) + l * 384;
    const float* kg = pin(p, 26) + l * 256;
    const float2* rope = (const float2*)(p.ws + WS_ROPE);
    u16* Kb = (u16*)(p.ws + WS_K);
#pragma unroll 2
    for (int rr = 0; rr < 8; ++rr) {
      int tt = wid * 8 + rr, pos = pos0 + tt;
      u16* row = projw + ((size_t)b * SP + pos) * DINP;
      unsigned* q32 = (unsigned*)(row + OFF_Q);
      unsigned* k32 = (unsigned*)(row + OFF_KV);
      unsigned v[3], w[2];
      float ss = 0.f, s2 = 0.f;
#pragma unroll
      for (int j = 0; j < 3; ++j) v[j] = q32[lane + 64 * j];
#pragma unroll
      for (int j = 0; j < 2; ++j) w[j] = k32[lane + 64 * j];
      const int rd = lane & 31;
      float val = bf2f(row[OFF_KV + 256 + rd]);
#pragma unroll
      for (int j = 0; j < 3; ++j) { float a = bf2f(v[j] & 0xffff), c2 = bf2f(v[j] >> 16); ss += a * a + c2 * c2; }
#pragma unroll
      for (int j = 0; j < 2; ++j) { float a = bf2f(w[j] & 0xffff), c2 = bf2f(w[j] >> 16); s2 += a * a + c2 * c2; }
      ss = wave_sum(ss);
      s2 = wave_sum(s2);
      float r = rsqrtf(ss * (1.f / 384.f) + EPS), r2 = rsqrtf(s2 * (1.f / 256.f) + EPS);
#pragma unroll
      for (int j = 0; j < 3; ++j) {
        int n = (lane + 64 * j) * 2;
        q32[lane + 64 * j] = pk2(bf2f(v[j] & 0xffff) * r * qg[n], bf2f(v[j] >> 16) * r * qg[n + 1]);
      }
#pragma unroll
      for (int j = 0; j < 2; ++j) {
        int n = (lane + 64 * j) * 2;
        k32[lane + 64 * j] = pk2(bf2f(w[j] & 0xffff) * r2 * kg[n], bf2f(w[j] >> 16) * r2 * kg[n + 1]);
      }
      float partner = shx(val, 8);
      if (!isctx) {
        int t = pos - CTX, idx = (rd < 16) ? (t >> 6) : (t & 63);
        float2 cs = rope[idx * 8 + (rd & 7)];
        float sgn = (rd & 8) ? 1.f : -1.f;
        val = val * cs.x + sgn * partner * cs.y;
      }
      if (lane < 32) {
        u16 o = f2bf(val);
#pragma unroll
        for (int hd = 0; hd < 8; ++hd) Kb[((size_t)(b * 8 + hd) * SP + pos) * 96 + 64 + rd] = o;
      }
    }
  }
}

__device__ __forceinline__ int xi(int i) { const int h = i >> 5; return i ^ (((h & 3) * 5) | ((h & 2) << 3)); }
typedef float v2f __attribute__((ext_vector_type(2)));
__device__ __forceinline__ v2f cmulv(v2f a, v2f b) {
  v2f bs = {-b.y, b.x};
  return a.xx * b + a.yy * bs;
}
__device__ __forceinline__ void bf_fwd(float2* Xf, int base, int q, float2 w1f) {
  v2f* X = (v2f*)Xf;
  const v2f w1 = {w1f.x, w1f.y};
  const v2f w2 = cmulv(w1, w1), w3 = cmulv(w2, w1);
  const int i0 = xi(base), i1 = xi(base + q), i2 = xi(base + 2 * q), i3 = xi(base + 3 * q);
  v2f a0 = X[i0], a1 = X[i1], a2 = X[i2], a3 = X[i3];
  v2f s02 = a0 + a2, d02 = a0 - a2, s13 = a1 + a3, d13 = a1 - a3;
  v2f d13r = {d13.y, -d13.x};
  X[i0] = s02 + s13;
  X[i1] = cmulv(d02 + d13r, w1);
  X[i2] = cmulv(s02 - s13, w2);
  X[i3] = cmulv(d02 - d13r, w3);
}
__device__ __forceinline__ void bf_inv(float2* Xf, int base, int q, float2 w1f) {
  v2f* X = (v2f*)Xf;
  const v2f w1 = {w1f.x, -w1f.y};
  const v2f w2 = cmulv(w1, w1), w3 = cmulv(w2, w1);
  const int i0 = xi(base), i1 = xi(base + q), i2 = xi(base + 2 * q), i3 = xi(base + 3 * q);
  v2f b0 = X[i0], c1 = cmulv(X[i1], w1), c2 = cmulv(X[i2], w2), c3 = cmulv(X[i3], w3);
  v2f s02 = b0 + c2, d02 = b0 - c2, s13 = c1 + c3, d13 = c1 - c3;
  v2f d13r = {-d13.y, d13.x};
  X[i0] = s02 + s13;
  X[i1] = d02 + d13r;
  X[i2] = s02 - s13;
  X[i3] = d02 - d13r;
}
template <bool INV, int LQ>
__device__ __forceinline__ void fft_pass(float2* X, const float2* __restrict__ tw, const float2 (&twr)[6], int tid) {
  constexpr int q = 1 << LQ;
  if (LQ == 12) {
    float2 w[8];
#pragma unroll
    for (int b8 = 0; b8 < 8; ++b8) w[b8] = tw[b8 * NT + tid];
#pragma unroll
    for (int b8 = 0; b8 < 8; ++b8) { int u = b8 * NT + tid; if (INV) bf_inv(X, u, q, w[b8]); else bf_fwd(X, u, q, w[b8]); }
  } else if (LQ == 10) {
#pragma unroll 2
    for (int b8 = 0; b8 < 8; ++b8) {
      int u = b8 * NT + tid, j = u & 1023, base = ((u >> 10) << 12) + j;
      float2 w = (b8 & 1) ? twr[1] : twr[0];
      if (INV) bf_inv(X, base, q, w); else bf_fwd(X, base, q, w);
    }
  } else {
    const int j = tid & (q - 1);
    const float2 w = (LQ == 0) ? make_float2(1.f, 0.f) : twr[2 + (8 - LQ) / 2];
#pragma unroll 2
    for (int b8 = 0; b8 < 8; ++b8) {
      int u = b8 * NT + tid, base = ((u >> LQ) << (LQ + 2)) + j;
      if (INV) bf_inv(X, base, q, w); else bf_fwd(X, base, q, w);
    }
  }
  __syncthreads();
}
__device__ __forceinline__ void fft_load_tw(const float2* __restrict__ tw, int tid, float2 (&twr)[6]) {
  twr[0] = tw[tid << 2];
  twr[1] = tw[(512 + tid) << 2];
  twr[2] = tw[(tid & 255) << 4];
  twr[3] = tw[(tid & 63) << 6];
  twr[4] = tw[(tid & 15) << 8];
  twr[5] = tw[(tid & 3) << 10];
}
__device__ __forceinline__ void fft_dif(float2* X, const float2* __restrict__ tw, const float2 (&twr)[6]) {
  const int tid = tid_l();
  fft_pass<false, 12>(X, tw, twr, tid); fft_pass<false, 10>(X, tw, twr, tid); fft_pass<false, 8>(X, tw, twr, tid); fft_pass<false, 6>(X, tw, twr, tid);
  fft_pass<false, 4>(X, tw, twr, tid); fft_pass<false, 2>(X, tw, twr, tid); fft_pass<false, 0>(X, tw, twr, tid);
}
__device__ __forceinline__ void fft_dit_inv(float2* X, const float2* __restrict__ tw, const float2 (&twr)[6]) {
  const int tid = tid_l();
  fft_pass<true, 0>(X, tw, twr, tid); fft_pass<true, 2>(X, tw, twr, tid); fft_pass<true, 4>(X, tw, twr, tid); fft_pass<true, 6>(X, tw, twr, tid);
  fft_pass<true, 8>(X, tw, twr, tid); fft_pass<true, 10>(X, tw, twr, tid); fft_pass<true, 12>(X, tw, twr, tid);
}
__device__ __forceinline__ float block_sum(float v, float* red) {
  v = wave_sum(v);
  __syncthreads();
  { const int tb = tid_l(); if ((tb & 63) == 0) red[tb >> 6] = v; }
  __syncthreads();
  float s = red[0] + red[1] + red[2] + red[3] + red[4] + red[5] + red[6] + red[7];
  __syncthreads();
  return s;
}

__device__ __forceinline__ void fft_task(const Ctx& p, int l, int c, char* smem) {
  float2* X = (float2*)smem;
  float* aux = (float*)(smem + AUX_OFF);
  float* red = aux + 128;
  const int tid = tid_l();
  const float2* tw = (const float2*)(p.ws + WS_TW);
  float2 twr[6];
  fft_load_tw(tw, tid, twr);
  const float* w3 = pin(p, 20) + (size_t)l * 64 * 1024;
  if (tid < 64) { aux[tid] = w3[tid * 1024 + c]; aux[64 + tid] = w3[tid * 1024 + 512 + c]; }
  __syncthreads();
  const float dF = fabsf(pin(p, 21)[(l * 2 + 0) * 512 + c]), dB = fabsf(pin(p, 21)[(l * 2 + 1) * 512 + c]);
  const float bias = pin(p, 22)[l * 512 + c];
  float2* zp = (float2*)(p.ws + WS_ZV) + (size_t)c * SP;
  float l1 = 0.f;
  {
    const u16* ff = (const u16*)((const char*)p.out + WO_FILT) + (size_t)c * 8192 + tid;
    const u16* fb = ff + (size_t)512 * 8192;
    u16 rf[16], rb[16];
#pragma unroll
    for (int i = 0; i < 16; ++i) { rf[i] = ff[i * NT]; rb[i] = fb[i * NT]; }
#pragma unroll
    for (int i = 0; i < 16; ++i) {
      int t = i * NT + tid;
      float tl = (float)t * (1.f / 8191.f);
      float hf = bf2f(rf[i]) * expf(-tl * dF);
      float hb = bf2f(rb[i]) * expf(-tl * dB);
      X[xi(t)] = make_float2(hf, 0.f);
      if (t >= 1) { X[xi(16384 - t)] = make_float2(hb, 0.f); l1 += fabsf(hf) + fabsf(hb); }
      else { X[xi(8192)] = make_float2(0.f, 0.f); l1 += fabsf(hf); }
    }
  }
  float l1tot = block_sum(l1, red);
  fft_dif(X, tw, twr);
  float2 F[32];
  {
    float s = 1.f / (l1tot * 16384.f);
#pragma unroll
    for (int i = 0; i < 32; ++i) { float2 v = X[xi(i * NT + tid)]; F[i] = make_float2(v.x * s, v.y * s); }
  }
  __syncthreads();
#pragma unroll 8
  for (int i = 0; i < 16; ++i) {
    int t = i * NT + tid;
    X[xi(t)] = zp[CTX + t];
    X[xi(8192 + t)] = make_float2(0.f, 0.f);
  }
  __syncthreads();
  fft_dif(X, tw, twr);
#pragma unroll
  for (int i = 0; i < 32; ++i) { int idx = xi(i * NT + tid); X[idx] = cmul(X[idx], F[i]); }
  __syncthreads();
  fft_dit_inv(X, tw, twr);
  {
    float2 zz[16];
#pragma unroll
    for (int i = 0; i < 16; ++i) zz[i] = zp[CTX + i * NT + tid];
#pragma unroll
    for (int i = 0; i < 16; ++i) {
      int t = i * NT + tid;
      float2 y = X[xi(t)];
      zp[CTX + t] = make_float2(y.x + bias * zz[i].x, y.y + bias * zz[i].y);
    }
  }
  __syncthreads();
  {
    float* hFc = (float*)smem;
    float* hBc = hFc + 256;
    float2* zc = (float2*)(hBc + 256);
    float l1c = 0.f;
    if (tid < 256) {
      int t = tid;
      const float* hc = (const float*)(p.ws + WS_HID2C) + (size_t)l * 64 * 256 + t;
      float hf = 0.f, hb = 0.f;
#pragma unroll 16
      for (int k = 0; k < 64; ++k) { float v = hc[k * 256]; hf += v * aux[k]; hb += v * aux[64 + k]; }
      float tl = (float)t * (1.f / 255.f);
      hf *= expf(-tl * dF);
      hb *= expf(-tl * dB);
      hFc[t] = hf;
      hBc[t] = hb;
      l1c = fabsf(hf) + (t >= 1 ? fabsf(hb) : 0.f);
      zc[t] = zp[t];
    }
    float l1ct = block_sum(l1c, red);
    const int bb = tid >> 8, t = tid & 255;
    float acc = 0.f;
    for (int s = 0; s < 256; ++s) {
      float kf = (s <= t) ? hFc[t - s] : hBc[s - t];
      float2 z = zc[s];
      acc += kf * (bb ? z.y : z.x);
    }
    float2 z = zc[t];
    ((float*)zp)[t * 2 + bb] = acc / l1ct + bias * (bb ? z.y : z.x);
    __syncthreads();
  }
}

constexpr int AT_KT = 128, AT_KP = 208, AT_VP = 264, AT_STAGE = AT_KT * AT_KP + 64 * AT_VP;
__device__ __forceinline__ void attn_task(const Ctx& p, int bh, int qb, char* smem) {
  const int tid = tid_l(), wid = tid >> 6, lane = tid & 63, r = lane & 31, hh = lane >> 5;
  const u16* Qp = (const u16*)(p.ws + WS_Q) + ((size_t)bh * SP + qb * 256) * 96;
  const u16* Kp = (const u16*)(p.ws + WS_K) + (size_t)bh * SP * 96;
  const u16* Vp = (const u16*)(p.ws + WS_VT) + (size_t)bh * 64 * SP;
  const int nkt = (qb == 0) ? 2 : 66;
  bf16x8 qf[6];
#pragma unroll
  for (int ks = 0; ks < 6; ++ks) qf[ks] = *(const bf16x8*)(Qp + (size_t)(wid * 32 + r) * 96 + ks * 16 + hh * 8);
  f32x16 o0, o1;
#pragma unroll
  for (int i = 0; i < 16; ++i) { o0[i] = 0.f; o1[i] = 0.f; }
  float mrun = 0.f, lrun = 0.f;
  const u16* src[5];
  int dst[5];
#pragma unroll
  for (int i = 0; i < 5; ++i) {
    int ch = tid + i * NT;
    if (i < 3) { int row = ch / 12, cc = ch - row * 12; src[i] = Kp + (size_t)row * 96 + cc * 8; dst[i] = row * AT_KP + cc * 16; }
    else { int v = ch - 1536, row = v >> 4, cc = v & 15; src[i] = Vp + (size_t)row * SP + cc * 8; dst[i] = AT_KT * AT_KP + row * AT_VP + cc * 16; }
  }
  uint4 st[5];
#define AT_LOAD(t)                                                                                   \
  do {                                                                                               \
    _Pragma("unroll") for (int i = 0; i < 5; ++i) st[i] = *(const uint4*)(src[i] + (size_t)(t) * (i < 3 ? AT_KT * 96 : AT_KT)); \
  } while (0)
#define AT_WRITE(buf)                                                                                \
  do {                                                                                               \
    char* base_ = smem + (buf) * AT_STAGE;                                                           \
    _Pragma("unroll") for (int i = 0; i < 5; ++i) {                                                  \
      uint2* d_ = (uint2*)(base_ + dst[i]);                                                          \
      d_[0] = make_uint2(st[i].x, st[i].y);                                                          \
      d_[1] = make_uint2(st[i].z, st[i].w);                                                          \
    }                                                                                                \
  } while (0)
#define AT_QK(S, kb)                                                                                 \
  __builtin_amdgcn_s_setprio(1);                                                                     \
  _Pragma("unroll") for (int ks = 0; ks < 6; ++ks) {                                                 \
    bf16x8 a_ = *(const bf16x8*)(Ks + ((kb) * 32 + r) * AT_KP + ks * 32 + hh * 16);                  \
    S = __builtin_amdgcn_mfma_f32_32x32x16_bf16(a_, qf[ks], S, 0, 0, 0);                             \
  }                                                                                                  \
  __builtin_amdgcn_s_setprio(0);
#define AT_SOFT_PV(S, kb)                                                                            \
  _Pragma("unroll") for (int i = 0; i < 16; ++i) { S[i] = __builtin_amdgcn_exp2f(S[i]); ps += S[i]; pmx = fmaxf(pmx, S[i]); } \
  _Pragma("unroll") for (int sI = 0; sI < 2; ++sI) {                                                 \
    union { bf16x8 v; unsigned u[4]; } pu;                                                           \
    _Pragma("unroll") for (int j = 0; j < 4; ++j) pu.u[j] = pk2(S[8 * sI + 2 * j], S[8 * sI + 2 * j + 1]); \
    const int koff = ((kb) * 32 + 16 * sI + 4 * hh) * 2;                                             \
    union { bf16x8 v; uint2 h2[2]; } va, vb;                                                         \
    va.h2[0] = *(const uint2*)(Vs + r * AT_VP + koff);                                               \
    va.h2[1] = *(const uint2*)(Vs + r * AT_VP + koff + 16);                                          \
    vb.h2[0] = *(const uint2*)(Vs + (32 + r) * AT_VP + koff);                                        \
    vb.h2[1] = *(const uint2*)(Vs + (32 + r) * AT_VP + koff + 16);                                   \
    o0 = __builtin_amdgcn_mfma_f32_32x32x16_bf16(va.v, pu.v, o0, 0, 0, 0);                           \
    o1 = __builtin_amdgcn_mfma_f32_32x32x16_bf16(vb.v, pu.v, o1, 0, 0, 0);                           \
  }
  AT_LOAD(0);
  AT_WRITE(0);
  __syncthreads();
  for (int t = 0; t < nkt; ++t) {
    const int cur = t & 1;
    if (t + 1 < nkt) AT_LOAD(t + 1);
    const char* Ks = smem + cur * AT_STAGE;
    const char* Vs = Ks + AT_KT * AT_KP;
    const float nm = -mrun;
    f32x16 sA, sB;
    float ps = 0.f, pmx = 0.f;
#pragma unroll
    for (int i = 0; i < 16; ++i) sA[i] = nm;
    AT_QK(sA, 0)
#pragma unroll
    for (int i = 0; i < 16; ++i) sB[i] = nm;
    AT_QK(sB, 1)
    AT_SOFT_PV(sA, 0)
#pragma unroll
    for (int i = 0; i < 16; ++i) sA[i] = nm;
    AT_QK(sA, 2)
    AT_SOFT_PV(sB, 1)
#pragma unroll
    for (int i = 0; i < 16; ++i) sB[i] = nm;
    AT_QK(sB, 3)
    AT_SOFT_PV(sA, 2)
    AT_SOFT_PV(sB, 3)
    lrun += ps;
    pmx = fmaxf(pmx, shx(pmx, 32));
    if (__any(pmx > 256.f)) {
      const float delta = pmx > 256.f ? ceilf(__log2f(pmx)) : 0.f;
      const float alpha = __builtin_amdgcn_exp2f(-delta);
      mrun += delta;
      lrun *= alpha;
#pragma unroll
      for (int i = 0; i < 16; ++i) { o0[i] *= alpha; o1[i] *= alpha; }
    }
    if (t + 1 < nkt) AT_WRITE(cur ^ 1);
    __syncthreads();
  }
  const float ltot = lrun + shx(lrun, 32);
  const float inv = 1.f / ltot;
  const int b = bh >> 3, head = bh & 7;
  u16* Op = (u16*)(p.ws + WS_O) + ((size_t)b * SP + qb * 256 + wid * 32 + r) * 512 + head * 64;
#pragma unroll
  for (int g = 0; g < 4; ++g) {
    uint2 w0, w1;
    w0.x = pk2(o0[4 * g] * inv, o0[4 * g + 1] * inv);
    w0.y = pk2(o0[4 * g + 2] * inv, o0[4 * g + 3] * inv);
    w1.x = pk2(o1[4 * g] * inv, o1[4 * g + 1] * inv);
    w1.y = pk2(o1[4 * g + 2] * inv, o1[4 * g + 3] * inv);
    *(uint2*)(Op + 8 * g + 4 * hh) = w0;
    *(uint2*)(Op + 32 + 8 * g + 4 * hh) = w1;
  }
#undef AT_LOAD
#undef AT_WRITE
#undef AT_QK
#undef AT_SOFT_PV
}

__device__ __forceinline__ void hypost_task(const Ctx& p, int task, char* smem) {
  const int tid = tid_l(), lane = tid & 63, wid = tid >> 6;
  const int tile64 = task >> 1, ch0 = (task & 1) * 256;
  const int m0 = tile64 * 64, b = m0 / SP, pos0 = m0 - b * SP;
  float* T = (float*)smem;
  const float* ZV = (const float*)(p.ws + WS_ZV);
#pragma unroll 8
  for (int cc = 0; cc < 32; ++cc) {
    int c = wid * 32 + cc;
    T[c * 65 + lane] = ZV[((size_t)(ch0 + c) * SP + pos0 + lane) * 2 + b];
  }
  __syncthreads();
  u16* Y = (u16*)(p.ws + WS_Y);
  const int c = tid & 255, th = tid >> 8;
  u16* yp = Y + (size_t)(m0 + th * 32) * 512 + ch0 + c;
  u16 yv[32];
#pragma unroll
  for (int i = 0; i < 32; ++i) yv[i] = yp[(size_t)i * 512];
#pragma unroll
  for (int i = 0; i < 32; ++i) yp[(size_t)i * 512] = f2bf(bf2f(yv[i]) * T[c * 65 + th * 32 + i]);
  __syncthreads();
}

#ifndef PHMASK
#define PHMASK 0xFFFF
#endif
#define PHON(k) (((PHMASK) >> (k)) & 1)
constexpr int NPH = 1 + 4 * 10 + 1;
__global__ void __launch_bounds__(NT, 2) mega(Params prm) {
  __shared__ __attribute__((aligned(1024))) char smem[LDS_BYTES];
  cg::grid_group grid = cg::this_grid();
  const int bid = blockIdx.x, nb = gridDim.x;
  {
    unsigned long long* it = (unsigned long long*)(smem + AUX_OFF + 6144);
    if (threadIdx.x < 33) it[threadIdx.x] = (unsigned long long)prm.in[threadIdx.x];
    if (threadIdx.x == 0) *(uint4*)(smem + AUX_OFF + 7168) = make_uint4(0u, 0u, 0u, 0u);
    __syncthreads();
  }
  XcdBarrier xbar = xcd_barrier_post((unsigned*)(prm.ws + WS_BAR), (volatile LAS unsigned*)(smem + AUX_OFF + 7168));
  if (prm.ph_lo == 0) {
    Ctx p;
    p.intab = (const unsigned long long*)(smem + AUX_OFF + 6144);
    p.ws = prm.ws;
    p.out = prm.out;
    const int bid = blockIdx.x, nb = gridDim.x;
      if (PHON(10)) {
      p0_misc(p);
      for (int t = bid; t < 192; t += nb) p0_mod_task(p, t, smem);
      for (int t = bid; t < 528; t += nb) p0_hid_task(p, t, smem);
      for (int t = bid; t < 128; t += nb) { const int w = (t + 64) & 127; wpe_task(p, w >> 5, w & 31, smem); }
      }
  }
  unsigned nbar = 0;
  for (int ph = prm.ph_lo; ph < prm.ph_hi; ++ph) {
    Ctx p;
    p.intab = (const unsigned long long*)(smem + AUX_OFF + 6144);
    p.ws = prm.ws;
    p.out = prm.out;
    asm volatile("" : "+s"(p.ws), "+s"(p.out));
    float* modall = (float*)(p.ws + WS_MOD);
    u16* proj = (u16*)(p.ws + WS_PROJ);
    u16* xn = (u16*)(p.ws + WS_U);
    char* wo = (char*)p.out;
    if (ph == 0) {
    } else if (ph == NPH - 1) {
      if (PHON(11)) final_norm(p);
    } else {
      const int l = (ph - 1) / 10, sp = (ph - 1) % 10;
      const float* modl = modall + (size_t)l * 3 * 6144;
      GD* tab = (GD*)(smem + AUX_OFF + 4096);
      int ng = 0, nN0 = 0, nN1 = 0, nsplit = 1;
      const bool last = (l == 3);
      const float* gate = modl;
      if (sp == 0 && PHON(0)) {
        wt_phase(p, l, smem);
        norm_rows(p, pin(p, 6) + l * 1024, modl, 0, 1, xn);
      } else if (sp == 1 && PHON(1)) {
        if (threadIdx.x == 0) tab[0] = GD{xn, 1024, (const u16*)(wo + WO_IN), 1024, 1024, 23, EM_PROJ, 1};
        ng = 1; nN0 = 23;
      } else if (sp == 2 && PHON(2)) {
        for (int t = bid; t < 264 * 6; t += nb) premix_task(p, l, t, smem);
        {
          Epi ef{EM_FILT, p.ws, gate, nullptr, (u16*)(wo + WO_FILT)};
          const u16* hA = (const u16*)(p.ws + WS_HID2) + (size_t)l * 8192 * 64;
          const u16* wB = (const u16*)(p.ws + WS_W3T) + (size_t)l * 1024 * 64;
#pragma unroll 1
          for (int t = nb - 1 - bid; t < 128; t += nb) gemm_tile(hA, 64, wB, 64, 64, (t >> 2) * 256, (t & 3) * 256, smem, ef);
        }
      } else if (sp == 3 && PHON(3)) {
        for (int t = bid; t < 512; t += nb) fft_task(p, l, t, smem);
        if (threadIdx.x == 0) {
          tab[0] = GD{proj + OFF_Q, DINP, (const u16*)(wo + WO_UQ), 384, 384, 3, EM_Q, 1};
          tab[1] = GD{proj + OFF_KV, DINP, (const u16*)(wo + WO_UKV), 256, 256, 4, EM_KV, 1};
        }
        ng = 2; nN0 = 3; nN1 = 4;
        for (int i = tid_l(); i < 1024; i += NT) ((float2*)(smem + 131072))[i] = ((const float2*)(p.ws + WS_ROPE))[i];
      } else if (sp == 4 && PHON(4)) {
        for (int t = bid; t < (last ? 512 : 528); t += nb) {
          int bh, qb;
          if (t < 512) { int rnd = t >> 8, w = t & 255; bh = (w & 7) + 8 * rnd; qb = 1 + (w >> 3); }
          else { bh = t - 512; qb = 0; }
          attn_task(p, bh, qb, smem);
        }
        for (int t = bid; t < 528; t += nb) hypost_task(p, t, smem);
      } else if (sp == 5 && PHON(5)) {
        for (int t = bid; t < 8 * 68; t += nb) {
          const int x = t & 7, g = t >> 3, pm = (g >> 2) * 8 + x;
          if (pm < 132 && !(last && (pm % 66) < 2)) mix_tile(p, l, pm, g & 3, smem);
        }
      } else if (sp == 6 && PHON(6)) {
        if (threadIdx.x == 0) tab[0] = GD{(const u16*)(p.ws + WS_ZV), 1024, (const u16*)(wo + WO_OUT), 1024, 1024, 4, EM_RESID, 4};
        ng = 1; nN0 = 4; nsplit = 4;
        gate = modl + 2 * 1024;
      } else if (sp == 7 && PHON(7)) {
        norm_rows(p, pin(p, 7) + l * 1024, modl, 3, 4, xn);
      } else if (sp == 8 && PHON(8)) {
        if (threadIdx.x == 0) tab[0] = GD{xn, 1024, (const u16*)(wo + WO_FF1), 1024, 1024, 16, EM_SQRELU, last ? 2 : 1};
        ng = 1; nN0 = 16; nsplit = last ? 2 : 1;
      } else if (sp == 9 && PHON(9)) {
        if (threadIdx.x == 0) tab[0] = GD{proj, DFF, (const u16*)(wo + WO_FF2), 4096, 4096, 4, EM_RESID, 8};
        ng = 1; nN0 = 4; nsplit = 8;
        gate = modl + 5 * 1024;
      }
      if (ng > 0) {
        __syncthreads();
        const int nt0 = (nsplit > 1) ? (64 * nN0 + (last ? 0 : 2 * nN0 * nsplit)) : NMT * nN0, ntot = nt0 + NMT * nN1;
#pragma unroll 1
        for (int t = bid; t < ntot; t += nb) {
          int gi = 0, tt = t;
          if (t >= nt0) { gi = 1; tt = t - nt0; }
          const volatile GD* gp = tab + gi;
          unsigned long long a64 = (unsigned long long)gp->A, b64 = (unsigned long long)gp->Bt;
          a64 = ((unsigned long long)(unsigned)__builtin_amdgcn_readfirstlane((unsigned)(a64 >> 32)) << 32) | (unsigned long long)(unsigned)__builtin_amdgcn_readfirstlane((unsigned)a64);
          b64 = ((unsigned long long)(unsigned)__builtin_amdgcn_readfirstlane((unsigned)(b64 >> 32)) << 32) | (unsigned long long)(unsigned)__builtin_amdgcn_readfirstlane((unsigned)b64);
          const int lda = __builtin_amdgcn_readfirstlane(gp->lda), ldb = __builtin_amdgcn_readfirstlane(gp->ldb);
          const int K = __builtin_amdgcn_readfirstlane(gp->K), nN = __builtin_amdgcn_readfirstlane(gp->nN);
          const int ks = __builtin_amdgcn_readfirstlane(gp->ks);
          const int mode = __builtin_amdgcn_readfirstlane(gp->mode);
          int pm, pn, Kuse = K, emode = mode;
          if (ks > 1) {
            const int nlat = 64 * nN;
            if (tt < nlat) { int pm64; tile_map(tt, 64, nN, pm64, pn); pm = (pm64 >> 5) * 33 + 1 + (pm64 & 31); }
            else {
              int u = tt - nlat, kp = u % ks, tile = u / ks;
              pm = (tile / nN) * 33; pn = tile % nN;
              Kuse = K / ks; emode = EM_RESID_AT;
              a64 += (unsigned long long)kp * Kuse * 2; b64 += (unsigned long long)kp * Kuse * 2;
            }
          } else tile_map(tt, NMT, nN, pm, pn);
          Epi e{emode, p.ws, gate, (const float2*)(smem + 131072), nullptr};
          gemm_tile((const u16*)a64, lda, (const u16*)b64, ldb, Kuse, pm * 256, pn * 256, smem, e);
        }
      }
    }
    if (ph + 1 < prm.ph_hi) {
      if (ph == prm.ph_lo) grid.sync();
      else xcd_barrier(xbar);
    }
  }
}

extern "C" void kernel_launch(void* const* d_in, const int* in_sizes, int n_in, void* d_out, int out_size, void* d_ws,
                              size_t ws_size, hipStream_t stream) {
  static int grid_blocks = 0;
  if (grid_blocks == 0) {
    if (n_in != 33 || ws_size < WS_END || (size_t)out_size * 4 < WO_END) {
      fprintf(stderr, "kernel_launch: unexpected sizes n_in=%d ws=%zu (need %zu) out=%d\n", n_in, ws_size, (size_t)WS_END, out_size);
      grid_blocks = -1;
      return;
    }
    int dev = 0, cus = 0, per_cu = 0;
    hipGetDevice(&dev);
    hipDeviceGetAttribute(&cus, hipDeviceAttributeMultiprocessorCount, dev);
    hipOccupancyMaxActiveBlocksPerMultiprocessor(&per_cu, mega, NT, 0);
    if (per_cu < 1) per_cu = 1;
    if (per_cu > 1) per_cu = 1;
    grid_blocks = cus * per_cu;
  }
  if (grid_blocks < 0) return;
  Params p{};
  for (int i = 0; i < 33; ++i) p.in[i] = (const float*)d_in[i];
  p.out = (float*)d_out;
  p.ws = (char*)d_ws;
  p.ph_lo = 0;
  p.ph_hi = NPH;
  (void)hipMemsetAsync((char*)d_ws + WS_BAR, 0, 16384, stream);
  void* args[] = {&p};
  hipError_t e = hipLaunchCooperativeKernel((void*)mega, dim3(grid_blocks), dim3(NT), args, 0, stream);
  if (e != hipSuccess) fprintf(stderr, "cooperative launch failed: %s (grid %d)\n", hipGetErrorString(e), grid_blocks);
}
```

```cpp
#include <hip/hip_runtime.h>
#include <hip/hip_cooperative_groups.h>
#include <cstdio>
namespace cg = cooperative_groups;

typedef unsigned short u16;
using bf16x8 = __attribute__((ext_vector_type(8))) short;
using f32x4 = __attribute__((ext_vector_type(4))) float;
using f32x16 = __attribute__((ext_vector_type(16))) float;

constexpr int D = 1024, SEQ = 8192, CTX = 256, SP = 8448, MROWS = 16896, NMT = 66;
constexpr int DIN = 5792, DINP = 5888, DFF = 4096;
constexpr int OFF_HY = 512, OFF_Q = 2048, OFF_KV = 2432, OFF_GATE = 2720;
constexpr int NT = 512;
constexpr float EPS = 1e-6f;

constexpr size_t WS_H = 0;
constexpr size_t WS_PROJ = WS_H + (size_t)MROWS * D * 4;
constexpr size_t WS_U = WS_PROJ + (size_t)MROWS * DINP * 2;
constexpr size_t WS_Y = WS_U + (size_t)MROWS * 512 * 2;
constexpr size_t WS_O = WS_Y + (size_t)MROWS * 512 * 2;
constexpr size_t WS_Q = WS_O + (size_t)MROWS * 512 * 2;
constexpr size_t WS_K = WS_Q + (size_t)16 * SP * 96 * 2;
constexpr size_t WS_VT = WS_K + (size_t)16 * SP * 96 * 2;
constexpr size_t WS_ZV = WS_VT + (size_t)16 * 64 * SP * 2;
constexpr size_t WS_HID2 = WS_ZV + (size_t)512 * SP * 8;
constexpr size_t WS_HID2C = WS_HID2 + (size_t)4 * 8192 * 64 * 4;
constexpr size_t WS_MOD = WS_HID2C + (size_t)4 * 256 * 64 * 4;
constexpr size_t WS_ROPE = WS_MOD + (size_t)4 * 3 * 6144 * 4;
constexpr size_t WS_TW = WS_ROPE + (size_t)128 * 8 * 8;
constexpr size_t WS_WPE = WS_TW + (size_t)16384 * 8;
constexpr size_t WS_BAR = WS_WPE + (size_t)4 * 1024 * 512 * 2;
constexpr size_t WS_END = WS_BAR + 16384;
constexpr size_t WO_IN = 0;
constexpr size_t WO_FF1 = WO_IN + (size_t)DINP * 1024 * 2;
constexpr size_t WO_FF2 = WO_FF1 + (size_t)4096 * 1024 * 2;
constexpr size_t WO_OUT = WO_FF2 + (size_t)4096 * 1024 * 2;
constexpr size_t WO_HY = WO_OUT + (size_t)1024 * 1024 * 2;
constexpr size_t WO_WO = WO_HY + (size_t)1024 * 512 * 2;
constexpr size_t WO_PE = WO_WO + (size_t)1024 * 512 * 2;
constexpr size_t WO_UQ = WO_PE + (size_t)1024 * 512 * 2;
constexpr size_t WO_UKV = WO_UQ + (size_t)768 * 384 * 2;
constexpr size_t WO_FILT = WO_UKV + (size_t)1024 * 256 * 2;
constexpr size_t WO_END = WO_FILT + (size_t)1024 * 8192 * 2;
constexpr size_t WS_W3T = WS_HID2 + (size_t)4 * 8192 * 64 * 2;

constexpr int AUX_OFF = 147456;
constexpr int LDS_BYTES = AUX_OFF + 8192;

struct Params {
  const float* in[33];
  float* out;
  char* ws;
  int ph_lo, ph_hi;
};

struct Ctx { const unsigned long long* intab; char* ws; float* out; };
__device__ __forceinline__ const float* pin(const Ctx& c, int i) {
  unsigned long long v = c.intab[i];
  unsigned lo = __builtin_amdgcn_readfirstlane((unsigned)v), hi = __builtin_amdgcn_readfirstlane((unsigned)(v >> 32));
  return (const float*)(((unsigned long long)hi << 32) | lo);
}

typedef __bf16 hwbf2 __attribute__((ext_vector_type(2)));
typedef float hwf2 __attribute__((ext_vector_type(2)));
__device__ __forceinline__ unsigned pk2(float a, float b) {
  hwf2 v = {a, b};
  hwbf2 r = __builtin_convertvector(v, hwbf2);
  return __builtin_bit_cast(unsigned, r);
}
__device__ __forceinline__ u16 f2bf(float f) { return (u16)(pk2(f, 0.f) & 0xffffu); }
__device__ __forceinline__ float bf2f(u16 b) { return __uint_as_float(((unsigned)b) << 16); }
__device__ __forceinline__ float shx(float v, int o) {
  int l = __builtin_amdgcn_mbcnt_hi(~0u, __builtin_amdgcn_mbcnt_lo(~0u, 0u));
  asm volatile("" : "+v"(l));
  return __int_as_float(__builtin_amdgcn_ds_bpermute((l ^ o) << 2, __float_as_int(v)));
}
__device__ __forceinline__ float wave_sum(float v) {
#pragma unroll
  for (int o = 1; o < 64; o <<= 1) v += shx(v, o);
  return v;
}
__device__ __forceinline__ int grp_of_row(int m) {
  int tile = m >> 8, b = tile / 33, t33 = tile - b * 33;
  return t33 == 0 ? 2 : b;
}
__device__ __forceinline__ float2 cmul(float2 a, float2 b) { return make_float2(a.x * b.x - a.y * b.y, a.x * b.y + a.y * b.x); }

__device__ __forceinline__ int tid_l() { int t = threadIdx.x; asm volatile("" : "+v"(t)); return t; }
#define XB_TMO      128
#define XB_XCNT(j)  (256  + 64 * (j))
#define XB_XSUB(j)  (1280 + 64 * (j))
#define XB_XGEN(j)  (2304 + 64 * (j))
#define XB_TOP      3328
#define XB_TOPGEN   3392
#define XCD_BAR_WORDS 3456
#define XB_SPIN_CAP (1u << 18)
#define LAS __attribute__((address_space(3)))
__device__ __forceinline__ unsigned xb_ld(unsigned* p)              { return __hip_atomic_load(p, __ATOMIC_RELAXED, __HIP_MEMORY_SCOPE_AGENT); }
__device__ __forceinline__ unsigned xb_add(unsigned* p, unsigned v) { return __hip_atomic_fetch_add(p, v, __ATOMIC_RELAXED, __HIP_MEMORY_SCOPE_AGENT); }
__device__ __forceinline__ unsigned xb_xcc_id() { return (unsigned)__builtin_amdgcn_s_getreg((3 << 11) | 20) & 0xFu; }
#define XB_SPIN(cond, bar) do { unsigned _sp = 0; while (cond) { __builtin_amdgcn_s_sleep(1); \
    if ((++_sp & 255u) == 0u) { if (xb_ld(&(bar)[XB_TMO])) break; if (_sp > XB_SPIN_CAP) { atomicAdd(&(bar)[XB_TMO], 1u); break; } } } } while (0)
struct XcdBarrier { unsigned* bar; unsigned x; volatile LAS unsigned* st; };
__device__ __forceinline__ XcdBarrier xcd_barrier_post(unsigned* bar, volatile LAS unsigned* st) {
    XcdBarrier b; b.bar = bar; b.x = xb_xcc_id(); b.st = st;
    if (threadIdx.x == 0) (void)xb_add(&bar[XB_XCNT(b.x)], 1u);
    return b;
}
__device__ __forceinline__ void xcd_barrier_complete(unsigned* bar, unsigned x, unsigned& nloc, unsigned& nx) {
    const unsigned G = gridDim.x * gridDim.y * gridDim.z;
    unsigned sum, cnt, mine, sp = 0u;
    for (;;) {
        sum = 0u; cnt = 0u; mine = 0u;
#pragma unroll
        for (unsigned j = 0; j < 16; ++j) { const unsigned c = xb_ld(&bar[XB_XCNT(j)]); sum += c; cnt += (c > 0u) ? 1u : 0u; mine = (j == x) ? c : mine; }
        if (sum == G) break;
        __builtin_amdgcn_s_sleep(1);
        if ((++sp & 255u) == 0u) { if (xb_ld(&bar[XB_TMO])) break; if (sp > XB_SPIN_CAP) { atomicAdd(&bar[XB_TMO], 1u); break; } }
    }
    nloc = mine > 0u ? mine : 1u; nx = cnt > 0u ? cnt : 1u;
}
__device__ __forceinline__ void xcd_barrier(const XcdBarrier& b) {
    asm volatile("s_waitcnt vmcnt(0)" ::: "memory");
    __syncthreads();
    if (threadIdx.x == 0) {
        unsigned* bar = b.bar;
        __builtin_amdgcn_s_waitcnt(0);
        unsigned nloc = b.st[0], nx = b.st[1];
        if (nloc == 0u) { xcd_barrier_complete(bar, b.x, nloc, nx); b.st[0] = nloc; b.st[1] = nx; }
        const unsigned old = xb_add(&bar[XB_XSUB(b.x)], 1u);
        const unsigned gen = old / nloc;
        if (old + 1u == (gen + 1u) * nloc) {
            __builtin_amdgcn_fence(__ATOMIC_RELEASE, "agent");
            asm volatile("s_waitcnt vmcnt(0)" ::: "memory");
            const unsigned og = xb_add(&bar[XB_TOP], 1u);
            const unsigned tg = og / nx;
            if (og + 1u == (tg + 1u) * nx) xb_add(&bar[XB_TOPGEN], 1u);
            else XB_SPIN(xb_ld(&bar[XB_TOPGEN]) == tg, bar);
            __builtin_amdgcn_fence(__ATOMIC_ACQUIRE, "agent");
            xb_add(&bar[XB_XGEN(b.x)], 1u);
            asm volatile("s_waitcnt vmcnt(0)" ::: "memory");
        } else {
            XB_SPIN(xb_ld(&bar[XB_XGEN(b.x)]) == gen, bar);
            __builtin_amdgcn_fence(__ATOMIC_ACQUIRE, "agent");
            asm volatile("s_waitcnt vmcnt(0)" ::: "memory");
        }
    }
    __syncthreads();
}

__device__ __forceinline__ void grid_barrier(unsigned* bar, unsigned target) {
  asm volatile("s_waitcnt vmcnt(0)" ::: "memory");
  __syncthreads();
  if (threadIdx.x == 0) {
    __builtin_amdgcn_fence(__ATOMIC_RELEASE, "agent");
    asm volatile("s_waitcnt vmcnt(0)" ::: "memory");
    __hip_atomic_fetch_add(bar, 1u, __ATOMIC_RELAXED, __HIP_MEMORY_SCOPE_AGENT);
    while (__hip_atomic_load(bar, __ATOMIC_RELAXED, __HIP_MEMORY_SCOPE_AGENT) < target) __builtin_amdgcn_s_sleep(2);
    __builtin_amdgcn_fence(__ATOMIC_ACQUIRE, "agent");
    asm volatile("s_waitcnt vmcnt(0)" ::: "memory");
  }
  __syncthreads();
}
#define WAIT_V(n) asm volatile("s_waitcnt vmcnt(%0)" ::"n"(n) : "memory")
#define SCHED() __builtin_amdgcn_sched_barrier(0)
#define RAW_BARRIER() do { asm volatile("s_waitcnt lgkmcnt(0)" ::: "memory"); __builtin_amdgcn_s_barrier(); } while (0)

constexpr float QSCALE = 0.10206207261596575f * 1.4426950408889634f;
enum { EM_PROJ = 0, EM_SQRELU = 1, EM_RESID = 2, EM_RESID_AT = 3, EM_FILT = 4, EM_Q = 6, EM_KV = 7 };
struct Epi {
  int mode;
  char* ws;
  const float* gate;
  const float2* rope_lds;
  u16* filt_out;
  __device__ __forceinline__ void proj(int row, int col, f32x4 v) const {
    {
      u16* out = (u16*)(ws + WS_PROJ);
#pragma unroll
      for (int j = 0; j < 4; ++j) out[(size_t)(row + j) * DINP + col] = f2bf(v[j]);
    }
  }
  __device__ __forceinline__ void sqrelu(int row, int col, f32x4 v) const {
    {
      u16* out = (u16*)(ws + WS_PROJ);
#pragma unroll
      for (int j = 0; j < 4; ++j) { float r = fmaxf(v[j], 0.f); out[(size_t)(row + j) * DFF + col] = f2bf(r * r); }
    }
  }
  __device__ __forceinline__ void resid(int row, int col, f32x4 v) const {
    {
      float* h = (float*)(ws + WS_H);
      float g = gate[grp_of_row(row) * 6144 + col];
#pragma unroll
      for (int j = 0; j < 4; ++j) unsafeAtomicAdd(h + (size_t)(row + j) * D + col, g * v[j]);
    }
  }
  __device__ __forceinline__ void filt(int row, int col, f32x4 v) const {
    uint2 o;
    o.x = pk2(v[0], v[1]);
    o.y = pk2(v[2], v[3]);
    *(uint2*)(filt_out + (size_t)col * 8192 + row) = o;
  }
  __device__ __forceinline__ void q(int row, int col, f32x4 v) const {
    {
      u16* Q = (u16*)(ws + WS_Q);
      const float2* rope = rope_lds;
      int head = col / 96, d = col - head * 96;
      int b = row / SP, pos0 = row - b * SP;
      bool isrope = (d >= 64) && (pos0 >= CTX);
      int rd = d - 64;
#pragma unroll
      for (int j = 0; j < 4; ++j) {
        float val = v[j];
        float partner = shx(val, 8);
        int pos = pos0 + j;
        if (isrope) {
          int t = pos - CTX, idx = (rd < 16) ? (t >> 6) : (t & 63);
          float2 cs = rope[idx * 8 + (rd & 7)];
          float sgn = (rd & 8) ? 1.f : -1.f;
          val = val * cs.x + sgn * partner * cs.y;
        }
        Q[((size_t)(b * 8 + head) * SP + pos) * 96 + d] = f2bf(val * QSCALE);
      }
    }
  }
  __device__ __forceinline__ void kv(int row, int col, f32x4 v) const {
    {
      u16* Kb = (u16*)(ws + WS_K);
      u16* Vt = (u16*)(ws + WS_VT);
      int head = col >> 7, j2 = col & 127;
      int b = row / SP, pos0 = row - b * SP;
      if (j2 < 64) {
#pragma unroll
        for (int j = 0; j < 4; ++j) Kb[((size_t)(b * 8 + head) * SP + pos0 + j) * 96 + j2] = f2bf(v[j]);
      } else {
        uint2 o;
        o.x = pk2(v[0], v[1]);
        o.y = pk2(v[2], v[3]);
        *(uint2*)(Vt + ((size_t)(b * 8 + head) * 64 + (j2 - 64)) * SP + pos0) = o;
      }
    }
  }
};
struct GD { const u16* A; int lda; const u16* Bt; int ldb; int K; int nN; int mode; int ks; };

constexpr int G_TILE_B = 256 * 64 * 2, G_STAGE_B = 2 * G_TILE_B;
__device__ __forceinline__ int lds_byte(int r, int c) {
  int st = (r >> 4) * 2 + (c >> 5), ob = (r & 15) * 64 + (c & 31) * 2;
  return st * 1024 + (ob ^ (((ob >> 9) & 1) << 5));
}
__device__ __forceinline__ void stage_rc(int b, int& R, int& C) {
  int st = b >> 10, sb = b & 1023, swz = sb ^ (((sb >> 9) & 1) << 5);
  R = (st / 2) * 16 + swz / 64;
  C = (st % 2) * 32 + (swz % 64) / 2;
}

template <int MI>
__device__ __forceinline__ void gemm_core(const u16* __restrict__ A, int lda, const u16* __restrict__ Bt, int ldb, int K,
                                          int brow, int bcol, char* shm, f32x4 (&acc)[MI][4]) {
  constexpr int TILE_A = MI * 32 * 64 * 2, TILE_BB = 256 * 64 * 2, STAGE = TILE_A + TILE_BB;
  const int tid = tid_l(), wid = tid >> 6, lane = tid & 63, wr = wid >> 2, wc = wid & 3, fr = lane & 15, fq = lane >> 4;
  const u16* Ab = A + (size_t)brow * lda;
  const u16* Bb = Bt + (size_t)bcol * ldb;
  int sR[4], sC[4];
#pragma unroll
  for (int i = 0; i < 4; ++i) stage_rc(wid * 1024 + i * 8192 + lane * 16, sR[i], sC[i]);
#define SA(b) (shm + (b) * STAGE)
#define SB(b) (shm + (b) * STAGE + TILE_A)
#define GLDS_STAGE(buf, kt)                                                                                              \
  do {                                                                                                                   \
    _Pragma("unroll") for (int i = 0; i < 4; ++i) {                                                                      \
      if (i < MI / 2)                                                                                                    \
        __builtin_amdgcn_global_load_lds((const unsigned*)(Ab + (size_t)sR[i] * lda + (kt) * 64 + sC[i]),                \
                                         (unsigned*)(SA(buf) + wid * 1024 + i * 8192), 16, 0, 0);                        \
      __builtin_amdgcn_global_load_lds((const unsigned*)(Bb + (size_t)sR[i] * ldb + (kt) * 64 + sC[i]),                  \
                                       (unsigned*)(SB(buf) + wid * 1024 + i * 8192), 16, 0, 0);                          \
    }                                                                                                                    \
  } while (0)
  const int nt = K / 64;
  GLDS_STAGE(0, 0);
  WAIT_V(0);
  __syncthreads();
  for (int t = 0; t < nt; ++t) {
    const int cur = t & 1;
    if (t + 1 < nt) GLDS_STAGE(cur ^ 1, t + 1);
#pragma unroll
    for (int ks = 0; ks < 2; ++ks) {
      bf16x8 At[MI], Bf[4];
#pragma unroll
      for (int m = 0; m < MI; ++m) At[m] = *(const bf16x8*)(SA(cur) + lds_byte(wr * (MI * 16) + m * 16 + fr, ks * 32 + fq * 8));
#pragma unroll
      for (int n = 0; n < 4; ++n) Bf[n] = *(const bf16x8*)(SB(cur) + lds_byte(wc * 64 + n * 16 + fr, ks * 32 + fq * 8));
#pragma unroll
      for (int m = 0; m < MI; ++m)
#pragma unroll
        for (int n = 0; n < 4; ++n) acc[m][n] = __builtin_amdgcn_mfma_f32_16x16x32_bf16(At[m], Bf[n], acc[m][n], 0, 0, 0);
      SCHED();
    }
    WAIT_V(0);
    __syncthreads();
  }
#undef SA
#undef SB
#undef GLDS_STAGE
}

template <class EpiT>
__device__ __forceinline__ void gemm_tile(const u16* __restrict__ A, int lda, const u16* __restrict__ Bt, int ldb, int K,
                                          int brow, int bcol, char* shm, const EpiT& epi) {
  const int tid = tid_l(), wid = tid >> 6, lane = tid & 63, wr = wid >> 2, wc = wid & 3, fr = lane & 15, fq = lane >> 4;
  f32x4 acc[8][4];
#pragma unroll
  for (int m = 0; m < 8; ++m)
#pragma unroll
    for (int n = 0; n < 4; ++n) acc[m][n] = (f32x4){0.f, 0.f, 0.f, 0.f};
  gemm_core<8>(A, lda, Bt, ldb, K, brow, bcol, shm, acc);
#define EPI_LOOP(CALL)                                                                              \
  _Pragma("unroll") for (int m = 0; m < 8; ++m) _Pragma("unroll") for (int n = 0; n < 4; ++n) {      \
    const int row = brow + wr * 128 + m * 16 + fq * 4, col = bcol + wc * 64 + n * 16 + fr;           \
    const f32x4 v = acc[m][n];                                                                        \
    CALL;                                                                                             \
  }
  if (epi.mode == EM_PROJ) { EPI_LOOP(epi.proj(row, col, v)) }
  else if (epi.mode == EM_SQRELU) { EPI_LOOP(epi.sqrelu(row, col, v)) }
  else if (epi.mode == EM_RESID_AT) { EPI_LOOP(epi.resid(row, col, v)) }
  else if (epi.mode == EM_RESID) {
    float* h = (float*)(epi.ws + WS_H);
    float g4[4];
#pragma unroll
    for (int n = 0; n < 4; ++n) g4[n] = epi.gate[grp_of_row(brow) * 6144 + bcol + wc * 64 + n * 16 + fr];
    float hv[8][4][4];
    float* hp0 = h + (size_t)(brow + wr * 128 + fq * 4) * D + bcol + wc * 64 + fr;
#define H_LOAD(m) _Pragma("unroll") for (int n = 0; n < 4; ++n) _Pragma("unroll") for (int j = 0; j < 4; ++j) hv[m][n][j] = hp0[(size_t)((m) * 16 + j) * D + n * 16]
#define H_STORE(m) _Pragma("unroll") for (int n = 0; n < 4; ++n) _Pragma("unroll") for (int j = 0; j < 4; ++j) hp0[(size_t)((m) * 16 + j) * D + n * 16] = hv[m][n][j] + g4[n] * acc[m][n][j]
    H_LOAD(0); H_LOAD(1);
    SCHED();
    H_STORE(0); H_LOAD(2); SCHED();
    H_STORE(1); H_LOAD(3); SCHED();
    H_STORE(2); H_LOAD(4); SCHED();
    H_STORE(3); H_LOAD(5); SCHED();
    H_STORE(4); H_LOAD(6); SCHED();
    H_STORE(5); H_LOAD(7); SCHED();
    H_STORE(6); H_STORE(7);
#undef H_LOAD
#undef H_STORE
  }
  else if (epi.mode == EM_FILT) { EPI_LOOP(epi.filt(row, col, v)) }
  else if (epi.mode == EM_Q) { EPI_LOOP(epi.q(row, col, v)) }
  else { EPI_LOOP(epi.kv(row, col, v)) }
#undef EPI_LOOP
}

template <int MI>
__device__ __forceinline__ void mix_tile(const Ctx& p, int l, int brow, int pn, char* shm) {
  constexpr int TILE_A = MI * 32 * 64 * 2, TILE_BB = 256 * 64 * 2, STAGE = TILE_A + TILE_BB, WROWS = MI * 16;
  const int tid = tid_l(), wid = tid >> 6, lane = tid & 63, wr = wid >> 2, wc = wid & 3, fr = lane & 15, fq = lane >> 4;
  const int bcol = pn * 256;
  const u16* projb = (const u16*)(p.ws + WS_PROJ);
  char* wo = (char*)p.out;
#define SA(b) (shm + (b) * STAGE)
#define SB(b) (shm + (b) * STAGE + TILE_A)
#define MIX_STAGE(buf, kt)                                                                                               \
  do {                                                                                                                   \
    const int br_ = (kt) >> 3, ko_ = ((kt) & 7) * 64;                                                                    \
    const u16* Ab_ = (const u16*)(p.ws + (br_ == 0 ? WS_U : br_ == 1 ? WS_Y : WS_O)) + (size_t)brow * 512 + ko_;         \
    const u16* Bb_ = (br_ == 0 ? (const u16*)(p.ws + WS_WPE) + (size_t)l * 1024 * 512 : (const u16*)(wo + (br_ == 1 ? WO_HY : WO_WO))) + (size_t)bcol * 512 + ko_;        \
    _Pragma("unroll") for (int i = 0; i < 4; ++i) {                                                                      \
      int sR_, sC_; stage_rc(wid * 1024 + i * 8192 + lane * 16, sR_, sC_);                                              \
      if (i < MI / 2)                                                                                                    \
        __builtin_amdgcn_global_load_lds((const unsigned*)(Ab_ + sR_ * 512 + sC_),                           \
                                         (unsigned*)(SA(buf) + wid * 1024 + i * 8192), 16, 0, 0);                        \
      __builtin_amdgcn_global_load_lds((const unsigned*)(Bb_ + sR_ * 512 + sC_),                             \
                                       (unsigned*)(SB(buf) + wid * 1024 + i * 8192), 16, 0, 0);                          \
    }                                                                                                                    \
  } while (0)
  f32x4 tot[MI][4], acc[MI][4];
#pragma unroll
  for (int m = 0; m < MI; ++m)
#pragma unroll
    for (int n = 0; n < 4; ++n) { tot[m][n] = (f32x4){0.f, 0.f, 0.f, 0.f}; acc[m][n] = (f32x4){0.f, 0.f, 0.f, 0.f}; }
  MIX_STAGE(0, 0);
  MIX_STAGE(1, 1);
  WAIT_V(6);
  RAW_BARRIER();
  int cur = 0;
#pragma unroll 1
  for (int br = 0; br < 3; ++br) {
    unsigned gpk[MI][4][2];
    const u16* gp = projb + (size_t)(brow + wr * WROWS + fq * 4) * DINP + OFF_GATE + br * 1024 + bcol + wc * 64 + fr;
#define GATE_LOAD(m)                                                                                   \
    _Pragma("unroll") for (int n = 0; n < 4; ++n) _Pragma("unroll") for (int j2 = 0; j2 < 2; ++j2) {       \
      unsigned lo = gp[(size_t)((m) * 16 + 2 * j2) * DINP + n * 16], hi = gp[(size_t)((m) * 16 + 2 * j2 + 1) * DINP + n * 16]; \
      gpk[m][n][j2] = lo | (hi << 16);                                                                     \
    }
    GATE_LOAD(0); GATE_LOAD(1);
    if (MI == 4) { GATE_LOAD(2); }
#pragma unroll 1
    for (int kk = 0; kk < 8; ++kk) {
      const int t = br * 8 + kk;
      { int nx = cur + 2; if (nx >= 3) nx -= 3; if (t + 2 < 24) MIX_STAGE(nx, t + 2); }
#pragma unroll
      for (int ks = 0; ks < 2; ++ks) {
        bf16x8 At[2], Bf[4];
#pragma unroll
        for (int n = 0; n < 4; ++n) Bf[n] = *(const bf16x8*)(SB(cur) + lds_byte(wc * 64 + n * 16 + fr, ks * 32 + fq * 8));
#pragma unroll
        for (int mh = 0; mh < MI / 2; ++mh) {
#pragma unroll
          for (int m = 0; m < 2; ++m) At[m] = *(const bf16x8*)(SA(cur) + lds_byte(wr * WROWS + (mh * 2 + m) * 16 + fr, ks * 32 + fq * 8));
#pragma unroll
          for (int m = 0; m < 2; ++m)
#pragma unroll
            for (int n = 0; n < 4; ++n) acc[mh * 2 + m][n] = __builtin_amdgcn_mfma_f32_16x16x32_bf16(At[m], Bf[n], acc[mh * 2 + m][n], 0, 0, 0);
          SCHED();
        }
      }
      if (t + 2 < 24) WAIT_V(6); else WAIT_V(0);
      RAW_BARRIER();
      cur = (cur == 2) ? 0 : cur + 1;
    }
    if (MI == 4) { GATE_LOAD(3); }
#undef GATE_LOAD
#pragma unroll
    for (int m = 0; m < MI; ++m)
#pragma unroll
      for (int n = 0; n < 4; ++n)
#pragma unroll
        for (int j = 0; j < 4; ++j) {
          const unsigned w = gpk[m][n][j >> 1];
          const float gv = __uint_as_float((j & 1) ? (w & 0xffff0000u) : (w << 16));
          tot[m][n][j] += acc[m][n][j] / (1.f + __expf(-gv));
          acc[m][n][j] = 0.f;
        }
  }
  u16* mixb = (u16*)(p.ws + WS_ZV);
#pragma unroll
  for (int m = 0; m < MI; ++m)
#pragma unroll
    for (int n = 0; n < 4; ++n)
#pragma unroll
      for (int j = 0; j < 4; ++j)
        mixb[(size_t)(brow + wr * WROWS + m * 16 + fq * 4 + j) * D + bcol + wc * 64 + n * 16 + fr] = f2bf(tot[m][n][j]);
#undef SA
#undef SB
#undef MIX_STAGE
}

__device__ __forceinline__ void tile_map(int t, int nM, int nN, int& pm, int& pn) {
  int nwg = nM * nN, wgid = t;
  {
    int q = nwg / 8, r = nwg % 8, xcd = wgid % 8, off = wgid / 8;
    wgid = (xcd < r ? xcd * (q + 1) : r * (q + 1) + (xcd - r) * q) + off;
  }
  constexpr int WGM = 4;
  int nig = WGM * nN, gid = wgid / nig, fm = gid * WGM, gsz = min(nM - fm, WGM);
  pm = fm + ((wgid % nig) % gsz);
  pn = (wgid % nig) / gsz;
}

__device__ __forceinline__ void p0_misc(const Ctx& p) {
  const int gtid = blockIdx.x * NT + tid_l(), gn = gridDim.x * NT;
  float4* h4 = (float4*)(p.ws + WS_H);
  const float4* x4 = (const float4*)pin(p, 0);
  const float4* c4 = (const float4*)pin(p, 2);
#pragma unroll 8
  for (int i = gtid; i < MROWS * 256; i += gn) {
    int m = i >> 8, q = i & 255, b = m / SP, pos = m - b * SP;
    float4 v = (pos < CTX) ? c4[(size_t)(b * CTX + pos) * 256 + q] : x4[(size_t)(b * SEQ + pos - CTX) * 256 + q];
    h4[i] = v;
  }
  float2* rope = (float2*)(p.ws + WS_ROPE);
  for (int i = gtid; i < 1024; i += gn) {
    int idx = i >> 3, f = i & 7;
    float inv = powf(10000.f, -(float)f / 8.f);
    float a = (float)idx * inv;
    rope[i] = make_float2(cosf(a), sinf(a));
  }
  {
    u16* w3t = (u16*)(p.ws + WS_W3T);
    const float* w3 = pin(p, 20);
    for (int i = gtid; i < 4 * 1024 * 64; i += gn) { int l = i >> 16, c2 = (i >> 6) & 1023, k = i & 63; w3t[i] = f2bf(w3[((size_t)l * 64 + k) * 1024 + c2]); }
  }
  float2* tw = (float2*)(p.ws + WS_TW);
  for (int i = gtid; i < 16384; i += gn) {
    float s, c;
    sincospif(-(float)i / 8192.f, &s, &c);
    tw[i] = make_float2(c, s);
  }
}

__device__ __forceinline__ void p0_mod_task(const Ctx& p, int task, char* smem) {
  float* s = (float*)smem;
  float* red = s + 3072;
  const int tid = tid_l();
  const int l = task / 48, chunk = task - l * 48;
  for (int i = tid; i < 3072; i += NT) {
    int g = i >> 10, k = i & 1023;
    float cv = (g < 2) ? pin(p, 1)[g * 1024 + k] : pin(p, 3)[k];
    s[i] = cv / (1.f + __expf(-cv));
  }
  __syncthreads();
  const int kq = tid >> 7, col = tid & 127, n = chunk * 128 + col;
  const float* W = pin(p, 4) + (size_t)l * 1024 * 6144 + n;
  float a0 = 0.f, a1 = 0.f, a2 = 0.f;
#pragma unroll 32
  for (int k = kq * 256; k < kq * 256 + 256; ++k) {
    float w = W[(size_t)k * 6144];
    a0 += s[k] * w; a1 += s[1024 + k] * w; a2 += s[2048 + k] * w;
  }
  red[(kq * 3 + 0) * 128 + col] = a0;
  red[(kq * 3 + 1) * 128 + col] = a1;
  red[(kq * 3 + 2) * 128 + col] = a2;
  __syncthreads();
  if (tid < 384) {
    int g = tid >> 7, c2 = tid & 127, n2 = chunk * 128 + c2;
    float v = red[(0 * 3 + g) * 128 + c2] + red[(1 * 3 + g) * 128 + c2] + red[(2 * 3 + g) * 128 + c2] + red[(3 * 3 + g) * 128 + c2];
    ((float*)(p.ws + WS_MOD))[(size_t)(l * 3 + g) * 6144 + n2] = v + pin(p, 5)[l * 6144 + n2];
  }
  __syncthreads();
}

__device__ __forceinline__ void p0_hid_task(const Ctx& p, int task, char* smem) {
  float* zs = (float*)smem;
  float* h1 = zs + 8 * 36;
  float* w1s = h1 + 8 * 64;
  float* w2s = w1s + 33 * 64;
  const int tid = tid_l(), tl = tid >> 6, j = tid & 63;
  const int l = task / 132, r = task - l * 132;
  const bool isctx = r >= 128;
  const int L = isctx ? 256 : 8192;
  const int tbase = (isctx ? (r - 128) : r) * 64;
  for (int i = tid; i < 33 * 64; i += NT) w1s[i] = pin(p, 14)[l * 33 * 64 + i];
  for (int i = tid; i < 64 * 64; i += NT) w2s[i] = pin(p, 17)[l * 64 * 64 + i];
  const float b1 = pin(p, 15)[l * 64 + j], f1 = pin(p, 16)[l * 64 + j], b2 = pin(p, 18)[l * 64 + j], f2 = pin(p, 19)[l * 64 + j];
  __syncthreads();
  for (int sub = 0; sub < 8; ++sub) {
    const int t = tbase + sub * 8 + tl;
    if (j < 33) {
      float z;
      if (j == 0) z = (float)t / (float)(L - 1);
      else {
        int i = (j - 1) & 15;
        float band = 1e-4f + (float)i * ((15.f - 1e-4f) / 15.f);
        float omega = 6.2831855f * (float)t / (float)L;
        float a = omega * band;
        z = (j <= 16) ? cosf(a) : -sinf(a);
      }
      zs[tl * 36 + j] = z;
    }
    __syncthreads();
    {
      float a = b1;
#pragma unroll
      for (int k = 0; k < 33; ++k) a += zs[tl * 36 + k] * w1s[k * 64 + j];
      h1[tl * 64 + j] = sinf(f1 * a);
    }
    __syncthreads();
    {
      float a = b2;
#pragma unroll 16
      for (int k = 0; k < 64; ++k) a += h1[tl * 64 + k] * w2s[k * 64 + j];
      float v = sinf(f2 * a);
      if (isctx) ((float*)(p.ws + WS_HID2C))[((size_t)l * 64 + j) * 256 + t] = v;
      else ((u16*)(p.ws + WS_HID2))[((size_t)l * 8192 + t) * 64 + j] = f2bf(v);
    }
  }
  __syncthreads();
}

struct WtItem { const float* W; u16* WT; int K, N, k0, n0; };
__device__ __forceinline__ WtItem wt_decode(const Ctx& p, int l, int r) {
  char* wo = (char*)p.out;
  WtItem it;
  int nblk;
  if (r < 1472) { it.W = pin(p, 8) + (size_t)l * 1024 * DIN; it.K = 1024; it.N = DIN; it.WT = (u16*)(wo + WO_IN); nblk = 92; }
  else if ((r -= 1472) < 1024) { it.W = pin(p, 30) + (size_t)l * 1024 * 4096; it.K = 1024; it.N = 4096; it.WT = (u16*)(wo + WO_FF1); nblk = 64; }
  else if ((r -= 1024) < 1024) { it.W = pin(p, 31) + (size_t)l * 4096 * 1024; it.K = 4096; it.N = 1024; it.WT = (u16*)(wo + WO_FF2); nblk = 16; }
  else if ((r -= 1024) < 256) { it.W = pin(p, 29) + (size_t)l * 1024 * 1024; it.K = 1024; it.N = 1024; it.WT = (u16*)(wo + WO_OUT); nblk = 16; }
  else if ((r -= 256) < 128) { it.W = pin(p, 23) + (size_t)l * 512 * 1024; it.K = 512; it.N = 1024; it.WT = (u16*)(wo + WO_HY); nblk = 16; }
  else if ((r -= 128) < 128) { it.W = pin(p, 28) + (size_t)l * 512 * 1024; it.K = 512; it.N = 1024; it.WT = (u16*)(wo + WO_WO); nblk = 16; }
  else if ((r -= 128) < 72) { it.W = pin(p, 25) + (size_t)l * 384 * 768; it.K = 384; it.N = 768; it.WT = (u16*)(wo + WO_UQ); nblk = 12; }
  else { r -= 72; it.W = pin(p, 27) + (size_t)l * 256 * 1024; it.K = 256; it.N = 1024; it.WT = (u16*)(wo + WO_UKV); nblk = 16; }
  const int kb = r / nblk, nb2 = r - kb * nblk;
  it.k0 = kb * 64; it.n0 = nb2 * 64;
  return it;
}
__device__ __forceinline__ void wt_load(const WtItem& it, int tid, float (&v)[8]) {
  const int nn = tid & 63, kq = tid >> 6;
  const bool ok = it.n0 + nn < it.N;
  const float* src = it.W + (size_t)(it.k0 + kq) * it.N + it.n0 + (ok ? nn : 0);
#pragma unroll
  for (int r = 0; r < 8; ++r) { float x = src[(size_t)(r * 8) * it.N]; v[r] = ok ? x : 0.f; }
}
__device__ __forceinline__ void wt_phase(const Ctx& p, int l, char* smem) {
  float* tile = (float*)smem;
  const int tid = tid_l();
  const int bid = blockIdx.x, nb = gridDim.x;
  int t = bid;
  if (t >= 4168) return;
  WtItem cur = wt_decode(p, l, t);
  float v[8];
  wt_load(cur, tid, v);
#pragma unroll 1
  while (true) {
    const int tn = t + nb;
    const bool more = tn < 4168;
    WtItem nxt = cur;
    float vn[8];
    if (more) { nxt = wt_decode(p, l, tn); wt_load(nxt, tid, vn); }
#pragma unroll
    for (int r = 0; r < 8; ++r) tile[(r * 8 + (tid >> 6)) * 65 + (tid & 63)] = v[r];
    __syncthreads();
    {
      int n = tid >> 3, kc = (tid & 7) * 8;
      uint4 o;
      o.x = pk2(tile[(kc + 0) * 65 + n], tile[(kc + 1) * 65 + n]);
      o.y = pk2(tile[(kc + 2) * 65 + n], tile[(kc + 3) * 65 + n]);
      o.z = pk2(tile[(kc + 4) * 65 + n], tile[(kc + 5) * 65 + n]);
      o.w = pk2(tile[(kc + 6) * 65 + n], tile[(kc + 7) * 65 + n]);
      *(uint4*)(cur.WT + (size_t)(cur.n0 + n) * cur.K + cur.k0 + kc) = o;
    }
    __syncthreads();
    if (!more) break;
    cur = nxt;
#pragma unroll
    for (int r = 0; r < 8; ++r) v[r] = vn[r];
    t = tn;
  }
}

__device__ __forceinline__ void wpe_task(const Ctx& p, int l, int task, char* smem) {
  const int g = task >> 3, c0 = (task & 7) * 16, tid = tid_l();
  const float* pw = pin(p, 9) + ((size_t)(l * 4 + g) * 128) * 128;
  const float* sc = pin(p, 10) + l * 512 + g * 128;
  const float* po = pin(p, 11) + ((size_t)l * 512 + g * 128) * 1024;
  u16* WpeT = (u16*)(p.ws + WS_WPE) + (size_t)l * 1024 * 512;
  float* wl = (float*)smem;
  for (int i = tid; i < 16 * 128; i += NT) { int d = i & 127; wl[i] = pw[(c0 + (i >> 7)) * 128 + d] * sc[d]; }
  __syncthreads();
  float acc0[16], acc1[16];
#pragma unroll
  for (int i = 0; i < 16; ++i) { acc0[i] = 0.f; acc1[i] = 0.f; }
#pragma unroll 16
  for (int d = 0; d < 128; ++d) {
    float p0 = po[(size_t)d * 1024 + tid], p1 = po[(size_t)d * 1024 + 512 + tid];
#pragma unroll
    for (int i = 0; i < 16; ++i) { float w = wl[i * 128 + d]; acc0[i] += w * p0; acc1[i] += w * p1; }
  }
  uint4 o0, o1;
  o0.x = pk2(acc0[0], acc0[1]); o0.y = pk2(acc0[2], acc0[3]); o0.z = pk2(acc0[4], acc0[5]); o0.w = pk2(acc0[6], acc0[7]);
  o1.x = pk2(acc0[8], acc0[9]); o1.y = pk2(acc0[10], acc0[11]); o1.z = pk2(acc0[12], acc0[13]); o1.w = pk2(acc0[14], acc0[15]);
  uint4* dst = (uint4*)(WpeT + (size_t)tid * 512 + g * 128 + c0);
  dst[0] = o0; dst[1] = o1;
  o0.x = pk2(acc1[0], acc1[1]); o0.y = pk2(acc1[2], acc1[3]); o0.z = pk2(acc1[4], acc1[5]); o0.w = pk2(acc1[6], acc1[7]);
  o1.x = pk2(acc1[8], acc1[9]); o1.y = pk2(acc1[10], acc1[11]); o1.z = pk2(acc1[12], acc1[13]); o1.w = pk2(acc1[14], acc1[15]);
  dst = (uint4*)(WpeT + (size_t)(512 + tid) * 512 + g * 128 + c0);
  dst[0] = o0; dst[1] = o1;
  __syncthreads();
}

__device__ __forceinline__ void norm_rows(const Ctx& p, const float* gain, const float* modl, int sh_idx, int sc_idx, u16* outp) {
  const int tidx = tid_l(), lane = tidx & 63, gw = blockIdx.x * 8 + (tidx >> 6), ngw = gridDim.x * 8;
  const float* h = (const float*)(p.ws + WS_H);
  float4 g[4];
#pragma unroll
  for (int j = 0; j < 4; ++j) g[j] = *(const float4*)(gain + lane * 4 + 256 * j);
  for (int m0 = gw; m0 < MROWS; m0 += 2 * ngw) {
    const int m1 = m0 + ngw;
    const bool has1 = m1 < MROWS;
    const int m1c = has1 ? m1 : m0;
    const float4* hr0 = (const float4*)(h + (size_t)m0 * D) + lane;
    const float4* hr1 = (const float4*)(h + (size_t)m1c * D) + lane;
    float4 v0[4], v1[4];
#pragma unroll
    for (int j = 0; j < 4; ++j) { v0[j] = hr0[64 * j]; v1[j] = hr1[64 * j]; }
    const float* mg0 = modl + grp_of_row(m0) * 6144;
    const float* mg1 = modl + grp_of_row(m1c) * 6144;
    float s0 = 0.f, s1 = 0.f;
#pragma unroll
    for (int j = 0; j < 4; ++j) {
      s0 += v0[j].x * v0[j].x + v0[j].y * v0[j].y + v0[j].z * v0[j].z + v0[j].w * v0[j].w;
      s1 += v1[j].x * v1[j].x + v1[j].y * v1[j].y + v1[j].z * v1[j].z + v1[j].w * v1[j].w;
    }
    s0 = wave_sum(s0);
    s1 = wave_sum(s1);
    const float r0 = rsqrtf(s0 * (1.f / D) + EPS), r1 = rsqrtf(s1 * (1.f / D) + EPS);
    uint2* o0 = (uint2*)(outp + (size_t)m0 * D) + lane;
    uint2* o1 = (uint2*)(outp + (size_t)m1c * D) + lane;
#pragma unroll
    for (int j = 0; j < 4; ++j) {
      int n = lane * 4 + 256 * j;
      float4 sc = *(const float4*)(mg0 + sc_idx * 1024 + n), sh = *(const float4*)(mg0 + sh_idx * 1024 + n);
      uint2 o;
      o.x = pk2(v0[j].x * r0 * g[j].x * (1.f + sc.x) + sh.x, v0[j].y * r0 * g[j].y * (1.f + sc.y) + sh.y);
      o.y = pk2(v0[j].z * r0 * g[j].z * (1.f + sc.z) + sh.z, v0[j].w * r0 * g[j].w * (1.f + sc.w) + sh.w);
      o0[64 * j] = o;
    }
    if (has1) {
#pragma unroll
      for (int j = 0; j < 4; ++j) {
        int n = lane * 4 + 256 * j;
        float4 sc = *(const float4*)(mg1 + sc_idx * 1024 + n), sh = *(const float4*)(mg1 + sh_idx * 1024 + n);
        uint2 o;
        o.x = pk2(v1[j].x * r1 * g[j].x * (1.f + sc.x) + sh.x, v1[j].y * r1 * g[j].y * (1.f + sc.y) + sh.y);
        o.y = pk2(v1[j].z * r1 * g[j].z * (1.f + sc.z) + sh.z, v1[j].w * r1 * g[j].w * (1.f + sc.w) + sh.w);
        o1[64 * j] = o;
      }
    }
  }
}

__device__ __forceinline__ void final_norm(const Ctx& p) {
  const int tidx = tid_l(), lane = tidx & 63, gw = blockIdx.x * 8 + (tidx >> 6), ngw = gridDim.x * 8;
  const float* h = (const float*)(p.ws + WS_H);
  const float* gain = pin(p, 32);
  for (int r0 = gw; r0 < 2 * SEQ; r0 += ngw) {
    int b = r0 >> 13, t = r0 & 8191, m = b * SP + CTX + t;
    const float4* hr = (const float4*)(h + (size_t)m * D) + lane;
    float4 v[4];
    float ss = 0.f;
#pragma unroll
    for (int j = 0; j < 4; ++j) { v[j] = hr[64 * j]; ss += v[j].x * v[j].x + v[j].y * v[j].y + v[j].z * v[j].z + v[j].w * v[j].w; }
    ss = wave_sum(ss);
    float r = rsqrtf(ss * (1.f / D) + EPS);
    float4* o = (float4*)(p.out + (size_t)r0 * D) + lane;
#pragma unroll
    for (int j = 0; j < 4; ++j) {
      float4 g = *(const float4*)(gain + lane * 4 + 256 * j);
      o[64 * j] = make_float4(v[j].x * r * g.x, v[j].y * r * g.y, v[j].z * r * g.z, v[j].w * r * g.w);
    }
  }
}

__device__ __forceinline__ void premix_task(const Ctx& p, int l, int task, char* smem) {
  const int tid = tid_l(), lane = tid & 63, wid = tid >> 6;
  const int part = task / 264, tile64 = task - part * 264;
  const int m0 = tile64 * 64, b = m0 / SP, pos0 = m0 - b * SP;
  const bool isctx = pos0 < CTX;
  const int s0 = isctx ? 0 : CTX, L = isctx ? CTX : SEQ, t0 = pos0 - s0;
  const size_t mb = (size_t)b * SP + s0;
  const u16* proj = (const u16*)(p.ws + WS_PROJ);
  if (part == 0) {
    u16* P = (u16*)smem;
#pragma unroll
    for (int i = tid; i < 80 * 64; i += NT) {
      int r = i >> 6, ch = i & 63, t = t0 - 8 + r;
      uint4 v = make_uint4(0, 0, 0, 0);
      if (t >= 0 && t < L) v = *(const uint4*)(proj + (mb + t) * DINP + ch * 8);
      *(uint4*)(P + r * 512 + ch * 8) = v;
    }
    __syncthreads();
    const int c = tid, g = c >> 7, hw = 1 << g;
    u16* U = (u16*)(p.ws + WS_U);
    float s = 0.f;
    for (int q = -hw; q < hw; ++q) s += bf2f(P[(8 + q) * 512 + c]);
#pragma unroll 4
    for (int tt = 0; tt < 64; ++tt) {
      int t = t0 + tt, lo = max(t - hw, 0), hi = min(t + hw, L);
      float u = s / (float)(hi - lo) - bf2f(P[(tt + 8) * 512 + c]);
      U[(mb + t) * 512 + c] = f2bf(u);
      s += bf2f(P[(tt + 8 + hw) * 512 + c]) - bf2f(P[(tt + 8 - hw) * 512 + c]);
    }
    __syncthreads();
  } else if (part <= 4) {
    const int ch0 = (part - 1) * 128;
    constexpr int PITCH = 136;
    u16* X = (u16*)smem;
    float* T = (float*)(smem + 3 * 66 * PITCH * 2 + 64);
#pragma unroll
    for (int ii = 0; ii < 7; ++ii) {
      const int i = tid + ii * NT;
      if (i >= 3 * 66 * 16) break;
      int pr = i / (66 * 16), rem = i - pr * 66 * 16, r = rem >> 4, ch = rem & 15, t = t0 - 1 + r;
      uint4 v = make_uint4(0, 0, 0, 0);
      if (t >= 0 && t < L) v = *(const uint4*)(proj + (mb + t) * DINP + OFF_HY + pr * 512 + ch0 + ch * 8);
      *(uint4*)(X + (pr * 66 + r) * PITCH + ch * 8) = v;
    }
    __syncthreads();
    const float* cw = pin(p, 12) + l * 3 * 1536;
    const float* cb = pin(p, 13) + l * 1536;
    {
      const int c = tid & 127, tq = tid >> 7, col = ch0 + c;
      const float w00 = cw[col], w01 = cw[1536 + col], w02 = cw[3072 + col], b0 = cb[col];
      const float w10 = cw[512 + col], w11 = cw[1536 + 512 + col], w12 = cw[3072 + 512 + col], b1 = cb[512 + col];
      const float w20 = cw[1024 + col], w21 = cw[1536 + 1024 + col], w22 = cw[3072 + 1024 + col], b2 = cb[1024 + col];
      const u16* X0 = X, *X1 = X + 66 * PITCH, *XV = X + 2 * 66 * PITCH;
      u16* Y = (u16*)(p.ws + WS_Y);
#pragma unroll 4
      for (int tt = tq * 16; tt < tq * 16 + 16; ++tt) {
        float x0 = w00 * bf2f(X0[tt * PITCH + c]) + w01 * bf2f(X0[(tt + 1) * PITCH + c]) + w02 * bf2f(X0[(tt + 2) * PITCH + c]) + b0;
        float x1 = w10 * bf2f(X1[tt * PITCH + c]) + w11 * bf2f(X1[(tt + 1) * PITCH + c]) + w12 * bf2f(X1[(tt + 2) * PITCH + c]) + b1;
        float vv = w20 * bf2f(XV[tt * PITCH + c]) + w21 * bf2f(XV[(tt + 1) * PITCH + c]) + w22 * bf2f(XV[(tt + 2) * PITCH + c]) + b2;
        Y[(mb + t0 + tt) * 512 + col] = f2bf(x0);
        T[c * 65 + tt] = x1 * vv;
      }
    }
    __syncthreads();
    {
      float* ZV = (float*)(p.ws + WS_ZV);
#pragma unroll 4
      for (int cc = 0; cc < 16; ++cc) {
        int c = wid * 16 + cc;
        ZV[((size_t)(ch0 + c) * SP + pos0 + lane) * 2 + b] = T[c * 65 + lane];
      }
    }
    __syncthreads();
  } else {
    u16* projw = (u16*)(p.ws + WS_PROJ);
    const float* qg = pin(p, 24) + l * 384;
    const float* kg = pin(p, 26) + l * 256;
    const float2* rope = (const float2*)(p.ws + WS_ROPE);
    u16* Kb = (u16*)(p.ws + WS_K);
#pragma unroll 2
    for (int rr = 0; rr < 8; ++rr) {
      int tt = wid * 8 + rr, pos = pos0 + tt;
      u16* row = projw + ((size_t)b * SP + pos) * DINP;
      unsigned* q32 = (unsigned*)(row + OFF_Q);
      unsigned* k32 = (unsigned*)(row + OFF_KV);
      unsigned v[3], w[2];
      float ss = 0.f, s2 = 0.f;
#pragma unroll
      for (int j = 0; j < 3; ++j) v[j] = q32[lane + 64 * j];
#pragma unroll
      for (int j = 0; j < 2; ++j) w[j] = k32[lane + 64 * j];
      const int rd = lane & 31;
      float val = bf2f(row[OFF_KV + 256 + rd]);
#pragma unroll
      for (int j = 0; j < 3; ++j) { float a = bf2f(v[j] & 0xffff), c2 = bf2f(v[j] >> 16); ss += a * a + c2 * c2; }
#pragma unroll
      for (int j = 0; j < 2; ++j) { float a = bf2f(w[j] & 0xffff), c2 = bf2f(w[j] >> 16); s2 += a * a + c2 * c2; }
      ss = wave_sum(ss);
      s2 = wave_sum(s2);
      float r = rsqrtf(ss * (1.f / 384.f) + EPS), r2 = rsqrtf(s2 * (1.f / 256.f) + EPS);
#pragma unroll
      for (int j = 0; j < 3; ++j) {
        int n = (lane + 64 * j) * 2;
        q32[lane + 64 * j] = pk2(bf2f(v[j] & 0xffff) * r * qg[n], bf2f(v[j] >> 16) * r * qg[n + 1]);
      }
#pragma unroll
      for (int j = 0; j < 2; ++j) {
        int n = (lane + 64 * j) * 2;
        k32[lane + 64 * j] = pk2(bf2f(w[j] & 0xffff) * r2 * kg[n], bf2f(w[j] >> 16) * r2 * kg[n + 1]);
      }
      float partner = shx(val, 8);
      if (!isctx) {
        int t = pos - CTX, idx = (rd < 16) ? (t >> 6) : (t & 63);
        float2 cs = rope[idx * 8 + (rd & 7)];
        float sgn = (rd & 8) ? 1.f : -1.f;
        val = val * cs.x + sgn * partner * cs.y;
      }
      if (lane < 32) {
        u16 o = f2bf(val);
#pragma unroll
        for (int hd = 0; hd < 8; ++hd) Kb[((size_t)(b * 8 + hd) * SP + pos) * 96 + 64 + rd] = o;
      }
    }
  }
}

__device__ __forceinline__ int xi(int i) { const int h = i >> 5; return i ^ (((h & 3) * 5) | ((h & 2) << 3)); }
typedef float v2f __attribute__((ext_vector_type(2)));
__device__ __forceinline__ v2f cmulv(v2f a, v2f b) {
  v2f bs = {-b.y, b.x};
  return a.xx * b + a.yy * bs;
}
__device__ __forceinline__ void bf_fwd(float2* Xf, int base, int q, float2 w1f) {
  v2f* X = (v2f*)Xf;
  const v2f w1 = {w1f.x, w1f.y};
  const v2f w2 = cmulv(w1, w1), w3 = cmulv(w2, w1);
  const int i0 = xi(base), i1 = xi(base + q), i2 = xi(base + 2 * q), i3 = xi(base + 3 * q);
  v2f a0 = X[i0], a1 = X[i1], a2 = X[i2], a3 = X[i3];
  v2f s02 = a0 + a2, d02 = a0 - a2, s13 = a1 + a3, d13 = a1 - a3;
  v2f d13r = {d13.y, -d13.x};
  X[i0] = s02 + s13;
  X[i1] = cmulv(d02 + d13r, w1);
  X[i2] = cmulv(s02 - s13, w2);
  X[i3] = cmulv(d02 - d13r, w3);
}
__device__ __forceinline__ void bf_inv(float2* Xf, int base, int q, float2 w1f) {
  v2f* X = (v2f*)Xf;
  const v2f w1 = {w1f.x, -w1f.y};
  const v2f w2 = cmulv(w1, w1), w3 = cmulv(w2, w1);
  const int i0 = xi(base), i1 = xi(base + q), i2 = xi(base + 2 * q), i3 = xi(base + 3 * q);
  v2f b0 = X[i0], c1 = cmulv(X[i1], w1), c2 = cmulv(X[i2], w2), c3 = cmulv(X[i3], w3);
  v2f s02 = b0 + c2, d02 = b0 - c2, s13 = c1 + c3, d13 = c1 - c3;
  v2f d13r = {-d13.y, d13.x};
  X[i0] = s02 + s13;
  X[i1] = d02 + d13r;
  X[i2] = s02 - s13;
  X[i3] = d02 - d13r;
}
template <bool INV, int LQ>
__device__ __forceinline__ void fft_pass(float2* X, const float2* __restrict__ tw, const float2 (&twr)[6], int tid) {
  constexpr int q = 1 << LQ;
  if (LQ == 12) {
    float2 w[8];
#pragma unroll
    for (int b8 = 0; b8 < 8; ++b8) w[b8] = tw[b8 * NT + tid];
#pragma unroll
    for (int b8 = 0; b8 < 8; ++b8) { int u = b8 * NT + tid; if (INV) bf_inv(X, u, q, w[b8]); else bf_fwd(X, u, q, w[b8]); }
  } else if (LQ == 10) {
#pragma unroll 2
    for (int b8 = 0; b8 < 8; ++b8) {
      int u = b8 * NT + tid, j = u & 1023, base = ((u >> 10) << 12) + j;
      float2 w = (b8 & 1) ? twr[1] : twr[0];
      if (INV) bf_inv(X, base, q, w); else bf_fwd(X, base, q, w);
    }
  } else {
    const int j = tid & (q - 1);
    const float2 w = (LQ == 0) ? make_float2(1.f, 0.f) : twr[2 + (8 - LQ) / 2];
#pragma unroll 2
    for (int b8 = 0; b8 < 8; ++b8) {
      int u = b8 * NT + tid, base = ((u >> LQ) << (LQ + 2)) + j;
      if (INV) bf_inv(X, base, q, w); else bf_fwd(X, base, q, w);
    }
  }
  __syncthreads();
}
__device__ __forceinline__ void fft_load_tw(const float2* __restrict__ tw, int tid, float2 (&twr)[6]) {
  twr[0] = tw[tid << 2];
  twr[1] = tw[(512 + tid) << 2];
  twr[2] = tw[(tid & 255) << 4];
  twr[3] = tw[(tid & 63) << 6];
  twr[4] = tw[(tid & 15) << 8];
  twr[5] = tw[(tid & 3) << 10];
}
__device__ __forceinline__ void fft_dif(float2* X, const float2* __restrict__ tw, const float2 (&twr)[6]) {
  const int tid = tid_l();
  fft_pass<false, 12>(X, tw, twr, tid); fft_pass<false, 10>(X, tw, twr, tid); fft_pass<false, 8>(X, tw, twr, tid); fft_pass<false, 6>(X, tw, twr, tid);
  fft_pass<false, 4>(X, tw, twr, tid); fft_pass<false, 2>(X, tw, twr, tid); fft_pass<false, 0>(X, tw, twr, tid);
}
__device__ __forceinline__ void fft_dit_inv(float2* X, const float2* __restrict__ tw, const float2 (&twr)[6]) {
  const int tid = tid_l();
  fft_pass<true, 0>(X, tw, twr, tid); fft_pass<true, 2>(X, tw, twr, tid); fft_pass<true, 4>(X, tw, twr, tid); fft_pass<true, 6>(X, tw, twr, tid);
  fft_pass<true, 8>(X, tw, twr, tid); fft_pass<true, 10>(X, tw, twr, tid); fft_pass<true, 12>(X, tw, twr, tid);
}
__device__ __forceinline__ float block_sum(float v, float* red) {
  v = wave_sum(v);
  __syncthreads();
  { const int tb = tid_l(); if ((tb & 63) == 0) red[tb >> 6] = v; }
  __syncthreads();
  float s = red[0] + red[1] + red[2] + red[3] + red[4] + red[5] + red[6] + red[7];
  __syncthreads();
  return s;
}

__device__ __forceinline__ void fft_task(const Ctx& p, int l, int c, char* smem) {
  float2* X = (float2*)smem;
  float zl = 0.f;
  asm volatile("" : "+v"(zl));
  float* aux = (float*)(smem + AUX_OFF);
  float* red = aux + 128;
  const int tid = tid_l();
  const float2* tw = (const float2*)(p.ws + WS_TW);
  float2 twr[6];
  fft_load_tw(tw, tid, twr);
  const float* w3 = pin(p, 20) + (size_t)l * 64 * 1024;
  if (tid < 64) { aux[tid] = w3[tid * 1024 + c]; aux[64 + tid] = w3[tid * 1024 + 512 + c]; }
  __syncthreads();
  const float dF = fabsf(pin(p, 21)[(l * 2 + 0) * 512 + c]), dB = fabsf(pin(p, 21)[(l * 2 + 1) * 512 + c]);
  const float bias = pin(p, 22)[l * 512 + c];
  float2* zp = (float2*)(p.ws + WS_ZV) + (size_t)c * SP;
  float l1 = 0.f;
  {
    const u16* ff = (const u16*)((const char*)p.out + WO_FILT) + (size_t)c * 8192 + tid;
    const u16* fb = ff + (size_t)512 * 8192;
    u16 rf[16], rb[16];
#pragma unroll
    for (int i = 0; i < 16; ++i) { rf[i] = ff[i * NT]; rb[i] = fb[i * NT]; }
#pragma unroll
    for (int i = 0; i < 16; ++i) {
      int t = i * NT + tid;
      float tl = (float)t * (1.f / 8191.f);
      float hf = bf2f(rf[i]) * expf(-tl * dF);
      float hb = bf2f(rb[i]) * expf(-tl * dB);
      X[xi(t)] = make_float2(hf, 0.f);
      if (t >= 1) { X[xi(16384 - t)] = make_float2(hb, 0.f); l1 += fabsf(hf) + fabsf(hb); }
      else { X[xi(8192)] = make_float2(zl, zl); l1 += fabsf(hf); }
    }
  }
  float l1tot = block_sum(l1, red);
  fft_dif(X, tw, twr);
  float2 F[32];
  {
    float s = 1.f / (l1tot * 16384.f);
#pragma unroll
    for (int i = 0; i < 32; ++i) { float2 v = X[xi(i * NT + tid)]; F[i] = make_float2(v.x * s, v.y * s); }
  }
  __syncthreads();
#pragma unroll 8
  for (int i = 0; i < 16; ++i) {
    int t = i * NT + tid;
    X[xi(t)] = zp[CTX + t];
    X[xi(8192 + t)] = make_float2(zl, zl);
  }
  __syncthreads();
  fft_dif(X, tw, twr);
#pragma unroll
  for (int i = 0; i < 32; ++i) { int idx = xi(i * NT + tid); X[idx] = cmul(X[idx], F[i]); }
  __syncthreads();
  fft_dit_inv(X, tw, twr);
  {
    float2 zz[16];
#pragma unroll
    for (int i = 0; i < 16; ++i) zz[i] = zp[CTX + i * NT + tid];
#pragma unroll
    for (int i = 0; i < 16; ++i) {
      int t = i * NT + tid;
      float2 y = X[xi(t)];
      zp[CTX + t] = make_float2(y.x + bias * zz[i].x, y.y + bias * zz[i].y);
    }
  }
  __syncthreads();
  {
    float* hFc = (float*)smem;
    float* hBc = hFc + 256;
    float2* zc = (float2*)(hBc + 256);
    float l1c = 0.f;
    if (tid < 256) {
      int t = tid;
      const float* hc = (const float*)(p.ws + WS_HID2C) + (size_t)l * 64 * 256 + t;
      float hf = 0.f, hb = 0.f;
#pragma unroll 16
      for (int k = 0; k < 64; ++k) { float v = hc[k * 256]; hf += v * aux[k]; hb += v * aux[64 + k]; }
      float tl = (float)t * (1.f / 255.f);
      hf *= expf(-tl * dF);
      hb *= expf(-tl * dB);
      hFc[t] = hf;
      hBc[t] = hb;
      l1c = fabsf(hf) + (t >= 1 ? fabsf(hb) : 0.f);
      zc[t] = zp[t];
    }
    float l1ct = block_sum(l1c, red);
    const int bb = tid >> 8, t = tid & 255;
    float acc = 0.f;
    for (int s = 0; s < 256; ++s) {
      float kf = (s <= t) ? hFc[t - s] : hBc[s - t];
      float2 z = zc[s];
      acc += kf * (bb ? z.y : z.x);
    }
    float2 z = zc[t];
    ((float*)zp)[t * 2 + bb] = acc / l1ct + bias * (bb ? z.y : z.x);
    __syncthreads();
  }
}

constexpr int AT_KT = 128, AT_KP = 208, AT_VP = 264, AT_STAGE = AT_KT * AT_KP + 64 * AT_VP;
__device__ __forceinline__ void attn_task(const Ctx& p, int bh, int qb, char* smem) {
  const int tid = tid_l(), wid = tid >> 6, lane = tid & 63, r = lane & 31, hh = lane >> 5;
  const u16* Qp = (const u16*)(p.ws + WS_Q) + ((size_t)bh * SP + qb * 256) * 96;
  const u16* Kp = (const u16*)(p.ws + WS_K) + (size_t)bh * SP * 96;
  const u16* Vp = (const u16*)(p.ws + WS_VT) + (size_t)bh * 64 * SP;
  const int nkt = (qb == 0) ? 2 : 66;
  bf16x8 qf[6];
#pragma unroll
  for (int ks = 0; ks < 6; ++ks) qf[ks] = *(const bf16x8*)(Qp + (size_t)(wid * 32 + r) * 96 + ks * 16 + hh * 8);
  f32x16 o0, o1;
#pragma unroll
  for (int i = 0; i < 16; ++i) { o0[i] = 0.f; o1[i] = 0.f; }
  float mrun = 0.f, lrun = 0.f;
  const u16* src[5];
  int dst[5];
#pragma unroll
  for (int i = 0; i < 5; ++i) {
    int ch = tid + i * NT;
    if (i < 3) { int row = ch / 12, cc = ch - row * 12; src[i] = Kp + (size_t)row * 96 + cc * 8; dst[i] = row * AT_KP + cc * 16; }
    else { int v = ch - 1536, row = v >> 4, cc = v & 15; src[i] = Vp + (size_t)row * SP + cc * 8; dst[i] = AT_KT * AT_KP + row * AT_VP + cc * 16; }
  }
  uint4 st[5];
#define AT_LOAD(t)                                                                                   \
  do {                                                                                               \
    _Pragma("unroll") for (int i = 0; i < 5; ++i) st[i] = *(const uint4*)(src[i] + (size_t)(t) * (i < 3 ? AT_KT * 96 : AT_KT)); \
  } while (0)
#define AT_WRITE(buf)                                                                                \
  do {                                                                                               \
    char* base_ = smem + (buf) * AT_STAGE;                                                           \
    _Pragma("unroll") for (int i = 0; i < 5; ++i) {                                                  \
      uint2* d_ = (uint2*)(base_ + dst[i]);                                                          \
      d_[0] = make_uint2(st[i].x, st[i].y);                                                          \
      d_[1] = make_uint2(st[i].z, st[i].w);                                                          \
    }                                                                                                \
  } while (0)
#define AT_QK(S, kb)                                                                                 \
  __builtin_amdgcn_s_setprio(1);                                                                     \
  _Pragma("unroll") for (int ks = 0; ks < 6; ++ks) {                                                 \
    bf16x8 a_ = *(const bf16x8*)(Ks + ((kb) * 32 + r) * AT_KP + ks * 32 + hh * 16);                  \
    S = __builtin_amdgcn_mfma_f32_32x32x16_bf16(a_, qf[ks], S, 0, 0, 0);                             \
  }                                                                                                  \
  __builtin_amdgcn_s_setprio(0);
#define AT_SOFT_PV(S, kb)                                                                            \
  _Pragma("unroll") for (int i = 0; i < 16; ++i) { S[i] = __builtin_amdgcn_exp2f(S[i]); ps += S[i]; pmx = fmaxf(pmx, S[i]); } \
  _Pragma("unroll") for (int sI = 0; sI < 2; ++sI) {                                                 \
    union { bf16x8 v; unsigned u[4]; } pu;                                                           \
    _Pragma("unroll") for (int j = 0; j < 4; ++j) pu.u[j] = pk2(S[8 * sI + 2 * j], S[8 * sI + 2 * j + 1]); \
    const int koff = ((kb) * 32 + 16 * sI + 4 * hh) * 2;                                             \
    union { bf16x8 v; uint2 h2[2]; } va, vb;                                                         \
    va.h2[0] = *(const uint2*)(Vs + r * AT_VP + koff);                                               \
    va.h2[1] = *(const uint2*)(Vs + r * AT_VP + koff + 16);                                          \
    vb.h2[0] = *(const uint2*)(Vs + (32 + r) * AT_VP + koff);                                        \
    vb.h2[1] = *(const uint2*)(Vs + (32 + r) * AT_VP + koff + 16);                                   \
    o0 = __builtin_amdgcn_mfma_f32_32x32x16_bf16(va.v, pu.v, o0, 0, 0, 0);                           \
    o1 = __builtin_amdgcn_mfma_f32_32x32x16_bf16(vb.v, pu.v, o1, 0, 0, 0);                           \
  }
  AT_LOAD(0);
  AT_WRITE(0);
  __syncthreads();
  for (int t = 0; t < nkt; ++t) {
    const int cur = t & 1;
    if (t + 1 < nkt) AT_LOAD(t + 1);
    const char* Ks = smem + cur * AT_STAGE;
    const char* Vs = Ks + AT_KT * AT_KP;
    const float nm = -mrun;
    f32x16 sA, sB;
    float ps = 0.f, pmx = 0.f;
#pragma unroll
    for (int i = 0; i < 16; ++i) sA[i] = nm;
    AT_QK(sA, 0)
#pragma unroll
    for (int i = 0; i < 16; ++i) sB[i] = nm;
    AT_QK(sB, 1)
    AT_SOFT_PV(sA, 0)
#pragma unroll
    for (int i = 0; i < 16; ++i) sA[i] = nm;
    AT_QK(sA, 2)
    AT_SOFT_PV(sB, 1)
#pragma unroll
    for (int i = 0; i < 16; ++i) sB[i] = nm;
    AT_QK(sB, 3)
    AT_SOFT_PV(sA, 2)
    AT_SOFT_PV(sB, 3)
    lrun += ps;
    pmx = fmaxf(pmx, shx(pmx, 32));
    if (__any(pmx > 256.f)) {
      const float delta = pmx > 256.f ? ceilf(__log2f(pmx)) : 0.f;
      const float alpha = __builtin_amdgcn_exp2f(-delta);
      mrun += delta;
      lrun *= alpha;
#pragma unroll
      for (int i = 0; i < 16; ++i) { o0[i] *= alpha; o1[i] *= alpha; }
    }
    if (t + 1 < nkt) AT_WRITE(cur ^ 1);
    __syncthreads();
  }
  const float ltot = lrun + shx(lrun, 32);
  const float inv = 1.f / ltot;
  const int b = bh >> 3, head = bh & 7;
  u16* Op = (u16*)(p.ws + WS_O) + ((size_t)b * SP + qb * 256 + wid * 32 + r) * 512 + head * 64;
#pragma unroll
  for (int g = 0; g < 4; ++g) {
    uint2 w0, w1;
    w0.x = pk2(o0[4 * g] * inv, o0[4 * g + 1] * inv);
    w0.y = pk2(o0[4 * g + 2] * inv, o0[4 * g + 3] * inv);
    w1.x = pk2(o1[4 * g] * inv, o1[4 * g + 1] * inv);
    w1.y = pk2(o1[4 * g + 2] * inv, o1[4 * g + 3] * inv);
    *(uint2*)(Op + 8 * g + 4 * hh) = w0;
    *(uint2*)(Op + 32 + 8 * g + 4 * hh) = w1;
  }
#undef AT_LOAD
#undef AT_WRITE
#undef AT_QK
#undef AT_SOFT_PV
}

__device__ __forceinline__ void hypost_task(const Ctx& p, int task, char* smem) {
  const int tid = tid_l(), lane = tid & 63, wid = tid >> 6;
  const int tile64 = task >> 1, ch0 = (task & 1) * 256;
  const int m0 = tile64 * 64, b = m0 / SP, pos0 = m0 - b * SP;
  float* T = (float*)smem;
  const float* ZV = (const float*)(p.ws + WS_ZV);
#pragma unroll 8
  for (int cc = 0; cc < 32; ++cc) {
    int c = wid * 32 + cc;
    T[c * 65 + lane] = ZV[((size_t)(ch0 + c) * SP + pos0 + lane) * 2 + b];
  }
  __syncthreads();
  u16* Y = (u16*)(p.ws + WS_Y);
  const int c = tid & 255, th = tid >> 8;
  u16* yp = Y + (size_t)(m0 + th * 32) * 512 + ch0 + c;
  u16 yv[32];
#pragma unroll
  for (int i = 0; i < 32; ++i) yv[i] = yp[(size_t)i * 512];
#pragma unroll
  for (int i = 0; i < 32; ++i) yp[(size_t)i * 512] = f2bf(bf2f(yv[i]) * T[c * 65 + th * 32 + i]);
  __syncthreads();
}

#ifndef PHMASK
#define PHMASK 0xFFFF
#endif
#define PHON(k) (((PHMASK) >> (k)) & 1)
constexpr int NPH = 1 + 4 * 10 + 1;
__global__ void __launch_bounds__(NT, 2) mega(Params prm) {
  __shared__ __attribute__((aligned(1024))) char smem[LDS_BYTES];
  cg::grid_group grid = cg::this_grid();
  const int bid = blockIdx.x, nb = gridDim.x;
  {
    unsigned long long* it = (unsigned long long*)(smem + AUX_OFF + 6144);
    if (threadIdx.x < 33) it[threadIdx.x] = (unsigned long long)prm.in[threadIdx.x];
    if (threadIdx.x == 0) *(uint4*)(smem + AUX_OFF + 7168) = make_uint4(0u, 0u, 0u, 0u);
    __syncthreads();
  }
  XcdBarrier xbar = xcd_barrier_post((unsigned*)(prm.ws + WS_BAR), (volatile LAS unsigned*)(smem + AUX_OFF + 7168));
  if (prm.ph_lo == 0) {
    Ctx p;
    p.intab = (const unsigned long long*)(smem + AUX_OFF + 6144);
    p.ws = prm.ws;
    p.out = prm.out;
    const int bid = blockIdx.x, nb = gridDim.x;
      if (PHON(10)) {
      p0_misc(p);
      for (int t = bid; t < 192; t += nb) p0_mod_task(p, t, smem);
      for (int t = bid; t < 528; t += nb) p0_hid_task(p, t, smem);
      for (int t = bid; t < 128; t += nb) { const int w = (t + 64) & 127; wpe_task(p, w >> 5, w & 31, smem); }
      }
  }
  unsigned nbar = 0;
  for (int ph = prm.ph_lo; ph < prm.ph_hi; ++ph) {
    Ctx p;
    p.intab = (const unsigned long long*)(smem + AUX_OFF + 6144);
    p.ws = prm.ws;
    p.out = prm.out;
    asm volatile("" : "+s"(p.ws), "+s"(p.out));
    float* modall = (float*)(p.ws + WS_MOD);
    u16* proj = (u16*)(p.ws + WS_PROJ);
    u16* xn = (u16*)(p.ws + WS_U);
    char* wo = (char*)p.out;
    if (ph == 0) {
    } else if (ph == NPH - 1) {
      if (PHON(11)) final_norm(p);
    } else {
      const int l = (ph - 1) / 10, sp = (ph - 1) % 10;
      const float* modl = modall + (size_t)l * 3 * 6144;
      GD* tab = (GD*)(smem + AUX_OFF + 4096);
      int ng = 0, nN0 = 0, nN1 = 0, nsplit = 1;
      const bool last = (l == 3);
      const float* gate = modl;
      if (sp == 0 && PHON(0)) {
        wt_phase(p, l, smem);
        norm_rows(p, pin(p, 6) + l * 1024, modl, 0, 1, xn);
      } else if (sp == 1 && PHON(1)) {
        if (threadIdx.x == 0) tab[0] = GD{xn, 1024, (const u16*)(wo + WO_IN), 1024, 1024, 23, EM_PROJ, 1};
        ng = 1; nN0 = 23;
      } else if (sp == 2 && PHON(2)) {
        for (int t = bid; t < 264 * 6; t += nb) premix_task(p, l, t, smem);
        {
          Epi ef{EM_FILT, p.ws, gate, nullptr, (u16*)(wo + WO_FILT)};
          const u16* hA = (const u16*)(p.ws + WS_HID2) + (size_t)l * 8192 * 64;
          const u16* wB = (const u16*)(p.ws + WS_W3T) + (size_t)l * 1024 * 64;
#pragma unroll 1
          for (int t = nb - 1 - bid; t < 128; t += nb) gemm_tile(hA, 64, wB, 64, 64, (t >> 2) * 256, (t & 3) * 256, smem, ef);
        }
      } else if (sp == 3 && PHON(3)) {
        for (int t = bid; t < 512; t += nb) fft_task(p, l, t, smem);
        if (threadIdx.x == 0) {
          tab[0] = GD{proj + OFF_Q, DINP, (const u16*)(wo + WO_UQ), 384, 384, 3, EM_Q, 1};
          tab[1] = GD{proj + OFF_KV, DINP, (const u16*)(wo + WO_UKV), 256, 256, 4, EM_KV, 1};
        }
        ng = 2; nN0 = 3; nN1 = 4;
        for (int i = tid_l(); i < 1024; i += NT) ((float2*)(smem + 131072))[i] = ((const float2*)(p.ws + WS_ROPE))[i];
      } else if (sp == 4 && PHON(4)) {
        for (int t = bid; t < (last ? 512 : 528); t += nb) {
          int bh, qb;
          if (t < 512) { int rnd = t >> 8, w = t & 255; bh = (w & 7) + 8 * rnd; qb = 1 + (w >> 3); }
          else { bh = t - 512; qb = 0; }
          attn_task(p, bh, qb, smem);
        }
        for (int t = bid; t < 528; t += nb) hypost_task(p, t, smem);
      } else if (sp == 5 && PHON(5)) {
        for (int t = bid; t < (last ? 512 : 544); t += nb) {
          if (t < 512) {
            const int x = t & 7, g = t >> 3, pmi = (g >> 2) * 8 + x, pm = pmi + 2 + (pmi >= 64 ? 2 : 0);
            mix_tile<4>(p, l, pm * 128, g & 3, smem);
          } else {
            const int c = t - 512, cm = c >> 2;
            mix_tile<2>(p, l, (cm >> 2) * SP + (cm & 3) * 64, c & 3, smem);
          }
        }
      } else if (sp == 6 && PHON(6)) {
        if (threadIdx.x == 0) tab[0] = GD{(const u16*)(p.ws + WS_ZV), 1024, (const u16*)(wo + WO_OUT), 1024, 1024, 4, EM_RESID, 4};
        ng = 1; nN0 = 4; nsplit = 4;
        gate = modl + 2 * 1024;
      } else if (sp == 7 && PHON(7)) {
        norm_rows(p, pin(p, 7) + l * 1024, modl, 3, 4, xn);
      } else if (sp == 8 && PHON(8)) {
        if (threadIdx.x == 0) tab[0] = GD{xn, 1024, (const u16*)(wo + WO_FF1), 1024, 1024, 16, EM_SQRELU, last ? 2 : 1};
        ng = 1; nN0 = 16; nsplit = last ? 2 : 1;
      } else if (sp == 9 && PHON(9)) {
        if (threadIdx.x == 0) tab[0] = GD{proj, DFF, (const u16*)(wo + WO_FF2), 4096, 4096, 4, EM_RESID, 8};
        ng = 1; nN0 = 4; nsplit = 8;
        gate = modl + 5 * 1024;
      }
      if (ng > 0) {
        __syncthreads();
        const int nt0 = (nsplit > 1) ? (64 * nN0 + (last ? 0 : 2 * nN0 * nsplit)) : NMT * nN0, ntot = nt0 + NMT * nN1;
#pragma unroll 1
        for (int t = bid; t < ntot; t += nb) {
          int gi = 0, tt = t;
          if (t >= nt0) { gi = 1; tt = t - nt0; }
          const volatile GD* gp = tab + gi;
          unsigned long long a64 = (unsigned long long)gp->A, b64 = (unsigned long long)gp->Bt;
          a64 = ((unsigned long long)(unsigned)__builtin_amdgcn_readfirstlane((unsigned)(a64 >> 32)) << 32) | (unsigned long long)(unsigned)__builtin_amdgcn_readfirstlane((unsigned)a64);
          b64 = ((unsigned long long)(unsigned)__builtin_amdgcn_readfirstlane((unsigned)(b64 >> 32)) << 32) | (unsigned long long)(unsigned)__builtin_amdgcn_readfirstlane((unsigned)b64);
          const int lda = __builtin_amdgcn_readfirstlane(gp->lda), ldb = __builtin_amdgcn_readfirstlane(gp->ldb);
          const int K = __builtin_amdgcn_readfirstlane(gp->K), nN = __builtin_amdgcn_readfirstlane(gp->nN);
          const int ks = __builtin_amdgcn_readfirstlane(gp->ks);
          const int mode = __builtin_amdgcn_readfirstlane(gp->mode);
          int pm, pn, Kuse = K, emode = mode;
          if (ks > 1) {
            const int nlat = 64 * nN;
            if (tt < nlat) { int pm64; tile_map(tt, 64, nN, pm64, pn); pm = (pm64 >> 5) * 33 + 1 + (pm64 & 31); }
            else {
              int u = tt - nlat, kp = u % ks, tile = u / ks;
              pm = (tile / nN) * 33; pn = tile % nN;
              Kuse = K / ks; emode = EM_RESID_AT;
              a64 += (unsigned long long)kp * Kuse * 2; b64 += (unsigned long long)kp * Kuse * 2;
            }
          } else tile_map(tt, NMT, nN, pm, pn);
          Epi e{emode, p.ws, gate, (const float2*)(smem + 131072), nullptr};
          gemm_tile((const u16*)a64, lda, (const u16*)b64, ldb, Kuse, pm * 256, pn * 256, smem, e);
        }
      }
    }
    if (ph + 1 < prm.ph_hi) {
      if (ph == prm.ph_lo) grid.sync();
      else xcd_barrier(xbar);
    }
  }
}

extern "C" void kernel_launch(void* const* d_in, const int* in_sizes, int n_in, void* d_out, int out_size, void* d_ws,
                              size_t ws_size, hipStream_t stream) {
  static int grid_blocks = 0;
  if (grid_blocks == 0) {
    if (n_in != 33 || ws_size < WS_END || (size_t)out_size * 4 < WO_END) {
      fprintf(stderr, "kernel_launch: unexpected sizes n_in=%d ws=%zu (need %zu) out=%d\n", n_in, ws_size, (size_t)WS_END, out_size);
      grid_blocks = -1;
      return;
    }
    int dev = 0, cus = 0, per_cu = 0;
    hipGetDevice(&dev);
    hipDeviceGetAttribute(&cus, hipDeviceAttributeMultiprocessorCount, dev);
    hipOccupancyMaxActiveBlocksPerMultiprocessor(&per_cu, mega, NT, 0);
    if (per_cu < 1) per_cu = 1;
    if (per_cu > 1) per_cu = 1;
    grid_blocks = cus * per_cu;
  }
  if (grid_blocks < 0) return;
  Params p{};
  for (int i = 0; i < 33; ++i) p.in[i] = (const float*)d_in[i];
  p.out = (float*)d_out;
  p.ws = (char*)d_ws;
  p.ph_lo = 0;
  p.ph_hi = NPH;
  (void)hipMemsetAsync((char*)d_ws + WS_BAR, 0, 16384, stream);
  void* args[] = {&p};
  hipError_t e = hipLaunchCooperativeKernel((void*)mega, dim3(grid_blocks), dim3(NT), args, 0, stream);
  if (e != hipSuccess) fprintf(stderr, "cooperative launch failed: %s (grid %d)\n", hipGetErrorString(e), grid_blocks);
}
```

```cpp
#include <hip/hip_runtime.h>
#include <hip/hip_cooperative_groups.h>
#include <cstdio>
namespace cg = cooperative_groups;

typedef unsigned short u16;
using bf16x8 = __attribute__((ext_vector_type(8))) short;
using f32x4 = __attribute__((ext_vector_type(4))) float;
using f32x16 = __attribute__((ext_vector_type(16))) float;

constexpr int D = 1024, SEQ = 8192, CTX = 256, SP = 8448, MROWS = 16896, NMT = 66;
constexpr int DIN = 5792, DINP = 5888, DFF = 4096;
constexpr int OFF_HY = 512, OFF_Q = 2048, OFF_KV = 2432, OFF_GATE = 2720;
constexpr int NT = 512;
constexpr float EPS = 1e-6f;

constexpr size_t WS_H = 0;
constexpr size_t WS_PROJ = WS_H + (size_t)MROWS * D * 4;
constexpr size_t WS_U = WS_PROJ + (size_t)MROWS * DINP * 2;
constexpr size_t WS_Y = WS_U + (size_t)MROWS * 512 * 2;
constexpr size_t WS_O = WS_Y + (size_t)MROWS * 512 * 2;
constexpr size_t WS_Q = WS_O + (size_t)MROWS * 512 * 2;
constexpr size_t WS_K = WS_Q + (size_t)16 * SP * 96 * 2;
constexpr size_t WS_VT = WS_K + (size_t)16 * SP * 96 * 2;
constexpr size_t WS_ZV = WS_VT + (size_t)16 * 64 * SP * 2;
constexpr size_t WS_HID2 = WS_ZV + (size_t)512 * SP * 8;
constexpr size_t WS_HID2C = WS_HID2 + (size_t)4 * 8192 * 64 * 4;
constexpr size_t WS_MOD = WS_HID2C + (size_t)4 * 256 * 64 * 4;
constexpr size_t WS_ROPE = WS_MOD + (size_t)4 * 3 * 6144 * 4;
constexpr size_t WS_TW = WS_ROPE + (size_t)128 * 8 * 8;
constexpr size_t WS_WPE = WS_TW + (size_t)16384 * 8;
constexpr size_t WS_BAR = WS_WPE + (size_t)4 * 1024 * 512 * 2;
constexpr size_t WS_END = WS_BAR + 16384;
constexpr size_t WO_IN = 0;
constexpr size_t WO_FF1 = WO_IN + (size_t)DINP * 1024 * 2;
constexpr size_t WO_FF2 = WO_FF1 + (size_t)4096 * 1024 * 2;
constexpr size_t WO_OUT = WO_FF2 + (size_t)4096 * 1024 * 2;
constexpr size_t WO_HY = WO_OUT + (size_t)1024 * 1024 * 2;
constexpr size_t WO_WO = WO_HY + (size_t)1024 * 512 * 2;
constexpr size_t WO_PE = WO_WO + (size_t)1024 * 512 * 2;
constexpr size_t WO_UQ = WO_PE + (size_t)1024 * 512 * 2;
constexpr size_t WO_UKV = WO_UQ + (size_t)768 * 384 * 2;
constexpr size_t WO_FILT = WO_UKV + (size_t)1024 * 256 * 2;
constexpr size_t WO_END = WO_FILT + (size_t)1024 * 8192 * 2;
constexpr size_t WS_W3T = WS_HID2 + (size_t)4 * 8192 * 64 * 2;

constexpr int AUX_OFF = 147456;
constexpr int LDS_BYTES = AUX_OFF + 8192;

struct Params {
  const float* in[33];
  float* out;
  char* ws;
  int ph_lo, ph_hi;
};

struct Ctx { const unsigned long long* intab; char* ws; float* out; };
__device__ __forceinline__ const float* pin(const Ctx& c, int i) {
  unsigned long long v = c.intab[i];
  unsigned lo = __builtin_amdgcn_readfirstlane((unsigned)v), hi = __builtin_amdgcn_readfirstlane((unsigned)(v >> 32));
  return (const float*)(((unsigned long long)hi << 32) | lo);
}

typedef __bf16 hwbf2 __attribute__((ext_vector_type(2)));
typedef float hwf2 __attribute__((ext_vector_type(2)));
__device__ __forceinline__ unsigned pk2(float a, float b) {
  hwf2 v = {a, b};
  hwbf2 r = __builtin_convertvector(v, hwbf2);
  return __builtin_bit_cast(unsigned, r);
}
__device__ __forceinline__ u16 f2bf(float f) { return (u16)(pk2(f, 0.f) & 0xffffu); }
__device__ __forceinline__ float bf2f(u16 b) { return __uint_as_float(((unsigned)b) << 16); }
__device__ __forceinline__ float shx(float v, int o) {
  int l = __builtin_amdgcn_mbcnt_hi(~0u, __builtin_amdgcn_mbcnt_lo(~0u, 0u));
  asm volatile("" : "+v"(l));
  return __int_as_float(__builtin_amdgcn_ds_bpermute((l ^ o) << 2, __float_as_int(v)));
}
__device__ __forceinline__ float wave_sum(float v) {
#pragma unroll
  for (int o = 1; o < 64; o <<= 1) v += shx(v, o);
  return v;
}
__device__ __forceinline__ int grp_of_row(int m) {
  int tile = m >> 8, b = tile / 33, t33 = tile - b * 33;
  return t33 == 0 ? 2 : b;
}
__device__ __forceinline__ float2 cmul(float2 a, float2 b) { return make_float2(a.x * b.x - a.y * b.y, a.x * b.y + a.y * b.x); }

__device__ __forceinline__ int tid_l() { int t = threadIdx.x; asm volatile("" : "+v"(t)); return t; }
#define XB_TMO      128
#define XB_XCNT(j)  (256  + 64 * (j))
#define XB_XSUB(j)  (1280 + 64 * (j))
#define XB_XGEN(j)  (2304 + 64 * (j))
#define XB_TOP      3328
#define XB_TOPGEN   3392
#define XCD_BAR_WORDS 3456
#define XB_SPIN_CAP (1u << 18)
#define LAS __attribute__((address_space(3)))
__device__ __forceinline__ unsigned xb_ld(unsigned* p)              { return __hip_atomic_load(p, __ATOMIC_RELAXED, __HIP_MEMORY_SCOPE_AGENT); }
__device__ __forceinline__ unsigned xb_add(unsigned* p, unsigned v) { return __hip_atomic_fetch_add(p, v, __ATOMIC_RELAXED, __HIP_MEMORY_SCOPE_AGENT); }
__device__ __forceinline__ unsigned xb_xcc_id() { return (unsigned)__builtin_amdgcn_s_getreg((3 << 11) | 20) & 0xFu; }
#define XB_SPIN(cond, bar) do { unsigned _sp = 0; while (cond) { __builtin_amdgcn_s_sleep(1); \
    if ((++_sp & 255u) == 0u) { if (xb_ld(&(bar)[XB_TMO])) break; if (_sp > XB_SPIN_CAP) { atomicAdd(&(bar)[XB_TMO], 1u); break; } } } } while (0)
struct XcdBarrier { unsigned* bar; unsigned x; volatile LAS unsigned* st; };
__device__ __forceinline__ XcdBarrier xcd_barrier_post(unsigned* bar, volatile LAS unsigned* st) {
    XcdBarrier b; b.bar = bar; b.x = xb_xcc_id(); b.st = st;
    if (threadIdx.x == 0) (void)xb_add(&bar[XB_XCNT(b.x)], 1u);
    return b;
}
__device__ __forceinline__ void xcd_barrier_complete(unsigned* bar, unsigned x, unsigned& nloc, unsigned& nx) {
    const unsigned G = gridDim.x * gridDim.y * gridDim.z;
    unsigned sum, cnt, mine, sp = 0u;
    for (;;) {
        sum = 0u; cnt = 0u; mine = 0u;
#pragma unroll
        for (unsigned j = 0; j < 16; ++j) { const unsigned c = xb_ld(&bar[XB_XCNT(j)]); sum += c; cnt += (c > 0u) ? 1u : 0u; mine = (j == x) ? c : mine; }
        if (sum == G) break;
        __builtin_amdgcn_s_sleep(1);
        if ((++sp & 255u) == 0u) { if (xb_ld(&bar[XB_TMO])) break; if (sp > XB_SPIN_CAP) { atomicAdd(&bar[XB_TMO], 1u); break; } }
    }
    nloc = mine > 0u ? mine : 1u; nx = cnt > 0u ? cnt : 1u;
}
__device__ __forceinline__ void xcd_barrier(const XcdBarrier& b) {
    asm volatile("s_waitcnt vmcnt(0)" ::: "memory");
    __syncthreads();
    if (threadIdx.x == 0) {
        unsigned* bar = b.bar;
        __builtin_amdgcn_s_waitcnt(0);
        unsigned nloc = b.st[0], nx = b.st[1];
        if (nloc == 0u) { xcd_barrier_complete(bar, b.x, nloc, nx); b.st[0] = nloc; b.st[1] = nx; }
        const unsigned old = xb_add(&bar[XB_XSUB(b.x)], 1u);
        const unsigned gen = old / nloc;
        if (old + 1u == (gen + 1u) * nloc) {
            __builtin_amdgcn_fence(__ATOMIC_RELEASE, "agent");
            asm volatile("s_waitcnt vmcnt(0)" ::: "memory");
            const unsigned og = xb_add(&bar[XB_TOP], 1u);
            const unsigned tg = og / nx;
            if (og + 1u == (tg + 1u) * nx) xb_add(&bar[XB_TOPGEN], 1u);
            else XB_SPIN(xb_ld(&bar[XB_TOPGEN]) == tg, bar);
            __builtin_amdgcn_fence(__ATOMIC_ACQUIRE, "agent");
            xb_add(&bar[XB_XGEN(b.x)], 1u);
            asm volatile("s_waitcnt vmcnt(0)" ::: "memory");
        } else {
            XB_SPIN(xb_ld(&bar[XB_XGEN(b.x)]) == gen, bar);
            __builtin_amdgcn_fence(__ATOMIC_ACQUIRE, "agent");
            asm volatile("s_waitcnt vmcnt(0)" ::: "memory");
        }
    }
    __syncthreads();
}

__device__ __forceinline__ void grid_barrier(unsigned* bar, unsigned target) {
  asm volatile("s_waitcnt vmcnt(0)" ::: "memory");
  __syncthreads();
  if (threadIdx.x == 0) {
    __builtin_amdgcn_fence(__ATOMIC_RELEASE, "agent");
    asm volatile("s_waitcnt vmcnt(0)" ::: "memory");
    __hip_atomic_fetch_add(bar, 1u, __ATOMIC_RELAXED, __HIP_MEMORY_SCOPE_AGENT);
    while (__hip_atomic_load(bar, __ATOMIC_RELAXED, __HIP_MEMORY_SCOPE_AGENT) < target) __builtin_amdgcn_s_sleep(2);
    __builtin_amdgcn_fence(__ATOMIC_ACQUIRE, "agent");
    asm volatile("s_waitcnt vmcnt(0)" ::: "memory");
  }
  __syncthreads();
}
#define WAIT_V(n) asm volatile("s_waitcnt vmcnt(%0)" ::"n"(n) : "memory")
#define SCHED() __builtin_amdgcn_sched_barrier(0)
#define RAW_BARRIER() do { asm volatile("s_waitcnt lgkmcnt(0)" ::: "memory"); __builtin_amdgcn_s_barrier(); } while (0)

constexpr float QSCALE = 0.10206207261596575f * 1.4426950408889634f;
enum { EM_PROJ = 0, EM_SQRELU = 1, EM_RESID = 2, EM_RESID_AT = 3, EM_FILT = 4, EM_Q = 6, EM_KV = 7 };
struct Epi {
  int mode;
  char* ws;
  const float* gate;
  const float2* rope_lds;
  u16* filt_out;
  __device__ __forceinline__ void proj(int row, int col, f32x4 v) const {
    {
      u16* out = (u16*)(ws + WS_PROJ);
#pragma unroll
      for (int j = 0; j < 4; ++j) out[(size_t)(row + j) * DINP + col] = f2bf(v[j]);
    }
  }
  __device__ __forceinline__ void sqrelu(int row, int col, f32x4 v) const {
    {
      u16* out = (u16*)(ws + WS_PROJ);
#pragma unroll
      for (int j = 0; j < 4; ++j) { float r = fmaxf(v[j], 0.f); out[(size_t)(row + j) * DFF + col] = f2bf(r * r); }
    }
  }
  __device__ __forceinline__ void resid(int row, int col, f32x4 v) const {
    {
      float* h = (float*)(ws + WS_H);
      float g = gate[grp_of_row(row) * 6144 + col];
#pragma unroll
      for (int j = 0; j < 4; ++j) unsafeAtomicAdd(h + (size_t)(row + j) * D + col, g * v[j]);
    }
  }
  __device__ __forceinline__ void filt(int row, int col, f32x4 v) const {
    uint2 o;
    o.x = pk2(v[0], v[1]);
    o.y = pk2(v[2], v[3]);
    *(uint2*)(filt_out + (size_t)col * 8192 + row) = o;
  }
  __device__ __forceinline__ void q(int row, int col, f32x4 v) const {
    {
      u16* Q = (u16*)(ws + WS_Q);
      const float2* rope = rope_lds;
      int head = col / 96, d = col - head * 96;
      int b = row / SP, pos0 = row - b * SP;
      bool isrope = (d >= 64) && (pos0 >= CTX);
      int rd = d - 64;
#pragma unroll
      for (int j = 0; j < 4; ++j) {
        float val = v[j];
        float partner = shx(val, 8);
        int pos = pos0 + j;
        if (isrope) {
          int t = pos - CTX, idx = (rd < 16) ? (t >> 6) : (t & 63);
          float2 cs = rope[idx * 8 + (rd & 7)];
          float sgn = (rd & 8) ? 1.f : -1.f;
          val = val * cs.x + sgn * partner * cs.y;
        }
        Q[((size_t)(b * 8 + head) * SP + pos) * 96 + d] = f2bf(val * QSCALE);
      }
    }
  }
  __device__ __forceinline__ void kv(int row, int col, f32x4 v) const {
    {
      u16* Kb = (u16*)(ws + WS_K);
      u16* Vt = (u16*)(ws + WS_VT);
      int head = col >> 7, j2 = col & 127;
      int b = row / SP, pos0 = row - b * SP;
      if (j2 < 64) {
#pragma unroll
        for (int j = 0; j < 4; ++j) Kb[((size_t)(b * 8 + head) * SP + pos0 + j) * 96 + j2] = f2bf(v[j]);
      } else {
        uint2 o;
        o.x = pk2(v[0], v[1]);
        o.y = pk2(v[2], v[3]);
        *(uint2*)(Vt + ((size_t)(b * 8 + head) * 64 + (j2 - 64)) * SP + pos0) = o;
      }
    }
  }
};
struct GD { const u16* A; int lda; const u16* Bt; int ldb; int K; int nN; int mode; int ks; };

constexpr int G_TILE_B = 256 * 64 * 2, G_STAGE_B = 2 * G_TILE_B;
__device__ __forceinline__ int lds_byte(int r, int c) {
  int st = (r >> 4) * 2 + (c >> 5), ob = (r & 15) * 64 + (c & 31) * 2;
  return st * 1024 + (ob ^ (((ob >> 9) & 1) << 5));
}
__device__ __forceinline__ void stage_rc(int b, int& R, int& C) {
  int st = b >> 10, sb = b & 1023, swz = sb ^ (((sb >> 9) & 1) << 5);
  R = (st / 2) * 16 + swz / 64;
  C = (st % 2) * 32 + (swz % 64) / 2;
}

template <int MI>
__device__ __forceinline__ void gemm_core(const u16* __restrict__ A, int lda, const u16* __restrict__ Bt, int ldb, int K,
                                          int brow, int bcol, char* shm, f32x4 (&acc)[MI][4]) {
  constexpr int TILE_A = MI * 32 * 64 * 2, TILE_BB = 256 * 64 * 2, STAGE = TILE_A + TILE_BB;
  const int tid = tid_l(), wid = tid >> 6, lane = tid & 63, wr = wid >> 2, wc = wid & 3, fr = lane & 15, fq = lane >> 4;
  const u16* Ab = A + (size_t)brow * lda;
  const u16* Bb = Bt + (size_t)bcol * ldb;
  int sR[4], sC[4];
#pragma unroll
  for (int i = 0; i < 4; ++i) stage_rc(wid * 1024 + i * 8192 + lane * 16, sR[i], sC[i]);
#define SA(b) (shm + (b) * STAGE)
#define SB(b) (shm + (b) * STAGE + TILE_A)
#define GLDS_STAGE(buf, kt)                                                                                              \
  do {                                                                                                                   \
    _Pragma("unroll") for (int i = 0; i < 4; ++i) {                                                                      \
      if (i < MI / 2)                                                                                                    \
        __builtin_amdgcn_global_load_lds((const unsigned*)(Ab + (size_t)sR[i] * lda + (kt) * 64 + sC[i]),                \
                                         (unsigned*)(SA(buf) + wid * 1024 + i * 8192), 16, 0, 0);                        \
      __builtin_amdgcn_global_load_lds((const unsigned*)(Bb + (size_t)sR[i] * ldb + (kt) * 64 + sC[i]),                  \
                                       (unsigned*)(SB(buf) + wid * 1024 + i * 8192), 16, 0, 0);                          \
    }                                                                                                                    \
  } while (0)
  const int nt = K / 64;
  GLDS_STAGE(0, 0);
  WAIT_V(0);
  __syncthreads();
  for (int t = 0; t < nt; ++t) {
    const int cur = t & 1;
    if (t + 1 < nt) GLDS_STAGE(cur ^ 1, t + 1);
#pragma unroll
    for (int ks = 0; ks < 2; ++ks) {
      bf16x8 At[MI], Bf[4];
#pragma unroll
      for (int m = 0; m < MI; ++m) At[m] = *(const bf16x8*)(SA(cur) + lds_byte(wr * (MI * 16) + m * 16 + fr, ks * 32 + fq * 8));
#pragma unroll
      for (int n = 0; n < 4; ++n) Bf[n] = *(const bf16x8*)(SB(cur) + lds_byte(wc * 64 + n * 16 + fr, ks * 32 + fq * 8));
#pragma unroll
      for (int m = 0; m < MI; ++m)
#pragma unroll
        for (int n = 0; n < 4; ++n) acc[m][n] = __builtin_amdgcn_mfma_f32_16x16x32_bf16(At[m], Bf[n], acc[m][n], 0, 0, 0);
      SCHED();
    }
    WAIT_V(0);
    __syncthreads();
  }
#undef SA
#undef SB
#undef GLDS_STAGE
}

template <class EpiT>
__device__ __forceinline__ void gemm_tile(const u16* __restrict__ A, int lda, const u16* __restrict__ Bt, int ldb, int K,
                                          int brow, int bcol, char* shm, const EpiT& epi) {
  const int tid = tid_l(), wid = tid >> 6, lane = tid & 63, wr = wid >> 2, wc = wid & 3, fr = lane & 15, fq = lane >> 4;
  f32x4 acc[8][4];
#pragma unroll
  for (int m = 0; m < 8; ++m)
#pragma unroll
    for (int n = 0; n < 4; ++n) acc[m][n] = (f32x4){0.f, 0.f, 0.f, 0.f};
  gemm_core<8>(A, lda, Bt, ldb, K, brow, bcol, shm, acc);
#define EPI_LOOP(CALL)                                                                              \
  _Pragma("unroll") for (int m = 0; m < 8; ++m) _Pragma("unroll") for (int n = 0; n < 4; ++n) {      \
    const int row = brow + wr * 128 + m * 16 + fq * 4, col = bcol + wc * 64 + n * 16 + fr;           \
    const f32x4 v = acc[m][n];                                                                        \
    CALL;                                                                                             \
  }
  if (epi.mode == EM_PROJ) { EPI_LOOP(epi.proj(row, col, v)) }
  else if (epi.mode == EM_SQRELU) { EPI_LOOP(epi.sqrelu(row, col, v)) }
  else if (epi.mode == EM_RESID_AT) { EPI_LOOP(epi.resid(row, col, v)) }
  else if (epi.mode == EM_RESID) {
    float* h = (float*)(epi.ws + WS_H);
    float g4[4];
#pragma unroll
    for (int n = 0; n < 4; ++n) g4[n] = epi.gate[grp_of_row(brow) * 6144 + bcol + wc * 64 + n * 16 + fr];
    float hv[8][4][4];
    float* hp0 = h + (size_t)(brow + wr * 128 + fq * 4) * D + bcol + wc * 64 + fr;
#define H_LOAD(m) _Pragma("unroll") for (int n = 0; n < 4; ++n) _Pragma("unroll") for (int j = 0; j < 4; ++j) hv[m][n][j] = hp0[(size_t)((m) * 16 + j) * D + n * 16]
#define H_STORE(m) _Pragma("unroll") for (int n = 0; n < 4; ++n) _Pragma("unroll") for (int j = 0; j < 4; ++j) hp0[(size_t)((m) * 16 + j) * D + n * 16] = hv[m][n][j] + g4[n] * acc[m][n][j]
    H_LOAD(0); H_LOAD(1);
    SCHED();
    H_STORE(0); H_LOAD(2); SCHED();
    H_STORE(1); H_LOAD(3); SCHED();
    H_STORE(2); H_LOAD(4); SCHED();
    H_STORE(3); H_LOAD(5); SCHED();
    H_STORE(4); H_LOAD(6); SCHED();
    H_STORE(5); H_LOAD(7); SCHED();
    H_STORE(6); H_STORE(7);
#undef H_LOAD
#undef H_STORE
  }
  else if (epi.mode == EM_FILT) { EPI_LOOP(epi.filt(row, col, v)) }
  else if (epi.mode == EM_Q) { EPI_LOOP(epi.q(row, col, v)) }
  else { EPI_LOOP(epi.kv(row, col, v)) }
#undef EPI_LOOP
}

template <int MI>
__device__ __forceinline__ void mix_tile(const Ctx& p, int l, int brow, int pn, char* shm) {
  constexpr int TILE_A = MI * 32 * 64 * 2, TILE_BB = 256 * 64 * 2, STAGE = TILE_A + TILE_BB, WROWS = MI * 16;
  const int tid = tid_l(), wid = tid >> 6, lane = tid & 63, wr = wid >> 2, wc = wid & 3, fr = lane & 15, fq = lane >> 4;
  const int bcol = pn * 256;
  const u16* projb = (const u16*)(p.ws + WS_PROJ);
  char* wo = (char*)p.out;
#define SA(b) (shm + (b) * STAGE)
#define SB(b) (shm + (b) * STAGE + TILE_A)
#define MIX_STAGE(buf, kt)                                                                                               \
  do {                                                                                                                   \
    const int br_ = (kt) >> 3, ko_ = ((kt) & 7) * 64;                                                                    \
    const u16* Ab_ = (const u16*)(p.ws + (br_ == 0 ? WS_U : br_ == 1 ? WS_Y : WS_O)) + (size_t)brow * 512 + ko_;         \
    const u16* Bb_ = (br_ == 0 ? (const u16*)(p.ws + WS_WPE) + (size_t)l * 1024 * 512 : (const u16*)(wo + (br_ == 1 ? WO_HY : WO_WO))) + (size_t)bcol * 512 + ko_;        \
    _Pragma("unroll") for (int i = 0; i < 4; ++i) {                                                                      \
      int sR_, sC_; stage_rc(wid * 1024 + i * 8192 + lane * 16, sR_, sC_);                                              \
      if (i < MI / 2)                                                                                                    \
        __builtin_amdgcn_global_load_lds((const unsigned*)(Ab_ + sR_ * 512 + sC_),                           \
                                         (unsigned*)(SA(buf) + wid * 1024 + i * 8192), 16, 0, 0);                        \
      __builtin_amdgcn_global_load_lds((const unsigned*)(Bb_ + sR_ * 512 + sC_),                             \
                                       (unsigned*)(SB(buf) + wid * 1024 + i * 8192), 16, 0, 0);                          \
    }                                                                                                                    \
  } while (0)
  f32x4 tot[MI][4], acc[MI][4];
#pragma unroll
  for (int m = 0; m < MI; ++m)
#pragma unroll
    for (int n = 0; n < 4; ++n) { tot[m][n] = (f32x4){0.f, 0.f, 0.f, 0.f}; acc[m][n] = (f32x4){0.f, 0.f, 0.f, 0.f}; }
  MIX_STAGE(0, 0);
  MIX_STAGE(1, 1);
  WAIT_V(6);
  RAW_BARRIER();
  int cur = 0;
#pragma unroll 1
  for (int br = 0; br < 3; ++br) {
    unsigned gpk[MI][4][2];
    const u16* gp = projb + (size_t)(brow + wr * WROWS + fq * 4) * DINP + OFF_GATE + br * 1024 + bcol + wc * 64 + fr;
#define GATE_LOAD(m)                                                                                   \
    _Pragma("unroll") for (int n = 0; n < 4; ++n) _Pragma("unroll") for (int j2 = 0; j2 < 2; ++j2) {       \
      unsigned lo = gp[(size_t)((m) * 16 + 2 * j2) * DINP + n * 16], hi = gp[(size_t)((m) * 16 + 2 * j2 + 1) * DINP + n * 16]; \
      gpk[m][n][j2] = lo | (hi << 16);                                                                     \
    }
    GATE_LOAD(0); GATE_LOAD(1);
    if (MI == 4) { GATE_LOAD(2); }
#pragma unroll 1
    for (int kk = 0; kk < 8; ++kk) {
      const int t = br * 8 + kk;
      { int nx = cur + 2; if (nx >= 3) nx -= 3; if (t + 2 < 24) MIX_STAGE(nx, t + 2); }
#pragma unroll
      for (int ks = 0; ks < 2; ++ks) {
        bf16x8 At[2], Bf[4];
#pragma unroll
        for (int n = 0; n < 4; ++n) Bf[n] = *(const bf16x8*)(SB(cur) + lds_byte(wc * 64 + n * 16 + fr, ks * 32 + fq * 8));
#pragma unroll
        for (int mh = 0; mh < MI / 2; ++mh) {
#pragma unroll
          for (int m = 0; m < 2; ++m) At[m] = *(const bf16x8*)(SA(cur) + lds_byte(wr * WROWS + (mh * 2 + m) * 16 + fr, ks * 32 + fq * 8));
#pragma unroll
          for (int m = 0; m < 2; ++m)
#pragma unroll
            for (int n = 0; n < 4; ++n) acc[mh * 2 + m][n] = __builtin_amdgcn_mfma_f32_16x16x32_bf16(At[m], Bf[n], acc[mh * 2 + m][n], 0, 0, 0);
          SCHED();
        }
      }
      if (t + 2 < 24) WAIT_V(6); else WAIT_V(0);
      RAW_BARRIER();
      cur = (cur == 2) ? 0 : cur + 1;
    }
    if (MI == 4) { GATE_LOAD(3); }
#undef GATE_LOAD
#pragma unroll
    for (int m = 0; m < MI; ++m)
#pragma unroll
      for (int n = 0; n < 4; ++n)
#pragma unroll
        for (int j = 0; j < 4; ++j) {
          const unsigned w = gpk[m][n][j >> 1];
          const float gv = __uint_as_float((j & 1) ? (w & 0xffff0000u) : (w << 16));
          tot[m][n][j] += acc[m][n][j] / (1.f + __expf(-gv));
          acc[m][n][j] = 0.f;
        }
  }
  u16* mixb = (u16*)(p.ws + WS_ZV);
#pragma unroll
  for (int m = 0; m < MI; ++m)
#pragma unroll
    for (int n = 0; n < 4; ++n)
#pragma unroll
      for (int j = 0; j < 4; ++j)
        mixb[(size_t)(brow + wr * WROWS + m * 16 + fq * 4 + j) * D + bcol + wc * 64 + n * 16 + fr] = f2bf(tot[m][n][j]);
#undef SA
#undef SB
#undef MIX_STAGE
}

__device__ __forceinline__ void tile_map(int t, int nM, int nN, int& pm, int& pn) {
  int nwg = nM * nN, wgid = t;
  {
    int q = nwg / 8, r = nwg % 8, xcd = wgid % 8, off = wgid / 8;
    wgid = (xcd < r ? xcd * (q + 1) : r * (q + 1) + (xcd - r) * q) + off;
  }
  constexpr int WGM = 4;
  int nig = WGM * nN, gid = wgid / nig, fm = gid * WGM, gsz = min(nM - fm, WGM);
  pm = fm + ((wgid % nig) % gsz);
  pn = (wgid % nig) / gsz;
}

__device__ __forceinline__ void p0_misc(const Ctx& p) {
  const int gtid = blockIdx.x * NT + tid_l(), gn = gridDim.x * NT;
  float4* h4 = (float4*)(p.ws + WS_H);
  const float4* x4 = (const float4*)pin(p, 0);
  const float4* c4 = (const float4*)pin(p, 2);
#pragma unroll 8
  for (int i = gtid; i < MROWS * 256; i += gn) {
    int m = i >> 8, q = i & 255, b = m / SP, pos = m - b * SP;
    float4 v = (pos < CTX) ? c4[(size_t)(b * CTX + pos) * 256 + q] : x4[(size_t)(b * SEQ + pos - CTX) * 256 + q];
    h4[i] = v;
  }
  float2* rope = (float2*)(p.ws + WS_ROPE);
  for (int i = gtid; i < 1024; i += gn) {
    int idx = i >> 3, f = i & 7;
    float inv = powf(10000.f, -(float)f / 8.f);
    float a = (float)idx * inv;
    rope[i] = make_float2(cosf(a), sinf(a));
  }
  {
    u16* w3t = (u16*)(p.ws + WS_W3T);
    const float* w3 = pin(p, 20);
    for (int i = gtid; i < 4 * 1024 * 64; i += gn) { int l = i >> 16, c2 = (i >> 6) & 1023, k = i & 63; w3t[i] = f2bf(w3[((size_t)l * 64 + k) * 1024 + c2]); }
  }
  float2* tw = (float2*)(p.ws + WS_TW);
  for (int i = gtid; i < 16384; i += gn) {
    float s, c;
    sincospif(-(float)i / 8192.f, &s, &c);
    tw[i] = make_float2(c, s);
  }
}

__device__ __forceinline__ void p0_mod_task(const Ctx& p, int task, char* smem) {
  float* s = (float*)smem;
  float* red = s + 3072;
  const int tid = tid_l();
  const int l = task / 48, chunk = task - l * 48;
  for (int i = tid; i < 3072; i += NT) {
    int g = i >> 10, k = i & 1023;
    float cv = (g < 2) ? pin(p, 1)[g * 1024 + k] : pin(p, 3)[k];
    s[i] = cv / (1.f + __expf(-cv));
  }
  __syncthreads();
  const int kq = tid >> 7, col = tid & 127, n = chunk * 128 + col;
  const float* W = pin(p, 4) + (size_t)l * 1024 * 6144 + n;
  float a0 = 0.f, a1 = 0.f, a2 = 0.f;
#pragma unroll 32
  for (int k = kq * 256; k < kq * 256 + 256; ++k) {
    float w = W[(size_t)k * 6144];
    a0 += s[k] * w; a1 += s[1024 + k] * w; a2 += s[2048 + k] * w;
  }
  red[(kq * 3 + 0) * 128 + col] = a0;
  red[(kq * 3 + 1) * 128 + col] = a1;
  red[(kq * 3 + 2) * 128 + col] = a2;
  __syncthreads();
  if (tid < 384) {
    int g = tid >> 7, c2 = tid & 127, n2 = chunk * 128 + c2;
    float v = red[(0 * 3 + g) * 128 + c2] + red[(1 * 3 + g) * 128 + c2] + red[(2 * 3 + g) * 128 + c2] + red[(3 * 3 + g) * 128 + c2];
    ((float*)(p.ws + WS_MOD))[(size_t)(l * 3 + g) * 6144 + n2] = v + pin(p, 5)[l * 6144 + n2];
  }
  __syncthreads();
}

__device__ __forceinline__ void p0_hid_task(const Ctx& p, int task, char* smem) {
  float* zs = (float*)smem;
  float* h1 = zs + 8 * 36;
  float* w1s = h1 + 8 * 64;
  float* w2s = w1s + 33 * 64;
  const int tid = tid_l(), tl = tid >> 6, j = tid & 63;
  const int l = task / 132, r = task - l * 132;
  const bool isctx = r >= 128;
  const int L = isctx ? 256 : 8192;
  const int tbase = (isctx ? (r - 128) : r) * 64;
  for (int i = tid; i < 33 * 64; i += NT) w1s[i] = pin(p, 14)[l * 33 * 64 + i];
  for (int i = tid; i < 64 * 64; i += NT) w2s[i] = pin(p, 17)[l * 64 * 64 + i];
  const float b1 = pin(p, 15)[l * 64 + j], f1 = pin(p, 16)[l * 64 + j], b2 = pin(p, 18)[l * 64 + j], f2 = pin(p, 19)[l * 64 + j];
  __syncthreads();
  for (int sub = 0; sub < 8; ++sub) {
    const int t = tbase + sub * 8 + tl;
    if (j < 33) {
      float z;
      if (j == 0) z = (float)t / (float)(L - 1);
      else {
        int i = (j - 1) & 15;
        float band = 1e-4f + (float)i * ((15.f - 1e-4f) / 15.f);
        float omega = 6.2831855f * (float)t / (float)L;
        float a = omega * band;
        z = (j <= 16) ? cosf(a) : -sinf(a);
      }
      zs[tl * 36 + j] = z;
    }
    __syncthreads();
    {
      float a = b1;
#pragma unroll
      for (int k = 0; k < 33; ++k) a += zs[tl * 36 + k] * w1s[k * 64 + j];
      h1[tl * 64 + j] = sinf(f1 * a);
    }
    __syncthreads();
    {
      float a = b2;
#pragma unroll 16
      for (int k = 0; k < 64; ++k) a += h1[tl * 64 + k] * w2s[k * 64 + j];
      float v = sinf(f2 * a);
      if (isctx) ((float*)(p.ws + WS_HID2C))[((size_t)l * 64 + j) * 256 + t] = v;
      else ((u16*)(p.ws + WS_HID2))[((size_t)l * 8192 + t) * 64 + j] = f2bf(v);
    }
  }
  __syncthreads();
}

struct WtItem { const float* W; u16* WT; int K, N, k0, n0; };
__device__ __forceinline__ WtItem wt_decode(const Ctx& p, int l, int r) {
  char* wo = (char*)p.out;
  WtItem it;
  int nblk;
  if (r < 1472) { it.W = pin(p, 8) + (size_t)l * 1024 * DIN; it.K = 1024; it.N = DIN; it.WT = (u16*)(wo + WO_IN); nblk = 92; }
  else if ((r -= 1472) < 1024) { it.W = pin(p, 30) + (size_t)l * 1024 * 4096; it.K = 1024; it.N = 4096; it.WT = (u16*)(wo + WO_FF1); nblk = 64; }
  else if ((r -= 1024) < 1024) { it.W = pin(p, 31) + (size_t)l * 4096 * 1024; it.K = 4096; it.N = 1024; it.WT = (u16*)(wo + WO_FF2); nblk = 16; }
  else if ((r -= 1024) < 256) { it.W = pin(p, 29) + (size_t)l * 1024 * 1024; it.K = 1024; it.N = 1024; it.WT = (u16*)(wo + WO_OUT); nblk = 16; }
  else if ((r -= 256) < 128) { it.W = pin(p, 23) + (size_t)l * 512 * 1024; it.K = 512; it.N = 1024; it.WT = (u16*)(wo + WO_HY); nblk = 16; }
  else if ((r -= 128) < 128) { it.W = pin(p, 28) + (size_t)l * 512 * 1024; it.K = 512; it.N = 1024; it.WT = (u16*)(wo + WO_WO); nblk = 16; }
  else if ((r -= 128) < 72) { it.W = pin(p, 25) + (size_t)l * 384 * 768; it.K = 384; it.N = 768; it.WT = (u16*)(wo + WO_UQ); nblk = 12; }
  else { r -= 72; it.W = pin(p, 27) + (size_t)l * 256 * 1024; it.K = 256; it.N = 1024; it.WT = (u16*)(wo + WO_UKV); nblk = 16; }
  const int kb = r / nblk, nb2 = r - kb * nblk;
  it.k0 = kb * 64; it.n0 = nb2 * 64;
  return it;
}
__device__ __forceinline__ void wt_load(const WtItem& it, int tid, float (&v)[8]) {
  const int nn = tid & 63, kq = tid >> 6;
  const bool ok = it.n0 + nn < it.N;
  const float* src = it.W + (size_t)(it.k0 + kq) * it.N + it.n0 + (ok ? nn : 0);
#pragma unroll
  for (int r = 0; r < 8; ++r) { float x = src[(size_t)(r * 8) * it.N]; v[r] = ok ? x : 0.f; }
}
__device__ __forceinline__ void wt_phase(const Ctx& p, int l, char* smem) {
  float* tile = (float*)smem;
  const int tid = tid_l();
  const int bid = blockIdx.x, nb = gridDim.x;
  int t = bid;
  if (t >= 4168) return;
  WtItem cur = wt_decode(p, l, t);
  float v[8];
  wt_load(cur, tid, v);
#pragma unroll 1
  while (true) {
    const int tn = t + nb;
    const bool more = tn < 4168;
    WtItem nxt = cur;
    float vn[8];
    if (more) { nxt = wt_decode(p, l, tn); wt_load(nxt, tid, vn); }
#pragma unroll
    for (int r = 0; r < 8; ++r) tile[(r * 8 + (tid >> 6)) * 65 + (tid & 63)] = v[r];
    __syncthreads();
    {
      int n = tid >> 3, kc = (tid & 7) * 8;
      uint4 o;
      o.x = pk2(tile[(kc + 0) * 65 + n], tile[(kc + 1) * 65 + n]);
      o.y = pk2(tile[(kc + 2) * 65 + n], tile[(kc + 3) * 65 + n]);
      o.z = pk2(tile[(kc + 4) * 65 + n], tile[(kc + 5) * 65 + n]);
      o.w = pk2(tile[(kc + 6) * 65 + n], tile[(kc + 7) * 65 + n]);
      *(uint4*)(cur.WT + (size_t)(cur.n0 + n) * cur.K + cur.k0 + kc) = o;
    }
    __syncthreads();
    if (!more) break;
    cur = nxt;
#pragma unroll
    for (int r = 0; r < 8; ++r) v[r] = vn[r];
    t = tn;
  }
}

__device__ __forceinline__ void wpe_task(const Ctx& p, int l, int task, char* smem) {
  const int g = task >> 3, c0 = (task & 7) * 16, tid = tid_l();
  const float* pw = pin(p, 9) + ((size_t)(l * 4 + g) * 128) * 128;
  const float* sc = pin(p, 10) + l * 512 + g * 128;
  const float* po = pin(p, 11) + ((size_t)l * 512 + g * 128) * 1024;
  u16* WpeT = (u16*)(p.ws + WS_WPE) + (size_t)l * 1024 * 512;
  float* wl = (float*)smem;
  for (int i = tid; i < 16 * 128; i += NT) { int d = i & 127; wl[i] = pw[(c0 + (i >> 7)) * 128 + d] * sc[d]; }
  __syncthreads();
  float acc0[16], acc1[16];
#pragma unroll
  for (int i = 0; i < 16; ++i) { acc0[i] = 0.f; acc1[i] = 0.f; }
#pragma unroll 16
  for (int d = 0; d < 128; ++d) {
    float p0 = po[(size_t)d * 1024 + tid], p1 = po[(size_t)d * 1024 + 512 + tid];
#pragma unroll
    for (int i = 0; i < 16; ++i) { float w = wl[i * 128 + d]; acc0[i] += w * p0; acc1[i] += w * p1; }
  }
  uint4 o0, o1;
  o0.x = pk2(acc0[0], acc0[1]); o0.y = pk2(acc0[2], acc0[3]); o0.z = pk2(acc0[4], acc0[5]); o0.w = pk2(acc0[6], acc0[7]);
  o1.x = pk2(acc0[8], acc0[9]); o1.y = pk2(acc0[10], acc0[11]); o1.z = pk2(acc0[12], acc0[13]); o1.w = pk2(acc0[14], acc0[15]);
  uint4* dst = (uint4*)(WpeT + (size_t)tid * 512 + g * 128 + c0);
  dst[0] = o0; dst[1] = o1;
  o0.x = pk2(acc1[0], acc1[1]); o0.y = pk2(acc1[2], acc1[3]); o0.z = pk2(acc1[4], acc1[5]); o0.w = pk2(acc1[6], acc1[7]);
  o1.x = pk2(acc1[8], acc1[9]); o1.y = pk2(acc1[10], acc1[11]); o1.z = pk2(acc1[12], acc1[13]); o1.w = pk2(acc1[14], acc1[15]);
  dst = (uint4*)(WpeT + (size_t)(512 + tid) * 512 + g * 128 + c0);
  dst[0] = o0; dst[1] = o1;
  __syncthreads();
}

__device__ __forceinline__ void norm_rows(const Ctx& p, const float* gain, const float* modl, int sh_idx, int sc_idx, u16* outp) {
  const int tidx = tid_l(), lane = tidx & 63, gw = blockIdx.x * 8 + (tidx >> 6), ngw = gridDim.x * 8;
  const float* h = (const float*)(p.ws + WS_H);
  float4 g[4];
#pragma unroll
  for (int j = 0; j < 4; ++j) g[j] = *(const float4*)(gain + lane * 4 + 256 * j);
  for (int m0 = gw; m0 < MROWS; m0 += 2 * ngw) {
    const int m1 = m0 + ngw;
    const bool has1 = m1 < MROWS;
    const int m1c = has1 ? m1 : m0;
    const float4* hr0 = (const float4*)(h + (size_t)m0 * D) + lane;
    const float4* hr1 = (const float4*)(h + (size_t)m1c * D) + lane;
    float4 v0[4], v1[4];
#pragma unroll
    for (int j = 0; j < 4; ++j) { v0[j] = hr0[64 * j]; v1[j] = hr1[64 * j]; }
    const float* mg0 = modl + grp_of_row(m0) * 6144;
    const float* mg1 = modl + grp_of_row(m1c) * 6144;
    float s0 = 0.f, s1 = 0.f;
#pragma unroll
    for (int j = 0; j < 4; ++j) {
      s0 += v0[j].x * v0[j].x + v0[j].y * v0[j].y + v0[j].z * v0[j].z + v0[j].w * v0[j].w;
      s1 += v1[j].x * v1[j].x + v1[j].y * v1[j].y + v1[j].z * v1[j].z + v1[j].w * v1[j].w;
    }
    s0 = wave_sum(s0);
    s1 = wave_sum(s1);
    const float r0 = rsqrtf(s0 * (1.f / D) + EPS), r1 = rsqrtf(s1 * (1.f / D) + EPS);
    uint2* o0 = (uint2*)(outp + (size_t)m0 * D) + lane;
    uint2* o1 = (uint2*)(outp + (size_t)m1c * D) + lane;
#pragma unroll
    for (int j = 0; j < 4; ++j) {
      int n = lane * 4 + 256 * j;
      float4 sc = *(const float4*)(mg0 + sc_idx * 1024 + n), sh = *(const float4*)(mg0 + sh_idx * 1024 + n);
      uint2 o;
      o.x = pk2(v0[j].x * r0 * g[j].x * (1.f + sc.x) + sh.x, v0[j].y * r0 * g[j].y * (1.f + sc.y) + sh.y);
      o.y = pk2(v0[j].z * r0 * g[j].z * (1.f + sc.z) + sh.z, v0[j].w * r0 * g[j].w * (1.f + sc.w) + sh.w);
      o0[64 * j] = o;
    }
    if (has1) {
#pragma unroll
      for (int j = 0; j < 4; ++j) {
        int n = lane * 4 + 256 * j;
        float4 sc = *(const float4*)(mg1 + sc_idx * 1024 + n), sh = *(const float4*)(mg1 + sh_idx * 1024 + n);
        uint2 o;
        o.x = pk2(v1[j].x * r1 * g[j].x * (1.f + sc.x) + sh.x, v1[j].y * r1 * g[j].y * (1.f + sc.y) + sh.y);
        o.y = pk2(v1[j].z * r1 * g[j].z * (1.f + sc.z) + sh.z, v1[j].w * r1 * g[j].w * (1.f + sc.w) + sh.w);
        o1[64 * j] = o;
      }
    }
  }
}

__device__ __forceinline__ void final_norm(const Ctx& p) {
  const int tidx = tid_l(), lane = tidx & 63, gw = blockIdx.x * 8 + (tidx >> 6), ngw = gridDim.x * 8;
  const float* h = (const float*)(p.ws + WS_H);
  const float* gain = pin(p, 32);
  for (int r0 = gw; r0 < 2 * SEQ; r0 += ngw) {
    int b = r0 >> 13, t = r0 & 8191, m = b * SP + CTX + t;
    const float4* hr = (const float4*)(h + (size_t)m * D) + lane;
    float4 v[4];
    float ss = 0.f;
#pragma unroll
    for (int j = 0; j < 4; ++j) { v[j] = hr[64 * j]; ss += v[j].x * v[j].x + v[j].y * v[j].y + v[j].z * v[j].z + v[j].w * v[j].w; }
    ss = wave_sum(ss);
    float r = rsqrtf(ss * (1.f / D) + EPS);
    float4* o = (float4*)(p.out + (size_t)r0 * D) + lane;
#pragma unroll
    for (int j = 0; j < 4; ++j) {
      float4 g = *(const float4*)(gain + lane * 4 + 256 * j);
      o[64 * j] = make_float4(v[j].x * r * g.x, v[j].y * r * g.y, v[j].z * r * g.z, v[j].w * r * g.w);
    }
  }
}

__device__ __forceinline__ void premix_task(const Ctx& p, int l, int task, char* smem) {
  const int tid = tid_l(), lane = tid & 63, wid = tid >> 6;
  const int part = task / 264, tile64 = task - part * 264;
  const int m0 = tile64 * 64, b = m0 / SP, pos0 = m0 - b * SP;
  const bool isctx = pos0 < CTX;
  const int s0 = isctx ? 0 : CTX, L = isctx ? CTX : SEQ, t0 = pos0 - s0;
  const size_t mb = (size_t)b * SP + s0;
  const u16* proj = (const u16*)(p.ws + WS_PROJ);
  if (part == 0) {
    u16* P = (u16*)smem;
#pragma unroll
    for (int i = tid; i < 80 * 64; i += NT) {
      int r = i >> 6, ch = i & 63, t = t0 - 8 + r;
      uint4 v = make_uint4(0, 0, 0, 0);
      if (t >= 0 && t < L) v = *(const uint4*)(proj + (mb + t) * DINP + ch * 8);
      *(uint4*)(P + r * 512 + ch * 8) = v;
    }
    __syncthreads();
    const int c = tid, g = c >> 7, hw = 1 << g;
    u16* U = (u16*)(p.ws + WS_U);
    float s = 0.f;
    for (int q = -hw; q < hw; ++q) s += bf2f(P[(8 + q) * 512 + c]);
#pragma unroll 4
    for (int tt = 0; tt < 64; ++tt) {
      int t = t0 + tt, lo = max(t - hw, 0), hi = min(t + hw, L);
      float u = s / (float)(hi - lo) - bf2f(P[(tt + 8) * 512 + c]);
      U[(mb + t) * 512 + c] = f2bf(u);
      s += bf2f(P[(tt + 8 + hw) * 512 + c]) - bf2f(P[(tt + 8 - hw) * 512 + c]);
    }
    __syncthreads();
  } else if (part <= 4) {
    const int ch0 = (part - 1) * 128;
    constexpr int PITCH = 136;
    u16* X = (u16*)smem;
    float* T = (float*)(smem + 3 * 66 * PITCH * 2 + 64);
#pragma unroll
    for (int ii = 0; ii < 7; ++ii) {
      const int i = tid + ii * NT;
      if (i >= 3 * 66 * 16) break;
      int pr = i / (66 * 16), rem = i - pr * 66 * 16, r = rem >> 4, ch = rem & 15, t = t0 - 1 + r;
      uint4 v = make_uint4(0, 0, 0, 0);
      if (t >= 0 && t < L) v = *(const uint4*)(proj + (mb + t) * DINP + OFF_HY + pr * 512 + ch0 + ch * 8);
      *(uint4*)(X + (pr * 66 + r) * PITCH + ch * 8) = v;
    }
    __syncthreads();
    const float* cw = pin(p, 12) + l * 3 * 1536;
    const float* cb = pin(p, 13) + l * 1536;
    {
      const int c = tid & 127, tq = tid >> 7, col = ch0 + c;
      const float w00 = cw[col], w01 = cw[1536 + col], w02 = cw[3072 + col], b0 = cb[col];
      const float w10 = cw[512 + col], w11 = cw[1536 + 512 + col], w12 = cw[3072 + 512 + col], b1 = cb[512 + col];
      const float w20 = cw[1024 + col], w21 = cw[1536 + 1024 + col], w22 = cw[3072 + 1024 + col], b2 = cb[1024 + col];
      const u16* X0 = X, *X1 = X + 66 * PITCH, *XV = X + 2 * 66 * PITCH;
      u16* Y = (u16*)(p.ws + WS_Y);
#pragma unroll 4
      for (int tt = tq * 16; tt < tq * 16 + 16; ++tt) {
        float x0 = w00 * bf2f(X0[tt * PITCH + c]) + w01 * bf2f(X0[(tt + 1) * PITCH + c]) + w02 * bf2f(X0[(tt + 2) * PITCH + c]) + b0;
        float x1 = w10 * bf2f(X1[tt * PITCH + c]) + w11 * bf2f(X1[(tt + 1) * PITCH + c]) + w12 * bf2f(X1[(tt + 2) * PITCH + c]) + b1;
        float vv = w20 * bf2f(XV[tt * PITCH + c]) + w21 * bf2f(XV[(tt + 1) * PITCH + c]) + w22 * bf2f(XV[(tt + 2) * PITCH + c]) + b2;
        Y[(mb + t0 + tt) * 512 + col] = f2bf(x0);
        T[c * 65 + tt] = x1 * vv;
      }
    }
    __syncthreads();
    {
      float* ZV = (float*)(p.ws + WS_ZV);
#pragma unroll 4
      for (int cc = 0; cc < 16; ++cc) {
        int c = wid * 16 + cc;
        ZV[((size_t)(ch0 + c) * SP + pos0 + lane) * 2 + b] = T[c * 65 + lane];
      }
    }
    __syncthreads();
  } else {
    u16* projw = (u16*)(p.ws + WS_PROJ);
    const float* qg = pin(p, 24) + l * 384;
    const float* kg = pin(p, 26) + l * 256;
    const float2* rope = (const float2*)(p.ws + WS_ROPE);
    u16* Kb = (u16*)(p.ws + WS_K);
#pragma unroll 2
    for (int rr = 0; rr < 8; ++rr) {
      int tt = wid * 8 + rr, pos = pos0 + tt;
      u16* row = projw + ((size_t)b * SP + pos) * DINP;
      unsigned* q32 = (unsigned*)(row + OFF_Q);
      unsigned* k32 = (unsigned*)(row + OFF_KV);
      unsigned v[3], w[2];
      float ss = 0.f, s2 = 0.f;
#pragma unroll
      for (int j = 0; j < 3; ++j) v[j] = q32[lane + 64 * j];
#pragma unroll
      for (int j = 0; j < 2; ++j) w[j] = k32[lane + 64 * j];
      const int rd = lane & 31;
      float val = bf2f(row[OFF_KV + 256 + rd]);
#pragma unroll
      for (int j = 0; j < 3; ++j) { float a = bf2f(v[j] & 0xffff), c2 = bf2f(v[j] >> 16); ss += a * a + c2 * c2; }
#pragma unroll
      for (int j = 0; j < 2; ++j) { float a = bf2f(w[j] & 0xffff), c2 = bf2f(w[j] >> 16); s2 += a * a + c2 * c2; }
      ss = wave_sum(ss);
      s2 = wave_sum(s2);
      float r = rsqrtf(ss * (1.f / 384.f) + EPS), r2 = rsqrtf(s2 * (1.f / 256.f) + EPS);
#pragma unroll
      for (int j = 0; j < 3; ++j) {
        int n = (lane + 64 * j) * 2;
        q32[lane + 64 * j] = pk2(bf2f(v[j] & 0xffff) * r * qg[n], bf2f(v[j] >> 16) * r * qg[n + 1]);
      }
#pragma unroll
      for (int j = 0; j < 2; ++j) {
        int n = (lane + 64 * j) * 2;
        k32[lane + 64 * j] = pk2(bf2f(w[j] & 0xffff) * r2 * kg[n], bf2f(w[j] >> 16) * r2 * kg[n + 1]);
      }
      float partner = shx(val, 8);
      if (!isctx) {
        int t = pos - CTX, idx = (rd < 16) ? (t >> 6) : (t & 63);
        float2 cs = rope[idx * 8 + (rd & 7)];
        float sgn = (rd & 8) ? 1.f : -1.f;
        val = val * cs.x + sgn * partner * cs.y;
      }
      if (lane < 32) {
        u16 o = f2bf(val);
#pragma unroll
        for (int hd = 0; hd < 8; ++hd) Kb[((size_t)(b * 8 + hd) * SP + pos) * 96 + 64 + rd] = o;
      }
    }
  }
}

__device__ __forceinline__ int xi(int i) { const int h = i >> 5; return i ^ (((h & 3) * 5) | ((h & 2) << 3)); }
typedef float v2f __attribute__((ext_vector_type(2)));
__device__ __forceinline__ v2f cmulv(v2f a, v2f b) {
  v2f bs = {-b.y, b.x};
  return a.xx * b + a.yy * bs;
}
__device__ __forceinline__ void bf_fwd(float2* Xf, int base, int q, float2 w1f) {
  v2f* X = (v2f*)Xf;
  const v2f w1 = {w1f.x, w1f.y};
  const v2f w2 = cmulv(w1, w1), w3 = cmulv(w2, w1);
  const int i0 = xi(base), i1 = xi(base + q), i2 = xi(base + 2 * q), i3 = xi(base + 3 * q);
  v2f a0 = X[i0], a1 = X[i1], a2 = X[i2], a3 = X[i3];
  v2f s02 = a0 + a2, d02 = a0 - a2, s13 = a1 + a3, d13 = a1 - a3;
  v2f d13r = {d13.y, -d13.x};
  X[i0] = s02 + s13;
  X[i1] = cmulv(d02 + d13r, w1);
  X[i2] = cmulv(s02 - s13, w2);
  X[i3] = cmulv(d02 - d13r, w3);
}
__device__ __forceinline__ void bf_inv(float2* Xf, int base, int q, float2 w1f) {
  v2f* X = (v2f*)Xf;
  const v2f w1 = {w1f.x, -w1f.y};
  const v2f w2 = cmulv(w1, w1), w3 = cmulv(w2, w1);
  const int i0 = xi(base), i1 = xi(base + q), i2 = xi(base + 2 * q), i3 = xi(base + 3 * q);
  v2f b0 = X[i0], c1 = cmulv(X[i1], w1), c2 = cmulv(X[i2], w2), c3 = cmulv(X[i3], w3);
  v2f s02 = b0 + c2, d02 = b0 - c2, s13 = c1 + c3, d13 = c1 - c3;
  v2f d13r = {-d13.y, d13.x};
  X[i0] = s02 + s13;
  X[i1] = d02 + d13r;
  X[i2] = s02 - s13;
  X[i3] = d02 - d13r;
}
template <bool INV, int LQ>
__device__ __forceinline__ void fft_pass(float2* X, const float2* __restrict__ tw, const float2 (&twr)[6], int tid) {
  constexpr int q = 1 << LQ;
  if (LQ == 12) {
    float2 w[8];
#pragma unroll
    for (int b8 = 0; b8 < 8; ++b8) w[b8] = tw[b8 * NT + tid];
#pragma unroll
    for (int b8 = 0; b8 < 8; ++b8) { int u = b8 * NT + tid; if (INV) bf_inv(X, u, q, w[b8]); else bf_fwd(X, u, q, w[b8]); }
  } else if (LQ == 10) {
#pragma unroll 2
    for (int b8 = 0; b8 < 8; ++b8) {
      int u = b8 * NT + tid, j = u & 1023, base = ((u >> 10) << 12) + j;
      float2 w = (b8 & 1) ? twr[1] : twr[0];
      if (INV) bf_inv(X, base, q, w); else bf_fwd(X, base, q, w);
    }
  } else {
    const int j = tid & (q - 1);
    const float2 w = (LQ == 0) ? make_float2(1.f, 0.f) : twr[2 + (8 - LQ) / 2];
#pragma unroll 2
    for (int b8 = 0; b8 < 8; ++b8) {
      int u = b8 * NT + tid, base = ((u >> LQ) << (LQ + 2)) + j;
      if (INV) bf_inv(X, base, q, w); else bf_fwd(X, base, q, w);
    }
  }
  __syncthreads();
}
__device__ __forceinline__ void fft_load_tw(const float2* __restrict__ tw, int tid, float2 (&twr)[6]) {
  twr[0] = tw[tid << 2];
  twr[1] = tw[(512 + tid) << 2];
  twr[2] = tw[(tid & 255) << 4];
  twr[3] = tw[(tid & 63) << 6];
  twr[4] = tw[(tid & 15) << 8];
  twr[5] = tw[(tid & 3) << 10];
}
__device__ __forceinline__ void fft_dif(float2* X, const float2* __restrict__ tw, const float2 (&twr)[6]) {
  const int tid = tid_l();
  fft_pass<false, 12>(X, tw, twr, tid); fft_pass<false, 10>(X, tw, twr, tid); fft_pass<false, 8>(X, tw, twr, tid); fft_pass<false, 6>(X, tw, twr, tid);
  fft_pass<false, 4>(X, tw, twr, tid); fft_pass<false, 2>(X, tw, twr, tid); fft_pass<false, 0>(X, tw, twr, tid);
}
__device__ __forceinline__ void fft_dit_inv(float2* X, const float2* __restrict__ tw, const float2 (&twr)[6]) {
  const int tid = tid_l();
  fft_pass<true, 0>(X, tw, twr, tid); fft_pass<true, 2>(X, tw, twr, tid); fft_pass<true, 4>(X, tw, twr, tid); fft_pass<true, 6>(X, tw, twr, tid);
  fft_pass<true, 8>(X, tw, twr, tid); fft_pass<true, 10>(X, tw, twr, tid); fft_pass<true, 12>(X, tw, twr, tid);
}
__device__ __forceinline__ float block_sum(float v, float* red) {
  v = wave_sum(v);
  __syncthreads();
  { const int tb = tid_l(); if ((tb & 63) == 0) red[tb >> 6] = v; }
  __syncthreads();
  float s = red[0] + red[1] + red[2] + red[3] + red[4] + red[5] + red[6] + red[7];
  __syncthreads();
  return s;
}

__device__ __forceinline__ void fft_task(const Ctx& p, int l, int c, char* smem) {
  float2* X = (float2*)smem;
  float zl = 0.f;
  asm volatile("" : "+v"(zl));
  float* aux = (float*)(smem + AUX_OFF);
  float* red = aux + 128;
  const int tid = tid_l();
  const float2* tw = (const float2*)(p.ws + WS_TW);
  float2 twr[6];
  fft_load_tw(tw, tid, twr);
  const float* w3 = pin(p, 20) + (size_t)l * 64 * 1024;
  if (tid < 64) { aux[tid] = w3[tid * 1024 + c]; aux[64 + tid] = w3[tid * 1024 + 512 + c]; }
  __syncthreads();
  const float dF = fabsf(pin(p, 21)[(l * 2 + 0) * 512 + c]), dB = fabsf(pin(p, 21)[(l * 2 + 1) * 512 + c]);
  const float bias = pin(p, 22)[l * 512 + c];
  float2* zp = (float2*)(p.ws + WS_ZV) + (size_t)c * SP;
  float l1 = 0.f;
  {
    const u16* ff = (const u16*)((const char*)p.out + WO_FILT) + (size_t)c * 8192 + tid;
    const u16* fb = ff + (size_t)512 * 8192;
    u16 rf[16], rb[16];
#pragma unroll
    for (int i = 0; i < 16; ++i) { rf[i] = ff[i * NT]; rb[i] = fb[i * NT]; }
#pragma unroll
    for (int i = 0; i < 16; ++i) {
      int t = i * NT + tid;
      float tl = (float)t * (1.f / 8191.f);
      float hf = bf2f(rf[i]) * expf(-tl * dF);
      float hb = bf2f(rb[i]) * expf(-tl * dB);
      X[xi(t)] = make_float2(hf, 0.f);
      if (t >= 1) { X[xi(16384 - t)] = make_float2(hb, 0.f); l1 += fabsf(hf) + fabsf(hb); }
      else { X[xi(8192)] = make_float2(zl, zl); l1 += fabsf(hf); }
    }
  }
  float l1tot = block_sum(l1, red);
  fft_dif(X, tw, twr);
  float2 F[32];
  {
    float s = 1.f / (l1tot * 16384.f);
#pragma unroll
    for (int i = 0; i < 32; ++i) { float2 v = X[xi(i * NT + tid)]; F[i] = make_float2(v.x * s, v.y * s); }
  }
  __syncthreads();
#pragma unroll 8
  for (int i = 0; i < 16; ++i) {
    int t = i * NT + tid;
    X[xi(t)] = zp[CTX + t];
    X[xi(8192 + t)] = make_float2(zl, zl);
  }
  __syncthreads();
  fft_dif(X, tw, twr);
#pragma unroll
  for (int i = 0; i < 32; ++i) { int idx = xi(i * NT + tid); X[idx] = cmul(X[idx], F[i]); }
  __syncthreads();
  fft_dit_inv(X, tw, twr);
  {
    float2 zz[16];
#pragma unroll
    for (int i = 0; i < 16; ++i) zz[i] = zp[CTX + i * NT + tid];
#pragma unroll
    for (int i = 0; i < 16; ++i) {
      int t = i * NT + tid;
      float2 y = X[xi(t)];
      zp[CTX + t] = make_float2(y.x + bias * zz[i].x, y.y + bias * zz[i].y);
    }
  }
  __syncthreads();
  {
    float* hFc = (float*)smem;
    float* hBc = hFc + 256;
    float2* zc = (float2*)(hBc + 256);
    float l1c = 0.f;
    if (tid < 256) {
      int t = tid;
      const float* hc = (const float*)(p.ws + WS_HID2C) + (size_t)l * 64 * 256 + t;
      float hf = 0.f, hb = 0.f;
#pragma unroll 16
      for (int k = 0; k < 64; ++k) { float v = hc[k * 256]; hf += v * aux[k]; hb += v * aux[64 + k]; }
      float tl = (float)t * (1.f / 255.f);
      hf *= expf(-tl * dF);
      hb *= expf(-tl * dB);
      hFc[t] = hf;
      hBc[t] = hb;
      l1c = fabsf(hf) + (t >= 1 ? fabsf(hb) : 0.f);
      zc[t] = zp[t];
    }
    float l1ct = block_sum(l1c, red);
    const int bb = tid >> 8, t = tid & 255;
    float acc = 0.f;
    for (int s = 0; s < 256; ++s) {
      float kf = (s <= t) ? hFc[t - s] : hBc[s - t];
      float2 z = zc[s];
      acc += kf * (bb ? z.y : z.x);
    }
    float2 z = zc[t];
    ((float*)zp)[t * 2 + bb] = acc / l1ct + bias * (bb ? z.y : z.x);
    __syncthreads();
  }
}

constexpr int AT_KT = 128, AT_KP = 208, AT_VP = 264, AT_STAGE = AT_KT * AT_KP + 64 * AT_VP;
__device__ __forceinline__ void attn_task(const Ctx& p, int bh, int qb, char* smem) {
  const int tid = tid_l(), wid = tid >> 6, lane = tid & 63, r = lane & 31, hh = lane >> 5;
  const u16* Qp = (const u16*)(p.ws + WS_Q) + ((size_t)bh * SP + qb * 256) * 96;
  const u16* Kp = (const u16*)(p.ws + WS_K) + (size_t)bh * SP * 96;
  const u16* Vp = (const u16*)(p.ws + WS_VT) + (size_t)bh * 64 * SP;
  const int nkt = (qb == 0) ? 2 : 66;
  bf16x8 qf[6];
#pragma unroll
  for (int ks = 0; ks < 6; ++ks) qf[ks] = *(const bf16x8*)(Qp + (size_t)(wid * 32 + r) * 96 + ks * 16 + hh * 8);
  f32x16 o0, o1;
#pragma unroll
  for (int i = 0; i < 16; ++i) { o0[i] = 0.f; o1[i] = 0.f; }
  float mrun = 0.f, lrun = 0.f;
  const u16* src[5];
  int dst[5];
#pragma unroll
  for (int i = 0; i < 5; ++i) {
    int ch = tid + i * NT;
    if (i < 3) { int row = ch / 12, cc = ch - row * 12; src[i] = Kp + (size_t)row * 96 + cc * 8; dst[i] = row * AT_KP + cc * 16; }
    else { int v = ch - 1536, row = v >> 4, cc = v & 15; src[i] = Vp + (size_t)row * SP + cc * 8; dst[i] = AT_KT * AT_KP + row * AT_VP + cc * 16; }
  }
  uint4 st[5];
#define AT_LOAD(t)                                                                                   \
  do {                                                                                               \
    _Pragma("unroll") for (int i = 0; i < 5; ++i) st[i] = *(const uint4*)(src[i] + (size_t)(t) * (i < 3 ? AT_KT * 96 : AT_KT)); \
  } while (0)
#define AT_WRITE(buf)                                                                                \
  do {                                                                                               \
    char* base_ = smem + (buf) * AT_STAGE;                                                           \
    _Pragma("unroll") for (int i = 0; i < 5; ++i) {                                                  \
      uint2* d_ = (uint2*)(base_ + dst[i]);                                                          \
      d_[0] = make_uint2(st[i].x, st[i].y);                                                          \
      d_[1] = make_uint2(st[i].z, st[i].w);                                                          \
    }                                                                                                \
  } while (0)
#define AT_QK(S, kb)                                                                                 \
  __builtin_amdgcn_s_setprio(1);                                                                     \
  _Pragma("unroll") for (int ks = 0; ks < 6; ++ks) {                                                 \
    bf16x8 a_ = *(const bf16x8*)(Ks + ((kb) * 32 + r) * AT_KP + ks * 32 + hh * 16);                  \
    S = __builtin_amdgcn_mfma_f32_32x32x16_bf16(a_, qf[ks], S, 0, 0, 0);                             \
  }                                                                                                  \
  __builtin_amdgcn_s_setprio(0);
#define AT_SOFT_PV(S, kb)                                                                            \
  _Pragma("unroll") for (int i = 0; i < 16; ++i) { S[i] = __builtin_amdgcn_exp2f(S[i]); ps += S[i]; } \
  _Pragma("unroll") for (int sI = 0; sI < 2; ++sI) {                                                 \
    union { bf16x8 v; unsigned u[4]; } pu;                                                           \
    _Pragma("unroll") for (int j = 0; j < 4; ++j) pu.u[j] = pk2(S[8 * sI + 2 * j], S[8 * sI + 2 * j + 1]); \
    const int koff = ((kb) * 32 + 16 * sI + 4 * hh) * 2;                                             \
    union { bf16x8 v; uint2 h2[2]; } va, vb;                                                         \
    va.h2[0] = *(const uint2*)(Vs + r * AT_VP + koff);                                               \
    va.h2[1] = *(const uint2*)(Vs + r * AT_VP + koff + 16);                                          \
    vb.h2[0] = *(const uint2*)(Vs + (32 + r) * AT_VP + koff);                                        \
    vb.h2[1] = *(const uint2*)(Vs + (32 + r) * AT_VP + koff + 16);                                   \
    o0 = __builtin_amdgcn_mfma_f32_32x32x16_bf16(va.v, pu.v, o0, 0, 0, 0);                           \
    o1 = __builtin_amdgcn_mfma_f32_32x32x16_bf16(vb.v, pu.v, o1, 0, 0, 0);                           \
  }
  AT_LOAD(0);
  AT_WRITE(0);
  __syncthreads();
  for (int t = 0; t < nkt; ++t) {
    const int cur = t & 1;
    if (t + 1 < nkt) AT_LOAD(t + 1);
    const char* Ks = smem + cur * AT_STAGE;
    const char* Vs = Ks + AT_KT * AT_KP;
    const float nm = -mrun;
    f32x16 sA, sB;
    float ps = 0.f;
#pragma unroll
    for (int i = 0; i < 16; ++i) sA[i] = nm;
    AT_QK(sA, 0)
#pragma unroll
    for (int i = 0; i < 16; ++i) sB[i] = nm;
    AT_QK(sB, 1)
    AT_SOFT_PV(sA, 0)
#pragma unroll
    for (int i = 0; i < 16; ++i) sA[i] = nm;
    AT_QK(sA, 2)
    AT_SOFT_PV(sB, 1)
#pragma unroll
    for (int i = 0; i < 16; ++i) sB[i] = nm;
    AT_QK(sB, 3)
    AT_SOFT_PV(sA, 2)
    AT_SOFT_PV(sB, 3)
    lrun += ps;
    float pmx = fmaxf(ps, shx(ps, 32));
    if (__any(pmx > 65536.f)) {
      const float delta = pmx > 65536.f ? ceilf(__log2f(pmx)) : 0.f;
      const float alpha = __builtin_amdgcn_exp2f(-delta);
      mrun += delta;
      lrun *= alpha;
#pragma unroll
      for (int i = 0; i < 16; ++i) { o0[i] *= alpha; o1[i] *= alpha; }
    }
    if (t + 1 < nkt) AT_WRITE(cur ^ 1);
    __syncthreads();
  }
  const float ltot = lrun + shx(lrun, 32);
  const float inv = 1.f / ltot;
  const int b = bh >> 3, head = bh & 7;
  u16* Op = (u16*)(p.ws + WS_O) + ((size_t)b * SP + qb * 256 + wid * 32 + r) * 512 + head * 64;
#pragma unroll
  for (int g = 0; g < 4; ++g) {
    uint2 w0, w1;
    w0.x = pk2(o0[4 * g] * inv, o0[4 * g + 1] * inv);
    w0.y = pk2(o0[4 * g + 2] * inv, o0[4 * g + 3] * inv);
    w1.x = pk2(o1[4 * g] * inv, o1[4 * g + 1] * inv);
    w1.y = pk2(o1[4 * g + 2] * inv, o1[4 * g + 3] * inv);
    *(uint2*)(Op + 8 * g + 4 * hh) = w0;
    *(uint2*)(Op + 32 + 8 * g + 4 * hh) = w1;
  }
#undef AT_LOAD
#undef AT_WRITE
#undef AT_QK
#undef AT_SOFT_PV
}

__device__ __forceinline__ void hypost_task(const Ctx& p, int task, char* smem) {
  const int tid = tid_l(), lane = tid & 63, wid = tid >> 6;
  const int tile64 = task >> 1, ch0 = (task & 1) * 256;
  const int m0 = tile64 * 64, b = m0 / SP, pos0 = m0 - b * SP;
  float* T = (float*)smem;
  const float* ZV = (const float*)(p.ws + WS_ZV);
#pragma unroll 8
  for (int cc = 0; cc < 32; ++cc) {
    int c = wid * 32 + cc;
    T[c * 65 + lane] = ZV[((size_t)(ch0 + c) * SP + pos0 + lane) * 2 + b];
  }
  __syncthreads();
  u16* Y = (u16*)(p.ws + WS_Y);
  const int c = tid & 255, th = tid >> 8;
  u16* yp = Y + (size_t)(m0 + th * 32) * 512 + ch0 + c;
  u16 yv[32];
#pragma unroll
  for (int i = 0; i < 32; ++i) yv[i] = yp[(size_t)i * 512];
#pragma unroll
  for (int i = 0; i < 32; ++i) yp[(size_t)i * 512] = f2bf(bf2f(yv[i]) * T[c * 65 + th * 32 + i]);
  __syncthreads();
}

#ifndef PHMASK
#define PHMASK 0xFFFF
#endif
#define PHON(k) (((PHMASK) >> (k)) & 1)
constexpr int NPH = 1 + 4 * 10 + 1;
__global__ void __launch_bounds__(NT, 2) mega(Params prm) {
  __shared__ __attribute__((aligned(1024))) char smem[LDS_BYTES];
  cg::grid_group grid = cg::this_grid();
  const int bid = blockIdx.x, nb = gridDim.x;
  {
    unsigned long long* it = (unsigned long long*)(smem + AUX_OFF + 6144);
    if (threadIdx.x < 33) it[threadIdx.x] = (unsigned long long)prm.in[threadIdx.x];
    if (threadIdx.x == 0) *(uint4*)(smem + AUX_OFF + 7168) = make_uint4(0u, 0u, 0u, 0u);
    __syncthreads();
  }
  XcdBarrier xbar = xcd_barrier_post((unsigned*)(prm.ws + WS_BAR), (volatile LAS unsigned*)(smem + AUX_OFF + 7168));
  if (prm.ph_lo == 0) {
    Ctx p;
    p.intab = (const unsigned long long*)(smem + AUX_OFF + 6144);
    p.ws = prm.ws;
    p.out = prm.out;
    const int bid = blockIdx.x, nb = gridDim.x;
      if (PHON(10)) {
      p0_misc(p);
      for (int t = bid; t < 192; t += nb) p0_mod_task(p, t, smem);
      for (int t = bid; t < 528; t += nb) p0_hid_task(p, t, smem);
      for (int t = bid; t < 128; t += nb) { const int w = (t + 64) & 127; wpe_task(p, w >> 5, w & 31, smem); }
      }
  }
  unsigned nbar = 0;
  for (int ph = prm.ph_lo; ph < prm.ph_hi; ++ph) {
    Ctx p;
    p.intab = (const unsigned long long*)(smem + AUX_OFF + 6144);
    p.ws = prm.ws;
    p.out = prm.out;
    asm volatile("" : "+s"(p.ws), "+s"(p.out));
    float* modall = (float*)(p.ws + WS_MOD);
    u16* proj = (u16*)(p.ws + WS_PROJ);
    u16* xn = (u16*)(p.ws + WS_U);
    char* wo = (char*)p.out;
    if (ph == 0) {
    } else if (ph == NPH - 1) {
      if (PHON(11)) final_norm(p);
    } else {
      const int l = (ph - 1) / 10, sp = (ph - 1) % 10;
      const float* modl = modall + (size_t)l * 3 * 6144;
      GD* tab = (GD*)(smem + AUX_OFF + 4096);
      int ng = 0, nN0 = 0, nN1 = 0, nsplit = 1;
      const bool last = (l == 3);
      const float* gate = modl;
      if (sp == 0 && PHON(0)) {
        wt_phase(p, l, smem);
        norm_rows(p, pin(p, 6) + l * 1024, modl, 0, 1, xn);
      } else if (sp == 1 && PHON(1)) {
        if (threadIdx.x == 0) tab[0] = GD{xn, 1024, (const u16*)(wo + WO_IN), 1024, 1024, 23, EM_PROJ, 1};
        ng = 1; nN0 = 23;
      } else if (sp == 2 && PHON(2)) {
        for (int t = bid; t < 264 * 6; t += nb) premix_task(p, l, t, smem);
        {
          Epi ef{EM_FILT, p.ws, gate, nullptr, (u16*)(wo + WO_FILT)};
          const u16* hA = (const u16*)(p.ws + WS_HID2) + (size_t)l * 8192 * 64;
          const u16* wB = (const u16*)(p.ws + WS_W3T) + (size_t)l * 1024 * 64;
#pragma unroll 1
          for (int t = nb - 1 - bid; t < 128; t += nb) gemm_tile(hA, 64, wB, 64, 64, (t >> 2) * 256, (t & 3) * 256, smem, ef);
        }
      } else if (sp == 3 && PHON(3)) {
        for (int t = bid; t < 512; t += nb) fft_task(p, l, t, smem);
        if (threadIdx.x == 0) {
          tab[0] = GD{proj + OFF_Q, DINP, (const u16*)(wo + WO_UQ), 384, 384, 3, EM_Q, 1};
          tab[1] = GD{proj + OFF_KV, DINP, (const u16*)(wo + WO_UKV), 256, 256, 4, EM_KV, 1};
        }
        ng = 2; nN0 = 3; nN1 = 4;
        for (int i = tid_l(); i < 1024; i += NT) ((float2*)(smem + 131072))[i] = ((const float2*)(p.ws + WS_ROPE))[i];
      } else if (sp == 4 && PHON(4)) {
        for (int t = bid; t < (last ? 512 : 528); t += nb) {
          int bh, qb;
          if (t < 512) { int rnd = t >> 8, w = t & 255; bh = (w & 7) + 8 * rnd; qb = 1 + (w >> 3); }
          else { bh = t - 512; qb = 0; }
          attn_task(p, bh, qb, smem);
        }
        for (int t = bid; t < 528; t += nb) hypost_task(p, t, smem);
      } else if (sp == 5 && PHON(5)) {
        for (int t = bid; t < (last ? 512 : 544); t += nb) {
          if (t < 512) {
            const int x = t & 7, g = t >> 3, pmi = (g >> 2) * 8 + x, pm = pmi + 2 + (pmi >= 64 ? 2 : 0);
            mix_tile<4>(p, l, pm * 128, g & 3, smem);
          } else {
            const int c = t - 512, cm = c >> 2;
            mix_tile<2>(p, l, (cm >> 2) * SP + (cm & 3) * 64, c & 3, smem);
          }
        }
      } else if (sp == 6 && PHON(6)) {
        if (threadIdx.x == 0) tab[0] = GD{(const u16*)(p.ws + WS_ZV), 1024, (const u16*)(wo + WO_OUT), 1024, 1024, 4, EM_RESID, 4};
        ng = 1; nN0 = 4; nsplit = 4;
        gate = modl + 2 * 1024;
      } else if (sp == 7 && PHON(7)) {
        norm_rows(p, pin(p, 7) + l * 1024, modl, 3, 4, xn);
      } else if (sp == 8 && PHON(8)) {
        if (threadIdx.x == 0) tab[0] = GD{xn, 1024, (const u16*)(wo + WO_FF1), 1024, 1024, 16, EM_SQRELU, last ? 2 : 1};
        ng = 1; nN0 = 16; nsplit = last ? 2 : 1;
      } else if (sp == 9 && PHON(9)) {
        if (threadIdx.x == 0) tab[0] = GD{proj, DFF, (const u16*)(wo + WO_FF2), 4096, 4096, 4, EM_RESID, 8};
        ng = 1; nN0 = 4; nsplit = 8;
        gate = modl + 5 * 1024;
      }
      if (ng > 0) {
        __syncthreads();
        const int nt0 = (nsplit > 1) ? (64 * nN0 + (last ? 0 : 2 * nN0 * nsplit)) : NMT * nN0, ntot = nt0 + NMT * nN1;
#pragma unroll 1
        for (int t = bid; t < ntot; t += nb) {
          int gi = 0, tt = t;
          if (t >= nt0) { gi = 1; tt = t - nt0; }
          const volatile GD* gp = tab + gi;
          unsigned long long a64 = (unsigned long long)gp->A, b64 = (unsigned long long)gp->Bt;
          a64 = ((unsigned long long)(unsigned)__builtin_amdgcn_readfirstlane((unsigned)(a64 >> 32)) << 32) | (unsigned long long)(unsigned)__builtin_amdgcn_readfirstlane((unsigned)a64);
          b64 = ((unsigned long long)(unsigned)__builtin_amdgcn_readfirstlane((unsigned)(b64 >> 32)) << 32) | (unsigned long long)(unsigned)__builtin_amdgcn_readfirstlane((unsigned)b64);
          const int lda = __builtin_amdgcn_readfirstlane(gp->lda), ldb = __builtin_amdgcn_readfirstlane(gp->ldb);
          const int K = __builtin_amdgcn_readfirstlane(gp->K), nN = __builtin_amdgcn_readfirstlane(gp->nN);
          const int ks = __builtin_amdgcn_readfirstlane(gp->ks);
          const int mode = __builtin_amdgcn_readfirstlane(gp->mode);
          int pm, pn, Kuse = K, emode = mode;
          if (ks > 1) {
            const int nlat = 64 * nN;
            if (tt < nlat) { int pm64; tile_map(tt, 64, nN, pm64, pn); pm = (pm64 >> 5) * 33 + 1 + (pm64 & 31); }
            else {
              int u = tt - nlat, kp = u % ks, tile = u / ks;
              pm = (tile / nN) * 33; pn = tile % nN;
              Kuse = K / ks; emode = EM_RESID_AT;
              a64 += (unsigned long long)kp * Kuse * 2; b64 += (unsigned long long)kp * Kuse * 2;
            }
          } else tile_map(tt, NMT, nN, pm, pn);
          Epi e{emode, p.ws, gate, (const float2*)(smem + 131072), nullptr};
          gemm_tile((const u16*)a64, lda, (const u16*)b64, ldb, Kuse, pm * 256, pn * 256, smem, e);
        }
      }
    }
    if (ph + 1 < prm.ph_hi) {
      if (ph == prm.ph_lo) grid.sync();
      else xcd_barrier(xbar);
    }
  }
}

extern "C" void kernel_launch(void* const* d_in, const int* in_sizes, int n_in, void* d_out, int out_size, void* d_ws,
                              size_t ws_size, hipStream_t stream) {
  static int grid_blocks = 0;
  if (grid_blocks == 0) {
    if (n_in != 33 || ws_size < WS_END || (size_t)out_size * 4 < WO_END) {
      fprintf(stderr, "kernel_launch: unexpected sizes n_in=%d ws=%zu (need %zu) out=%d\n", n_in, ws_size, (size_t)WS_END, out_size);
      grid_blocks = -1;
      return;
    }
    int dev = 0, cus = 0, per_cu = 0;
    hipGetDevice(&dev);
    hipDeviceGetAttribute(&cus, hipDeviceAttributeMultiprocessorCount, dev);
    hipOccupancyMaxActiveBlocksPerMultiprocessor(&per_cu, mega, NT, 0);
    if (per_cu < 1) per_cu = 1;
    if (per_cu > 1) per_cu = 1;
    grid_blocks = cus * per_cu;
  }
  if (grid_blocks < 0) return;
  Params p{};
  for (int i = 0; i < 33; ++i) p.in[i] = (const float*)d_in[i];
  p.out = (float*)d_out;
  p.ws = (char*)d_ws;
  p.ph_lo = 0;
  p.ph_hi = NPH;
  (void)hipMemsetAsync((char*)d_ws + WS_BAR, 0, 16384, stream);
  void* args[] = {&p};
  hipError_t e = hipLaunchCooperativeKernel((void*)mega, dim3(grid_blocks), dim3(NT), args, 0, stream);
  if (e != hipSuccess) fprintf(stderr, "cooperative launch failed: %s (grid %d)\n", hipGetErrorString(e), grid_blocks);
}
```

```cpp
#include <hip/hip_runtime.h>
#include <hip/hip_cooperative_groups.h>
#include <cstdio>
namespace cg = cooperative_groups;

typedef unsigned short u16;
using bf16x8 = __attribute__((ext_vector_type(8))) short;
using f32x4 = __attribute__((ext_vector_type(4))) float;
using f32x16 = __attribute__((ext_vector_type(16))) float;

constexpr int D = 1024, SEQ = 8192, CTX = 256, SP = 8448, MROWS = 16896, NMT = 66;
constexpr int DIN = 5792, DINP = 5888, DFF = 4096;
constexpr int OFF_HY = 512, OFF_Q = 2048, OFF_KV = 2432, OFF_GATE = 2720;
constexpr int NT = 512;
constexpr float EPS = 1e-6f;

constexpr size_t WS_H = 0;
constexpr size_t WS_PROJ = WS_H + (size_t)MROWS * D * 4;
constexpr size_t WS_U = WS_PROJ + (size_t)MROWS * DINP * 2;
constexpr size_t WS_Y = WS_U + (size_t)MROWS * 512 * 2;
constexpr size_t WS_O = WS_Y + (size_t)MROWS * 512 * 2;
constexpr size_t WS_Q = WS_O + (size_t)MROWS * 512 * 2;
constexpr size_t WS_K = WS_Q + (size_t)16 * SP * 96 * 2;
constexpr size_t WS_VT = WS_K + (size_t)16 * SP * 96 * 2;
constexpr size_t WS_ZV = WS_VT + (size_t)16 * 64 * SP * 2;
constexpr size_t WS_HID2 = WS_ZV + (size_t)512 * SP * 8;
constexpr size_t WS_HID2C = WS_HID2 + (size_t)4 * 8192 * 64 * 4;
constexpr size_t WS_MOD = WS_HID2C + (size_t)4 * 256 * 64 * 4;
constexpr size_t WS_ROPE = WS_MOD + (size_t)4 * 3 * 6144 * 4;
constexpr size_t WS_TW = WS_ROPE + (size_t)128 * 8 * 8;
constexpr size_t WS_WPE = WS_TW + (size_t)16384 * 8;
constexpr size_t WS_BAR = WS_WPE + (size_t)4 * 1024 * 512 * 2;
constexpr size_t WS_END = WS_BAR + 16384;
constexpr size_t WO_IN = 0;
constexpr size_t WO_FF1 = WO_IN + (size_t)DINP * 1024 * 2;
constexpr size_t WO_FF2 = WO_FF1 + (size_t)4096 * 1024 * 2;
constexpr size_t WO_OUT = WO_FF2 + (size_t)4096 * 1024 * 2;
constexpr size_t WO_HY = WO_OUT + (size_t)1024 * 1024 * 2;
constexpr size_t WO_WO = WO_HY + (size_t)1024 * 512 * 2;
constexpr size_t WO_PE = WO_WO + (size_t)1024 * 512 * 2;
constexpr size_t WO_UQ = WO_PE + (size_t)1024 * 512 * 2;
constexpr size_t WO_UKV = WO_UQ + (size_t)768 * 384 * 2;
constexpr size_t WO_FILT = WO_UKV + (size_t)1024 * 256 * 2;
constexpr size_t WO_END = WO_FILT + (size_t)1024 * 8192 * 2;
constexpr size_t WS_W3T = WS_HID2 + (size_t)4 * 8192 * 64 * 2;

constexpr int AUX_OFF = 147456;
constexpr int LDS_BYTES = AUX_OFF + 8192;

struct Params {
  const float* in[33];
  float* out;
  char* ws;
  int ph_lo, ph_hi;
};

struct Ctx { const unsigned long long* intab; char* ws; float* out; };
__device__ __forceinline__ const float* pin(const Ctx& c, int i) {
  unsigned long long v = c.intab[i];
  unsigned lo = __builtin_amdgcn_readfirstlane((unsigned)v), hi = __builtin_amdgcn_readfirstlane((unsigned)(v >> 32));
  return (const float*)(((unsigned long long)hi << 32) | lo);
}

typedef __bf16 hwbf2 __attribute__((ext_vector_type(2)));
typedef float hwf2 __attribute__((ext_vector_type(2)));
__device__ __forceinline__ unsigned pk2(float a, float b) {
  hwf2 v = {a, b};
  hwbf2 r = __builtin_convertvector(v, hwbf2);
  return __builtin_bit_cast(unsigned, r);
}
__device__ __forceinline__ u16 f2bf(float f) { return (u16)(pk2(f, 0.f) & 0xffffu); }
__device__ __forceinline__ float bf2f(u16 b) { return __uint_as_float(((unsigned)b) << 16); }
__device__ __forceinline__ float shx(float v, int o) {
  int l = __builtin_amdgcn_mbcnt_hi(~0u, __builtin_amdgcn_mbcnt_lo(~0u, 0u));
  asm volatile("" : "+v"(l));
  return __int_as_float(__builtin_amdgcn_ds_bpermute((l ^ o) << 2, __float_as_int(v)));
}
__device__ __forceinline__ float wave_sum(float v) {
#pragma unroll
  for (int o = 1; o < 64; o <<= 1) v += shx(v, o);
  return v;
}
__device__ __forceinline__ int grp_of_row(int m) {
  int tile = m >> 8, b = tile / 33, t33 = tile - b * 33;
  return t33 == 0 ? 2 : b;
}
__device__ __forceinline__ float2 cmul(float2 a, float2 b) { return make_float2(a.x * b.x - a.y * b.y, a.x * b.y + a.y * b.x); }

__device__ __forceinline__ int tid_l() { int t = threadIdx.x; asm volatile("" : "+v"(t)); return t; }
#define XB_TMO      128
#define XB_XCNT(j)  (256  + 64 * (j))
#define XB_XSUB(j)  (1280 + 64 * (j))
#define XB_XGEN(j)  (2304 + 64 * (j))
#define XB_TOP      3328
#define XB_TOPGEN   3392
#define XCD_BAR_WORDS 3456
#define XB_SPIN_CAP (1u << 18)
#define LAS __attribute__((address_space(3)))
__device__ __forceinline__ unsigned xb_ld(unsigned* p)              { return __hip_atomic_load(p, __ATOMIC_RELAXED, __HIP_MEMORY_SCOPE_AGENT); }
__device__ __forceinline__ unsigned xb_add(unsigned* p, unsigned v) { return __hip_atomic_fetch_add(p, v, __ATOMIC_RELAXED, __HIP_MEMORY_SCOPE_AGENT); }
__device__ __forceinline__ unsigned xb_xcc_id() { return (unsigned)__builtin_amdgcn_s_getreg((3 << 11) | 20) & 0xFu; }
#define XB_SPIN(cond, bar) do { unsigned _sp = 0; while (cond) { __builtin_amdgcn_s_sleep(1); \
    if ((++_sp & 255u) == 0u) { if (xb_ld(&(bar)[XB_TMO])) break; if (_sp > XB_SPIN_CAP) { atomicAdd(&(bar)[XB_TMO], 1u); break; } } } } while (0)
struct XcdBarrier { unsigned* bar; unsigned x; volatile LAS unsigned* st; };
__device__ __forceinline__ XcdBarrier xcd_barrier_post(unsigned* bar, volatile LAS unsigned* st) {
    XcdBarrier b; b.bar = bar; b.x = xb_xcc_id(); b.st = st;
    if (threadIdx.x == 0) (void)xb_add(&bar[XB_XCNT(b.x)], 1u);
    return b;
}
__device__ __forceinline__ void xcd_barrier_complete(unsigned* bar, unsigned x, unsigned& nloc, unsigned& nx) {
    const unsigned G = gridDim.x * gridDim.y * gridDim.z;
    unsigned sum, cnt, mine, sp = 0u;
    for (;;) {
        sum = 0u; cnt = 0u; mine = 0u;
#pragma unroll
        for (unsigned j = 0; j < 16; ++j) { const unsigned c = xb_ld(&bar[XB_XCNT(j)]); sum += c; cnt += (c > 0u) ? 1u : 0u; mine = (j == x) ? c : mine; }
        if (sum == G) break;
        __builtin_amdgcn_s_sleep(1);
        if ((++sp & 255u) == 0u) { if (xb_ld(&bar[XB_TMO])) break; if (sp > XB_SPIN_CAP) { atomicAdd(&bar[XB_TMO], 1u); break; } }
    }
    nloc = mine > 0u ? mine : 1u; nx = cnt > 0u ? cnt : 1u;
}
__device__ __forceinline__ void xcd_barrier(const XcdBarrier& b) {
    asm volatile("s_waitcnt vmcnt(0)" ::: "memory");
    __syncthreads();
    if (threadIdx.x == 0) {
        unsigned* bar = b.bar;
        __builtin_amdgcn_s_waitcnt(0);
        unsigned nloc = b.st[0], nx = b.st[1];
        if (nloc == 0u) { xcd_barrier_complete(bar, b.x, nloc, nx); b.st[0] = nloc; b.st[1] = nx; }
        const unsigned old = xb_add(&bar[XB_XSUB(b.x)], 1u);
        const unsigned gen = old / nloc;
        if (old + 1u == (gen + 1u) * nloc) {
            __builtin_amdgcn_fence(__ATOMIC_RELEASE, "agent");
            asm volatile("s_waitcnt vmcnt(0)" ::: "memory");
            const unsigned og = xb_add(&bar[XB_TOP], 1u);
            const unsigned tg = og / nx;
            if (og + 1u == (tg + 1u) * nx) xb_add(&bar[XB_TOPGEN], 1u);
            else XB_SPIN(xb_ld(&bar[XB_TOPGEN]) == tg, bar);
            __builtin_amdgcn_fence(__ATOMIC_ACQUIRE, "agent");
            xb_add(&bar[XB_XGEN(b.x)], 1u);
            asm volatile("s_waitcnt vmcnt(0)" ::: "memory");
        } else {
            XB_SPIN(xb_ld(&bar[XB_XGEN(b.x)]) == gen, bar);
            __builtin_amdgcn_fence(__ATOMIC_ACQUIRE, "agent");
            asm volatile("s_waitcnt vmcnt(0)" ::: "memory");
        }
    }
    __syncthreads();
}

__device__ __forceinline__ void grid_barrier(unsigned* bar, unsigned target) {
  asm volatile("s_waitcnt vmcnt(0)" ::: "memory");
  __syncthreads();
  if (threadIdx.x == 0) {
    __builtin_amdgcn_fence(__ATOMIC_RELEASE, "agent");
    asm volatile("s_waitcnt vmcnt(0)" ::: "memory");
    __hip_atomic_fetch_add(bar, 1u, __ATOMIC_RELAXED, __HIP_MEMORY_SCOPE_AGENT);
    while (__hip_atomic_load(bar, __ATOMIC_RELAXED, __HIP_MEMORY_SCOPE_AGENT) < target) __builtin_amdgcn_s_sleep(2);
    __builtin_amdgcn_fence(__ATOMIC_ACQUIRE, "agent");
    asm volatile("s_waitcnt vmcnt(0)" ::: "memory");
  }
  __syncthreads();
}
#define WAIT_V(n) asm volatile("s_waitcnt vmcnt(%0)" ::"n"(n) : "memory")
#define SCHED() __builtin_amdgcn_sched_barrier(0)
#define RAW_BARRIER() do { asm volatile("s_waitcnt lgkmcnt(0)" ::: "memory"); __builtin_amdgcn_s_barrier(); } while (0)

constexpr float QSCALE = 0.10206207261596575f * 1.4426950408889634f;
enum { EM_PROJ = 0, EM_SQRELU = 1, EM_RESID = 2, EM_RESID_AT = 3, EM_FILT = 4, EM_Q = 6, EM_KV = 7 };
struct Epi {
  int mode;
  char* ws;
  const float* gate;
  const float2* rope_lds;
  u16* filt_out;
  __device__ __forceinline__ void proj(int row, int col, f32x4 v) const {
    {
      u16* out = (u16*)(ws + WS_PROJ);
#pragma unroll
      for (int j = 0; j < 4; ++j) out[(size_t)(row + j) * DINP + col] = f2bf(v[j]);
    }
  }
  __device__ __forceinline__ void sqrelu(int row, int col, f32x4 v) const {
    {
      u16* out = (u16*)(ws + WS_PROJ);
#pragma unroll
      for (int j = 0; j < 4; ++j) { float r = fmaxf(v[j], 0.f); out[(size_t)(row + j) * DFF + col] = f2bf(r * r); }
    }
  }
  __device__ __forceinline__ void resid(int row, int col, f32x4 v) const {
    {
      float* h = (float*)(ws + WS_H);
      float g = gate[grp_of_row(row) * 6144 + col];
#pragma unroll
      for (int j = 0; j < 4; ++j) unsafeAtomicAdd(h + (size_t)(row + j) * D + col, g * v[j]);
    }
  }
  __device__ __forceinline__ void filt(int row, int col, f32x4 v) const {
    uint2 o;
    o.x = pk2(v[0], v[1]);
    o.y = pk2(v[2], v[3]);
    *(uint2*)(filt_out + (size_t)col * 8192 + row) = o;
  }
  __device__ __forceinline__ void q(int row, int col, f32x4 v) const {
    {
      u16* Q = (u16*)(ws + WS_Q);
      const float2* rope = rope_lds;
      int head = col / 96, d = col - head * 96;
      int b = row / SP, pos0 = row - b * SP;
      bool isrope = (d >= 64) && (pos0 >= CTX);
      int rd = d - 64;
#pragma unroll
      for (int j = 0; j < 4; ++j) {
        float val = v[j];
        float partner = shx(val, 8);
        int pos = pos0 + j;
        if (isrope) {
          int t = pos - CTX, idx = (rd < 16) ? (t >> 6) : (t & 63);
          float2 cs = rope[idx * 8 + (rd & 7)];
          float sgn = (rd & 8) ? 1.f : -1.f;
          val = val * cs.x + sgn * partner * cs.y;
        }
        Q[((size_t)(b * 8 + head) * SP + pos) * 96 + d] = f2bf(val * QSCALE);
      }
    }
  }
  __device__ __forceinline__ void kv(int row, int col, f32x4 v) const {
    {
      u16* Kb = (u16*)(ws + WS_K);
      u16* Vt = (u16*)(ws + WS_VT);
      int head = col >> 7, j2 = col & 127;
      int b = row / SP, pos0 = row - b * SP;
      if (j2 < 64) {
#pragma unroll
        for (int j = 0; j < 4; ++j) Kb[((size_t)(b * 8 + head) * SP + pos0 + j) * 96 + j2] = f2bf(v[j]);
      } else {
        uint2 o;
        o.x = pk2(v[0], v[1]);
        o.y = pk2(v[2], v[3]);
        *(uint2*)(Vt + ((size_t)(b * 8 + head) * 64 + (j2 - 64)) * SP + pos0) = o;
      }
    }
  }
};
struct GD { const u16* A; int lda; const u16* Bt; int ldb; int K; int nN; int mode; int ks; };

constexpr int G_TILE_B = 256 * 64 * 2, G_STAGE_B = 2 * G_TILE_B;
__device__ __forceinline__ int lds_byte(int r, int c) {
  int st = (r >> 4) * 2 + (c >> 5), ob = (r & 15) * 64 + (c & 31) * 2;
  return st * 1024 + (ob ^ (((ob >> 9) & 1) << 5));
}
__device__ __forceinline__ void stage_rc(int b, int& R, int& C) {
  int st = b >> 10, sb = b & 1023, swz = sb ^ (((sb >> 9) & 1) << 5);
  R = (st / 2) * 16 + swz / 64;
  C = (st % 2) * 32 + (swz % 64) / 2;
}

template <int MI>
__device__ __forceinline__ void gemm_core(const u16* __restrict__ A, int lda, const u16* __restrict__ Bt, int ldb, int K,
                                          int brow, int bcol, char* shm, f32x4 (&acc)[MI][4]) {
  constexpr int TILE_A = MI * 32 * 64 * 2, TILE_BB = 256 * 64 * 2, STAGE = TILE_A + TILE_BB;
  const int tid = tid_l(), wid = tid >> 6, lane = tid & 63, wr = wid >> 2, wc = wid & 3, fr = lane & 15, fq = lane >> 4;
  const u16* Ab = A + (size_t)brow * lda;
  const u16* Bb = Bt + (size_t)bcol * ldb;
  int sR[4], sC[4];
#pragma unroll
  for (int i = 0; i < 4; ++i) stage_rc(wid * 1024 + i * 8192 + lane * 16, sR[i], sC[i]);
#define SA(b) (shm + (b) * STAGE)
#define SB(b) (shm + (b) * STAGE + TILE_A)
#define GLDS_STAGE(buf, kt)                                                                                              \
  do {                                                                                                                   \
    _Pragma("unroll") for (int i = 0; i < 4; ++i) {                                                                      \
      if (i < MI / 2)                                                                                                    \
        __builtin_amdgcn_global_load_lds((const unsigned*)(Ab + (size_t)sR[i] * lda + (kt) * 64 + sC[i]),                \
                                         (unsigned*)(SA(buf) + wid * 1024 + i * 8192), 16, 0, 0);                        \
      __builtin_amdgcn_global_load_lds((const unsigned*)(Bb + (size_t)sR[i] * ldb + (kt) * 64 + sC[i]),                  \
                                       (unsigned*)(SB(buf) + wid * 1024 + i * 8192), 16, 0, 0);                          \
    }                                                                                                                    \
  } while (0)
  const int nt = K / 64;
  GLDS_STAGE(0, 0);
  WAIT_V(0);
  __syncthreads();
  for (int t = 0; t < nt; ++t) {
    const int cur = t & 1;
    if (t + 1 < nt) GLDS_STAGE(cur ^ 1, t + 1);
#pragma unroll
    for (int ks = 0; ks < 2; ++ks) {
      bf16x8 At[MI], Bf[4];
#pragma unroll
      for (int m = 0; m < MI; ++m) At[m] = *(const bf16x8*)(SA(cur) + lds_byte(wr * (MI * 16) + m * 16 + fr, ks * 32 + fq * 8));
#pragma unroll
      for (int n = 0; n < 4; ++n) Bf[n] = *(const bf16x8*)(SB(cur) + lds_byte(wc * 64 + n * 16 + fr, ks * 32 + fq * 8));
#pragma unroll
      for (int m = 0; m < MI; ++m)
#pragma unroll
        for (int n = 0; n < 4; ++n) acc[m][n] = __builtin_amdgcn_mfma_f32_16x16x32_bf16(At[m], Bf[n], acc[m][n], 0, 0, 0);
      SCHED();
    }
    WAIT_V(0);
    __syncthreads();
  }
#undef SA
#undef SB
#undef GLDS_STAGE
}

template <class EpiT>
__device__ __forceinline__ void gemm_tile(const u16* __restrict__ A, int lda, const u16* __restrict__ Bt, int ldb, int K,
                                          int brow, int bcol, char* shm, const EpiT& epi) {
  const int tid = tid_l(), wid = tid >> 6, lane = tid & 63, wr = wid >> 2, wc = wid & 3, fr = lane & 15, fq = lane >> 4;
  f32x4 acc[8][4];
#pragma unroll
  for (int m = 0; m < 8; ++m)
#pragma unroll
    for (int n = 0; n < 4; ++n) acc[m][n] = (f32x4){0.f, 0.f, 0.f, 0.f};
  gemm_core<8>(A, lda, Bt, ldb, K, brow, bcol, shm, acc);
#define EPI_LOOP(CALL)                                                                              \
  _Pragma("unroll") for (int m = 0; m < 8; ++m) _Pragma("unroll") for (int n = 0; n < 4; ++n) {      \
    const int row = brow + wr * 128 + m * 16 + fq * 4, col = bcol + wc * 64 + n * 16 + fr;           \
    const f32x4 v = acc[m][n];                                                                        \
    CALL;                                                                                             \
  }
  if (epi.mode == EM_PROJ) { EPI_LOOP(epi.proj(row, col, v)) }
  else if (epi.mode == EM_SQRELU) { EPI_LOOP(epi.sqrelu(row, col, v)) }
  else if (epi.mode == EM_RESID_AT) { EPI_LOOP(epi.resid(row, col, v)) }
  else if (epi.mode == EM_RESID) {
    float* h = (float*)(epi.ws + WS_H);
    float g4[4];
#pragma unroll
    for (int n = 0; n < 4; ++n) g4[n] = epi.gate[grp_of_row(brow) * 6144 + bcol + wc * 64 + n * 16 + fr];
    float hv[8][4][4];
    float* hp0 = h + (size_t)(brow + wr * 128 + fq * 4) * D + bcol + wc * 64 + fr;
#define H_LOAD(m) _Pragma("unroll") for (int n = 0; n < 4; ++n) _Pragma("unroll") for (int j = 0; j < 4; ++j) hv[m][n][j] = hp0[(size_t)((m) * 16 + j) * D + n * 16]
#define H_STORE(m) _Pragma("unroll") for (int n = 0; n < 4; ++n) _Pragma("unroll") for (int j = 0; j < 4; ++j) hp0[(size_t)((m) * 16 + j) * D + n * 16] = hv[m][n][j] + g4[n] * acc[m][n][j]
    H_LOAD(0); H_LOAD(1);
    SCHED();
    H_STORE(0); H_LOAD(2); SCHED();
    H_STORE(1); H_LOAD(3); SCHED();
    H_STORE(2); H_LOAD(4); SCHED();
    H_STORE(3); H_LOAD(5); SCHED();
    H_STORE(4); H_LOAD(6); SCHED();
    H_STORE(5); H_LOAD(7); SCHED();
    H_STORE(6); H_STORE(7);
#undef H_LOAD
#undef H_STORE
  }
  else if (epi.mode == EM_FILT) { EPI_LOOP(epi.filt(row, col, v)) }
  else if (epi.mode == EM_Q) { EPI_LOOP(epi.q(row, col, v)) }
  else { EPI_LOOP(epi.kv(row, col, v)) }
#undef EPI_LOOP
}

template <int MI>
__device__ __forceinline__ void mix_tile(const Ctx& p, int l, int brow, int pn, char* shm) {
  constexpr int TILE_A = MI * 32 * 64 * 2, TILE_BB = 256 * 64 * 2, STAGE = TILE_A + TILE_BB, WROWS = MI * 16;
  const int tid = tid_l(), wid = tid >> 6, lane = tid & 63, wr = wid >> 2, wc = wid & 3, fr = lane & 15, fq = lane >> 4;
  const int bcol = pn * 256;
  const u16* projb = (const u16*)(p.ws + WS_PROJ);
  char* wo = (char*)p.out;
#define SA(b) (shm + (b) * STAGE)
#define SB(b) (shm + (b) * STAGE + TILE_A)
#define MIX_STAGE(buf, kt)                                                                                               \
  do {                                                                                                                   \
    const int br_ = (kt) >> 3, ko_ = ((kt) & 7) * 64;                                                                    \
    const u16* Ab_ = (const u16*)(p.ws + (br_ == 0 ? WS_U : br_ == 1 ? WS_Y : WS_O)) + (size_t)brow * 512 + ko_;         \
    const u16* Bb_ = (br_ == 0 ? (const u16*)(p.ws + WS_WPE) + (size_t)l * 1024 * 512 : (const u16*)(wo + (br_ == 1 ? WO_HY : WO_WO))) + (size_t)bcol * 512 + ko_;        \
    _Pragma("unroll") for (int i = 0; i < 4; ++i) {                                                                      \
      int sR_, sC_; stage_rc(wid * 1024 + i * 8192 + lane * 16, sR_, sC_);                                              \
      if (i < MI / 2)                                                                                                    \
        __builtin_amdgcn_global_load_lds((const unsigned*)(Ab_ + sR_ * 512 + sC_),                           \
                                         (unsigned*)(SA(buf) + wid * 1024 + i * 8192), 16, 0, 0);                        \
      __builtin_amdgcn_global_load_lds((const unsigned*)(Bb_ + sR_ * 512 + sC_),                             \
                                       (unsigned*)(SB(buf) + wid * 1024 + i * 8192), 16, 0, 0);                          \
    }                                                                                                                    \
  } while (0)
  f32x4 tot[MI][4], acc[MI][4];
#pragma unroll
  for (int m = 0; m < MI; ++m)
#pragma unroll
    for (int n = 0; n < 4; ++n) { tot[m][n] = (f32x4){0.f, 0.f, 0.f, 0.f}; acc[m][n] = (f32x4){0.f, 0.f, 0.f, 0.f}; }
  MIX_STAGE(0, 0);
  MIX_STAGE(1, 1);
  WAIT_V(6);
  RAW_BARRIER();
  int cur = 0;
#pragma unroll 1
  for (int br = 0; br < 3; ++br) {
    unsigned gpk[MI][4][2];
    const u16* gp = projb + (size_t)(brow + wr * WROWS + fq * 4) * DINP + OFF_GATE + br * 1024 + bcol + wc * 64 + fr;
#define GATE_LOAD(m)                                                                                   \
    _Pragma("unroll") for (int n = 0; n < 4; ++n) _Pragma("unroll") for (int j2 = 0; j2 < 2; ++j2) {       \
      unsigned lo = gp[(size_t)((m) * 16 + 2 * j2) * DINP + n * 16], hi = gp[(size_t)((m) * 16 + 2 * j2 + 1) * DINP + n * 16]; \
      gpk[m][n][j2] = lo | (hi << 16);                                                                     \
    }
    GATE_LOAD(0); GATE_LOAD(1);
    if (MI == 4) { GATE_LOAD(2); }
#pragma unroll 1
    for (int kk = 0; kk < 8; ++kk) {
      const int t = br * 8 + kk;
      { int nx = cur + 2; if (nx >= 3) nx -= 3; if (t + 2 < 24) MIX_STAGE(nx, t + 2); }
#pragma unroll
      for (int ks = 0; ks < 2; ++ks) {
        bf16x8 At[2], Bf[4];
#pragma unroll
        for (int n = 0; n < 4; ++n) Bf[n] = *(const bf16x8*)(SB(cur) + lds_byte(wc * 64 + n * 16 + fr, ks * 32 + fq * 8));
#pragma unroll
        for (int mh = 0; mh < MI / 2; ++mh) {
#pragma unroll
          for (int m = 0; m < 2; ++m) At[m] = *(const bf16x8*)(SA(cur) + lds_byte(wr * WROWS + (mh * 2 + m) * 16 + fr, ks * 32 + fq * 8));
#pragma unroll
          for (int m = 0; m < 2; ++m)
#pragma unroll
            for (int n = 0; n < 4; ++n) acc[mh * 2 + m][n] = __builtin_amdgcn_mfma_f32_16x16x32_bf16(At[m], Bf[n], acc[mh * 2 + m][n], 0, 0, 0);
          SCHED();
        }
      }
      if (t + 2 < 24) WAIT_V(6); else WAIT_V(0);
      RAW_BARRIER();
      cur = (cur == 2) ? 0 : cur + 1;
    }
    if (MI == 4) { GATE_LOAD(3); }
#undef GATE_LOAD
#pragma unroll
    for (int m = 0; m < MI; ++m)
#pragma unroll
      for (int n = 0; n < 4; ++n)
#pragma unroll
        for (int j = 0; j < 4; ++j) {
          const unsigned w = gpk[m][n][j >> 1];
          const float gv = __uint_as_float((j & 1) ? (w & 0xffff0000u) : (w << 16));
          tot[m][n][j] += acc[m][n][j] * __builtin_amdgcn_rcpf(1.f + __expf(-gv));
          acc[m][n][j] = 0.f;
        }
  }
  u16* mixb = (u16*)(p.ws + WS_ZV);
#pragma unroll
  for (int m = 0; m < MI; ++m)
#pragma unroll
    for (int n = 0; n < 4; ++n)
#pragma unroll
      for (int j = 0; j < 4; ++j)
        mixb[(size_t)(brow + wr * WROWS + m * 16 + fq * 4 + j) * D + bcol + wc * 64 + n * 16 + fr] = f2bf(tot[m][n][j]);
#undef SA
#undef SB
#undef MIX_STAGE
}

__device__ __forceinline__ void tile_map(int t, int nM, int nN, int& pm, int& pn) {
  int nwg = nM * nN, wgid = t;
  {
    int q = nwg / 8, r = nwg % 8, xcd = wgid % 8, off = wgid / 8;
    wgid = (xcd < r ? xcd * (q + 1) : r * (q + 1) + (xcd - r) * q) + off;
  }
  constexpr int WGM = 4;
  int nig = WGM * nN, gid = wgid / nig, fm = gid * WGM, gsz = min(nM - fm, WGM);
  pm = fm + ((wgid % nig) % gsz);
  pn = (wgid % nig) / gsz;
}

__device__ __forceinline__ void p0_misc(const Ctx& p) {
  const int gtid = blockIdx.x * NT + tid_l(), gn = gridDim.x * NT;
  float4* h4 = (float4*)(p.ws + WS_H);
  const float4* x4 = (const float4*)pin(p, 0);
  const float4* c4 = (const float4*)pin(p, 2);
#pragma unroll 8
  for (int i = gtid; i < MROWS * 256; i += gn) {
    int m = i >> 8, q = i & 255, b = m / SP, pos = m - b * SP;
    float4 v = (pos < CTX) ? c4[(size_t)(b * CTX + pos) * 256 + q] : x4[(size_t)(b * SEQ + pos - CTX) * 256 + q];
    h4[i] = v;
  }
  float2* rope = (float2*)(p.ws + WS_ROPE);
  for (int i = gtid; i < 1024; i += gn) {
    int idx = i >> 3, f = i & 7;
    float inv = powf(10000.f, -(float)f / 8.f);
    float a = (float)idx * inv;
    rope[i] = make_float2(cosf(a), sinf(a));
  }
  {
    u16* w3t = (u16*)(p.ws + WS_W3T);
    const float* w3 = pin(p, 20);
    for (int i = gtid; i < 4 * 1024 * 64; i += gn) { int l = i >> 16, c2 = (i >> 6) & 1023, k = i & 63; w3t[i] = f2bf(w3[((size_t)l * 64 + k) * 1024 + c2]); }
  }
  float2* tw = (float2*)(p.ws + WS_TW);
  for (int i = gtid; i < 16384; i += gn) {
    float s, c;
    sincospif(-(float)i / 8192.f, &s, &c);
    tw[i] = make_float2(c, s);
  }
}

__device__ __forceinline__ void p0_mod_task(const Ctx& p, int task, char* smem) {
  float* s = (float*)smem;
  float* red = s + 3072;
  const int tid = tid_l();
  const int l = task / 48, chunk = task - l * 48;
  for (int i = tid; i < 3072; i += NT) {
    int g = i >> 10, k = i & 1023;
    float cv = (g < 2) ? pin(p, 1)[g * 1024 + k] : pin(p, 3)[k];
    s[i] = cv / (1.f + __expf(-cv));
  }
  __syncthreads();
  const int kq = tid >> 7, col = tid & 127, n = chunk * 128 + col;
  const float* W = pin(p, 4) + (size_t)l * 1024 * 6144 + n;
  float a0 = 0.f, a1 = 0.f, a2 = 0.f;
#pragma unroll 32
  for (int k = kq * 256; k < kq * 256 + 256; ++k) {
    float w = W[(size_t)k * 6144];
    a0 += s[k] * w; a1 += s[1024 + k] * w; a2 += s[2048 + k] * w;
  }
  red[(kq * 3 + 0) * 128 + col] = a0;
  red[(kq * 3 + 1) * 128 + col] = a1;
  red[(kq * 3 + 2) * 128 + col] = a2;
  __syncthreads();
  if (tid < 384) {
    int g = tid >> 7, c2 = tid & 127, n2 = chunk * 128 + c2;
    float v = red[(0 * 3 + g) * 128 + c2] + red[(1 * 3 + g) * 128 + c2] + red[(2 * 3 + g) * 128 + c2] + red[(3 * 3 + g) * 128 + c2];
    ((float*)(p.ws + WS_MOD))[(size_t)(l * 3 + g) * 6144 + n2] = v + pin(p, 5)[l * 6144 + n2];
  }
  __syncthreads();
}

__device__ __forceinline__ void p0_hid_task(const Ctx& p, int task, char* smem) {
  float* zs = (float*)smem;
  float* h1 = zs + 8 * 36;
  float* w1s = h1 + 8 * 64;
  float* w2s = w1s + 33 * 64;
  const int tid = tid_l(), tl = tid >> 6, j = tid & 63;
  const int l = task / 132, r = task - l * 132;
  const bool isctx = r >= 128;
  const int L = isctx ? 256 : 8192;
  const int tbase = (isctx ? (r - 128) : r) * 64;
  for (int i = tid; i < 33 * 64; i += NT) w1s[i] = pin(p, 14)[l * 33 * 64 + i];
  for (int i = tid; i < 64 * 64; i += NT) w2s[i] = pin(p, 17)[l * 64 * 64 + i];
  const float b1 = pin(p, 15)[l * 64 + j], f1 = pin(p, 16)[l * 64 + j], b2 = pin(p, 18)[l * 64 + j], f2 = pin(p, 19)[l * 64 + j];
  __syncthreads();
  for (int sub = 0; sub < 8; ++sub) {
    const int t = tbase + sub * 8 + tl;
    if (j < 33) {
      float z;
      if (j == 0) z = (float)t / (float)(L - 1);
      else {
        int i = (j - 1) & 15;
        float band = 1e-4f + (float)i * ((15.f - 1e-4f) / 15.f);
        float omega = 6.2831855f * (float)t / (float)L;
        float a = omega * band;
        z = (j <= 16) ? cosf(a) : -sinf(a);
      }
      zs[tl * 36 + j] = z;
    }
    __syncthreads();
    {
      float a = b1;
#pragma unroll
      for (int k = 0; k < 33; ++k) a += zs[tl * 36 + k] * w1s[k * 64 + j];
      h1[tl * 64 + j] = sinf(f1 * a);
    }
    __syncthreads();
    {
      float a = b2;
#pragma unroll 16
      for (int k = 0; k < 64; ++k) a += h1[tl * 64 + k] * w2s[k * 64 + j];
      float v = sinf(f2 * a);
      if (isctx) ((float*)(p.ws + WS_HID2C))[((size_t)l * 64 + j) * 256 + t] = v;
      else ((u16*)(p.ws + WS_HID2))[((size_t)l * 8192 + t) * 64 + j] = f2bf(v);
    }
  }
  __syncthreads();
}

struct WtItem { const float* W; u16* WT; int K, N, k0, n0; };
__device__ __forceinline__ WtItem wt_decode(const Ctx& p, int l, int r) {
  char* wo = (char*)p.out;
  WtItem it;
  int nblk;
  if (r < 1472) { it.W = pin(p, 8) + (size_t)l * 1024 * DIN; it.K = 1024; it.N = DIN; it.WT = (u16*)(wo + WO_IN); nblk = 92; }
  else if ((r -= 1472) < 1024) { it.W = pin(p, 30) + (size_t)l * 1024 * 4096; it.K = 1024; it.N = 4096; it.WT = (u16*)(wo + WO_FF1); nblk = 64; }
  else if ((r -= 1024) < 1024) { it.W = pin(p, 31) + (size_t)l * 4096 * 1024; it.K = 4096; it.N = 1024; it.WT = (u16*)(wo + WO_FF2); nblk = 16; }
  else if ((r -= 1024) < 256) { it.W = pin(p, 29) + (size_t)l * 1024 * 1024; it.K = 1024; it.N = 1024; it.WT = (u16*)(wo + WO_OUT); nblk = 16; }
  else if ((r -= 256) < 128) { it.W = pin(p, 23) + (size_t)l * 512 * 1024; it.K = 512; it.N = 1024; it.WT = (u16*)(wo + WO_HY); nblk = 16; }
  else if ((r -= 128) < 128) { it.W = pin(p, 28) + (size_t)l * 512 * 1024; it.K = 512; it.N = 1024; it.WT = (u16*)(wo + WO_WO); nblk = 16; }
  else if ((r -= 128) < 72) { it.W = pin(p, 25) + (size_t)l * 384 * 768; it.K = 384; it.N = 768; it.WT = (u16*)(wo + WO_UQ); nblk = 12; }
  else { r -= 72; it.W = pin(p, 27) + (size_t)l * 256 * 1024; it.K = 256; it.N = 1024; it.WT = (u16*)(wo + WO_UKV); nblk = 16; }
  const int kb = r / nblk, nb2 = r - kb * nblk;
  it.k0 = kb * 64; it.n0 = nb2 * 64;
  return it;
}
__device__ __forceinline__ void wt_load(const WtItem& it, int tid, float (&v)[8]) {
  const int nn = tid & 63, kq = tid >> 6;
  const bool ok = it.n0 + nn < it.N;
  const float* src = it.W + (size_t)(it.k0 + kq) * it.N + it.n0 + (ok ? nn : 0);
#pragma unroll
  for (int r = 0; r < 8; ++r) { float x = src[(size_t)(r * 8) * it.N]; v[r] = ok ? x : 0.f; }
}
__device__ __forceinline__ void wt_phase(const Ctx& p, int l, char* smem) {
  float* tile = (float*)smem;
  const int tid = tid_l();
  const int bid = blockIdx.x, nb = gridDim.x;
  int t = bid;
  if (t >= 4168) return;
  WtItem cur = wt_decode(p, l, t);
  float v[8];
  wt_load(cur, tid, v);
#pragma unroll 1
  while (true) {
    const int tn = t + nb;
    const bool more = tn < 4168;
    WtItem nxt = cur;
    float vn[8];
    if (more) { nxt = wt_decode(p, l, tn); wt_load(nxt, tid, vn); }
#pragma unroll
    for (int r = 0; r < 8; ++r) tile[(r * 8 + (tid >> 6)) * 65 + (tid & 63)] = v[r];
    __syncthreads();
    {
      int n = tid >> 3, kc = (tid & 7) * 8;
      uint4 o;
      o.x = pk2(tile[(kc + 0) * 65 + n], tile[(kc + 1) * 65 + n]);
      o.y = pk2(tile[(kc + 2) * 65 + n], tile[(kc + 3) * 65 + n]);
      o.z = pk2(tile[(kc + 4) * 65 + n], tile[(kc + 5) * 65 + n]);
      o.w = pk2(tile[(kc + 6) * 65 + n], tile[(kc + 7) * 65 + n]);
      *(uint4*)(cur.WT + (size_t)(cur.n0 + n) * cur.K + cur.k0 + kc) = o;
    }
    __syncthreads();
    if (!more) break;
    cur = nxt;
#pragma unroll
    for (int r = 0; r < 8; ++r) v[r] = vn[r];
    t = tn;
  }
}

__device__ __forceinline__ void wpe_task(const Ctx& p, int l, int task, char* smem) {
  const int g = task >> 3, c0 = (task & 7) * 16, tid = tid_l();
  const float* pw = pin(p, 9) + ((size_t)(l * 4 + g) * 128) * 128;
  const float* sc = pin(p, 10) + l * 512 + g * 128;
  const float* po = pin(p, 11) + ((size_t)l * 512 + g * 128) * 1024;
  u16* WpeT = (u16*)(p.ws + WS_WPE) + (size_t)l * 1024 * 512;
  float* wl = (float*)smem;
  for (int i = tid; i < 16 * 128; i += NT) { int d = i & 127; wl[i] = pw[(c0 + (i >> 7)) * 128 + d] * sc[d]; }
  __syncthreads();
  float acc0[16], acc1[16];
#pragma unroll
  for (int i = 0; i < 16; ++i) { acc0[i] = 0.f; acc1[i] = 0.f; }
#pragma unroll 16
  for (int d = 0; d < 128; ++d) {
    float p0 = po[(size_t)d * 1024 + tid], p1 = po[(size_t)d * 1024 + 512 + tid];
#pragma unroll
    for (int i = 0; i < 16; ++i) { float w = wl[i * 128 + d]; acc0[i] += w * p0; acc1[i] += w * p1; }
  }
  uint4 o0, o1;
  o0.x = pk2(acc0[0], acc0[1]); o0.y = pk2(acc0[2], acc0[3]); o0.z = pk2(acc0[4], acc0[5]); o0.w = pk2(acc0[6], acc0[7]);
  o1.x = pk2(acc0[8], acc0[9]); o1.y = pk2(acc0[10], acc0[11]); o1.z = pk2(acc0[12], acc0[13]); o1.w = pk2(acc0[14], acc0[15]);
  uint4* dst = (uint4*)(WpeT + (size_t)tid * 512 + g * 128 + c0);
  dst[0] = o0; dst[1] = o1;
  o0.x = pk2(acc1[0], acc1[1]); o0.y = pk2(acc1[2], acc1[3]); o0.z = pk2(acc1[4], acc1[5]); o0.w = pk2(acc1[6], acc1[7]);
  o1.x = pk2(acc1[8], acc1[9]); o1.y = pk2(acc1[10], acc1[11]); o1.z = pk2(acc1[12], acc1[13]); o1.w = pk2(acc1[14], acc1[15]);
  dst = (uint4*)(WpeT + (size_t)(512 + tid) * 512 + g * 128 + c0);
  dst[0] = o0; dst[1] = o1;
  __syncthreads();
}

__device__ __forceinline__ void norm_rows(const Ctx& p, const float* gain, const float* modl, int sh_idx, int sc_idx, u16* outp) {
  const int tidx = tid_l(), lane = tidx & 63, gw = blockIdx.x * 8 + (tidx >> 6), ngw = gridDim.x * 8;
  const float* h = (const float*)(p.ws + WS_H);
  float4 g[4];
#pragma unroll
  for (int j = 0; j < 4; ++j) g[j] = *(const float4*)(gain + lane * 4 + 256 * j);
  for (int m0 = gw; m0 < MROWS; m0 += 2 * ngw) {
    const int m1 = m0 + ngw;
    const bool has1 = m1 < MROWS;
    const int m1c = has1 ? m1 : m0;
    const float4* hr0 = (const float4*)(h + (size_t)m0 * D) + lane;
    const float4* hr1 = (const float4*)(h + (size_t)m1c * D) + lane;
    float4 v0[4], v1[4];
#pragma unroll
    for (int j = 0; j < 4; ++j) { v0[j] = hr0[64 * j]; v1[j] = hr1[64 * j]; }
    const float* mg0 = modl + grp_of_row(m0) * 6144;
    const float* mg1 = modl + grp_of_row(m1c) * 6144;
    float s0 = 0.f, s1 = 0.f;
#pragma unroll
    for (int j = 0; j < 4; ++j) {
      s0 += v0[j].x * v0[j].x + v0[j].y * v0[j].y + v0[j].z * v0[j].z + v0[j].w * v0[j].w;
      s1 += v1[j].x * v1[j].x + v1[j].y * v1[j].y + v1[j].z * v1[j].z + v1[j].w * v1[j].w;
    }
    s0 = wave_sum(s0);
    s1 = wave_sum(s1);
    const float r0 = rsqrtf(s0 * (1.f / D) + EPS), r1 = rsqrtf(s1 * (1.f / D) + EPS);
    uint2* o0 = (uint2*)(outp + (size_t)m0 * D) + lane;
    uint2* o1 = (uint2*)(outp + (size_t)m1c * D) + lane;
#pragma unroll
    for (int j = 0; j < 4; ++j) {
      int n = lane * 4 + 256 * j;
      float4 sc = *(const float4*)(mg0 + sc_idx * 1024 + n), sh = *(const float4*)(mg0 + sh_idx * 1024 + n);
      uint2 o;
      o.x = pk2(v0[j].x * r0 * g[j].x * (1.f + sc.x) + sh.x, v0[j].y * r0 * g[j].y * (1.f + sc.y) + sh.y);
      o.y = pk2(v0[j].z * r0 * g[j].z * (1.f + sc.z) + sh.z, v0[j].w * r0 * g[j].w * (1.f + sc.w) + sh.w);
      o0[64 * j] = o;
    }
    if (has1) {
#pragma unroll
      for (int j = 0; j < 4; ++j) {
        int n = lane * 4 + 256 * j;
        float4 sc = *(const float4*)(mg1 + sc_idx * 1024 + n), sh = *(const float4*)(mg1 + sh_idx * 1024 + n);
        uint2 o;
        o.x = pk2(v1[j].x * r1 * g[j].x * (1.f + sc.x) + sh.x, v1[j].y * r1 * g[j].y * (1.f + sc.y) + sh.y);
        o.y = pk2(v1[j].z * r1 * g[j].z * (1.f + sc.z) + sh.z, v1[j].w * r1 * g[j].w * (1.f + sc.w) + sh.w);
        o1[64 * j] = o;
      }
    }
  }
}

__device__ __forceinline__ void final_norm(const Ctx& p) {
  const int tidx = tid_l(), lane = tidx & 63, gw = blockIdx.x * 8 + (tidx >> 6), ngw = gridDim.x * 8;
  const float* h = (const float*)(p.ws + WS_H);
  const float* gain = pin(p, 32);
  for (int r0 = gw; r0 < 2 * SEQ; r0 += ngw) {
    int b = r0 >> 13, t = r0 & 8191, m = b * SP + CTX + t;
    const float4* hr = (const float4*)(h + (size_t)m * D) + lane;
    float4 v[4];
    float ss = 0.f;
#pragma unroll
    for (int j = 0; j < 4; ++j) { v[j] = hr[64 * j]; ss += v[j].x * v[j].x + v[j].y * v[j].y + v[j].z * v[j].z + v[j].w * v[j].w; }
    ss = wave_sum(ss);
    float r = rsqrtf(ss * (1.f / D) + EPS);
    float4* o = (float4*)(p.out + (size_t)r0 * D) + lane;
#pragma unroll
    for (int j = 0; j < 4; ++j) {
      float4 g = *(const float4*)(gain + lane * 4 + 256 * j);
      o[64 * j] = make_float4(v[j].x * r * g.x, v[j].y * r * g.y, v[j].z * r * g.z, v[j].w * r * g.w);
    }
  }
}

__device__ __forceinline__ void premix_task(const Ctx& p, int l, int task, char* smem) {
  const int tid = tid_l(), lane = tid & 63, wid = tid >> 6;
  const int part = task / 264, tile64 = task - part * 264;
  const int m0 = tile64 * 64, b = m0 / SP, pos0 = m0 - b * SP;
  const bool isctx = pos0 < CTX;
  const int s0 = isctx ? 0 : CTX, L = isctx ? CTX : SEQ, t0 = pos0 - s0;
  const size_t mb = (size_t)b * SP + s0;
  const u16* proj = (const u16*)(p.ws + WS_PROJ);
  if (part == 0) {
    u16* P = (u16*)smem;
#pragma unroll
    for (int i = tid; i < 80 * 64; i += NT) {
      int r = i >> 6, ch = i & 63, t = t0 - 8 + r;
      uint4 v = make_uint4(0, 0, 0, 0);
      if (t >= 0 && t < L) v = *(const uint4*)(proj + (mb + t) * DINP + ch * 8);
      *(uint4*)(P + r * 512 + ch * 8) = v;
    }
    __syncthreads();
    const int c = tid, g = c >> 7, hw = 1 << g;
    u16* U = (u16*)(p.ws + WS_U);
    float s = 0.f;
    for (int q = -hw; q < hw; ++q) s += bf2f(P[(8 + q) * 512 + c]);
#pragma unroll 4
    for (int tt = 0; tt < 64; ++tt) {
      int t = t0 + tt, lo = max(t - hw, 0), hi = min(t + hw, L);
      float u = s * __builtin_amdgcn_rcpf((float)(hi - lo)) - bf2f(P[(tt + 8) * 512 + c]);
      U[(mb + t) * 512 + c] = f2bf(u);
      s += bf2f(P[(tt + 8 + hw) * 512 + c]) - bf2f(P[(tt + 8 - hw) * 512 + c]);
    }
    __syncthreads();
  } else if (part <= 4) {
    const int ch0 = (part - 1) * 128;
    constexpr int PITCH = 136;
    u16* X = (u16*)smem;
    float* T = (float*)(smem + 3 * 66 * PITCH * 2 + 64);
#pragma unroll
    for (int ii = 0; ii < 7; ++ii) {
      const int i = tid + ii * NT;
      if (i >= 3 * 66 * 16) break;
      int pr = i / (66 * 16), rem = i - pr * 66 * 16, r = rem >> 4, ch = rem & 15, t = t0 - 1 + r;
      uint4 v = make_uint4(0, 0, 0, 0);
      if (t >= 0 && t < L) v = *(const uint4*)(proj + (mb + t) * DINP + OFF_HY + pr * 512 + ch0 + ch * 8);
      *(uint4*)(X + (pr * 66 + r) * PITCH + ch * 8) = v;
    }
    __syncthreads();
    const float* cw = pin(p, 12) + l * 3 * 1536;
    const float* cb = pin(p, 13) + l * 1536;
    {
      const int c = tid & 127, tq = tid >> 7, col = ch0 + c;
      const float w00 = cw[col], w01 = cw[1536 + col], w02 = cw[3072 + col], b0 = cb[col];
      const float w10 = cw[512 + col], w11 = cw[1536 + 512 + col], w12 = cw[3072 + 512 + col], b1 = cb[512 + col];
      const float w20 = cw[1024 + col], w21 = cw[1536 + 1024 + col], w22 = cw[3072 + 1024 + col], b2 = cb[1024 + col];
      const u16* X0 = X, *X1 = X + 66 * PITCH, *XV = X + 2 * 66 * PITCH;
      u16* Y = (u16*)(p.ws + WS_Y);
#pragma unroll 4
      for (int tt = tq * 16; tt < tq * 16 + 16; ++tt) {
        float x0 = w00 * bf2f(X0[tt * PITCH + c]) + w01 * bf2f(X0[(tt + 1) * PITCH + c]) + w02 * bf2f(X0[(tt + 2) * PITCH + c]) + b0;
        float x1 = w10 * bf2f(X1[tt * PITCH + c]) + w11 * bf2f(X1[(tt + 1) * PITCH + c]) + w12 * bf2f(X1[(tt + 2) * PITCH + c]) + b1;
        float vv = w20 * bf2f(XV[tt * PITCH + c]) + w21 * bf2f(XV[(tt + 1) * PITCH + c]) + w22 * bf2f(XV[(tt + 2) * PITCH + c]) + b2;
        Y[(mb + t0 + tt) * 512 + col] = f2bf(x0);
        T[c * 65 + tt] = x1 * vv;
      }
    }
    __syncthreads();
    {
      float* ZV = (float*)(p.ws + WS_ZV);
#pragma unroll 4
      for (int cc = 0; cc < 16; ++cc) {
        int c = wid * 16 + cc;
        ZV[((size_t)(ch0 + c) * SP + pos0 + lane) * 2 + b] = T[c * 65 + lane];
      }
    }
    __syncthreads();
  } else {
    u16* projw = (u16*)(p.ws + WS_PROJ);
    const float* qg = pin(p, 24) + l * 384;
    const float* kg = pin(p, 26) + l * 256;
    const float2* rope = (const float2*)(p.ws + WS_ROPE);
    u16* Kb = (u16*)(p.ws + WS_K);
#pragma unroll 2
    for (int rr = 0; rr < 8; ++rr) {
      int tt = wid * 8 + rr, pos = pos0 + tt;
      u16* row = projw + ((size_t)b * SP + pos) * DINP;
      unsigned* q32 = (unsigned*)(row + OFF_Q);
      unsigned* k32 = (unsigned*)(row + OFF_KV);
      unsigned v[3], w[2];
      float ss = 0.f, s2 = 0.f;
#pragma unroll
      for (int j = 0; j < 3; ++j) v[j] = q32[lane + 64 * j];
#pragma unroll
      for (int j = 0; j < 2; ++j) w[j] = k32[lane + 64 * j];
      const int rd = lane & 31;
      float val = bf2f(row[OFF_KV + 256 + rd]);
#pragma unroll
      for (int j = 0; j < 3; ++j) { float a = bf2f(v[j] & 0xffff), c2 = bf2f(v[j] >> 16); ss += a * a + c2 * c2; }
#pragma unroll
      for (int j = 0; j < 2; ++j) { float a = bf2f(w[j] & 0xffff), c2 = bf2f(w[j] >> 16); s2 += a * a + c2 * c2; }
      ss = wave_sum(ss);
      s2 = wave_sum(s2);
      float r = rsqrtf(ss * (1.f / 384.f) + EPS), r2 = rsqrtf(s2 * (1.f / 256.f) + EPS);
#pragma unroll
      for (int j = 0; j < 3; ++j) {
        int n = (lane + 64 * j) * 2;
        q32[lane + 64 * j] = pk2(bf2f(v[j] & 0xffff) * r * qg[n], bf2f(v[j] >> 16) * r * qg[n + 1]);
      }
#pragma unroll
      for (int j = 0; j < 2; ++j) {
        int n = (lane + 64 * j) * 2;
        k32[lane + 64 * j] = pk2(bf2f(w[j] & 0xffff) * r2 * kg[n], bf2f(w[j] >> 16) * r2 * kg[n + 1]);
      }
      float partner = shx(val, 8);
      if (!isctx) {
        int t = pos - CTX, idx = (rd < 16) ? (t >> 6) : (t & 63);
        float2 cs = rope[idx * 8 + (rd & 7)];
        float sgn = (rd & 8) ? 1.f : -1.f;
        val = val * cs.x + sgn * partner * cs.y;
      }
      if (lane < 32) {
        u16 o = f2bf(val);
#pragma unroll
        for (int hd = 0; hd < 8; ++hd) Kb[((size_t)(b * 8 + hd) * SP + pos) * 96 + 64 + rd] = o;
      }
    }
  }
}

__device__ __forceinline__ int xi(int i) { const int h = i >> 5; return i ^ (((h & 3) * 5) | ((h & 2) << 3)); }
typedef float v2f __attribute__((ext_vector_type(2)));
__device__ __forceinline__ v2f cmulv(v2f a, v2f b) {
  v2f bs = {-b.y, b.x};
  return a.xx * b + a.yy * bs;
}
__device__ __forceinline__ void bf_fwd(float2* Xf, int base, int q, float2 w1f) {
  v2f* X = (v2f*)Xf;
  const v2f w1 = {w1f.x, w1f.y};
  const v2f w2 = cmulv(w1, w1), w3 = cmulv(w2, w1);
  const int i0 = xi(base), i1 = xi(base + q), i2 = xi(base + 2 * q), i3 = xi(base + 3 * q);
  v2f a0 = X[i0], a1 = X[i1], a2 = X[i2], a3 = X[i3];
  v2f s02 = a0 + a2, d02 = a0 - a2, s13 = a1 + a3, d13 = a1 - a3;
  v2f d13r = {d13.y, -d13.x};
  X[i0] = s02 + s13;
  X[i1] = cmulv(d02 + d13r, w1);
  X[i2] = cmulv(s02 - s13, w2);
  X[i3] = cmulv(d02 - d13r, w3);
}
__device__ __forceinline__ void bf_inv(float2* Xf, int base, int q, float2 w1f) {
  v2f* X = (v2f*)Xf;
  const v2f w1 = {w1f.x, -w1f.y};
  const v2f w2 = cmulv(w1, w1), w3 = cmulv(w2, w1);
  const int i0 = xi(base), i1 = xi(base + q), i2 = xi(base + 2 * q), i3 = xi(base + 3 * q);
  v2f b0 = X[i0], c1 = cmulv(X[i1], w1), c2 = cmulv(X[i2], w2), c3 = cmulv(X[i3], w3);
  v2f s02 = b0 + c2, d02 = b0 - c2, s13 = c1 + c3, d13 = c1 - c3;
  v2f d13r = {-d13.y, d13.x};
  X[i0] = s02 + s13;
  X[i1] = d02 + d13r;
  X[i2] = s02 - s13;
  X[i3] = d02 - d13r;
}
template <bool INV, int LQ>
__device__ __forceinline__ void fft_pass(float2* X, const float2* __restrict__ tw, const float2 (&twr)[6], int tid) {
  constexpr int q = 1 << LQ;
  if (LQ == 12) {
    float2 w[8];
#pragma unroll
    for (int b8 = 0; b8 < 8; ++b8) w[b8] = tw[b8 * NT + tid];
#pragma unroll
    for (int b8 = 0; b8 < 8; ++b8) { int u = b8 * NT + tid; if (INV) bf_inv(X, u, q, w[b8]); else bf_fwd(X, u, q, w[b8]); }
  } else if (LQ == 10) {
#pragma unroll 2
    for (int b8 = 0; b8 < 8; ++b8) {
      int u = b8 * NT + tid, j = u & 1023, base = ((u >> 10) << 12) + j;
      float2 w = (b8 & 1) ? twr[1] : twr[0];
      if (INV) bf_inv(X, base, q, w); else bf_fwd(X, base, q, w);
    }
  } else {
    const int j = tid & (q - 1);
    const float2 w = (LQ == 0) ? make_float2(1.f, 0.f) : twr[2 + (8 - LQ) / 2];
#pragma unroll 2
    for (int b8 = 0; b8 < 8; ++b8) {
      int u = b8 * NT + tid, base = ((u >> LQ) << (LQ + 2)) + j;
      if (INV) bf_inv(X, base, q, w); else bf_fwd(X, base, q, w);
    }
  }
  __syncthreads();
}
__device__ __forceinline__ void fft_load_tw(const float2* __restrict__ tw, int tid, float2 (&twr)[6]) {
  twr[0] = tw[tid << 2];
  twr[1] = tw[(512 + tid) << 2];
  twr[2] = tw[(tid & 255) << 4];
  twr[3] = tw[(tid & 63) << 6];
  twr[4] = tw[(tid & 15) << 8];
  twr[5] = tw[(tid & 3) << 10];
}
__device__ __forceinline__ void fft_dif(float2* X, const float2* __restrict__ tw, const float2 (&twr)[6]) {
  const int tid = tid_l();
  fft_pass<false, 12>(X, tw, twr, tid); fft_pass<false, 10>(X, tw, twr, tid); fft_pass<false, 8>(X, tw, twr, tid); fft_pass<false, 6>(X, tw, twr, tid);
  fft_pass<false, 4>(X, tw, twr, tid); fft_pass<false, 2>(X, tw, twr, tid); fft_pass<false, 0>(X, tw, twr, tid);
}
__device__ __forceinline__ void fft_dit_inv(float2* X, const float2* __restrict__ tw, const float2 (&twr)[6]) {
  const int tid = tid_l();
  fft_pass<true, 0>(X, tw, twr, tid); fft_pass<true, 2>(X, tw, twr, tid); fft_pass<true, 4>(X, tw, twr, tid); fft_pass<true, 6>(X, tw, twr, tid);
  fft_pass<true, 8>(X, tw, twr, tid); fft_pass<true, 10>(X, tw, twr, tid); fft_pass<true, 12>(X, tw, twr, tid);
}
__device__ __forceinline__ float block_sum(float v, float* red) {
  v = wave_sum(v);
  __syncthreads();
  { const int tb = tid_l(); if ((tb & 63) == 0) red[tb >> 6] = v; }
  __syncthreads();
  float s = red[0] + red[1] + red[2] + red[3] + red[4] + red[5] + red[6] + red[7];
  __syncthreads();
  return s;
}

__device__ __forceinline__ void fft_task(const Ctx& p, int l, int c, char* smem) {
  float2* X = (float2*)smem;
  float zl = 0.f;
  asm volatile("" : "+v"(zl));
  float* aux = (float*)(smem + AUX_OFF);
  float* red = aux + 128;
  const int tid = tid_l();
  const float2* tw = (const float2*)(p.ws + WS_TW);
  float2 twr[6];
  fft_load_tw(tw, tid, twr);
  const float* w3 = pin(p, 20) + (size_t)l * 64 * 1024;
  if (tid < 64) { aux[tid] = w3[tid * 1024 + c]; aux[64 + tid] = w3[tid * 1024 + 512 + c]; }
  __syncthreads();
  const float dF = fabsf(pin(p, 21)[(l * 2 + 0) * 512 + c]), dB = fabsf(pin(p, 21)[(l * 2 + 1) * 512 + c]);
  const float bias = pin(p, 22)[l * 512 + c];
  float2* zp = (float2*)(p.ws + WS_ZV) + (size_t)c * SP;
  float l1 = 0.f;
  {
    const u16* ff = (const u16*)((const char*)p.out + WO_FILT) + (size_t)c * 8192 + tid;
    const u16* fb = ff + (size_t)512 * 8192;
    u16 rf[16], rb[16];
#pragma unroll
    for (int i = 0; i < 16; ++i) { rf[i] = ff[i * NT]; rb[i] = fb[i * NT]; }
#pragma unroll
    for (int i = 0; i < 16; ++i) {
      int t = i * NT + tid;
      float tl = (float)t * (1.f / 8191.f);
      float hf = bf2f(rf[i]) * __expf(-tl * dF);
      float hb = bf2f(rb[i]) * __expf(-tl * dB);
      X[xi(t)] = make_float2(hf, 0.f);
      if (t >= 1) { X[xi(16384 - t)] = make_float2(hb, 0.f); l1 += fabsf(hf) + fabsf(hb); }
      else { X[xi(8192)] = make_float2(zl, zl); l1 += fabsf(hf); }
    }
  }
  float l1tot = block_sum(l1, red);
  fft_dif(X, tw, twr);
  float2 F[32];
  {
    float s = 1.f / (l1tot * 16384.f);
#pragma unroll
    for (int i = 0; i < 32; ++i) { float2 v = X[xi(i * NT + tid)]; F[i] = make_float2(v.x * s, v.y * s); }
  }
  __syncthreads();
#pragma unroll 8
  for (int i = 0; i < 16; ++i) {
    int t = i * NT + tid;
    X[xi(t)] = zp[CTX + t];
    X[xi(8192 + t)] = make_float2(zl, zl);
  }
  __syncthreads();
  fft_dif(X, tw, twr);
#pragma unroll
  for (int i = 0; i < 32; ++i) { int idx = xi(i * NT + tid); X[idx] = cmul(X[idx], F[i]); }
  __syncthreads();
  fft_dit_inv(X, tw, twr);
  {
    float2 zz[16];
#pragma unroll
    for (int i = 0; i < 16; ++i) zz[i] = zp[CTX + i * NT + tid];
#pragma unroll
    for (int i = 0; i < 16; ++i) {
      int t = i * NT + tid;
      float2 y = X[xi(t)];
      zp[CTX + t] = make_float2(y.x + bias * zz[i].x, y.y + bias * zz[i].y);
    }
  }
  __syncthreads();
  {
    float* hFc = (float*)smem;
    float* hBc = hFc + 256;
    float2* zc = (float2*)(hBc + 256);
    float l1c = 0.f;
    if (tid < 256) {
      int t = tid;
      const float* hc = (const float*)(p.ws + WS_HID2C) + (size_t)l * 64 * 256 + t;
      float hf = 0.f, hb = 0.f;
#pragma unroll 16
      for (int k = 0; k < 64; ++k) { float v = hc[k * 256]; hf += v * aux[k]; hb += v * aux[64 + k]; }
      float tl = (float)t * (1.f / 255.f);
      hf *= expf(-tl * dF);
      hb *= expf(-tl * dB);
      hFc[t] = hf;
      hBc[t] = hb;
      l1c = fabsf(hf) + (t >= 1 ? fabsf(hb) : 0.f);
      zc[t] = zp[t];
    }
    float l1ct = block_sum(l1c, red);
    const int bb = tid >> 8, t = tid & 255;
    float acc = 0.f;
    for (int s = 0; s < 256; ++s) {
      float kf = (s <= t) ? hFc[t - s] : hBc[s - t];
      float2 z = zc[s];
      acc += kf * (bb ? z.y : z.x);
    }
    float2 z = zc[t];
    ((float*)zp)[t * 2 + bb] = acc / l1ct + bias * (bb ? z.y : z.x);
    __syncthreads();
  }
}

constexpr int AT_KT = 128, AT_KP = 208, AT_VP = 264, AT_STAGE = AT_KT * AT_KP + 64 * AT_VP;
__device__ __forceinline__ void attn_task(const Ctx& p, int bh, int qb, char* smem) {
  const int tid = tid_l(), wid = tid >> 6, lane = tid & 63, r = lane & 31, hh = lane >> 5;
  const u16* Qp = (const u16*)(p.ws + WS_Q) + ((size_t)bh * SP + qb * 256) * 96;
  const u16* Kp = (const u16*)(p.ws + WS_K) + (size_t)bh * SP * 96;
  const u16* Vp = (const u16*)(p.ws + WS_VT) + (size_t)bh * 64 * SP;
  const int nkt = (qb == 0) ? 2 : 66;
  bf16x8 qf[6];
#pragma unroll
  for (int ks = 0; ks < 6; ++ks) qf[ks] = *(const bf16x8*)(Qp + (size_t)(wid * 32 + r) * 96 + ks * 16 + hh * 8);
  f32x16 o0, o1;
#pragma unroll
  for (int i = 0; i < 16; ++i) { o0[i] = 0.f; o1[i] = 0.f; }
  float mrun = 0.f, lrun = 0.f;
  const u16* src[5];
  int dst[5];
#pragma unroll
  for (int i = 0; i < 5; ++i) {
    int ch = tid + i * NT;
    if (i < 3) { int row = ch / 12, cc = ch - row * 12; src[i] = Kp + (size_t)row * 96 + cc * 8; dst[i] = row * AT_KP + cc * 16; }
    else { int v = ch - 1536, row = v >> 4, cc = v & 15; src[i] = Vp + (size_t)row * SP + cc * 8; dst[i] = AT_KT * AT_KP + row * AT_VP + cc * 16; }
  }
  uint4 st[5];
#define AT_LOAD(t)                                                                                   \
  do {                                                                                               \
    _Pragma("unroll") for (int i = 0; i < 5; ++i) st[i] = *(const uint4*)(src[i] + (size_t)(t) * (i < 3 ? AT_KT * 96 : AT_KT)); \
  } while (0)
#define AT_WRITE(buf)                                                                                \
  do {                                                                                               \
    char* base_ = smem + (buf) * AT_STAGE;                                                           \
    _Pragma("unroll") for (int i = 0; i < 5; ++i) {                                                  \
      uint2* d_ = (uint2*)(base_ + dst[i]);                                                          \
      d_[0] = make_uint2(st[i].x, st[i].y);                                                          \
      d_[1] = make_uint2(st[i].z, st[i].w);                                                          \
    }                                                                                                \
  } while (0)
#define AT_QK(S, kb)                                                                                 \
  __builtin_amdgcn_s_setprio(1);                                                                     \
  _Pragma("unroll") for (int ks = 0; ks < 6; ++ks) {                                                 \
    bf16x8 a_ = *(const bf16x8*)(Ks + ((kb) * 32 + r) * AT_KP + ks * 32 + hh * 16);                  \
    S = __builtin_amdgcn_mfma_f32_32x32x16_bf16(a_, qf[ks], S, 0, 0, 0);                             \
  }                                                                                                  \
  __builtin_amdgcn_s_setprio(0);
#define AT_SOFT_PV(S, kb)                                                                            \
  _Pragma("unroll") for (int i = 0; i < 16; ++i) { S[i] = __builtin_amdgcn_exp2f(S[i]); ps += S[i]; } \
  _Pragma("unroll") for (int sI = 0; sI < 2; ++sI) {                                                 \
    union { bf16x8 v; unsigned u[4]; } pu;                                                           \
    _Pragma("unroll") for (int j = 0; j < 4; ++j) pu.u[j] = pk2(S[8 * sI + 2 * j], S[8 * sI + 2 * j + 1]); \
    const int koff = ((kb) * 32 + 16 * sI + 4 * hh) * 2;                                             \
    union { bf16x8 v; uint2 h2[2]; } va, vb;                                                         \
    va.h2[0] = *(const uint2*)(Vs + r * AT_VP + koff);                                               \
    va.h2[1] = *(const uint2*)(Vs + r * AT_VP + koff + 16);                                          \
    vb.h2[0] = *(const uint2*)(Vs + (32 + r) * AT_VP + koff);                                        \
    vb.h2[1] = *(const uint2*)(Vs + (32 + r) * AT_VP + koff + 16);                                   \
    o0 = __builtin_amdgcn_mfma_f32_32x32x16_bf16(va.v, pu.v, o0, 0, 0, 0);                           \
    o1 = __builtin_amdgcn_mfma_f32_32x32x16_bf16(vb.v, pu.v, o1, 0, 0, 0);                           \
  }
  AT_LOAD(0);
  AT_WRITE(0);
  __syncthreads();
  for (int t = 0; t < nkt; ++t) {
    const int cur = t & 1;
    if (t + 1 < nkt) AT_LOAD(t + 1);
    const char* Ks = smem + cur * AT_STAGE;
    const char* Vs = Ks + AT_KT * AT_KP;
    const float nm = -mrun;
    f32x16 sA, sB;
    float ps = 0.f;
#pragma unroll
    for (int i = 0; i < 16; ++i) sA[i] = nm;
    AT_QK(sA, 0)
#pragma unroll
    for (int i = 0; i < 16; ++i) sB[i] = nm;
    AT_QK(sB, 1)
    AT_SOFT_PV(sA, 0)
#pragma unroll
    for (int i = 0; i < 16; ++i) sA[i] = nm;
    AT_QK(sA, 2)
    AT_SOFT_PV(sB, 1)
#pragma unroll
    for (int i = 0; i < 16; ++i) sB[i] = nm;
    AT_QK(sB, 3)
    AT_SOFT_PV(sA, 2)
    AT_SOFT_PV(sB, 3)
    lrun += ps;
    float pmx = fmaxf(ps, shx(ps, 32));
    if (__any(pmx > 65536.f)) {
      const float delta = pmx > 65536.f ? ceilf(__log2f(pmx)) : 0.f;
      const float alpha = __builtin_amdgcn_exp2f(-delta);
      mrun += delta;
      lrun *= alpha;
#pragma unroll
      for (int i = 0; i < 16; ++i) { o0[i] *= alpha; o1[i] *= alpha; }
    }
    if (t + 1 < nkt) AT_WRITE(cur ^ 1);
    __syncthreads();
  }
  const float ltot = lrun + shx(lrun, 32);
  const float inv = 1.f / ltot;
  const int b = bh >> 3, head = bh & 7;
  u16* Op = (u16*)(p.ws + WS_O) + ((size_t)b * SP + qb * 256 + wid * 32 + r) * 512 + head * 64;
#pragma unroll
  for (int g = 0; g < 4; ++g) {
    uint2 w0, w1;
    w0.x = pk2(o0[4 * g] * inv, o0[4 * g + 1] * inv);
    w0.y = pk2(o0[4 * g + 2] * inv, o0[4 * g + 3] * inv);
    w1.x = pk2(o1[4 * g] * inv, o1[4 * g + 1] * inv);
    w1.y = pk2(o1[4 * g + 2] * inv, o1[4 * g + 3] * inv);
    *(uint2*)(Op + 8 * g + 4 * hh) = w0;
    *(uint2*)(Op + 32 + 8 * g + 4 * hh) = w1;
  }
#undef AT_LOAD
#undef AT_WRITE
#undef AT_QK
#undef AT_SOFT_PV
}

__device__ __forceinline__ void hypost_task(const Ctx& p, int task, char* smem) {
  const int tid = tid_l(), lane = tid & 63, wid = tid >> 6;
  const int tile64 = task >> 1, ch0 = (task & 1) * 256;
  const int m0 = tile64 * 64, b = m0 / SP, pos0 = m0 - b * SP;
  float* T = (float*)smem;
  const float* ZV = (const float*)(p.ws + WS_ZV);
#pragma unroll 8
  for (int cc = 0; cc < 32; ++cc) {
    int c = wid * 32 + cc;
    T[c * 65 + lane] = ZV[((size_t)(ch0 + c) * SP + pos0 + lane) * 2 + b];
  }
  __syncthreads();
  u16* Y = (u16*)(p.ws + WS_Y);
  const int c = tid & 255, th = tid >> 8;
  u16* yp = Y + (size_t)(m0 + th * 32) * 512 + ch0 + c;
  u16 yv[32];
#pragma unroll
  for (int i = 0; i < 32; ++i) yv[i] = yp[(size_t)i * 512];
#pragma unroll
  for (int i = 0; i < 32; ++i) yp[(size_t)i * 512] = f2bf(bf2f(yv[i]) * T[c * 65 + th * 32 + i]);
  __syncthreads();
}

#ifndef PHMASK
#define PHMASK 0xFFFF
#endif
#define PHON(k) (((PHMASK) >> (k)) & 1)
constexpr int NPH = 1 + 4 * 10 + 1;
__global__ void __launch_bounds__(NT, 2) mega(Params prm) {
  __shared__ __attribute__((aligned(1024))) char smem[LDS_BYTES];
  cg::grid_group grid = cg::this_grid();
  const int bid = blockIdx.x, nb = gridDim.x;
  {
    unsigned long long* it = (unsigned long long*)(smem + AUX_OFF + 6144);
    if (threadIdx.x < 33) it[threadIdx.x] = (unsigned long long)prm.in[threadIdx.x];
    if (threadIdx.x == 0) *(uint4*)(smem + AUX_OFF + 7168) = make_uint4(0u, 0u, 0u, 0u);
    __syncthreads();
  }
  XcdBarrier xbar = xcd_barrier_post((unsigned*)(prm.ws + WS_BAR), (volatile LAS unsigned*)(smem + AUX_OFF + 7168));
  if (prm.ph_lo == 0) {
    Ctx p;
    p.intab = (const unsigned long long*)(smem + AUX_OFF + 6144);
    p.ws = prm.ws;
    p.out = prm.out;
    const int bid = blockIdx.x, nb = gridDim.x;
      if (PHON(10)) {
      p0_misc(p);
      for (int t = bid; t < 192; t += nb) p0_mod_task(p, t, smem);
      for (int t = bid; t < 528; t += nb) p0_hid_task(p, t, smem);
      for (int t = bid; t < 128; t += nb) { const int w = (t + 64) & 127; wpe_task(p, w >> 5, w & 31, smem); }
      }
  }
  unsigned nbar = 0;
  for (int ph = prm.ph_lo; ph < prm.ph_hi; ++ph) {
    Ctx p;
    p.intab = (const unsigned long long*)(smem + AUX_OFF + 6144);
    p.ws = prm.ws;
    p.out = prm.out;
    asm volatile("" : "+s"(p.ws), "+s"(p.out));
    float* modall = (float*)(p.ws + WS_MOD);
    u16* proj = (u16*)(p.ws + WS_PROJ);
    u16* xn = (u16*)(p.ws + WS_U);
    char* wo = (char*)p.out;
    if (ph == 0) {
    } else if (ph == NPH - 1) {
      if (PHON(11)) final_norm(p);
    } else {
      const int l = (ph - 1) / 10, sp = (ph - 1) % 10;
      const float* modl = modall + (size_t)l * 3 * 6144;
      GD* tab = (GD*)(smem + AUX_OFF + 4096);
      int ng = 0, nN0 = 0, nN1 = 0, nsplit = 1;
      const bool last = (l == 3);
      const float* gate = modl;
      if (sp == 0 && PHON(0)) {
        wt_phase(p, l, smem);
        norm_rows(p, pin(p, 6) + l * 1024, modl, 0, 1, xn);
      } else if (sp == 1 && PHON(1)) {
        if (threadIdx.x == 0) tab[0] = GD{xn, 1024, (const u16*)(wo + WO_IN), 1024, 1024, 23, EM_PROJ, 1};
        ng = 1; nN0 = 23;
      } else if (sp == 2 && PHON(2)) {
        for (int t = bid; t < 264 * 6; t += nb) premix_task(p, l, t, smem);
        {
          Epi ef{EM_FILT, p.ws, gate, nullptr, (u16*)(wo + WO_FILT)};
          const u16* hA = (const u16*)(p.ws + WS_HID2) + (size_t)l * 8192 * 64;
          const u16* wB = (const u16*)(p.ws + WS_W3T) + (size_t)l * 1024 * 64;
#pragma unroll 1
          for (int t = nb - 1 - bid; t < 128; t += nb) gemm_tile(hA, 64, wB, 64, 64, (t >> 2) * 256, (t & 3) * 256, smem, ef);
        }
      } else if (sp == 3 && PHON(3)) {
        for (int t = bid; t < 512; t += nb) fft_task(p, l, t, smem);
        if (threadIdx.x == 0) {
          tab[0] = GD{proj + OFF_Q, DINP, (const u16*)(wo + WO_UQ), 384, 384, 3, EM_Q, 1};
          tab[1] = GD{proj + OFF_KV, DINP, (const u16*)(wo + WO_UKV), 256, 256, 4, EM_KV, 1};
        }
        ng = 2; nN0 = 3; nN1 = 4;
        for (int i = tid_l(); i < 1024; i += NT) ((float2*)(smem + 131072))[i] = ((const float2*)(p.ws + WS_ROPE))[i];
      } else if (sp == 4 && PHON(4)) {
        for (int t = bid; t < (last ? 512 : 528); t += nb) {
          int bh, qb;
          if (t < 512) { int rnd = t >> 8, w = t & 255; bh = (w & 7) + 8 * rnd; qb = 1 + (w >> 3); }
          else { bh = t - 512; qb = 0; }
          attn_task(p, bh, qb, smem);
        }
        for (int t = bid; t < 528; t += nb) hypost_task(p, t, smem);
      } else if (sp == 5 && PHON(5)) {
        for (int t = bid; t < (last ? 512 : 544); t += nb) {
          if (t < 512) {
            const int x = t & 7, g = t >> 3, pmi = (g >> 2) * 8 + x, pm = pmi + 2 + (pmi >= 64 ? 2 : 0);
            mix_tile<4>(p, l, pm * 128, g & 3, smem);
          } else {
            const int c = t - 512, cm = c >> 2;
            mix_tile<2>(p, l, (cm >> 2) * SP + (cm & 3) * 64, c & 3, smem);
          }
        }
      } else if (sp == 6 && PHON(6)) {
        if (threadIdx.x == 0) tab[0] = GD{(const u16*)(p.ws + WS_ZV), 1024, (const u16*)(wo + WO_OUT), 1024, 1024, 4, EM_RESID, 4};
        ng = 1; nN0 = 4; nsplit = 4;
        gate = modl + 2 * 1024;
      } else if (sp == 7 && PHON(7)) {
        norm_rows(p, pin(p, 7) + l * 1024, modl, 3, 4, xn);
      } else if (sp == 8 && PHON(8)) {
        if (threadIdx.x == 0) tab[0] = GD{xn, 1024, (const u16*)(wo + WO_FF1), 1024, 1024, 16, EM_SQRELU, last ? 2 : 1};
        ng = 1; nN0 = 16; nsplit = last ? 2 : 1;
      } else if (sp == 9 && PHON(9)) {
        if (threadIdx.x == 0) tab[0] = GD{proj, DFF, (const u16*)(wo + WO_FF2), 4096, 4096, 4, EM_RESID, 8};
        ng = 1; nN0 = 4; nsplit = 8;
        gate = modl + 5 * 1024;
      }
      if (ng > 0) {
        __syncthreads();
        const int nt0 = (nsplit > 1) ? (64 * nN0 + (last ? 0 : 2 * nN0 * nsplit)) : NMT * nN0, ntot = nt0 + NMT * nN1;
#pragma unroll 1
        for (int t = bid; t < ntot; t += nb) {
          int gi = 0, tt = t;
          if (t >= nt0) { gi = 1; tt = t - nt0; }
          const volatile GD* gp = tab + gi;
          unsigned long long a64 = (unsigned long long)gp->A, b64 = (unsigned long long)gp->Bt;
          a64 = ((unsigned long long)(unsigned)__builtin_amdgcn_readfirstlane((unsigned)(a64 >> 32)) << 32) | (unsigned long long)(unsigned)__builtin_amdgcn_readfirstlane((unsigned)a64);
          b64 = ((unsigned long long)(unsigned)__builtin_amdgcn_readfirstlane((unsigned)(b64 >> 32)) << 32) | (unsigned long long)(unsigned)__builtin_amdgcn_readfirstlane((unsigned)b64);
          const int lda = __builtin_amdgcn_readfirstlane(gp->lda), ldb = __builtin_amdgcn_readfirstlane(gp->ldb);
          const int K = __builtin_amdgcn_readfirstlane(gp->K), nN = __builtin_amdgcn_readfirstlane(gp->nN);
          const int ks = __builtin_amdgcn_readfirstlane(gp->ks);
          const int mode = __builtin_amdgcn_readfirstlane(gp->mode);
          int pm, pn, Kuse = K, emode = mode;
          if (ks > 1) {
            const int nlat = 64 * nN;
            if (tt < nlat) { int pm64; tile_map(tt, 64, nN, pm64, pn); pm = (pm64 >> 5) * 33 + 1 + (pm64 & 31); }
            else {
              int u = tt - nlat, kp = u % ks, tile = u / ks;
              pm = (tile / nN) * 33; pn = tile % nN;
              Kuse = K / ks; emode = EM_RESID_AT;
              a64 += (unsigned long long)kp * Kuse * 2; b64 += (unsigned long long)kp * Kuse * 2;
            }
          } else tile_map(tt, NMT, nN, pm, pn);
          Epi e{emode, p.ws, gate, (const float2*)(smem + 131072), nullptr};
          gemm_tile((const u16*)a64, lda, (const u16*)b64, ldb, Kuse, pm * 256, pn * 256, smem, e);
        }
      }
    }
    if (ph + 1 < prm.ph_hi) {
      if (ph == prm.ph_lo) grid.sync();
      else xcd_barrier(xbar);
    }
  }
}

extern "C" void kernel_launch(void* const* d_in, const int* in_sizes, int n_in, void* d_out, int out_size, void* d_ws,
                              size_t ws_size, hipStream_t stream) {
  static int grid_blocks = 0;
  if (grid_blocks == 0) {
    if (n_in != 33 || ws_size < WS_END || (size_t)out_size * 4 < WO_END) {
      fprintf(stderr, "kernel_launch: unexpected sizes n_in=%d ws=%zu (need %zu) out=%d\n", n_in, ws_size, (size_t)WS_END, out_size);
      grid_blocks = -1;
      return;
    }
    int dev = 0, cus = 0, per_cu = 0;
    hipGetDevice(&dev);
    hipDeviceGetAttribute(&cus, hipDeviceAttributeMultiprocessorCount, dev);
    hipOccupancyMaxActiveBlocksPerMultiprocessor(&per_cu, mega, NT, 0);
    if (per_cu < 1) per_cu = 1;
    if (per_cu > 1) per_cu = 1;
    grid_blocks = cus * per_cu;
  }
  if (grid_blocks < 0) return;
  Params p{};
  for (int i = 0; i < 33; ++i) p.in[i] = (const float*)d_in[i];
  p.out = (float*)d_out;
  p.ws = (char*)d_ws;
  p.ph_lo = 0;
  p.ph_hi = NPH;
  (void)hipMemsetAsync((char*)d_ws + WS_BAR, 0, 16384, stream);
  void* args[] = {&p};
  hipError_t e = hipLaunchCooperativeKernel((void*)mega, dim3(grid_blocks), dim3(NT), args, 0, stream);
  if (e != hipSuccess) fprintf(stderr, "cooperative launch failed: %s (grid %d)\n", hipGetErrorString(e), grid_blocks);
}
```

```cpp
#include <hip/hip_runtime.h>
#include <hip/hip_cooperative_groups.h>
#include <cstdio>
namespace cg = cooperative_groups;

typedef unsigned short u16;
using bf16x8 = __attribute__((ext_vector_type(8))) short;
using f32x4 = __attribute__((ext_vector_type(4))) float;
using f32x16 = __attribute__((ext_vector_type(16))) float;

constexpr int D = 1024, SEQ = 8192, CTX = 256, SP = 8448, MROWS = 16896, NMT = 66;
constexpr int DIN = 5792, DINP = 5888, DFF = 4096;
constexpr int OFF_HY = 512, OFF_Q = 2048, OFF_KV = 2432, OFF_GATE = 2720;
constexpr int NT = 512;
constexpr float EPS = 1e-6f;

constexpr size_t WS_H = 0;
constexpr size_t WS_PROJ = WS_H + (size_t)MROWS * D * 4;
constexpr size_t WS_U = WS_PROJ + (size_t)MROWS * DINP * 2;
constexpr size_t WS_Y = WS_U + (size_t)MROWS * 512 * 2;
constexpr size_t WS_O = WS_Y + (size_t)MROWS * 512 * 2;
constexpr size_t WS_Q = WS_O + (size_t)MROWS * 512 * 2;
constexpr size_t WS_K = WS_Q + (size_t)16 * SP * 96 * 2;
constexpr size_t WS_VT = WS_K + (size_t)16 * SP * 96 * 2;
constexpr size_t WS_ZV = WS_VT + (size_t)16 * 64 * SP * 2;
constexpr size_t WS_HID2 = WS_ZV + (size_t)512 * SP * 8;
constexpr size_t WS_HID2C = WS_HID2 + (size_t)4 * 8192 * 64 * 4;
constexpr size_t WS_MOD = WS_HID2C + (size_t)4 * 256 * 64 * 4;
constexpr size_t WS_ROPE = WS_MOD + (size_t)4 * 3 * 6144 * 4;
constexpr size_t WS_TW = WS_ROPE + (size_t)128 * 8 * 8;
constexpr size_t WS_WPE = WS_TW + (size_t)16384 * 8;
constexpr size_t WS_BAR = WS_WPE + (size_t)4 * 1024 * 512 * 2;
constexpr size_t WS_END = WS_BAR + 16384;
constexpr size_t WO_IN = 0;
constexpr size_t WO_FF1 = WO_IN + (size_t)DINP * 1024 * 2;
constexpr size_t WO_FF2 = WO_FF1 + (size_t)4096 * 1024 * 2;
constexpr size_t WO_OUT = WO_FF2 + (size_t)4096 * 1024 * 2;
constexpr size_t WO_HY = WO_OUT + (size_t)1024 * 1024 * 2;
constexpr size_t WO_WO = WO_HY + (size_t)1024 * 512 * 2;
constexpr size_t WO_PE = WO_WO + (size_t)1024 * 512 * 2;
constexpr size_t WO_UQ = WO_PE + (size_t)1024 * 512 * 2;
constexpr size_t WO_UKV = WO_UQ + (size_t)768 * 384 * 2;
constexpr size_t WO_FILT = WO_UKV + (size_t)1024 * 256 * 2;
constexpr size_t WO_END = WO_FILT + (size_t)1024 * 8192 * 2;
constexpr size_t WS_W3T = WS_HID2 + (size_t)4 * 8192 * 64 * 2;

constexpr int AUX_OFF = 147456;
constexpr int LDS_BYTES = AUX_OFF + 8192;

struct Params {
  const float* in[33];
  float* out;
  char* ws;
  int ph_lo, ph_hi;
};

struct Ctx { const unsigned long long* intab; char* ws; float* out; };
__device__ __forceinline__ const float* pin(const Ctx& c, int i) {
  unsigned long long v = c.intab[i];
  unsigned lo = __builtin_amdgcn_readfirstlane((unsigned)v), hi = __builtin_amdgcn_readfirstlane((unsigned)(v >> 32));
  return (const float*)(((unsigned long long)hi << 32) | lo);
}

typedef __bf16 hwbf2 __attribute__((ext_vector_type(2)));
typedef float hwf2 __attribute__((ext_vector_type(2)));
__device__ __forceinline__ unsigned pk2(float a, float b) {
  hwf2 v = {a, b};
  hwbf2 r = __builtin_convertvector(v, hwbf2);
  return __builtin_bit_cast(unsigned, r);
}
__device__ __forceinline__ u16 f2bf(float f) { return (u16)(pk2(f, 0.f) & 0xffffu); }
__device__ __forceinline__ float bf2f(u16 b) { return __uint_as_float(((unsigned)b) << 16); }
__device__ __forceinline__ float shx(float v, int o) {
  int l = __builtin_amdgcn_mbcnt_hi(~0u, __builtin_amdgcn_mbcnt_lo(~0u, 0u));
  asm volatile("" : "+v"(l));
  return __int_as_float(__builtin_amdgcn_ds_bpermute((l ^ o) << 2, __float_as_int(v)));
}
__device__ __forceinline__ float wave_sum(float v) {
#pragma unroll
  for (int o = 1; o < 64; o <<= 1) v += shx(v, o);
  return v;
}
__device__ __forceinline__ int grp_of_row(int m) {
  int tile = m >> 8, b = tile / 33, t33 = tile - b * 33;
  return t33 == 0 ? 2 : b;
}
__device__ __forceinline__ float2 cmul(float2 a, float2 b) { return make_float2(a.x * b.x - a.y * b.y, a.x * b.y + a.y * b.x); }

__device__ __forceinline__ int tid_l() { int t = threadIdx.x; asm volatile("" : "+v"(t)); return t; }
#define XB_TMO      128
#define XB_XCNT(j)  (256  + 64 * (j))
#define XB_XSUB(j)  (1280 + 64 * (j))
#define XB_XGEN(j)  (2304 + 64 * (j))
#define XB_TOP      3328
#define XB_TOPGEN   3392
#define XCD_BAR_WORDS 3456
#define XB_SPIN_CAP (1u << 18)
#define LAS __attribute__((address_space(3)))
__device__ __forceinline__ unsigned xb_ld(unsigned* p)              { return __hip_atomic_load(p, __ATOMIC_RELAXED, __HIP_MEMORY_SCOPE_AGENT); }
__device__ __forceinline__ unsigned xb_add(unsigned* p, unsigned v) { return __hip_atomic_fetch_add(p, v, __ATOMIC_RELAXED, __HIP_MEMORY_SCOPE_AGENT); }
__device__ __forceinline__ unsigned xb_xcc_id() { return (unsigned)__builtin_amdgcn_s_getreg((3 << 11) | 20) & 0xFu; }
#define XB_SPIN(cond, bar) do { unsigned _sp = 0; while (cond) { __builtin_amdgcn_s_sleep(1); \
    if ((++_sp & 255u) == 0u) { if (xb_ld(&(bar)[XB_TMO])) break; if (_sp > XB_SPIN_CAP) { atomicAdd(&(bar)[XB_TMO], 1u); break; } } } } while (0)
struct XcdBarrier { unsigned* bar; unsigned x; volatile LAS unsigned* st; };
__device__ __forceinline__ XcdBarrier xcd_barrier_post(unsigned* bar, volatile LAS unsigned* st) {
    XcdBarrier b; b.bar = bar; b.x = xb_xcc_id(); b.st = st;
    if (threadIdx.x == 0) (void)xb_add(&bar[XB_XCNT(b.x)], 1u);
    return b;
}
__device__ __forceinline__ void xcd_barrier_complete(unsigned* bar, unsigned x, unsigned& nloc, unsigned& nx) {
    const unsigned G = gridDim.x * gridDim.y * gridDim.z;
    unsigned sum, cnt, mine, sp = 0u;
    for (;;) {
        sum = 0u; cnt = 0u; mine = 0u;
#pragma unroll
        for (unsigned j = 0; j < 16; ++j) { const unsigned c = xb_ld(&bar[XB_XCNT(j)]); sum += c; cnt += (c > 0u) ? 1u : 0u; mine = (j == x) ? c : mine; }
        if (sum == G) break;
        __builtin_amdgcn_s_sleep(1);
        if ((++sp & 255u) == 0u) { if (xb_ld(&bar[XB_TMO])) break; if (sp > XB_SPIN_CAP) { atomicAdd(&bar[XB_TMO], 1u); break; } }
    }
    nloc = mine > 0u ? mine : 1u; nx = cnt > 0u ? cnt : 1u;
}
__device__ __forceinline__ void xcd_barrier(const XcdBarrier& b) {
    asm volatile("s_waitcnt vmcnt(0)" ::: "memory");
    __syncthreads();
    if (threadIdx.x == 0) {
        unsigned* bar = b.bar;
        __builtin_amdgcn_s_waitcnt(0);
        unsigned nloc = b.st[0], nx = b.st[1];
        if (nloc == 0u) { xcd_barrier_complete(bar, b.x, nloc, nx); b.st[0] = nloc; b.st[1] = nx; }
        const unsigned old = xb_add(&bar[XB_XSUB(b.x)], 1u);
        const unsigned gen = old / nloc;
        if (old + 1u == (gen + 1u) * nloc) {
            __builtin_amdgcn_fence(__ATOMIC_RELEASE, "agent");
            asm volatile("s_waitcnt vmcnt(0)" ::: "memory");
            const unsigned og = xb_add(&bar[XB_TOP], 1u);
            const unsigned tg = og / nx;
            if (og + 1u == (tg + 1u) * nx) xb_add(&bar[XB_TOPGEN], 1u);
            else XB_SPIN(xb_ld(&bar[XB_TOPGEN]) == tg, bar);
            __builtin_amdgcn_fence(__ATOMIC_ACQUIRE, "agent");
            xb_add(&bar[XB_XGEN(b.x)], 1u);
            asm volatile("s_waitcnt vmcnt(0)" ::: "memory");
        } else {
            XB_SPIN(xb_ld(&bar[XB_XGEN(b.x)]) == gen, bar);
            __builtin_amdgcn_fence(__ATOMIC_ACQUIRE, "agent");
            asm volatile("s_waitcnt vmcnt(0)" ::: "memory");
        }
    }
    __syncthreads();
}

__device__ __forceinline__ void grid_barrier(unsigned* bar, unsigned target) {
  asm volatile("s_waitcnt vmcnt(0)" ::: "memory");
  __syncthreads();
  if (threadIdx.x == 0) {
    __builtin_amdgcn_fence(__ATOMIC_RELEASE, "agent");
    asm volatile("s_waitcnt vmcnt(0)" ::: "memory");
    __hip_atomic_fetch_add(bar, 1u, __ATOMIC_RELAXED, __HIP_MEMORY_SCOPE_AGENT);
    while (__hip_atomic_load(bar, __ATOMIC_RELAXED, __HIP_MEMORY_SCOPE_AGENT) < target) __builtin_amdgcn_s_sleep(2);
    __builtin_amdgcn_fence(__ATOMIC_ACQUIRE, "agent");
    asm volatile("s_waitcnt vmcnt(0)" ::: "memory");
  }
  __syncthreads();
}
#define WAIT_V(n) asm volatile("s_waitcnt vmcnt(%0)" ::"n"(n) : "memory")
#define SCHED() __builtin_amdgcn_sched_barrier(0)
#define RAW_BARRIER() do { asm volatile("s_waitcnt lgkmcnt(0)" ::: "memory"); __builtin_amdgcn_s_barrier(); } while (0)

constexpr float QSCALE = 0.10206207261596575f * 1.4426950408889634f;
enum { EM_PROJ = 0, EM_SQRELU = 1, EM_RESID = 2, EM_RESID_AT = 3, EM_FILT = 4, EM_Q = 6, EM_KV = 7 };
struct Epi {
  int mode;
  char* ws;
  const float* gate;
  const float2* rope_lds;
  u16* filt_out;
  __device__ __forceinline__ void proj(int row, int col, f32x4 v) const {
    {
      u16* out = (u16*)(ws + WS_PROJ);
#pragma unroll
      for (int j = 0; j < 4; ++j) out[(size_t)(row + j) * DINP + col] = f2bf(v[j]);
    }
  }
  __device__ __forceinline__ void sqrelu(int row, int col, f32x4 v) const {
    {
      u16* out = (u16*)(ws + WS_PROJ);
#pragma unroll
      for (int j = 0; j < 4; ++j) { float r = fmaxf(v[j], 0.f); out[(size_t)(row + j) * DFF + col] = f2bf(r * r); }
    }
  }
  __device__ __forceinline__ void resid(int row, int col, f32x4 v) const {
    {
      float* h = (float*)(ws + WS_H);
      float g = gate[grp_of_row(row) * 6144 + col];
#pragma unroll
      for (int j = 0; j < 4; ++j) unsafeAtomicAdd(h + (size_t)(row + j) * D + col, g * v[j]);
    }
  }
  __device__ __forceinline__ void filt(int row, int col, f32x4 v) const {
    uint2 o;
    o.x = pk2(v[0], v[1]);
    o.y = pk2(v[2], v[3]);
    *(uint2*)(filt_out + (size_t)col * 8192 + row) = o;
  }
  __device__ __forceinline__ void q(int row, int col, f32x4 v) const {
    {
      u16* Q = (u16*)(ws + WS_Q);
      const float2* rope = rope_lds;
      int head = col / 96, d = col - head * 96;
      int b = row / SP, pos0 = row - b * SP;
      bool isrope = (d >= 64) && (pos0 >= CTX);
      int rd = d - 64;
#pragma unroll
      for (int j = 0; j < 4; ++j) {
        float val = v[j];
        float partner = shx(val, 8);
        int pos = pos0 + j;
        if (isrope) {
          int t = pos - CTX, idx = (rd < 16) ? (t >> 6) : (t & 63);
          float2 cs = rope[idx * 8 + (rd & 7)];
          float sgn = (rd & 8) ? 1.f : -1.f;
          val = val * cs.x + sgn * partner * cs.y;
        }
        Q[((size_t)(b * 8 + head) * SP + pos) * 96 + d] = f2bf(val * QSCALE);
      }
    }
  }
  __device__ __forceinline__ void kv(int row, int col, f32x4 v) const {
    {
      u16* Kb = (u16*)(ws + WS_K);
      u16* Vt = (u16*)(ws + WS_VT);
      int head = col >> 7, j2 = col & 127;
      int b = row / SP, pos0 = row - b * SP;
      if (j2 < 64) {
#pragma unroll
        for (int j = 0; j < 4; ++j) Kb[((size_t)(b * 8 + head) * SP + pos0 + j) * 96 + j2] = f2bf(v[j]);
      } else {
        uint2 o;
        o.x = pk2(v[0], v[1]);
        o.y = pk2(v[2], v[3]);
        *(uint2*)(Vt + ((size_t)(b * 8 + head) * 64 + (j2 - 64)) * SP + pos0) = o;
      }
    }
  }
};
struct GD { const u16* A; int lda; const u16* Bt; int ldb; int K; int nN; int mode; int ks; };

constexpr int G_TILE_B = 256 * 64 * 2, G_STAGE_B = 2 * G_TILE_B;
__device__ __forceinline__ int lds_byte(int r, int c) {
  int st = (r >> 4) * 2 + (c >> 5), ob = (r & 15) * 64 + (c & 31) * 2;
  return st * 1024 + (ob ^ (((ob >> 9) & 1) << 5));
}
__device__ __forceinline__ void stage_rc(int b, int& R, int& C) {
  int st = b >> 10, sb = b & 1023, swz = sb ^ (((sb >> 9) & 1) << 5);
  R = (st / 2) * 16 + swz / 64;
  C = (st % 2) * 32 + (swz % 64) / 2;
}

template <int MI>
__device__ __forceinline__ void gemm_core(const u16* __restrict__ A, int lda, const u16* __restrict__ Bt, int ldb, int K,
                                          int brow, int bcol, char* shm, f32x4 (&acc)[MI][4]) {
  constexpr int TILE_A = MI * 32 * 64 * 2, TILE_BB = 256 * 64 * 2, STAGE = TILE_A + TILE_BB;
  const int tid = tid_l(), wid = tid >> 6, lane = tid & 63, wr = wid >> 2, wc = wid & 3, fr = lane & 15, fq = lane >> 4;
  const u16* Ab = A + (size_t)brow * lda;
  const u16* Bb = Bt + (size_t)bcol * ldb;
  int sR[4], sC[4];
#pragma unroll
  for (int i = 0; i < 4; ++i) stage_rc(wid * 1024 + i * 8192 + lane * 16, sR[i], sC[i]);
#define SA(b) (shm + (b) * STAGE)
#define SB(b) (shm + (b) * STAGE + TILE_A)
#define GLDS_STAGE(buf, kt)                                                                                              \
  do {                                                                                                                   \
    _Pragma("unroll") for (int i = 0; i < 4; ++i) {                                                                      \
      if (i < MI / 2)                                                                                                    \
        __builtin_amdgcn_global_load_lds((const unsigned*)(Ab + (size_t)sR[i] * lda + (kt) * 64 + sC[i]),                \
                                         (unsigned*)(SA(buf) + wid * 1024 + i * 8192), 16, 0, 0);                        \
      __builtin_amdgcn_global_load_lds((const unsigned*)(Bb + (size_t)sR[i] * ldb + (kt) * 64 + sC[i]),                  \
                                       (unsigned*)(SB(buf) + wid * 1024 + i * 8192), 16, 0, 0);                          \
    }                                                                                                                    \
  } while (0)
  const int nt = K / 64;
  GLDS_STAGE(0, 0);
  WAIT_V(0);
  __syncthreads();
  for (int t = 0; t < nt; ++t) {
    const int cur = t & 1;
    if (t + 1 < nt) GLDS_STAGE(cur ^ 1, t + 1);
#pragma unroll
    for (int ks = 0; ks < 2; ++ks) {
      bf16x8 At[MI], Bf[4];
#pragma unroll
      for (int m = 0; m < MI; ++m) At[m] = *(const bf16x8*)(SA(cur) + lds_byte(wr * (MI * 16) + m * 16 + fr, ks * 32 + fq * 8));
#pragma unroll
      for (int n = 0; n < 4; ++n) Bf[n] = *(const bf16x8*)(SB(cur) + lds_byte(wc * 64 + n * 16 + fr, ks * 32 + fq * 8));
#pragma unroll
      for (int m = 0; m < MI; ++m)
#pragma unroll
        for (int n = 0; n < 4; ++n) acc[m][n] = __builtin_amdgcn_mfma_f32_16x16x32_bf16(At[m], Bf[n], acc[m][n], 0, 0, 0);
    }
    WAIT_V(0);
    __syncthreads();
  }
#undef SA
#undef SB
#undef GLDS_STAGE
}

template <class EpiT>
__device__ __forceinline__ void gemm_tile(const u16* __restrict__ A, int lda, const u16* __restrict__ Bt, int ldb, int K,
                                          int brow, int bcol, char* shm, const EpiT& epi) {
  const int tid = tid_l(), wid = tid >> 6, lane = tid & 63, wr = wid >> 2, wc = wid & 3, fr = lane & 15, fq = lane >> 4;
  f32x4 acc[8][4];
#pragma unroll
  for (int m = 0; m < 8; ++m)
#pragma unroll
    for (int n = 0; n < 4; ++n) acc[m][n] = (f32x4){0.f, 0.f, 0.f, 0.f};
  gemm_core<8>(A, lda, Bt, ldb, K, brow, bcol, shm, acc);
#define EPI_LOOP(CALL)                                                                              \
  _Pragma("unroll") for (int m = 0; m < 8; ++m) _Pragma("unroll") for (int n = 0; n < 4; ++n) {      \
    const int row = brow + wr * 128 + m * 16 + fq * 4, col = bcol + wc * 64 + n * 16 + fr;           \
    const f32x4 v = acc[m][n];                                                                        \
    CALL;                                                                                             \
  }
  if (epi.mode == EM_PROJ) { EPI_LOOP(epi.proj(row, col, v)) }
  else if (epi.mode == EM_SQRELU) { EPI_LOOP(epi.sqrelu(row, col, v)) }
  else if (epi.mode == EM_RESID_AT) { EPI_LOOP(epi.resid(row, col, v)) }
  else if (epi.mode == EM_RESID) {
    float* h = (float*)(epi.ws + WS_H);
    float g4[4];
#pragma unroll
    for (int n = 0; n < 4; ++n) g4[n] = epi.gate[grp_of_row(brow) * 6144 + bcol + wc * 64 + n * 16 + fr];
    float hv[8][4][4];
    float* hp0 = h + (size_t)(brow + wr * 128 + fq * 4) * D + bcol + wc * 64 + fr;
#define H_LOAD(m) _Pragma("unroll") for (int n = 0; n < 4; ++n) _Pragma("unroll") for (int j = 0; j < 4; ++j) hv[m][n][j] = hp0[(size_t)((m) * 16 + j) * D + n * 16]
#define H_STORE(m) _Pragma("unroll") for (int n = 0; n < 4; ++n) _Pragma("unroll") for (int j = 0; j < 4; ++j) hp0[(size_t)((m) * 16 + j) * D + n * 16] = hv[m][n][j] + g4[n] * acc[m][n][j]
    H_LOAD(0); H_LOAD(1);
    SCHED();
    H_STORE(0); H_LOAD(2); SCHED();
    H_STORE(1); H_LOAD(3); SCHED();
    H_STORE(2); H_LOAD(4); SCHED();
    H_STORE(3); H_LOAD(5); SCHED();
    H_STORE(4); H_LOAD(6); SCHED();
    H_STORE(5); H_LOAD(7); SCHED();
    H_STORE(6); H_STORE(7);
#undef H_LOAD
#undef H_STORE
  }
  else if (epi.mode == EM_FILT) { EPI_LOOP(epi.filt(row, col, v)) }
  else if (epi.mode == EM_Q) { EPI_LOOP(epi.q(row, col, v)) }
  else { EPI_LOOP(epi.kv(row, col, v)) }
#undef EPI_LOOP
}

template <int MI>
__device__ __forceinline__ void mix_tile(const Ctx& p, int l, int brow, int pn, char* shm) {
  constexpr int TILE_A = MI * 32 * 64 * 2, TILE_BB = 256 * 64 * 2, STAGE = TILE_A + TILE_BB, WROWS = MI * 16;
  const int tid = tid_l(), wid = tid >> 6, lane = tid & 63, wr = wid >> 2, wc = wid & 3, fr = lane & 15, fq = lane >> 4;
  const int bcol = pn * 256;
  const u16* projb = (const u16*)(p.ws + WS_PROJ);
  char* wo = (char*)p.out;
#define SA(b) (shm + (b) * STAGE)
#define SB(b) (shm + (b) * STAGE + TILE_A)
#define MIX_STAGE(buf, kt)                                                                                               \
  do {                                                                                                                   \
    const int br_ = (kt) >> 3, ko_ = ((kt) & 7) * 64;                                                                    \
    const u16* Ab_ = (const u16*)(p.ws + (br_ == 0 ? WS_U : br_ == 1 ? WS_Y : WS_O)) + (size_t)brow * 512 + ko_;         \
    const u16* Bb_ = (br_ == 0 ? (const u16*)(p.ws + WS_WPE) + (size_t)l * 1024 * 512 : (const u16*)(wo + (br_ == 1 ? WO_HY : WO_WO))) + (size_t)bcol * 512 + ko_;        \
    _Pragma("unroll") for (int i = 0; i < 4; ++i) {                                                                      \
      int sR_, sC_; stage_rc(wid * 1024 + i * 8192 + lane * 16, sR_, sC_);                                              \
      if (i < MI / 2)                                                                                                    \
        __builtin_amdgcn_global_load_lds((const unsigned*)(Ab_ + sR_ * 512 + sC_),                           \
                                         (unsigned*)(SA(buf) + wid * 1024 + i * 8192), 16, 0, 0);                        \
      __builtin_amdgcn_global_load_lds((const unsigned*)(Bb_ + sR_ * 512 + sC_),                             \
                                       (unsigned*)(SB(buf) + wid * 1024 + i * 8192), 16, 0, 0);                          \
    }                                                                                                                    \
  } while (0)
  f32x4 tot[MI][4], acc[MI][4];
#pragma unroll
  for (int m = 0; m < MI; ++m)
#pragma unroll
    for (int n = 0; n < 4; ++n) { tot[m][n] = (f32x4){0.f, 0.f, 0.f, 0.f}; acc[m][n] = (f32x4){0.f, 0.f, 0.f, 0.f}; }
  MIX_STAGE(0, 0);
  MIX_STAGE(1, 1);
  WAIT_V(6);
  RAW_BARRIER();
  int cur = 0;
#pragma unroll 1
  for (int br = 0; br < 3; ++br) {
    unsigned gpk[MI][4][2];
    const u16* gp = projb + (size_t)(brow + wr * WROWS + fq * 4) * DINP + OFF_GATE + br * 1024 + bcol + wc * 64 + fr;
#define GATE_LOAD(m)                                                                                   \
    _Pragma("unroll") for (int n = 0; n < 4; ++n) _Pragma("unroll") for (int j2 = 0; j2 < 2; ++j2) {       \
      unsigned lo = gp[(size_t)((m) * 16 + 2 * j2) * DINP + n * 16], hi = gp[(size_t)((m) * 16 + 2 * j2 + 1) * DINP + n * 16]; \
      gpk[m][n][j2] = lo | (hi << 16);                                                                     \
    }
    GATE_LOAD(0); GATE_LOAD(1);
    if (MI == 4) { GATE_LOAD(2); }
#pragma unroll 1
    for (int kk = 0; kk < 8; ++kk) {
      const int t = br * 8 + kk;
      { int nx = cur + 2; if (nx >= 3) nx -= 3; if (t + 2 < 24) MIX_STAGE(nx, t + 2); }
#pragma unroll
      for (int ks = 0; ks < 2; ++ks) {
        bf16x8 At[2], Bf[4];
#pragma unroll
        for (int n = 0; n < 4; ++n) Bf[n] = *(const bf16x8*)(SB(cur) + lds_byte(wc * 64 + n * 16 + fr, ks * 32 + fq * 8));
#pragma unroll
        for (int mh = 0; mh < MI / 2; ++mh) {
#pragma unroll
          for (int m = 0; m < 2; ++m) At[m] = *(const bf16x8*)(SA(cur) + lds_byte(wr * WROWS + (mh * 2 + m) * 16 + fr, ks * 32 + fq * 8));
#pragma unroll
          for (int m = 0; m < 2; ++m)
#pragma unroll
            for (int n = 0; n < 4; ++n) acc[mh * 2 + m][n] = __builtin_amdgcn_mfma_f32_16x16x32_bf16(At[m], Bf[n], acc[mh * 2 + m][n], 0, 0, 0);
        }
      }
      if (t + 2 < 24) WAIT_V(6); else WAIT_V(0);
      RAW_BARRIER();
      cur = (cur == 2) ? 0 : cur + 1;
    }
    if (MI == 4) { GATE_LOAD(3); }
#undef GATE_LOAD
#pragma unroll
    for (int m = 0; m < MI; ++m)
#pragma unroll
      for (int n = 0; n < 4; ++n)
#pragma unroll
        for (int j = 0; j < 4; ++j) {
          const unsigned w = gpk[m][n][j >> 1];
          const float gv = __uint_as_float((j & 1) ? (w & 0xffff0000u) : (w << 16));
          tot[m][n][j] += acc[m][n][j] * __builtin_amdgcn_rcpf(1.f + __expf(-gv));
          acc[m][n][j] = 0.f;
        }
  }
  u16* mixb = (u16*)(p.ws + WS_ZV);
#pragma unroll
  for (int m = 0; m < MI; ++m)
#pragma unroll
    for (int n = 0; n < 4; ++n)
#pragma unroll
      for (int j = 0; j < 4; ++j)
        mixb[(size_t)(brow + wr * WROWS + m * 16 + fq * 4 + j) * D + bcol + wc * 64 + n * 16 + fr] = f2bf(tot[m][n][j]);
#undef SA
#undef SB
#undef MIX_STAGE
}

__device__ __forceinline__ void tile_map(int t, int nM, int nN, int& pm, int& pn) {
  int nwg = nM * nN, wgid = t;
  {
    int q = nwg / 8, r = nwg % 8, xcd = wgid % 8, off = wgid / 8;
    wgid = (xcd < r ? xcd * (q + 1) : r * (q + 1) + (xcd - r) * q) + off;
  }
  constexpr int WGM = 4;
  int nig = WGM * nN, gid = wgid / nig, fm = gid * WGM, gsz = min(nM - fm, WGM);
  pm = fm + ((wgid % nig) % gsz);
  pn = (wgid % nig) / gsz;
}

__device__ __forceinline__ void p0_misc(const Ctx& p) {
  const int gtid = blockIdx.x * NT + tid_l(), gn = gridDim.x * NT;
  float4* h4 = (float4*)(p.ws + WS_H);
  const float4* x4 = (const float4*)pin(p, 0);
  const float4* c4 = (const float4*)pin(p, 2);
#pragma unroll 8
  for (int i = gtid; i < MROWS * 256; i += gn) {
    int m = i >> 8, q = i & 255, b = m / SP, pos = m - b * SP;
    float4 v = (pos < CTX) ? c4[(size_t)(b * CTX + pos) * 256 + q] : x4[(size_t)(b * SEQ + pos - CTX) * 256 + q];
    h4[i] = v;
  }
  float2* rope = (float2*)(p.ws + WS_ROPE);
  for (int i = gtid; i < 1024; i += gn) {
    int idx = i >> 3, f = i & 7;
    float inv = powf(10000.f, -(float)f / 8.f);
    float a = (float)idx * inv;
    rope[i] = make_float2(cosf(a), sinf(a));
  }
  {
    u16* w3t = (u16*)(p.ws + WS_W3T);
    const float* w3 = pin(p, 20);
    for (int i = gtid; i < 4 * 1024 * 64; i += gn) { int l = i >> 16, c2 = (i >> 6) & 1023, k = i & 63; w3t[i] = f2bf(w3[((size_t)l * 64 + k) * 1024 + c2]); }
  }
  float2* tw = (float2*)(p.ws + WS_TW);
  for (int i = gtid; i < 16384; i += gn) {
    float s, c;
    sincospif(-(float)i / 8192.f, &s, &c);
    tw[i] = make_float2(c, s);
  }
}

__device__ __forceinline__ void p0_mod_task(const Ctx& p, int task, char* smem) {
  float* s = (float*)smem;
  float* red = s + 3072;
  const int tid = tid_l();
  const int l = task / 48, chunk = task - l * 48;
  for (int i = tid; i < 3072; i += NT) {
    int g = i >> 10, k = i & 1023;
    float cv = (g < 2) ? pin(p, 1)[g * 1024 + k] : pin(p, 3)[k];
    s[i] = cv / (1.f + __expf(-cv));
  }
  __syncthreads();
  const int kq = tid >> 7, col = tid & 127, n = chunk * 128 + col;
  const float* W = pin(p, 4) + (size_t)l * 1024 * 6144 + n;
  float a0 = 0.f, a1 = 0.f, a2 = 0.f;
#pragma unroll 32
  for (int k = kq * 256; k < kq * 256 + 256; ++k) {
    float w = W[(size_t)k * 6144];
    a0 += s[k] * w; a1 += s[1024 + k] * w; a2 += s[2048 + k] * w;
  }
  red[(kq * 3 + 0) * 128 + col] = a0;
  red[(kq * 3 + 1) * 128 + col] = a1;
  red[(kq * 3 + 2) * 128 + col] = a2;
  __syncthreads();
  if (tid < 384) {
    int g = tid >> 7, c2 = tid & 127, n2 = chunk * 128 + c2;
    float v = red[(0 * 3 + g) * 128 + c2] + red[(1 * 3 + g) * 128 + c2] + red[(2 * 3 + g) * 128 + c2] + red[(3 * 3 + g) * 128 + c2];
    ((float*)(p.ws + WS_MOD))[(size_t)(l * 3 + g) * 6144 + n2] = v + pin(p, 5)[l * 6144 + n2];
  }
  __syncthreads();
}

__device__ __forceinline__ void p0_hid_task(const Ctx& p, int task, char* smem) {
  float* zs = (float*)smem;
  float* h1 = zs + 8 * 36;
  float* w1s = h1 + 8 * 64;
  float* w2s = w1s + 33 * 64;
  const int tid = tid_l(), tl = tid >> 6, j = tid & 63;
  const int l = task / 132, r = task - l * 132;
  const bool isctx = r >= 128;
  const int L = isctx ? 256 : 8192;
  const int tbase = (isctx ? (r - 128) : r) * 64;
  for (int i = tid; i < 33 * 64; i += NT) w1s[i] = pin(p, 14)[l * 33 * 64 + i];
  for (int i = tid; i < 64 * 64; i += NT) w2s[i] = pin(p, 17)[l * 64 * 64 + i];
  const float b1 = pin(p, 15)[l * 64 + j], f1 = pin(p, 16)[l * 64 + j], b2 = pin(p, 18)[l * 64 + j], f2 = pin(p, 19)[l * 64 + j];
  __syncthreads();
  for (int sub = 0; sub < 8; ++sub) {
    const int t = tbase + sub * 8 + tl;
    if (j < 33) {
      float z;
      if (j == 0) z = (float)t / (float)(L - 1);
      else {
        int i = (j - 1) & 15;
        float band = 1e-4f + (float)i * ((15.f - 1e-4f) / 15.f);
        float omega = 6.2831855f * (float)t / (float)L;
        float a = omega * band;
        z = (j <= 16) ? cosf(a) : -sinf(a);
      }
      zs[tl * 36 + j] = z;
    }
    __syncthreads();
    {
      float a = b1;
#pragma unroll
      for (int k = 0; k < 33; ++k) a += zs[tl * 36 + k] * w1s[k * 64 + j];
      h1[tl * 64 + j] = sinf(f1 * a);
    }
    __syncthreads();
    {
      float a = b2;
#pragma unroll 16
      for (int k = 0; k < 64; ++k) a += h1[tl * 64 + k] * w2s[k * 64 + j];
      float v = sinf(f2 * a);
      if (isctx) ((float*)(p.ws + WS_HID2C))[((size_t)l * 64 + j) * 256 + t] = v;
      else ((u16*)(p.ws + WS_HID2))[((size_t)l * 8192 + t) * 64 + j] = f2bf(v);
    }
  }
  __syncthreads();
}

struct WtItem { const float* W; u16* WT; int K, N, k0, n0; };
__device__ __forceinline__ WtItem wt_decode(const Ctx& p, int l, int r) {
  char* wo = (char*)p.out;
  WtItem it;
  int nblk;
  if (r < 1472) { it.W = pin(p, 8) + (size_t)l * 1024 * DIN; it.K = 1024; it.N = DIN; it.WT = (u16*)(wo + WO_IN); nblk = 92; }
  else if ((r -= 1472) < 1024) { it.W = pin(p, 30) + (size_t)l * 1024 * 4096; it.K = 1024; it.N = 4096; it.WT = (u16*)(wo + WO_FF1); nblk = 64; }
  else if ((r -= 1024) < 1024) { it.W = pin(p, 31) + (size_t)l * 4096 * 1024; it.K = 4096; it.N = 1024; it.WT = (u16*)(wo + WO_FF2); nblk = 16; }
  else if ((r -= 1024) < 256) { it.W = pin(p, 29) + (size_t)l * 1024 * 1024; it.K = 1024; it.N = 1024; it.WT = (u16*)(wo + WO_OUT); nblk = 16; }
  else if ((r -= 256) < 128) { it.W = pin(p, 23) + (size_t)l * 512 * 1024; it.K = 512; it.N = 1024; it.WT = (u16*)(wo + WO_HY); nblk = 16; }
  else if ((r -= 128) < 128) { it.W = pin(p, 28) + (size_t)l * 512 * 1024; it.K = 512; it.N = 1024; it.WT = (u16*)(wo + WO_WO); nblk = 16; }
  else if ((r -= 128) < 72) { it.W = pin(p, 25) + (size_t)l * 384 * 768; it.K = 384; it.N = 768; it.WT = (u16*)(wo + WO_UQ); nblk = 12; }
  else { r -= 72; it.W = pin(p, 27) + (size_t)l * 256 * 1024; it.K = 256; it.N = 1024; it.WT = (u16*)(wo + WO_UKV); nblk = 16; }
  const int kb = r / nblk, nb2 = r - kb * nblk;
  it.k0 = kb * 64; it.n0 = nb2 * 64;
  return it;
}
__device__ __forceinline__ void wt_load(const WtItem& it, int tid, float (&v)[8]) {
  const int nn = tid & 63, kq = tid >> 6;
  const bool ok = it.n0 + nn < it.N;
  const float* src = it.W + (size_t)(it.k0 + kq) * it.N + it.n0 + (ok ? nn : 0);
#pragma unroll
  for (int r = 0; r < 8; ++r) { float x = src[(size_t)(r * 8) * it.N]; v[r] = ok ? x : 0.f; }
}
__device__ __forceinline__ void wt_phase(const Ctx& p, int l, char* smem) {
  float* tile = (float*)smem;
  const int tid = tid_l();
  const int bid = blockIdx.x, nb = gridDim.x;
  int t = bid;
  if (t >= 4168) return;
  WtItem cur = wt_decode(p, l, t);
  float v[8];
  wt_load(cur, tid, v);
#pragma unroll 1
  while (true) {
    const int tn = t + nb;
    const bool more = tn < 4168;
    WtItem nxt = cur;
    float vn[8];
    if (more) { nxt = wt_decode(p, l, tn); wt_load(nxt, tid, vn); }
#pragma unroll
    for (int r = 0; r < 8; ++r) tile[(r * 8 + (tid >> 6)) * 65 + (tid & 63)] = v[r];
    __syncthreads();
    {
      int n = tid >> 3, kc = (tid & 7) * 8;
      uint4 o;
      o.x = pk2(tile[(kc + 0) * 65 + n], tile[(kc + 1) * 65 + n]);
      o.y = pk2(tile[(kc + 2) * 65 + n], tile[(kc + 3) * 65 + n]);
      o.z = pk2(tile[(kc + 4) * 65 + n], tile[(kc + 5) * 65 + n]);
      o.w = pk2(tile[(kc + 6) * 65 + n], tile[(kc + 7) * 65 + n]);
      *(uint4*)(cur.WT + (size_t)(cur.n0 + n) * cur.K + cur.k0 + kc) = o;
    }
    __syncthreads();
    if (!more) break;
    cur = nxt;
#pragma unroll
    for (int r = 0; r < 8; ++r) v[r] = vn[r];
    t = tn;
  }
}

__device__ __forceinline__ void wpe_task(const Ctx& p, int l, int task, char* smem) {
  const int g = task >> 3, c0 = (task & 7) * 16, tid = tid_l();
  const float* pw = pin(p, 9) + ((size_t)(l * 4 + g) * 128) * 128;
  const float* sc = pin(p, 10) + l * 512 + g * 128;
  const float* po = pin(p, 11) + ((size_t)l * 512 + g * 128) * 1024;
  u16* WpeT = (u16*)(p.ws + WS_WPE) + (size_t)l * 1024 * 512;
  float* wl = (float*)smem;
  for (int i = tid; i < 16 * 128; i += NT) { int d = i & 127; wl[i] = pw[(c0 + (i >> 7)) * 128 + d] * sc[d]; }
  __syncthreads();
  float acc0[16], acc1[16];
#pragma unroll
  for (int i = 0; i < 16; ++i) { acc0[i] = 0.f; acc1[i] = 0.f; }
#pragma unroll 16
  for (int d = 0; d < 128; ++d) {
    float p0 = po[(size_t)d * 1024 + tid], p1 = po[(size_t)d * 1024 + 512 + tid];
#pragma unroll
    for (int i = 0; i < 16; ++i) { float w = wl[i * 128 + d]; acc0[i] += w * p0; acc1[i] += w * p1; }
  }
  uint4 o0, o1;
  o0.x = pk2(acc0[0], acc0[1]); o0.y = pk2(acc0[2], acc0[3]); o0.z = pk2(acc0[4], acc0[5]); o0.w = pk2(acc0[6], acc0[7]);
  o1.x = pk2(acc0[8], acc0[9]); o1.y = pk2(acc0[10], acc0[11]); o1.z = pk2(acc0[12], acc0[13]); o1.w = pk2(acc0[14], acc0[15]);
  uint4* dst = (uint4*)(WpeT + (size_t)tid * 512 + g * 128 + c0);
  dst[0] = o0; dst[1] = o1;
  o0.x = pk2(acc1[0], acc1[1]); o0.y = pk2(acc1[2], acc1[3]); o0.z = pk2(acc1[4], acc1[5]); o0.w = pk2(acc1[6], acc1[7]);
  o1.x = pk2(acc1[8], acc1[9]); o1.y = pk2(acc1[10], acc1[11]); o1.z = pk2(acc1[12], acc1[13]); o1.w = pk2(acc1[14], acc1[15]);
  dst = (uint4*)(WpeT + (size_t)(512 + tid) * 512 + g * 128 + c0);
  dst[0] = o0; dst[1] = o1;
  __syncthreads();
}

__device__ __forceinline__ void norm_rows(const Ctx& p, const float* gain, const float* modl, int sh_idx, int sc_idx, u16* outp) {
  const int tidx = tid_l(), lane = tidx & 63, gw = blockIdx.x * 8 + (tidx >> 6), ngw = gridDim.x * 8;
  const float* h = (const float*)(p.ws + WS_H);
  float4 g[4];
#pragma unroll
  for (int j = 0; j < 4; ++j) g[j] = *(const float4*)(gain + lane * 4 + 256 * j);
  for (int m0 = gw; m0 < MROWS; m0 += 2 * ngw) {
    const int m1 = m0 + ngw;
    const bool has1 = m1 < MROWS;
    const int m1c = has1 ? m1 : m0;
    const float4* hr0 = (const float4*)(h + (size_t)m0 * D) + lane;
    const float4* hr1 = (const float4*)(h + (size_t)m1c * D) + lane;
    float4 v0[4], v1[4];
#pragma unroll
    for (int j = 0; j < 4; ++j) { v0[j] = hr0[64 * j]; v1[j] = hr1[64 * j]; }
    const float* mg0 = modl + grp_of_row(m0) * 6144;
    const float* mg1 = modl + grp_of_row(m1c) * 6144;
    float s0 = 0.f, s1 = 0.f;
#pragma unroll
    for (int j = 0; j < 4; ++j) {
      s0 += v0[j].x * v0[j].x + v0[j].y * v0[j].y + v0[j].z * v0[j].z + v0[j].w * v0[j].w;
      s1 += v1[j].x * v1[j].x + v1[j].y * v1[j].y + v1[j].z * v1[j].z + v1[j].w * v1[j].w;
    }
    s0 = wave_sum(s0);
    s1 = wave_sum(s1);
    const float r0 = rsqrtf(s0 * (1.f / D) + EPS), r1 = rsqrtf(s1 * (1.f / D) + EPS);
    uint2* o0 = (uint2*)(outp + (size_t)m0 * D) + lane;
    uint2* o1 = (uint2*)(outp + (size_t)m1c * D) + lane;
#pragma unroll
    for (int j = 0; j < 4; ++j) {
      int n = lane * 4 + 256 * j;
      float4 sc = *(const float4*)(mg0 + sc_idx * 1024 + n), sh = *(const float4*)(mg0 + sh_idx * 1024 + n);
      uint2 o;
      o.x = pk2(v0[j].x * r0 * g[j].x * (1.f + sc.x) + sh.x, v0[j].y * r0 * g[j].y * (1.f + sc.y) + sh.y);
      o.y = pk2(v0[j].z * r0 * g[j].z * (1.f + sc.z) + sh.z, v0[j].w * r0 * g[j].w * (1.f + sc.w) + sh.w);
      o0[64 * j] = o;
    }
    if (has1) {
#pragma unroll
      for (int j = 0; j < 4; ++j) {
        int n = lane * 4 + 256 * j;
        float4 sc = *(const float4*)(mg1 + sc_idx * 1024 + n), sh = *(const float4*)(mg1 + sh_idx * 1024 + n);
        uint2 o;
        o.x = pk2(v1[j].x * r1 * g[j].x * (1.f + sc.x) + sh.x, v1[j].y * r1 * g[j].y * (1.f + sc.y) + sh.y);
        o.y = pk2(v1[j].z * r1 * g[j].z * (1.f + sc.z) + sh.z, v1[j].w * r1 * g[j].w * (1.f + sc.w) + sh.w);
        o1[64 * j] = o;
      }
    }
  }
}

__device__ __forceinline__ void final_norm(const Ctx& p) {
  const int tidx = tid_l(), lane = tidx & 63, gw = blockIdx.x * 8 + (tidx >> 6), ngw = gridDim.x * 8;
  const float* h = (const float*)(p.ws + WS_H);
  const float* gain = pin(p, 32);
  for (int r0 = gw; r0 < 2 * SEQ; r0 += ngw) {
    int b = r0 >> 13, t = r0 & 8191, m = b * SP + CTX + t;
    const float4* hr = (const float4*)(h + (size_t)m * D) + lane;
    float4 v[4];
    float ss = 0.f;
#pragma unroll
    for (int j = 0; j < 4; ++j) { v[j] = hr[64 * j]; ss += v[j].x * v[j].x + v[j].y * v[j].y + v[j].z * v[j].z + v[j].w * v[j].w; }
    ss = wave_sum(ss);
    float r = rsqrtf(ss * (1.f / D) + EPS);
    float4* o = (float4*)(p.out + (size_t)r0 * D) + lane;
#pragma unroll
    for (int j = 0; j < 4; ++j) {
      float4 g = *(const float4*)(gain + lane * 4 + 256 * j);
      o[64 * j] = make_float4(v[j].x * r * g.x, v[j].y * r * g.y, v[j].z * r * g.z, v[j].w * r * g.w);
    }
  }
}

__device__ __forceinline__ void premix_task(const Ctx& p, int l, int task, char* smem) {
  const int tid = tid_l(), lane = tid & 63, wid = tid >> 6;
  const int part = task / 264, tile64 = task - part * 264;
  const int m0 = tile64 * 64, b = m0 / SP, pos0 = m0 - b * SP;
  const bool isctx = pos0 < CTX;
  const int s0 = isctx ? 0 : CTX, L = isctx ? CTX : SEQ, t0 = pos0 - s0;
  const size_t mb = (size_t)b * SP + s0;
  const u16* proj = (const u16*)(p.ws + WS_PROJ);
  if (part == 0) {
    u16* P = (u16*)smem;
#pragma unroll
    for (int i = tid; i < 80 * 64; i += NT) {
      int r = i >> 6, ch = i & 63, t = t0 - 8 + r;
      uint4 v = make_uint4(0, 0, 0, 0);
      if (t >= 0 && t < L) v = *(const uint4*)(proj + (mb + t) * DINP + ch * 8);
      *(uint4*)(P + r * 512 + ch * 8) = v;
    }
    __syncthreads();
    const int c = tid, g = c >> 7, hw = 1 << g;
    u16* U = (u16*)(p.ws + WS_U);
    float s = 0.f;
    for (int q = -hw; q < hw; ++q) s += bf2f(P[(8 + q) * 512 + c]);
#pragma unroll 4
    for (int tt = 0; tt < 64; ++tt) {
      int t = t0 + tt, lo = max(t - hw, 0), hi = min(t + hw, L);
      float u = s * __builtin_amdgcn_rcpf((float)(hi - lo)) - bf2f(P[(tt + 8) * 512 + c]);
      U[(mb + t) * 512 + c] = f2bf(u);
      s += bf2f(P[(tt + 8 + hw) * 512 + c]) - bf2f(P[(tt + 8 - hw) * 512 + c]);
    }
    __syncthreads();
  } else if (part <= 4) {
    const int ch0 = (part - 1) * 128;
    constexpr int PITCH = 136;
    u16* X = (u16*)smem;
    float* T = (float*)(smem + 3 * 66 * PITCH * 2 + 64);
#pragma unroll
    for (int ii = 0; ii < 7; ++ii) {
      const int i = tid + ii * NT;
      if (i >= 3 * 66 * 16) break;
      int pr = i / (66 * 16), rem = i - pr * 66 * 16, r = rem >> 4, ch = rem & 15, t = t0 - 1 + r;
      uint4 v = make_uint4(0, 0, 0, 0);
      if (t >= 0 && t < L) v = *(const uint4*)(proj + (mb + t) * DINP + OFF_HY + pr * 512 + ch0 + ch * 8);
      *(uint4*)(X + (pr * 66 + r) * PITCH + ch * 8) = v;
    }
    __syncthreads();
    const float* cw = pin(p, 12) + l * 3 * 1536;
    const float* cb = pin(p, 13) + l * 1536;
    {
      const int c = tid & 127, tq = tid >> 7, col = ch0 + c;
      const float w00 = cw[col], w01 = cw[1536 + col], w02 = cw[3072 + col], b0 = cb[col];
      const float w10 = cw[512 + col], w11 = cw[1536 + 512 + col], w12 = cw[3072 + 512 + col], b1 = cb[512 + col];
      const float w20 = cw[1024 + col], w21 = cw[1536 + 1024 + col], w22 = cw[3072 + 1024 + col], b2 = cb[1024 + col];
      const u16* X0 = X, *X1 = X + 66 * PITCH, *XV = X + 2 * 66 * PITCH;
      u16* Y = (u16*)(p.ws + WS_Y);
#pragma unroll 4
      for (int tt = tq * 16; tt < tq * 16 + 16; ++tt) {
        float x0 = w00 * bf2f(X0[tt * PITCH + c]) + w01 * bf2f(X0[(tt + 1) * PITCH + c]) + w02 * bf2f(X0[(tt + 2) * PITCH + c]) + b0;
        float x1 = w10 * bf2f(X1[tt * PITCH + c]) + w11 * bf2f(X1[(tt + 1) * PITCH + c]) + w12 * bf2f(X1[(tt + 2) * PITCH + c]) + b1;
        float vv = w20 * bf2f(XV[tt * PITCH + c]) + w21 * bf2f(XV[(tt + 1) * PITCH + c]) + w22 * bf2f(XV[(tt + 2) * PITCH + c]) + b2;
        Y[(mb + t0 + tt) * 512 + col] = f2bf(x0);
        T[c * 65 + tt] = x1 * vv;
      }
    }
    __syncthreads();
    {
      float* ZV = (float*)(p.ws + WS_ZV);
#pragma unroll 4
      for (int cc = 0; cc < 16; ++cc) {
        int c = wid * 16 + cc;
        ZV[((size_t)(ch0 + c) * SP + pos0 + lane) * 2 + b] = T[c * 65 + lane];
      }
    }
    __syncthreads();
  } else {
    u16* projw = (u16*)(p.ws + WS_PROJ);
    const float* qg = pin(p, 24) + l * 384;
    const float* kg = pin(p, 26) + l * 256;
    const float2* rope = (const float2*)(p.ws + WS_ROPE);
    u16* Kb = (u16*)(p.ws + WS_K);
#pragma unroll 2
    for (int rr = 0; rr < 8; ++rr) {
      int tt = wid * 8 + rr, pos = pos0 + tt;
      u16* row = projw + ((size_t)b * SP + pos) * DINP;
      unsigned* q32 = (unsigned*)(row + OFF_Q);
      unsigned* k32 = (unsigned*)(row + OFF_KV);
      unsigned v[3], w[2];
      float ss = 0.f, s2 = 0.f;
#pragma unroll
      for (int j = 0; j < 3; ++j) v[j] = q32[lane + 64 * j];
#pragma unroll
      for (int j = 0; j < 2; ++j) w[j] = k32[lane + 64 * j];
      const int rd = lane & 31;
      float val = bf2f(row[OFF_KV + 256 + rd]);
#pragma unroll
      for (int j = 0; j < 3; ++j) { float a = bf2f(v[j] & 0xffff), c2 = bf2f(v[j] >> 16); ss += a * a + c2 * c2; }
#pragma unroll
      for (int j = 0; j < 2; ++j) { float a = bf2f(w[j] & 0xffff), c2 = bf2f(w[j] >> 16); s2 += a * a + c2 * c2; }
      ss = wave_sum(ss);
      s2 = wave_sum(s2);
      float r = rsqrtf(ss * (1.f / 384.f) + EPS), r2 = rsqrtf(s2 * (1.f / 256.f) + EPS);
#pragma unroll
      for (int j = 0; j < 3; ++j) {
        int n = (lane + 64 * j) * 2;
        q32[lane + 64 * j] = pk2(bf2f(v[j] & 0xffff) * r * qg[n], bf2f(v[j] >> 16) * r * qg[n + 1]);
      }
#pragma unroll
      for (int j = 0; j < 2; ++j) {
        int n = (lane + 64 * j) * 2;
        k32[lane + 64 * j] = pk2(bf2f(w[j] & 0xffff) * r2 * kg[n], bf2f(w[j] >> 16) * r2 * kg[n + 1]);
      }
      float partner = shx(val, 8);
      if (!isctx) {
        int t = pos - CTX, idx = (rd < 16) ? (t >> 6) : (t & 63);
        float2 cs = rope[idx * 8 + (rd & 7)];
        float sgn = (rd & 8) ? 1.f : -1.f;
        val = val * cs.x + sgn * partner * cs.y;
      }
      if (lane < 32) {
        u16 o = f2bf(val);
#pragma unroll
        for (int hd = 0; hd < 8; ++hd) Kb[((size_t)(b * 8 + hd) * SP + pos) * 96 + 64 + rd] = o;
      }
    }
  }
}

__device__ __forceinline__ int xi(int i) { const int h = i >> 5; return i ^ (((h & 3) * 5) | ((h & 2) << 3)); }
typedef float v2f __attribute__((ext_vector_type(2)));
__device__ __forceinline__ v2f cmulv(v2f a, v2f b) {
  v2f bs = {-b.y, b.x};
  return a.xx * b + a.yy * bs;
}
__device__ __forceinline__ void bf_fwd(float2* Xf, int base, int q, float2 w1f) {
  v2f* X = (v2f*)Xf;
  const v2f w1 = {w1f.x, w1f.y};
  const v2f w2 = cmulv(w1, w1), w3 = cmulv(w2, w1);
  const int i0 = xi(base), i1 = xi(base + q), i2 = xi(base + 2 * q), i3 = xi(base + 3 * q);
  v2f a0 = X[i0], a1 = X[i1], a2 = X[i2], a3 = X[i3];
  v2f s02 = a0 + a2, d02 = a0 - a2, s13 = a1 + a3, d13 = a1 - a3;
  v2f d13r = {d13.y, -d13.x};
  X[i0] = s02 + s13;
  X[i1] = cmulv(d02 + d13r, w1);
  X[i2] = cmulv(s02 - s13, w2);
  X[i3] = cmulv(d02 - d13r, w3);
}
__device__ __forceinline__ void bf_inv(float2* Xf, int base, int q, float2 w1f) {
  v2f* X = (v2f*)Xf;
  const v2f w1 = {w1f.x, -w1f.y};
  const v2f w2 = cmulv(w1, w1), w3 = cmulv(w2, w1);
  const int i0 = xi(base), i1 = xi(base + q), i2 = xi(base + 2 * q), i3 = xi(base + 3 * q);
  v2f b0 = X[i0], c1 = cmulv(X[i1], w1), c2 = cmulv(X[i2], w2), c3 = cmulv(X[i3], w3);
  v2f s02 = b0 + c2, d02 = b0 - c2, s13 = c1 + c3, d13 = c1 - c3;
  v2f d13r = {-d13.y, d13.x};
  X[i0] = s02 + s13;
  X[i1] = d02 + d13r;
  X[i2] = s02 - s13;
  X[i3] = d02 - d13r;
}
template <bool INV, int LQ>
__device__ __forceinline__ void fft_pass(float2* X, const float2* __restrict__ tw, const float2 (&twr)[6], int tid) {
  constexpr int q = 1 << LQ;
  if (LQ == 12) {
    float2 w[8];
#pragma unroll
    for (int b8 = 0; b8 < 8; ++b8) w[b8] = tw[b8 * NT + tid];
#pragma unroll
    for (int b8 = 0; b8 < 8; ++b8) { int u = b8 * NT + tid; if (INV) bf_inv(X, u, q, w[b8]); else bf_fwd(X, u, q, w[b8]); }
  } else if (LQ == 10) {
#pragma unroll 2
    for (int b8 = 0; b8 < 8; ++b8) {
      int u = b8 * NT + tid, j = u & 1023, base = ((u >> 10) << 12) + j;
      float2 w = (b8 & 1) ? twr[1] : twr[0];
      if (INV) bf_inv(X, base, q, w); else bf_fwd(X, base, q, w);
    }
  } else {
    const int j = tid & (q - 1);
    const float2 w = (LQ == 0) ? make_float2(1.f, 0.f) : twr[2 + (8 - LQ) / 2];
#pragma unroll 2
    for (int b8 = 0; b8 < 8; ++b8) {
      int u = b8 * NT + tid, base = ((u >> LQ) << (LQ + 2)) + j;
      if (INV) bf_inv(X, base, q, w); else bf_fwd(X, base, q, w);
    }
  }
  __syncthreads();
}
__device__ __forceinline__ void fft_load_tw(const float2* __restrict__ tw, int tid, float2 (&twr)[6]) {
  twr[0] = tw[tid << 2];
  twr[1] = tw[(512 + tid) << 2];
  twr[2] = tw[(tid & 255) << 4];
  twr[3] = tw[(tid & 63) << 6];
  twr[4] = tw[(tid & 15) << 8];
  twr[5] = tw[(tid & 3) << 10];
}
__device__ __forceinline__ void fft_dif(float2* X, const float2* __restrict__ tw, const float2 (&twr)[6]) {
  const int tid = tid_l();
  fft_pass<false, 12>(X, tw, twr, tid); fft_pass<false, 10>(X, tw, twr, tid); fft_pass<false, 8>(X, tw, twr, tid); fft_pass<false, 6>(X, tw, twr, tid);
  fft_pass<false, 4>(X, tw, twr, tid); fft_pass<false, 2>(X, tw, twr, tid); fft_pass<false, 0>(X, tw, twr, tid);
}
__device__ __forceinline__ void fft_dit_inv(float2* X, const float2* __restrict__ tw, const float2 (&twr)[6]) {
  const int tid = tid_l();
  fft_pass<true, 0>(X, tw, twr, tid); fft_pass<true, 2>(X, tw, twr, tid); fft_pass<true, 4>(X, tw, twr, tid); fft_pass<true, 6>(X, tw, twr, tid);
  fft_pass<true, 8>(X, tw, twr, tid); fft_pass<true, 10>(X, tw, twr, tid); fft_pass<true, 12>(X, tw, twr, tid);
}
__device__ __forceinline__ float block_sum(float v, float* red) {
  v = wave_sum(v);
  __syncthreads();
  { const int tb = tid_l(); if ((tb & 63) == 0) red[tb >> 6] = v; }
  __syncthreads();
  float s = red[0] + red[1] + red[2] + red[3] + red[4] + red[5] + red[6] + red[7];
  __syncthreads();
  return s;
}

__device__ __forceinline__ void fft_task(const Ctx& p, int l, int c, char* smem) {
  float2* X = (float2*)smem;
  float zl = 0.f;
  asm volatile("" : "+v"(zl));
  float* aux = (float*)(smem + AUX_OFF);
  float* red = aux + 128;
  const int tid = tid_l();
  const float2* tw = (const float2*)(p.ws + WS_TW);
  float2 twr[6];
  fft_load_tw(tw, tid, twr);
  const float* w3 = pin(p, 20) + (size_t)l * 64 * 1024;
  if (tid < 64) { aux[tid] = w3[tid * 1024 + c]; aux[64 + tid] = w3[tid * 1024 + 512 + c]; }
  __syncthreads();
  const float dF = fabsf(pin(p, 21)[(l * 2 + 0) * 512 + c]), dB = fabsf(pin(p, 21)[(l * 2 + 1) * 512 + c]);
  const float bias = pin(p, 22)[l * 512 + c];
  float2* zp = (float2*)(p.ws + WS_ZV) + (size_t)c * SP;
  float l1 = 0.f;
  {
    const u16* ff = (const u16*)((const char*)p.out + WO_FILT) + (size_t)c * 8192 + tid;
    const u16* fb = ff + (size_t)512 * 8192;
    u16 rf[16], rb[16];
#pragma unroll
    for (int i = 0; i < 16; ++i) { rf[i] = ff[i * NT]; rb[i] = fb[i * NT]; }
#pragma unroll
    for (int i = 0; i < 16; ++i) {
      int t = i * NT + tid;
      float tl = (float)t * (1.f / 8191.f);
      float hf = bf2f(rf[i]) * __expf(-tl * dF);
      float hb = bf2f(rb[i]) * __expf(-tl * dB);
      X[xi(t)] = make_float2(hf, 0.f);
      if (t >= 1) { X[xi(16384 - t)] = make_float2(hb, 0.f); l1 += fabsf(hf) + fabsf(hb); }
      else { X[xi(8192)] = make_float2(zl, zl); l1 += fabsf(hf); }
    }
  }
  float l1tot = block_sum(l1, red);
  fft_dif(X, tw, twr);
  float2 F[32];
  {
    float s = 1.f / (l1tot * 16384.f);
#pragma unroll
    for (int i = 0; i < 32; ++i) { float2 v = X[xi(i * NT + tid)]; F[i] = make_float2(v.x * s, v.y * s); }
  }
  __syncthreads();
#pragma unroll 8
  for (int i = 0; i < 16; ++i) {
    int t = i * NT + tid;
    X[xi(t)] = zp[CTX + t];
    X[xi(8192 + t)] = make_float2(zl, zl);
  }
  __syncthreads();
  fft_dif(X, tw, twr);
#pragma unroll
  for (int i = 0; i < 32; ++i) { int idx = xi(i * NT + tid); X[idx] = cmul(X[idx], F[i]); }
  __syncthreads();
  fft_dit_inv(X, tw, twr);
  {
    float2 zz[16];
#pragma unroll
    for (int i = 0; i < 16; ++i) zz[i] = zp[CTX + i * NT + tid];
#pragma unroll
    for (int i = 0; i < 16; ++i) {
      int t = i * NT + tid;
      float2 y = X[xi(t)];
      zp[CTX + t] = make_float2(y.x + bias * zz[i].x, y.y + bias * zz[i].y);
    }
  }
  __syncthreads();
  {
    float* hFc = (float*)smem;
    float* hBc = hFc + 256;
    float2* zc = (float2*)(hBc + 256);
    float l1c = 0.f;
    if (tid < 256) {
      int t = tid;
      const float* hc = (const float*)(p.ws + WS_HID2C) + (size_t)l * 64 * 256 + t;
      float hf = 0.f, hb = 0.f;
#pragma unroll 16
      for (int k = 0; k < 64; ++k) { float v = hc[k * 256]; hf += v * aux[k]; hb += v * aux[64 + k]; }
      float tl = (float)t * (1.f / 255.f);
      hf *= expf(-tl * dF);
      hb *= expf(-tl * dB);
      hFc[t] = hf;
      hBc[t] = hb;
      l1c = fabsf(hf) + (t >= 1 ? fabsf(hb) : 0.f);
      zc[t] = zp[t];
    }
    float l1ct = block_sum(l1c, red);
    const int bb = tid >> 8, t = tid & 255;
    float acc = 0.f;
    for (int s = 0; s < 256; ++s) {
      float kf = (s <= t) ? hFc[t - s] : hBc[s - t];
      float2 z = zc[s];
      acc += kf * (bb ? z.y : z.x);
    }
    float2 z = zc[t];
    ((float*)zp)[t * 2 + bb] = acc / l1ct + bias * (bb ? z.y : z.x);
    __syncthreads();
  }
}

constexpr int AT_KT = 128, AT_KP = 208, AT_VP = 264, AT_STAGE = AT_KT * AT_KP + 64 * AT_VP;
__device__ __forceinline__ void attn_task(const Ctx& p, int bh, int qb, char* smem) {
  const int tid = tid_l(), wid = tid >> 6, lane = tid & 63, r = lane & 31, hh = lane >> 5;
  const u16* Qp = (const u16*)(p.ws + WS_Q) + ((size_t)bh * SP + qb * 256) * 96;
  const u16* Kp = (const u16*)(p.ws + WS_K) + (size_t)bh * SP * 96;
  const u16* Vp = (const u16*)(p.ws + WS_VT) + (size_t)bh * 64 * SP;
  const int nkt = (qb == 0) ? 2 : 66;
  bf16x8 qf[6];
#pragma unroll
  for (int ks = 0; ks < 6; ++ks) qf[ks] = *(const bf16x8*)(Qp + (size_t)(wid * 32 + r) * 96 + ks * 16 + hh * 8);
  f32x16 o0, o1;
#pragma unroll
  for (int i = 0; i < 16; ++i) { o0[i] = 0.f; o1[i] = 0.f; }
  float mrun = 0.f, lrun = 0.f;
  const u16* src[5];
  int dst[5];
#pragma unroll
  for (int i = 0; i < 5; ++i) {
    int ch = tid + i * NT;
    if (i < 3) { int row = ch / 12, cc = ch - row * 12; src[i] = Kp + (size_t)row * 96 + cc * 8; dst[i] = row * AT_KP + cc * 16; }
    else { int v = ch - 1536, row = v >> 4, cc = v & 15; src[i] = Vp + (size_t)row * SP + cc * 8; dst[i] = AT_KT * AT_KP + row * AT_VP + cc * 16; }
  }
  uint4 st[5];
#define AT_LOAD(t)                                                                                   \
  do {                                                                                               \
    _Pragma("unroll") for (int i = 0; i < 5; ++i) st[i] = *(const uint4*)(src[i] + (size_t)(t) * (i < 3 ? AT_KT * 96 : AT_KT)); \
  } while (0)
#define AT_WRITE(buf)                                                                                \
  do {                                                                                               \
    char* base_ = smem + (buf) * AT_STAGE;                                                           \
    _Pragma("unroll") for (int i = 0; i < 5; ++i) {                                                  \
      uint2* d_ = (uint2*)(base_ + dst[i]);                                                          \
      d_[0] = make_uint2(st[i].x, st[i].y);                                                          \
      d_[1] = make_uint2(st[i].z, st[i].w);                                                          \
    }                                                                                                \
  } while (0)
#define AT_QK(S, kb)                                                                                 \
  __builtin_amdgcn_s_setprio(1);                                                                     \
  _Pragma("unroll") for (int ks = 0; ks < 6; ++ks) {                                                 \
    bf16x8 a_ = *(const bf16x8*)(Ks + ((kb) * 32 + r) * AT_KP + ks * 32 + hh * 16);                  \
    S = __builtin_amdgcn_mfma_f32_32x32x16_bf16(a_, qf[ks], S, 0, 0, 0);                             \
  }                                                                                                  \
  __builtin_amdgcn_s_setprio(0);
#define AT_SOFT_PV(S, kb)                                                                            \
  _Pragma("unroll") for (int i = 0; i < 16; ++i) { S[i] = __builtin_amdgcn_exp2f(S[i]); ps += S[i]; } \
  _Pragma("unroll") for (int sI = 0; sI < 2; ++sI) {                                                 \
    union { bf16x8 v; unsigned u[4]; } pu;                                                           \
    _Pragma("unroll") for (int j = 0; j < 4; ++j) pu.u[j] = pk2(S[8 * sI + 2 * j], S[8 * sI + 2 * j + 1]); \
    const int koff = ((kb) * 32 + 16 * sI + 4 * hh) * 2;                                             \
    union { bf16x8 v; uint2 h2[2]; } va, vb;                                                         \
    va.h2[0] = *(const uint2*)(Vs + r * AT_VP + koff);                                               \
    va.h2[1] = *(const uint2*)(Vs + r * AT_VP + koff + 16);                                          \
    vb.h2[0] = *(const uint2*)(Vs + (32 + r) * AT_VP + koff);                                        \
    vb.h2[1] = *(const uint2*)(Vs + (32 + r) * AT_VP + koff + 16);                                   \
    o0 = __builtin_amdgcn_mfma_f32_32x32x16_bf16(va.v, pu.v, o0, 0, 0, 0);                           \
    o1 = __builtin_amdgcn_mfma_f32_32x32x16_bf16(vb.v, pu.v, o1, 0, 0, 0);                           \
  }
  AT_LOAD(0);
  AT_WRITE(0);
  __syncthreads();
  for (int t = 0; t < nkt; ++t) {
    const int cur = t & 1;
    if (t + 1 < nkt) AT_LOAD(t + 1);
    const char* Ks = smem + cur * AT_STAGE;
    const char* Vs = Ks + AT_KT * AT_KP;
    const float nm = -mrun;
    f32x16 sA, sB;
    float ps = 0.f;
#pragma unroll
    for (int i = 0; i < 16; ++i) sA[i] = nm;
    AT_QK(sA, 0)
#pragma unroll
    for (int i = 0; i < 16; ++i) sB[i] = nm;
    AT_QK(sB, 1)
    AT_SOFT_PV(sA, 0)
#pragma unroll
    for (int i = 0; i < 16; ++i) sA[i] = nm;
    AT_QK(sA, 2)
    AT_SOFT_PV(sB, 1)
#pragma unroll
    for (int i = 0; i < 16; ++i) sB[i] = nm;
    AT_QK(sB, 3)
    AT_SOFT_PV(sA, 2)
    AT_SOFT_PV(sB, 3)
    lrun += ps;
    float pmx = fmaxf(ps, shx(ps, 32));
    if (__any(pmx > 65536.f)) {
      const float delta = pmx > 65536.f ? ceilf(__log2f(pmx)) : 0.f;
      const float alpha = __builtin_amdgcn_exp2f(-delta);
      mrun += delta;
      lrun *= alpha;
#pragma unroll
      for (int i = 0; i < 16; ++i) { o0[i] *= alpha; o1[i] *= alpha; }
    }
    if (t + 1 < nkt) AT_WRITE(cur ^ 1);
    __syncthreads();
  }
  const float ltot = lrun + shx(lrun, 32);
  const float inv = 1.f / ltot;
  const int b = bh >> 3, head = bh & 7;
  u16* Op = (u16*)(p.ws + WS_O) + ((size_t)b * SP + qb * 256 + wid * 32 + r) * 512 + head * 64;
#pragma unroll
  for (int g = 0; g < 4; ++g) {
    uint2 w0, w1;
    w0.x = pk2(o0[4 * g] * inv, o0[4 * g + 1] * inv);
    w0.y = pk2(o0[4 * g + 2] * inv, o0[4 * g + 3] * inv);
    w1.x = pk2(o1[4 * g] * inv, o1[4 * g + 1] * inv);
    w1.y = pk2(o1[4 * g + 2] * inv, o1[4 * g + 3] * inv);
    *(uint2*)(Op + 8 * g + 4 * hh) = w0;
    *(uint2*)(Op + 32 + 8 * g + 4 * hh) = w1;
  }
#undef AT_LOAD
#undef AT_WRITE
#undef AT_QK
#undef AT_SOFT_PV
}

__device__ __forceinline__ void hypost_task(const Ctx& p, int task, char* smem) {
  const int tid = tid_l(), lane = tid & 63, wid = tid >> 6;
  const int tile64 = task >> 1, ch0 = (task & 1) * 256;
  const int m0 = tile64 * 64, b = m0 / SP, pos0 = m0 - b * SP;
  float* T = (float*)smem;
  const float* ZV = (const float*)(p.ws + WS_ZV);
#pragma unroll 8
  for (int cc = 0; cc < 32; ++cc) {
    int c = wid * 32 + cc;
    T[c * 65 + lane] = ZV[((size_t)(ch0 + c) * SP + pos0 + lane) * 2 + b];
  }
  __syncthreads();
  u16* Y = (u16*)(p.ws + WS_Y);
  const int c = tid & 255, th = tid >> 8;
  u16* yp = Y + (size_t)(m0 + th * 32) * 512 + ch0 + c;
  u16 yv[32];
#pragma unroll
  for (int i = 0; i < 32; ++i) yv[i] = yp[(size_t)i * 512];
#pragma unroll
  for (int i = 0; i < 32; ++i) yp[(size_t)i * 512] = f2bf(bf2f(yv[i]) * T[c * 65 + th * 32 + i]);
  __syncthreads();
}

#ifndef PHMASK
#define PHMASK 0xFFFF
#endif
#define PHON(k) (((PHMASK) >> (k)) & 1)
constexpr int NPH = 1 + 4 * 10 + 1;
__global__ void __launch_bounds__(NT, 2) mega(Params prm) {
  __shared__ __attribute__((aligned(1024))) char smem[LDS_BYTES];
  cg::grid_group grid = cg::this_grid();
  const int bid = blockIdx.x, nb = gridDim.x;
  {
    unsigned long long* it = (unsigned long long*)(smem + AUX_OFF + 6144);
    if (threadIdx.x < 33) it[threadIdx.x] = (unsigned long long)prm.in[threadIdx.x];
    if (threadIdx.x == 0) *(uint4*)(smem + AUX_OFF + 7168) = make_uint4(0u, 0u, 0u, 0u);
    __syncthreads();
  }
  XcdBarrier xbar = xcd_barrier_post((unsigned*)(prm.ws + WS_BAR), (volatile LAS unsigned*)(smem + AUX_OFF + 7168));
  if (prm.ph_lo == 0) {
    Ctx p;
    p.intab = (const unsigned long long*)(smem + AUX_OFF + 6144);
    p.ws = prm.ws;
    p.out = prm.out;
    const int bid = blockIdx.x, nb = gridDim.x;
      if (PHON(10)) {
      p0_misc(p);
      for (int t = bid; t < 192; t += nb) p0_mod_task(p, t, smem);
      for (int t = bid; t < 528; t += nb) p0_hid_task(p, t, smem);
      for (int t = bid; t < 128; t += nb) { const int w = (t + 64) & 127; wpe_task(p, w >> 5, w & 31, smem); }
      }
  }
  unsigned nbar = 0;
  for (int ph = prm.ph_lo; ph < prm.ph_hi; ++ph) {
    Ctx p;
    p.intab = (const unsigned long long*)(smem + AUX_OFF + 6144);
    p.ws = prm.ws;
    p.out = prm.out;
    asm volatile("" : "+s"(p.ws), "+s"(p.out));
    float* modall = (float*)(p.ws + WS_MOD);
    u16* proj = (u16*)(p.ws + WS_PROJ);
    u16* xn = (u16*)(p.ws + WS_U);
    char* wo = (char*)p.out;
    if (ph == 0) {
    } else if (ph == NPH - 1) {
      if (PHON(11)) final_norm(p);
    } else {
      const int l = (ph - 1) / 10, sp = (ph - 1) % 10;
      const float* modl = modall + (size_t)l * 3 * 6144;
      GD* tab = (GD*)(smem + AUX_OFF + 4096);
      int ng = 0, nN0 = 0, nN1 = 0, nsplit = 1;
      const bool last = (l == 3);
      const float* gate = modl;
      if (sp == 0 && PHON(0)) {
        wt_phase(p, l, smem);
        norm_rows(p, pin(p, 6) + l * 1024, modl, 0, 1, xn);
      } else if (sp == 1 && PHON(1)) {
        if (threadIdx.x == 0) tab[0] = GD{xn, 1024, (const u16*)(wo + WO_IN), 1024, 1024, 23, EM_PROJ, 1};
        ng = 1; nN0 = 23;
      } else if (sp == 2 && PHON(2)) {
        for (int t = bid; t < 264 * 6; t += nb) premix_task(p, l, t, smem);
        {
          Epi ef{EM_FILT, p.ws, gate, nullptr, (u16*)(wo + WO_FILT)};
          const u16* hA = (const u16*)(p.ws + WS_HID2) + (size_t)l * 8192 * 64;
          const u16* wB = (const u16*)(p.ws + WS_W3T) + (size_t)l * 1024 * 64;
#pragma unroll 1
          for (int t = nb - 1 - bid; t < 128; t += nb) gemm_tile(hA, 64, wB, 64, 64, (t >> 2) * 256, (t & 3) * 256, smem, ef);
        }
      } else if (sp == 3 && PHON(3)) {
        for (int t = bid; t < 512; t += nb) fft_task(p, l, t, smem);
        if (threadIdx.x == 0) {
          tab[0] = GD{proj + OFF_Q, DINP, (const u16*)(wo + WO_UQ), 384, 384, 3, EM_Q, 1};
          tab[1] = GD{proj + OFF_KV, DINP, (const u16*)(wo + WO_UKV), 256, 256, 4, EM_KV, 1};
        }
        ng = 2; nN0 = 3; nN1 = 4;
        for (int i = tid_l(); i < 1024; i += NT) ((float2*)(smem + 131072))[i] = ((const float2*)(p.ws + WS_ROPE))[i];
      } else if (sp == 4 && PHON(4)) {
        for (int t = bid; t < (last ? 512 : 528); t += nb) {
          int bh, qb;
          if (t < 512) { int rnd = t >> 8, w = t & 255; bh = (w & 7) + 8 * rnd; qb = 1 + (w >> 3); }
          else { bh = t - 512; qb = 0; }
          attn_task(p, bh, qb, smem);
        }
        for (int t = bid; t < 528; t += nb) hypost_task(p, t, smem);
      } else if (sp == 5 && PHON(5)) {
        for (int t = bid; t < (last ? 512 : 544); t += nb) {
          if (t < 512) {
            const int x = t & 7, g = t >> 3, pmi = (g >> 2) * 8 + x, pm = pmi + 2 + (pmi >= 64 ? 2 : 0);
            mix_tile<4>(p, l, pm * 128, g & 3, smem);
          } else {
            const int c = t - 512, cm = c >> 2;
            mix_tile<2>(p, l, (cm >> 2) * SP + (cm & 3) * 64, c & 3, smem);
          }
        }
      } else if (sp == 6 && PHON(6)) {
        if (threadIdx.x == 0) tab[0] = GD{(const u16*)(p.ws + WS_ZV), 1024, (const u16*)(wo + WO_OUT), 1024, 1024, 4, EM_RESID, 4};
        ng = 1; nN0 = 4; nsplit = 4;
        gate = modl + 2 * 1024;
      } else if (sp == 7 && PHON(7)) {
        norm_rows(p, pin(p, 7) + l * 1024, modl, 3, 4, xn);
      } else if (sp == 8 && PHON(8)) {
        if (threadIdx.x == 0) tab[0] = GD{xn, 1024, (const u16*)(wo + WO_FF1), 1024, 1024, 16, EM_SQRELU, last ? 2 : 1};
        ng = 1; nN0 = 16; nsplit = last ? 2 : 1;
      } else if (sp == 9 && PHON(9)) {
        if (threadIdx.x == 0) tab[0] = GD{proj, DFF, (const u16*)(wo + WO_FF2), 4096, 4096, 4, EM_RESID, 8};
        ng = 1; nN0 = 4; nsplit = 8;
        gate = modl + 5 * 1024;
      }
      if (ng > 0) {
        __syncthreads();
        const int nt0 = (nsplit > 1) ? (64 * nN0 + (last ? 0 : 2 * nN0 * nsplit)) : NMT * nN0, ntot = nt0 + NMT * nN1;
#pragma unroll 1
        for (int t = bid; t < ntot; t += nb) {
          int gi = 0, tt = t;
          if (t >= nt0) { gi = 1; tt = t - nt0; }
          const volatile GD* gp = tab + gi;
          unsigned long long a64 = (unsigned long long)gp->A, b64 = (unsigned long long)gp->Bt;
          a64 = ((unsigned long long)(unsigned)__builtin_amdgcn_readfirstlane((unsigned)(a64 >> 32)) << 32) | (unsigned long long)(unsigned)__builtin_amdgcn_readfirstlane((unsigned)a64);
          b64 = ((unsigned long long)(unsigned)__builtin_amdgcn_readfirstlane((unsigned)(b64 >> 32)) << 32) | (unsigned long long)(unsigned)__builtin_amdgcn_readfirstlane((unsigned)b64);
          const int lda = __builtin_amdgcn_readfirstlane(gp->lda), ldb = __builtin_amdgcn_readfirstlane(gp->ldb);
          const int K = __builtin_amdgcn_readfirstlane(gp->K), nN = __builtin_amdgcn_readfirstlane(gp->nN);
          const int ks = __builtin_amdgcn_readfirstlane(gp->ks);
          const int mode = __builtin_amdgcn_readfirstlane(gp->mode);
          int pm, pn, Kuse = K, emode = mode;
          if (ks > 1) {
            const int nlat = 64 * nN;
            if (tt < nlat) { int pm64; tile_map(tt, 64, nN, pm64, pn); pm = (pm64 >> 5) * 33 + 1 + (pm64 & 31); }
            else {
              int u = tt - nlat, kp = u % ks, tile = u / ks;
              pm = (tile / nN) * 33; pn = tile % nN;
              Kuse = K / ks; emode = EM_RESID_AT;
              a64 += (unsigned long long)kp * Kuse * 2; b64 += (unsigned long long)kp * Kuse * 2;
            }
          } else tile_map(tt, NMT, nN, pm, pn);
          Epi e{emode, p.ws, gate, (const float2*)(smem + 131072), nullptr};
          gemm_tile((const u16*)a64, lda, (const u16*)b64, ldb, Kuse, pm * 256, pn * 256, smem, e);
        }
      }
    }
    if (ph + 1 < prm.ph_hi) {
      if (ph == prm.ph_lo) grid.sync();
      else xcd_barrier(xbar);
    }
  }
}

extern "C" void kernel_launch(void* const* d_in, const int* in_sizes, int n_in, void* d_out, int out_size, void* d_ws,
                              size_t ws_size, hipStream_t stream) {
  static int grid_blocks = 0;
  if (grid_blocks == 0) {
    if (n_in != 33 || ws_size < WS_END || (size_t)out_size * 4 < WO_END) {
      fprintf(stderr, "kernel_launch: unexpected sizes n_in=%d ws=%zu (need %zu) out=%d\n", n_in, ws_size, (size_t)WS_END, out_size);
      grid_blocks = -1;
      return;
    }
    int dev = 0, cus = 0, per_cu = 0;
    hipGetDevice(&dev);
    hipDeviceGetAttribute(&cus, hipDeviceAttributeMultiprocessorCount, dev);
    hipOccupancyMaxActiveBlocksPerMultiprocessor(&per_cu, mega, NT, 0);
    if (per_cu < 1) per_cu = 1;
    if (per_cu > 1) per_cu = 1;
    grid_blocks = cus * per_cu;
  }
  if (grid_blocks < 0) return;
  Params p{};
  for (int i = 0; i < 33; ++i) p.in[i] = (const float*)d_in[i];
  p.out = (float*)d_out;
  p.ws = (char*)d_ws;
  p.ph_lo = 0;
  p.ph_hi = NPH;
  (void)hipMemsetAsync((char*)d_ws + WS_BAR, 0, 16384, stream);
  void* args[] = {&p};
  hipError_t e = hipLaunchCooperativeKernel((void*)mega, dim3(grid_blocks), dim3(NT), args, 0, stream);
  if (e != hipSuccess) fprintf(stderr, "cooperative launch failed: %s (grid %d)\n", hipGetErrorString(e), grid_blocks);
}
```

```cpp
#include <hip/hip_runtime.h>
#include <hip/hip_cooperative_groups.h>
#include <cstdio>
namespace cg = cooperative_groups;

typedef unsigned short u16;
using bf16x8 = __attribute__((ext_vector_type(8))) short;
using f32x4 = __attribute__((ext_vector_type(4))) float;
using f32x16 = __attribute__((ext_vector_type(16))) float;

constexpr int D = 1024, SEQ = 8192, CTX = 256, SP = 8448, MROWS = 16896, NMT = 66;
constexpr int DIN = 5792, DINP = 5888, DFF = 4096;
constexpr int OFF_HY = 512, OFF_Q = 2048, OFF_KV = 2432, OFF_GATE = 2720;
constexpr int NT = 512;
constexpr float EPS = 1e-6f;

constexpr size_t WS_H = 0;
constexpr size_t WS_PROJ = WS_H + (size_t)MROWS * D * 4;
constexpr size_t WS_U = WS_PROJ + (size_t)MROWS * DINP * 2;
constexpr size_t WS_Y = WS_U + (size_t)MROWS * 512 * 2;
constexpr size_t WS_O = WS_Y + (size_t)MROWS * 512 * 2;
constexpr size_t WS_Q = WS_O + (size_t)MROWS * 512 * 2;
constexpr size_t WS_K = WS_Q + (size_t)16 * SP * 96 * 2;
constexpr size_t WS_VT = WS_K + (size_t)16 * SP * 96 * 2;
constexpr size_t WS_ZV = WS_VT + (size_t)16 * 64 * SP * 2;
constexpr size_t WS_HID2 = WS_ZV + (size_t)512 * SP * 8;
constexpr size_t WS_HID2C = WS_HID2 + (size_t)4 * 8192 * 64 * 4;
constexpr size_t WS_MOD = WS_HID2C + (size_t)4 * 256 * 64 * 4;
constexpr size_t WS_ROPE = WS_MOD + (size_t)4 * 3 * 6144 * 4;
constexpr size_t WS_TW = WS_ROPE + (size_t)128 * 8 * 8;
constexpr size_t WS_WPE = WS_TW + (size_t)16384 * 8;
constexpr size_t WS_BAR = WS_WPE + (size_t)4 * 1024 * 512 * 2;
constexpr size_t WS_END = WS_BAR + 16384;
constexpr size_t WO_IN = 0;
constexpr size_t WO_FF1 = WO_IN + (size_t)DINP * 1024 * 2;
constexpr size_t WO_FF2 = WO_FF1 + (size_t)4096 * 1024 * 2;
constexpr size_t WO_OUT = WO_FF2 + (size_t)4096 * 1024 * 2;
constexpr size_t WO_HY = WO_OUT + (size_t)1024 * 1024 * 2;
constexpr size_t WO_WO = WO_HY + (size_t)1024 * 512 * 2;
constexpr size_t WO_PE = WO_WO + (size_t)1024 * 512 * 2;
constexpr size_t WO_UQ = WO_PE + (size_t)1024 * 512 * 2;
constexpr size_t WO_UKV = WO_UQ + (size_t)768 * 384 * 2;
constexpr size_t WO_FILT = WO_UKV + (size_t)1024 * 256 * 2;
constexpr size_t WO_END = WO_FILT + (size_t)1024 * 8192 * 2;
constexpr size_t WS_W3T = WS_HID2 + (size_t)4 * 8192 * 64 * 2;

constexpr int AUX_OFF = 147456;
constexpr int LDS_BYTES = AUX_OFF + 8192;

struct Params {
  const float* in[33];
  float* out;
  char* ws;
  int ph_lo, ph_hi;
};

struct Ctx { const unsigned long long* intab; char* ws; float* out; };
__device__ __forceinline__ const float* pin(const Ctx& c, int i) {
  unsigned long long v = c.intab[i];
  unsigned lo = __builtin_amdgcn_readfirstlane((unsigned)v), hi = __builtin_amdgcn_readfirstlane((unsigned)(v >> 32));
  return (const float*)(((unsigned long long)hi << 32) | lo);
}

typedef __bf16 hwbf2 __attribute__((ext_vector_type(2)));
typedef float hwf2 __attribute__((ext_vector_type(2)));
__device__ __forceinline__ unsigned pk2(float a, float b) {
  hwf2 v = {a, b};
  hwbf2 r = __builtin_convertvector(v, hwbf2);
  return __builtin_bit_cast(unsigned, r);
}
__device__ __forceinline__ u16 f2bf(float f) { return (u16)(pk2(f, 0.f) & 0xffffu); }
__device__ __forceinline__ float bf2f(u16 b) { return __uint_as_float(((unsigned)b) << 16); }
__device__ __forceinline__ float shx(float v, int o) {
  int l = __builtin_amdgcn_mbcnt_hi(~0u, __builtin_amdgcn_mbcnt_lo(~0u, 0u));
  asm volatile("" : "+v"(l));
  return __int_as_float(__builtin_amdgcn_ds_bpermute((l ^ o) << 2, __float_as_int(v)));
}
__device__ __forceinline__ float wave_sum(float v) {
#pragma unroll
  for (int o = 1; o < 64; o <<= 1) v += shx(v, o);
  return v;
}
__device__ __forceinline__ int grp_of_row(int m) {
  int tile = m >> 8, b = tile / 33, t33 = tile - b * 33;
  return t33 == 0 ? 2 : b;
}
__device__ __forceinline__ float2 cmul(float2 a, float2 b) { return make_float2(a.x * b.x - a.y * b.y, a.x * b.y + a.y * b.x); }

__device__ __forceinline__ int tid_l() { int t = threadIdx.x; asm volatile("" : "+v"(t)); return t; }
#define XB_TMO      128
#define XB_XCNT(j)  (256  + 64 * (j))
#define XB_XSUB(j)  (1280 + 64 * (j))
#define XB_XGEN(j)  (2304 + 64 * (j))
#define XB_TOP      3328
#define XB_TOPGEN   3392
#define XCD_BAR_WORDS 3456
#define XB_SPIN_CAP (1u << 18)
#define LAS __attribute__((address_space(3)))
__device__ __forceinline__ unsigned xb_ld(unsigned* p)              { return __hip_atomic_load(p, __ATOMIC_RELAXED, __HIP_MEMORY_SCOPE_AGENT); }
__device__ __forceinline__ unsigned xb_add(unsigned* p, unsigned v) { return __hip_atomic_fetch_add(p, v, __ATOMIC_RELAXED, __HIP_MEMORY_SCOPE_AGENT); }
__device__ __forceinline__ unsigned xb_xcc_id() { return (unsigned)__builtin_amdgcn_s_getreg((3 << 11) | 20) & 0xFu; }
#define XB_SPIN(cond, bar) do { unsigned _sp = 0; while (cond) { __builtin_amdgcn_s_sleep(1); \
    if ((++_sp & 255u) == 0u) { if (xb_ld(&(bar)[XB_TMO])) break; if (_sp > XB_SPIN_CAP) { atomicAdd(&(bar)[XB_TMO], 1u); break; } } } } while (0)
struct XcdBarrier { unsigned* bar; unsigned x; volatile LAS unsigned* st; };
__device__ __forceinline__ XcdBarrier xcd_barrier_post(unsigned* bar, volatile LAS unsigned* st) {
    XcdBarrier b; b.bar = bar; b.x = xb_xcc_id(); b.st = st;
    if (threadIdx.x == 0) (void)xb_add(&bar[XB_XCNT(b.x)], 1u);
    return b;
}
__device__ __forceinline__ void xcd_barrier_complete(unsigned* bar, unsigned x, unsigned& nloc, unsigned& nx) {
    const unsigned G = gridDim.x * gridDim.y * gridDim.z;
    unsigned sum, cnt, mine, sp = 0u;
    for (;;) {
        sum = 0u; cnt = 0u; mine = 0u;
#pragma unroll
        for (unsigned j = 0; j < 16; ++j) { const unsigned c = xb_ld(&bar[XB_XCNT(j)]); sum += c; cnt += (c > 0u) ? 1u : 0u; mine = (j == x) ? c : mine; }
        if (sum == G) break;
        __builtin_amdgcn_s_sleep(1);
        if ((++sp & 255u) == 0u) { if (xb_ld(&bar[XB_TMO])) break; if (sp > XB_SPIN_CAP) { atomicAdd(&bar[XB_TMO], 1u); break; } }
    }
    nloc = mine > 0u ? mine : 1u; nx = cnt > 0u ? cnt : 1u;
}
__device__ __forceinline__ void xcd_barrier(const XcdBarrier& b) {
    asm volatile("s_waitcnt vmcnt(0)" ::: "memory");
    __syncthreads();
    if (threadIdx.x == 0) {
        unsigned* bar = b.bar;
        __builtin_amdgcn_s_waitcnt(0);
        unsigned nloc = b.st[0], nx = b.st[1];
        if (nloc == 0u) { xcd_barrier_complete(bar, b.x, nloc, nx); b.st[0] = nloc; b.st[1] = nx; }
        const unsigned old = xb_add(&bar[XB_XSUB(b.x)], 1u);
        const unsigned gen = old / nloc;
        if (old + 1u == (gen + 1u) * nloc) {
            __builtin_amdgcn_fence(__ATOMIC_RELEASE, "agent");
            asm volatile("s_waitcnt vmcnt(0)" ::: "memory");
            const unsigned og = xb_add(&bar[XB_TOP], 1u);
            const unsigned tg = og / nx;
            if (og + 1u == (tg + 1u) * nx) xb_add(&bar[XB_TOPGEN], 1u);
            else XB_SPIN(xb_ld(&bar[XB_TOPGEN]) == tg, bar);
            __builtin_amdgcn_fence(__ATOMIC_ACQUIRE, "agent");
            xb_add(&bar[XB_XGEN(b.x)], 1u);
            asm volatile("s_waitcnt vmcnt(0)" ::: "memory");
        } else {
            XB_SPIN(xb_ld(&bar[XB_XGEN(b.x)]) == gen, bar);
            __builtin_amdgcn_fence(__ATOMIC_ACQUIRE, "agent");
            asm volatile("s_waitcnt vmcnt(0)" ::: "memory");
        }
    }
    __syncthreads();
}

__device__ __forceinline__ void grid_barrier(unsigned* bar, unsigned target) {
  asm volatile("s_waitcnt vmcnt(0)" ::: "memory");
  __syncthreads();
  if (threadIdx.x == 0) {
    __builtin_amdgcn_fence(__ATOMIC_RELEASE, "agent");
    asm volatile("s_waitcnt vmcnt(0)" ::: "memory");
    __hip_atomic_fetch_add(bar, 1u, __ATOMIC_RELAXED, __HIP_MEMORY_SCOPE_AGENT);
    while (__hip_atomic_load(bar, __ATOMIC_RELAXED, __HIP_MEMORY_SCOPE_AGENT) < target) __builtin_amdgcn_s_sleep(2);
    __builtin_amdgcn_fence(__ATOMIC_ACQUIRE, "agent");
    asm volatile("s_waitcnt vmcnt(0)" ::: "memory");
  }
  __syncthreads();
}
#define WAIT_V(n) asm volatile("s_waitcnt vmcnt(%0)" ::"n"(n) : "memory")
#define SCHED() __builtin_amdgcn_sched_barrier(0)
#define RAW_BARRIER() do { asm volatile("s_waitcnt lgkmcnt(0)" ::: "memory"); __builtin_amdgcn_s_barrier(); } while (0)

constexpr float QSCALE = 0.10206207261596575f * 1.4426950408889634f;
enum { EM_PROJ = 0, EM_SQRELU = 1, EM_RESID = 2, EM_RESID_AT = 3, EM_FILT = 4, EM_Q = 6, EM_KV = 7 };
struct Epi {
  int mode;
  char* ws;
  const float* gate;
  const float2* rope_lds;
  u16* filt_out;
  __device__ __forceinline__ void proj(int row, int col, f32x4 v) const {
    {
      u16* out = (u16*)(ws + WS_PROJ);
#pragma unroll
      for (int j = 0; j < 4; ++j) out[(size_t)(row + j) * DINP + col] = f2bf(v[j]);
    }
  }
  __device__ __forceinline__ void sqrelu(int row, int col, f32x4 v) const {
    {
      u16* out = (u16*)(ws + WS_PROJ);
#pragma unroll
      for (int j = 0; j < 4; ++j) { float r = fmaxf(v[j], 0.f); out[(size_t)(row + j) * DFF + col] = f2bf(r * r); }
    }
  }
  __device__ __forceinline__ void resid(int row, int col, f32x4 v) const {
    {
      float* h = (float*)(ws + WS_H);
      float g = gate[grp_of_row(row) * 6144 + col];
#pragma unroll
      for (int j = 0; j < 4; ++j) unsafeAtomicAdd(h + (size_t)(row + j) * D + col, g * v[j]);
    }
  }
  __device__ __forceinline__ void filt(int row, int col, f32x4 v) const {
    uint2 o;
    o.x = pk2(v[0], v[1]);
    o.y = pk2(v[2], v[3]);
    *(uint2*)(filt_out + (size_t)col * 8192 + row) = o;
  }
  __device__ __forceinline__ void q(int row, int col, f32x4 v) const {
    {
      u16* Q = (u16*)(ws + WS_Q);
      const float2* rope = rope_lds;
      int head = col / 96, d = col - head * 96;
      int b = row / SP, pos0 = row - b * SP;
      bool isrope = (d >= 64) && (pos0 >= CTX);
      int rd = d - 64;
#pragma unroll
      for (int j = 0; j < 4; ++j) {
        float val = v[j];
        float partner = shx(val, 8);
        int pos = pos0 + j;
        if (isrope) {
          int t = pos - CTX, idx = (rd < 16) ? (t >> 6) : (t & 63);
          float2 cs = rope[idx * 8 + (rd & 7)];
          float sgn = (rd & 8) ? 1.f : -1.f;
          val = val * cs.x + sgn * partner * cs.y;
        }
        Q[((size_t)(b * 8 + head) * SP + pos) * 96 + d] = f2bf(val * QSCALE);
      }
    }
  }
  __device__ __forceinline__ void kv(int row, int col, f32x4 v) const {
    {
      u16* Kb = (u16*)(ws + WS_K);
      u16* Vt = (u16*)(ws + WS_VT);
      int head = col >> 7, j2 = col & 127;
      int b = row / SP, pos0 = row - b * SP;
      if (j2 < 64) {
#pragma unroll
        for (int j = 0; j < 4; ++j) Kb[((size_t)(b * 8 + head) * SP + pos0 + j) * 96 + j2] = f2bf(v[j]);
      } else {
        uint2 o;
        o.x = pk2(v[0], v[1]);
        o.y = pk2(v[2], v[3]);
        *(uint2*)(Vt + ((size_t)(b * 8 + head) * 64 + (j2 - 64)) * SP + pos0) = o;
      }
    }
  }
};
struct GD { const u16* A; int lda; const u16* Bt; int ldb; int K; int nN; int mode; int ks; };

constexpr int G_TILE_B = 256 * 64 * 2, G_STAGE_B = 2 * G_TILE_B;
__device__ __forceinline__ int lds_byte(int r, int c) {
  int st = (r >> 4) * 2 + (c >> 5), ob = (r & 15) * 64 + (c & 31) * 2;
  return st * 1024 + (ob ^ (((ob >> 9) & 1) << 5));
}
__device__ __forceinline__ void stage_rc(int b, int& R, int& C) {
  int st = b >> 10, sb = b & 1023, swz = sb ^ (((sb >> 9) & 1) << 5);
  R = (st / 2) * 16 + swz / 64;
  C = (st % 2) * 32 + (swz % 64) / 2;
}

template <int MI>
__device__ __forceinline__ void gemm_core(const u16* __restrict__ A, int lda, const u16* __restrict__ Bt, int ldb, int K,
                                          int brow, int bcol, char* shm, f32x4 (&acc)[MI][4]) {
  constexpr int TILE_A = MI * 32 * 64 * 2, TILE_BB = 256 * 64 * 2, STAGE = TILE_A + TILE_BB;
  const int tid = tid_l(), wid = tid >> 6, lane = tid & 63, wr = wid >> 2, wc = wid & 3, fr = lane & 15, fq = lane >> 4;
  const u16* Ab = A + (size_t)brow * lda;
  const u16* Bb = Bt + (size_t)bcol * ldb;
  int sR[4], sC[4];
#pragma unroll
  for (int i = 0; i < 4; ++i) stage_rc(wid * 1024 + i * 8192 + lane * 16, sR[i], sC[i]);
#define SA(b) (shm + (b) * STAGE)
#define SB(b) (shm + (b) * STAGE + TILE_A)
#define GLDS_STAGE(buf, kt)                                                                                              \
  do {                                                                                                                   \
    _Pragma("unroll") for (int i = 0; i < 4; ++i) {                                                                      \
      if (i < MI / 2)                                                                                                    \
        __builtin_amdgcn_global_load_lds((const unsigned*)(Ab + (size_t)sR[i] * lda + (kt) * 64 + sC[i]),                \
                                         (unsigned*)(SA(buf) + wid * 1024 + i * 8192), 16, 0, 0);                        \
      __builtin_amdgcn_global_load_lds((const unsigned*)(Bb + (size_t)sR[i] * ldb + (kt) * 64 + sC[i]),                  \
                                       (unsigned*)(SB(buf) + wid * 1024 + i * 8192), 16, 0, 0);                          \
    }                                                                                                                    \
  } while (0)
  const int nt = K / 64;
  GLDS_STAGE(0, 0);
  WAIT_V(0);
  __syncthreads();
  for (int t = 0; t < nt; ++t) {
    const int cur = t & 1;
    if (t + 1 < nt) GLDS_STAGE(cur ^ 1, t + 1);
    __builtin_amdgcn_iglp_opt(1);
#pragma unroll
    for (int ks = 0; ks < 2; ++ks) {
      bf16x8 At[MI], Bf[4];
#pragma unroll
      for (int m = 0; m < MI; ++m) At[m] = *(const bf16x8*)(SA(cur) + lds_byte(wr * (MI * 16) + m * 16 + fr, ks * 32 + fq * 8));
#pragma unroll
      for (int n = 0; n < 4; ++n) Bf[n] = *(const bf16x8*)(SB(cur) + lds_byte(wc * 64 + n * 16 + fr, ks * 32 + fq * 8));
#pragma unroll
      for (int m = 0; m < MI; ++m)
#pragma unroll
        for (int n = 0; n < 4; ++n) acc[m][n] = __builtin_amdgcn_mfma_f32_16x16x32_bf16(At[m], Bf[n], acc[m][n], 0, 0, 0);
    }
    WAIT_V(0);
    __syncthreads();
  }
#undef SA
#undef SB
#undef GLDS_STAGE
}

template <class EpiT>
__device__ __forceinline__ void gemm_tile(const u16* __restrict__ A, int lda, const u16* __restrict__ Bt, int ldb, int K,
                                          int brow, int bcol, char* shm, const EpiT& epi) {
  const int tid = tid_l(), wid = tid >> 6, lane = tid & 63, wr = wid >> 2, wc = wid & 3, fr = lane & 15, fq = lane >> 4;
  f32x4 acc[8][4];
#pragma unroll
  for (int m = 0; m < 8; ++m)
#pragma unroll
    for (int n = 0; n < 4; ++n) acc[m][n] = (f32x4){0.f, 0.f, 0.f, 0.f};
  gemm_core<8>(A, lda, Bt, ldb, K, brow, bcol, shm, acc);
#define EPI_LOOP(CALL)                                                                              \
  _Pragma("unroll") for (int m = 0; m < 8; ++m) _Pragma("unroll") for (int n = 0; n < 4; ++n) {      \
    const int row = brow + wr * 128 + m * 16 + fq * 4, col = bcol + wc * 64 + n * 16 + fr;           \
    const f32x4 v = acc[m][n];                                                                        \
    CALL;                                                                                             \
  }
  if (epi.mode == EM_PROJ) { EPI_LOOP(epi.proj(row, col, v)) }
  else if (epi.mode == EM_SQRELU) { EPI_LOOP(epi.sqrelu(row, col, v)) }
  else if (epi.mode == EM_RESID_AT) { EPI_LOOP(epi.resid(row, col, v)) }
  else if (epi.mode == EM_RESID) {
    float* h = (float*)(epi.ws + WS_H);
    float g4[4];
#pragma unroll
    for (int n = 0; n < 4; ++n) g4[n] = epi.gate[grp_of_row(brow) * 6144 + bcol + wc * 64 + n * 16 + fr];
    float hv[8][4][4];
    float* hp0 = h + (size_t)(brow + wr * 128 + fq * 4) * D + bcol + wc * 64 + fr;
#define H_LOAD(m) _Pragma("unroll") for (int n = 0; n < 4; ++n) _Pragma("unroll") for (int j = 0; j < 4; ++j) hv[m][n][j] = hp0[(size_t)((m) * 16 + j) * D + n * 16]
#define H_STORE(m) _Pragma("unroll") for (int n = 0; n < 4; ++n) _Pragma("unroll") for (int j = 0; j < 4; ++j) hp0[(size_t)((m) * 16 + j) * D + n * 16] = hv[m][n][j] + g4[n] * acc[m][n][j]
    H_LOAD(0); H_LOAD(1);
    SCHED();
    H_STORE(0); H_LOAD(2); SCHED();
    H_STORE(1); H_LOAD(3); SCHED();
    H_STORE(2); H_LOAD(4); SCHED();
    H_STORE(3); H_LOAD(5); SCHED();
    H_STORE(4); H_LOAD(6); SCHED();
    H_STORE(5); H_LOAD(7); SCHED();
    H_STORE(6); H_STORE(7);
#undef H_LOAD
#undef H_STORE
  }
  else if (epi.mode == EM_FILT) { EPI_LOOP(epi.filt(row, col, v)) }
  else if (epi.mode == EM_Q) { EPI_LOOP(epi.q(row, col, v)) }
  else { EPI_LOOP(epi.kv(row, col, v)) }
#undef EPI_LOOP
}

template <int MI>
__device__ __forceinline__ void mix_tile(const Ctx& p, int l, int brow, int pn, char* shm) {
  constexpr int TILE_A = MI * 32 * 64 * 2, TILE_BB = 256 * 64 * 2, STAGE = TILE_A + TILE_BB, WROWS = MI * 16;
  const int tid = tid_l(), wid = tid >> 6, lane = tid & 63, wr = wid >> 2, wc = wid & 3, fr = lane & 15, fq = lane >> 4;
  const int bcol = pn * 256;
  const u16* projb = (const u16*)(p.ws + WS_PROJ);
  char* wo = (char*)p.out;
#define SA(b) (shm + (b) * STAGE)
#define SB(b) (shm + (b) * STAGE + TILE_A)
#define MIX_STAGE(buf, kt)                                                                                               \
  do {                                                                                                                   \
    const int br_ = (kt) >> 3, ko_ = ((kt) & 7) * 64;                                                                    \
    const u16* Ab_ = (const u16*)(p.ws + (br_ == 0 ? WS_U : br_ == 1 ? WS_Y : WS_O)) + (size_t)brow * 512 + ko_;         \
    const u16* Bb_ = (br_ == 0 ? (const u16*)(p.ws + WS_WPE) + (size_t)l * 1024 * 512 : (const u16*)(wo + (br_ == 1 ? WO_HY : WO_WO))) + (size_t)bcol * 512 + ko_;        \
    _Pragma("unroll") for (int i = 0; i < 4; ++i) {                                                                      \
      int sR_, sC_; stage_rc(wid * 1024 + i * 8192 + lane * 16, sR_, sC_);                                              \
      if (i < MI / 2)                                                                                                    \
        __builtin_amdgcn_global_load_lds((const unsigned*)(Ab_ + sR_ * 512 + sC_),                           \
                                         (unsigned*)(SA(buf) + wid * 1024 + i * 8192), 16, 0, 0);                        \
      __builtin_amdgcn_global_load_lds((const unsigned*)(Bb_ + sR_ * 512 + sC_),                             \
                                       (unsigned*)(SB(buf) + wid * 1024 + i * 8192), 16, 0, 0);                          \
    }                                                                                                                    \
  } while (0)
  f32x4 tot[MI][4], acc[MI][4];
#pragma unroll
  for (int m = 0; m < MI; ++m)
#pragma unroll
    for (int n = 0; n < 4; ++n) { tot[m][n] = (f32x4){0.f, 0.f, 0.f, 0.f}; acc[m][n] = (f32x4){0.f, 0.f, 0.f, 0.f}; }
  MIX_STAGE(0, 0);
  MIX_STAGE(1, 1);
  WAIT_V(6);
  RAW_BARRIER();
  int cur = 0;
#pragma unroll 1
  for (int br = 0; br < 3; ++br) {
    unsigned gpk[MI][4][2];
    const u16* gp = projb + (size_t)(brow + wr * WROWS + fq * 4) * DINP + OFF_GATE + br * 1024 + bcol + wc * 64 + fr;
#define GATE_LOAD(m)                                                                                   \
    _Pragma("unroll") for (int n = 0; n < 4; ++n) _Pragma("unroll") for (int j2 = 0; j2 < 2; ++j2) {       \
      unsigned lo = gp[(size_t)((m) * 16 + 2 * j2) * DINP + n * 16], hi = gp[(size_t)((m) * 16 + 2 * j2 + 1) * DINP + n * 16]; \
      gpk[m][n][j2] = lo | (hi << 16);                                                                     \
    }
    GATE_LOAD(0); GATE_LOAD(1);
    if (MI == 4) { GATE_LOAD(2); }
#pragma unroll 1
    for (int kk = 0; kk < 8; ++kk) {
      const int t = br * 8 + kk;
      { int nx = cur + 2; if (nx >= 3) nx -= 3; if (t + 2 < 24) MIX_STAGE(nx, t + 2); }
      __builtin_amdgcn_iglp_opt(1);
#pragma unroll
      for (int ks = 0; ks < 2; ++ks) {
        bf16x8 At[2], Bf[4];
#pragma unroll
        for (int n = 0; n < 4; ++n) Bf[n] = *(const bf16x8*)(SB(cur) + lds_byte(wc * 64 + n * 16 + fr, ks * 32 + fq * 8));
#pragma unroll
        for (int mh = 0; mh < MI / 2; ++mh) {
#pragma unroll
          for (int m = 0; m < 2; ++m) At[m] = *(const bf16x8*)(SA(cur) + lds_byte(wr * WROWS + (mh * 2 + m) * 16 + fr, ks * 32 + fq * 8));
#pragma unroll
          for (int m = 0; m < 2; ++m)
#pragma unroll
            for (int n = 0; n < 4; ++n) acc[mh * 2 + m][n] = __builtin_amdgcn_mfma_f32_16x16x32_bf16(At[m], Bf[n], acc[mh * 2 + m][n], 0, 0, 0);
        }
      }
      if (t + 2 < 24) WAIT_V(6); else WAIT_V(0);
      RAW_BARRIER();
      cur = (cur == 2) ? 0 : cur + 1;
    }
    if (MI == 4) { GATE_LOAD(3); }
#undef GATE_LOAD
#pragma unroll
    for (int m = 0; m < MI; ++m)
#pragma unroll
      for (int n = 0; n < 4; ++n)
#pragma unroll
        for (int j = 0; j < 4; ++j) {
          const unsigned w = gpk[m][n][j >> 1];
          const float gv = __uint_as_float((j & 1) ? (w & 0xffff0000u) : (w << 16));
          tot[m][n][j] += acc[m][n][j] * __builtin_amdgcn_rcpf(1.f + __expf(-gv));
          acc[m][n][j] = 0.f;
        }
  }
  u16* mixb = (u16*)(p.ws + WS_ZV);
#pragma unroll
  for (int m = 0; m < MI; ++m)
#pragma unroll
    for (int n = 0; n < 4; ++n)
#pragma unroll
      for (int j = 0; j < 4; ++j)
        mixb[(size_t)(brow + wr * WROWS + m * 16 + fq * 4 + j) * D + bcol + wc * 64 + n * 16 + fr] = f2bf(tot[m][n][j]);
#undef SA
#undef SB
#undef MIX_STAGE
}

__device__ __forceinline__ void tile_map(int t, int nM, int nN, int& pm, int& pn) {
  int nwg = nM * nN, wgid = t;
  {
    int q = nwg / 8, r = nwg % 8, xcd = wgid % 8, off = wgid / 8;
    wgid = (xcd < r ? xcd * (q + 1) : r * (q + 1) + (xcd - r) * q) + off;
  }
  constexpr int WGM = 4;
  int nig = WGM * nN, gid = wgid / nig, fm = gid * WGM, gsz = min(nM - fm, WGM);
  pm = fm + ((wgid % nig) % gsz);
  pn = (wgid % nig) / gsz;
}

__device__ __forceinline__ void p0_misc(const Ctx& p) {
  const int gtid = blockIdx.x * NT + tid_l(), gn = gridDim.x * NT;
  float4* h4 = (float4*)(p.ws + WS_H);
  const float4* x4 = (const float4*)pin(p, 0);
  const float4* c4 = (const float4*)pin(p, 2);
#pragma unroll 8
  for (int i = gtid; i < MROWS * 256; i += gn) {
    int m = i >> 8, q = i & 255, b = m / SP, pos = m - b * SP;
    float4 v = (pos < CTX) ? c4[(size_t)(b * CTX + pos) * 256 + q] : x4[(size_t)(b * SEQ + pos - CTX) * 256 + q];
    h4[i] = v;
  }
  float2* rope = (float2*)(p.ws + WS_ROPE);
  for (int i = gtid; i < 1024; i += gn) {
    int idx = i >> 3, f = i & 7;
    float inv = powf(10000.f, -(float)f / 8.f);
    float a = (float)idx * inv;
    rope[i] = make_float2(cosf(a), sinf(a));
  }
  {
    u16* w3t = (u16*)(p.ws + WS_W3T);
    const float* w3 = pin(p, 20);
    for (int i = gtid; i < 4 * 1024 * 64; i += gn) { int l = i >> 16, c2 = (i >> 6) & 1023, k = i & 63; w3t[i] = f2bf(w3[((size_t)l * 64 + k) * 1024 + c2]); }
  }
  float2* tw = (float2*)(p.ws + WS_TW);
  for (int i = gtid; i < 16384; i += gn) {
    float s, c;
    sincospif(-(float)i / 8192.f, &s, &c);
    tw[i] = make_float2(c, s);
  }
}

__device__ __forceinline__ void p0_mod_task(const Ctx& p, int task, char* smem) {
  float* s = (float*)smem;
  float* red = s + 3072;
  const int tid = tid_l();
  const int l = task / 48, chunk = task - l * 48;
  for (int i = tid; i < 3072; i += NT) {
    int g = i >> 10, k = i & 1023;
    float cv = (g < 2) ? pin(p, 1)[g * 1024 + k] : pin(p, 3)[k];
    s[i] = cv / (1.f + __expf(-cv));
  }
  __syncthreads();
  const int kq = tid >> 7, col = tid & 127, n = chunk * 128 + col;
  const float* W = pin(p, 4) + (size_t)l * 1024 * 6144 + n;
  float a0 = 0.f, a1 = 0.f, a2 = 0.f;
#pragma unroll 32
  for (int k = kq * 256; k < kq * 256 + 256; ++k) {
    float w = W[(size_t)k * 6144];
    a0 += s[k] * w; a1 += s[1024 + k] * w; a2 += s[2048 + k] * w;
  }
  red[(kq * 3 + 0) * 128 + col] = a0;
  red[(kq * 3 + 1) * 128 + col] = a1;
  red[(kq * 3 + 2) * 128 + col] = a2;
  __syncthreads();
  if (tid < 384) {
    int g = tid >> 7, c2 = tid & 127, n2 = chunk * 128 + c2;
    float v = red[(0 * 3 + g) * 128 + c2] + red[(1 * 3 + g) * 128 + c2] + red[(2 * 3 + g) * 128 + c2] + red[(3 * 3 + g) * 128 + c2];
    ((float*)(p.ws + WS_MOD))[(size_t)(l * 3 + g) * 6144 + n2] = v + pin(p, 5)[l * 6144 + n2];
  }
  __syncthreads();
}

__device__ __forceinline__ void p0_hid_task(const Ctx& p, int task, char* smem) {
  float* zs = (float*)smem;
  float* h1 = zs + 8 * 36;
  float* w1s = h1 + 8 * 64;
  float* w2s = w1s + 33 * 64;
  const int tid = tid_l(), tl = tid >> 6, j = tid & 63;
  const int l = task / 132, r = task - l * 132;
  const bool isctx = r >= 128;
  const int L = isctx ? 256 : 8192;
  const int tbase = (isctx ? (r - 128) : r) * 64;
  for (int i = tid; i < 33 * 64; i += NT) w1s[i] = pin(p, 14)[l * 33 * 64 + i];
  for (int i = tid; i < 64 * 64; i += NT) w2s[i] = pin(p, 17)[l * 64 * 64 + i];
  const float b1 = pin(p, 15)[l * 64 + j], f1 = pin(p, 16)[l * 64 + j], b2 = pin(p, 18)[l * 64 + j], f2 = pin(p, 19)[l * 64 + j];
  __syncthreads();
  for (int sub = 0; sub < 8; ++sub) {
    const int t = tbase + sub * 8 + tl;
    if (j < 33) {
      float z;
      if (j == 0) z = (float)t / (float)(L - 1);
      else {
        int i = (j - 1) & 15;
        float band = 1e-4f + (float)i * ((15.f - 1e-4f) / 15.f);
        float omega = 6.2831855f * (float)t / (float)L;
        float a = omega * band;
        z = (j <= 16) ? cosf(a) : -sinf(a);
      }
      zs[tl * 36 + j] = z;
    }
    __syncthreads();
    {
      float a = b1;
#pragma unroll
      for (int k = 0; k < 33; ++k) a += zs[tl * 36 + k] * w1s[k * 64 + j];
      h1[tl * 64 + j] = sinf(f1 * a);
    }
    __syncthreads();
    {
      float a = b2;
#pragma unroll 16
      for (int k = 0; k < 64; ++k) a += h1[tl * 64 + k] * w2s[k * 64 + j];
      float v = sinf(f2 * a);
      if (isctx) ((float*)(p.ws + WS_HID2C))[((size_t)l * 64 + j) * 256 + t] = v;
      else ((u16*)(p.ws + WS_HID2))[((size_t)l * 8192 + t) * 64 + j] = f2bf(v);
    }
  }
  __syncthreads();
}

struct WtItem { const float* W; u16* WT; int K, N, k0, n0; };
__device__ __forceinline__ WtItem wt_decode(const Ctx& p, int l, int r) {
  char* wo = (char*)p.out;
  WtItem it;
  int nblk;
  if (r < 1472) { it.W = pin(p, 8) + (size_t)l * 1024 * DIN; it.K = 1024; it.N = DIN; it.WT = (u16*)(wo + WO_IN); nblk = 92; }
  else if ((r -= 1472) < 1024) { it.W = pin(p, 30) + (size_t)l * 1024 * 4096; it.K = 1024; it.N = 4096; it.WT = (u16*)(wo + WO_FF1); nblk = 64; }
  else if ((r -= 1024) < 1024) { it.W = pin(p, 31) + (size_t)l * 4096 * 1024; it.K = 4096; it.N = 1024; it.WT = (u16*)(wo + WO_FF2); nblk = 16; }
  else if ((r -= 1024) < 256) { it.W = pin(p, 29) + (size_t)l * 1024 * 1024; it.K = 1024; it.N = 1024; it.WT = (u16*)(wo + WO_OUT); nblk = 16; }
  else if ((r -= 256) < 128) { it.W = pin(p, 23) + (size_t)l * 512 * 1024; it.K = 512; it.N = 1024; it.WT = (u16*)(wo + WO_HY); nblk = 16; }
  else if ((r -= 128) < 128) { it.W = pin(p, 28) + (size_t)l * 512 * 1024; it.K = 512; it.N = 1024; it.WT = (u16*)(wo + WO_WO); nblk = 16; }
  else if ((r -= 128) < 72) { it.W = pin(p, 25) + (size_t)l * 384 * 768; it.K = 384; it.N = 768; it.WT = (u16*)(wo + WO_UQ); nblk = 12; }
  else { r -= 72; it.W = pin(p, 27) + (size_t)l * 256 * 1024; it.K = 256; it.N = 1024; it.WT = (u16*)(wo + WO_UKV); nblk = 16; }
  const int kb = r / nblk, nb2 = r - kb * nblk;
  it.k0 = kb * 64; it.n0 = nb2 * 64;
  return it;
}
__device__ __forceinline__ void wt_load(const WtItem& it, int tid, float (&v)[8]) {
  const int nn = tid & 63, kq = tid >> 6;
  const bool ok = it.n0 + nn < it.N;
  const float* src = it.W + (size_t)(it.k0 + kq) * it.N + it.n0 + (ok ? nn : 0);
#pragma unroll
  for (int r = 0; r < 8; ++r) { float x = src[(size_t)(r * 8) * it.N]; v[r] = ok ? x : 0.f; }
}
__device__ __forceinline__ void wt_phase(const Ctx& p, int l, char* smem) {
  float* tile = (float*)smem;
  const int tid = tid_l();
  const int bid = blockIdx.x, nb = gridDim.x;
  int t = bid;
  if (t >= 4168) return;
  WtItem cur = wt_decode(p, l, t);
  float v[8];
  wt_load(cur, tid, v);
#pragma unroll 1
  while (true) {
    const int tn = t + nb;
    const bool more = tn < 4168;
    WtItem nxt = cur;
    float vn[8];
    if (more) { nxt = wt_decode(p, l, tn); wt_load(nxt, tid, vn); }
#pragma unroll
    for (int r = 0; r < 8; ++r) tile[(r * 8 + (tid >> 6)) * 65 + (tid & 63)] = v[r];
    __syncthreads();
    {
      int n = tid >> 3, kc = (tid & 7) * 8;
      uint4 o;
      o.x = pk2(tile[(kc + 0) * 65 + n], tile[(kc + 1) * 65 + n]);
      o.y = pk2(tile[(kc + 2) * 65 + n], tile[(kc + 3) * 65 + n]);
      o.z = pk2(tile[(kc + 4) * 65 + n], tile[(kc + 5) * 65 + n]);
      o.w = pk2(tile[(kc + 6) * 65 + n], tile[(kc + 7) * 65 + n]);
      *(uint4*)(cur.WT + (size_t)(cur.n0 + n) * cur.K + cur.k0 + kc) = o;
    }
    __syncthreads();
    if (!more) break;
    cur = nxt;
#pragma unroll
    for (int r = 0; r < 8; ++r) v[r] = vn[r];
    t = tn;
  }
}

__device__ __forceinline__ void wpe_task(const Ctx& p, int l, int task, char* smem) {
  const int g = task >> 3, c0 = (task & 7) * 16, tid = tid_l();
  const float* pw = pin(p, 9) + ((size_t)(l * 4 + g) * 128) * 128;
  const float* sc = pin(p, 10) + l * 512 + g * 128;
  const float* po = pin(p, 11) + ((size_t)l * 512 + g * 128) * 1024;
  u16* WpeT = (u16*)(p.ws + WS_WPE) + (size_t)l * 1024 * 512;
  float* wl = (float*)smem;
  for (int i = tid; i < 16 * 128; i += NT) { int d = i & 127; wl[i] = pw[(c0 + (i >> 7)) * 128 + d] * sc[d]; }
  __syncthreads();
  float acc0[16], acc1[16];
#pragma unroll
  for (int i = 0; i < 16; ++i) { acc0[i] = 0.f; acc1[i] = 0.f; }
#pragma unroll 16
  for (int d = 0; d < 128; ++d) {
    float p0 = po[(size_t)d * 1024 + tid], p1 = po[(size_t)d * 1024 + 512 + tid];
#pragma unroll
    for (int i = 0; i < 16; ++i) { float w = wl[i * 128 + d]; acc0[i] += w * p0; acc1[i] += w * p1; }
  }
  uint4 o0, o1;
  o0.x = pk2(acc0[0], acc0[1]); o0.y = pk2(acc0[2], acc0[3]); o0.z = pk2(acc0[4], acc0[5]); o0.w = pk2(acc0[6], acc0[7]);
  o1.x = pk2(acc0[8], acc0[9]); o1.y = pk2(acc0[10], acc0[11]); o1.z = pk2(acc0[12], acc0[13]); o1.w = pk2(acc0[14], acc0[15]);
  uint4* dst = (uint4*)(WpeT + (size_t)tid * 512 + g * 128 + c0);
  dst[0] = o0; dst[1] = o1;
  o0.x = pk2(acc1[0], acc1[1]); o0.y = pk2(acc1[2], acc1[3]); o0.z = pk2(acc1[4], acc1[5]); o0.w = pk2(acc1[6], acc1[7]);
  o1.x = pk2(acc1[8], acc1[9]); o1.y = pk2(acc1[10], acc1[11]); o1.z = pk2(acc1[12], acc1[13]); o1.w = pk2(acc1[14], acc1[15]);
  dst = (uint4*)(WpeT + (size_t)(512 + tid) * 512 + g * 128 + c0);
  dst[0] = o0; dst[1] = o1;
  __syncthreads();
}

__device__ __forceinline__ void norm_rows(const Ctx& p, const float* gain, const float* modl, int sh_idx, int sc_idx, u16* outp) {
  const int tidx = tid_l(), lane = tidx & 63, gw = blockIdx.x * 8 + (tidx >> 6), ngw = gridDim.x * 8;
  const float* h = (const float*)(p.ws + WS_H);
  float4 g[4];
#pragma unroll
  for (int j = 0; j < 4; ++j) g[j] = *(const float4*)(gain + lane * 4 + 256 * j);
  for (int m0 = gw; m0 < MROWS; m0 += 2 * ngw) {
    const int m1 = m0 + ngw;
    const bool has1 = m1 < MROWS;
    const int m1c = has1 ? m1 : m0;
    const float4* hr0 = (const float4*)(h + (size_t)m0 * D) + lane;
    const float4* hr1 = (const float4*)(h + (size_t)m1c * D) + lane;
    float4 v0[4], v1[4];
#pragma unroll
    for (int j = 0; j < 4; ++j) { v0[j] = hr0[64 * j]; v1[j] = hr1[64 * j]; }
    const float* mg0 = modl + grp_of_row(m0) * 6144;
    const float* mg1 = modl + grp_of_row(m1c) * 6144;
    float s0 = 0.f, s1 = 0.f;
#pragma unroll
    for (int j = 0; j < 4; ++j) {
      s0 += v0[j].x * v0[j].x + v0[j].y * v0[j].y + v0[j].z * v0[j].z + v0[j].w * v0[j].w;
      s1 += v1[j].x * v1[j].x + v1[j].y * v1[j].y + v1[j].z * v1[j].z + v1[j].w * v1[j].w;
    }
    s0 = wave_sum(s0);
    s1 = wave_sum(s1);
    const float r0 = rsqrtf(s0 * (1.f / D) + EPS), r1 = rsqrtf(s1 * (1.f / D) + EPS);
    uint2* o0 = (uint2*)(outp + (size_t)m0 * D) + lane;
    uint2* o1 = (uint2*)(outp + (size_t)m1c * D) + lane;
#pragma unroll
    for (int j = 0; j < 4; ++j) {
      int n = lane * 4 + 256 * j;
      float4 sc = *(const float4*)(mg0 + sc_idx * 1024 + n), sh = *(const float4*)(mg0 + sh_idx * 1024 + n);
      uint2 o;
      o.x = pk2(v0[j].x * r0 * g[j].x * (1.f + sc.x) + sh.x, v0[j].y * r0 * g[j].y * (1.f + sc.y) + sh.y);
      o.y = pk2(v0[j].z * r0 * g[j].z * (1.f + sc.z) + sh.z, v0[j].w * r0 * g[j].w * (1.f + sc.w) + sh.w);
      o0[64 * j] = o;
    }
    if (has1) {
#pragma unroll
      for (int j = 0; j < 4; ++j) {
        int n = lane * 4 + 256 * j;
        float4 sc = *(const float4*)(mg1 + sc_idx * 1024 + n), sh = *(const float4*)(mg1 + sh_idx * 1024 + n);
        uint2 o;
        o.x = pk2(v1[j].x * r1 * g[j].x * (1.f + sc.x) + sh.x, v1[j].y * r1 * g[j].y * (1.f + sc.y) + sh.y);
        o.y = pk2(v1[j].z * r1 * g[j].z * (1.f + sc.z) + sh.z, v1[j].w * r1 * g[j].w * (1.f + sc.w) + sh.w);
        o1[64 * j] = o;
      }
    }
  }
}

__device__ __forceinline__ void final_norm(const Ctx& p) {
  const int tidx = tid_l(), lane = tidx & 63, gw = blockIdx.x * 8 + (tidx >> 6), ngw = gridDim.x * 8;
  const float* h = (const float*)(p.ws + WS_H);
  const float* gain = pin(p, 32);
  for (int r0 = gw; r0 < 2 * SEQ; r0 += ngw) {
    int b = r0 >> 13, t = r0 & 8191, m = b * SP + CTX + t;
    const float4* hr = (const float4*)(h + (size_t)m * D) + lane;
    float4 v[4];
    float ss = 0.f;
#pragma unroll
    for (int j = 0; j < 4; ++j) { v[j] = hr[64 * j]; ss += v[j].x * v[j].x + v[j].y * v[j].y + v[j].z * v[j].z + v[j].w * v[j].w; }
    ss = wave_sum(ss);
    float r = rsqrtf(ss * (1.f / D) + EPS);
    float4* o = (float4*)(p.out + (size_t)r0 * D) + lane;
#pragma unroll
    for (int j = 0; j < 4; ++j) {
      float4 g = *(const float4*)(gain + lane * 4 + 256 * j);
      o[64 * j] = make_float4(v[j].x * r * g.x, v[j].y * r * g.y, v[j].z * r * g.z, v[j].w * r * g.w);
    }
  }
}

__device__ __forceinline__ void premix_task(const Ctx& p, int l, int task, char* smem) {
  const int tid = tid_l(), lane = tid & 63, wid = tid >> 6;
  const int part = task / 264, tile64 = task - part * 264;
  const int m0 = tile64 * 64, b = m0 / SP, pos0 = m0 - b * SP;
  const bool isctx = pos0 < CTX;
  const int s0 = isctx ? 0 : CTX, L = isctx ? CTX : SEQ, t0 = pos0 - s0;
  const size_t mb = (size_t)b * SP + s0;
  const u16* proj = (const u16*)(p.ws + WS_PROJ);
  if (part == 0) {
    u16* P = (u16*)smem;
#pragma unroll
    for (int i = tid; i < 80 * 64; i += NT) {
      int r = i >> 6, ch = i & 63, t = t0 - 8 + r;
      uint4 v = make_uint4(0, 0, 0, 0);
      if (t >= 0 && t < L) v = *(const uint4*)(proj + (mb + t) * DINP + ch * 8);
      *(uint4*)(P + r * 512 + ch * 8) = v;
    }
    __syncthreads();
    const int c = tid, g = c >> 7, hw = 1 << g;
    u16* U = (u16*)(p.ws + WS_U);
    float s = 0.f;
    for (int q = -hw; q < hw; ++q) s += bf2f(P[(8 + q) * 512 + c]);
#pragma unroll 4
    for (int tt = 0; tt < 64; ++tt) {
      int t = t0 + tt, lo = max(t - hw, 0), hi = min(t + hw, L);
      float u = s * __builtin_amdgcn_rcpf((float)(hi - lo)) - bf2f(P[(tt + 8) * 512 + c]);
      U[(mb + t) * 512 + c] = f2bf(u);
      s += bf2f(P[(tt + 8 + hw) * 512 + c]) - bf2f(P[(tt + 8 - hw) * 512 + c]);
    }
    __syncthreads();
  } else if (part <= 4) {
    const int ch0 = (part - 1) * 128;
    constexpr int PITCH = 136;
    u16* X = (u16*)smem;
    float* T = (float*)(smem + 3 * 66 * PITCH * 2 + 64);
#pragma unroll
    for (int ii = 0; ii < 7; ++ii) {
      const int i = tid + ii * NT;
      if (i >= 3 * 66 * 16) break;
      int pr = i / (66 * 16), rem = i - pr * 66 * 16, r = rem >> 4, ch = rem & 15, t = t0 - 1 + r;
      uint4 v = make_uint4(0, 0, 0, 0);
      if (t >= 0 && t < L) v = *(const uint4*)(proj + (mb + t) * DINP + OFF_HY + pr * 512 + ch0 + ch * 8);
      *(uint4*)(X + (pr * 66 + r) * PITCH + ch * 8) = v;
    }
    __syncthreads();
    const float* cw = pin(p, 12) + l * 3 * 1536;
    const float* cb = pin(p, 13) + l * 1536;
    {
      const int c = tid & 127, tq = tid >> 7, col = ch0 + c;
      const float w00 = cw[col], w01 = cw[1536 + col], w02 = cw[3072 + col], b0 = cb[col];
      const float w10 = cw[512 + col], w11 = cw[1536 + 512 + col], w12 = cw[3072 + 512 + col], b1 = cb[512 + col];
      const float w20 = cw[1024 + col], w21 = cw[1536 + 1024 + col], w22 = cw[3072 + 1024 + col], b2 = cb[1024 + col];
      const u16* X0 = X, *X1 = X + 66 * PITCH, *XV = X + 2 * 66 * PITCH;
      u16* Y = (u16*)(p.ws + WS_Y);
#pragma unroll 4
      for (int tt = tq * 16; tt < tq * 16 + 16; ++tt) {
        float x0 = w00 * bf2f(X0[tt * PITCH + c]) + w01 * bf2f(X0[(tt + 1) * PITCH + c]) + w02 * bf2f(X0[(tt + 2) * PITCH + c]) + b0;
        float x1 = w10 * bf2f(X1[tt * PITCH + c]) + w11 * bf2f(X1[(tt + 1) * PITCH + c]) + w12 * bf2f(X1[(tt + 2) * PITCH + c]) + b1;
        float vv = w20 * bf2f(XV[tt * PITCH + c]) + w21 * bf2f(XV[(tt + 1) * PITCH + c]) + w22 * bf2f(XV[(tt + 2) * PITCH + c]) + b2;
        Y[(mb + t0 + tt) * 512 + col] = f2bf(x0);
        T[c * 65 + tt] = x1 * vv;
      }
    }
    __syncthreads();
    {
      float* ZV = (float*)(p.ws + WS_ZV);
#pragma unroll 4
      for (int cc = 0; cc < 16; ++cc) {
        int c = wid * 16 + cc;
        ZV[((size_t)(ch0 + c) * SP + pos0 + lane) * 2 + b] = T[c * 65 + lane];
      }
    }
    __syncthreads();
  } else {
    u16* projw = (u16*)(p.ws + WS_PROJ);
    const float* qg = pin(p, 24) + l * 384;
    const float* kg = pin(p, 26) + l * 256;
    const float2* rope = (const float2*)(p.ws + WS_ROPE);
    u16* Kb = (u16*)(p.ws + WS_K);
#pragma unroll 2
    for (int rr = 0; rr < 8; ++rr) {
      int tt = wid * 8 + rr, pos = pos0 + tt;
      u16* row = projw + ((size_t)b * SP + pos) * DINP;
      unsigned* q32 = (unsigned*)(row + OFF_Q);
      unsigned* k32 = (unsigned*)(row + OFF_KV);
      unsigned v[3], w[2];
      float ss = 0.f, s2 = 0.f;
#pragma unroll
      for (int j = 0; j < 3; ++j) v[j] = q32[lane + 64 * j];
#pragma unroll
      for (int j = 0; j < 2; ++j) w[j] = k32[lane + 64 * j];
      const int rd = lane & 31;
      float val = bf2f(row[OFF_KV + 256 + rd]);
#pragma unroll
      for (int j = 0; j < 3; ++j) { float a = bf2f(v[j] & 0xffff), c2 = bf2f(v[j] >> 16); ss += a * a + c2 * c2; }
#pragma unroll
      for (int j = 0; j < 2; ++j) { float a = bf2f(w[j] & 0xffff), c2 = bf2f(w[j] >> 16); s2 += a * a + c2 * c2; }
      ss = wave_sum(ss);
      s2 = wave_sum(s2);
      float r = rsqrtf(ss * (1.f / 384.f) + EPS), r2 = rsqrtf(s2 * (1.f / 256.f) + EPS);
#pragma unroll
      for (int j = 0; j < 3; ++j) {
        int n = (lane + 64 * j) * 2;
        q32[lane + 64 * j] = pk2(bf2f(v[j] & 0xffff) * r * qg[n], bf2f(v[j] >> 16) * r * qg[n + 1]);
      }
#pragma unroll
      for (int j = 0; j < 2; ++j) {
        int n = (lane + 64 * j) * 2;
        k32[lane + 64 * j] = pk2(bf2f(w[j] & 0xffff) * r2 * kg[n], bf2f(w[j] >> 16) * r2 * kg[n + 1]);
      }
      float partner = shx(val, 8);
      if (!isctx) {
        int t = pos - CTX, idx = (rd < 16) ? (t >> 6) : (t & 63);
        float2 cs = rope[idx * 8 + (rd & 7)];
        float sgn = (rd & 8) ? 1.f : -1.f;
        val = val * cs.x + sgn * partner * cs.y;
      }
      if (lane < 32) {
        u16 o = f2bf(val);
#pragma unroll
        for (int hd = 0; hd < 8; ++hd) Kb[((size_t)(b * 8 + hd) * SP + pos) * 96 + 64 + rd] = o;
      }
    }
  }
}

__device__ __forceinline__ int xi(int i) { const int h = i >> 5; return i ^ (((h & 3) * 5) | ((h & 2) << 3)); }
typedef float v2f __attribute__((ext_vector_type(2)));
__device__ __forceinline__ v2f cmulv(v2f a, v2f b) {
  v2f bs = {-b.y, b.x};
  return a.xx * b + a.yy * bs;
}
__device__ __forceinline__ void bf_fwd(float2* Xf, int base, int q, float2 w1f) {
  v2f* X = (v2f*)Xf;
  const v2f w1 = {w1f.x, w1f.y};
  const v2f w2 = cmulv(w1, w1), w3 = cmulv(w2, w1);
  const int i0 = xi(base), i1 = xi(base + q), i2 = xi(base + 2 * q), i3 = xi(base + 3 * q);
  v2f a0 = X[i0], a1 = X[i1], a2 = X[i2], a3 = X[i3];
  v2f s02 = a0 + a2, d02 = a0 - a2, s13 = a1 + a3, d13 = a1 - a3;
  v2f d13r = {d13.y, -d13.x};
  X[i0] = s02 + s13;
  X[i1] = cmulv(d02 + d13r, w1);
  X[i2] = cmulv(s02 - s13, w2);
  X[i3] = cmulv(d02 - d13r, w3);
}
__device__ __forceinline__ void bf_inv(float2* Xf, int base, int q, float2 w1f) {
  v2f* X = (v2f*)Xf;
  const v2f w1 = {w1f.x, -w1f.y};
  const v2f w2 = cmulv(w1, w1), w3 = cmulv(w2, w1);
  const int i0 = xi(base), i1 = xi(base + q), i2 = xi(base + 2 * q), i3 = xi(base + 3 * q);
  v2f b0 = X[i0], c1 = cmulv(X[i1], w1), c2 = cmulv(X[i2], w2), c3 = cmulv(X[i3], w3);
  v2f s02 = b0 + c2, d02 = b0 - c2, s13 = c1 + c3, d13 = c1 - c3;
  v2f d13r = {-d13.y, d13.x};
  X[i0] = s02 + s13;
  X[i1] = d02 + d13r;
  X[i2] = s02 - s13;
  X[i3] = d02 - d13r;
}
template <bool INV, int LQ>
__device__ __forceinline__ void fft_pass(float2* X, const float2* __restrict__ tw, const float2 (&twr)[6], int tid) {
  constexpr int q = 1 << LQ;
  if (LQ == 12) {
    float2 w[8];
#pragma unroll
    for (int b8 = 0; b8 < 8; ++b8) w[b8] = tw[b8 * NT + tid];
#pragma unroll
    for (int b8 = 0; b8 < 8; ++b8) { int u = b8 * NT + tid; if (INV) bf_inv(X, u, q, w[b8]); else bf_fwd(X, u, q, w[b8]); }
  } else if (LQ == 10) {
#pragma unroll 2
    for (int b8 = 0; b8 < 8; ++b8) {
      int u = b8 * NT + tid, j = u & 1023, base = ((u >> 10) << 12) + j;
      float2 w = (b8 & 1) ? twr[1] : twr[0];
      if (INV) bf_inv(X, base, q, w); else bf_fwd(X, base, q, w);
    }
  } else {
    const int j = tid & (q - 1);
    const float2 w = (LQ == 0) ? make_float2(1.f, 0.f) : twr[2 + (8 - LQ) / 2];
#pragma unroll 2
    for (int b8 = 0; b8 < 8; ++b8) {
      int u = b8 * NT + tid, base = ((u >> LQ) << (LQ + 2)) + j;
      if (INV) bf_inv(X, base, q, w); else bf_fwd(X, base, q, w);
    }
  }
  __syncthreads();
}
__device__ __forceinline__ void fft_load_tw(const float2* __restrict__ tw, int tid, float2 (&twr)[6]) {
  twr[0] = tw[tid << 2];
  twr[1] = tw[(512 + tid) << 2];
  twr[2] = tw[(tid & 255) << 4];
  twr[3] = tw[(tid & 63) << 6];
  twr[4] = tw[(tid & 15) << 8];
  twr[5] = tw[(tid & 3) << 10];
}
__device__ __forceinline__ void fft_dif(float2* X, const float2* __restrict__ tw, const float2 (&twr)[6]) {
  const int tid = tid_l();
  fft_pass<false, 12>(X, tw, twr, tid); fft_pass<false, 10>(X, tw, twr, tid); fft_pass<false, 8>(X, tw, twr, tid); fft_pass<false, 6>(X, tw, twr, tid);
  fft_pass<false, 4>(X, tw, twr, tid); fft_pass<false, 2>(X, tw, twr, tid); fft_pass<false, 0>(X, tw, twr, tid);
}
__device__ __forceinline__ void fft_dit_inv(float2* X, const float2* __restrict__ tw, const float2 (&twr)[6]) {
  const int tid = tid_l();
  fft_pass<true, 0>(X, tw, twr, tid); fft_pass<true, 2>(X, tw, twr, tid); fft_pass<true, 4>(X, tw, twr, tid); fft_pass<true, 6>(X, tw, twr, tid);
  fft_pass<true, 8>(X, tw, twr, tid); fft_pass<true, 10>(X, tw, twr, tid); fft_pass<true, 12>(X, tw, twr, tid);
}
__device__ __forceinline__ float block_sum(float v, float* red) {
  v = wave_sum(v);
  __syncthreads();
  { const int tb = tid_l(); if ((tb & 63) == 0) red[tb >> 6] = v; }
  __syncthreads();
  float s = red[0] + red[1] + red[2] + red[3] + red[4] + red[5] + red[6] + red[7];
  __syncthreads();
  return s;
}

__device__ __forceinline__ void fft_task(const Ctx& p, int l, int c, char* smem) {
  float2* X = (float2*)smem;
  float zl = 0.f;
  asm volatile("" : "+v"(zl));
  float* aux = (float*)(smem + AUX_OFF);
  float* red = aux + 128;
  const int tid = tid_l();
  const float2* tw = (const float2*)(p.ws + WS_TW);
  float2 twr[6];
  fft_load_tw(tw, tid, twr);
  const float* w3 = pin(p, 20) + (size_t)l * 64 * 1024;
  if (tid < 64) { aux[tid] = w3[tid * 1024 + c]; aux[64 + tid] = w3[tid * 1024 + 512 + c]; }
  __syncthreads();
  const float dF = fabsf(pin(p, 21)[(l * 2 + 0) * 512 + c]), dB = fabsf(pin(p, 21)[(l * 2 + 1) * 512 + c]);
  const float bias = pin(p, 22)[l * 512 + c];
  float2* zp = (float2*)(p.ws + WS_ZV) + (size_t)c * SP;
  float l1 = 0.f;
  {
    const u16* ff = (const u16*)((const char*)p.out + WO_FILT) + (size_t)c * 8192 + tid;
    const u16* fb = ff + (size_t)512 * 8192;
    u16 rf[16], rb[16];
#pragma unroll
    for (int i = 0; i < 16; ++i) { rf[i] = ff[i * NT]; rb[i] = fb[i * NT]; }
#pragma unroll
    for (int i = 0; i < 16; ++i) {
      int t = i * NT + tid;
      float tl = (float)t * (1.f / 8191.f);
      float hf = bf2f(rf[i]) * __expf(-tl * dF);
      float hb = bf2f(rb[i]) * __expf(-tl * dB);
      X[xi(t)] = make_float2(hf, 0.f);
      if (t >= 1) { X[xi(16384 - t)] = make_float2(hb, 0.f); l1 += fabsf(hf) + fabsf(hb); }
      else { X[xi(8192)] = make_float2(zl, zl); l1 += fabsf(hf); }
    }
  }
  float l1tot = block_sum(l1, red);
  fft_dif(X, tw, twr);
  float2 F[32];
  {
    float s = 1.f / (l1tot * 16384.f);
#pragma unroll
    for (int i = 0; i < 32; ++i) { float2 v = X[xi(i * NT + tid)]; F[i] = make_float2(v.x * s, v.y * s); }
  }
  __syncthreads();
#pragma unroll 8
  for (int i = 0; i < 16; ++i) {
    int t = i * NT + tid;
    X[xi(t)] = zp[CTX + t];
    X[xi(8192 + t)] = make_float2(zl, zl);
  }
  __syncthreads();
  fft_dif(X, tw, twr);
#pragma unroll
  for (int i = 0; i < 32; ++i) { int idx = xi(i * NT + tid); X[idx] = cmul(X[idx], F[i]); }
  __syncthreads();
  fft_dit_inv(X, tw, twr);
  {
    float2 zz[16];
#pragma unroll
    for (int i = 0; i < 16; ++i) zz[i] = zp[CTX + i * NT + tid];
#pragma unroll
    for (int i = 0; i < 16; ++i) {
      int t = i * NT + tid;
      float2 y = X[xi(t)];
      zp[CTX + t] = make_float2(y.x + bias * zz[i].x, y.y + bias * zz[i].y);
    }
  }
  __syncthreads();
  {
    float* hFc = (float*)smem;
    float* hBc = hFc + 256;
    float2* zc = (float2*)(hBc + 256);
    float l1c = 0.f;
    if (tid < 256) {
      int t = tid;
      const float* hc = (const float*)(p.ws + WS_HID2C) + (size_t)l * 64 * 256 + t;
      float hf = 0.f, hb = 0.f;
#pragma unroll 16
      for (int k = 0; k < 64; ++k) { float v = hc[k * 256]; hf += v * aux[k]; hb += v * aux[64 + k]; }
      float tl = (float)t * (1.f / 255.f);
      hf *= expf(-tl * dF);
      hb *= expf(-tl * dB);
      hFc[t] = hf;
      hBc[t] = hb;
      l1c = fabsf(hf) + (t >= 1 ? fabsf(hb) : 0.f);
      zc[t] = zp[t];
    }
    float l1ct = block_sum(l1c, red);
    const int bb = tid >> 8, t = tid & 255;
    float acc = 0.f;
    for (int s = 0; s < 256; ++s) {
      float kf = (s <= t) ? hFc[t - s] : hBc[s - t];
      float2 z = zc[s];
      acc += kf * (bb ? z.y : z.x);
    }
    float2 z = zc[t];
    ((float*)zp)[t * 2 + bb] = acc / l1ct + bias * (bb ? z.y : z.x);
    __syncthreads();
  }
}

constexpr int AT_KT = 128, AT_KP = 208, AT_VP = 264, AT_STAGE = AT_KT * AT_KP + 64 * AT_VP;
__device__ __forceinline__ void attn_task(const Ctx& p, int bh, int qb, char* smem) {
  const int tid = tid_l(), wid = tid >> 6, lane = tid & 63, r = lane & 31, hh = lane >> 5;
  const u16* Qp = (const u16*)(p.ws + WS_Q) + ((size_t)bh * SP + qb * 256) * 96;
  const u16* Kp = (const u16*)(p.ws + WS_K) + (size_t)bh * SP * 96;
  const u16* Vp = (const u16*)(p.ws + WS_VT) + (size_t)bh * 64 * SP;
  const int nkt = (qb == 0) ? 2 : 66;
  bf16x8 qf[6];
#pragma unroll
  for (int ks = 0; ks < 6; ++ks) qf[ks] = *(const bf16x8*)(Qp + (size_t)(wid * 32 + r) * 96 + ks * 16 + hh * 8);
  f32x16 o0, o1;
#pragma unroll
  for (int i = 0; i < 16; ++i) { o0[i] = 0.f; o1[i] = 0.f; }
  float mrun = 0.f, lrun = 0.f;
  const u16* src[5];
  int dst[5];
#pragma unroll
  for (int i = 0; i < 5; ++i) {
    int ch = tid + i * NT;
    if (i < 3) { int row = ch / 12, cc = ch - row * 12; src[i] = Kp + (size_t)row * 96 + cc * 8; dst[i] = row * AT_KP + cc * 16; }
    else { int v = ch - 1536, row = v >> 4, cc = v & 15; src[i] = Vp + (size_t)row * SP + cc * 8; dst[i] = AT_KT * AT_KP + row * AT_VP + cc * 16; }
  }
  uint4 st[5];
#define AT_LOAD(t)                                                                                   \
  do {                                                                                               \
    _Pragma("unroll") for (int i = 0; i < 5; ++i) st[i] = *(const uint4*)(src[i] + (size_t)(t) * (i < 3 ? AT_KT * 96 : AT_KT)); \
  } while (0)
#define AT_WRITE(buf)                                                                                \
  do {                                                                                               \
    char* base_ = smem + (buf) * AT_STAGE;                                                           \
    _Pragma("unroll") for (int i = 0; i < 5; ++i) {                                                  \
      uint2* d_ = (uint2*)(base_ + dst[i]);                                                          \
      d_[0] = make_uint2(st[i].x, st[i].y);                                                          \
      d_[1] = make_uint2(st[i].z, st[i].w);                                                          \
    }                                                                                                \
  } while (0)
#define AT_QK(S, kb)                                                                                 \
  __builtin_amdgcn_s_setprio(1);                                                                     \
  _Pragma("unroll") for (int ks = 0; ks < 6; ++ks) {                                                 \
    bf16x8 a_ = *(const bf16x8*)(Ks + ((kb) * 32 + r) * AT_KP + ks * 32 + hh * 16);                  \
    S = __builtin_amdgcn_mfma_f32_32x32x16_bf16(a_, qf[ks], S, 0, 0, 0);                             \
  }                                                                                                  \
  __builtin_amdgcn_s_setprio(0);
#define AT_SOFT_PV(S, kb)                                                                            \
  _Pragma("unroll") for (int i = 0; i < 16; ++i) { S[i] = __builtin_amdgcn_exp2f(S[i]); ps += S[i]; } \
  _Pragma("unroll") for (int sI = 0; sI < 2; ++sI) {                                                 \
    union { bf16x8 v; unsigned u[4]; } pu;                                                           \
    _Pragma("unroll") for (int j = 0; j < 4; ++j) pu.u[j] = pk2(S[8 * sI + 2 * j], S[8 * sI + 2 * j + 1]); \
    const int koff = ((kb) * 32 + 16 * sI + 4 * hh) * 2;                                             \
    union { bf16x8 v; uint2 h2[2]; } va, vb;                                                         \
    va.h2[0] = *(const uint2*)(Vs + r * AT_VP + koff);                                               \
    va.h2[1] = *(const uint2*)(Vs + r * AT_VP + koff + 16);                                          \
    vb.h2[0] = *(const uint2*)(Vs + (32 + r) * AT_VP + koff);                                        \
    vb.h2[1] = *(const uint2*)(Vs + (32 + r) * AT_VP + koff + 16);                                   \
    o0 = __builtin_amdgcn_mfma_f32_32x32x16_bf16(va.v, pu.v, o0, 0, 0, 0);                           \
    o1 = __builtin_amdgcn_mfma_f32_32x32x16_bf16(vb.v, pu.v, o1, 0, 0, 0);                           \
  }
  AT_LOAD(0);
  AT_WRITE(0);
  __syncthreads();
  for (int t = 0; t < nkt; ++t) {
    const int cur = t & 1;
    if (t + 1 < nkt) AT_LOAD(t + 1);
    const char* Ks = smem + cur * AT_STAGE;
    const char* Vs = Ks + AT_KT * AT_KP;
    const float nm = -mrun;
    f32x16 sA, sB;
    float ps = 0.f;
#pragma unroll
    for (int i = 0; i < 16; ++i) sA[i] = nm;
    AT_QK(sA, 0)
#pragma unroll
    for (int i = 0; i < 16; ++i) sB[i] = nm;
    AT_QK(sB, 1)
    AT_SOFT_PV(sA, 0)
#pragma unroll
    for (int i = 0; i < 16; ++i) sA[i] = nm;
    AT_QK(sA, 2)
    AT_SOFT_PV(sB, 1)
#pragma unroll
    for (int i = 0; i < 16; ++i) sB[i] = nm;
    AT_QK(sB, 3)
    AT_SOFT_PV(sA, 2)
    AT_SOFT_PV(sB, 3)
    lrun += ps;
    float pmx = fmaxf(ps, shx(ps, 32));
    if (__any(pmx > 65536.f)) {
      const float delta = pmx > 65536.f ? ceilf(__log2f(pmx)) : 0.f;
      const float alpha = __builtin_amdgcn_exp2f(-delta);
      mrun += delta;
      lrun *= alpha;
#pragma unroll
      for (int i = 0; i < 16; ++i) { o0[i] *= alpha; o1[i] *= alpha; }
    }
    if (t + 1 < nkt) AT_WRITE(cur ^ 1);
    __syncthreads();
  }
  const float ltot = lrun + shx(lrun, 32);
  const float inv = 1.f / ltot;
  const int b = bh >> 3, head = bh & 7;
  u16* Op = (u16*)(p.ws + WS_O) + ((size_t)b * SP + qb * 256 + wid * 32 + r) * 512 + head * 64;
#pragma unroll
  for (int g = 0; g < 4; ++g) {
    uint2 w0, w1;
    w0.x = pk2(o0[4 * g] * inv, o0[4 * g + 1] * inv);
    w0.y = pk2(o0[4 * g + 2] * inv, o0[4 * g + 3] * inv);
    w1.x = pk2(o1[4 * g] * inv, o1[4 * g + 1] * inv);
    w1.y = pk2(o1[4 * g + 2] * inv, o1[4 * g + 3] * inv);
    *(uint2*)(Op + 8 * g + 4 * hh) = w0;
    *(uint2*)(Op + 32 + 8 * g + 4 * hh) = w1;
  }
#undef AT_LOAD
#undef AT_WRITE
#undef AT_QK
#undef AT_SOFT_PV
}

__device__ __forceinline__ void hypost_task(const Ctx& p, int task, char* smem) {
  const int tid = tid_l(), lane = tid & 63, wid = tid >> 6;
  const int tile64 = task >> 1, ch0 = (task & 1) * 256;
  const int m0 = tile64 * 64, b = m0 / SP, pos0 = m0 - b * SP;
  float* T = (float*)smem;
  const float* ZV = (const float*)(p.ws + WS_ZV);
#pragma unroll 8
  for (int cc = 0; cc < 32; ++cc) {
    int c = wid * 32 + cc;
    T[c * 65 + lane] = ZV[((size_t)(ch0 + c) * SP + pos0 + lane) * 2 + b];
  }
  __syncthreads();
  u16* Y = (u16*)(p.ws + WS_Y);
  const int c = tid & 255, th = tid >> 8;
  u16* yp = Y + (size_t)(m0 + th * 32) * 512 + ch0 + c;
  u16 yv[32];
#pragma unroll
  for (int i = 0; i < 32; ++i) yv[i] = yp[(size_t)i * 512];
#pragma unroll
  for (int i = 0; i < 32; ++i) yp[(size_t)i * 512] = f2bf(bf2f(yv[i]) * T[c * 65 + th * 32 + i]);
  __syncthreads();
}

#ifndef PHMASK
#define PHMASK 0xFFFF
#endif
#define PHON(k) (((PHMASK) >> (k)) & 1)
constexpr int NPH = 1 + 4 * 10 + 1;
__global__ void __launch_bounds__(NT, 2) mega(Params prm) {
  __shared__ __attribute__((aligned(1024))) char smem[LDS_BYTES];
  cg::grid_group grid = cg::this_grid();
  const int bid = blockIdx.x, nb = gridDim.x;
  {
    unsigned long long* it = (unsigned long long*)(smem + AUX_OFF + 6144);
    if (threadIdx.x < 33) it[threadIdx.x] = (unsigned long long)prm.in[threadIdx.x];
    if (threadIdx.x == 0) *(uint4*)(smem + AUX_OFF + 7168) = make_uint4(0u, 0u, 0u, 0u);
    __syncthreads();
  }
  XcdBarrier xbar = xcd_barrier_post((unsigned*)(prm.ws + WS_BAR), (volatile LAS unsigned*)(smem + AUX_OFF + 7168));
  if (prm.ph_lo == 0) {
    Ctx p;
    p.intab = (const unsigned long long*)(smem + AUX_OFF + 6144);
    p.ws = prm.ws;
    p.out = prm.out;
    const int bid = blockIdx.x, nb = gridDim.x;
      if (PHON(10)) {
      p0_misc(p);
      for (int t = bid; t < 192; t += nb) p0_mod_task(p, t, smem);
      for (int t = bid; t < 528; t += nb) p0_hid_task(p, t, smem);
      for (int t = bid; t < 128; t += nb) { const int w = (t + 64) & 127; wpe_task(p, w >> 5, w & 31, smem); }
      }
  }
  unsigned nbar = 0;
  for (int ph = prm.ph_lo; ph < prm.ph_hi; ++ph) {
    Ctx p;
    p.intab = (const unsigned long long*)(smem + AUX_OFF + 6144);
    p.ws = prm.ws;
    p.out = prm.out;
    asm volatile("" : "+s"(p.ws), "+s"(p.out));
    float* modall = (float*)(p.ws + WS_MOD);
    u16* proj = (u16*)(p.ws + WS_PROJ);
    u16* xn = (u16*)(p.ws + WS_U);
    char* wo = (char*)p.out;
    if (ph == 0) {
    } else if (ph == NPH - 1) {
      if (PHON(11)) final_norm(p);
    } else {
      const int l = (ph - 1) / 10, sp = (ph - 1) % 10;
      const float* modl = modall + (size_t)l * 3 * 6144;
      GD* tab = (GD*)(smem + AUX_OFF + 4096);
      int ng = 0, nN0 = 0, nN1 = 0, nsplit = 1;
      const bool last = (l == 3);
      const float* gate = modl;
      if (sp == 0 && PHON(0)) {
        wt_phase(p, l, smem);
        norm_rows(p, pin(p, 6) + l * 1024, modl, 0, 1, xn);
      } else if (sp == 1 && PHON(1)) {
        if (threadIdx.x == 0) tab[0] = GD{xn, 1024, (const u16*)(wo + WO_IN), 1024, 1024, 23, EM_PROJ, 1};
        ng = 1; nN0 = 23;
      } else if (sp == 2 && PHON(2)) {
        for (int t = bid; t < 264 * 6; t += nb) premix_task(p, l, t, smem);
        {
          Epi ef{EM_FILT, p.ws, gate, nullptr, (u16*)(wo + WO_FILT)};
          const u16* hA = (const u16*)(p.ws + WS_HID2) + (size_t)l * 8192 * 64;
          const u16* wB = (const u16*)(p.ws + WS_W3T) + (size_t)l * 1024 * 64;
#pragma unroll 1
          for (int t = nb - 1 - bid; t < 128; t += nb) gemm_tile(hA, 64, wB, 64, 64, (t >> 2) * 256, (t & 3) * 256, smem, ef);
        }
      } else if (sp == 3 && PHON(3)) {
        for (int t = bid; t < 512; t += nb) fft_task(p, l, t, smem);
        if (threadIdx.x == 0) {
          tab[0] = GD{proj + OFF_Q, DINP, (const u16*)(wo + WO_UQ), 384, 384, 3, EM_Q, 1};
          tab[1] = GD{proj + OFF_KV, DINP, (const u16*)(wo + WO_UKV), 256, 256, 4, EM_KV, 1};
        }
        ng = 2; nN0 = 3; nN1 = 4;
        for (int i = tid_l(); i < 1024; i += NT) ((float2*)(smem + 131072))[i] = ((const float2*)(p.ws + WS_ROPE))[i];
      } else if (sp == 4 && PHON(4)) {
        for (int t = bid; t < (last ? 512 : 528); t += nb) {
          int bh, qb;
          if (t < 512) { int rnd = t >> 8, w = t & 255; bh = (w & 7) + 8 * rnd; qb = 1 + (w >> 3); }
          else { bh = t - 512; qb = 0; }
          attn_task(p, bh, qb, smem);
        }
        for (int t = bid; t < 528; t += nb) hypost_task(p, t, smem);
      } else if (sp == 5 && PHON(5)) {
        for (int t = bid; t < (last ? 512 : 544); t += nb) {
          if (t < 512) {
            const int x = t & 7, g = t >> 3, pmi = (g >> 2) * 8 + x, pm = pmi + 2 + (pmi >= 64 ? 2 : 0);
            mix_tile<4>(p, l, pm * 128, g & 3, smem);
          } else {
            const int c = t - 512, cm = c >> 2;
            mix_tile<2>(p, l, (cm >> 2) * SP + (cm & 3) * 64, c & 3, smem);
          }
        }
      } else if (sp == 6 && PHON(6)) {
        if (threadIdx.x == 0) tab[0] = GD{(const u16*)(p.ws + WS_ZV), 1024, (const u16*)(wo + WO_OUT), 1024, 1024, 4, EM_RESID, 4};
        ng = 1; nN0 = 4; nsplit = 4;
        gate = modl + 2 * 1024;
      } else if (sp == 7 && PHON(7)) {
        norm_rows(p, pin(p, 7) + l * 1024, modl, 3, 4, xn);
      } else if (sp == 8 && PHON(8)) {
        if (threadIdx.x == 0) tab[0] = GD{xn, 1024, (const u16*)(wo + WO_FF1), 1024, 1024, 16, EM_SQRELU, last ? 2 : 1};
        ng = 1; nN0 = 16; nsplit = last ? 2 : 1;
      } else if (sp == 9 && PHON(9)) {
        if (threadIdx.x == 0) tab[0] = GD{proj, DFF, (const u16*)(wo + WO_FF2), 4096, 4096, 4, EM_RESID, 8};
        ng = 1; nN0 = 4; nsplit = 8;
        gate = modl + 5 * 1024;
      }
      if (ng > 0) {
        __syncthreads();
        const int nt0 = (nsplit > 1) ? (64 * nN0 + (last ? 0 : 2 * nN0 * nsplit)) : NMT * nN0, ntot = nt0 + NMT * nN1;
#pragma unroll 1
        for (int t = bid; t < ntot; t += nb) {
          int gi = 0, tt = t;
          if (t >= nt0) { gi = 1; tt = t - nt0; }
          const volatile GD* gp = tab + gi;
          unsigned long long a64 = (unsigned long long)gp->A, b64 = (unsigned long long)gp->Bt;
          a64 = ((unsigned long long)(unsigned)__builtin_amdgcn_readfirstlane((unsigned)(a64 >> 32)) << 32) | (unsigned long long)(unsigned)__builtin_amdgcn_readfirstlane((unsigned)a64);
          b64 = ((unsigned long long)(unsigned)__builtin_amdgcn_readfirstlane((unsigned)(b64 >> 32)) << 32) | (unsigned long long)(unsigned)__builtin_amdgcn_readfirstlane((unsigned)b64);
          const int lda = __builtin_amdgcn_readfirstlane(gp->lda), ldb = __builtin_amdgcn_readfirstlane(gp->ldb);
          const int K = __builtin_amdgcn_readfirstlane(gp->K), nN = __builtin_amdgcn_readfirstlane(gp->nN);
          const int ks = __builtin_amdgcn_readfirstlane(gp->ks);
          const int mode = __builtin_amdgcn_readfirstlane(gp->mode);
          int pm, pn, Kuse = K, emode = mode;
          if (ks > 1) {
            const int nlat = 64 * nN;
            if (tt < nlat) { int pm64; tile_map(tt, 64, nN, pm64, pn); pm = (pm64 >> 5) * 33 + 1 + (pm64 & 31); }
            else {
              int u = tt - nlat, kp = u % ks, tile = u / ks;
              pm = (tile / nN) * 33; pn = tile % nN;
              Kuse = K / ks; emode = EM_RESID_AT;
              a64 += (unsigned long long)kp * Kuse * 2; b64 += (unsigned long long)kp * Kuse * 2;
            }
          } else tile_map(tt, NMT, nN, pm, pn);
          Epi e{emode, p.ws, gate, (const float2*)(smem + 131072), nullptr};
          gemm_tile((const u16*)a64, lda, (const u16*)b64, ldb, Kuse, pm * 256, pn * 256, smem, e);
        }
      }
    }
    if (ph + 1 < prm.ph_hi) {
      if (ph == prm.ph_lo) grid.sync();
      else xcd_barrier(xbar);
    }
  }
}

extern "C" void kernel_launch(void* const* d_in, const int* in_sizes, int n_in, void* d_out, int out_size, void* d_ws,
                              size_t ws_size, hipStream_t stream) {
  static int grid_blocks = 0;
  if (grid_blocks == 0) {
    if (n_in != 33 || ws_size < WS_END || (size_t)out_size * 4 < WO_END) {
      fprintf(stderr, "kernel_launch: unexpected sizes n_in=%d ws=%zu (need %zu) out=%d\n", n_in, ws_size, (size_t)WS_END, out_size);
      grid_blocks = -1;
      return;
    }
    int dev = 0, cus = 0, per_cu = 0;
    hipGetDevice(&dev);
    hipDeviceGetAttribute(&cus, hipDeviceAttributeMultiprocessorCount, dev);
    hipOccupancyMaxActiveBlocksPerMultiprocessor(&per_cu, mega, NT, 0);
    if (per_cu < 1) per_cu = 1;
    if (per_cu > 1) per_cu = 1;
    grid_blocks = cus * per_cu;
  }
  if (grid_blocks < 0) return;
  Params p{};
  for (int i = 0; i < 33; ++i) p.in[i] = (const float*)d_in[i];
  p.out = (float*)d_out;
  p.ws = (char*)d_ws;
  p.ph_lo = 0;
  p.ph_hi = NPH;
  (void)hipMemsetAsync((char*)d_ws + WS_BAR, 0, 16384, stream);
  void* args[] = {&p};
  hipError_t e = hipLaunchCooperativeKernel((void*)mega, dim3(grid_blocks), dim3(NT), args, 0, stream);
  if (e != hipSuccess) fprintf(stderr, "cooperative launch failed: %s (grid %d)\n", hipGetErrorString(e), grid_blocks);
}
```

```cpp
#include <hip/hip_runtime.h>
#include <hip/hip_cooperative_groups.h>
#include <cstdio>
namespace cg = cooperative_groups;

typedef unsigned short u16;
using bf16x8 = __attribute__((ext_vector_type(8))) short;
using f32x4 = __attribute__((ext_vector_type(4))) float;
using f32x16 = __attribute__((ext_vector_type(16))) float;

constexpr int D = 1024, SEQ = 8192, CTX = 256, SP = 8448, MROWS = 16896, NMT = 66;
constexpr int DIN = 5792, DINP = 5888, DFF = 4096;
constexpr int OFF_HY = 512, OFF_Q = 2048, OFF_KV = 2432, OFF_GATE = 2720;
constexpr int NT = 512;
constexpr float EPS = 1e-6f;

constexpr size_t WS_H = 0;
constexpr size_t WS_PROJ = WS_H + (size_t)MROWS * D * 4;
constexpr size_t WS_U = WS_PROJ + (size_t)MROWS * DINP * 2;
constexpr size_t WS_Y = WS_U + (size_t)MROWS * 512 * 2;
constexpr size_t WS_O = WS_Y + (size_t)MROWS * 512 * 2;
constexpr size_t WS_Q = WS_O + (size_t)MROWS * 512 * 2;
constexpr size_t WS_K = WS_Q + (size_t)16 * SP * 96 * 2;
constexpr size_t WS_VT = WS_K + (size_t)16 * SP * 96 * 2;
constexpr size_t WS_ZV = WS_VT + (size_t)16 * 64 * SP * 2;
constexpr size_t WS_HID2 = WS_ZV + (size_t)512 * SP * 8;
constexpr size_t WS_HID2C = WS_HID2 + (size_t)4 * 8192 * 64 * 4;
constexpr size_t WS_MOD = WS_HID2C + (size_t)4 * 256 * 64 * 4;
constexpr size_t WS_ROPE = WS_MOD + (size_t)4 * 3 * 6144 * 4;
constexpr size_t WS_TW = WS_ROPE + (size_t)128 * 8 * 8;
constexpr size_t WS_WPE = WS_TW + (size_t)16384 * 8;
constexpr size_t WS_BAR = WS_WPE + (size_t)4 * 1024 * 512 * 2;
constexpr size_t WS_END = WS_BAR + 16384;
constexpr size_t WO_IN = 0;
constexpr size_t WO_FF1 = WO_IN + (size_t)DINP * 1024 * 2;
constexpr size_t WO_FF2 = WO_FF1 + (size_t)4096 * 1024 * 2;
constexpr size_t WO_OUT = WO_FF2 + (size_t)4096 * 1024 * 2;
constexpr size_t WO_HY = WO_OUT + (size_t)1024 * 1024 * 2;
constexpr size_t WO_WO = WO_HY + (size_t)1024 * 512 * 2;
constexpr size_t WO_PE = WO_WO + (size_t)1024 * 512 * 2;
constexpr size_t WO_UQ = WO_PE + (size_t)1024 * 512 * 2;
constexpr size_t WO_UKV = WO_UQ + (size_t)768 * 384 * 2;
constexpr size_t WO_FILT = WO_UKV + (size_t)1024 * 256 * 2;
constexpr size_t WO_END = WO_FILT + (size_t)1024 * 8192 * 2;
constexpr size_t WS_W3T = WS_HID2 + (size_t)4 * 8192 * 64 * 2;

constexpr int AUX_OFF = 147456;
constexpr int LDS_BYTES = AUX_OFF + 8192;

struct Params {
  const float* in[33];
  float* out;
  char* ws;
  int ph_lo, ph_hi;
};

struct Ctx { const unsigned long long* intab; char* ws; float* out; };
__device__ __forceinline__ const float* pin(const Ctx& c, int i) {
  unsigned long long v = c.intab[i];
  unsigned lo = __builtin_amdgcn_readfirstlane((unsigned)v), hi = __builtin_amdgcn_readfirstlane((unsigned)(v >> 32));
  return (const float*)(((unsigned long long)hi << 32) | lo);
}

typedef __bf16 hwbf2 __attribute__((ext_vector_type(2)));
typedef float hwf2 __attribute__((ext_vector_type(2)));
__device__ __forceinline__ unsigned pk2(float a, float b) {
  hwf2 v = {a, b};
  hwbf2 r = __builtin_convertvector(v, hwbf2);
  return __builtin_bit_cast(unsigned, r);
}
__device__ __forceinline__ u16 f2bf(float f) { return (u16)(pk2(f, 0.f) & 0xffffu); }
__device__ __forceinline__ float bf2f(u16 b) { return __uint_as_float(((unsigned)b) << 16); }
__device__ __forceinline__ float shx(float v, int o) {
  int l = __builtin_amdgcn_mbcnt_hi(~0u, __builtin_amdgcn_mbcnt_lo(~0u, 0u));
  asm volatile("" : "+v"(l));
  return __int_as_float(__builtin_amdgcn_ds_bpermute((l ^ o) << 2, __float_as_int(v)));
}
__device__ __forceinline__ float wave_sum(float v) {
#pragma unroll
  for (int o = 1; o < 64; o <<= 1) v += shx(v, o);
  return v;
}
__device__ __forceinline__ int grp_of_row(int m) {
  int tile = m >> 8, b = tile / 33, t33 = tile - b * 33;
  return t33 == 0 ? 2 : b;
}
__device__ __forceinline__ float2 cmul(float2 a, float2 b) { return make_float2(a.x * b.x - a.y * b.y, a.x * b.y + a.y * b.x); }

__device__ __forceinline__ int tid_l() { int t = threadIdx.x; asm volatile("" : "+v"(t)); return t; }
#define XB_TMO      128
#define XB_XCNT(j)  (256  + 64 * (j))
#define XB_XSUB(j)  (1280 + 64 * (j))
#define XB_XGEN(j)  (2304 + 64 * (j))
#define XB_TOP      3328
#define XB_TOPGEN   3392
#define XCD_BAR_WORDS 3456
#define XB_SPIN_CAP (1u << 18)
#define LAS __attribute__((address_space(3)))
__device__ __forceinline__ unsigned xb_ld(unsigned* p)              { return __hip_atomic_load(p, __ATOMIC_RELAXED, __HIP_MEMORY_SCOPE_AGENT); }
__device__ __forceinline__ unsigned xb_add(unsigned* p, unsigned v) { return __hip_atomic_fetch_add(p, v, __ATOMIC_RELAXED, __HIP_MEMORY_SCOPE_AGENT); }
__device__ __forceinline__ unsigned xb_xcc_id() { return (unsigned)__builtin_amdgcn_s_getreg((3 << 11) | 20) & 0xFu; }
#define XB_SPIN(cond, bar) do { unsigned _sp = 0; while (cond) { __builtin_amdgcn_s_sleep(1); \
    if ((++_sp & 255u) == 0u) { if (xb_ld(&(bar)[XB_TMO])) break; if (_sp > XB_SPIN_CAP) { atomicAdd(&(bar)[XB_TMO], 1u); break; } } } } while (0)
struct XcdBarrier { unsigned* bar; unsigned x; volatile LAS unsigned* st; };
__device__ __forceinline__ XcdBarrier xcd_barrier_post(unsigned* bar, volatile LAS unsigned* st) {
    XcdBarrier b; b.bar = bar; b.x = xb_xcc_id(); b.st = st;
    if (threadIdx.x == 0) (void)xb_add(&bar[XB_XCNT(b.x)], 1u);
    return b;
}
__device__ __forceinline__ void xcd_barrier_complete(unsigned* bar, unsigned x, unsigned& nloc, unsigned& nx) {
    const unsigned G = gridDim.x * gridDim.y * gridDim.z;
    unsigned sum, cnt, mine, sp = 0u;
    for (;;) {
        sum = 0u; cnt = 0u; mine = 0u;
#pragma unroll
        for (unsigned j = 0; j < 16; ++j) { const unsigned c = xb_ld(&bar[XB_XCNT(j)]); sum += c; cnt += (c > 0u) ? 1u : 0u; mine = (j == x) ? c : mine; }
        if (sum == G) break;
        __builtin_amdgcn_s_sleep(1);
        if ((++sp & 255u) == 0u) { if (xb_ld(&bar[XB_TMO])) break; if (sp > XB_SPIN_CAP) { atomicAdd(&bar[XB_TMO], 1u); break; } }
    }
    nloc = mine > 0u ? mine : 1u; nx = cnt > 0u ? cnt : 1u;
}
__device__ __forceinline__ void xcd_barrier(const XcdBarrier& b) {
    asm volatile("s_waitcnt vmcnt(0)" ::: "memory");
    __syncthreads();
    if (threadIdx.x == 0) {
        unsigned* bar = b.bar;
        __builtin_amdgcn_s_waitcnt(0);
        unsigned nloc = b.st[0], nx = b.st[1];
        if (nloc == 0u) { xcd_barrier_complete(bar, b.x, nloc, nx); b.st[0] = nloc; b.st[1] = nx; }
        const unsigned old = xb_add(&bar[XB_XSUB(b.x)], 1u);
        const unsigned gen = old / nloc;
        if (old + 1u == (gen + 1u) * nloc) {
            __builtin_amdgcn_fence(__ATOMIC_RELEASE, "agent");
            asm volatile("s_waitcnt vmcnt(0)" ::: "memory");
            const unsigned og = xb_add(&bar[XB_TOP], 1u);
            const unsigned tg = og / nx;
            if (og + 1u == (tg + 1u) * nx) xb_add(&bar[XB_TOPGEN], 1u);
            else XB_SPIN(xb_ld(&bar[XB_TOPGEN]) == tg, bar);
            __builtin_amdgcn_fence(__ATOMIC_ACQUIRE, "agent");
            xb_add(&bar[XB_XGEN(b.x)], 1u);
            asm volatile("s_waitcnt vmcnt(0)" ::: "memory");
        } else {
            XB_SPIN(xb_ld(&bar[XB_XGEN(b.x)]) == gen, bar);
            __builtin_amdgcn_fence(__ATOMIC_ACQUIRE, "agent");
            asm volatile("s_waitcnt vmcnt(0)" ::: "memory");
        }
    }
    __syncthreads();
}

__device__ __forceinline__ void grid_barrier(unsigned* bar, unsigned target) {
  asm volatile("s_waitcnt vmcnt(0)" ::: "memory");
  __syncthreads();
  if (threadIdx.x == 0) {
    __builtin_amdgcn_fence(__ATOMIC_RELEASE, "agent");
    asm volatile("s_waitcnt vmcnt(0)" ::: "memory");
    __hip_atomic_fetch_add(bar, 1u, __ATOMIC_RELAXED, __HIP_MEMORY_SCOPE_AGENT);
    while (__hip_atomic_load(bar, __ATOMIC_RELAXED, __HIP_MEMORY_SCOPE_AGENT) < target) __builtin_amdgcn_s_sleep(2);
    __builtin_amdgcn_fence(__ATOMIC_ACQUIRE, "agent");
    asm volatile("s_waitcnt vmcnt(0)" ::: "memory");
  }
  __syncthreads();
}
#define WAIT_V(n) asm volatile("s_waitcnt vmcnt(%0)" ::"n"(n) : "memory")
#define SCHED() __builtin_amdgcn_sched_barrier(0)
#define RAW_BARRIER() do { asm volatile("s_waitcnt lgkmcnt(0)" ::: "memory"); __builtin_amdgcn_s_barrier(); } while (0)

constexpr float QSCALE = 0.10206207261596575f * 1.4426950408889634f;
enum { EM_PROJ = 0, EM_SQRELU = 1, EM_RESID = 2, EM_RESID_AT = 3, EM_FILT = 4, EM_Q = 6, EM_KV = 7 };
struct Epi {
  int mode;
  char* ws;
  const float* gate;
  const float2* rope_lds;
  u16* filt_out;
  __device__ __forceinline__ void proj(int row, int col, f32x4 v) const {
    {
      u16* out = (u16*)(ws + WS_PROJ);
#pragma unroll
      for (int j = 0; j < 4; ++j) out[(size_t)(row + j) * DINP + col] = f2bf(v[j]);
    }
  }
  __device__ __forceinline__ void sqrelu(int row, int col, f32x4 v) const {
    {
      u16* out = (u16*)(ws + WS_PROJ);
#pragma unroll
      for (int j = 0; j < 4; ++j) { float r = fmaxf(v[j], 0.f); out[(size_t)(row + j) * DFF + col] = f2bf(r * r); }
    }
  }
  __device__ __forceinline__ void resid(int row, int col, f32x4 v) const {
    {
      float* h = (float*)(ws + WS_H);
      float g = gate[grp_of_row(row) * 6144 + col];
#pragma unroll
      for (int j = 0; j < 4; ++j) unsafeAtomicAdd(h + (size_t)(row + j) * D + col, g * v[j]);
    }
  }
  __device__ __forceinline__ void filt(int row, int col, f32x4 v) const {
    uint2 o;
    o.x = pk2(v[0], v[1]);
    o.y = pk2(v[2], v[3]);
    *(uint2*)(filt_out + (size_t)col * 8192 + row) = o;
  }
  __device__ __forceinline__ void q(int row, int col, f32x4 v) const {
    {
      u16* Q = (u16*)(ws + WS_Q);
      const float2* rope = rope_lds;
      int head = col / 96, d = col - head * 96;
      int b = row / SP, pos0 = row - b * SP;
      bool isrope = (d >= 64) && (pos0 >= CTX);
      int rd = d - 64;
#pragma unroll
      for (int j = 0; j < 4; ++j) {
        float val = v[j];
        float partner = shx(val, 8);
        int pos = pos0 + j;
        if (isrope) {
          int t = pos - CTX, idx = (rd < 16) ? (t >> 6) : (t & 63);
          float2 cs = rope[idx * 8 + (rd & 7)];
          float sgn = (rd & 8) ? 1.f : -1.f;
          val = val * cs.x + sgn * partner * cs.y;
        }
        Q[((size_t)(b * 8 + head) * SP + pos) * 96 + d] = f2bf(val * QSCALE);
      }
    }
  }
  __device__ __forceinline__ void kv(int row, int col, f32x4 v) const {
    {
      u16* Kb = (u16*)(ws + WS_K);
      u16* Vt = (u16*)(ws + WS_VT);
      int head = col >> 7, j2 = col & 127;
      int b = row / SP, pos0 = row - b * SP;
      if (j2 < 64) {
#pragma unroll
        for (int j = 0; j < 4; ++j) Kb[((size_t)(b * 8 + head) * SP + pos0 + j) * 96 + j2] = f2bf(v[j]);
      } else {
        uint2 o;
        o.x = pk2(v[0], v[1]);
        o.y = pk2(v[2], v[3]);
        *(uint2*)(Vt + ((size_t)(b * 8 + head) * 64 + (j2 - 64)) * SP + pos0) = o;
      }
    }
  }
};
struct GD { const u16* A; int lda; const u16* Bt; int ldb; int K; int nN; int mode; int ks; };

constexpr int G_TILE_B = 256 * 64 * 2, G_STAGE_B = 2 * G_TILE_B;
__device__ __forceinline__ int lds_byte(int r, int c) {
  int st = (r >> 4) * 2 + (c >> 5), ob = (r & 15) * 64 + (c & 31) * 2;
  return st * 1024 + (ob ^ (((ob >> 9) & 1) << 5));
}
__device__ __forceinline__ void stage_rc(int b, int& R, int& C) {
  int st = b >> 10, sb = b & 1023, swz = sb ^ (((sb >> 9) & 1) << 5);
  R = (st / 2) * 16 + swz / 64;
  C = (st % 2) * 32 + (swz % 64) / 2;
}

template <int MI>
__device__ __forceinline__ void gemm_core(const u16* __restrict__ A, int lda, const u16* __restrict__ Bt, int ldb, int K,
                                          int brow, int bcol, char* shm, f32x4 (&acc)[MI][4]) {
  constexpr int TILE_A = MI * 32 * 64 * 2, TILE_BB = 256 * 64 * 2, STAGE = TILE_A + TILE_BB;
  const int tid = tid_l(), wid = tid >> 6, lane = tid & 63, wr = wid >> 2, wc = wid & 3, fr = lane & 15, fq = lane >> 4;
  const u16* Ab = A + (size_t)brow * lda;
  const u16* Bb = Bt + (size_t)bcol * ldb;
  int sR[4], sC[4];
#pragma unroll
  for (int i = 0; i < 4; ++i) stage_rc(wid * 1024 + i * 8192 + lane * 16, sR[i], sC[i]);
#define SA(b) (shm + (b) * STAGE)
#define SB(b) (shm + (b) * STAGE + TILE_A)
#define GLDS_STAGE(buf, kt)                                                                                              \
  do {                                                                                                                   \
    _Pragma("unroll") for (int i = 0; i < 4; ++i) {                                                                      \
      if (i < MI / 2)                                                                                                    \
        __builtin_amdgcn_global_load_lds((const unsigned*)(Ab + (size_t)sR[i] * lda + (kt) * 64 + sC[i]),                \
                                         (unsigned*)(SA(buf) + wid * 1024 + i * 8192), 16, 0, 0);                        \
      __builtin_amdgcn_global_load_lds((const unsigned*)(Bb + (size_t)sR[i] * ldb + (kt) * 64 + sC[i]),                  \
                                       (unsigned*)(SB(buf) + wid * 1024 + i * 8192), 16, 0, 0);                          \
    }                                                                                                                    \
  } while (0)
  const int nt = K / 64;
  GLDS_STAGE(0, 0);
  WAIT_V(0);
  __syncthreads();
  for (int t = 0; t < nt; ++t) {
    const int cur = t & 1;
    if (t + 1 < nt) GLDS_STAGE(cur ^ 1, t + 1);
    __builtin_amdgcn_iglp_opt(1);
#pragma unroll
    for (int ks = 0; ks < 2; ++ks) {
      bf16x8 At[MI], Bf[4];
#pragma unroll
      for (int m = 0; m < MI; ++m) At[m] = *(const bf16x8*)(SA(cur) + lds_byte(wr * (MI * 16) + m * 16 + fr, ks * 32 + fq * 8));
#pragma unroll
      for (int n = 0; n < 4; ++n) Bf[n] = *(const bf16x8*)(SB(cur) + lds_byte(wc * 64 + n * 16 + fr, ks * 32 + fq * 8));
#pragma unroll
      for (int m = 0; m < MI; ++m)
#pragma unroll
        for (int n = 0; n < 4; ++n) acc[m][n] = __builtin_amdgcn_mfma_f32_16x16x32_bf16(At[m], Bf[n], acc[m][n], 0, 0, 0);
    }
    WAIT_V(0);
    __syncthreads();
  }
#undef SA
#undef SB
#undef GLDS_STAGE
}

template <class EpiT>
__device__ __forceinline__ void gemm_tile(const u16* __restrict__ A, int lda, const u16* __restrict__ Bt, int ldb, int K,
                                          int brow, int bcol, char* shm, const EpiT& epi) {
  const int tid = tid_l(), wid = tid >> 6, lane = tid & 63, wr = wid >> 2, wc = wid & 3, fr = lane & 15, fq = lane >> 4;
  f32x4 acc[8][4];
#pragma unroll
  for (int m = 0; m < 8; ++m)
#pragma unroll
    for (int n = 0; n < 4; ++n) acc[m][n] = (f32x4){0.f, 0.f, 0.f, 0.f};
  gemm_core<8>(A, lda, Bt, ldb, K, brow, bcol, shm, acc);
#define EPI_LOOP(CALL)                                                                              \
  _Pragma("unroll") for (int m = 0; m < 8; ++m) _Pragma("unroll") for (int n = 0; n < 4; ++n) {      \
    const int row = brow + wr * 128 + m * 16 + fq * 4, col = bcol + wc * 64 + n * 16 + fr;           \
    const f32x4 v = acc[m][n];                                                                        \
    CALL;                                                                                             \
  }
  if (epi.mode == EM_PROJ) { EPI_LOOP(epi.proj(row, col, v)) }
  else if (epi.mode == EM_SQRELU) { EPI_LOOP(epi.sqrelu(row, col, v)) }
  else if (epi.mode == EM_RESID_AT) { EPI_LOOP(epi.resid(row, col, v)) }
  else if (epi.mode == EM_RESID) {
    float* h = (float*)(epi.ws + WS_H);
    float g4[4];
#pragma unroll
    for (int n = 0; n < 4; ++n) g4[n] = epi.gate[grp_of_row(brow) * 6144 + bcol + wc * 64 + n * 16 + fr];
    float hv[8][4][4];
    float* hp0 = h + (size_t)(brow + wr * 128 + fq * 4) * D + bcol + wc * 64 + fr;
#define H_LOAD(m) _Pragma("unroll") for (int n = 0; n < 4; ++n) _Pragma("unroll") for (int j = 0; j < 4; ++j) hv[m][n][j] = hp0[(size_t)((m) * 16 + j) * D + n * 16]
#define H_STORE(m) _Pragma("unroll") for (int n = 0; n < 4; ++n) _Pragma("unroll") for (int j = 0; j < 4; ++j) hp0[(size_t)((m) * 16 + j) * D + n * 16] = hv[m][n][j] + g4[n] * acc[m][n][j]
    H_LOAD(0); H_LOAD(1);
    SCHED();
    H_STORE(0); H_LOAD(2); SCHED();
    H_STORE(1); H_LOAD(3); SCHED();
    H_STORE(2); H_LOAD(4); SCHED();
    H_STORE(3); H_LOAD(5); SCHED();
    H_STORE(4); H_LOAD(6); SCHED();
    H_STORE(5); H_LOAD(7); SCHED();
    H_STORE(6); H_STORE(7);
#undef H_LOAD
#undef H_STORE
  }
  else if (epi.mode == EM_FILT) { EPI_LOOP(epi.filt(row, col, v)) }
  else if (epi.mode == EM_Q) { EPI_LOOP(epi.q(row, col, v)) }
  else { EPI_LOOP(epi.kv(row, col, v)) }
#undef EPI_LOOP
}

template <int MI>
__device__ __forceinline__ void mix_tile(const Ctx& p, int l, int brow, int pn, char* shm) {
  constexpr int TILE_A = MI * 32 * 64 * 2, TILE_BB = 256 * 64 * 2, STAGE = TILE_A + TILE_BB, WROWS = MI * 16;
  const int tid = tid_l(), wid = tid >> 6, lane = tid & 63, wr = wid >> 2, wc = wid & 3, fr = lane & 15, fq = lane >> 4;
  const int bcol = pn * 256;
  const u16* projb = (const u16*)(p.ws + WS_PROJ);
  char* wo = (char*)p.out;
#define SA(b) (shm + (b) * STAGE)
#define SB(b) (shm + (b) * STAGE + TILE_A)
#define MIX_STAGE(buf, kt)                                                                                               \
  do {                                                                                                                   \
    const int br_ = (kt) >> 3, ko_ = ((kt) & 7) * 64;                                                                    \
    const u16* Ab_ = (const u16*)(p.ws + (br_ == 0 ? WS_U : br_ == 1 ? WS_Y : WS_O)) + (size_t)brow * 512 + ko_;         \
    const u16* Bb_ = (br_ == 0 ? (const u16*)(p.ws + WS_WPE) + (size_t)l * 1024 * 512 : (const u16*)(wo + (br_ == 1 ? WO_HY : WO_WO))) + (size_t)bcol * 512 + ko_;        \
    _Pragma("unroll") for (int i = 0; i < 4; ++i) {                                                                      \
      int sR_, sC_; stage_rc(wid * 1024 + i * 8192 + lane * 16, sR_, sC_);                                              \
      if (i < MI / 2)                                                                                                    \
        __builtin_amdgcn_global_load_lds((const unsigned*)(Ab_ + sR_ * 512 + sC_),                           \
                                         (unsigned*)(SA(buf) + wid * 1024 + i * 8192), 16, 0, 0);                        \
      __builtin_amdgcn_global_load_lds((const unsigned*)(Bb_ + sR_ * 512 + sC_),                             \
                                       (unsigned*)(SB(buf) + wid * 1024 + i * 8192), 16, 0, 0);                          \
    }                                                                                                                    \
  } while (0)
  f32x4 tot[MI][4], acc[MI][4];
#pragma unroll
  for (int m = 0; m < MI; ++m)
#pragma unroll
    for (int n = 0; n < 4; ++n) { tot[m][n] = (f32x4){0.f, 0.f, 0.f, 0.f}; acc[m][n] = (f32x4){0.f, 0.f, 0.f, 0.f}; }
  MIX_STAGE(0, 0);
  MIX_STAGE(1, 1);
  WAIT_V(6);
  RAW_BARRIER();
  int cur = 0;
#pragma unroll 1
  for (int br = 0; br < 3; ++br) {
    unsigned gpk[MI][4][2];
    const u16* gp = projb + (size_t)(brow + wr * WROWS + fq * 4) * DINP + OFF_GATE + br * 1024 + bcol + wc * 64 + fr;
#define GATE_LOAD(m)                                                                                   \
    _Pragma("unroll") for (int n = 0; n < 4; ++n) _Pragma("unroll") for (int j2 = 0; j2 < 2; ++j2) {       \
      unsigned lo = gp[(size_t)((m) * 16 + 2 * j2) * DINP + n * 16], hi = gp[(size_t)((m) * 16 + 2 * j2 + 1) * DINP + n * 16]; \
      gpk[m][n][j2] = lo | (hi << 16);                                                                     \
    }
    GATE_LOAD(0); GATE_LOAD(1);
    if (MI == 4) { GATE_LOAD(2); }
#pragma unroll 1
    for (int kk = 0; kk < 8; ++kk) {
      const int t = br * 8 + kk;
      { int nx = cur + 2; if (nx >= 3) nx -= 3; if (t + 2 < 24) MIX_STAGE(nx, t + 2); }
      __builtin_amdgcn_iglp_opt(1);
#pragma unroll
      for (int ks = 0; ks < 2; ++ks) {
        bf16x8 At[2], Bf[4];
#pragma unroll
        for (int n = 0; n < 4; ++n) Bf[n] = *(const bf16x8*)(SB(cur) + lds_byte(wc * 64 + n * 16 + fr, ks * 32 + fq * 8));
#pragma unroll
        for (int mh = 0; mh < MI / 2; ++mh) {
#pragma unroll
          for (int m = 0; m < 2; ++m) At[m] = *(const bf16x8*)(SA(cur) + lds_byte(wr * WROWS + (mh * 2 + m) * 16 + fr, ks * 32 + fq * 8));
#pragma unroll
          for (int m = 0; m < 2; ++m)
#pragma unroll
            for (int n = 0; n < 4; ++n) acc[mh * 2 + m][n] = __builtin_amdgcn_mfma_f32_16x16x32_bf16(At[m], Bf[n], acc[mh * 2 + m][n], 0, 0, 0);
        }
      }
      if (t + 2 < 24) WAIT_V(6); else WAIT_V(0);
      RAW_BARRIER();
      cur = (cur == 2) ? 0 : cur + 1;
    }
    if (MI == 4) { GATE_LOAD(3); }
#undef GATE_LOAD
#pragma unroll
    for (int m = 0; m < MI; ++m)
#pragma unroll
      for (int n = 0; n < 4; ++n)
#pragma unroll
        for (int j = 0; j < 4; ++j) {
          const unsigned w = gpk[m][n][j >> 1];
          const float gv = __uint_as_float((j & 1) ? (w & 0xffff0000u) : (w << 16));
          tot[m][n][j] += acc[m][n][j] * __builtin_amdgcn_rcpf(1.f + __expf(-gv));
          acc[m][n][j] = 0.f;
        }
  }
  u16* mixb = (u16*)(p.ws + WS_ZV);
#pragma unroll
  for (int m = 0; m < MI; ++m)
#pragma unroll
    for (int n = 0; n < 4; ++n)
#pragma unroll
      for (int j = 0; j < 4; ++j)
        mixb[(size_t)(brow + wr * WROWS + m * 16 + fq * 4 + j) * D + bcol + wc * 64 + n * 16 + fr] = f2bf(tot[m][n][j]);
#undef SA
#undef SB
#undef MIX_STAGE
}

__device__ __forceinline__ void tile_map(int t, int nM, int nN, int& pm, int& pn) {
  int nwg = nM * nN, wgid = t;
  {
    int q = nwg / 8, r = nwg % 8, xcd = wgid % 8, off = wgid / 8;
    wgid = (xcd < r ? xcd * (q + 1) : r * (q + 1) + (xcd - r) * q) + off;
  }
  constexpr int WGM = 4;
  int nig = WGM * nN, gid = wgid / nig, fm = gid * WGM, gsz = min(nM - fm, WGM);
  pm = fm + ((wgid % nig) % gsz);
  pn = (wgid % nig) / gsz;
}

__device__ __forceinline__ void p0_misc(const Ctx& p) {
  const int gtid = blockIdx.x * NT + tid_l(), gn = gridDim.x * NT;
  float4* h4 = (float4*)(p.ws + WS_H);
  const float4* x4 = (const float4*)pin(p, 0);
  const float4* c4 = (const float4*)pin(p, 2);
#pragma unroll 8
  for (int i = gtid; i < MROWS * 256; i += gn) {
    int m = i >> 8, q = i & 255, b = m / SP, pos = m - b * SP;
    float4 v = (pos < CTX) ? c4[(size_t)(b * CTX + pos) * 256 + q] : x4[(size_t)(b * SEQ + pos - CTX) * 256 + q];
    h4[i] = v;
  }
  float2* rope = (float2*)(p.ws + WS_ROPE);
  for (int i = gtid; i < 1024; i += gn) {
    int idx = i >> 3, f = i & 7;
    float inv = powf(10000.f, -(float)f / 8.f);
    float a = (float)idx * inv;
    rope[i] = make_float2(cosf(a), sinf(a));
  }
  {
    u16* w3t = (u16*)(p.ws + WS_W3T);
    const float* w3 = pin(p, 20);
    for (int i = gtid; i < 4 * 1024 * 64; i += gn) { int l = i >> 16, c2 = (i >> 6) & 1023, k = i & 63; w3t[i] = f2bf(w3[((size_t)l * 64 + k) * 1024 + c2]); }
  }
  float2* tw = (float2*)(p.ws + WS_TW);
  for (int i = gtid; i < 16384; i += gn) {
    float s, c;
    sincospif(-(float)i / 8192.f, &s, &c);
    tw[i] = make_float2(c, s);
  }
}

__device__ __forceinline__ void p0_mod_task(const Ctx& p, int task, char* smem) {
  float* s = (float*)smem;
  float* red = s + 3072;
  const int tid = tid_l();
  const int l = task / 48, chunk = task - l * 48;
  for (int i = tid; i < 3072; i += NT) {
    int g = i >> 10, k = i & 1023;
    float cv = (g < 2) ? pin(p, 1)[g * 1024 + k] : pin(p, 3)[k];
    s[i] = cv / (1.f + __expf(-cv));
  }
  __syncthreads();
  const int kq = tid >> 7, col = tid & 127, n = chunk * 128 + col;
  const float* W = pin(p, 4) + (size_t)l * 1024 * 6144 + n;
  float a0 = 0.f, a1 = 0.f, a2 = 0.f;
#pragma unroll 32
  for (int k = kq * 256; k < kq * 256 + 256; ++k) {
    float w = W[(size_t)k * 6144];
    a0 += s[k] * w; a1 += s[1024 + k] * w; a2 += s[2048 + k] * w;
  }
  red[(kq * 3 + 0) * 128 + col] = a0;
  red[(kq * 3 + 1) * 128 + col] = a1;
  red[(kq * 3 + 2) * 128 + col] = a2;
  __syncthreads();
  if (tid < 384) {
    int g = tid >> 7, c2 = tid & 127, n2 = chunk * 128 + c2;
    float v = red[(0 * 3 + g) * 128 + c2] + red[(1 * 3 + g) * 128 + c2] + red[(2 * 3 + g) * 128 + c2] + red[(3 * 3 + g) * 128 + c2];
    ((float*)(p.ws + WS_MOD))[(size_t)(l * 3 + g) * 6144 + n2] = v + pin(p, 5)[l * 6144 + n2];
  }
  __syncthreads();
}

__device__ __forceinline__ void p0_hid_task(const Ctx& p, int task, char* smem) {
  float* zs = (float*)smem;
  float* h1 = zs + 8 * 36;
  float* w1s = h1 + 8 * 64;
  float* w2s = w1s + 33 * 64;
  const int tid = tid_l(), tl = tid >> 6, j = tid & 63;
  const int l = task / 132, r = task - l * 132;
  const bool isctx = r >= 128;
  const int L = isctx ? 256 : 8192;
  const int tbase = (isctx ? (r - 128) : r) * 64;
  for (int i = tid; i < 33 * 64; i += NT) w1s[i] = pin(p, 14)[l * 33 * 64 + i];
  for (int i = tid; i < 64 * 64; i += NT) w2s[i] = pin(p, 17)[l * 64 * 64 + i];
  const float b1 = pin(p, 15)[l * 64 + j], f1 = pin(p, 16)[l * 64 + j], b2 = pin(p, 18)[l * 64 + j], f2 = pin(p, 19)[l * 64 + j];
  __syncthreads();
  for (int sub = 0; sub < 8; ++sub) {
    const int t = tbase + sub * 8 + tl;
    if (j < 33) {
      float z;
      if (j == 0) z = (float)t / (float)(L - 1);
      else {
        int i = (j - 1) & 15;
        float band = 1e-4f + (float)i * ((15.f - 1e-4f) / 15.f);
        float omega = 6.2831855f * (float)t / (float)L;
        float a = omega * band;
        z = (j <= 16) ? cosf(a) : -sinf(a);
      }
      zs[tl * 36 + j] = z;
    }
    __syncthreads();
    {
      float a = b1;
#pragma unroll
      for (int k = 0; k < 33; ++k) a += zs[tl * 36 + k] * w1s[k * 64 + j];
      h1[tl * 64 + j] = sinf(f1 * a);
    }
    __syncthreads();
    {
      float a = b2;
#pragma unroll 16
      for (int k = 0; k < 64; ++k) a += h1[tl * 64 + k] * w2s[k * 64 + j];
      float v = sinf(f2 * a);
      if (isctx) ((float*)(p.ws + WS_HID2C))[((size_t)l * 64 + j) * 256 + t] = v;
      else ((u16*)(p.ws + WS_HID2))[((size_t)l * 8192 + t) * 64 + j] = f2bf(v);
    }
  }
  __syncthreads();
}

struct WtItem { const float* W; u16* WT; int K, N, k0, n0; };
__device__ __forceinline__ WtItem wt_decode(const Ctx& p, int l, int r) {
  char* wo = (char*)p.out;
  WtItem it;
  int nblk;
  if (r < 1472) { it.W = pin(p, 8) + (size_t)l * 1024 * DIN; it.K = 1024; it.N = DIN; it.WT = (u16*)(wo + WO_IN); nblk = 92; }
  else if ((r -= 1472) < 1024) { it.W = pin(p, 30) + (size_t)l * 1024 * 4096; it.K = 1024; it.N = 4096; it.WT = (u16*)(wo + WO_FF1); nblk = 64; }
  else if ((r -= 1024) < 1024) { it.W = pin(p, 31) + (size_t)l * 4096 * 1024; it.K = 4096; it.N = 1024; it.WT = (u16*)(wo + WO_FF2); nblk = 16; }
  else if ((r -= 1024) < 256) { it.W = pin(p, 29) + (size_t)l * 1024 * 1024; it.K = 1024; it.N = 1024; it.WT = (u16*)(wo + WO_OUT); nblk = 16; }
  else if ((r -= 256) < 128) { it.W = pin(p, 23) + (size_t)l * 512 * 1024; it.K = 512; it.N = 1024; it.WT = (u16*)(wo + WO_HY); nblk = 16; }
  else if ((r -= 128) < 128) { it.W = pin(p, 28) + (size_t)l * 512 * 1024; it.K = 512; it.N = 1024; it.WT = (u16*)(wo + WO_WO); nblk = 16; }
  else if ((r -= 128) < 72) { it.W = pin(p, 25) + (size_t)l * 384 * 768; it.K = 384; it.N = 768; it.WT = (u16*)(wo + WO_UQ); nblk = 12; }
  else { r -= 72; it.W = pin(p, 27) + (size_t)l * 256 * 1024; it.K = 256; it.N = 1024; it.WT = (u16*)(wo + WO_UKV); nblk = 16; }
  const int kb = r / nblk, nb2 = r - kb * nblk;
  it.k0 = kb * 64; it.n0 = nb2 * 64;
  return it;
}
__device__ __forceinline__ void wt_load(const WtItem& it, int tid, float (&v)[8]) {
  const int nn = tid & 63, kq = tid >> 6;
  const bool ok = it.n0 + nn < it.N;
  const float* src = it.W + (size_t)(it.k0 + kq) * it.N + it.n0 + (ok ? nn : 0);
#pragma unroll
  for (int r = 0; r < 8; ++r) { float x = src[(size_t)(r * 8) * it.N]; v[r] = ok ? x : 0.f; }
}
__device__ __forceinline__ void wt_phase(const Ctx& p, int l, char* smem) {
  float* tile = (float*)smem;
  const int tid = tid_l();
  const int bid = blockIdx.x, nb = gridDim.x;
  int t = bid;
  if (t >= 4168) return;
  WtItem cur = wt_decode(p, l, t);
  float v[8];
  wt_load(cur, tid, v);
#pragma unroll 1
  while (true) {
    const int tn = t + nb;
    const bool more = tn < 4168;
    WtItem nxt = cur;
    float vn[8];
    if (more) { nxt = wt_decode(p, l, tn); wt_load(nxt, tid, vn); }
#pragma unroll
    for (int r = 0; r < 8; ++r) tile[(r * 8 + (tid >> 6)) * 65 + (tid & 63)] = v[r];
    __syncthreads();
    {
      int n = tid >> 3, kc = (tid & 7) * 8;
      uint4 o;
      o.x = pk2(tile[(kc + 0) * 65 + n], tile[(kc + 1) * 65 + n]);
      o.y = pk2(tile[(kc + 2) * 65 + n], tile[(kc + 3) * 65 + n]);
      o.z = pk2(tile[(kc + 4) * 65 + n], tile[(kc + 5) * 65 + n]);
      o.w = pk2(tile[(kc + 6) * 65 + n], tile[(kc + 7) * 65 + n]);
      *(uint4*)(cur.WT + (size_t)(cur.n0 + n) * cur.K + cur.k0 + kc) = o;
    }
    __syncthreads();
    if (!more) break;
    cur = nxt;
#pragma unroll
    for (int r = 0; r < 8; ++r) v[r] = vn[r];
    t = tn;
  }
}

__device__ __forceinline__ void wpe_task(const Ctx& p, int l, int task, char* smem) {
  const int g = task >> 3, c0 = (task & 7) * 16, tid = tid_l();
  const float* pw = pin(p, 9) + ((size_t)(l * 4 + g) * 128) * 128;
  const float* sc = pin(p, 10) + l * 512 + g * 128;
  const float* po = pin(p, 11) + ((size_t)l * 512 + g * 128) * 1024;
  u16* WpeT = (u16*)(p.ws + WS_WPE) + (size_t)l * 1024 * 512;
  float* wl = (float*)smem;
  for (int i = tid; i < 16 * 128; i += NT) { int d = i & 127; wl[i] = pw[(c0 + (i >> 7)) * 128 + d] * sc[d]; }
  __syncthreads();
  float acc0[16], acc1[16];
#pragma unroll
  for (int i = 0; i < 16; ++i) { acc0[i] = 0.f; acc1[i] = 0.f; }
#pragma unroll 16
  for (int d = 0; d < 128; ++d) {
    float p0 = po[(size_t)d * 1024 + tid], p1 = po[(size_t)d * 1024 + 512 + tid];
#pragma unroll
    for (int i = 0; i < 16; ++i) { float w = wl[i * 128 + d]; acc0[i] += w * p0; acc1[i] += w * p1; }
  }
  uint4 o0, o1;
  o0.x = pk2(acc0[0], acc0[1]); o0.y = pk2(acc0[2], acc0[3]); o0.z = pk2(acc0[4], acc0[5]); o0.w = pk2(acc0[6], acc0[7]);
  o1.x = pk2(acc0[8], acc0[9]); o1.y = pk2(acc0[10], acc0[11]); o1.z = pk2(acc0[12], acc0[13]); o1.w = pk2(acc0[14], acc0[15]);
  uint4* dst = (uint4*)(WpeT + (size_t)tid * 512 + g * 128 + c0);
  dst[0] = o0; dst[1] = o1;
  o0.x = pk2(acc1[0], acc1[1]); o0.y = pk2(acc1[2], acc1[3]); o0.z = pk2(acc1[4], acc1[5]); o0.w = pk2(acc1[6], acc1[7]);
  o1.x = pk2(acc1[8], acc1[9]); o1.y = pk2(acc1[10], acc1[11]); o1.z = pk2(acc1[12], acc1[13]); o1.w = pk2(acc1[14], acc1[15]);
  dst = (uint4*)(WpeT + (size_t)(512 + tid) * 512 + g * 128 + c0);
  dst[0] = o0; dst[1] = o1;
  __syncthreads();
}

__device__ __forceinline__ void norm_rows(const Ctx& p, const float* gain, const float* modl, int sh_idx, int sc_idx, u16* outp) {
  const int tidx = tid_l(), lane = tidx & 63, gw = blockIdx.x * 8 + (tidx >> 6), ngw = gridDim.x * 8;
  const float* h = (const float*)(p.ws + WS_H);
  float4 g[4];
#pragma unroll
  for (int j = 0; j < 4; ++j) g[j] = *(const float4*)(gain + lane * 4 + 256 * j);
  for (int m0 = gw; m0 < MROWS; m0 += 2 * ngw) {
    const int m1 = m0 + ngw;
    const bool has1 = m1 < MROWS;
    const int m1c = has1 ? m1 : m0;
    const float4* hr0 = (const float4*)(h + (size_t)m0 * D) + lane;
    const float4* hr1 = (const float4*)(h + (size_t)m1c * D) + lane;
    float4 v0[4], v1[4];
#pragma unroll
    for (int j = 0; j < 4; ++j) { v0[j] = hr0[64 * j]; v1[j] = hr1[64 * j]; }
    const float* mg0 = modl + grp_of_row(m0) * 6144;
    const float* mg1 = modl + grp_of_row(m1c) * 6144;
    float s0 = 0.f, s1 = 0.f;
#pragma unroll
    for (int j = 0; j < 4; ++j) {
      s0 += v0[j].x * v0[j].x + v0[j].y * v0[j].y + v0[j].z * v0[j].z + v0[j].w * v0[j].w;
      s1 += v1[j].x * v1[j].x + v1[j].y * v1[j].y + v1[j].z * v1[j].z + v1[j].w * v1[j].w;
    }
    s0 = wave_sum(s0);
    s1 = wave_sum(s1);
    const float r0 = rsqrtf(s0 * (1.f / D) + EPS), r1 = rsqrtf(s1 * (1.f / D) + EPS);
    uint2* o0 = (uint2*)(outp + (size_t)m0 * D) + lane;
    uint2* o1 = (uint2*)(outp + (size_t)m1c * D) + lane;
#pragma unroll
    for (int j = 0; j < 4; ++j) {
      int n = lane * 4 + 256 * j;
      float4 sc = *(const float4*)(mg0 + sc_idx * 1024 + n), sh = *(const float4*)(mg0 + sh_idx * 1024 + n);
      uint2 o;
      o.x = pk2(v0[j].x * r0 * g[j].x * (1.f + sc.x) + sh.x, v0[j].y * r0 * g[j].y * (1.f + sc.y) + sh.y);
      o.y = pk2(v0[j].z * r0 * g[j].z * (1.f + sc.z) + sh.z, v0[j].w * r0 * g[j].w * (1.f + sc.w) + sh.w);
      o0[64 * j] = o;
    }
    if (has1) {
#pragma unroll
      for (int j = 0; j < 4; ++j) {
        int n = lane * 4 + 256 * j;
        float4 sc = *(const float4*)(mg1 + sc_idx * 1024 + n), sh = *(const float4*)(mg1 + sh_idx * 1024 + n);
        uint2 o;
        o.x = pk2(v1[j].x * r1 * g[j].x * (1.f + sc.x) + sh.x, v1[j].y * r1 * g[j].y * (1.f + sc.y) + sh.y);
        o.y = pk2(v1[j].z * r1 * g[j].z * (1.f + sc.z) + sh.z, v1[j].w * r1 * g[j].w * (1.f + sc.w) + sh.w);
        o1[64 * j] = o;
      }
    }
  }
}

__device__ __forceinline__ void final_norm(const Ctx& p) {
  const int tidx = tid_l(), lane = tidx & 63, gw = blockIdx.x * 8 + (tidx >> 6), ngw = gridDim.x * 8;
  const float* h = (const float*)(p.ws + WS_H);
  const float* gain = pin(p, 32);
  for (int r0 = gw; r0 < 2 * SEQ; r0 += ngw) {
    int b = r0 >> 13, t = r0 & 8191, m = b * SP + CTX + t;
    const float4* hr = (const float4*)(h + (size_t)m * D) + lane;
    float4 v[4];
    float ss = 0.f;
#pragma unroll
    for (int j = 0; j < 4; ++j) { v[j] = hr[64 * j]; ss += v[j].x * v[j].x + v[j].y * v[j].y + v[j].z * v[j].z + v[j].w * v[j].w; }
    ss = wave_sum(ss);
    float r = rsqrtf(ss * (1.f / D) + EPS);
    float4* o = (float4*)(p.out + (size_t)r0 * D) + lane;
#pragma unroll
    for (int j = 0; j < 4; ++j) {
      float4 g = *(const float4*)(gain + lane * 4 + 256 * j);
      o[64 * j] = make_float4(v[j].x * r * g.x, v[j].y * r * g.y, v[j].z * r * g.z, v[j].w * r * g.w);
    }
  }
}

__device__ __forceinline__ void premix_task(const Ctx& p, int l, int task, char* smem) {
  const int tid = tid_l(), lane = tid & 63, wid = tid >> 6;
  const int part = task / 264, tile64 = task - part * 264;
  const int m0 = tile64 * 64, b = m0 / SP, pos0 = m0 - b * SP;
  const bool isctx = pos0 < CTX;
  const int s0 = isctx ? 0 : CTX, L = isctx ? CTX : SEQ, t0 = pos0 - s0;
  const size_t mb = (size_t)b * SP + s0;
  const u16* proj = (const u16*)(p.ws + WS_PROJ);
  if (part == 0) {
    u16* P = (u16*)smem;
#pragma unroll
    for (int i = tid; i < 80 * 64; i += NT) {
      int r = i >> 6, ch = i & 63, t = t0 - 8 + r;
      uint4 v = make_uint4(0, 0, 0, 0);
      if (t >= 0 && t < L) v = *(const uint4*)(proj + (mb + t) * DINP + ch * 8);
      *(uint4*)(P + r * 512 + ch * 8) = v;
    }
    __syncthreads();
    const int c = tid, g = c >> 7, hw = 1 << g;
    u16* U = (u16*)(p.ws + WS_U);
    float s = 0.f;
    for (int q = -hw; q < hw; ++q) s += bf2f(P[(8 + q) * 512 + c]);
#pragma unroll 4
    for (int tt = 0; tt < 64; ++tt) {
      int t = t0 + tt, lo = max(t - hw, 0), hi = min(t + hw, L);
      float u = s * __builtin_amdgcn_rcpf((float)(hi - lo)) - bf2f(P[(tt + 8) * 512 + c]);
      U[(mb + t) * 512 + c] = f2bf(u);
      s += bf2f(P[(tt + 8 + hw) * 512 + c]) - bf2f(P[(tt + 8 - hw) * 512 + c]);
    }
    __syncthreads();
  } else if (part <= 4) {
    const int ch0 = (part - 1) * 128;
    constexpr int PITCH = 136;
    u16* X = (u16*)smem;
    float* T = (float*)(smem + 3 * 66 * PITCH * 2 + 64);
#pragma unroll
    for (int ii = 0; ii < 7; ++ii) {
      const int i = tid + ii * NT;
      if (i >= 3 * 66 * 16) break;
      int pr = i / (66 * 16), rem = i - pr * 66 * 16, r = rem >> 4, ch = rem & 15, t = t0 - 1 + r;
      uint4 v = make_uint4(0, 0, 0, 0);
      if (t >= 0 && t < L) v = *(const uint4*)(proj + (mb + t) * DINP + OFF_HY + pr * 512 + ch0 + ch * 8);
      *(uint4*)(X + (pr * 66 + r) * PITCH + ch * 8) = v;
    }
    __syncthreads();
    const float* cw = pin(p, 12) + l * 3 * 1536;
    const float* cb = pin(p, 13) + l * 1536;
    {
      const int c = tid & 127, tq = tid >> 7, col = ch0 + c;
      const float w00 = cw[col], w01 = cw[1536 + col], w02 = cw[3072 + col], b0 = cb[col];
      const float w10 = cw[512 + col], w11 = cw[1536 + 512 + col], w12 = cw[3072 + 512 + col], b1 = cb[512 + col];
      const float w20 = cw[1024 + col], w21 = cw[1536 + 1024 + col], w22 = cw[3072 + 1024 + col], b2 = cb[1024 + col];
      const u16* X0 = X, *X1 = X + 66 * PITCH, *XV = X + 2 * 66 * PITCH;
      u16* Y = (u16*)(p.ws + WS_Y);
#pragma unroll 4
      for (int tt = tq * 16; tt < tq * 16 + 16; ++tt) {
        float x0 = w00 * bf2f(X0[tt * PITCH + c]) + w01 * bf2f(X0[(tt + 1) * PITCH + c]) + w02 * bf2f(X0[(tt + 2) * PITCH + c]) + b0;
        float x1 = w10 * bf2f(X1[tt * PITCH + c]) + w11 * bf2f(X1[(tt + 1) * PITCH + c]) + w12 * bf2f(X1[(tt + 2) * PITCH + c]) + b1;
        float vv = w20 * bf2f(XV[tt * PITCH + c]) + w21 * bf2f(XV[(tt + 1) * PITCH + c]) + w22 * bf2f(XV[(tt + 2) * PITCH + c]) + b2;
        Y[(mb + t0 + tt) * 512 + col] = f2bf(x0);
        T[c * 65 + tt] = x1 * vv;
      }
    }
    __syncthreads();
    {
      float* ZV = (float*)(p.ws + WS_ZV);
#pragma unroll 4
      for (int cc = 0; cc < 16; ++cc) {
        int c = wid * 16 + cc;
        ZV[((size_t)(ch0 + c) * SP + pos0 + lane) * 2 + b] = T[c * 65 + lane];
      }
    }
    __syncthreads();
  } else {
    u16* projw = (u16*)(p.ws + WS_PROJ);
    const float* qg = pin(p, 24) + l * 384;
    const float* kg = pin(p, 26) + l * 256;
    const float2* rope = (const float2*)(p.ws + WS_ROPE);
    u16* Kb = (u16*)(p.ws + WS_K);
#pragma unroll 2
    for (int rr = 0; rr < 8; ++rr) {
      int tt = wid * 8 + rr, pos = pos0 + tt;
      u16* row = projw + ((size_t)b * SP + pos) * DINP;
      unsigned* q32 = (unsigned*)(row + OFF_Q);
      unsigned* k32 = (unsigned*)(row + OFF_KV);
      unsigned v[3], w[2];
      float ss = 0.f, s2 = 0.f;
#pragma unroll
      for (int j = 0; j < 3; ++j) v[j] = q32[lane + 64 * j];
#pragma unroll
      for (int j = 0; j < 2; ++j) w[j] = k32[lane + 64 * j];
      const int rd = lane & 31;
      float val = bf2f(row[OFF_KV + 256 + rd]);
#pragma unroll
      for (int j = 0; j < 3; ++j) { float a = bf2f(v[j] & 0xffff), c2 = bf2f(v[j] >> 16); ss += a * a + c2 * c2; }
#pragma unroll
      for (int j = 0; j < 2; ++j) { float a = bf2f(w[j] & 0xffff), c2 = bf2f(w[j] >> 16); s2 += a * a + c2 * c2; }
      ss = wave_sum(ss);
      s2 = wave_sum(s2);
      float r = rsqrtf(ss * (1.f / 384.f) + EPS), r2 = rsqrtf(s2 * (1.f / 256.f) + EPS);
#pragma unroll
      for (int j = 0; j < 3; ++j) {
        int n = (lane + 64 * j) * 2;
        q32[lane + 64 * j] = pk2(bf2f(v[j] & 0xffff) * r * qg[n], bf2f(v[j] >> 16) * r * qg[n + 1]);
      }
#pragma unroll
      for (int j = 0; j < 2; ++j) {
        int n = (lane + 64 * j) * 2;
        k32[lane + 64 * j] = pk2(bf2f(w[j] & 0xffff) * r2 * kg[n], bf2f(w[j] >> 16) * r2 * kg[n + 1]);
      }
      float partner = shx(val, 8);
      if (!isctx) {
        int t = pos - CTX, idx = (rd < 16) ? (t >> 6) : (t & 63);
        float2 cs = rope[idx * 8 + (rd & 7)];
        float sgn = (rd & 8) ? 1.f : -1.f;
        val = val * cs.x + sgn * partner * cs.y;
      }
      if (lane < 32) {
        u16 o = f2bf(val);
#pragma unroll
        for (int hd = 0; hd < 8; ++hd) Kb[((size_t)(b * 8 + hd) * SP + pos) * 96 + 64 + rd] = o;
      }
    }
  }
}

__device__ __forceinline__ int xi(int i) { const int h = i >> 5; return i ^ (((h & 3) * 5) | ((h & 2) << 3)); }
typedef float v2f __attribute__((ext_vector_type(2)));
__device__ __forceinline__ v2f cmulv(v2f a, v2f b) {
  v2f bs = {-b.y, b.x};
  return a.xx * b + a.yy * bs;
}
__device__ __forceinline__ void bf_fwd(float2* Xf, int base, int q, float2 w1f) {
  v2f* X = (v2f*)Xf;
  const v2f w1 = {w1f.x, w1f.y};
  const v2f w2 = cmulv(w1, w1), w3 = cmulv(w2, w1);
  const int i0 = xi(base), i1 = xi(base + q), i2 = xi(base + 2 * q), i3 = xi(base + 3 * q);
  v2f a0 = X[i0], a1 = X[i1], a2 = X[i2], a3 = X[i3];
  v2f s02 = a0 + a2, d02 = a0 - a2, s13 = a1 + a3, d13 = a1 - a3;
  v2f d13r = {d13.y, -d13.x};
  X[i0] = s02 + s13;
  X[i1] = cmulv(d02 + d13r, w1);
  X[i2] = cmulv(s02 - s13, w2);
  X[i3] = cmulv(d02 - d13r, w3);
}
__device__ __forceinline__ void bf_inv(float2* Xf, int base, int q, float2 w1f) {
  v2f* X = (v2f*)Xf;
  const v2f w1 = {w1f.x, -w1f.y};
  const v2f w2 = cmulv(w1, w1), w3 = cmulv(w2, w1);
  const int i0 = xi(base), i1 = xi(base + q), i2 = xi(base + 2 * q), i3 = xi(base + 3 * q);
  v2f b0 = X[i0], c1 = cmulv(X[i1], w1), c2 = cmulv(X[i2], w2), c3 = cmulv(X[i3], w3);
  v2f s02 = b0 + c2, d02 = b0 - c2, s13 = c1 + c3, d13 = c1 - c3;
  v2f d13r = {-d13.y, d13.x};
  X[i0] = s02 + s13;
  X[i1] = d02 + d13r;
  X[i2] = s02 - s13;
  X[i3] = d02 - d13r;
}
template <bool INV, int LQ>
__device__ __forceinline__ void fft_pass(float2* X, const float2* __restrict__ tw, const float2 (&twr)[6], int tid) {
  constexpr int q = 1 << LQ;
  if (LQ == 12) {
    float2 w[8];
#pragma unroll
    for (int b8 = 0; b8 < 8; ++b8) w[b8] = tw[b8 * NT + tid];
#pragma unroll
    for (int b8 = 0; b8 < 8; ++b8) { int u = b8 * NT + tid; if (INV) bf_inv(X, u, q, w[b8]); else bf_fwd(X, u, q, w[b8]); }
  } else if (LQ == 10) {
#pragma unroll 4
    for (int b8 = 0; b8 < 8; ++b8) {
      int u = b8 * NT + tid, j = u & 1023, base = ((u >> 10) << 12) + j;
      float2 w = (b8 & 1) ? twr[1] : twr[0];
      if (INV) bf_inv(X, base, q, w); else bf_fwd(X, base, q, w);
    }
  } else {
    const int j = tid & (q - 1);
    const float2 w = (LQ == 0) ? make_float2(1.f, 0.f) : twr[2 + (8 - LQ) / 2];
#pragma unroll 4
    for (int b8 = 0; b8 < 8; ++b8) {
      int u = b8 * NT + tid, base = ((u >> LQ) << (LQ + 2)) + j;
      if (INV) bf_inv(X, base, q, w); else bf_fwd(X, base, q, w);
    }
  }
  __syncthreads();
}
__device__ __forceinline__ void fft_load_tw(const float2* __restrict__ tw, int tid, float2 (&twr)[6]) {
  twr[0] = tw[tid << 2];
  twr[1] = tw[(512 + tid) << 2];
  twr[2] = tw[(tid & 255) << 4];
  twr[3] = tw[(tid & 63) << 6];
  twr[4] = tw[(tid & 15) << 8];
  twr[5] = tw[(tid & 3) << 10];
}
__device__ __forceinline__ void fft_dif(float2* X, const float2* __restrict__ tw, const float2 (&twr)[6]) {
  const int tid = tid_l();
  fft_pass<false, 12>(X, tw, twr, tid); fft_pass<false, 10>(X, tw, twr, tid); fft_pass<false, 8>(X, tw, twr, tid); fft_pass<false, 6>(X, tw, twr, tid);
  fft_pass<false, 4>(X, tw, twr, tid); fft_pass<false, 2>(X, tw, twr, tid); fft_pass<false, 0>(X, tw, twr, tid);
}
__device__ __forceinline__ void fft_dit_inv(float2* X, const float2* __restrict__ tw, const float2 (&twr)[6]) {
  const int tid = tid_l();
  fft_pass<true, 0>(X, tw, twr, tid); fft_pass<true, 2>(X, tw, twr, tid); fft_pass<true, 4>(X, tw, twr, tid); fft_pass<true, 6>(X, tw, twr, tid);
  fft_pass<true, 8>(X, tw, twr, tid); fft_pass<true, 10>(X, tw, twr, tid); fft_pass<true, 12>(X, tw, twr, tid);
}
__device__ __forceinline__ float block_sum(float v, float* red) {
  v = wave_sum(v);
  __syncthreads();
  { const int tb = tid_l(); if ((tb & 63) == 0) red[tb >> 6] = v; }
  __syncthreads();
  float s = red[0] + red[1] + red[2] + red[3] + red[4] + red[5] + red[6] + red[7];
  __syncthreads();
  return s;
}

__device__ __forceinline__ void fft_task(const Ctx& p, int l, int c, char* smem) {
  float2* X = (float2*)smem;
  float zl = 0.f;
  asm volatile("" : "+v"(zl));
  float* aux = (float*)(smem + AUX_OFF);
  float* red = aux + 128;
  const int tid = tid_l();
  const float2* tw = (const float2*)(p.ws + WS_TW);
  float2 twr[6];
  fft_load_tw(tw, tid, twr);
  const float* w3 = pin(p, 20) + (size_t)l * 64 * 1024;
  if (tid < 64) { aux[tid] = w3[tid * 1024 + c]; aux[64 + tid] = w3[tid * 1024 + 512 + c]; }
  __syncthreads();
  const float dF = fabsf(pin(p, 21)[(l * 2 + 0) * 512 + c]), dB = fabsf(pin(p, 21)[(l * 2 + 1) * 512 + c]);
  const float bias = pin(p, 22)[l * 512 + c];
  float2* zp = (float2*)(p.ws + WS_ZV) + (size_t)c * SP;
  float l1 = 0.f;
  {
    const u16* ff = (const u16*)((const char*)p.out + WO_FILT) + (size_t)c * 8192 + tid;
    const u16* fb = ff + (size_t)512 * 8192;
    u16 rf[16], rb[16];
#pragma unroll
    for (int i = 0; i < 16; ++i) { rf[i] = ff[i * NT]; rb[i] = fb[i * NT]; }
#pragma unroll
    for (int i = 0; i < 16; ++i) {
      int t = i * NT + tid;
      float tl = (float)t * (1.f / 8191.f);
      float hf = bf2f(rf[i]) * __expf(-tl * dF);
      float hb = bf2f(rb[i]) * __expf(-tl * dB);
      X[xi(t)] = make_float2(hf, 0.f);
      if (t >= 1) { X[xi(16384 - t)] = make_float2(hb, 0.f); l1 += fabsf(hf) + fabsf(hb); }
      else { X[xi(8192)] = make_float2(zl, zl); l1 += fabsf(hf); }
    }
  }
  float l1tot = block_sum(l1, red);
  fft_dif(X, tw, twr);
  float2 F[32];
  {
    float s = 1.f / (l1tot * 16384.f);
#pragma unroll
    for (int i = 0; i < 32; ++i) { float2 v = X[xi(i * NT + tid)]; F[i] = make_float2(v.x * s, v.y * s); }
  }
  __syncthreads();
#pragma unroll 8
  for (int i = 0; i < 16; ++i) {
    int t = i * NT + tid;
    X[xi(t)] = zp[CTX + t];
    X[xi(8192 + t)] = make_float2(zl, zl);
  }
  __syncthreads();
  fft_dif(X, tw, twr);
#pragma unroll
  for (int i = 0; i < 32; ++i) { int idx = xi(i * NT + tid); X[idx] = cmul(X[idx], F[i]); }
  __syncthreads();
  fft_dit_inv(X, tw, twr);
  {
    float2 zz[16];
#pragma unroll
    for (int i = 0; i < 16; ++i) zz[i] = zp[CTX + i * NT + tid];
#pragma unroll
    for (int i = 0; i < 16; ++i) {
      int t = i * NT + tid;
      float2 y = X[xi(t)];
      zp[CTX + t] = make_float2(y.x + bias * zz[i].x, y.y + bias * zz[i].y);
    }
  }
  __syncthreads();
  {
    float* hFc = (float*)smem;
    float* hBc = hFc + 256;
    float2* zc = (float2*)(hBc + 256);
    float l1c = 0.f;
    if (tid < 256) {
      int t = tid;
      const float* hc = (const float*)(p.ws + WS_HID2C) + (size_t)l * 64 * 256 + t;
      float hf = 0.f, hb = 0.f;
#pragma unroll 16
      for (int k = 0; k < 64; ++k) { float v = hc[k * 256]; hf += v * aux[k]; hb += v * aux[64 + k]; }
      float tl = (float)t * (1.f / 255.f);
      hf *= expf(-tl * dF);
      hb *= expf(-tl * dB);
      hFc[t] = hf;
      hBc[t] = hb;
      l1c = fabsf(hf) + (t >= 1 ? fabsf(hb) : 0.f);
      zc[t] = zp[t];
    }
    float l1ct = block_sum(l1c, red);
    const int bb = tid >> 8, t = tid & 255;
    float acc = 0.f;
    for (int s = 0; s < 256; ++s) {
      float kf = (s <= t) ? hFc[t - s] : hBc[s - t];
      float2 z = zc[s];
      acc += kf * (bb ? z.y : z.x);
    }
    float2 z = zc[t];
    ((float*)zp)[t * 2 + bb] = acc / l1ct + bias * (bb ? z.y : z.x);
    __syncthreads();
  }
}

constexpr int AT_KT = 128, AT_KP = 208, AT_VP = 264, AT_STAGE = AT_KT * AT_KP + 64 * AT_VP;
__device__ __forceinline__ void attn_task(const Ctx& p, int bh, int qb, char* smem) {
  const int tid = tid_l(), wid = tid >> 6, lane = tid & 63, r = lane & 31, hh = lane >> 5;
  const u16* Qp = (const u16*)(p.ws + WS_Q) + ((size_t)bh * SP + qb * 256) * 96;
  const u16* Kp = (const u16*)(p.ws + WS_K) + (size_t)bh * SP * 96;
  const u16* Vp = (const u16*)(p.ws + WS_VT) + (size_t)bh * 64 * SP;
  const int nkt = (qb == 0) ? 2 : 66;
  bf16x8 qf[6];
#pragma unroll
  for (int ks = 0; ks < 6; ++ks) qf[ks] = *(const bf16x8*)(Qp + (size_t)(wid * 32 + r) * 96 + ks * 16 + hh * 8);
  f32x16 o0, o1;
#pragma unroll
  for (int i = 0; i < 16; ++i) { o0[i] = 0.f; o1[i] = 0.f; }
  float mrun = 0.f, lrun = 0.f;
  const u16* src[5];
  int dst[5];
#pragma unroll
  for (int i = 0; i < 5; ++i) {
    int ch = tid + i * NT;
    if (i < 3) { int row = ch / 12, cc = ch - row * 12; src[i] = Kp + (size_t)row * 96 + cc * 8; dst[i] = row * AT_KP + cc * 16; }
    else { int v = ch - 1536, row = v >> 4, cc = v & 15; src[i] = Vp + (size_t)row * SP + cc * 8; dst[i] = AT_KT * AT_KP + row * AT_VP + cc * 16; }
  }
  uint4 st[5];
#define AT_LOAD(t)                                                                                   \
  do {                                                                                               \
    _Pragma("unroll") for (int i = 0; i < 5; ++i) st[i] = *(const uint4*)(src[i] + (size_t)(t) * (i < 3 ? AT_KT * 96 : AT_KT)); \
  } while (0)
#define AT_WRITE(buf)                                                                                \
  do {                                                                                               \
    char* base_ = smem + (buf) * AT_STAGE;                                                           \
    _Pragma("unroll") for (int i = 0; i < 5; ++i) {                                                  \
      uint2* d_ = (uint2*)(base_ + dst[i]);                                                          \
      d_[0] = make_uint2(st[i].x, st[i].y);                                                          \
      d_[1] = make_uint2(st[i].z, st[i].w);                                                          \
    }                                                                                                \
  } while (0)
#define AT_QK(S, kb)                                                                                 \
  __builtin_amdgcn_s_setprio(1);                                                                     \
  _Pragma("unroll") for (int ks = 0; ks < 6; ++ks) {                                                 \
    bf16x8 a_ = *(const bf16x8*)(Ks + ((kb) * 32 + r) * AT_KP + ks * 32 + hh * 16);                  \
    S = __builtin_amdgcn_mfma_f32_32x32x16_bf16(a_, qf[ks], S, 0, 0, 0);                             \
  }                                                                                                  \
  __builtin_amdgcn_s_setprio(0);
#define AT_SOFT_PV(S, kb)                                                                            \
  _Pragma("unroll") for (int i = 0; i < 16; ++i) { S[i] = __builtin_amdgcn_exp2f(S[i]); ps += S[i]; } \
  _Pragma("unroll") for (int sI = 0; sI < 2; ++sI) {                                                 \
    union { bf16x8 v; unsigned u[4]; } pu;                                                           \
    _Pragma("unroll") for (int j = 0; j < 4; ++j) pu.u[j] = pk2(S[8 * sI + 2 * j], S[8 * sI + 2 * j + 1]); \
    const int koff = ((kb) * 32 + 16 * sI + 4 * hh) * 2;                                             \
    union { bf16x8 v; uint2 h2[2]; } va, vb;                                                         \
    va.h2[0] = *(const uint2*)(Vs + r * AT_VP + koff);                                               \
    va.h2[1] = *(const uint2*)(Vs + r * AT_VP + koff + 16);                                          \
    vb.h2[0] = *(const uint2*)(Vs + (32 + r) * AT_VP + koff);                                        \
    vb.h2[1] = *(const uint2*)(Vs + (32 + r) * AT_VP + koff + 16);                                   \
    o0 = __builtin_amdgcn_mfma_f32_32x32x16_bf16(va.v, pu.v, o0, 0, 0, 0);                           \
    o1 = __builtin_amdgcn_mfma_f32_32x32x16_bf16(vb.v, pu.v, o1, 0, 0, 0);                           \
  }
  AT_LOAD(0);
  AT_WRITE(0);
  __syncthreads();
  for (int t = 0; t < nkt; ++t) {
    const int cur = t & 1;
    if (t + 1 < nkt) AT_LOAD(t + 1);
    const char* Ks = smem + cur * AT_STAGE;
    const char* Vs = Ks + AT_KT * AT_KP;
    const float nm = -mrun;
    f32x16 sA, sB;
    float ps = 0.f;
#pragma unroll
    for (int i = 0; i < 16; ++i) sA[i] = nm;
    AT_QK(sA, 0)
#pragma unroll
    for (int i = 0; i < 16; ++i) sB[i] = nm;
    AT_QK(sB, 1)
    AT_SOFT_PV(sA, 0)
#pragma unroll
    for (int i = 0; i < 16; ++i) sA[i] = nm;
    AT_QK(sA, 2)
    AT_SOFT_PV(sB, 1)
#pragma unroll
    for (int i = 0; i < 16; ++i) sB[i] = nm;
    AT_QK(sB, 3)
    AT_SOFT_PV(sA, 2)
    AT_SOFT_PV(sB, 3)
    lrun += ps;
    float pmx = fmaxf(ps, shx(ps, 32));
    if (__any(pmx > 65536.f)) {
      const float delta = pmx > 65536.f ? ceilf(__log2f(pmx)) : 0.f;
      const float alpha = __builtin_amdgcn_exp2f(-delta);
      mrun += delta;
      lrun *= alpha;
#pragma unroll
      for (int i = 0; i < 16; ++i) { o0[i] *= alpha; o1[i] *= alpha; }
    }
    if (t + 1 < nkt) AT_WRITE(cur ^ 1);
    __syncthreads();
  }
  const float ltot = lrun + shx(lrun, 32);
  const float inv = 1.f / ltot;
  const int b = bh >> 3, head = bh & 7;
  u16* Op = (u16*)(p.ws + WS_O) + ((size_t)b * SP + qb * 256 + wid * 32 + r) * 512 + head * 64;
#pragma unroll
  for (int g = 0; g < 4; ++g) {
    uint2 w0, w1;
    w0.x = pk2(o0[4 * g] * inv, o0[4 * g + 1] * inv);
    w0.y = pk2(o0[4 * g + 2] * inv, o0[4 * g + 3] * inv);
    w1.x = pk2(o1[4 * g] * inv, o1[4 * g + 1] * inv);
    w1.y = pk2(o1[4 * g + 2] * inv, o1[4 * g + 3] * inv);
    *(uint2*)(Op + 8 * g + 4 * hh) = w0;
    *(uint2*)(Op + 32 + 8 * g + 4 * hh) = w1;
  }
#undef AT_LOAD
#undef AT_WRITE
#undef AT_QK
#undef AT_SOFT_PV
}

__device__ __forceinline__ void hypost_task(const Ctx& p, int task, char* smem) {
  const int tid = tid_l(), lane = tid & 63, wid = tid >> 6;
  const int tile64 = task >> 1, ch0 = (task & 1) * 256;
  const int m0 = tile64 * 64, b = m0 / SP, pos0 = m0 - b * SP;
  float* T = (float*)smem;
  const float* ZV = (const float*)(p.ws + WS_ZV);
#pragma unroll 8
  for (int cc = 0; cc < 32; ++cc) {
    int c = wid * 32 + cc;
    T[c * 65 + lane] = ZV[((size_t)(ch0 + c) * SP + pos0 + lane) * 2 + b];
  }
  __syncthreads();
  u16* Y = (u16*)(p.ws + WS_Y);
  const int c = tid & 255, th = tid >> 8;
  u16* yp = Y + (size_t)(m0 + th * 32) * 512 + ch0 + c;
  u16 yv[32];
#pragma unroll
  for (int i = 0; i < 32; ++i) yv[i] = yp[(size_t)i * 512];
#pragma unroll
  for (int i = 0; i < 32; ++i) yp[(size_t)i * 512] = f2bf(bf2f(yv[i]) * T[c * 65 + th * 32 + i]);
  __syncthreads();
}

#ifndef PHMASK
#define PHMASK 0xFFFF
#endif
#define PHON(k) (((PHMASK) >> (k)) & 1)
constexpr int NPH = 1 + 4 * 10 + 1;
__global__ void __launch_bounds__(NT, 2) mega(Params prm) {
  __shared__ __attribute__((aligned(1024))) char smem[LDS_BYTES];
  cg::grid_group grid = cg::this_grid();
  const int bid = blockIdx.x, nb = gridDim.x;
  {
    unsigned long long* it = (unsigned long long*)(smem + AUX_OFF + 6144);
    if (threadIdx.x < 33) it[threadIdx.x] = (unsigned long long)prm.in[threadIdx.x];
    if (threadIdx.x == 0) *(uint4*)(smem + AUX_OFF + 7168) = make_uint4(0u, 0u, 0u, 0u);
    __syncthreads();
  }
  XcdBarrier xbar = xcd_barrier_post((unsigned*)(prm.ws + WS_BAR), (volatile LAS unsigned*)(smem + AUX_OFF + 7168));
  if (prm.ph_lo == 0) {
    Ctx p;
    p.intab = (const unsigned long long*)(smem + AUX_OFF + 6144);
    p.ws = prm.ws;
    p.out = prm.out;
    const int bid = blockIdx.x, nb = gridDim.x;
      if (PHON(10)) {
      p0_misc(p);
      for (int t = bid; t < 192; t += nb) p0_mod_task(p, t, smem);
      for (int t = bid; t < 528; t += nb) p0_hid_task(p, t, smem);
      for (int t = bid; t < 128; t += nb) { const int w = (t + 64) & 127; wpe_task(p, w >> 5, w & 31, smem); }
      }
  }
  unsigned nbar = 0;
  for (int ph = prm.ph_lo; ph < prm.ph_hi; ++ph) {
    Ctx p;
    p.intab = (const unsigned long long*)(smem + AUX_OFF + 6144);
    p.ws = prm.ws;
    p.out = prm.out;
    asm volatile("" : "+s"(p.ws), "+s"(p.out));
    float* modall = (float*)(p.ws + WS_MOD);
    u16* proj = (u16*)(p.ws + WS_PROJ);
    u16* xn = (u16*)(p.ws + WS_U);
    char* wo = (char*)p.out;
    if (ph == 0) {
    } else if (ph == NPH - 1) {
      if (PHON(11)) final_norm(p);
    } else {
      const int l = (ph - 1) / 10, sp = (ph - 1) % 10;
      const float* modl = modall + (size_t)l * 3 * 6144;
      GD* tab = (GD*)(smem + AUX_OFF + 4096);
      int ng = 0, nN0 = 0, nN1 = 0, nsplit = 1;
      const bool last = (l == 3);
      const float* gate = modl;
      if (sp == 0 && PHON(0)) {
        wt_phase(p, l, smem);
        norm_rows(p, pin(p, 6) + l * 1024, modl, 0, 1, xn);
      } else if (sp == 1 && PHON(1)) {
        if (threadIdx.x == 0) tab[0] = GD{xn, 1024, (const u16*)(wo + WO_IN), 1024, 1024, 23, EM_PROJ, 1};
        ng = 1; nN0 = 23;
      } else if (sp == 2 && PHON(2)) {
        for (int t = bid; t < 264 * 6; t += nb) premix_task(p, l, t, smem);
        {
          Epi ef{EM_FILT, p.ws, gate, nullptr, (u16*)(wo + WO_FILT)};
          const u16* hA = (const u16*)(p.ws + WS_HID2) + (size_t)l * 8192 * 64;
          const u16* wB = (const u16*)(p.ws + WS_W3T) + (size_t)l * 1024 * 64;
#pragma unroll 1
          for (int t = nb - 1 - bid; t < 128; t += nb) gemm_tile(hA, 64, wB, 64, 64, (t >> 2) * 256, (t & 3) * 256, smem, ef);
        }
      } else if (sp == 3 && PHON(3)) {
        for (int t = bid; t < 512; t += nb) fft_task(p, l, t, smem);
        if (threadIdx.x == 0) {
          tab[0] = GD{proj + OFF_Q, DINP, (const u16*)(wo + WO_UQ), 384, 384, 3, EM_Q, 1};
          tab[1] = GD{proj + OFF_KV, DINP, (const u16*)(wo + WO_UKV), 256, 256, 4, EM_KV, 1};
        }
        ng = 2; nN0 = 3; nN1 = 4;
        for (int i = tid_l(); i < 1024; i += NT) ((float2*)(smem + 131072))[i] = ((const float2*)(p.ws + WS_ROPE))[i];
      } else if (sp == 4 && PHON(4)) {
        for (int t = bid; t < (last ? 512 : 528); t += nb) {
          int bh, qb;
          if (t < 512) { int rnd = t >> 8, w = t & 255; bh = (w & 7) + 8 * rnd; qb = 1 + (w >> 3); }
          else { bh = t - 512; qb = 0; }
          attn_task(p, bh, qb, smem);
        }
        for (int t = bid; t < 528; t += nb) hypost_task(p, t, smem);
      } else if (sp == 5 && PHON(5)) {
        for (int t = bid; t < (last ? 512 : 544); t += nb) {
          if (t < 512) {
            const int x = t & 7, g = t >> 3, pmi = (g >> 2) * 8 + x, pm = pmi + 2 + (pmi >= 64 ? 2 : 0);
            mix_tile<4>(p, l, pm * 128, g & 3, smem);
          } else {
            const int c = t - 512, cm = c >> 2;
            mix_tile<2>(p, l, (cm >> 2) * SP + (cm & 3) * 64, c & 3, smem);
          }
        }
      } else if (sp == 6 && PHON(6)) {
        if (threadIdx.x == 0) tab[0] = GD{(const u16*)(p.ws + WS_ZV), 1024, (const u16*)(wo + WO_OUT), 1024, 1024, 4, EM_RESID, 4};
        ng = 1; nN0 = 4; nsplit = 4;
        gate = modl + 2 * 1024;
      } else if (sp == 7 && PHON(7)) {
        norm_rows(p, pin(p, 7) + l * 1024, modl, 3, 4, xn);
      } else if (sp == 8 && PHON(8)) {
        if (threadIdx.x == 0) tab[0] = GD{xn, 1024, (const u16*)(wo + WO_FF1), 1024, 1024, 16, EM_SQRELU, last ? 2 : 1};
        ng = 1; nN0 = 16; nsplit = last ? 2 : 1;
      } else if (sp == 9 && PHON(9)) {
        if (threadIdx.x == 0) tab[0] = GD{proj, DFF, (const u16*)(wo + WO_FF2), 4096, 4096, 4, EM_RESID, 8};
        ng = 1; nN0 = 4; nsplit = 8;
        gate = modl + 5 * 1024;
      }
      if (ng > 0) {
        __syncthreads();
        const int nt0 = (nsplit > 1) ? (64 * nN0 + (last ? 0 : 2 * nN0 * nsplit)) : NMT * nN0, ntot = nt0 + NMT * nN1;
#pragma unroll 1
        for (int t = bid; t < ntot; t += nb) {
          int gi = 0, tt = t;
          if (t >= nt0) { gi = 1; tt = t - nt0; }
          const volatile GD* gp = tab + gi;
          unsigned long long a64 = (unsigned long long)gp->A, b64 = (unsigned long long)gp->Bt;
          a64 = ((unsigned long long)(unsigned)__builtin_amdgcn_readfirstlane((unsigned)(a64 >> 32)) << 32) | (unsigned long long)(unsigned)__builtin_amdgcn_readfirstlane((unsigned)a64);
          b64 = ((unsigned long long)(unsigned)__builtin_amdgcn_readfirstlane((unsigned)(b64 >> 32)) << 32) | (unsigned long long)(unsigned)__builtin_amdgcn_readfirstlane((unsigned)b64);
          const int lda = __builtin_amdgcn_readfirstlane(gp->lda), ldb = __builtin_amdgcn_readfirstlane(gp->ldb);
          const int K = __builtin_amdgcn_readfirstlane(gp->K), nN = __builtin_amdgcn_readfirstlane(gp->nN);
          const int ks = __builtin_amdgcn_readfirstlane(gp->ks);
          const int mode = __builtin_amdgcn_readfirstlane(gp->mode);
          int pm, pn, Kuse = K, emode = mode;
          if (ks > 1) {
            const int nlat = 64 * nN;
            if (tt < nlat) { int pm64; tile_map(tt, 64, nN, pm64, pn); pm = (pm64 >> 5) * 33 + 1 + (pm64 & 31); }
            else {
              int u = tt - nlat, kp = u % ks, tile = u / ks;
              pm = (tile / nN) * 33; pn = tile % nN;
              Kuse = K / ks; emode = EM_RESID_AT;
              a64 += (unsigned long long)kp * Kuse * 2; b64 += (unsigned long long)kp * Kuse * 2;
            }
          } else tile_map(tt, NMT, nN, pm, pn);
          Epi e{emode, p.ws, gate, (const float2*)(smem + 131072), nullptr};
          gemm_tile((const u16*)a64, lda, (const u16*)b64, ldb, Kuse, pm * 256, pn * 256, smem, e);
        }
      }
    }
    if (ph + 1 < prm.ph_hi) {
      if (ph == prm.ph_lo) grid.sync();
      else xcd_barrier(xbar);
    }
  }
}

extern "C" void kernel_launch(void* const* d_in, const int* in_sizes, int n_in, void* d_out, int out_size, void* d_ws,
                              size_t ws_size, hipStream_t stream) {
  static int grid_blocks = 0;
  if (grid_blocks == 0) {
    if (n_in != 33 || ws_size < WS_END || (size_t)out_size * 4 < WO_END) {
      fprintf(stderr, "kernel_launch: unexpected sizes n_in=%d ws=%zu (need %zu) out=%d\n", n_in, ws_size, (size_t)WS_END, out_size);
      grid_blocks = -1;
      return;
    }
    int dev = 0, cus = 0, per_cu = 0;
    hipGetDevice(&dev);
    hipDeviceGetAttribute(&cus, hipDeviceAttributeMultiprocessorCount, dev);
    hipOccupancyMaxActiveBlocksPerMultiprocessor(&per_cu, mega, NT, 0);
    if (per_cu < 1) per_cu = 1;
    if (per_cu > 1) per_cu = 1;
    grid_blocks = cus * per_cu;
  }
  if (grid_blocks < 0) return;
  Params p{};
  for (int i = 0; i < 33; ++i) p.in[i] = (const float*)d_in[i];
  p.out = (float*)d_out;
  p.ws = (char*)d_ws;
  p.ph_lo = 0;
  p.ph_hi = NPH;
  (void)hipMemsetAsync((char*)d_ws + WS_BAR, 0, 16384, stream);
  void* args[] = {&p};
  hipError_t e = hipLaunchCooperativeKernel((void*)mega, dim3(grid_blocks), dim3(NT), args, 0, stream);
  if (e != hipSuccess) fprintf(stderr, "cooperative launch failed: %s (grid %d)\n", hipGetErrorString(e), grid_blocks);
}
```

```cpp
#include <hip/hip_runtime.h>
#include <hip/hip_cooperative_groups.h>
#include <cstdio>
namespace cg = cooperative_groups;

typedef unsigned short u16;
using bf16x8 = __attribute__((ext_vector_type(8))) short;
using f32x4 = __attribute__((ext_vector_type(4))) float;
using f32x16 = __attribute__((ext_vector_type(16))) float;

constexpr int D = 1024, SEQ = 8192, CTX = 256, SP = 8448, MROWS = 16896, NMT = 66;
constexpr int DIN = 5792, DINP = 5888, DFF = 4096;
constexpr int OFF_HY = 512, OFF_Q = 2048, OFF_KV = 2432, OFF_GATE = 2720;
constexpr int NT = 512;
constexpr float EPS = 1e-6f;

constexpr size_t WS_H = 0;
constexpr size_t WS_PROJ = WS_H + (size_t)MROWS * D * 4;
constexpr size_t WS_U = WS_PROJ + (size_t)MROWS * DINP * 2;
constexpr size_t WS_Y = WS_U + (size_t)MROWS * 512 * 2;
constexpr size_t WS_O = WS_Y + (size_t)MROWS * 512 * 2;
constexpr size_t WS_Q = WS_O + (size_t)MROWS * 512 * 2;
constexpr size_t WS_K = WS_Q + (size_t)16 * SP * 96 * 2;
constexpr size_t WS_VT = WS_K + (size_t)16 * SP * 96 * 2;
constexpr size_t WS_ZV = WS_VT + (size_t)16 * 64 * SP * 2;
constexpr size_t WS_HID2 = WS_ZV + (size_t)512 * SP * 8;
constexpr size_t WS_HID2C = WS_HID2 + (size_t)4 * 8192 * 64 * 4;
constexpr size_t WS_MOD = WS_HID2C + (size_t)4 * 256 * 64 * 4;
constexpr size_t WS_ROPE = WS_MOD + (size_t)4 * 3 * 6144 * 4;
constexpr size_t WS_TW = WS_ROPE + (size_t)128 * 8 * 8;
constexpr size_t WS_WPE = WS_TW + (size_t)16384 * 8;
constexpr size_t WS_BAR = WS_WPE + (size_t)4 * 1024 * 512 * 2;
constexpr size_t WS_END = WS_BAR + 16384;
constexpr size_t WO_IN = 0;
constexpr size_t WO_FF1 = WO_IN + (size_t)DINP * 1024 * 2;
constexpr size_t WO_FF2 = WO_FF1 + (size_t)4096 * 1024 * 2;
constexpr size_t WO_OUT = WO_FF2 + (size_t)4096 * 1024 * 2;
constexpr size_t WO_HY = WO_OUT + (size_t)1024 * 1024 * 2;
constexpr size_t WO_WO = WO_HY + (size_t)1024 * 512 * 2;
constexpr size_t WO_PE = WO_WO + (size_t)1024 * 512 * 2;
constexpr size_t WO_UQ = WO_PE + (size_t)1024 * 512 * 2;
constexpr size_t WO_UKV = WO_UQ + (size_t)768 * 384 * 2;
constexpr size_t WO_FILT = WO_UKV + (size_t)1024 * 256 * 2;
constexpr size_t WO_END = WO_FILT + (size_t)1024 * 8192 * 2;
constexpr size_t WS_W3T = WS_HID2 + (size_t)4 * 8192 * 64 * 2;

constexpr int AUX_OFF = 147456;
constexpr int LDS_BYTES = AUX_OFF + 8192;

struct Params {
  const float* in[33];
  float* out;
  char* ws;
  int ph_lo, ph_hi;
};

struct Ctx { const unsigned long long* intab; char* ws; float* out; };
__device__ __forceinline__ const float* pin(const Ctx& c, int i) {
  unsigned long long v = c.intab[i];
  unsigned lo = __builtin_amdgcn_readfirstlane((unsigned)v), hi = __builtin_amdgcn_readfirstlane((unsigned)(v >> 32));
  return (const float*)(((unsigned long long)hi << 32) | lo);
}

typedef __bf16 hwbf2 __attribute__((ext_vector_type(2)));
typedef float hwf2 __attribute__((ext_vector_type(2)));
__device__ __forceinline__ unsigned pk2(float a, float b) {
  hwf2 v = {a, b};
  hwbf2 r = __builtin_convertvector(v, hwbf2);
  return __builtin_bit_cast(unsigned, r);
}
__device__ __forceinline__ u16 f2bf(float f) { return (u16)(pk2(f, 0.f) & 0xffffu); }
__device__ __forceinline__ float bf2f(u16 b) { return __uint_as_float(((unsigned)b) << 16); }
__device__ __forceinline__ float shx(float v, int o) {
  int l = __builtin_amdgcn_mbcnt_hi(~0u, __builtin_amdgcn_mbcnt_lo(~0u, 0u));
  asm volatile("" : "+v"(l));
  return __int_as_float(__builtin_amdgcn_ds_bpermute((l ^ o) << 2, __float_as_int(v)));
}
__device__ __forceinline__ float wave_sum(float v) {
#pragma unroll
  for (int o = 1; o < 64; o <<= 1) v += shx(v, o);
  return v;
}
__device__ __forceinline__ int grp_of_row(int m) {
  int tile = m >> 8, b = tile / 33, t33 = tile - b * 33;
  return t33 == 0 ? 2 : b;
}
__device__ __forceinline__ float2 cmul(float2 a, float2 b) { return make_float2(a.x * b.x - a.y * b.y, a.x * b.y + a.y * b.x); }

__device__ __forceinline__ int tid_l() { int t = threadIdx.x; asm volatile("" : "+v"(t)); return t; }
#define XB_TMO      128
#define XB_XCNT(j)  (256  + 64 * (j))
#define XB_XSUB(j)  (1280 + 64 * (j))
#define XB_XGEN(j)  (2304 + 64 * (j))
#define XB_TOP      3328
#define XB_TOPGEN   3392
#define XCD_BAR_WORDS 3456
#define XB_SPIN_CAP (1u << 18)
#define LAS __attribute__((address_space(3)))
__device__ __forceinline__ unsigned xb_ld(unsigned* p)              { return __hip_atomic_load(p, __ATOMIC_RELAXED, __HIP_MEMORY_SCOPE_AGENT); }
__device__ __forceinline__ unsigned xb_add(unsigned* p, unsigned v) { return __hip_atomic_fetch_add(p, v, __ATOMIC_RELAXED, __HIP_MEMORY_SCOPE_AGENT); }
__device__ __forceinline__ unsigned xb_xcc_id() { return (unsigned)__builtin_amdgcn_s_getreg((3 << 11) | 20) & 0xFu; }
#define XB_SPIN(cond, bar) do { unsigned _sp = 0; while (cond) { __builtin_amdgcn_s_sleep(1); \
    if ((++_sp & 255u) == 0u) { if (xb_ld(&(bar)[XB_TMO])) break; if (_sp > XB_SPIN_CAP) { atomicAdd(&(bar)[XB_TMO], 1u); break; } } } } while (0)
struct XcdBarrier { unsigned* bar; unsigned x; volatile LAS unsigned* st; };
__device__ __forceinline__ XcdBarrier xcd_barrier_post(unsigned* bar, volatile LAS unsigned* st) {
    XcdBarrier b; b.bar = bar; b.x = xb_xcc_id(); b.st = st;
    if (threadIdx.x == 0) (void)xb_add(&bar[XB_XCNT(b.x)], 1u);
    return b;
}
__device__ __forceinline__ void xcd_barrier_complete(unsigned* bar, unsigned x, unsigned& nloc, unsigned& nx) {
    const unsigned G = gridDim.x * gridDim.y * gridDim.z;
    unsigned sum, cnt, mine, sp = 0u;
    for (;;) {
        sum = 0u; cnt = 0u; mine = 0u;
#pragma unroll
        for (unsigned j = 0; j < 16; ++j) { const unsigned c = xb_ld(&bar[XB_XCNT(j)]); sum += c; cnt += (c > 0u) ? 1u : 0u; mine = (j == x) ? c : mine; }
        if (sum == G) break;
        __builtin_amdgcn_s_sleep(1);
        if ((++sp & 255u) == 0u) { if (xb_ld(&bar[XB_TMO])) break; if (sp > XB_SPIN_CAP) { atomicAdd(&bar[XB_TMO], 1u); break; } }
    }
    nloc = mine > 0u ? mine : 1u; nx = cnt > 0u ? cnt : 1u;
}
__device__ __forceinline__ void xcd_barrier(const XcdBarrier& b) {
    asm volatile("s_waitcnt vmcnt(0)" ::: "memory");
    __syncthreads();
    if (threadIdx.x == 0) {
        unsigned* bar = b.bar;
        __builtin_amdgcn_s_waitcnt(0);
        unsigned nloc = b.st[0], nx = b.st[1];
        if (nloc == 0u) { xcd_barrier_complete(bar, b.x, nloc, nx); b.st[0] = nloc; b.st[1] = nx; }
        const unsigned old = xb_add(&bar[XB_XSUB(b.x)], 1u);
        const unsigned gen = old / nloc;
        if (old + 1u == (gen + 1u) * nloc) {
            __builtin_amdgcn_fence(__ATOMIC_RELEASE, "agent");
            asm volatile("s_waitcnt vmcnt(0)" ::: "memory");
            const unsigned og = xb_add(&bar[XB_TOP], 1u);
            const unsigned tg = og / nx;
            if (og + 1u == (tg + 1u) * nx) xb_add(&bar[XB_TOPGEN], 1u);
            else XB_SPIN(xb_ld(&bar[XB_TOPGEN]) == tg, bar);
            __builtin_amdgcn_fence(__ATOMIC_ACQUIRE, "agent");
            xb_add(&bar[XB_XGEN(b.x)], 1u);
            asm volatile("s_waitcnt vmcnt(0)" ::: "memory");
        } else {
            XB_SPIN(xb_ld(&bar[XB_XGEN(b.x)]) == gen, bar);
            __builtin_amdgcn_fence(__ATOMIC_ACQUIRE, "agent");
            asm volatile("s_waitcnt vmcnt(0)" ::: "memory");
        }
    }
    __syncthreads();
}

__device__ __forceinline__ void grid_barrier(unsigned* bar, unsigned target) {
  asm volatile("s_waitcnt vmcnt(0)" ::: "memory");
  __syncthreads();
  if (threadIdx.x == 0) {
    __builtin_amdgcn_fence(__ATOMIC_RELEASE, "agent");
    asm volatile("s_waitcnt vmcnt(0)" ::: "memory");
    __hip_atomic_fetch_add(bar, 1u, __ATOMIC_RELAXED, __HIP_MEMORY_SCOPE_AGENT);
    while (__hip_atomic_load(bar, __ATOMIC_RELAXED, __HIP_MEMORY_SCOPE_AGENT) < target) __builtin_amdgcn_s_sleep(2);
    __builtin_amdgcn_fence(__ATOMIC_ACQUIRE, "agent");
    asm volatile("s_waitcnt vmcnt(0)" ::: "memory");
  }
  __syncthreads();
}
#define WAIT_V(n) asm volatile("s_waitcnt vmcnt(%0)" ::"n"(n) : "memory")
#define SCHED() __builtin_amdgcn_sched_barrier(0)
#define RAW_BARRIER() do { asm volatile("s_waitcnt lgkmcnt(0)" ::: "memory"); __builtin_amdgcn_s_barrier(); } while (0)

constexpr float QSCALE = 0.10206207261596575f * 1.4426950408889634f;
enum { EM_PROJ = 0, EM_SQRELU = 1, EM_RESID = 2, EM_RESID_AT = 3, EM_FILT = 4, EM_Q = 6, EM_KV = 7 };
struct Epi {
  int mode;
  char* ws;
  const float* gate;
  const float2* rope_lds;
  u16* filt_out;
  __device__ __forceinline__ void proj(int row, int col, f32x4 v) const {
    {
      u16* out = (u16*)(ws + WS_PROJ);
#pragma unroll
      for (int j = 0; j < 4; ++j) out[(size_t)(row + j) * DINP + col] = f2bf(v[j]);
    }
  }
  __device__ __forceinline__ void sqrelu(int row, int col, f32x4 v) const {
    {
      u16* out = (u16*)(ws + WS_PROJ);
#pragma unroll
      for (int j = 0; j < 4; ++j) { float r = fmaxf(v[j], 0.f); out[(size_t)(row + j) * DFF + col] = f2bf(r * r); }
    }
  }
  __device__ __forceinline__ void resid(int row, int col, f32x4 v) const {
    {
      float* h = (float*)(ws + WS_H);
      float g = gate[grp_of_row(row) * 6144 + col];
#pragma unroll
      for (int j = 0; j < 4; ++j) unsafeAtomicAdd(h + (size_t)(row + j) * D + col, g * v[j]);
    }
  }
  __device__ __forceinline__ void filt(int row, int col, f32x4 v) const {
    uint2 o;
    o.x = pk2(v[0], v[1]);
    o.y = pk2(v[2], v[3]);
    *(uint2*)(filt_out + (size_t)col * 8192 + row) = o;
  }
  __device__ __forceinline__ void q(int row, int col, f32x4 v) const {
    {
      u16* Q = (u16*)(ws + WS_Q);
      const float2* rope = rope_lds;
      int head = col / 96, d = col - head * 96;
      int b = row / SP, pos0 = row - b * SP;
      bool isrope = (d >= 64) && (pos0 >= CTX);
      int rd = d - 64;
#pragma unroll
      for (int j = 0; j < 4; ++j) {
        float val = v[j];
        float partner = shx(val, 8);
        int pos = pos0 + j;
        if (isrope) {
          int t = pos - CTX, idx = (rd < 16) ? (t >> 6) : (t & 63);
          float2 cs = rope[idx * 8 + (rd & 7)];
          float sgn = (rd & 8) ? 1.f : -1.f;
          val = val * cs.x + sgn * partner * cs.y;
        }
        Q[((size_t)(b * 8 + head) * SP + pos) * 96 + d] = f2bf(val * QSCALE);
      }
    }
  }
  __device__ __forceinline__ void kv(int row, int col, f32x4 v) const {
    {
      u16* Kb = (u16*)(ws + WS_K);
      u16* Vt = (u16*)(ws + WS_VT);
      int head = col >> 7, j2 = col & 127;
      int b = row / SP, pos0 = row - b * SP;
      if (j2 < 64) {
#pragma unroll
        for (int j = 0; j < 4; ++j) Kb[((size_t)(b * 8 + head) * SP + pos0 + j) * 96 + j2] = f2bf(v[j]);
      } else {
        uint2 o;
        o.x = pk2(v[0], v[1]);
        o.y = pk2(v[2], v[3]);
        *(uint2*)(Vt + ((size_t)(b * 8 + head) * 64 + (j2 - 64)) * SP + pos0) = o;
      }
    }
  }
};
struct GD { const u16* A; int lda; const u16* Bt; int ldb; int K; int nN; int mode; int ks; };

constexpr int G_TILE_B = 256 * 64 * 2, G_STAGE_B = 2 * G_TILE_B;
__device__ __forceinline__ int lds_byte(int r, int c) {
  int st = (r >> 4) * 2 + (c >> 5), ob = (r & 15) * 64 + (c & 31) * 2;
  return st * 1024 + (ob ^ (((ob >> 9) & 1) << 5));
}
__device__ __forceinline__ void stage_rc(int b, int& R, int& C) {
  int st = b >> 10, sb = b & 1023, swz = sb ^ (((sb >> 9) & 1) << 5);
  R = (st / 2) * 16 + swz / 64;
  C = (st % 2) * 32 + (swz % 64) / 2;
}

template <int MI>
__device__ __forceinline__ void gemm_core(const u16* __restrict__ A, int lda, const u16* __restrict__ Bt, int ldb, int K,
                                          int brow, int bcol, char* shm, f32x4 (&acc)[MI][4]) {
  constexpr int TILE_A = MI * 32 * 64 * 2, TILE_BB = 256 * 64 * 2, STAGE = TILE_A + TILE_BB;
  const int tid = tid_l(), wid = tid >> 6, lane = tid & 63, wr = wid >> 2, wc = wid & 3, fr = lane & 15, fq = lane >> 4;
  const u16* Ab = A + (size_t)brow * lda;
  const u16* Bb = Bt + (size_t)bcol * ldb;
  int sR[4], sC[4];
#pragma unroll
  for (int i = 0; i < 4; ++i) stage_rc(wid * 1024 + i * 8192 + lane * 16, sR[i], sC[i]);
#define SA(b) (shm + (b) * STAGE)
#define SB(b) (shm + (b) * STAGE + TILE_A)
#define GLDS_STAGE(buf, kt)                                                                                              \
  do {                                                                                                                   \
    _Pragma("unroll") for (int i = 0; i < 4; ++i) {                                                                      \
      if (i < MI / 2)                                                                                                    \
        __builtin_amdgcn_global_load_lds((const unsigned*)(Ab + (size_t)sR[i] * lda + (kt) * 64 + sC[i]),                \
                                         (unsigned*)(SA(buf) + wid * 1024 + i * 8192), 16, 0, 0);                        \
      __builtin_amdgcn_global_load_lds((const unsigned*)(Bb + (size_t)sR[i] * ldb + (kt) * 64 + sC[i]),                  \
                                       (unsigned*)(SB(buf) + wid * 1024 + i * 8192), 16, 0, 0);                          \
    }                                                                                                                    \
  } while (0)
  const int nt = K / 64;
  GLDS_STAGE(0, 0);
  WAIT_V(0);
  __syncthreads();
  for (int t = 0; t < nt; ++t) {
    const int cur = t & 1;
    if (t + 1 < nt) GLDS_STAGE(cur ^ 1, t + 1);
    __builtin_amdgcn_iglp_opt(1);
#pragma unroll
    for (int ks = 0; ks < 2; ++ks) {
      bf16x8 At[MI], Bf[4];
#pragma unroll
      for (int m = 0; m < MI; ++m) At[m] = *(const bf16x8*)(SA(cur) + lds_byte(wr * (MI * 16) + m * 16 + fr, ks * 32 + fq * 8));
#pragma unroll
      for (int n = 0; n < 4; ++n) Bf[n] = *(const bf16x8*)(SB(cur) + lds_byte(wc * 64 + n * 16 + fr, ks * 32 + fq * 8));
#pragma unroll
      for (int m = 0; m < MI; ++m)
#pragma unroll
        for (int n = 0; n < 4; ++n) acc[m][n] = __builtin_amdgcn_mfma_f32_16x16x32_bf16(At[m], Bf[n], acc[m][n], 0, 0, 0);
    }
    WAIT_V(0);
    __syncthreads();
  }
#undef SA
#undef SB
#undef GLDS_STAGE
}

template <class EpiT>
__device__ __forceinline__ void gemm_tile(const u16* __restrict__ A, int lda, const u16* __restrict__ Bt, int ldb, int K,
                                          int brow, int bcol, char* shm, const EpiT& epi) {
  const int tid = tid_l(), wid = tid >> 6, lane = tid & 63, wr = wid >> 2, wc = wid & 3, fr = lane & 15, fq = lane >> 4;
  f32x4 acc[8][4];
#pragma unroll
  for (int m = 0; m < 8; ++m)
#pragma unroll
    for (int n = 0; n < 4; ++n) acc[m][n] = (f32x4){0.f, 0.f, 0.f, 0.f};
  gemm_core<8>(A, lda, Bt, ldb, K, brow, bcol, shm, acc);
#define EPI_LOOP(CALL)                                                                              \
  _Pragma("unroll") for (int m = 0; m < 8; ++m) _Pragma("unroll") for (int n = 0; n < 4; ++n) {      \
    const int row = brow + wr * 128 + m * 16 + fq * 4, col = bcol + wc * 64 + n * 16 + fr;           \
    const f32x4 v = acc[m][n];                                                                        \
    CALL;                                                                                             \
  }
  if (epi.mode == EM_PROJ) { EPI_LOOP(epi.proj(row, col, v)) }
  else if (epi.mode == EM_SQRELU) { EPI_LOOP(epi.sqrelu(row, col, v)) }
  else if (epi.mode == EM_RESID_AT) { EPI_LOOP(epi.resid(row, col, v)) }
  else if (epi.mode == EM_RESID) {
    float* h = (float*)(epi.ws + WS_H);
    float g4[4];
#pragma unroll
    for (int n = 0; n < 4; ++n) g4[n] = epi.gate[grp_of_row(brow) * 6144 + bcol + wc * 64 + n * 16 + fr];
    float hv[8][4][4];
    float* hp0 = h + (size_t)(brow + wr * 128 + fq * 4) * D + bcol + wc * 64 + fr;
#define H_LOAD(m) _Pragma("unroll") for (int n = 0; n < 4; ++n) _Pragma("unroll") for (int j = 0; j < 4; ++j) hv[m][n][j] = hp0[(size_t)((m) * 16 + j) * D + n * 16]
#define H_STORE(m) _Pragma("unroll") for (int n = 0; n < 4; ++n) _Pragma("unroll") for (int j = 0; j < 4; ++j) hp0[(size_t)((m) * 16 + j) * D + n * 16] = hv[m][n][j] + g4[n] * acc[m][n][j]
    H_LOAD(0); H_LOAD(1);
    SCHED();
    H_STORE(0); H_LOAD(2); SCHED();
    H_STORE(1); H_LOAD(3); SCHED();
    H_STORE(2); H_LOAD(4); SCHED();
    H_STORE(3); H_LOAD(5); SCHED();
    H_STORE(4); H_LOAD(6); SCHED();
    H_STORE(5); H_LOAD(7); SCHED();
    H_STORE(6); H_STORE(7);
#undef H_LOAD
#undef H_STORE
  }
  else if (epi.mode == EM_FILT) { EPI_LOOP(epi.filt(row, col, v)) }
  else if (epi.mode == EM_Q) { EPI_LOOP(epi.q(row, col, v)) }
  else { EPI_LOOP(epi.kv(row, col, v)) }
#undef EPI_LOOP
}

template <int MI>
__device__ __forceinline__ void mix_tile(const Ctx& p, int l, int brow, int pn, char* shm) {
  constexpr int TILE_A = MI * 32 * 64 * 2, TILE_BB = 256 * 64 * 2, STAGE = TILE_A + TILE_BB, WROWS = MI * 16;
  const int tid = tid_l(), wid = tid >> 6, lane = tid & 63, wr = wid >> 2, wc = wid & 3, fr = lane & 15, fq = lane >> 4;
  const int bcol = pn * 256;
  const u16* projb = (const u16*)(p.ws + WS_PROJ);
  char* wo = (char*)p.out;
#define SA(b) (shm + (b) * STAGE)
#define SB(b) (shm + (b) * STAGE + TILE_A)
#define MIX_STAGE(buf, kt)                                                                                               \
  do {                                                                                                                   \
    const int br_ = (kt) >> 3, ko_ = ((kt) & 7) * 64;                                                                    \
    const u16* Ab_ = (const u16*)(p.ws + (br_ == 0 ? WS_U : br_ == 1 ? WS_Y : WS_O)) + (size_t)brow * 512 + ko_;         \
    const u16* Bb_ = (br_ == 0 ? (const u16*)(p.ws + WS_WPE) + (size_t)l * 1024 * 512 : (const u16*)(wo + (br_ == 1 ? WO_HY : WO_WO))) + (size_t)bcol * 512 + ko_;        \
    _Pragma("unroll") for (int i = 0; i < 4; ++i) {                                                                      \
      int sR_, sC_; stage_rc(wid * 1024 + i * 8192 + lane * 16, sR_, sC_);                                              \
      if (i < MI / 2)                                                                                                    \
        __builtin_amdgcn_global_load_lds((const unsigned*)(Ab_ + sR_ * 512 + sC_),                           \
                                         (unsigned*)(SA(buf) + wid * 1024 + i * 8192), 16, 0, 0);                        \
      __builtin_amdgcn_global_load_lds((const unsigned*)(Bb_ + sR_ * 512 + sC_),                             \
                                       (unsigned*)(SB(buf) + wid * 1024 + i * 8192), 16, 0, 0);                          \
    }                                                                                                                    \
  } while (0)
  f32x4 tot[MI][4], acc[MI][4];
#pragma unroll
  for (int m = 0; m < MI; ++m)
#pragma unroll
    for (int n = 0; n < 4; ++n) { tot[m][n] = (f32x4){0.f, 0.f, 0.f, 0.f}; acc[m][n] = (f32x4){0.f, 0.f, 0.f, 0.f}; }
  MIX_STAGE(0, 0);
  MIX_STAGE(1, 1);
  WAIT_V(6);
  RAW_BARRIER();
  int cur = 0;
#pragma unroll 1
  for (int br = 0; br < 3; ++br) {
    unsigned gpk[MI][4][2];
    const u16* gp = projb + (size_t)(brow + wr * WROWS + fq * 4) * DINP + OFF_GATE + br * 1024 + bcol + wc * 64 + fr;
#define GATE_LOAD(m)                                                                                   \
    _Pragma("unroll") for (int n = 0; n < 4; ++n) _Pragma("unroll") for (int j2 = 0; j2 < 2; ++j2) {       \
      unsigned lo = gp[(size_t)((m) * 16 + 2 * j2) * DINP + n * 16], hi = gp[(size_t)((m) * 16 + 2 * j2 + 1) * DINP + n * 16]; \
      gpk[m][n][j2] = lo | (hi << 16);                                                                     \
    }
    GATE_LOAD(0); GATE_LOAD(1);
    if (MI == 4) { GATE_LOAD(2); }
#pragma unroll 1
    for (int kk = 0; kk < 8; ++kk) {
      const int t = br * 8 + kk;
      { int nx = cur + 2; if (nx >= 3) nx -= 3; if (t + 2 < 24) MIX_STAGE(nx, t + 2); }
      __builtin_amdgcn_iglp_opt(1);
#pragma unroll
      for (int ks = 0; ks < 2; ++ks) {
        bf16x8 At[2], Bf[4];
#pragma unroll
        for (int n = 0; n < 4; ++n) Bf[n] = *(const bf16x8*)(SB(cur) + lds_byte(wc * 64 + n * 16 + fr, ks * 32 + fq * 8));
#pragma unroll
        for (int mh = 0; mh < MI / 2; ++mh) {
#pragma unroll
          for (int m = 0; m < 2; ++m) At[m] = *(const bf16x8*)(SA(cur) + lds_byte(wr * WROWS + (mh * 2 + m) * 16 + fr, ks * 32 + fq * 8));
#pragma unroll
          for (int m = 0; m < 2; ++m)
#pragma unroll
            for (int n = 0; n < 4; ++n) acc[mh * 2 + m][n] = __builtin_amdgcn_mfma_f32_16x16x32_bf16(At[m], Bf[n], acc[mh * 2 + m][n], 0, 0, 0);
        }
      }
      if (t + 2 < 24) WAIT_V(6); else WAIT_V(0);
      RAW_BARRIER();
      cur = (cur == 2) ? 0 : cur + 1;
    }
    if (MI == 4) { GATE_LOAD(3); }
#undef GATE_LOAD
#pragma unroll
    for (int m = 0; m < MI; ++m)
#pragma unroll
      for (int n = 0; n < 4; ++n)
#pragma unroll
        for (int j = 0; j < 4; ++j) {
          const unsigned w = gpk[m][n][j >> 1];
          const float gv = __uint_as_float((j & 1) ? (w & 0xffff0000u) : (w << 16));
          tot[m][n][j] += acc[m][n][j] * __builtin_amdgcn_rcpf(1.f + __expf(-gv));
          acc[m][n][j] = 0.f;
        }
  }
  u16* mixb = (u16*)(p.ws + WS_ZV);
#pragma unroll
  for (int m = 0; m < MI; ++m)
#pragma unroll
    for (int n = 0; n < 4; ++n)
#pragma unroll
      for (int j = 0; j < 4; ++j)
        mixb[(size_t)(brow + wr * WROWS + m * 16 + fq * 4 + j) * D + bcol + wc * 64 + n * 16 + fr] = f2bf(tot[m][n][j]);
#undef SA
#undef SB
#undef MIX_STAGE
}

__device__ __forceinline__ void tile_map(int t, int nM, int nN, int& pm, int& pn) {
  int nwg = nM * nN, wgid = t;
  {
    int q = nwg / 8, r = nwg % 8, xcd = wgid % 8, off = wgid / 8;
    wgid = (xcd < r ? xcd * (q + 1) : r * (q + 1) + (xcd - r) * q) + off;
  }
  constexpr int WGM = 4;
  int nig = WGM * nN, gid = wgid / nig, fm = gid * WGM, gsz = min(nM - fm, WGM);
  pm = fm + ((wgid % nig) % gsz);
  pn = (wgid % nig) / gsz;
}

__device__ __forceinline__ void p0_misc(const Ctx& p) {
  const int gtid = blockIdx.x * NT + tid_l(), gn = gridDim.x * NT;
  float4* h4 = (float4*)(p.ws + WS_H);
  const float4* x4 = (const float4*)pin(p, 0);
  const float4* c4 = (const float4*)pin(p, 2);
#pragma unroll 8
  for (int i = gtid; i < MROWS * 256; i += gn) {
    int m = i >> 8, q = i & 255, b = m / SP, pos = m - b * SP;
    float4 v = (pos < CTX) ? c4[(size_t)(b * CTX + pos) * 256 + q] : x4[(size_t)(b * SEQ + pos - CTX) * 256 + q];
    h4[i] = v;
  }
  float2* rope = (float2*)(p.ws + WS_ROPE);
  for (int i = gtid; i < 1024; i += gn) {
    int idx = i >> 3, f = i & 7;
    float inv = powf(10000.f, -(float)f / 8.f);
    float a = (float)idx * inv;
    rope[i] = make_float2(cosf(a), sinf(a));
  }
  {
    u16* w3t = (u16*)(p.ws + WS_W3T);
    const float* w3 = pin(p, 20);
    for (int i = gtid; i < 4 * 1024 * 64; i += gn) { int l = i >> 16, c2 = (i >> 6) & 1023, k = i & 63; w3t[i] = f2bf(w3[((size_t)l * 64 + k) * 1024 + c2]); }
  }
  float2* tw = (float2*)(p.ws + WS_TW);
  for (int i = gtid; i < 16384; i += gn) {
    float s, c;
    sincospif(-(float)i / 8192.f, &s, &c);
    tw[i] = make_float2(c, s);
  }
}

__device__ __forceinline__ void p0_mod_task(const Ctx& p, int task, char* smem) {
  float* s = (float*)smem;
  float* red = s + 3072;
  const int tid = tid_l();
  const int l = task / 48, chunk = task - l * 48;
  for (int i = tid; i < 3072; i += NT) {
    int g = i >> 10, k = i & 1023;
    float cv = (g < 2) ? pin(p, 1)[g * 1024 + k] : pin(p, 3)[k];
    s[i] = cv / (1.f + __expf(-cv));
  }
  __syncthreads();
  const int kq = tid >> 7, col = tid & 127, n = chunk * 128 + col;
  const float* W = pin(p, 4) + (size_t)l * 1024 * 6144 + n;
  float a0 = 0.f, a1 = 0.f, a2 = 0.f;
#pragma unroll 32
  for (int k = kq * 256; k < kq * 256 + 256; ++k) {
    float w = W[(size_t)k * 6144];
    a0 += s[k] * w; a1 += s[1024 + k] * w; a2 += s[2048 + k] * w;
  }
  red[(kq * 3 + 0) * 128 + col] = a0;
  red[(kq * 3 + 1) * 128 + col] = a1;
  red[(kq * 3 + 2) * 128 + col] = a2;
  __syncthreads();
  if (tid < 384) {
    int g = tid >> 7, c2 = tid & 127, n2 = chunk * 128 + c2;
    float v = red[(0 * 3 + g) * 128 + c2] + red[(1 * 3 + g) * 128 + c2] + red[(2 * 3 + g) * 128 + c2] + red[(3 * 3 + g) * 128 + c2];
    ((float*)(p.ws + WS_MOD))[(size_t)(l * 3 + g) * 6144 + n2] = v + pin(p, 5)[l * 6144 + n2];
  }
  __syncthreads();
}

__device__ __forceinline__ void p0_hid_task(const Ctx& p, int task, char* smem) {
  float* zs = (float*)smem;
  float* h1 = zs + 8 * 36;
  float* w1s = h1 + 8 * 64;
  float* w2s = w1s + 33 * 64;
  const int tid = tid_l(), tl = tid >> 6, j = tid & 63;
  const int l = task / 132, r = task - l * 132;
  const bool isctx = r >= 128;
  const int L = isctx ? 256 : 8192;
  const int tbase = (isctx ? (r - 128) : r) * 64;
  for (int i = tid; i < 33 * 64; i += NT) w1s[i] = pin(p, 14)[l * 33 * 64 + i];
  for (int i = tid; i < 64 * 64; i += NT) w2s[i] = pin(p, 17)[l * 64 * 64 + i];
  const float b1 = pin(p, 15)[l * 64 + j], f1 = pin(p, 16)[l * 64 + j], b2 = pin(p, 18)[l * 64 + j], f2 = pin(p, 19)[l * 64 + j];
  __syncthreads();
  for (int sub = 0; sub < 8; ++sub) {
    const int t = tbase + sub * 8 + tl;
    if (j < 33) {
      float z;
      if (j == 0) z = (float)t / (float)(L - 1);
      else {
        int i = (j - 1) & 15;
        float band = 1e-4f + (float)i * ((15.f - 1e-4f) / 15.f);
        float omega = 6.2831855f * (float)t / (float)L;
        float a = omega * band;
        z = (j <= 16) ? cosf(a) : -sinf(a);
      }
      zs[tl * 36 + j] = z;
    }
    __syncthreads();
    {
      float a = b1;
#pragma unroll
      for (int k = 0; k < 33; ++k) a += zs[tl * 36 + k] * w1s[k * 64 + j];
      h1[tl * 64 + j] = sinf(f1 * a);
    }
    __syncthreads();
    {
      float a = b2;
#pragma unroll 16
      for (int k = 0; k < 64; ++k) a += h1[tl * 64 + k] * w2s[k * 64 + j];
      float v = sinf(f2 * a);
      if (isctx) ((float*)(p.ws + WS_HID2C))[((size_t)l * 64 + j) * 256 + t] = v;
      else ((u16*)(p.ws + WS_HID2))[((size_t)l * 8192 + t) * 64 + j] = f2bf(v);
    }
  }
  __syncthreads();
}

struct WtItem { const float* W; u16* WT; int K, N, k0, n0; };
__device__ __forceinline__ WtItem wt_decode(const Ctx& p, int l, int r) {
  char* wo = (char*)p.out;
  WtItem it;
  int nblk;
  if (r < 1472) { it.W = pin(p, 8) + (size_t)l * 1024 * DIN; it.K = 1024; it.N = DIN; it.WT = (u16*)(wo + WO_IN); nblk = 92; }
  else if ((r -= 1472) < 1024) { it.W = pin(p, 30) + (size_t)l * 1024 * 4096; it.K = 1024; it.N = 4096; it.WT = (u16*)(wo + WO_FF1); nblk = 64; }
  else if ((r -= 1024) < 1024) { it.W = pin(p, 31) + (size_t)l * 4096 * 1024; it.K = 4096; it.N = 1024; it.WT = (u16*)(wo + WO_FF2); nblk = 16; }
  else if ((r -= 1024) < 256) { it.W = pin(p, 29) + (size_t)l * 1024 * 1024; it.K = 1024; it.N = 1024; it.WT = (u16*)(wo + WO_OUT); nblk = 16; }
  else if ((r -= 256) < 128) { it.W = pin(p, 23) + (size_t)l * 512 * 1024; it.K = 512; it.N = 1024; it.WT = (u16*)(wo + WO_HY); nblk = 16; }
  else if ((r -= 128) < 128) { it.W = pin(p, 28) + (size_t)l * 512 * 1024; it.K = 512; it.N = 1024; it.WT = (u16*)(wo + WO_WO); nblk = 16; }
  else if ((r -= 128) < 72) { it.W = pin(p, 25) + (size_t)l * 384 * 768; it.K = 384; it.N = 768; it.WT = (u16*)(wo + WO_UQ); nblk = 12; }
  else { r -= 72; it.W = pin(p, 27) + (size_t)l * 256 * 1024; it.K = 256; it.N = 1024; it.WT = (u16*)(wo + WO_UKV); nblk = 16; }
  const int kb = r / nblk, nb2 = r - kb * nblk;
  it.k0 = kb * 64; it.n0 = nb2 * 64;
  return it;
}
__device__ __forceinline__ void wt_load(const WtItem& it, int tid, float (&v)[8]) {
  const int nn = tid & 63, kq = tid >> 6;
  const bool ok = it.n0 + nn < it.N;
  const float* src = it.W + (size_t)(it.k0 + kq) * it.N + it.n0 + (ok ? nn : 0);
#pragma unroll
  for (int r = 0; r < 8; ++r) { float x = src[(size_t)(r * 8) * it.N]; v[r] = ok ? x : 0.f; }
}
__device__ __forceinline__ void wt_phase(const Ctx& p, int l, char* smem) {
  float* tile = (float*)smem;
  const int tid = tid_l();
  const int bid = blockIdx.x, nb = gridDim.x;
  int t = bid;
  if (t >= 4168) return;
  WtItem cur = wt_decode(p, l, t);
  float v[8];
  wt_load(cur, tid, v);
#pragma unroll 1
  while (true) {
    const int tn = t + nb;
    const bool more = tn < 4168;
    WtItem nxt = cur;
    float vn[8];
    if (more) { nxt = wt_decode(p, l, tn); wt_load(nxt, tid, vn); }
#pragma unroll
    for (int r = 0; r < 8; ++r) tile[(r * 8 + (tid >> 6)) * 65 + (tid & 63)] = v[r];
    __syncthreads();
    {
      int n = tid >> 3, kc = (tid & 7) * 8;
      uint4 o;
      o.x = pk2(tile[(kc + 0) * 65 + n], tile[(kc + 1) * 65 + n]);
      o.y = pk2(tile[(kc + 2) * 65 + n], tile[(kc + 3) * 65 + n]);
      o.z = pk2(tile[(kc + 4) * 65 + n], tile[(kc + 5) * 65 + n]);
      o.w = pk2(tile[(kc + 6) * 65 + n], tile[(kc + 7) * 65 + n]);
      *(uint4*)(cur.WT + (size_t)(cur.n0 + n) * cur.K + cur.k0 + kc) = o;
    }
    __syncthreads();
    if (!more) break;
    cur = nxt;
#pragma unroll
    for (int r = 0; r < 8; ++r) v[r] = vn[r];
    t = tn;
  }
}

__device__ __forceinline__ void wpe_task(const Ctx& p, int l, int task, char* smem) {
  const int g = task >> 3, c0 = (task & 7) * 16, tid = tid_l();
  const float* pw = pin(p, 9) + ((size_t)(l * 4 + g) * 128) * 128;
  const float* sc = pin(p, 10) + l * 512 + g * 128;
  const float* po = pin(p, 11) + ((size_t)l * 512 + g * 128) * 1024;
  u16* WpeT = (u16*)(p.ws + WS_WPE) + (size_t)l * 1024 * 512;
  float* wl = (float*)smem;
  for (int i = tid; i < 16 * 128; i += NT) { int d = i & 127; wl[i] = pw[(c0 + (i >> 7)) * 128 + d] * sc[d]; }
  __syncthreads();
  float acc0[16], acc1[16];
#pragma unroll
  for (int i = 0; i < 16; ++i) { acc0[i] = 0.f; acc1[i] = 0.f; }
#pragma unroll 16
  for (int d = 0; d < 128; ++d) {
    float p0 = po[(size_t)d * 1024 + tid], p1 = po[(size_t)d * 1024 + 512 + tid];
#pragma unroll
    for (int i = 0; i < 16; ++i) { float w = wl[i * 128 + d]; acc0[i] += w * p0; acc1[i] += w * p1; }
  }
  uint4 o0, o1;
  o0.x = pk2(acc0[0], acc0[1]); o0.y = pk2(acc0[2], acc0[3]); o0.z = pk2(acc0[4], acc0[5]); o0.w = pk2(acc0[6], acc0[7]);
  o1.x = pk2(acc0[8], acc0[9]); o1.y = pk2(acc0[10], acc0[11]); o1.z = pk2(acc0[12], acc0[13]); o1.w = pk2(acc0[14], acc0[15]);
  uint4* dst = (uint4*)(WpeT + (size_t)tid * 512 + g * 128 + c0);
  dst[0] = o0; dst[1] = o1;
  o0.x = pk2(acc1[0], acc1[1]); o0.y = pk2(acc1[2], acc1[3]); o0.z = pk2(acc1[4], acc1[5]); o0.w = pk2(acc1[6], acc1[7]);
  o1.x = pk2(acc1[8], acc1[9]); o1.y = pk2(acc1[10], acc1[11]); o1.z = pk2(acc1[12], acc1[13]); o1.w = pk2(acc1[14], acc1[15]);
  dst = (uint4*)(WpeT + (size_t)(512 + tid) * 512 + g * 128 + c0);
  dst[0] = o0; dst[1] = o1;
  __syncthreads();
}

__device__ __forceinline__ void norm_rows(const Ctx& p, const float* gain, const float* modl, int sh_idx, int sc_idx, u16* outp) {
  const int tidx = tid_l(), lane = tidx & 63, gw = blockIdx.x * 8 + (tidx >> 6), ngw = gridDim.x * 8;
  const float* h = (const float*)(p.ws + WS_H);
  float4 g[4];
#pragma unroll
  for (int j = 0; j < 4; ++j) g[j] = *(const float4*)(gain + lane * 4 + 256 * j);
  for (int m0 = gw; m0 < MROWS; m0 += 2 * ngw) {
    const int m1 = m0 + ngw;
    const bool has1 = m1 < MROWS;
    const int m1c = has1 ? m1 : m0;
    const float4* hr0 = (const float4*)(h + (size_t)m0 * D) + lane;
    const float4* hr1 = (const float4*)(h + (size_t)m1c * D) + lane;
    float4 v0[4], v1[4];
#pragma unroll
    for (int j = 0; j < 4; ++j) { v0[j] = hr0[64 * j]; v1[j] = hr1[64 * j]; }
    const float* mg0 = modl + grp_of_row(m0) * 6144;
    const float* mg1 = modl + grp_of_row(m1c) * 6144;
    float s0 = 0.f, s1 = 0.f;
#pragma unroll
    for (int j = 0; j < 4; ++j) {
      s0 += v0[j].x * v0[j].x + v0[j].y * v0[j].y + v0[j].z * v0[j].z + v0[j].w * v0[j].w;
      s1 += v1[j].x * v1[j].x + v1[j].y * v1[j].y + v1[j].z * v1[j].z + v1[j].w * v1[j].w;
    }
    s0 = wave_sum(s0);
    s1 = wave_sum(s1);
    const float r0 = rsqrtf(s0 * (1.f / D) + EPS), r1 = rsqrtf(s1 * (1.f / D) + EPS);
    uint2* o0 = (uint2*)(outp + (size_t)m0 * D) + lane;
    uint2* o1 = (uint2*)(outp + (size_t)m1c * D) + lane;
#pragma unroll
    for (int j = 0; j < 4; ++j) {
      int n = lane * 4 + 256 * j;
      float4 sc = *(const float4*)(mg0 + sc_idx * 1024 + n), sh = *(const float4*)(mg0 + sh_idx * 1024 + n);
      uint2 o;
      o.x = pk2(v0[j].x * r0 * g[j].x * (1.f + sc.x) + sh.x, v0[j].y * r0 * g[j].y * (1.f + sc.y) + sh.y);
      o.y = pk2(v0[j].z * r0 * g[j].z * (1.f + sc.z) + sh.z, v0[j].w * r0 * g[j].w * (1.f + sc.w) + sh.w);
      o0[64 * j] = o;
    }
    if (has1) {
#pragma unroll
      for (int j = 0; j < 4; ++j) {
        int n = lane * 4 + 256 * j;
        float4 sc = *(const float4*)(mg1 + sc_idx * 1024 + n), sh = *(const float4*)(mg1 + sh_idx * 1024 + n);
        uint2 o;
        o.x = pk2(v1[j].x * r1 * g[j].x * (1.f + sc.x) + sh.x, v1[j].y * r1 * g[j].y * (1.f + sc.y) + sh.y);
        o.y = pk2(v1[j].z * r1 * g[j].z * (1.f + sc.z) + sh.z, v1[j].w * r1 * g[j].w * (1.f + sc.w) + sh.w);
        o1[64 * j] = o;
      }
    }
  }
}

__device__ __forceinline__ void final_norm(const Ctx& p) {
  const int tidx = tid_l(), lane = tidx & 63, gw = blockIdx.x * 8 + (tidx >> 6), ngw = gridDim.x * 8;
  const float* h = (const float*)(p.ws + WS_H);
  const float* gain = pin(p, 32);
  for (int r0 = gw; r0 < 2 * SEQ; r0 += ngw) {
    int b = r0 >> 13, t = r0 & 8191, m = b * SP + CTX + t;
    const float4* hr = (const float4*)(h + (size_t)m * D) + lane;
    float4 v[4];
    float ss = 0.f;
#pragma unroll
    for (int j = 0; j < 4; ++j) { v[j] = hr[64 * j]; ss += v[j].x * v[j].x + v[j].y * v[j].y + v[j].z * v[j].z + v[j].w * v[j].w; }
    ss = wave_sum(ss);
    float r = rsqrtf(ss * (1.f / D) + EPS);
    float4* o = (float4*)(p.out + (size_t)r0 * D) + lane;
#pragma unroll
    for (int j = 0; j < 4; ++j) {
      float4 g = *(const float4*)(gain + lane * 4 + 256 * j);
      o[64 * j] = make_float4(v[j].x * r * g.x, v[j].y * r * g.y, v[j].z * r * g.z, v[j].w * r * g.w);
    }
  }
}

__device__ __forceinline__ void premix_task(const Ctx& p, int l, int task, char* smem) {
  const int tid = tid_l(), lane = tid & 63, wid = tid >> 6;
  const int part = task / 264, tile64 = task - part * 264;
  const int m0 = tile64 * 64, b = m0 / SP, pos0 = m0 - b * SP;
  const bool isctx = pos0 < CTX;
  const int s0 = isctx ? 0 : CTX, L = isctx ? CTX : SEQ, t0 = pos0 - s0;
  const size_t mb = (size_t)b * SP + s0;
  const u16* proj = (const u16*)(p.ws + WS_PROJ);
  if (part == 0) {
    u16* P = (u16*)smem;
#pragma unroll
    for (int i = tid; i < 80 * 64; i += NT) {
      int r = i >> 6, ch = i & 63, t = t0 - 8 + r;
      uint4 v = make_uint4(0, 0, 0, 0);
      if (t >= 0 && t < L) v = *(const uint4*)(proj + (mb + t) * DINP + ch * 8);
      *(uint4*)(P + r * 512 + ch * 8) = v;
    }
    __syncthreads();
    const int c = tid, g = c >> 7, hw = 1 << g;
    u16* U = (u16*)(p.ws + WS_U);
    float s = 0.f;
    for (int q = -hw; q < hw; ++q) s += bf2f(P[(8 + q) * 512 + c]);
#pragma unroll 4
    for (int tt = 0; tt < 64; ++tt) {
      int t = t0 + tt, lo = max(t - hw, 0), hi = min(t + hw, L);
      float u = s * __builtin_amdgcn_rcpf((float)(hi - lo)) - bf2f(P[(tt + 8) * 512 + c]);
      U[(mb + t) * 512 + c] = f2bf(u);
      s += bf2f(P[(tt + 8 + hw) * 512 + c]) - bf2f(P[(tt + 8 - hw) * 512 + c]);
    }
    __syncthreads();
  } else if (part <= 4) {
    const int ch0 = (part - 1) * 128;
    constexpr int PITCH = 136;
    u16* X = (u16*)smem;
    float* T = (float*)(smem + 3 * 66 * PITCH * 2 + 64);
#pragma unroll
    for (int ii = 0; ii < 7; ++ii) {
      const int i = tid + ii * NT;
      if (i >= 3 * 66 * 16) break;
      int pr = i / (66 * 16), rem = i - pr * 66 * 16, r = rem >> 4, ch = rem & 15, t = t0 - 1 + r;
      uint4 v = make_uint4(0, 0, 0, 0);
      if (t >= 0 && t < L) v = *(const uint4*)(proj + (mb + t) * DINP + OFF_HY + pr * 512 + ch0 + ch * 8);
      *(uint4*)(X + (pr * 66 + r) * PITCH + ch * 8) = v;
    }
    __syncthreads();
    const float* cw = pin(p, 12) + l * 3 * 1536;
    const float* cb = pin(p, 13) + l * 1536;
    {
      const int c = tid & 127, tq = tid >> 7, col = ch0 + c;
      const float w00 = cw[col], w01 = cw[1536 + col], w02 = cw[3072 + col], b0 = cb[col];
      const float w10 = cw[512 + col], w11 = cw[1536 + 512 + col], w12 = cw[3072 + 512 + col], b1 = cb[512 + col];
      const float w20 = cw[1024 + col], w21 = cw[1536 + 1024 + col], w22 = cw[3072 + 1024 + col], b2 = cb[1024 + col];
      const u16* X0 = X, *X1 = X + 66 * PITCH, *XV = X + 2 * 66 * PITCH;
      u16* Y = (u16*)(p.ws + WS_Y);
#pragma unroll 4
      for (int tt = tq * 16; tt < tq * 16 + 16; ++tt) {
        float x0 = w00 * bf2f(X0[tt * PITCH + c]) + w01 * bf2f(X0[(tt + 1) * PITCH + c]) + w02 * bf2f(X0[(tt + 2) * PITCH + c]) + b0;
        float x1 = w10 * bf2f(X1[tt * PITCH + c]) + w11 * bf2f(X1[(tt + 1) * PITCH + c]) + w12 * bf2f(X1[(tt + 2) * PITCH + c]) + b1;
        float vv = w20 * bf2f(XV[tt * PITCH + c]) + w21 * bf2f(XV[(tt + 1) * PITCH + c]) + w22 * bf2f(XV[(tt + 2) * PITCH + c]) + b2;
        Y[(mb + t0 + tt) * 512 + col] = f2bf(x0);
        T[c * 65 + tt] = x1 * vv;
      }
    }
    __syncthreads();
    {
      float* ZV = (float*)(p.ws + WS_ZV);
#pragma unroll 4
      for (int cc = 0; cc < 16; ++cc) {
        int c = wid * 16 + cc;
        ZV[((size_t)(ch0 + c) * SP + pos0 + lane) * 2 + b] = T[c * 65 + lane];
      }
    }
    __syncthreads();
  } else {
    u16* projw = (u16*)(p.ws + WS_PROJ);
    const float* qg = pin(p, 24) + l * 384;
    const float* kg = pin(p, 26) + l * 256;
    const float2* rope = (const float2*)(p.ws + WS_ROPE);
    u16* Kb = (u16*)(p.ws + WS_K);
#pragma unroll 2
    for (int rr = 0; rr < 8; ++rr) {
      int tt = wid * 8 + rr, pos = pos0 + tt;
      u16* row = projw + ((size_t)b * SP + pos) * DINP;
      unsigned* q32 = (unsigned*)(row + OFF_Q);
      unsigned* k32 = (unsigned*)(row + OFF_KV);
      unsigned v[3], w[2];
      float ss = 0.f, s2 = 0.f;
#pragma unroll
      for (int j = 0; j < 3; ++j) v[j] = q32[lane + 64 * j];
#pragma unroll
      for (int j = 0; j < 2; ++j) w[j] = k32[lane + 64 * j];
      const int rd = lane & 31;
      float val = bf2f(row[OFF_KV + 256 + rd]);
#pragma unroll
      for (int j = 0; j < 3; ++j) { float a = bf2f(v[j] & 0xffff), c2 = bf2f(v[j] >> 16); ss += a * a + c2 * c2; }
#pragma unroll
      for (int j = 0; j < 2; ++j) { float a = bf2f(w[j] & 0xffff), c2 = bf2f(w[j] >> 16); s2 += a * a + c2 * c2; }
      ss = wave_sum(ss);
      s2 = wave_sum(s2);
      float r = rsqrtf(ss * (1.f / 384.f) + EPS), r2 = rsqrtf(s2 * (1.f / 256.f) + EPS);
#pragma unroll
      for (int j = 0; j < 3; ++j) {
        int n = (lane + 64 * j) * 2;
        q32[lane + 64 * j] = pk2(bf2f(v[j] & 0xffff) * r * qg[n], bf2f(v[j] >> 16) * r * qg[n + 1]);
      }
#pragma unroll
      for (int j = 0; j < 2; ++j) {
        int n = (lane + 64 * j) * 2;
        k32[lane + 64 * j] = pk2(bf2f(w[j] & 0xffff) * r2 * kg[n], bf2f(w[j] >> 16) * r2 * kg[n + 1]);
      }
      float partner = shx(val, 8);
      if (!isctx) {
        int t = pos - CTX, idx = (rd < 16) ? (t >> 6) : (t & 63);
        float2 cs = rope[idx * 8 + (rd & 7)];
        float sgn = (rd & 8) ? 1.f : -1.f;
        val = val * cs.x + sgn * partner * cs.y;
      }
      if (lane < 32) {
        u16 o = f2bf(val);
#pragma unroll
        for (int hd = 0; hd < 8; ++hd) Kb[((size_t)(b * 8 + hd) * SP + pos) * 96 + 64 + rd] = o;
      }
    }
  }
}

__device__ __forceinline__ int xi(int i) { const int h = i >> 5; return i ^ (((h & 3) * 5) | ((h & 2) << 3)); }
typedef float v2f __attribute__((ext_vector_type(2)));
__device__ __forceinline__ v2f cmulv(v2f a, v2f b) {
  v2f bs = {-b.y, b.x};
  return a.xx * b + a.yy * bs;
}
__device__ __forceinline__ void bf_fwd(float2* Xf, int base, int q, float2 w1f) {
  v2f* X = (v2f*)Xf;
  const v2f w1 = {w1f.x, w1f.y};
  const v2f w2 = cmulv(w1, w1), w3 = cmulv(w2, w1);
  const int i0 = xi(base), i1 = xi(base + q), i2 = xi(base + 2 * q), i3 = xi(base + 3 * q);
  v2f a0 = X[i0], a1 = X[i1], a2 = X[i2], a3 = X[i3];
  v2f s02 = a0 + a2, d02 = a0 - a2, s13 = a1 + a3, d13 = a1 - a3;
  v2f d13r = {d13.y, -d13.x};
  X[i0] = s02 + s13;
  X[i1] = cmulv(d02 + d13r, w1);
  X[i2] = cmulv(s02 - s13, w2);
  X[i3] = cmulv(d02 - d13r, w3);
}
__device__ __forceinline__ void bf_inv(float2* Xf, int base, int q, float2 w1f) {
  v2f* X = (v2f*)Xf;
  const v2f w1 = {w1f.x, -w1f.y};
  const v2f w2 = cmulv(w1, w1), w3 = cmulv(w2, w1);
  const int i0 = xi(base), i1 = xi(base + q), i2 = xi(base + 2 * q), i3 = xi(base + 3 * q);
  v2f b0 = X[i0], c1 = cmulv(X[i1], w1), c2 = cmulv(X[i2], w2), c3 = cmulv(X[i3], w3);
  v2f s02 = b0 + c2, d02 = b0 - c2, s13 = c1 + c3, d13 = c1 - c3;
  v2f d13r = {-d13.y, d13.x};
  X[i0] = s02 + s13;
  X[i1] = d02 + d13r;
  X[i2] = s02 - s13;
  X[i3] = d02 - d13r;
}
template <bool INV, int LQ>
__device__ __forceinline__ void fft_pass(float2* X, const float2* __restrict__ tw, const float2 (&twr)[6], int tid) {
  constexpr int q = 1 << LQ;
  if (LQ == 12) {
    float2 w[8];
#pragma unroll
    for (int b8 = 0; b8 < 8; ++b8) w[b8] = tw[b8 * NT + tid];
#pragma unroll
    for (int b8 = 0; b8 < 8; ++b8) { int u = b8 * NT + tid; if (INV) bf_inv(X, u, q, w[b8]); else bf_fwd(X, u, q, w[b8]); }
  } else if (LQ == 10) {
#pragma unroll 4
    for (int b8 = 0; b8 < 8; ++b8) {
      int u = b8 * NT + tid, j = u & 1023, base = ((u >> 10) << 12) + j;
      float2 w = (b8 & 1) ? twr[1] : twr[0];
      if (INV) bf_inv(X, base, q, w); else bf_fwd(X, base, q, w);
    }
  } else {
    const int j = tid & (q - 1);
    const float2 w = (LQ == 0) ? make_float2(1.f, 0.f) : twr[2 + (8 - LQ) / 2];
#pragma unroll 4
    for (int b8 = 0; b8 < 8; ++b8) {
      int u = b8 * NT + tid, base = ((u >> LQ) << (LQ + 2)) + j;
      if (INV) bf_inv(X, base, q, w); else bf_fwd(X, base, q, w);
    }
  }
  __syncthreads();
}
__device__ __forceinline__ void fft_load_tw(const float2* __restrict__ tw, int tid, float2 (&twr)[6]) {
  twr[0] = tw[tid << 2];
  twr[1] = tw[(512 + tid) << 2];
  twr[2] = tw[(tid & 255) << 4];
  twr[3] = tw[(tid & 63) << 6];
  twr[4] = tw[(tid & 15) << 8];
  twr[5] = tw[(tid & 3) << 10];
}
__device__ __forceinline__ void fft_dif(float2* X, const float2* __restrict__ tw, const float2 (&twr)[6]) {
  const int tid = tid_l();
  fft_pass<false, 12>(X, tw, twr, tid); fft_pass<false, 10>(X, tw, twr, tid); fft_pass<false, 8>(X, tw, twr, tid); fft_pass<false, 6>(X, tw, twr, tid);
  fft_pass<false, 4>(X, tw, twr, tid); fft_pass<false, 2>(X, tw, twr, tid); fft_pass<false, 0>(X, tw, twr, tid);
}
__device__ __forceinline__ void fft_dit_inv(float2* X, const float2* __restrict__ tw, const float2 (&twr)[6]) {
  const int tid = tid_l();
  fft_pass<true, 0>(X, tw, twr, tid); fft_pass<true, 2>(X, tw, twr, tid); fft_pass<true, 4>(X, tw, twr, tid); fft_pass<true, 6>(X, tw, twr, tid);
  fft_pass<true, 8>(X, tw, twr, tid); fft_pass<true, 10>(X, tw, twr, tid); fft_pass<true, 12>(X, tw, twr, tid);
}
__device__ __forceinline__ float block_sum(float v, float* red) {
  v = wave_sum(v);
  __syncthreads();
  { const int tb = tid_l(); if ((tb & 63) == 0) red[tb >> 6] = v; }
  __syncthreads();
  float s = red[0] + red[1] + red[2] + red[3] + red[4] + red[5] + red[6] + red[7];
  __syncthreads();
  return s;
}

__device__ __forceinline__ void fft_task(const Ctx& p, int l, int c, char* smem) {
  float2* X = (float2*)smem;
  float zl = 0.f;
  asm volatile("" : "+v"(zl));
  float* aux = (float*)(smem + AUX_OFF);
  float* red = aux + 128;
  const int tid = tid_l();
  const float2* tw = (const float2*)(p.ws + WS_TW);
  float2 twr[6];
  fft_load_tw(tw, tid, twr);
  const float* w3 = pin(p, 20) + (size_t)l * 64 * 1024;
  if (tid < 64) { aux[tid] = w3[tid * 1024 + c]; aux[64 + tid] = w3[tid * 1024 + 512 + c]; }
  __syncthreads();
  const float dF = fabsf(pin(p, 21)[(l * 2 + 0) * 512 + c]), dB = fabsf(pin(p, 21)[(l * 2 + 1) * 512 + c]);
  const float bias = pin(p, 22)[l * 512 + c];
  float2* zp = (float2*)(p.ws + WS_ZV) + (size_t)c * SP;
  float l1 = 0.f;
  {
    const u16* ff = (const u16*)((const char*)p.out + WO_FILT) + (size_t)c * 8192 + tid;
    const u16* fb = ff + (size_t)512 * 8192;
    u16 rf[16], rb[16];
#pragma unroll
    for (int i = 0; i < 16; ++i) { rf[i] = ff[i * NT]; rb[i] = fb[i * NT]; }
#pragma unroll
    for (int i = 0; i < 16; ++i) {
      int t = i * NT + tid;
      float tl = (float)t * (1.f / 8191.f);
      float hf = bf2f(rf[i]) * __expf(-tl * dF);
      float hb = bf2f(rb[i]) * __expf(-tl * dB);
      X[xi(t)] = make_float2(hf, 0.f);
      if (t >= 1) { X[xi(16384 - t)] = make_float2(hb, 0.f); l1 += fabsf(hf) + fabsf(hb); }
      else { X[xi(8192)] = make_float2(zl, zl); l1 += fabsf(hf); }
    }
  }
  float l1tot = block_sum(l1, red);
  fft_dif(X, tw, twr);
  float2 F[32];
  {
    float s = 1.f / (l1tot * 16384.f);
#pragma unroll
    for (int i = 0; i < 32; ++i) { float2 v = X[xi(i * NT + tid)]; F[i] = make_float2(v.x * s, v.y * s); }
  }
  __syncthreads();
#pragma unroll 8
  for (int i = 0; i < 16; ++i) {
    int t = i * NT + tid;
    X[xi(t)] = zp[CTX + t];
    X[xi(8192 + t)] = make_float2(zl, zl);
  }
  __syncthreads();
  fft_dif(X, tw, twr);
#pragma unroll
  for (int i = 0; i < 32; ++i) { int idx = xi(i * NT + tid); X[idx] = cmul(X[idx], F[i]); }
  __syncthreads();
  fft_dit_inv(X, tw, twr);
  {
    float2 zz[16];
#pragma unroll
    for (int i = 0; i < 16; ++i) zz[i] = zp[CTX + i * NT + tid];
#pragma unroll
    for (int i = 0; i < 16; ++i) {
      int t = i * NT + tid;
      float2 y = X[xi(t)];
      zp[CTX + t] = make_float2(y.x + bias * zz[i].x, y.y + bias * zz[i].y);
    }
  }
  __syncthreads();
  {
    float* hFc = (float*)smem;
    float* hBc = hFc + 256;
    float2* zc = (float2*)(hBc + 256);
    float l1c = 0.f;
    if (tid < 256) {
      int t = tid;
      const float* hc = (const float*)(p.ws + WS_HID2C) + (size_t)l * 64 * 256 + t;
      float hf = 0.f, hb = 0.f;
#pragma unroll 16
      for (int k = 0; k < 64; ++k) { float v = hc[k * 256]; hf += v * aux[k]; hb += v * aux[64 + k]; }
      float tl = (float)t * (1.f / 255.f);
      hf *= expf(-tl * dF);
      hb *= expf(-tl * dB);
      hFc[t] = hf;
      hBc[t] = hb;
      l1c = fabsf(hf) + (t >= 1 ? fabsf(hb) : 0.f);
      zc[t] = zp[t];
    }
    float l1ct = block_sum(l1c, red);
    const int bb = tid >> 8, t = tid & 255;
    float acc = 0.f;
    for (int s = 0; s < 256; ++s) {
      float kf = (s <= t) ? hFc[t - s] : hBc[s - t];
      float2 z = zc[s];
      acc += kf * (bb ? z.y : z.x);
    }
    float2 z = zc[t];
    ((float*)zp)[t * 2 + bb] = acc / l1ct + bias * (bb ? z.y : z.x);
    __syncthreads();
  }
}

constexpr int AT_KT = 128, AT_KP = 208, AT_VP = 264, AT_STAGE = AT_KT * AT_KP + 64 * AT_VP;
__device__ __forceinline__ void attn_task(const Ctx& p, int bh, int qb, char* smem) {
  const int tid = tid_l(), wid = tid >> 6, lane = tid & 63, r = lane & 31, hh = lane >> 5;
  const u16* Qp = (const u16*)(p.ws + WS_Q) + ((size_t)bh * SP + qb * 256) * 96;
  const u16* Kp = (const u16*)(p.ws + WS_K) + (size_t)bh * SP * 96;
  const u16* Vp = (const u16*)(p.ws + WS_VT) + (size_t)bh * 64 * SP;
  const int nkt = (qb == 0) ? 2 : 66;
  bf16x8 qf[6];
#pragma unroll
  for (int ks = 0; ks < 6; ++ks) qf[ks] = *(const bf16x8*)(Qp + (size_t)(wid * 32 + r) * 96 + ks * 16 + hh * 8);
  f32x16 o0, o1;
#pragma unroll
  for (int i = 0; i < 16; ++i) { o0[i] = 0.f; o1[i] = 0.f; }
  float mrun = 0.f, lrun = 0.f;
  const u16* src[5];
  int dst[5];
#pragma unroll
  for (int i = 0; i < 5; ++i) {
    int ch = tid + i * NT;
    if (i < 3) { int row = ch / 12, cc = ch - row * 12; src[i] = Kp + (size_t)row * 96 + cc * 8; dst[i] = row * AT_KP + cc * 16; }
    else { int v = ch - 1536, row = v >> 4, cc = v & 15; src[i] = Vp + (size_t)row * SP + cc * 8; dst[i] = AT_KT * AT_KP + row * AT_VP + cc * 16; }
  }
  uint4 st[5];
#define AT_LOAD(t)                                                                                   \
  do {                                                                                               \
    _Pragma("unroll") for (int i = 0; i < 5; ++i) st[i] = *(const uint4*)(src[i] + (size_t)(t) * (i < 3 ? AT_KT * 96 : AT_KT)); \
  } while (0)
#define AT_WRITE(buf)                                                                                \
  do {                                                                                               \
    char* base_ = smem + (buf) * AT_STAGE;                                                           \
    _Pragma("unroll") for (int i = 0; i < 5; ++i) {                                                  \
      uint2* d_ = (uint2*)(base_ + dst[i]);                                                          \
      d_[0] = make_uint2(st[i].x, st[i].y);                                                          \
      d_[1] = make_uint2(st[i].z, st[i].w);                                                          \
    }                                                                                                \
  } while (0)
#define AT_QK(S, kb)                                                                                 \
  _Pragma("unroll") for (int ks = 0; ks < 6; ++ks) {                                                 \
    bf16x8 a_ = *(const bf16x8*)(Ks + ((kb) * 32 + r) * AT_KP + ks * 32 + hh * 16);                  \
    S = __builtin_amdgcn_mfma_f32_32x32x16_bf16(a_, qf[ks], S, 0, 0, 0);                             \
  }
#define AT_SOFT_PV(S, kb)                                                                            \
  _Pragma("unroll") for (int i = 0; i < 16; ++i) { S[i] = __builtin_amdgcn_exp2f(S[i]); ps += S[i]; } \
  _Pragma("unroll") for (int sI = 0; sI < 2; ++sI) {                                                 \
    union { bf16x8 v; unsigned u[4]; } pu;                                                           \
    _Pragma("unroll") for (int j = 0; j < 4; ++j) pu.u[j] = pk2(S[8 * sI + 2 * j], S[8 * sI + 2 * j + 1]); \
    const int koff = ((kb) * 32 + 16 * sI + 4 * hh) * 2;                                             \
    union { bf16x8 v; uint2 h2[2]; } va, vb;                                                         \
    va.h2[0] = *(const uint2*)(Vs + r * AT_VP + koff);                                               \
    va.h2[1] = *(const uint2*)(Vs + r * AT_VP + koff + 16);                                          \
    vb.h2[0] = *(const uint2*)(Vs + (32 + r) * AT_VP + koff);                                        \
    vb.h2[1] = *(const uint2*)(Vs + (32 + r) * AT_VP + koff + 16);                                   \
    o0 = __builtin_amdgcn_mfma_f32_32x32x16_bf16(va.v, pu.v, o0, 0, 0, 0);                           \
    o1 = __builtin_amdgcn_mfma_f32_32x32x16_bf16(vb.v, pu.v, o1, 0, 0, 0);                           \
  }
  AT_LOAD(0);
  AT_WRITE(0);
  __syncthreads();
  for (int t = 0; t < nkt; ++t) {
    const int cur = t & 1;
    if (t + 1 < nkt) AT_LOAD(t + 1);
    const char* Ks = smem + cur * AT_STAGE;
    const char* Vs = Ks + AT_KT * AT_KP;
    const float nm = -mrun;
    f32x16 sA, sB;
    float ps = 0.f;
#pragma unroll
    for (int i = 0; i < 16; ++i) sA[i] = nm;
    AT_QK(sA, 0)
#pragma unroll
    for (int i = 0; i < 16; ++i) sB[i] = nm;
    AT_QK(sB, 1)
    AT_SOFT_PV(sA, 0)
#pragma unroll
    for (int i = 0; i < 16; ++i) sA[i] = nm;
    AT_QK(sA, 2)
    AT_SOFT_PV(sB, 1)
#pragma unroll
    for (int i = 0; i < 16; ++i) sB[i] = nm;
    AT_QK(sB, 3)
    AT_SOFT_PV(sA, 2)
    AT_SOFT_PV(sB, 3)
    lrun += ps;
    float pmx = fmaxf(ps, shx(ps, 32));
    if (__any(pmx > 65536.f)) {
      const float delta = pmx > 65536.f ? ceilf(__log2f(pmx)) : 0.f;
      const float alpha = __builtin_amdgcn_exp2f(-delta);
      mrun += delta;
      lrun *= alpha;
#pragma unroll
      for (int i = 0; i < 16; ++i) { o0[i] *= alpha; o1[i] *= alpha; }
    }
    if (t + 1 < nkt) AT_WRITE(cur ^ 1);
    __syncthreads();
  }
  const float ltot = lrun + shx(lrun, 32);
  const float inv = 1.f / ltot;
  const int b = bh >> 3, head = bh & 7;
  u16* Op = (u16*)(p.ws + WS_O) + ((size_t)b * SP + qb * 256 + wid * 32 + r) * 512 + head * 64;
#pragma unroll
  for (int g = 0; g < 4; ++g) {
    uint2 w0, w1;
    w0.x = pk2(o0[4 * g] * inv, o0[4 * g + 1] * inv);
    w0.y = pk2(o0[4 * g + 2] * inv, o0[4 * g + 3] * inv);
    w1.x = pk2(o1[4 * g] * inv, o1[4 * g + 1] * inv);
    w1.y = pk2(o1[4 * g + 2] * inv, o1[4 * g + 3] * inv);
    *(uint2*)(Op + 8 * g + 4 * hh) = w0;
    *(uint2*)(Op + 32 + 8 * g + 4 * hh) = w1;
  }
#undef AT_LOAD
#undef AT_WRITE
#undef AT_QK
#undef AT_SOFT_PV
}

__device__ __forceinline__ void hypost_task(const Ctx& p, int task, char* smem) {
  const int tid = tid_l(), lane = tid & 63, wid = tid >> 6;
  const int tile64 = task >> 1, ch0 = (task & 1) * 256;
  const int m0 = tile64 * 64, b = m0 / SP, pos0 = m0 - b * SP;
  float* T = (float*)smem;
  const float* ZV = (const float*)(p.ws + WS_ZV);
#pragma unroll 8
  for (int cc = 0; cc < 32; ++cc) {
    int c = wid * 32 + cc;
    T[c * 65 + lane] = ZV[((size_t)(ch0 + c) * SP + pos0 + lane) * 2 + b];
  }
  __syncthreads();
  u16* Y = (u16*)(p.ws + WS_Y);
  const int c = tid & 255, th = tid >> 8;
  u16* yp = Y + (size_t)(m0 + th * 32) * 512 + ch0 + c;
  u16 yv[32];
#pragma unroll
  for (int i = 0; i < 32; ++i) yv[i] = yp[(size_t)i * 512];
#pragma unroll
  for (int i = 0; i < 32; ++i) yp[(size_t)i * 512] = f2bf(bf2f(yv[i]) * T[c * 65 + th * 32 + i]);
  __syncthreads();
}

#ifndef PHMASK
#define PHMASK 0xFFFF
#endif
#define PHON(k) (((PHMASK) >> (k)) & 1)
constexpr int NPH = 1 + 4 * 10 + 1;
__global__ void __launch_bounds__(NT, 2) mega(Params prm) {
  __shared__ __attribute__((aligned(1024))) char smem[LDS_BYTES];
  cg::grid_group grid = cg::this_grid();
  const int bid = blockIdx.x, nb = gridDim.x;
  {
    unsigned long long* it = (unsigned long long*)(smem + AUX_OFF + 6144);
    if (threadIdx.x < 33) it[threadIdx.x] = (unsigned long long)prm.in[threadIdx.x];
    if (threadIdx.x == 0) *(uint4*)(smem + AUX_OFF + 7168) = make_uint4(0u, 0u, 0u, 0u);
    __syncthreads();
  }
  XcdBarrier xbar = xcd_barrier_post((unsigned*)(prm.ws + WS_BAR), (volatile LAS unsigned*)(smem + AUX_OFF + 7168));
  if (prm.ph_lo == 0) {
    Ctx p;
    p.intab = (const unsigned long long*)(smem + AUX_OFF + 6144);
    p.ws = prm.ws;
    p.out = prm.out;
    const int bid = blockIdx.x, nb = gridDim.x;
      if (PHON(10)) {
      p0_misc(p);
      for (int t = bid; t < 192; t += nb) p0_mod_task(p, t, smem);
      for (int t = bid; t < 528; t += nb) p0_hid_task(p, t, smem);
      for (int t = bid; t < 128; t += nb) { const int w = (t + 64) & 127; wpe_task(p, w >> 5, w & 31, smem); }
      }
  }
  unsigned nbar = 0;
  for (int ph = prm.ph_lo; ph < prm.ph_hi; ++ph) {
    Ctx p;
    p.intab = (const unsigned long long*)(smem + AUX_OFF + 6144);
    p.ws = prm.ws;
    p.out = prm.out;
    asm volatile("" : "+s"(p.ws), "+s"(p.out));
    float* modall = (float*)(p.ws + WS_MOD);
    u16* proj = (u16*)(p.ws + WS_PROJ);
    u16* xn = (u16*)(p.ws + WS_U);
    char* wo = (char*)p.out;
    if (ph == 0) {
    } else if (ph == NPH - 1) {
      if (PHON(11)) final_norm(p);
    } else {
      const int l = (ph - 1) / 10, sp = (ph - 1) % 10;
      const float* modl = modall + (size_t)l * 3 * 6144;
      GD* tab = (GD*)(smem + AUX_OFF + 4096);
      int ng = 0, nN0 = 0, nN1 = 0, nsplit = 1;
      const bool last = (l == 3);
      const float* gate = modl;
      if (sp == 0 && PHON(0)) {
        wt_phase(p, l, smem);
        norm_rows(p, pin(p, 6) + l * 1024, modl, 0, 1, xn);
      } else if (sp == 1 && PHON(1)) {
        if (threadIdx.x == 0) tab[0] = GD{xn, 1024, (const u16*)(wo + WO_IN), 1024, 1024, 23, EM_PROJ, 1};
        ng = 1; nN0 = 23;
      } else if (sp == 2 && PHON(2)) {
        for (int t = bid; t < 264 * 6; t += nb) premix_task(p, l, t, smem);
        {
          Epi ef{EM_FILT, p.ws, gate, nullptr, (u16*)(wo + WO_FILT)};
          const u16* hA = (const u16*)(p.ws + WS_HID2) + (size_t)l * 8192 * 64;
          const u16* wB = (const u16*)(p.ws + WS_W3T) + (size_t)l * 1024 * 64;
#pragma unroll 1
          for (int t = nb - 1 - bid; t < 128; t += nb) gemm_tile(hA, 64, wB, 64, 64, (t >> 2) * 256, (t & 3) * 256, smem, ef);
        }
      } else if (sp == 3 && PHON(3)) {
        for (int t = bid; t < 512; t += nb) fft_task(p, l, t, smem);
        if (threadIdx.x == 0) {
          tab[0] = GD{proj + OFF_Q, DINP, (const u16*)(wo + WO_UQ), 384, 384, 3, EM_Q, 1};
          tab[1] = GD{proj + OFF_KV, DINP, (const u16*)(wo + WO_UKV), 256, 256, 4, EM_KV, 1};
        }
        ng = 2; nN0 = 3; nN1 = 4;
        for (int i = tid_l(); i < 1024; i += NT) ((float2*)(smem + 131072))[i] = ((const float2*)(p.ws + WS_ROPE))[i];
      } else if (sp == 4 && PHON(4)) {
        for (int t = bid; t < (last ? 512 : 528); t += nb) {
          int bh, qb;
          if (t < 512) { int rnd = t >> 8, w = t & 255; bh = (w & 7) + 8 * rnd; qb = 1 + (w >> 3); }
          else { bh = t - 512; qb = 0; }
          attn_task(p, bh, qb, smem);
        }
        for (int t = bid; t < 528; t += nb) hypost_task(p, t, smem);
      } else if (sp == 5 && PHON(5)) {
        for (int t = bid; t < (last ? 512 : 544); t += nb) {
          if (t < 512) {
            const int x = t & 7, g = t >> 3, pmi = (g >> 2) * 8 + x, pm = pmi + 2 + (pmi >= 64 ? 2 : 0);
            mix_tile<4>(p, l, pm * 128, g & 3, smem);
          } else {
            const int c = t - 512, cm = c >> 2;
            mix_tile<2>(p, l, (cm >> 2) * SP + (cm & 3) * 64, c & 3, smem);
          }
        }
      } else if (sp == 6 && PHON(6)) {
        if (threadIdx.x == 0) tab[0] = GD{(const u16*)(p.ws + WS_ZV), 1024, (const u16*)(wo + WO_OUT), 1024, 1024, 4, EM_RESID, 4};
        ng = 1; nN0 = 4; nsplit = 4;
        gate = modl + 2 * 1024;
      } else if (sp == 7 && PHON(7)) {
        norm_rows(p, pin(p, 7) + l * 1024, modl, 3, 4, xn);
      } else if (sp == 8 && PHON(8)) {
        if (threadIdx.x == 0) tab[0] = GD{xn, 1024, (const u16*)(wo + WO_FF1), 1024, 1024, 16, EM_SQRELU, last ? 2 : 1};
        ng = 1; nN0 = 16; nsplit = last ? 2 : 1;
      } else if (sp == 9 && PHON(9)) {
        if (threadIdx.x == 0) tab[0] = GD{proj, DFF, (const u16*)(wo + WO_FF2), 4096, 4096, 4, EM_RESID, 8};
        ng = 1; nN0 = 4; nsplit = 8;
        gate = modl + 5 * 1024;
      }
      if (ng > 0) {
        __syncthreads();
        const int nt0 = (nsplit > 1) ? (64 * nN0 + (last ? 0 : 2 * nN0 * nsplit)) : NMT * nN0, ntot = nt0 + NMT * nN1;
#pragma unroll 1
        for (int t = bid; t < ntot; t += nb) {
          int gi = 0, tt = t;
          if (t >= nt0) { gi = 1; tt = t - nt0; }
          const volatile GD* gp = tab + gi;
          unsigned long long a64 = (unsigned long long)gp->A, b64 = (unsigned long long)gp->Bt;
          a64 = ((unsigned long long)(unsigned)__builtin_amdgcn_readfirstlane((unsigned)(a64 >> 32)) << 32) | (unsigned long long)(unsigned)__builtin_amdgcn_readfirstlane((unsigned)a64);
          b64 = ((unsigned long long)(unsigned)__builtin_amdgcn_readfirstlane((unsigned)(b64 >> 32)) << 32) | (unsigned long long)(unsigned)__builtin_amdgcn_readfirstlane((unsigned)b64);
          const int lda = __builtin_amdgcn_readfirstlane(gp->lda), ldb = __builtin_amdgcn_readfirstlane(gp->ldb);
          const int K = __builtin_amdgcn_readfirstlane(gp->K), nN = __builtin_amdgcn_readfirstlane(gp->nN);
          const int ks = __builtin_amdgcn_readfirstlane(gp->ks);
          const int mode = __builtin_amdgcn_readfirstlane(gp->mode);
          int pm, pn, Kuse = K, emode = mode;
          if (ks > 1) {
            const int nlat = 64 * nN;
            if (tt < nlat) { int pm64; tile_map(tt, 64, nN, pm64, pn); pm = (pm64 >> 5) * 33 + 1 + (pm64 & 31); }
            else {
              int u = tt - nlat, kp = u % ks, tile = u / ks;
              pm = (tile / nN) * 33; pn = tile % nN;
              Kuse = K / ks; emode = EM_RESID_AT;
              a64 += (unsigned long long)kp * Kuse * 2; b64 += (unsigned long long)kp * Kuse * 2;
            }
          } else tile_map(tt, NMT, nN, pm, pn);
          Epi e{emode, p.ws, gate, (const float2*)(smem + 131072), nullptr};
          gemm_tile((const u16*)a64, lda, (const u16*)b64, ldb, Kuse, pm * 256, pn * 256, smem, e);
        }
      }
    }
    if (ph + 1 < prm.ph_hi) {
      if (ph == prm.ph_lo) grid.sync();
      else xcd_barrier(xbar);
    }
  }
}

extern "C" void kernel_launch(void* const* d_in, const int* in_sizes, int n_in, void* d_out, int out_size, void* d_ws,
                              size_t ws_size, hipStream_t stream) {
  static int grid_blocks = 0;
  if (grid_blocks == 0) {
    if (n_in != 33 || ws_size < WS_END || (size_t)out_size * 4 < WO_END) {
      fprintf(stderr, "kernel_launch: unexpected sizes n_in=%d ws=%zu (need %zu) out=%d\n", n_in, ws_size, (size_t)WS_END, out_size);
      grid_blocks = -1;
      return;
    }
    int dev = 0, cus = 0, per_cu = 0;
    hipGetDevice(&dev);
    hipDeviceGetAttribute(&cus, hipDeviceAttributeMultiprocessorCount, dev);
    hipOccupancyMaxActiveBlocksPerMultiprocessor(&per_cu, mega, NT, 0);
    if (per_cu < 1) per_cu = 1;
    if (per_cu > 1) per_cu = 1;
    grid_blocks = cus * per_cu;
  }
  if (grid_blocks < 0) return;
  Params p{};
  for (int i = 0; i < 33; ++i) p.in[i] = (const float*)d_in[i];
  p.out = (float*)d_out;
  p.ws = (char*)d_ws;
  p.ph_lo = 0;
  p.ph_hi = NPH;
  (void)hipMemsetAsync((char*)d_ws + WS_BAR, 0, 16384, stream);
  void* args[] = {&p};
  hipError_t e = hipLaunchCooperativeKernel((void*)mega, dim3(grid_blocks), dim3(NT), args, 0, stream);
  if (e != hipSuccess) fprintf(stderr, "cooperative launch failed: %s (grid %d)\n", hipGetErrorString(e), grid_blocks);
}
```
